# Optimizing an MI355X kernel written in HIP

```python
import math
import jax
import jax.numpy as jnp
from jax import lax
import numpy as np

D_MODEL = 1024
BATCH = 8
SEQ = 4096
DEPTH = 4

GRID_W = 64
CTX_LEN = 256
N_MIXERS = 2
NORM_EPS = 1e-6

MLA_HEADS = 8
QK_NOPE = 128
QK_ROPE = 64
V_HEAD = 128
QK_HEAD = QK_NOPE + QK_ROPE
Q_LORA = 384
KV_LORA = 256
ROPE_BASE = 10000.0
AXIS_PAIRS = QK_ROPE // 4
Q_BLOCK = 128
SM_SCALE = QK_HEAD ** -0.5

RWKV_HEAD = 64
RWKV_HEADS = D_MODEL // RWKV_HEAD
DECAY_LORA = 64
AAA_LORA = 64
MV_LORA = 32
GATE_LORA = 160
LN_X_EPS = 64e-5

D_FF = 2816
N_EXPERTS = 8
TOP_K = 2
D_FF_EXPERT = 3584

N_MLA = (DEPTH + 1) // 2
N_RWKV = DEPTH // 2
N_VRES = max(N_RWKV - 1, 0)
N_DENSE = (DEPTH + 1) // 2
N_MOE = DEPTH // 2

kernel_name = "hybrid_mla_rwkv7_moe_dit_prefix"


def rms_norm(x, g):
    xf = x.astype(jnp.float32)
    y = xf * lax.rsqrt(jnp.mean(xf * xf, axis=-1, keepdims=True) + NORM_EPS)
    return (y * g.astype(jnp.float32)).astype(x.dtype)


def modulate(h, shift, scale):
    return h * (1 + scale) + shift


def axial_rope_tables(rows):
    row_ids = jnp.repeat(jnp.arange(rows, dtype=jnp.float32), GRID_W)
    col_ids = jnp.tile(jnp.arange(GRID_W, dtype=jnp.float32), rows)
    inv_freq = 1.0 / (ROPE_BASE ** (jnp.arange(AXIS_PAIRS, dtype=jnp.float32) / AXIS_PAIRS))
    ang_r = row_ids[:, None] * inv_freq[None, :]
    ang_c = col_ids[:, None] * inv_freq[None, :]
    return (jnp.cos(ang_r), jnp.sin(ang_r), jnp.cos(ang_c), jnp.sin(ang_c))


def _rotate(z, cos, sin):
    m = cos.shape[-1]
    z1, z2 = z[..., :m], z[..., m:]
    cos = cos[:, None, :]
    sin = sin[:, None, :]
    return jnp.concatenate([z1 * cos - z2 * sin, z2 * cos + z1 * sin], axis=-1)


def apply_axial_rope(z, tables):
    cr, sr, cc, sc = tables
    zf = z.astype(jnp.float32)
    half = QK_ROPE // 2
    out = jnp.concatenate([_rotate(zf[..., :half], cr, sr), _rotate(zf[..., half:], cc, sc)], axis=-1)
    return out.astype(z.dtype)


def mla_queries(h, p, rope):
    B, T, _ = h.shape
    cq = rms_norm(h @ p["wqa"], p["qa_norm"])
    q = rms_norm((cq @ p["wqb"]).reshape(B, T, MLA_HEADS, QK_HEAD), p["q_norm"])
    if rope is not None:
        q = jnp.concatenate([q[..., :QK_NOPE], apply_axial_rope(q[..., QK_NOPE:], rope)], axis=-1)
    return q


def mla_keys_values(h, p, rope):
    B, T, _ = h.shape
    kv_a = h @ p["wkva"]
    ckv = rms_norm(kv_a[..., :KV_LORA], p["kva_norm"])
    k_rope = jnp.broadcast_to(kv_a[..., None, KV_LORA:], (B, T, MLA_HEADS, QK_ROPE))
    kv = (ckv @ p["wkvb"]).reshape(B, T, MLA_HEADS, QK_NOPE + V_HEAD)
    k = rms_norm(jnp.concatenate([kv[..., :QK_NOPE], k_rope], axis=-1), p["k_norm"])
    if rope is not None:
        k = jnp.concatenate([k[..., :QK_NOPE], apply_axial_rope(k[..., QK_NOPE:], rope)], axis=-1)
    return k, kv[..., QK_NOPE:]


def softmax_attend(q, k, v):
    s = jnp.einsum("bqhd,bkhd->bhqk", q, k, preferred_element_type=jnp.float32) * SM_SCALE
    pr = jax.nn.softmax(s, axis=-1).astype(v.dtype)
    return jnp.einsum("bhqk,bkhd->bqhd", pr, v)


def mla_mixer(hl, hc, p, rope, need_ctx_out):
    B, T, _ = hl.shape
    k_c, v_c = mla_keys_values(hc, p, None)
    k_l, v_l = mla_keys_values(hl, p, rope)
    q_l = mla_queries(hl, p, rope)
    k_all = jnp.concatenate([k_c, k_l], axis=1)
    v_all = jnp.concatenate([v_c, v_l], axis=1)
    nblk = T // Q_BLOCK
    qb = jnp.moveaxis(q_l.reshape(B, nblk, Q_BLOCK, MLA_HEADS, QK_HEAD), 1, 0)
    ob = lax.map(lambda qq: softmax_attend(qq, k_all, v_all), qb)
    out_l = jnp.moveaxis(ob, 0, 1).reshape(B, T, MLA_HEADS * V_HEAD) @ p["wo"]
    out_c = None
    if need_ctx_out:
        q_c = mla_queries(hc, p, None)
        out_c = softmax_attend(q_c, k_c, v_c).reshape(B, hc.shape[1], MLA_HEADS * V_HEAD) @ p["wo"]
    return out_l, out_c


def token_shift_centred(h):
    hp = jnp.pad(h, ((0, 0), (1, 1), (0, 0)))
    return 0.5 * (hp[:, :-2] + hp[:, 2:]) - h


def rwkv_features(h, p, vres, v_first, need_out):
    B, T, D = h.shape
    heads = lambda z: z.reshape(B, T, RWKV_HEADS, RWKV_HEAD)
    xx = token_shift_centred(h)
    mix = p["mix"]
    xw = h + xx * mix[1]
    xk = h + xx * mix[2]
    xv = h + xx * mix[3]
    xa = h + xx * mix[4]
    k = xk @ p["wk"]
    v = xv @ p["wv"]
    if vres is not None:
        v = v + (v_first - v) * jax.nn.sigmoid(vres["v0"] + (xv @ vres["v1"]) @ vres["v2"])
    kf = k.astype(jnp.float32)
    kk = heads(kf * p["k_k"])
    kk = kk / jnp.maximum(jnp.sqrt(jnp.sum(kk * kk, axis=-1, keepdims=True)), 1e-12)
    decay, a, kd = [], [], []
    for d in range(2):
        w_log = -jax.nn.softplus(-(p["w0"][d] + jnp.tanh(xw @ p["w1"][d]) @ p["w2"][d]).astype(jnp.float32)) - 0.5
        decay.append(heads(jnp.exp(-jnp.exp(w_log))))
        ad = jax.nn.sigmoid((p["a0"][d] + (xa @ p["a1"][d]) @ p["a2"][d]).astype(jnp.float32))
        a.append(heads(ad))
        kd.append(heads(kf * (1 + (ad - 1) * p["k_a"])))
    f = {"v": v, "vh": heads(v.astype(jnp.float32)), "kk": kk, "decay": decay, "a": a, "k": kd}
    if need_out:
        xr = h + xx * mix[0]
        xg = h + xx * mix[5]
        f["r"] = heads((xr @ p["wr"]).astype(jnp.float32))
        f["g"] = jax.nn.sigmoid(xg @ p["g1"]) @ p["g2"]
        f["k_bonus"] = 0.5 * (kd[0] + kd[1])
    return f


def wkv_scan(S0, decay, k, v, kk, a, r, reverse):
    emit = r is not None
    tm = lambda z: jnp.moveaxis(z.astype(jnp.float32), 1, 0)
    xs = (tm(decay), tm(k), tm(v), tm(-kk), tm(kk * a)) + ((tm(r),) if emit else ())

    def step(S, inp):
        w_t, k_t, v_t, a_t, b_t = inp[:5]
        sa = jnp.einsum("bhvk,bhk->bhv", S, a_t)
        S = S * w_t[:, :, None, :] + sa[..., None] * b_t[:, :, None, :] + v_t[..., None] * k_t[:, :, None, :]
        y = jnp.einsum("bhvk,bhk->bhv", S, inp[5]) if emit else None
        return S, y

    S, ys = lax.scan(step, S0, xs, reverse=reverse)
    return S, (jnp.moveaxis(ys, 0, 1) if emit else None)


def rwkv_output(y, f, p, dtype):
    B, T = y.shape[:2]
    mu = jnp.mean(y, axis=-1, keepdims=True)
    var = jnp.mean(jnp.square(y - mu), axis=-1, keepdims=True)
    yn = ((y - mu) * lax.rsqrt(var + LN_X_EPS)).reshape(B, T, D_MODEL) * p["ln_w"] + p["ln_b"]
    bonus = jnp.sum(f["r"] * f["k_bonus"] * p["r_k"], axis=-1, keepdims=True) * f["vh"]
    o = ((yn + bonus.reshape(B, T, D_MODEL)) * f["g"]).astype(dtype)
    return o @ p["wo"]


def rwkv_mixer(hl, hc, p, vres, v_first_l, v_first_c, need_ctx_out):
    B = hl.shape[0]
    fl = rwkv_features(hl, p, vres, v_first_l, True)
    fc = rwkv_features(hc, p, vres, v_first_c, need_ctx_out)
    y_l = 0.0
    y_c = 0.0
    for d, rev in ((0, False), (1, True)):
        S0 = jnp.zeros((B, RWKV_HEADS, RWKV_HEAD, RWKV_HEAD), jnp.float32)
        S_c, yc = wkv_scan(S0, fc["decay"][d], fc["k"][d], fc["vh"], fc["kk"], fc["a"][d], fc.get("r"), rev)
        _, yl = wkv_scan(S_c, fl["decay"][d], fl["k"][d], fl["vh"], fl["kk"], fl["a"][d], fl["r"], rev)
        y_l = y_l + yl
        if need_ctx_out:
            y_c = y_c + yc
    out_l = rwkv_output(y_l, fl, p, hl.dtype)
    out_c = rwkv_output(y_c, fc, p, hc.dtype) if need_ctx_out else None
    return out_l, out_c, fl["v"], fc["v"]


def swiglu(h, w1, w3, w2):
    return (jax.nn.silu(h @ w1) * (h @ w3)) @ w2


def moe_swiglu(h, router, w1, w3, w2):
    logits = (h @ router).astype(jnp.float32)
    top_val, top_idx = lax.top_k(logits, TOP_K)
    top_w = jax.nn.softmax(top_val, axis=-1)
    gates = jnp.sum(jax.nn.one_hot(top_idx, N_EXPERTS, dtype=jnp.float32) * top_w[..., None], axis=1)
    y = jnp.zeros_like(h)
    for e in range(N_EXPERTS):
        y = y + gates[:, e:e + 1].astype(h.dtype) * swiglu(h, w1[e], w3[e], w2[e])
    return y


def setup_inputs(seed: int = 0) -> dict:
    key = jax.random.key(seed)
    keys = jax.random.split(key, 48)
    counter = iter(range(48))
    D = D_MODEL

    def nrm(shape, scale):
        return scale * jax.random.normal(keys[next(counter)], shape, jnp.float32)

    def uni(shape, lo, hi):
        return jax.random.uniform(keys[next(counter)], shape, jnp.float32, lo, hi)

    def gain(shape):
        return 1.0 + nrm(shape, 0.02)

    return {
        "x": nrm((BATCH, SEQ, D), 1.0),
        "c": nrm((BATCH, D), 1.0),
        "ctx": nrm((BATCH, CTX_LEN, D), 1.0),
        "c_ctx": nrm((D,), 1.0),
        "ada_w": nrm((DEPTH, D, 6 * D), 0.5 * D ** -0.5),
        "ada_b": nrm((DEPTH, 6 * D), 0.02),
        "norm1_g": gain((DEPTH, D)),
        "norm2_g": gain((DEPTH, D)),
        "mla_wqa": nrm((N_MLA, D, Q_LORA), D ** -0.5),
        "mla_qa_norm": gain((N_MLA, Q_LORA)),
        "mla_wqb": nrm((N_MLA, Q_LORA, MLA_HEADS * QK_HEAD), Q_LORA ** -0.5),
        "mla_wkva": nrm((N_MLA, D, KV_LORA + QK_ROPE), D ** -0.5),
        "mla_kva_norm": gain((N_MLA, KV_LORA)),
        "mla_wkvb": nrm((N_MLA, KV_LORA, MLA_HEADS * (QK_NOPE + V_HEAD)), KV_LORA ** -0.5),
        "mla_q_norm": gain((N_MLA, QK_HEAD)),
        "mla_k_norm": gain((N_MLA, QK_HEAD)),
        "mla_wo": nrm((N_MLA, MLA_HEADS * V_HEAD, D), (MLA_HEADS * V_HEAD) ** -0.5),
        "rwkv_mix": uni((N_RWKV, 6, D), 0.0, 1.0),
        "rwkv_wr": nrm((N_RWKV, D, D), D ** -0.5),
        "rwkv_wk": nrm((N_RWKV, D, D), D ** -0.5),
        "rwkv_wv": nrm((N_RWKV, D, D), D ** -0.5),
        "rwkv_wo": nrm((N_RWKV, D, D), D ** -0.5),
        "rwkv_w0": uni((N_RWKV, 2, D), -5.5, 0.5),
        "rwkv_w1": nrm((N_RWKV, 2, D, DECAY_LORA), D ** -0.5),
        "rwkv_w2": nrm((N_RWKV, 2, DECAY_LORA, D), 0.1 * DECAY_LORA ** -0.5),
        "rwkv_a0": nrm((N_RWKV, 2, D), 0.1),
        "rwkv_a1": nrm((N_RWKV, 2, D, AAA_LORA), D ** -0.5),
        "rwkv_a2": nrm((N_RWKV, 2, AAA_LORA, D), 0.1 * AAA_LORA ** -0.5),
        "rwkv_g1": nrm((N_RWKV, D, GATE_LORA), D ** -0.5),
        "rwkv_g2": nrm((N_RWKV, GATE_LORA, D), GATE_LORA ** -0.5),
        "rwkv_k_k": 0.85 + nrm((N_RWKV, D), 0.02),
        "rwkv_k_a": gain((N_RWKV, D)),
        "rwkv_r_k": nrm((N_RWKV, RWKV_HEADS, RWKV_HEAD), 0.1),
        "rwkv_ln_w": gain((N_RWKV, D)),
        "rwkv_ln_b": nrm((N_RWKV, D), 0.02),
        "rwkv_v0": 1.0 + nrm((N_VRES, D), 0.1),
        "rwkv_v1": nrm((N_VRES, D, MV_LORA), D ** -0.5),
        "rwkv_v2": nrm((N_VRES, MV_LORA, D), 0.1 * MV_LORA ** -0.5),
        "ffn_w1": nrm((N_DENSE, D, D_FF), D ** -0.5),
        "ffn_w3": nrm((N_DENSE, D, D_FF), D ** -0.5),
        "ffn_w2": nrm((N_DENSE, D_FF, D), D_FF ** -0.5),
        "moe_router": nrm((N_MOE, D, N_EXPERTS), D ** -0.5),
        "moe_w1": nrm((N_MOE, N_EXPERTS, D, D_FF_EXPERT), D ** -0.5),
        "moe_w3": nrm((N_MOE, N_EXPERTS, D, D_FF_EXPERT), D ** -0.5),
        "moe_w2": nrm((N_MOE, N_EXPERTS, D_FF_EXPERT, D), D_FF_EXPERT ** -0.5),
    }


def reference(x, c, ctx, c_ctx, ada_w, ada_b, norm1_g, norm2_g,
              mla_wqa, mla_qa_norm, mla_wqb, mla_wkva, mla_kva_norm, mla_wkvb, mla_q_norm, mla_k_norm, mla_wo,
              rwkv_mix, rwkv_wr, rwkv_wk, rwkv_wv, rwkv_wo, rwkv_w0, rwkv_w1, rwkv_w2, rwkv_a0, rwkv_a1, rwkv_a2,
              rwkv_g1, rwkv_g2, rwkv_k_k, rwkv_k_a, rwkv_r_k, rwkv_ln_w, rwkv_ln_b, rwkv_v0, rwkv_v1, rwkv_v2,
              ffn_w1, ffn_w3, ffn_w2, moe_router, moe_w1, moe_w3, moe_w2):
    B, T, D = x.shape
    L = ctx.shape[1]
    rows = T // GRID_W
    rope = axial_rope_tables(rows)
    sc = jax.nn.silu(c)
    sc_ctx = jax.nn.silu(c_ctx)
    cs = ctx
    v_first_l = None
    v_first_c = None
    for i in range(DEPTH):
        last = i == DEPTH - 1
        j = i // N_MIXERS
        mod_l = (sc @ ada_w[i] + ada_b[i]).reshape(B, 6, 1, D)
        mod_c = (sc_ctx @ ada_w[i] + ada_b[i]).reshape(6, D)

        hl = modulate(rms_norm(x, norm1_g[i]), mod_l[:, 0], mod_l[:, 1])
        hc = modulate(rms_norm(cs, norm1_g[i]), mod_c[0], mod_c[1])
        if i % N_MIXERS == 0:
            p = {"wqa": mla_wqa[j], "qa_norm": mla_qa_norm[j], "wqb": mla_wqb[j], "wkva": mla_wkva[j],
                 "kva_norm": mla_kva_norm[j], "wkvb": mla_wkvb[j], "q_norm": mla_q_norm[j],
                 "k_norm": mla_k_norm[j], "wo": mla_wo[j]}
            out_l, out_c = mla_mixer(hl, hc, p, rope, not last)
        else:
            p = {"mix": rwkv_mix[j], "wr": rwkv_wr[j], "wk": rwkv_wk[j], "wv": rwkv_wv[j], "wo": rwkv_wo[j],
                 "w0": rwkv_w0[j], "w1": rwkv_w1[j], "w2": rwkv_w2[j], "a0": rwkv_a0[j], "a1": rwkv_a1[j],
                 "a2": rwkv_a2[j], "g1": rwkv_g1[j], "g2": rwkv_g2[j], "k_k": rwkv_k_k[j], "k_a": rwkv_k_a[j],
                 "r_k": rwkv_r_k[j], "ln_w": rwkv_ln_w[j], "ln_b": rwkv_ln_b[j]}
            vres = None if j == 0 else {"v0": rwkv_v0[j - 1], "v1": rwkv_v1[j - 1], "v2": rwkv_v2[j - 1]}
            out_l, out_c, v_l, v_c = rwkv_mixer(hl, hc, p, vres, v_first_l, v_first_c, not last)
            if j == 0:
                v_first_l, v_first_c = v_l, v_c
        x = x + mod_l[:, 2] * out_l
        if not last:
            cs = cs + mod_c[2] * out_c

        hl = modulate(rms_norm(x, norm2_g[i]), mod_l[:, 3], mod_l[:, 4]).reshape(B * T, D)
        if not last:
            hc = modulate(rms_norm(cs, norm2_g[i]), mod_c[3], mod_c[4]).reshape(B * L, D)
            tokens = jnp.concatenate([hl, hc], axis=0)
        else:
            tokens = hl
        if i % 2 == 0:
            k = i // 2
            y = swiglu(tokens, ffn_w1[k], ffn_w3[k], ffn_w2[k])
        else:
            k = i // 2
            y = moe_swiglu(tokens, moe_router[k], moe_w1[k], moe_w3[k], moe_w2[k])
        x = x + mod_l[:, 5] * y[:B * T].reshape(B, T, D)
        if not last:
            cs = cs + mod_c[5] * y[B * T:].reshape(B, L, D)
    return x
```

```cpp
#include <hip/hip_runtime.h>
#include <cstdio>
#include <cstdint>
#ifndef SCAN_CHUNKED
#define SCAN_CHUNKED 1
#endif
#ifndef CS_SERIAL
#define CS_SERIAL 0
#endif
#ifndef CS_BOTH
#define CS_BOTH 0
#endif
#ifndef CS_NOTILE
#define CS_NOTILE 0
#endif
#ifndef CS_OOP
#define CS_OOP 0
#endif
#ifndef CS_TOL
#define CS_TOL 0.05f
#endif

#ifndef MK_ONE_LAUNCH
#define MK_ONE_LAUNCH 1
#endif

#define LAS __attribute__((address_space(3)))
typedef unsigned short bf16_t;
typedef short bf16x8 __attribute__((ext_vector_type(8)));
typedef short s16x4 __attribute__((ext_vector_type(4)));
typedef float f32x2 __attribute__((ext_vector_type(2)));
typedef float f32x4 __attribute__((ext_vector_type(4)));
typedef float f32x16 __attribute__((ext_vector_type(16)));
typedef unsigned u32x2 __attribute__((ext_vector_type(2)));
typedef unsigned u32x4 __attribute__((ext_vector_type(4)));

constexpr int D = 1024, NB = 8, SEQ = 4096, CTX = 256, SEG = SEQ + CTX, R = NB * SEG;
constexpr int NPAN = R / 256;
constexpr int NTHR = 512, NWAVE = 8;
constexpr int QL = 384, KVL = 256, ROPE = 64, NOPE = 128, QKH = 192, VH = 128, NH = 8;
constexpr int DFF = 2816, NE = 8, DFE = 3584;
constexpr int MP_MAX = 71680;
constexpr float NORM_EPS = 1e-6f, LNX_EPS = 64e-5f;
constexpr float QSCALE = 0.07216878364870322f * 1.4426950408889634f;

enum { I_X = 0, I_C, I_CTX, I_CCTX, I_ADAW, I_ADAB, I_N1G, I_N2G, I_WQA, I_QAN, I_WQB, I_WKVA, I_KVAN, I_WKVB, I_QN, I_KN, I_MWO,
       I_MIX, I_WR, I_WK, I_WV, I_RWO, I_W0, I_W1, I_W2, I_A0, I_A1, I_A2, I_G1, I_G2, I_KK, I_KA, I_RK, I_LNW, I_LNB, I_V0, I_V1, I_V2,
       I_F1, I_F3, I_F2, I_ROUTER, I_M1, I_M3, I_M2, N_IN };

constexpr size_t U = (size_t)R * 1024 * 2;
constexpr size_t al256(size_t x) { return (x + 255) / 256 * 256; }
constexpr size_t WS_CTL = 0;
constexpr size_t CTL_BYTES = 65536;
constexpr size_t WS_MODS = WS_CTL + CTL_BYTES;
constexpr size_t WS_ROPE = WS_MODS + al256((size_t)4 * 9 * 6144 * 4);
constexpr size_t WS_CS = WS_ROPE + 8192;
constexpr size_t WS_RS = WS_CS + (size_t)NB * CTX * D * 4;
constexpr size_t WS_ROUTE = WS_RS + al256((size_t)R * 8);
constexpr size_t WS_RSLOT = WS_ROUTE + (size_t)R * 16;
constexpr size_t WS_HIST = WS_RSLOT + (size_t)R * 8;
constexpr size_t WS_META = WS_HIST + 2048 * 8 * 4;
constexpr size_t WS_WSM = WS_META + 256;
constexpr size_t E_QKVA = 768 * 1024, E_QB = 1536 * 384, E_KVB = 2048 * 384, E_MWO = 1024 * 1024, E_MLA = E_QKVA + E_QB + E_KVB + E_MWO;
constexpr size_t E_B1 = 1024 * 2048, E_B2 = 1024 * 2048, E_L1 = 512 * 2048, E_L2A = 4096 * 256, E_L2B = 2048 * 256, E_RWKV = E_B1 + E_B2 + E_L1 + E_L2A + E_L2B;
constexpr size_t E_F13 = 5632 * 1024, E_F2 = 1024 * 2816, E_FFN = E_F13 + E_F2;
constexpr size_t WS_WMLA = WS_WSM, WS_WRWKV = WS_WMLA + 2 * E_MLA * 2, WS_WFFN = WS_WRWKV + 2 * E_RWKV * 2;
constexpr size_t WS_VF = WS_WFFN + 2 * E_FFN * 2;
constexpr size_t WS_ARENA = WS_VF + U;
constexpr size_t A_H = 0;
constexpr size_t A_QKVA = U, A_Q = 2 * U, A_KV = 2 * U + U * 3 / 2, A_K = A_KV + 2 * U, A_O = A_K + U * 3 / 2;
constexpr size_t A_FHID = U;
constexpr size_t A_AX = 0, A_L1 = 5 * U, A_RR = A_L1 + U / 2, A_RK = A_RR + U, A_RV = A_RK + U, A_VL = A_RV + U, A_REND = A_VL + U;
constexpr size_t A_WL0 = 0, A_WL1 = U, A_AL0 = 2 * U, A_AL1 = 3 * U, A_G = 4 * U, A_RO = 0;
constexpr size_t A_YF = (SCAN_CHUNKED && CS_OOP && !CS_BOTH) ? A_REND : A_WL0, A_YR = (SCAN_CHUNKED && CS_OOP && !CS_BOTH) ? A_REND + U : A_WL1;
constexpr size_t A_YCF = CS_BOTH ? A_REND : A_YF, A_YCR = CS_BOTH ? A_REND + U : A_YR;
constexpr size_t A_HS = U, A_Y2 = U, A_MHID = A_HS + (size_t)MP_MAX * 1024 * 2, A_MEND = A_MHID + (size_t)MP_MAX * DFE * 2;
constexpr size_t E_M13 = (size_t)7168 * 1024, E_M2 = (size_t)1024 * 3584;
constexpr size_t A_WM13 = A_MEND, A_WM2 = A_WM13 + NE * E_M13 * 2, A_END = A_WM2 + NE * E_M2 * 2;
constexpr size_t WS_NEED = WS_ARENA + (A_END > A_REND ? A_END : A_REND);
static_assert(WS_NEED <= 1081188352ull, "workspace budget (sum of inputs)");
static_assert(CS_OOP || CS_BOTH || A_WM13 >= A_REND, "the MoE weight region must be free during the RWKV mixer (weights are converted inside the scan phase)");

struct Args { const float* in[N_IN]; float* out; unsigned char* ws; int ph_lo, ph_hi; };

__device__ __forceinline__ unsigned cvt_pk_bf16(float lo, float hi) { unsigned r; asm("v_cvt_pk_bf16_f32 %0, %1, %2" : "=v"(r) : "v"(lo), "v"(hi)); return r; }
__device__ __forceinline__ float bflo(unsigned w) { return __uint_as_float(w << 16); }
__device__ __forceinline__ float bfhi(unsigned w) { return __uint_as_float(w & 0xffff0000u); }
__device__ __forceinline__ void unpack8(const u32x4 w, float (&f)[8]) { f[0] = bflo(w.x); f[1] = bfhi(w.x); f[2] = bflo(w.y); f[3] = bfhi(w.y); f[4] = bflo(w.z); f[5] = bfhi(w.z); f[6] = bflo(w.w); f[7] = bfhi(w.w); }
__device__ __forceinline__ u32x4 pack8(const float (&f)[8]) { u32x4 w; w.x = cvt_pk_bf16(f[0], f[1]); w.y = cvt_pk_bf16(f[2], f[3]); w.z = cvt_pk_bf16(f[4], f[5]); w.w = cvt_pk_bf16(f[6], f[7]); return w; }
__device__ __forceinline__ float wave_sum(float v) {
#pragma unroll
    for (int o = 32; o >= 1; o >>= 1) v += __shfl_xor(v, o);
    return v;
}
template <int CTRL> __device__ __forceinline__ float dpp_f(float v) { return __int_as_float(__builtin_amdgcn_update_dpp(0, __float_as_int(v), CTRL, 0xF, 0xF, true)); }
__device__ __forceinline__ float red8(float v) { v += dpp_f<0xB1>(v); v += dpp_f<0x4E>(v); v += dpp_f<0x141>(v); return v; }
__device__ __forceinline__ int ltid() { int t = threadIdx.x; asm volatile("" : "+v"(t)); return t; }
template <class T> __device__ __forceinline__ T launder_s(T x) { asm volatile("" : "+s"(x)); return x; }
__device__ __forceinline__ Args launder_args(const Args& k) { Args a = k; a.ws = launder_s(k.ws); a.out = launder_s(k.out); return a; }
__device__ __forceinline__ float wave_sum_dpp(float v) {
    v += dpp_f<0xB1>(v); v += dpp_f<0x4E>(v); v += dpp_f<0x141>(v); v += dpp_f<0x140>(v);
    const int iv = __float_as_int(v);
    return (__int_as_float(__builtin_amdgcn_readlane(iv, 0)) + __int_as_float(__builtin_amdgcn_readlane(iv, 16))) + (__int_as_float(__builtin_amdgcn_readlane(iv, 32)) + __int_as_float(__builtin_amdgcn_readlane(iv, 48)));
}
__device__ __forceinline__ float sigmoidf_(float x) { return __builtin_amdgcn_rcpf(1.0f + __expf(-x)); }
__device__ __forceinline__ float* xrow(const Args& a, int row) {
    const int b = row / SEG, r = row - b * SEG;
    return r < CTX ? (float*)(a.ws + WS_CS) + (size_t)(b * CTX + r) * D : a.out + (size_t)(b * SEQ + r - CTX) * D;
}
__device__ __forceinline__ const float* xrow_in(const Args& a, int row) {
    const int b = row / SEG, r = row - b * SEG;
    return r < CTX ? a.in[I_CTX] + (size_t)(b * CTX + r) * D : a.in[I_X] + (size_t)(b * SEQ + r - CTX) * D;
}
__device__ __forceinline__ int mod_index(int row) { const int b = row / SEG, r = row - b * SEG; return r < CTX ? 8 : b; }
__device__ __forceinline__ const float* mods_ptr(const Args& a, int layer, int mi, int which) { return (const float*)(a.ws + WS_MODS) + ((size_t)(layer * 9 + mi) * 6 + which) * 1024; }

#define XB_TMO      128
#define XB_XCNT(j)  (256  + 64 * (j))
#define XB_XSUB(j)  (1280 + 64 * (j))
#define XB_XGEN(j)  (2304 + 64 * (j))
#define XB_TOP      3328
#define XB_TOPGEN   3392
#define XCD_BAR_WORDS 3456
#define XB_SPIN_CAP (1u << 22)
__device__ __forceinline__ unsigned xb_ld(unsigned* p)              { return __hip_atomic_load(p, __ATOMIC_RELAXED, __HIP_MEMORY_SCOPE_AGENT); }
__device__ __forceinline__ unsigned xb_add(unsigned* p, unsigned v) { return __hip_atomic_fetch_add(p, v, __ATOMIC_RELAXED, __HIP_MEMORY_SCOPE_AGENT); }
__device__ __forceinline__ unsigned xb_xcc_id() { return (unsigned)__builtin_amdgcn_s_getreg((3 << 11) | 20) & 0xFu; }
#define XB_SPIN(cond, bar) do { unsigned _sp = 0; while (cond) { __builtin_amdgcn_s_sleep(1); \
    if ((++_sp & 255u) == 0u) { if (xb_ld(&(bar)[XB_TMO])) break; if (_sp > XB_SPIN_CAP) { atomicAdd(&(bar)[XB_TMO], 1u); break; } } } } while (0)
struct XcdBarrier { unsigned* bar; unsigned x; volatile LAS unsigned* st; };
__device__ __forceinline__ XcdBarrier xcd_barrier_post(unsigned* bar, volatile LAS unsigned* st) {
    XcdBarrier b; b.bar = bar; b.x = xb_xcc_id(); b.st = st;
    if (threadIdx.x == 0) (void)xb_add(&bar[XB_XCNT(b.x)], 1u);
    return b;
}
__device__ __forceinline__ void xcd_barrier_complete(unsigned* bar, unsigned x, unsigned& nloc, unsigned& nx) {
    const unsigned G = gridDim.x * gridDim.y * gridDim.z;
    unsigned sum, cnt, mine, sp = 0u;
    for (;;) {
        sum = 0u; cnt = 0u; mine = 0u;
#pragma unroll
        for (unsigned j = 0; j < 16; ++j) { const unsigned c = xb_ld(&bar[XB_XCNT(j)]); sum += c; cnt += (c > 0u) ? 1u : 0u; mine = (j == x) ? c : mine; }
        if (sum == G) break;
        __builtin_amdgcn_s_sleep(1);
        if ((++sp & 255u) == 0u) { if (xb_ld(&bar[XB_TMO])) break; if (sp > XB_SPIN_CAP) { atomicAdd(&bar[XB_TMO], 1u); break; } }
    }
    nloc = mine > 0u ? mine : 1u; nx = cnt > 0u ? cnt : 1u;
}
__device__ __forceinline__ void xcd_barrier(const XcdBarrier& b) {
    asm volatile("s_waitcnt vmcnt(0)" ::: "memory");
    __syncthreads();
    if (threadIdx.x == 0) {
        unsigned* bar = b.bar;
        __builtin_amdgcn_s_waitcnt(0);
        unsigned nloc = b.st[0], nx = b.st[1];
        if (nloc == 0u) { xcd_barrier_complete(bar, b.x, nloc, nx); b.st[0] = nloc; b.st[1] = nx; }
        const unsigned old = xb_add(&bar[XB_XSUB(b.x)], 1u);
        const unsigned gen = old / nloc;
        if (old + 1u == (gen + 1u) * nloc) {
            __builtin_amdgcn_fence(__ATOMIC_RELEASE, "agent");
            asm volatile("s_waitcnt vmcnt(0)" ::: "memory");
            const unsigned og = xb_add(&bar[XB_TOP], 1u);
            const unsigned tg = og / nx;
            if (og + 1u == (tg + 1u) * nx) xb_add(&bar[XB_TOPGEN], 1u);
            else XB_SPIN(xb_ld(&bar[XB_TOPGEN]) == tg, bar);
            __builtin_amdgcn_fence(__ATOMIC_ACQUIRE, "agent");
            xb_add(&bar[XB_XGEN(b.x)], 1u);
            asm volatile("s_waitcnt vmcnt(0)" ::: "memory");
        } else {
            XB_SPIN(xb_ld(&bar[XB_XGEN(b.x)]) == gen, bar);
            __builtin_amdgcn_fence(__ATOMIC_ACQUIRE, "agent");
            asm volatile("s_waitcnt vmcnt(0)" ::: "memory");
        }
    }
    __syncthreads();
}

namespace pg8 {
constexpr int BM = 256, BK = 64, HALF = 128, HTB = HALF * BK * 2, STAGE_BYTES = 8 * HTB;
__device__ __forceinline__ int lds_byte(int r, int c) { const int st = (r >> 4) * 2 + (c >> 5), rr = r & 15, cc = c & 31, ob = rr * 64 + cc * 2; return st * 1024 + (ob ^ (((ob >> 9) & 1) << 5)); }
__device__ __forceinline__ void stage_rc(int b, int& Rr, int& C) { const int st = b / 1024, sb = b % 1024, swz = sb ^ (((sb >> 9) & 1) << 5); Rr = (st >> 1) * 16 + swz / 64; C = (st & 1) * 32 + (swz % 64) / 2; }
__device__ __forceinline__ int perm32(int rho) { const int n = rho >> 4, i = rho & 15; return 8 * (i >> 2) + 4 * n + (i & 3); }
struct GUnit { const char* A; const char* B; int nt, pm, pn, aux; };
__device__ __forceinline__ void tile_order(int L, int nM, int nN, int& pm, int& pn) {
    const int nwg = nM * nN; int wgid = L;
    { const int q = nwg / 8, r = nwg % 8, xcd = wgid % 8, off = wgid / 8; wgid = (xcd < r ? xcd * (q + 1) : r * (q + 1) + (xcd - r) * q) + off; }
    const int nig = 8 * nN, gid = wgid / nig, fm = gid * 8, gsz = (nM - fm) < 8 ? (nM - fm) : 8;
    pm = fm + ((wgid % nig) % gsz); pn = (wgid % nig) / gsz;
}
template <class Epi, class Map>
__device__ __forceinline__ void gemm_phase(LAS unsigned char* lds, const int lda, const int ldb, const Map& S, const Epi& E, const int G, const int c) {
    const int tid = ltid(), wid = __builtin_amdgcn_readfirstlane(tid >> 6), lane = tid & 63, wr = wid >> 2, wc = wid & 3, fr = lane & 15, fq = lane >> 4;
    unsigned voffA[2], voffB[2];
#pragma unroll
    for (int i = 0; i < 2; ++i) { int Rr, C; stage_rc(tid * 16 + i * 8192, Rr, C); const int Rb = Epi::PERM ? ((Rr & ~31) + perm32(Rr & 31)) : Rr;
        voffA[i] = (unsigned)(Rr * lda + C) * 2u; voffB[i] = (unsigned)(Rb * ldb + C) * 2u; }
    const size_t kstep = (size_t)(BK * 2);
    const size_t hA = (size_t)HALF * lda * 2, hB = (size_t)HALF * ldb * 2;
    const unsigned ldsw = (unsigned)wid * 1024u;
    const int aoff = lds_byte(wr * 64 + fr, fq * 8), boff = lds_byte(wc * 32 + fr, fq * 8);
#define PG8_SA(b, h) (((b) * 2 + (h)) * HTB)
#define PG8_SB(b, h) ((4 + (b) * 2 + (h)) * HTB)
#define PG8_STAGE(bufoff, gbase, voff) do { _Pragma("unroll") for (int _i = 0; _i < 2; ++_i) \
        __builtin_amdgcn_global_load_lds((const unsigned*)((const char*)(gbase) + (voff)[_i]), (LAS unsigned*)(lds + (bufoff) + ldsw + _i * 8192), 16, 0, 0); } while (0)
#define PG8_LDA(dst, b, h) do { _Pragma("unroll") for (int m = 0; m < 4; ++m) _Pragma("unroll") for (int k = 0; k < 2; ++k) dst[m][k] = *(const LAS bf16x8*)(lds + PG8_SA(b, h) + aoff + m * 2048 + k * 1024); } while (0)
#define PG8_LDB(dst, b, h) do { _Pragma("unroll") for (int n = 0; n < 2; ++n) _Pragma("unroll") for (int k = 0; k < 2; ++k) dst[n][k] = *(const LAS bf16x8*)(lds + PG8_SB(b, h) + boff + n * 2048 + k * 1024); } while (0)
#define PG8_MMA(ai, bj, At, Bt) do { __builtin_amdgcn_s_setprio(1); _Pragma("unroll") for (int m = 0; m < 4; ++m) _Pragma("unroll") for (int n = 0; n < 2; ++n) _Pragma("unroll") for (int k = 0; k < 2; ++k) \
        acc[ai][bj][m][n] = __builtin_amdgcn_mfma_f32_16x16x32_bf16(Bt[n][k], At[m][k], acc[ai][bj][m][n], 0, 0, 0); __builtin_amdgcn_s_setprio(0); } while (0)
#define PG8_WAIT_V(n) asm volatile("s_waitcnt vmcnt(" #n ")" ::: "memory")
#define PG8_WAIT_L(n) asm volatile("s_waitcnt lgkmcnt(" #n ")" ::: "memory")
#define PG8_BAR __builtin_amdgcn_s_barrier()
#define PG8_SCHED __builtin_amdgcn_sched_barrier(0)
    GUnit cur, nxt; int ui = 0;
    if (!S(c, cur)) return;
    f32x4 acc[2][2][4][2];
#pragma unroll
    for (int a = 0; a < 2; ++a)
#pragma unroll
        for (int b = 0; b < 2; ++b)
#pragma unroll
            for (int m = 0; m < 4; ++m)
#pragma unroll
                for (int n = 0; n < 2; ++n) acc[a][b][m][n] = (f32x4){0.f, 0.f, 0.f, 0.f};
    bf16x8 At[4][2], B0[2][2], B1[2][2];
    const char* cA = cur.A; const char* cB = cur.B;
    PG8_STAGE(PG8_SB(0, 0), cB, voffB); PG8_STAGE(PG8_SB(0, 1), cB + hB, voffB); PG8_STAGE(PG8_SA(0, 0), cA, voffA); PG8_STAGE(PG8_SA(0, 1), cA + hA, voffA);
    if (wr == 1) PG8_BAR;
    PG8_WAIT_V(2); PG8_BAR;
    PG8_STAGE(PG8_SB(1, 0), cB + kstep, voffB); PG8_STAGE(PG8_SA(1, 0), cA + kstep, voffA); PG8_STAGE(PG8_SB(1, 1), cB + hB + kstep, voffB);
    PG8_WAIT_V(6); PG8_BAR;
    for (;;) {
        const bool has_next = S((ui + 1) * G + c, nxt);
        const char* nA = has_next ? nxt.A : cA; const char* nB = has_next ? nxt.B : cB;
        const int nt = cur.nt;
        for (int t = 0; t < nt; t += 2) {
            const bool last = (t == nt - 2);
            const char* a1 = cA + (size_t)(t + 1) * kstep;
            const char* a2 = last ? nA : cA + (size_t)(t + 2) * kstep; const char* b2 = last ? nB : cB + (size_t)(t + 2) * kstep;
            const char* a3 = a2 + kstep; const char* b3 = b2 + kstep;
            PG8_LDB(B0, 0, 0); PG8_LDB(B1, 0, 1); PG8_SCHED; PG8_LDA(At, 0, 0); PG8_STAGE(PG8_SA(1, 1), a1 + hA, voffA);
            PG8_WAIT_V(8); PG8_WAIT_L(0); PG8_BAR; PG8_MMA(0, 0, At, B0); PG8_MMA(0, 1, At, B1); PG8_BAR; PG8_SCHED;
            PG8_LDA(At, 0, 1); PG8_STAGE(PG8_SB(0, 0), b2, voffB); PG8_STAGE(PG8_SB(0, 1), b2 + hB, voffB); PG8_STAGE(PG8_SA(0, 0), a2, voffA);
            PG8_WAIT_V(8); PG8_WAIT_L(0); PG8_BAR; PG8_MMA(1, 0, At, B0); PG8_MMA(1, 1, At, B1); PG8_BAR; PG8_SCHED;
            PG8_LDB(B0, 1, 0); PG8_LDB(B1, 1, 1); PG8_SCHED; PG8_LDA(At, 1, 0); PG8_STAGE(PG8_SA(0, 1), a2 + hA, voffA);
            PG8_WAIT_V(8); PG8_WAIT_L(0); PG8_BAR; PG8_MMA(0, 0, At, B0); PG8_MMA(0, 1, At, B1); PG8_BAR; PG8_SCHED;
            PG8_LDA(At, 1, 1); PG8_STAGE(PG8_SB(1, 0), b3, voffB); PG8_STAGE(PG8_SB(1, 1), b3 + hB, voffB); PG8_STAGE(PG8_SA(1, 0), a3, voffA);
            PG8_WAIT_V(8); PG8_WAIT_L(0); PG8_BAR; PG8_MMA(1, 0, At, B0); PG8_MMA(1, 1, At, B1); PG8_BAR; PG8_SCHED;
        }
        if (wr == 0) PG8_BAR;
        E(acc, cur, wr, wc, fr, fq);
        if (!has_next) break;
#pragma unroll
        for (int a = 0; a < 2; ++a)
#pragma unroll
            for (int b = 0; b < 2; ++b)
#pragma unroll
                for (int m = 0; m < 4; ++m)
#pragma unroll
                    for (int n = 0; n < 2; ++n) acc[a][b][m][n] = (f32x4){0.f, 0.f, 0.f, 0.f};
        cur = nxt; cA = nA; cB = nB; ++ui;
        if (wr == 1) PG8_BAR;
    }
    PG8_WAIT_V(0);
    PG8_BAR;
#undef PG8_SA
#undef PG8_SB
#undef PG8_STAGE
#undef PG8_LDA
#undef PG8_LDB
#undef PG8_MMA
#undef PG8_WAIT_V
#undef PG8_WAIT_L
#undef PG8_BAR
#undef PG8_SCHED
}
}

using pg8::GUnit;
typedef f32x4 Acc[2][2][4][2];
template <class F> struct EpiBf {
    static constexpr bool PERM = true;
    F f;
    __device__ __forceinline__ void operator()(const Acc& acc, const GUnit& u, int wr, int wc, int fr, int fq) const {
#pragma unroll
        for (int ai = 0; ai < 2; ++ai)
#pragma unroll
            for (int m = 0; m < 4; ++m) { const int trow = ai * 128 + wr * 64 + m * 16 + fr;
#pragma unroll
                for (int bj = 0; bj < 2; ++bj) f(acc[ai][bj][m][0], acc[ai][bj][m][1], u, trow, bj * 128 + wc * 32 + 8 * fq); }
    }
};
__device__ __forceinline__ void st8(bf16_t* p, f32x4 v0, f32x4 v1) { u32x4 w; w.x = cvt_pk_bf16(v0[0], v0[1]); w.y = cvt_pk_bf16(v0[2], v0[3]); w.z = cvt_pk_bf16(v1[0], v1[1]); w.w = cvt_pk_bf16(v1[2], v1[3]); *(u32x4*)p = w; }

struct FPlain { bf16_t* O; int ldc;
    __device__ __forceinline__ void operator()(f32x4 v0, f32x4 v1, const GUnit& u, int trow, int tcol) const { st8(O + (size_t)(u.pm * 256 + trow) * ldc + u.pn * 256 + tcol, v0, v1); } };
struct FQKV { bf16_t* Q; bf16_t* KV; const float* rsq; const float* rskv;
    __device__ __forceinline__ void operator()(f32x4 v0, f32x4 v1, const GUnit& u, int trow, int tcol) const {
        const int row = u.pm * 256 + trow;
        if (u.aux == 0) { const float s = rsq[row]; st8(Q + (size_t)row * 1536 + u.pn * 256 + tcol, v0 * s, v1 * s); }
        else { const float s = rskv[row]; st8(KV + (size_t)row * 2048 + u.pn * 256 + tcol, v0 * s, v1 * s); } } };
struct EpiQKV {
    static constexpr bool PERM = true;
    bf16_t* Q; bf16_t* KV; const float* rsq; const float* rskv;
    __device__ __forceinline__ void operator()(const Acc& acc, const GUnit& u, int wr, int wc, int fr, int fq) const {
        const float* rs = (u.aux == 0) ? rsq : rskv; bf16_t* O = (u.aux == 0) ? Q : KV; const int ldc = (u.aux == 0) ? 1536 : 2048;
        float sc[2][4];
#pragma unroll
        for (int ai = 0; ai < 2; ++ai)
#pragma unroll
            for (int m = 0; m < 4; ++m) sc[ai][m] = rs[u.pm * 256 + ai * 128 + wr * 64 + m * 16 + fr];
#pragma unroll
        for (int ai = 0; ai < 2; ++ai)
#pragma unroll
            for (int m = 0; m < 4; ++m) { const int row = u.pm * 256 + ai * 128 + wr * 64 + m * 16 + fr; const float s = sc[ai][m];
#pragma unroll
                for (int bj = 0; bj < 2; ++bj) st8(O + (size_t)row * ldc + u.pn * 256 + bj * 128 + wc * 32 + 8 * fq, acc[ai][bj][m][0] * s, acc[ai][bj][m][1] * s); }
    }
};
struct EpiRw2 {
    static constexpr bool PERM = true;
    bf16_t* base; bf16_t* vl; const float* w0; const float* a0;
    __device__ __forceinline__ void operator()(const Acc& acc, const GUnit& u, int wr, int wc, int fr, int fq) const {
        bf16_t* o = (u.aux < 5) ? base + (size_t)u.aux * ((size_t)R * 1024) : vl;
        const bool act = u.aux < 4; const float scl = (u.aux < 2) ? 0.6065306597126334f : 1.0f;
        f32x4 bv[2][2];
#pragma unroll
        for (int bj = 0; bj < 2; ++bj) { const int col = u.pn * 256 + bj * 128 + wc * 32 + 8 * fq; const float* bp = (u.aux < 2 ? w0 : a0) + (u.aux & 1) * 1024 + col;
            bv[bj][0] = act ? *(const f32x4*)bp : (f32x4){0.f, 0.f, 0.f, 0.f}; bv[bj][1] = act ? *(const f32x4*)(bp + 4) : (f32x4){0.f, 0.f, 0.f, 0.f}; }
#pragma unroll
        for (int ai = 0; ai < 2; ++ai)
#pragma unroll
            for (int m = 0; m < 4; ++m) { const int row = u.pm * 256 + ai * 128 + wr * 64 + m * 16 + fr;
#pragma unroll
                for (int bj = 0; bj < 2; ++bj) { f32x4 v0 = acc[ai][bj][m][0], v1 = acc[ai][bj][m][1];
                    if (act) {
#pragma unroll
                        for (int j = 0; j < 4; ++j) { v0[j] = scl * sigmoidf_(bv[bj][0][j] + v0[j]); v1[j] = scl * sigmoidf_(bv[bj][1][j] + v1[j]); } }
                    st8(o + (size_t)row * 1024 + u.pn * 256 + bj * 128 + wc * 32 + 8 * fq, v0, v1); } }
    }
};
struct FRw1 { bf16_t* L1; bf16_t* RR; bf16_t* RK; bf16_t* RV;
    __device__ __forceinline__ void operator()(f32x4 v0, f32x4 v1, const GUnit& u, int trow, int tcol) const {
        const int row = u.pm * 256 + trow;
        if (u.aux == 0) { const int col = u.pn * 256 + tcol;
            if (col < 128) {
#pragma unroll
                for (int j = 0; j < 4; ++j) { v0[j] = 1.0f - 2.0f * __builtin_amdgcn_rcpf(1.0f + __expf(2.0f * v0[j])); v1[j] = 1.0f - 2.0f * __builtin_amdgcn_rcpf(1.0f + __expf(2.0f * v1[j])); } }
            else if (col >= 320) {
#pragma unroll
                for (int j = 0; j < 4; ++j) { v0[j] = sigmoidf_(v0[j]); v1[j] = sigmoidf_(v1[j]); } }
            st8(L1 + (size_t)row * 512 + col, v0, v1); }
        else { bf16_t* o = u.aux == 1 ? RR : (u.aux == 2 ? RK : RV); st8(o + (size_t)row * 1024 + u.pn * 256 + tcol, v0, v1); } } };
struct FRw2 { bf16_t* base; bf16_t* vl; const float* w0; const float* a0;
    __device__ __forceinline__ void operator()(f32x4 v0, f32x4 v1, const GUnit& u, int trow, int tcol) const {
        const int col = u.pn * 256 + tcol;
        const unsigned off = (unsigned)(u.pm * 256 + trow) * 1024u + (unsigned)col + (u.aux < 5 ? (unsigned)u.aux * (unsigned)(R * 1024) : 0u);
        bf16_t* o = (u.aux < 5) ? base : vl;
        if (u.aux < 4) {
            const float* bp = (u.aux < 2 ? w0 : a0) + (u.aux & 1) * 1024 + col; const f32x4 b0 = *(const f32x4*)bp, b1 = *(const f32x4*)(bp + 4);
            const float sc = (u.aux < 2) ? 0.6065306597126334f : 1.0f;
#pragma unroll
            for (int j = 0; j < 4; ++j) { v0[j] = sc * sigmoidf_(b0[j] + v0[j]); v1[j] = sc * sigmoidf_(b1[j] + v1[j]); } }
        st8(o + off, v0, v1); } };
struct EpiSwiGLU {
    static constexpr bool PERM = true;
    bf16_t* O; int ldc;
    __device__ __forceinline__ void operator()(const Acc& acc, const GUnit& u, int wr, int wc, int fr, int fq) const {
#pragma unroll
        for (int ai = 0; ai < 2; ++ai)
#pragma unroll
            for (int m = 0; m < 4; ++m) { const int trow = ai * 128 + wr * 64 + m * 16 + fr; f32x4 h0, h1;
#pragma unroll
                for (int j = 0; j < 4; ++j) { const float g0 = acc[ai][0][m][0][j], g1 = acc[ai][0][m][1][j];
                    h0[j] = g0 * sigmoidf_(g0) * acc[ai][1][m][0][j]; h1[j] = g1 * sigmoidf_(g1) * acc[ai][1][m][1][j]; }
                st8(O + (size_t)(u.pm * 256 + trow) * ldc + u.pn * 128 + wc * 32 + 8 * fq, h0, h1); }
    }
};
struct EpiResid {
    static constexpr bool PERM = false;
    float* cs; float* out; const float* mods; int layer, which;
    const float* scs; const float* sout;
    __device__ __forceinline__ void operator()(const Acc& acc, const GUnit& u, int wr, int wc, int fr, int fq) const {
        const int b = u.pm / 17, isctx = (u.pm % 17 == 0);
        float* xp = isctx ? cs + (size_t)b * CTX * D : out + (size_t)(b * SEQ + (u.pm % 17 - 1) * 256) * D;
        const float* sp = isctx ? scs + (size_t)b * CTX * D : sout + (size_t)(b * SEQ + (u.pm % 17 - 1) * 256) * D;
        const float* gp = mods + ((size_t)(layer * 9 + (isctx ? 8 : b)) * 6 + which) * 1024;
        const int col0 = u.pn * 256 + wc * 32 + 4 * fq;
        f32x4 gv[2][2];
#pragma unroll
        for (int bj = 0; bj < 2; ++bj)
#pragma unroll
            for (int n = 0; n < 2; ++n) gv[bj][n] = *(const f32x4*)(gp + col0 + bj * 128 + n * 16);
#pragma unroll
        for (int ai = 0; ai < 2; ++ai)
#pragma unroll
            for (int mh = 0; mh < 2; ++mh) {
                f32x4 xv[2][2][2];
#pragma unroll
                for (int mm = 0; mm < 2; ++mm) { const float* srow = sp + (size_t)(ai * 128 + wr * 64 + (mh * 2 + mm) * 16 + fr) * D + col0;
#pragma unroll
                    for (int bj = 0; bj < 2; ++bj)
#pragma unroll
                        for (int n = 0; n < 2; ++n) xv[mm][bj][n] = *(const f32x4*)(srow + bj * 128 + n * 16); }
#pragma unroll
                for (int mm = 0; mm < 2; ++mm) { float* rowp = xp + (size_t)(ai * 128 + wr * 64 + (mh * 2 + mm) * 16 + fr) * D + col0;
#pragma unroll
                    for (int bj = 0; bj < 2; ++bj)
#pragma unroll
                        for (int n = 0; n < 2; ++n) *(f32x4*)(rowp + bj * 128 + n * 16) = xv[mm][bj][n] + gv[bj][n] * acc[ai][bj][mh * 2 + mm][n]; }
                asm volatile("" ::: "memory"); }
    }
};

struct MapSimple {
    const char* A; const char* B; size_t sa, sb; int nN, nt, lat;
    __device__ __forceinline__ bool operator()(int L, GUnit& u) const { const int nM = lat ? 128 : NPAN; if (L >= nM * nN) return false; int q; pg8::tile_order(L, nM, nN, q, u.pn);
        u.pm = lat ? (q / 16) * 17 + 1 + (q % 16) : q;
        u.A = A + (size_t)u.pm * sa; u.B = B + (size_t)u.pn * sb; u.nt = nt; u.aux = 0; return true; }
};
struct MapQKV {
    const char* QKVA; const char* QB; const char* KVB;
    __device__ __forceinline__ bool operator()(int L, GUnit& u) const { if (L >= NPAN * 14) return false; int pn; pg8::tile_order(L, NPAN, 14, u.pm, pn);
        const char* ap = QKVA + (size_t)u.pm * 256 * 768 * 2;
        if (pn < 6) { u.A = ap; u.B = QB + (size_t)pn * 256 * 384 * 2; u.nt = 6; u.pn = pn; u.aux = 0; }
        else { u.A = ap + 384 * 2; u.B = KVB + (size_t)(pn - 6) * 256 * 384 * 2; u.nt = 4; u.pn = pn - 6; u.aux = 1; }
        return true; }
};
struct MapRw1 {
    const char* AX; const char* B1; const char* B2; const char* L1;
    __device__ __forceinline__ bool operator()(int L, GUnit& u) const { if (L >= NPAN * 14) return false; int pn; pg8::tile_order(L, NPAN, 14, u.pm, pn);
        const char* ap = AX + (size_t)u.pm * 256 * 5120 * 2;
        if (pn < 2) { u.A = ap; u.B = L1 + (size_t)pn * 256 * 2048 * 2; u.nt = 32; u.pn = pn; u.aux = 0; }
        else if (pn < 6) { u.A = ap + 2048 * 2; u.B = B1 + (size_t)(pn - 2) * 256 * 2048 * 2; u.nt = 16; u.pn = pn - 2; u.aux = 1; }
        else if (pn < 10) { u.A = ap + 3072 * 2; u.B = B1 + (size_t)(pn - 6) * 256 * 2048 * 2 + 1024 * 2; u.nt = 16; u.pn = pn - 6; u.aux = 2; }
        else { u.A = ap + 4096 * 2; u.B = B2 + (size_t)(pn - 10) * 256 * 2048 * 2; u.nt = 16; u.pn = pn - 10; u.aux = 3; }
        return true; }
};
struct MapRw2 {
    const char* L1; const char* L2A; const char* L2B; int pn0, nN, nt;
    __device__ __forceinline__ bool operator()(int L, GUnit& u) const { if (L >= NPAN * nN) return false; int pn; pg8::tile_order(L, NPAN, nN, u.pm, pn); pn += pn0;
        const char* ap = L1 + (size_t)u.pm * 256 * 512 * 2; u.nt = nt; u.pn = pn & 3; u.aux = pn >> 2;
        if (pn < 16) { u.A = ap; u.B = L2A + (size_t)pn * 256 * 256 * 2; }
        else { u.A = ap + 256 * 2; u.B = L2B + (size_t)(pn - 16) * 256 * 256 * 2; }
        return true; }
};
struct MapMoe {
    const char* A; const char* B; size_t sa, sbe, sb; int nN, nt; const int* base;
    __device__ __forceinline__ bool operator()(int L, GUnit& u) const { const int nM = base[8] >> 8; if (L >= nM * nN) return false; pg8::tile_order(L, nM, nN, u.pm, u.pn);
        int e = 0;
#pragma unroll
        for (int j = 1; j < 8; ++j) e += (u.pm * 256 >= base[j]) ? 1 : 0;
        u.A = A + (size_t)u.pm * sa; u.B = B + (size_t)e * sbe + (size_t)u.pn * sb; u.nt = nt; u.aux = e; return true; }
};

struct Job { const float* src; const float* kscale; bf16_t* dst; int sld, srcK, srcN, ldd, Nd, Kd, koff, grp, gstride, tn, tile0, pad; };
constexpr int MAXJOB = 96;
#define NOGRP (1 << 30)
struct JobList { LAS Job* jobs; int n, tiles, z; };
__device__ __forceinline__ void addjob(JobList& L, const float* src, int sld, int srcK, int srcN, const float* kscale, bf16_t* dst, int ldd, int Nd, int Kd, int koff, int grp, int gstride) {
    LAS Job* j = L.jobs + L.n; j->src = src; j->kscale = kscale; j->dst = dst; j->sld = sld + L.z; j->srcK = srcK + L.z; j->srcN = srcN + L.z; j->ldd = ldd + L.z; j->Nd = Nd + L.z; j->Kd = Kd + L.z; j->koff = koff + L.z; j->grp = grp + L.z; j->gstride = gstride + L.z;
    const int tn = ((Nd + 63) >> 6) + L.z; j->tn = tn; j->tile0 = L.tiles; L.tiles += tn * (Kd >> 6); L.n += 1;
}
__device__ __forceinline__ bf16_t* wmla(const Args& a, int j) { return (bf16_t*)(a.ws + WS_WMLA) + (size_t)j * E_MLA; }
__device__ __forceinline__ bf16_t* wrwkv(const Args& a, int j) { return (bf16_t*)(a.ws + WS_WRWKV) + (size_t)j * E_RWKV; }
__device__ __forceinline__ bf16_t* wffn(const Args& a, int j) { return (bf16_t*)(a.ws + WS_WFFN) + (size_t)j * E_FFN; }
__device__ __forceinline__ void jobs_small(const Args& a, JobList& L) {
#pragma unroll 1
    for (int j = 0; j < 2; ++j) {
        {
            bf16_t* w = wmla(a, j); bf16_t* qkva = w; bf16_t* qb = w + E_QKVA; bf16_t* kvb = qb + E_QB; bf16_t* wo = kvb + E_KVB;
            addjob(L, a.in[I_WQA] + (size_t)j * D * QL, QL, D, QL, nullptr, qkva, 1024, 384, 1024, 0, NOGRP, 0);
            addjob(L, a.in[I_WKVA] + (size_t)j * D * 320, 320, D, 320, nullptr, qkva + (size_t)384 * 1024, 1024, 384, 1024, 0, NOGRP, 0);
            addjob(L, a.in[I_WQB] + (size_t)j * QL * 1536, 1536, QL, 1536, a.in[I_QAN] + j * QL, qb, 384, 1536, 384, 0, NOGRP, 0);
            addjob(L, a.in[I_WKVB] + (size_t)j * KVL * 2048, 2048, KVL, 2048, a.in[I_KVAN] + j * KVL, kvb, 384, 2048, 256, 0, NOGRP, 0);
            addjob(L, a.in[I_MWO] + (size_t)j * D * D, D, D, D, nullptr, wo, 1024, 1024, 1024, 0, NOGRP, 0);
        }
        {
            bf16_t* w = wrwkv(a, j); bf16_t* b1 = w; bf16_t* b2 = b1 + E_B1; bf16_t* l1 = b2 + E_B2; bf16_t* l2a = l1 + E_L1; bf16_t* l2b = l2a + E_L2A;
            const float* mix = a.in[I_MIX] + (size_t)j * 6 * D;
            addjob(L, a.in[I_WR] + (size_t)j * D * D, D, D, D, nullptr, b1, 2048, 1024, 1024, 0, NOGRP, 0);
            addjob(L, a.in[I_WK] + (size_t)j * D * D, D, D, D, nullptr, b1 + 1024, 2048, 1024, 1024, 0, NOGRP, 0);
            addjob(L, a.in[I_WV] + (size_t)j * D * D, D, D, D, nullptr, b2, 2048, 1024, 1024, 0, NOGRP, 0);
            addjob(L, a.in[I_RWO] + (size_t)j * D * D, D, D, D, nullptr, b2 + 1024, 2048, 1024, 1024, 0, NOGRP, 0);
            for (int d = 0; d < 2; ++d) {
                const float* w1 = a.in[I_W1] + (size_t)(j * 2 + d) * D * 64; const float* a1 = a.in[I_A1] + (size_t)(j * 2 + d) * D * 64;
                addjob(L, w1, 64, D, 64, nullptr, l1 + (size_t)(d * 64) * 2048, 2048, 64, 1024, 0, NOGRP, 0);
                addjob(L, w1, 64, D, 64, mix + 1 * D, l1 + (size_t)(d * 64) * 2048 + 1024, 2048, 64, 1024, 0, NOGRP, 0);
                addjob(L, a1, 64, D, 64, nullptr, l1 + (size_t)(128 + d * 64) * 2048, 2048, 64, 1024, 0, NOGRP, 0);
                addjob(L, a1, 64, D, 64, mix + 4 * D, l1 + (size_t)(128 + d * 64) * 2048 + 1024, 2048, 64, 1024, 0, NOGRP, 0);
            }
            const float* v1 = (j == 1) ? a.in[I_V1] : nullptr;
            addjob(L, v1, 32, D, 32, nullptr, l1 + (size_t)256 * 2048, 2048, 64, 1024, 0, NOGRP, 0);
            addjob(L, v1, 32, D, 32, mix + 3 * D, l1 + (size_t)256 * 2048 + 1024, 2048, 64, 1024, 0, NOGRP, 0);
            addjob(L, a.in[I_G1] + (size_t)j * D * 160, 160, D, 160, nullptr, l1 + (size_t)320 * 2048, 2048, 192, 1024, 0, NOGRP, 0);
            addjob(L, a.in[I_G1] + (size_t)j * D * 160, 160, D, 160, mix + 5 * D, l1 + (size_t)320 * 2048 + 1024, 2048, 192, 1024, 0, NOGRP, 0);
            for (int d = 0; d < 2; ++d) {
                addjob(L, a.in[I_W2] + (size_t)(j * 2 + d) * 64 * D, D, 64, D, nullptr, l2a + (size_t)(d * 1024) * 256, 256, 1024, 256, d * 64, NOGRP, 0);
                addjob(L, a.in[I_A2] + (size_t)(j * 2 + d) * 64 * D, D, 64, D, nullptr, l2a + (size_t)(2048 + d * 1024) * 256, 256, 1024, 256, 128 + d * 64, NOGRP, 0);
            }
            addjob(L, a.in[I_G2] + (size_t)j * 160 * D, D, 160, D, nullptr, l2b, 256, 1024, 256, 64, NOGRP, 0);
            addjob(L, (j == 1) ? a.in[I_V2] : nullptr, D, 32, D, nullptr, l2b + (size_t)1024 * 256, 256, 1024, 256, 0, NOGRP, 0);
        }
        {
            bf16_t* w = wffn(a, j);
            addjob(L, a.in[I_F1] + (size_t)j * D * DFF, DFF, D, DFF, nullptr, w, 1024, DFF, 1024, 0, 128, 256);
            addjob(L, a.in[I_F3] + (size_t)j * D * DFF, DFF, D, DFF, nullptr, w + (size_t)128 * 1024, 1024, DFF, 1024, 0, 128, 256);
            addjob(L, a.in[I_F2] + (size_t)j * DFF * D, D, DFF, D, nullptr, w + E_F13, DFF, 1024, DFF, 0, NOGRP, 0);
        }
    }
}
__device__ __forceinline__ void jobs_moe(const Args& a, JobList& L, int k) {
    bf16_t* w13 = (bf16_t*)(a.ws + WS_ARENA + A_WM13); bf16_t* w2 = (bf16_t*)(a.ws + WS_ARENA + A_WM2);
#pragma unroll 1
    for (int e = 0; e < NE; ++e) {
        const size_t so = (size_t)(k * NE + e) * D * DFE;
        addjob(L, a.in[I_M1] + so, DFE, D, DFE, nullptr, w13 + (size_t)e * E_M13, 1024, DFE, 1024, 0, 128, 256);
        addjob(L, a.in[I_M3] + so, DFE, D, DFE, nullptr, w13 + (size_t)e * E_M13 + (size_t)128 * 1024, 1024, DFE, 1024, 0, 128, 256);
        addjob(L, a.in[I_M2] + so, D, DFE, D, nullptr, w2 + (size_t)e * E_M2, DFE, 1024, DFE, 0, NOGRP, 0);
    }
}
__device__ __forceinline__ void run_prep(const Args& a, LAS unsigned char* jl, int which  , int j0  , int G, int c) {
    const int tid = ltid();
    LAS Job* jobs = (LAS Job*)jl; LAS int* hdr = (LAS int*)(jl + MAXJOB * sizeof(Job)); LAS float* tile = (LAS float*)(jl + MAXJOB * sizeof(Job) + 64);
    if (tid == 0) { JobList L{jobs, 0, 0, launder_s(0)}; if (which < 0) jobs_small(a, L); else jobs_moe(a, L, which); hdr[0] = L.n + L.z; hdr[1] = L.tiles + L.z; }
    __syncthreads();
    const int nj = hdr[0], ntile = hdr[1];
    const int kl = tid >> 4, nq = (tid & 15) * 4, sn = tid >> 3, sk = (tid & 7) * 8;
    int jcur = 0;
#define PREP_BAR() do { asm volatile("s_waitcnt lgkmcnt(0)" ::: "memory"); __builtin_amdgcn_s_barrier(); asm volatile("" ::: "memory"); } while (0)
    f32x4 vcur[2], vnxt[2];
#define PREP_FETCH(t_, dstv) do { while (jcur + 1 < nj && jobs[jcur + 1].tile0 <= (t_)) ++jcur; const LAS Job* J_ = jobs + jcur; \
        const float* src_ = J_->src; const float* ks_ = J_->kscale; const int sld_ = J_->sld, srcK_ = J_->srcK, srcN_ = J_->srcN, koff_ = J_->koff, tn_ = J_->tn, tl_ = (t_) - J_->tile0; \
        const int n0_ = (tl_ % tn_) * 64, k0_ = (tl_ / tn_) * 64; \
        _Pragma("unroll") for (int p = 0; p < 2; ++p) { const int kk = k0_ + kl + 32 * p, ksi = kk - koff_, n = n0_ + nq; f32x4 v = (f32x4){0.f, 0.f, 0.f, 0.f}; \
            if (src_ != nullptr && ksi >= 0 && ksi < srcK_ && n < srcN_) { v = *(const __attribute__((address_space(1))) f32x4*)(src_ + (size_t)ksi * sld_ + n); if (ks_) v = v * *(const __attribute__((address_space(1))) float*)(ks_ + ksi); } dstv[p] = v; } } while (0)
    int t = c + j0 * G;
    if (t < ntile) PREP_FETCH(t, vcur);
    for (; t < ntile; t += G) {
        const int jthis = jcur;
        if (t + G < ntile) PREP_FETCH(t + G, vnxt);
        const LAS Job* J = jobs + jthis;
        bf16_t* __restrict__ dst = J->dst;
        const int ldd = J->ldd, Nd = J->Nd, grp = J->grp, gstride = J->gstride, tn = J->tn, tl = t - J->tile0;
        const int n0 = (tl % tn) * 64, k0 = (tl / tn) * 64;
#pragma unroll
        for (int p = 0; p < 2; ++p) { LAS float* tp = tile + (kl + 32 * p) * 65 + nq; tp[0] = vcur[p][0]; tp[1] = vcur[p][1]; tp[2] = vcur[p][2]; tp[3] = vcur[p][3]; }
        PREP_BAR();
        { const int n = n0 + sn;
            if (n < Nd) { float f[8];
#pragma unroll
                for (int e = 0; e < 8; ++e) f[e] = tile[(sk + e) * 65 + sn];
                const int dr = (n / grp) * gstride + (n % grp);
                *(__attribute__((address_space(1))) u32x4*)(dst + (size_t)dr * ldd + k0 + sk) = pack8(f); } }
        PREP_BAR();
        vcur[0] = vnxt[0]; vcur[1] = vnxt[1];
    }
#undef PREP_FETCH
#undef PREP_BAR
    asm volatile("s_waitcnt vmcnt(0)" ::: "memory"); __syncthreads();
}

__device__ __forceinline__ void prologue_misc(const Args& a, LAS unsigned char* lds, int G, int c) {
    const int tid = ltid();
    if (c == 0) { float* rt = (float*)(a.ws + WS_ROPE);
      for (int i = tid; i < 1024; i += NTHR) { const int pos = i >> 4, j = i & 15; const double inv = 1.0 / pow(10000.0, (double)j / 16.0), ang = (double)pos * inv; rt[i] = (float)cos(ang); rt[1024 + i] = (float)sin(ang); } }
    LAS float* sc = (LAS float*)lds;
    LAS float* red = (LAS float*)(lds + 49152);
    for (int i = tid; i < 1024 * 12; i += NTHR) { const int k = i / 12, m = i % 12; float v = 0.f;
        if (m < 9) { const float x = (m < 8) ? a.in[I_C][m * D + k] : a.in[I_CCTX][k]; v = x / (1.0f + expf(-x)); } sc[i] = v; }
    __syncthreads();
    const int kq = tid >> 6, col = tid & 63;
    for (int u = c; u < 4 * 96; u += G) {
        const int layer = u / 96, n0 = (u % 96) * 64;
        const float* w = a.in[I_ADAW] + (size_t)layer * D * 6144 + n0 + col;
        float acc[9];
#pragma unroll
        for (int m = 0; m < 9; ++m) acc[m] = 0.f;
        for (int k8 = 0; k8 < 128; k8 += 8) {
            float wv[8];
#pragma unroll
            for (int e = 0; e < 8; ++e) wv[e] = w[(size_t)(kq * 128 + k8 + e) * 6144];
#pragma unroll
            for (int e = 0; e < 8; ++e) { const LAS f32x4* sp = (const LAS f32x4*)(sc + (kq * 128 + k8 + e) * 12); const f32x4 s0 = sp[0], s1 = sp[1], s2 = sp[2];
                acc[0] += s0[0] * wv[e]; acc[1] += s0[1] * wv[e]; acc[2] += s0[2] * wv[e]; acc[3] += s0[3] * wv[e];
                acc[4] += s1[0] * wv[e]; acc[5] += s1[1] * wv[e]; acc[6] += s1[2] * wv[e]; acc[7] += s1[3] * wv[e]; acc[8] += s2[0] * wv[e]; }
        }
#pragma unroll
        for (int m = 0; m < 9; ++m) red[(kq * 9 + m) * 64 + col] = acc[m];
        __syncthreads();
        for (int i = tid; i < 9 * 64; i += NTHR) { const int m = i >> 6, cc = i & 63; float s = 0.f;
#pragma unroll
            for (int q = 0; q < 8; ++q) s += red[(q * 9 + m) * 64 + cc];
            ((float*)(a.ws + WS_MODS))[(size_t)(layer * 9 + m) * 6144 + n0 + cc] = s + a.in[I_ADAB][layer * 6144 + n0 + cc]; }
        __syncthreads();
    }
}

struct RowParams { float A[16], Bv[16]; int mi; };
__device__ __forceinline__ void load_params(const Args& a, RowParams& P, int layer, int mi, const float* gain, int which, int lane) {
    const float* sh = mods_ptr(a, layer, mi, which); const float* scl = mods_ptr(a, layer, mi, which + 1);
#pragma unroll
    for (int j = 0; j < 2; ++j) { const int col = j * 512 + lane * 8;
#pragma unroll
        for (int q = 0; q < 2; ++q) { const f32x4 g = *(const f32x4*)(gain + col + 4 * q), s = *(const f32x4*)(scl + col + 4 * q), t = *(const f32x4*)(sh + col + 4 * q);
#pragma unroll
            for (int e = 0; e < 4; ++e) { P.A[j * 8 + q * 4 + e] = g[e] * (1.0f + s[e]); P.Bv[j * 8 + q * 4 + e] = t[e]; } } }
    P.mi = mi;
}
__device__ __forceinline__ void load_x16(const float* xp, int lane, float (&x)[16]) {
#pragma unroll
    for (int j = 0; j < 2; ++j)
#pragma unroll
        for (int q = 0; q < 2; ++q) { const f32x4 v = *(const f32x4*)(xp + j * 512 + lane * 8 + 4 * q); x[j * 8 + q * 4 + 0] = v[0]; x[j * 8 + q * 4 + 1] = v[1]; x[j * 8 + q * 4 + 2] = v[2]; x[j * 8 + q * 4 + 3] = v[3]; }
}
__device__ __forceinline__ void store_bf16_row(bf16_t* p, int lane, const float (&h)[16]) {
#pragma unroll
    for (int j = 0; j < 2; ++j) { u32x4 w; w.x = cvt_pk_bf16(h[j * 8 + 0], h[j * 8 + 1]); w.y = cvt_pk_bf16(h[j * 8 + 2], h[j * 8 + 3]); w.z = cvt_pk_bf16(h[j * 8 + 4], h[j * 8 + 5]); w.w = cvt_pk_bf16(h[j * 8 + 6], h[j * 8 + 7]);
        *(u32x4*)(p + j * 512 + lane * 8) = w; }
}
__device__ __forceinline__ void moe_combine16(const Args& a, int row, int layer_prev, int lane, float (&x)[16]) {
    const u32x4 rt = *(const u32x4*)(a.ws + WS_ROUTE + (size_t)row * 16);
    const int e0 = (int)rt[0];
    if (e0 < 0) return;
    const float p0 = __uint_as_float(rt[2]), p1 = __uint_as_float(rt[3]);
    const int* sl = (const int*)(a.ws + WS_RSLOT) + (size_t)row * 2; const int s0 = sl[0], s1 = sl[1];
    const bf16_t* y2 = (const bf16_t*)(a.ws + WS_ARENA + A_Y2);
    const float* g5 = mods_ptr(a, layer_prev, mod_index(row), 5);
#pragma unroll
    for (int j = 0; j < 2; ++j) { const int col = j * 512 + lane * 8; float ya[8], yb[8];
        unpack8(*(const u32x4*)(y2 + (size_t)s0 * 1024 + col), ya); unpack8(*(const u32x4*)(y2 + (size_t)s1 * 1024 + col), yb);
        const f32x4 g0 = *(const f32x4*)(g5 + col), g1 = *(const f32x4*)(g5 + col + 4);
#pragma unroll
        for (int e = 0; e < 8; ++e) x[j * 8 + e] += (e < 4 ? g0[e] : g1[e - 4]) * (p0 * ya[e] + p1 * yb[e]); }
}
__device__ __forceinline__ void store_x16(float* xp, int lane, const float (&x)[16]) {
#pragma unroll
    for (int j = 0; j < 2; ++j)
#pragma unroll
        for (int q = 0; q < 2; ++q) *(f32x4*)(xp + j * 512 + lane * 8 + 4 * q) = (f32x4){x[j * 8 + q * 4], x[j * 8 + q * 4 + 1], x[j * 8 + q * 4 + 2], x[j * 8 + q * 4 + 3]};
}
__device__ __forceinline__ void norm_row(const float (&x)[16], const RowParams& P, float (&h)[16]) {
    float ss = 0.f;
#pragma unroll
    for (int e = 0; e < 16; ++e) ss += x[e] * x[e];
    ss = wave_sum(ss);
    const float rstd = 1.0f / sqrtf(ss * (1.0f / 1024.0f) + NORM_EPS);
#pragma unroll
    for (int e = 0; e < 16; ++e) h[e] = x[e] * rstd * P.A[e] + P.Bv[e];
}
__device__ __forceinline__ void wave_rows(int G, int c, int& r0, int& r1) {
    const int nw = G * NWAVE, per = (R + nw - 1) / nw, gw = c * NWAVE + (ltid() >> 6);
    r0 = gw * per; r1 = r0 + per; if (r0 > R) r0 = R; if (r1 > R) r1 = R;
}
template <bool COMBINE, bool FIRST = false>
__device__ __forceinline__ void norm_plain(const Args& a, int layer, const float* gain, int which, bf16_t* Hout, int G, int c) {
    const int lane = ltid() & 63; int r0, r1; wave_rows(G, c, r0, r1);
    RowParams P; P.mi = -1;
    for (int row = r0; row < r1; ++row) {
        const int mi = mod_index(row); if (mi != P.mi) load_params(a, P, layer, mi, gain, which, lane);
        float* xp = xrow(a, row); float x[16], h[16]; load_x16(FIRST ? xrow_in(a, row) : xp, lane, x);
        if (COMBINE) { moe_combine16(a, row, layer - 1, lane, x); store_x16(xp, lane, x); }
        norm_row(x, P, h); store_bf16_row(Hout + (size_t)row * 1024, lane, h);
    }
}
__device__ __forceinline__ bool seg_first(int row) { const int r = row % SEG; return r == 0 || r == CTX; }
__device__ __forceinline__ bool seg_last(int row) { const int r = row % SEG; return r == CTX - 1 || r == SEG - 1; }
__device__ __forceinline__ void norm_mix(const Args& a, int layer, int j, int G, int c) {
    const int lane = ltid() & 63; int r0, r1; wave_rows(G, c, r0, r1); if (r0 >= r1) return;
    const float* gain = a.in[I_N1G] + layer * D; const float* mix = a.in[I_MIX] + (size_t)j * 6 * D;
    bf16_t* AX = (bf16_t*)(a.ws + WS_ARENA + A_AX);
    float mr[16], mk[16], mv[16];
#pragma unroll
    for (int jj = 0; jj < 2; ++jj)
#pragma unroll
        for (int e = 0; e < 8; ++e) { const int col = jj * 512 + lane * 8 + e; mr[jj * 8 + e] = mix[col]; mk[jj * 8 + e] = mix[2 * D + col]; mv[jj * 8 + e] = mix[3 * D + col]; }
    RowParams P; P.mi = -1;
    float hp[16], hc[16], hn[16], x[16];
    if (!seg_first(r0)) { const int mi = mod_index(r0 - 1); if (mi != P.mi) load_params(a, P, layer, mi, gain, 0, lane); load_x16(xrow(a, r0 - 1), lane, x); norm_row(x, P, hp); }
    else {
#pragma unroll
        for (int e = 0; e < 16; ++e) hp[e] = 0.f; }
    { const int mi = mod_index(r0); if (mi != P.mi) load_params(a, P, layer, mi, gain, 0, lane); load_x16(xrow(a, r0), lane, x); norm_row(x, P, hc); }
    for (int row = r0; row < r1; ++row) {
        if (row + 1 < R) { const int mi = mod_index(row + 1); if (mi != P.mi) load_params(a, P, layer, mi, gain, 0, lane); load_x16(xrow(a, row + 1), lane, x); norm_row(x, P, hn); }
        else {
#pragma unroll
            for (int e = 0; e < 16; ++e) hn[e] = 0.f; }
        const float fp = seg_first(row) ? 0.f : 0.5f, fn = seg_last(row) ? 0.f : 0.5f;
        float xx[16], t[16];
#pragma unroll
        for (int e = 0; e < 16; ++e) xx[e] = fp * hp[e] + fn * hn[e] - hc[e];
        bf16_t* o = AX + (size_t)row * 5120;
        store_bf16_row(o, lane, hc); store_bf16_row(o + 1024, lane, xx);
#pragma unroll
        for (int e = 0; e < 16; ++e) t[e] = hc[e] + xx[e] * mr[e];
        store_bf16_row(o + 2048, lane, t);
#pragma unroll
        for (int e = 0; e < 16; ++e) t[e] = hc[e] + xx[e] * mk[e];
        store_bf16_row(o + 3072, lane, t);
#pragma unroll
        for (int e = 0; e < 16; ++e) t[e] = hc[e] + xx[e] * mv[e];
        store_bf16_row(o + 4096, lane, t);
#pragma unroll
        for (int e = 0; e < 16; ++e) { hp[e] = hc[e]; hc[e] = hn[e]; }
    }
}
__device__ __forceinline__ void norm_router(const Args& a, int layer, int k, bool last, LAS unsigned char* lds, int G, int c) {
    const int tid = ltid(), lane = tid & 63; int r0, r1; wave_rows(G, c, r0, r1);
    LAS float* rw = (LAS float*)lds;
    { const float* rsrc = a.in[I_ROUTER] + (size_t)k * D * NE; for (int i = tid; i < D * NE; i += NTHR) rw[i] = rsrc[i]; }
    __syncthreads();
    const float* gain = a.in[I_N2G] + layer * D;
    bf16_t* Hout = (bf16_t*)(a.ws + WS_ARENA + A_H);
    RowParams P; P.mi = -1;
    int hist[8];
#pragma unroll
    for (int e = 0; e < 8; ++e) hist[e] = 0;
    for (int row = r0; row < r1; ++row) {
        const int mi = mod_index(row); if (mi != P.mi) load_params(a, P, layer, mi, gain, 3, lane);
        float x[16], h[16]; load_x16(xrow(a, row), lane, x); norm_row(x, P, h); store_bf16_row(Hout + (size_t)row * 1024, lane, h);
        const bool routed = !(last && mi == 8);
        float lg[8];
#pragma unroll
        for (int e = 0; e < 8; ++e) lg[e] = 0.f;
#pragma unroll
        for (int jj = 0; jj < 2; ++jj)
#pragma unroll
            for (int q = 0; q < 8; ++q) { const LAS f32x4* rp = (const LAS f32x4*)(rw + (jj * 512 + lane * 8 + q) * 8); const f32x4 w0 = rp[0], w1 = rp[1]; const float hv = h[jj * 8 + q];
                lg[0] += hv * w0[0]; lg[1] += hv * w0[1]; lg[2] += hv * w0[2]; lg[3] += hv * w0[3]; lg[4] += hv * w1[0]; lg[5] += hv * w1[1]; lg[6] += hv * w1[2]; lg[7] += hv * w1[3]; }
#pragma unroll
        for (int e = 0; e < 8; ++e) lg[e] = wave_sum(lg[e]);
        int e0 = 0; float v0 = lg[0];
#pragma unroll
        for (int e = 1; e < 8; ++e) if (lg[e] > v0) { v0 = lg[e]; e0 = e; }
        int e1 = -1; float v1 = -3.0e38f;
#pragma unroll
        for (int e = 0; e < 8; ++e) if (e != e0 && lg[e] > v1) { v1 = lg[e]; e1 = e; }
        const float p0 = 1.0f / (1.0f + expf(v1 - v0)), p1 = 1.0f - p0;
        if (routed) {
#pragma unroll
            for (int e = 0; e < 8; ++e) hist[e] += (e == e0 || e == e1) ? 1 : 0; }
        if (lane == 0) *(u32x4*)(a.ws + WS_ROUTE + (size_t)row * 16) = (u32x4){(unsigned)(routed ? e0 : -1), (unsigned)(routed ? e1 : -1), __float_as_uint(p0), __float_as_uint(p1)};
    }
    const int gw = c * NWAVE + (tid >> 6);
    if (lane == 0) { int* hp = (int*)(a.ws + WS_HIST) + (size_t)gw * 8;
#pragma unroll
        for (int e = 0; e < 8; ++e) hp[e] = hist[e]; }
}

__device__ __forceinline__ void mla_stats(const Args& a, int G, int c) {
    const int lane = ltid() & 63; int r0, r1; wave_rows(G, c, r0, r1);
    const bf16_t* QKVA = (const bf16_t*)(a.ws + WS_ARENA + A_QKVA); float* rs = (float*)(a.ws + WS_RS);
    for (int row = r0; row < r1; ++row) {
        float sq = 0.f, skv = 0.f; float f[8];
        if (lane < 48) { unpack8(*(const u32x4*)(QKVA + (size_t)row * 768 + lane * 8), f);
#pragma unroll
            for (int e = 0; e < 8; ++e) sq += f[e] * f[e]; }
        if (lane < 32) { unpack8(*(const u32x4*)(QKVA + (size_t)row * 768 + 384 + lane * 8), f);
#pragma unroll
            for (int e = 0; e < 8; ++e) skv += f[e] * f[e]; }
        sq = wave_sum(sq); skv = wave_sum(skv);
        if (lane == 0) { rs[row] = 1.0f / sqrtf(sq * (1.0f / 384.0f) + NORM_EPS); rs[R + row] = 1.0f / sqrtf(skv * (1.0f / 256.0f) + NORM_EPS); }
    }
}
__device__ __forceinline__ void mla_qkpost(const Args& a, int j, int G, int c) {
    const int lane = ltid() & 63, hd = lane >> 3, sub = lane & 7; int r0, r1; wave_rows(G, c, r0, r1);
    bf16_t* Q = (bf16_t*)(a.ws + WS_ARENA + A_Q); const bf16_t* KV = (const bf16_t*)(a.ws + WS_ARENA + A_KV); const bf16_t* QKVA = (const bf16_t*)(a.ws + WS_ARENA + A_QKVA);
    bf16_t* K = (bf16_t*)(a.ws + WS_ARENA + A_K); const float* rt = (const float*)(a.ws + WS_ROPE);
    float gq[3][8], gk[3][8];
#pragma unroll
    for (int cc = 0; cc < 3; ++cc)
#pragma unroll
        for (int e = 0; e < 8; ++e) { gq[cc][e] = a.in[I_QN][j * QKH + cc * 64 + sub * 8 + e]; gk[cc][e] = a.in[I_KN][j * QKH + cc * 64 + sub * 8 + e]; }
    const float sgn = (sub & 2) ? 1.0f : -1.0f;
    for (int row = r0; row < r1; ++row) {
        const int r = row % SEG; const bool lat = r >= CTX; const int t = r - CTX, pos = (sub & 4) ? (t & 63) : (t >> 6);
        float cs[8], sn[8];
        if (lat) {
#pragma unroll
            for (int q = 0; q < 2; ++q) { const f32x4 cv = *(const f32x4*)(rt + pos * 16 + (sub & 1) * 8 + 4 * q), sv = *(const f32x4*)(rt + 1024 + pos * 16 + (sub & 1) * 8 + 4 * q);
#pragma unroll
                for (int e = 0; e < 4; ++e) { cs[q * 4 + e] = cv[e]; sn[q * 4 + e] = sv[e]; } } }
        float v[3][8];
        bf16_t* qp = Q + (size_t)row * 1536 + hd * QKH + sub * 8;
#pragma unroll
        for (int cc = 0; cc < 3; ++cc) unpack8(*(const u32x4*)(qp + cc * 64), v[cc]);
        { float ss = 0.f;
#pragma unroll
          for (int cc = 0; cc < 3; ++cc)
#pragma unroll
              for (int e = 0; e < 8; ++e) ss += v[cc][e] * v[cc][e];
          ss = red8(ss); const float rstd = 1.0f / sqrtf(ss * (1.0f / 192.0f) + NORM_EPS);
#pragma unroll
          for (int cc = 0; cc < 3; ++cc)
#pragma unroll
              for (int e = 0; e < 8; ++e) v[cc][e] = v[cc][e] * rstd * gq[cc][e];
          if (lat) {
#pragma unroll
              for (int e = 0; e < 8; ++e) { const float pr = __shfl_xor(v[2][e], 2); v[2][e] = v[2][e] * cs[e] + sgn * pr * sn[e]; } }
#pragma unroll
          for (int cc = 0; cc < 3; ++cc) {
#pragma unroll
              for (int e = 0; e < 8; ++e) v[cc][e] *= QSCALE;
              *(u32x4*)(qp + cc * 64) = pack8(v[cc]); } }
        const bf16_t* kp = KV + (size_t)row * 2048 + hd * 256 + sub * 8;
        unpack8(*(const u32x4*)(kp), v[0]); unpack8(*(const u32x4*)(kp + 64), v[1]); unpack8(*(const u32x4*)(QKVA + (size_t)row * 768 + 640 + sub * 8), v[2]);
        { float ss = 0.f;
#pragma unroll
          for (int cc = 0; cc < 3; ++cc)
#pragma unroll
              for (int e = 0; e < 8; ++e) ss += v[cc][e] * v[cc][e];
          ss = red8(ss); const float rstd = 1.0f / sqrtf(ss * (1.0f / 192.0f) + NORM_EPS);
#pragma unroll
          for (int cc = 0; cc < 3; ++cc)
#pragma unroll
              for (int e = 0; e < 8; ++e) v[cc][e] = v[cc][e] * rstd * gk[cc][e];
          if (lat) {
#pragma unroll
              for (int e = 0; e < 8; ++e) { const float pr = __shfl_xor(v[2][e], 2); v[2][e] = v[2][e] * cs[e] + sgn * pr * sn[e]; } }
          bf16_t* ko = K + (size_t)row * 1536 + hd * QKH + sub * 8;
#pragma unroll
          for (int cc = 0; cc < 3; ++cc) *(u32x4*)(ko + cc * 64) = pack8(v[cc]); }
    }
}

namespace att {
constexpr int KVBLK = 64, KROWB = 384;
constexpr int SHM_V = KVBLK * 128 * 2, SHM_K = KVBLK * KROWB;
constexpr int SHM_ATTN = 2 * SHM_V + 2 * SHM_K + NWAVE * 64 * 4;
constexpr float THR = 11.5f;
#define KSWZ(row, colB) ((row) * att::KROWB + ((colB) ^ (((row) & 7) << 4)))
#define SBAR() __builtin_amdgcn_sched_barrier(0)
__device__ __forceinline__ int crow(int r, int hi) { return (r & 3) + 8 * (r >> 2) + 4 * hi; }
__device__ __forceinline__ void partialSM(f32x16& p0, f32x16& p1, float& m_reg, float& mn, float& alpha) {
    float pmax = p0[0];
#pragma unroll
    for (int r = 1; r < 16; ++r) pmax = fmaxf(pmax, p0[r]);
#pragma unroll
    for (int r = 0; r < 16; ++r) pmax = fmaxf(pmax, p1[r]);
    { auto rr = __builtin_amdgcn_permlane32_swap(__float_as_uint(pmax), __float_as_uint(pmax), false, false); pmax = fmaxf(__uint_as_float(rr[0]), __uint_as_float(rr[1])); }
    if (__builtin_expect(__all(pmax - m_reg <= THR), 1)) { mn = m_reg; alpha = 1.f; }
    else { mn = fmaxf(m_reg, pmax); alpha = __builtin_amdgcn_exp2f(m_reg - mn); m_reg = mn; }
#pragma unroll
    for (int r = 0; r < 16; ++r) { p0[r] -= mn; p1[r] -= mn; }
#pragma unroll
    for (int r = 0; r < 16; ++r) p0[r] = __builtin_amdgcn_exp2f(p0[r]);
}
__device__ __forceinline__ void finishSM(f32x16& p0, f32x16& p1, float alpha, float& l_reg, bf16x8& pa0, bf16x8& pa1, bf16x8& pa2, bf16x8& pa3) {
#pragma unroll
    for (int r = 0; r < 16; ++r) p1[r] = __builtin_amdgcn_exp2f(p1[r]);
    float ps = 0;
#pragma unroll
    for (int r = 0; r < 16; ++r) ps += p0[r];
#pragma unroll
    for (int r = 0; r < 16; ++r) ps += p1[r];
    { auto rr = __builtin_amdgcn_permlane32_swap(__float_as_uint(ps), __float_as_uint(ps), false, false); ps = __uint_as_float(rr[0]) + __uint_as_float(rr[1]); }
    l_reg = l_reg * alpha + ps;
#define PK4(P, BASE, OUT) do { unsigned a0 = cvt_pk_bf16(P[BASE + 0], P[BASE + 1]), a1 = cvt_pk_bf16(P[BASE + 2], P[BASE + 3]);   \
    unsigned b0 = cvt_pk_bf16(P[BASE + 4], P[BASE + 5]), b1 = cvt_pk_bf16(P[BASE + 6], P[BASE + 7]);                              \
    auto r0 = __builtin_amdgcn_permlane32_swap(a0, b0, false, false); auto r1 = __builtin_amdgcn_permlane32_swap(a1, b1, false, false); \
    u32x4 w = {r0[0], r1[0], r0[1], r1[1]}; OUT = *reinterpret_cast<bf16x8*>(&w); } while (0)
    PK4(p0, 0, pa0); PK4(p0, 8, pa1); PK4(p1, 0, pa2); PK4(p1, 8, pa3);
#undef PK4
}
__device__ __forceinline__ void qkt(f32x16& p0, f32x16& p1, const char* Ks, const bf16x8* qr, int r32, int hi) {
    p0 = f32x16{}; p1 = f32x16{};
    bf16x8 ka[4], kb[4];
#define QK_LD(buf, g) do { _Pragma("unroll") for (int q_ = 0; q_ < 2; ++q_) { const int cb_ = ((2 * (g) + q_) * 16 + hi * 8) * 2; \
        buf[2 * q_] = *reinterpret_cast<const bf16x8*>(Ks + KSWZ(r32, cb_)); buf[2 * q_ + 1] = *reinterpret_cast<const bf16x8*>(Ks + KSWZ(32 + r32, cb_)); } } while (0)
#define QK_MM(buf, g) do { _Pragma("unroll") for (int q_ = 0; q_ < 2; ++q_) { p0 = __builtin_amdgcn_mfma_f32_32x32x16_bf16(buf[2 * q_], qr[2 * (g) + q_], p0, 0, 0, 0); \
        p1 = __builtin_amdgcn_mfma_f32_32x32x16_bf16(buf[2 * q_ + 1], qr[2 * (g) + q_], p1, 0, 0, 0); } } while (0)
    QK_LD(ka, 0); SBAR();
    QK_LD(kb, 1); SBAR(); QK_MM(ka, 0); SBAR();
    QK_LD(ka, 2); SBAR(); QK_MM(kb, 1); SBAR();
    QK_LD(kb, 3); SBAR(); QK_MM(ka, 2); SBAR();
    QK_LD(ka, 4); SBAR(); QK_MM(kb, 3); SBAR();
    QK_LD(kb, 5); SBAR(); QK_MM(ka, 4); SBAR();
    QK_MM(kb, 5); SBAR();
#undef QK_LD
#undef QK_MM
}
__device__ __forceinline__ int v_st(int k, int c) { const int kk = (k & ~0xC) | ((k & 4) << 1) | ((k & 8) >> 1); return ((kk >> 3) * 4 + (c >> 5)) * 512 + ((kk & 7) * 32 + (c & 31)) * 2; }
__device__ __forceinline__ int v_rd_base(int lane) { return ((lane & 3) << 3) | (((lane >> 2) & 3) << 6) | (((lane >> 4) & 1) << 5) | (((lane >> 5) & 1) << 8); }
constexpr int v_rd_off(int d0, int ks, int half) { return d0 * 512 + ks * 4096 + half * 2048; }
template <int OFF> __device__ __forceinline__ s16x4 tr_read(int vb) { s16x4 r; asm volatile("ds_read_b64_tr_b16 %0, %1 offset:%2" : "=&v"(r) : "v"(vb), "i"(OFF) : "memory"); return r; }
struct VFrag { s16x4 l0, h0, l1, h1, l2, h2, l3, h3; };
template <int D0> __device__ __forceinline__ void pv_issue(VFrag& f, int vb) {
    f.l0 = tr_read<v_rd_off(D0, 0, 0)>(vb); f.h0 = tr_read<v_rd_off(D0, 0, 1)>(vb); f.l1 = tr_read<v_rd_off(D0, 1, 0)>(vb); f.h1 = tr_read<v_rd_off(D0, 1, 1)>(vb);
    f.l2 = tr_read<v_rd_off(D0, 2, 0)>(vb); f.h2 = tr_read<v_rd_off(D0, 2, 1)>(vb); f.l3 = tr_read<v_rd_off(D0, 3, 0)>(vb); f.h3 = tr_read<v_rd_off(D0, 3, 1)>(vb);
}
__device__ __forceinline__ void pv_mma(f32x16& od, const VFrag& f, bf16x8 pa0, bf16x8 pa1, bf16x8 pa2, bf16x8 pa3) {
#define PK(L, H) (bf16x8){L[0], L[1], L[2], L[3], H[0], H[1], H[2], H[3]}
    od = __builtin_amdgcn_mfma_f32_32x32x16_bf16(pa0, PK(f.l0, f.h0), od, 0, 0, 0);
    od = __builtin_amdgcn_mfma_f32_32x32x16_bf16(pa1, PK(f.l1, f.h1), od, 0, 0, 0);
    od = __builtin_amdgcn_mfma_f32_32x32x16_bf16(pa2, PK(f.l2, f.h2), od, 0, 0, 0);
    od = __builtin_amdgcn_mfma_f32_32x32x16_bf16(pa3, PK(f.l3, f.h3), od, 0, 0, 0);
#undef PK
}
__device__ __forceinline__ void pv_d0(f32x16* o, int vb, bf16x8 pa0, bf16x8 pa1, bf16x8 pa2, bf16x8 pa3) {
    VFrag fa, fb;
    pv_issue<0>(fa, vb); pv_issue<1>(fb, vb);
    asm volatile("s_waitcnt lgkmcnt(8)" ::: "memory"); SBAR(); pv_mma(o[0], fa, pa0, pa1, pa2, pa3); SBAR();
    pv_issue<2>(fa, vb);
    asm volatile("s_waitcnt lgkmcnt(8)" ::: "memory"); SBAR(); pv_mma(o[1], fb, pa0, pa1, pa2, pa3); SBAR();
    pv_issue<3>(fb, vb);
    asm volatile("s_waitcnt lgkmcnt(8)" ::: "memory"); SBAR(); pv_mma(o[2], fa, pa0, pa1, pa2, pa3); SBAR();
    asm volatile("s_waitcnt lgkmcnt(0)" ::: "memory"); SBAR(); pv_mma(o[3], fb, pa0, pa1, pa2, pa3);
}
__device__ __forceinline__ void attn_unit(const bf16_t* __restrict__ Qb, const bf16_t* __restrict__ Kh, const bf16_t* __restrict__ Vh, bf16_t* __restrict__ Ob, int seq, char* lds) {
    constexpr int LDQ = 1536, LDK = 1536, LDV = 2048, LDO = 1024;
    const int tid = ltid(), wid = tid >> 6, lane = tid & 63, r32 = lane & 31, hi = lane >> 5;
    char* V_lds = lds; char* K_lds = lds + 2 * SHM_V;
    float* wsp = (float*)(lds + 2 * SHM_V + 2 * SHM_K) + wid * 64; float* li_l = wsp; float* al_l = wsp + 32;
    float m_reg = -1e30f, l_reg = 0; f32x16 o[4] = {}; bf16x8 qr[12];
    const bf16_t* Qw = Qb + (long)(wid * 32 + r32) * LDQ + hi * 8;
#pragma unroll
    for (int d0 = 0; d0 < 12; ++d0) qr[d0] = *(const __attribute__((address_space(1))) bf16x8*)((const __attribute__((address_space(1))) bf16_t*)Qw + d0 * 16);
    const int sr = tid >> 4, sc = (tid & 15) * 8, vst0 = v_st(sr, sc), vst1 = v_st(32 + sr, sc);
    int kkey[3], kcb[3];
#pragma unroll
    for (int i = 0; i < 3; ++i) { const int ci = tid + i * 512; kkey[i] = ci / 24; kcb[i] = (ci % 24) * 16; }
    const int vb0 = (int)(uintptr_t)(LAS char*)V_lds + v_rd_base(lane);
    bf16x8 vs0, vs1, ks0, ks1, ks2;
#define GAS __attribute__((address_space(1)))
#define SLOAD(k0) do { vs0 = *(const GAS bf16x8*)((const GAS bf16_t*)Vh + (long)((k0) + sr) * LDV + sc); vs1 = *(const GAS bf16x8*)((const GAS bf16_t*)Vh + (long)((k0) + 32 + sr) * LDV + sc); \
    ks0 = *(const GAS bf16x8*)((const GAS char*)Kh + (long)((k0) + kkey[0]) * (LDK * 2) + kcb[0]); ks1 = *(const GAS bf16x8*)((const GAS char*)Kh + (long)((k0) + kkey[1]) * (LDK * 2) + kcb[1]); \
    ks2 = *(const GAS bf16x8*)((const GAS char*)Kh + (long)((k0) + kkey[2]) * (LDK * 2) + kcb[2]); } while (0)
#define SWRITE(b) do { *(bf16x8*)(V_lds + (b) * SHM_V + vst0) = vs0; *(bf16x8*)(V_lds + (b) * SHM_V + vst1) = vs1; \
    *(bf16x8*)(K_lds + (b) * SHM_K + KSWZ(kkey[0], kcb[0])) = ks0; *(bf16x8*)(K_lds + (b) * SHM_K + KSWZ(kkey[1], kcb[1])) = ks1; *(bf16x8*)(K_lds + (b) * SHM_K + KSWZ(kkey[2], kcb[2])) = ks2; } while (0)
#define SWAIT() asm volatile("s_waitcnt vmcnt(0)" ::: "memory")
#define RESC(al) do { if (__any((al) < 1.f)) { if (hi == 0) al_l[r32] = (al); asm volatile("s_waitcnt lgkmcnt(0)" ::: "memory"); \
    _Pragma("unroll") for (int d = 0; d < 4; ++d) _Pragma("unroll") for (int r = 0; r < 16; ++r) o[d][r] *= al_l[crow(r, hi)]; } } while (0)
    f32x16 p0, p1; float mn, al; bf16x8 pa0, pa1, pa2, pa3; const int NT = seq / KVBLK;
    SLOAD(0); SWAIT(); SWRITE(0); __syncthreads();
    for (int j = 0; j < NT; ++j) {
        const int bsel = j & 1;
        if (j + 1 < NT) SLOAD((j + 1) * KVBLK);
        SBAR(); qkt(p0, p1, K_lds + bsel * SHM_K, qr, r32, hi);
        partialSM(p0, p1, m_reg, mn, al);
        RESC(al);
        finishSM(p0, p1, al, l_reg, pa0, pa1, pa2, pa3); SBAR();
        pv_d0(o, vb0 + bsel * SHM_V, pa0, pa1, pa2, pa3);
        if (j + 1 < NT) { SWAIT(); SWRITE(bsel ^ 1); }
        __syncthreads();
    }
    if (hi == 0) li_l[r32] = l_reg; asm volatile("s_waitcnt lgkmcnt(0)" ::: "memory");
    float rli[16];
#pragma unroll
    for (int r = 0; r < 16; ++r) rli[r] = __builtin_amdgcn_rcpf(li_l[crow(r, hi)]);
    bf16_t* Ow = Ob + (long)(wid * 32) * LDO;
#pragma unroll
    for (int r = 0; r < 16; ++r) { const int orow = crow(r, hi);
#pragma unroll
        for (int d0 = 0; d0 < 4; ++d0) { const float val = o[d0][r] * rli[r]; ((__attribute__((address_space(1))) bf16_t*)Ow)[(long)orow * LDO + d0 * 32 + r32] = (bf16_t)(cvt_pk_bf16(val, val) & 0xffffu); } }
    __syncthreads();
#undef SLOAD
#undef SWRITE
#undef SWAIT
#undef RESC
}
}
__device__ __forceinline__ void attn_phase(const Args& a, LAS unsigned char* lds, int G, int c) {
    const bf16_t* Q = (const bf16_t*)(a.ws + WS_ARENA + A_Q); const bf16_t* K = (const bf16_t*)(a.ws + WS_ARENA + A_K); const bf16_t* KV = (const bf16_t*)(a.ws + WS_ARENA + A_KV);
    bf16_t* O = (bf16_t*)(a.ws + WS_ARENA + A_O);
    const int vcu = (G % 8 == 0) ? (c % 8) * (G / 8) + c / 8 : c;
    for (int L = vcu; L < 1024 + 64; L += G) {
        int b, h, q0, seq;
        if (L < 1024) { b = L >> 7; h = (L >> 4) & 7; q0 = CTX + (L & 15) * 256; seq = SEG; } else { const int l2 = L - 1024; b = l2 >> 3; h = l2 & 7; q0 = 0; seq = CTX; }
        const size_t rb = (size_t)b * SEG;
        att::attn_unit(Q + (rb + q0) * 1536 + h * QKH, K + rb * 1536 + h * QKH, KV + rb * 2048 + h * 256 + 128, O + (rb + q0) * 1024 + h * VH, seq, (char*)lds);
    }
}

namespace scan {
constexpr int CH = 32, STEP_B = 6 * 256, BUF_B = CH * STEP_B  , YB_B = CH * 64 * 4  , LDS_B = 2 * BUF_B + 2 * YB_B  , NCH = SEG / CH  ;
constexpr int TILE_B = 64 * 65 * 4, MT_TILES = 24 * 896;
struct MTile { const float* src; bf16_t* dst; int sld, ldd, n0, k0, grpd; };
__device__ __forceinline__ int step_row(int b, int dir, int gs) {
    const int base = b * SEG;
    if (dir == 0) return base + gs;
    return gs < CTX ? base + (CTX - 1 - gs) : base + CTX + (SEG - 1 - gs);
}
struct Raw { u32x4 k, r, v, wl, al, vf, vl; };
}
__device__ __forceinline__ bool moe_tile(const Args& a, int k, int t, scan::MTile& m) {
    if (CS_NOTILE || t >= scan::MT_TILES) return false;
    const int j = t / 896, tl = t - j * 896, e = j / 3, kind = j - e * 3; int tn;
    const size_t so = (size_t)(k * NE + e) * D * DFE;
    if (kind < 2) { m.src = a.in[kind == 0 ? I_M1 : I_M3] + so; m.sld = DFE; m.dst = (bf16_t*)(a.ws + WS_ARENA + A_WM13) + (size_t)e * E_M13 + (kind ? (size_t)128 * 1024 : 0); m.ldd = 1024; tn = 56; m.grpd = 1; }
    else { m.src = a.in[I_M2] + so; m.sld = D; m.dst = (bf16_t*)(a.ws + WS_ARENA + A_WM2) + (size_t)e * E_M2; m.ldd = DFE; tn = 16; m.grpd = 0; }
    m.n0 = (tl % tn) * 64; m.k0 = (tl / tn) * 64; return true;
}
__device__ __forceinline__ void scan_phase(const Args& a, int j, const bf16_t* Vsrc, const bool vres, LAS unsigned char* lds, int G, int c) {
    using namespace scan;
    int mt_round = 0;
    const int tid = ltid(), wave = tid >> 6, lane = tid & 63;
    const bf16_t* RR = (const bf16_t*)(a.ws + WS_ARENA + A_RR); const bf16_t* RK = (const bf16_t*)(a.ws + WS_ARENA + A_RK);
    for (int chain = c; chain < 256; chain += G) {
        const int b = chain >> 5, h = (chain >> 1) & 15, dir = chain & 1;
        const bf16_t* WL = (const bf16_t*)(a.ws + WS_ARENA + (dir ? A_WL1 : A_WL0)); const bf16_t* AL = (const bf16_t*)(a.ws + WS_ARENA + (dir ? A_AL1 : A_AL0));
        bf16_t* Y = (bf16_t*)(a.ws + WS_ARENA + (dir ? A_YR : A_YF));
        if (wave >= 4) {
            const int pt = tid - 256, s = pt >> 3, seg = pt & 7, ch0 = h * 64 + seg * 8;
            float kkp[8], kap[8], v0p[8];
            const bf16_t* VFp = (const bf16_t*)(a.ws + WS_VF); const bf16_t* VLp = (const bf16_t*)(a.ws + WS_ARENA + A_VL);
#pragma unroll
            for (int e = 0; e < 8; ++e) v0p[e] = vres ? a.in[I_V0][ch0 + e] : 0.f;
#pragma unroll
            for (int e = 0; e < 8; ++e) { kkp[e] = a.in[I_KK][(size_t)j * D + ch0 + e]; kap[e] = a.in[I_KA][(size_t)j * D + ch0 + e]; }
            Raw raw;
#define GLOAD(q) do { const size_t off_ = (size_t)step_row(b, dir, (q) * CH + s) * 1024 + ch0; \
                raw.k = *(const u32x4*)(RK + off_); raw.r = *(const u32x4*)(RR + off_); raw.v = *(const u32x4*)(Vsrc + off_); raw.wl = *(const u32x4*)(WL + off_); raw.al = *(const u32x4*)(AL + off_); \
                if (vres) { raw.vf = *(const u32x4*)(VFp + off_); raw.vl = *(const u32x4*)(VLp + off_); } } while (0)
#define PRODUCE(buf) do { \
                float k[8], r[8], v[8], wl[8], al[8]; unpack8(raw.k, k); unpack8(raw.r, r); unpack8(raw.v, v); unpack8(raw.wl, wl); unpack8(raw.al, al); \
                if (vres) { float vf[8], vl[8]; unpack8(raw.vf, vf); unpack8(raw.vl, vl); _Pragma("unroll") for (int e = 0; e < 8; ++e) v[e] = v[e] + (vf[e] - v[e]) * sigmoidf_(v0p[e] + vl[e]); } \
                float ad[8], kd[8], kk[8], ww[8], ss = 0.f; \
                _Pragma("unroll") for (int e = 0; e < 8; ++e) { ad[e] = al[e]; kd[e] = k[e] * (1.0f + (ad[e] - 1.0f) * kap[e]); kk[e] = k[e] * kkp[e]; ss += kk[e] * kk[e]; \
                    ww[e] = __expf(-wl[e]); } \
                ss = red8(ss); const float inv = 1.0f / fmaxf(sqrtf(ss), 1e-12f); \
                LAS f32x4* o = (LAS f32x4*)(lds + (buf) * BUF_B + s * STEP_B + seg * 32); \
                _Pragma("unroll") for (int e = 0; e < 8; ++e) kk[e] *= inv; \
                o[0] = (f32x4){ww[0], ww[1], ww[2], ww[3]}; o[1] = (f32x4){ww[4], ww[5], ww[6], ww[7]}; \
                o[16] = (f32x4){kd[0], kd[1], kd[2], kd[3]}; o[17] = (f32x4){kd[4], kd[5], kd[6], kd[7]}; \
                o[32] = (f32x4){-kk[0], -kk[1], -kk[2], -kk[3]}; o[33] = (f32x4){-kk[4], -kk[5], -kk[6], -kk[7]}; \
                o[48] = (f32x4){kk[0] * ad[0], kk[1] * ad[1], kk[2] * ad[2], kk[3] * ad[3]}; o[49] = (f32x4){kk[4] * ad[4], kk[5] * ad[5], kk[6] * ad[6], kk[7] * ad[7]}; \
                o[64] = (f32x4){r[0], r[1], r[2], r[3]}; o[65] = (f32x4){r[4], r[5], r[6], r[7]}; \
                o[80] = (f32x4){v[0], v[1], v[2], v[3]}; o[81] = (f32x4){v[4], v[5], v[6], v[7]}; } while (0)
#define YSTORE(q) do { const LAS f32x4* yp = (const LAS f32x4*)(lds + 2 * BUF_B + ((q) & 1) * YB_B + s * 256 + seg * 32); const f32x4 y0 = yp[0], y1 = yp[1]; \
                u32x4 w; w.x = cvt_pk_bf16(y0[0], y0[1]); w.y = cvt_pk_bf16(y0[2], y0[3]); w.z = cvt_pk_bf16(y1[0], y1[1]); w.w = cvt_pk_bf16(y1[2], y1[3]); \
                *(u32x4*)(Y + (size_t)step_row(b, dir, (q) * CH + s) * 1024 + ch0) = w; } while (0)
            GLOAD(0); PRODUCE(0); GLOAD(1);
            __syncthreads();
            f32x4 treg[4]; const int kl = pt >> 4, nq = (pt & 15) * 4, sn = pt >> 2, sk = (pt & 3) * 16;
            for (int q = 0; q < NCH; ++q) {
                if (q + 1 < NCH) { PRODUCE((q + 1) & 1); if (q + 2 < NCH) GLOAD(q + 2); }
                if (q >= 1) YSTORE(q - 1);
                MTile m;
                if (q >= 2 && moe_tile(a, j, c + (mt_round + q - 2) * G, m)) {
                    const LAS float* tl_ = (const LAS float*)(lds + LDS_B + (q & 1) * TILE_B); float f0[8], f1[8];
#pragma unroll
                    for (int e = 0; e < 8; ++e) { f0[e] = tl_[(sk + e) * 65 + sn]; f1[e] = tl_[(sk + 8 + e) * 65 + sn]; }
                    const int n = m.n0 + sn, dr = m.grpd ? ((n >> 7) * 256 + (n & 127)) : n; bf16_t* dp = m.dst + (size_t)dr * m.ldd + m.k0 + sk;
                    *(u32x4*)dp = pack8(f0); *(u32x4*)(dp + 8) = pack8(f1); }
                if (q >= 1 && q <= NCH - 2 && moe_tile(a, j, c + (mt_round + q - 1) * G, m)) {
                    LAS float* tl_ = (LAS float*)(lds + LDS_B + ((q - 1) & 1) * TILE_B);
#pragma unroll
                    for (int p = 0; p < 4; ++p) { LAS float* tp = tl_ + (kl + 16 * p) * 65 + nq; tp[0] = treg[p][0]; tp[1] = treg[p][1]; tp[2] = treg[p][2]; tp[3] = treg[p][3]; } }
                if (q <= NCH - 3 && moe_tile(a, j, c + (mt_round + q) * G, m)) {
#pragma unroll
                    for (int p = 0; p < 4; ++p) treg[p] = *(const f32x4*)(m.src + (size_t)(m.k0 + kl + 16 * p) * m.sld + m.n0 + nq); }
                __syncthreads();
            }
            YSTORE(NCH - 1);
#undef GLOAD
#undef PRODUCE
#undef YSTORE
        } else {
            const int rp = lane >> 3, ks = lane & 7, v0i = wave * 16 + rp * 2;
            f32x2 s0[4], s1[4];
#pragma unroll
            for (int i = 0; i < 4; ++i) { s0[i] = (f32x2){0.f, 0.f}; s1[i] = (f32x2){0.f, 0.f}; }
            __syncthreads();
            struct Vecs { f32x4 w0, w1, k0, k1, a0, a1, b0, b1, r0, r1; f32x2 vv; };
#define LOADV(V, t) do { const LAS f32x4* p_ = (const LAS f32x4*)(bp + (t) * STEP_B); V.w0 = p_[0]; V.w1 = p_[1]; V.k0 = p_[16]; V.k1 = p_[17]; V.a0 = p_[32]; V.a1 = p_[33]; \
                    V.b0 = p_[48]; V.b1 = p_[49]; V.r0 = p_[64]; V.r1 = p_[65]; V.vv = *(const LAS f32x2*)(vp + (t) * STEP_B); } while (0)
#define STEPV(V, t, HAVEPREV) do { \
                    const f32x2 wv[4] = {{V.w0[0], V.w0[1]}, {V.w0[2], V.w0[3]}, {V.w1[0], V.w1[1]}, {V.w1[2], V.w1[3]}}, kv[4] = {{V.k0[0], V.k0[1]}, {V.k0[2], V.k0[3]}, {V.k1[0], V.k1[1]}, {V.k1[2], V.k1[3]}}; \
                    const f32x2 av[4] = {{V.a0[0], V.a0[1]}, {V.a0[2], V.a0[3]}, {V.a1[0], V.a1[1]}, {V.a1[2], V.a1[3]}}, bv[4] = {{V.b0[0], V.b0[1]}, {V.b0[2], V.b0[3]}, {V.b1[0], V.b1[1]}, {V.b1[2], V.b1[3]}}; \
                    const f32x2 rv[4] = {{V.r0[0], V.r0[1]}, {V.r0[2], V.r0[3]}, {V.r1[0], V.r1[1]}, {V.r1[2], V.r1[3]}}; \
                    f32x2 d0 = s0[0] * av[0], d1 = s1[0] * av[0]; \
                    d0 += s0[1] * av[1]; d1 += s1[1] * av[1]; d0 += s0[2] * av[2]; d1 += s1[2] * av[2]; d0 += s0[3] * av[3]; d1 += s1[3] * av[3]; \
                    float h0 = d0.x + d0.y, h1 = d1.x + d1.y; \
                    h0 += dpp_f<0xB1>(h0); h1 += dpp_f<0xB1>(h1); yp0 += dpp_f<0xB1>(yp0); yp1 += dpp_f<0xB1>(yp1); \
                    h0 += dpp_f<0x4E>(h0); h1 += dpp_f<0x4E>(h1); yp0 += dpp_f<0x4E>(yp0); yp1 += dpp_f<0x4E>(yp1); \
                    h0 += dpp_f<0x141>(h0); h1 += dpp_f<0x141>(h1); yp0 += dpp_f<0x141>(yp0); yp1 += dpp_f<0x141>(yp1); \
                    if (HAVEPREV) yb[((t) - 1) * 64 + v0i + (ks & 1)] = (ks & 1) ? yp1 : yp0; \
                    const f32x2 sa0v = {h0, h0}, sa1v = {h1, h1}, v0v = {V.vv.x, V.vv.x}, v1v = {V.vv.y, V.vv.y}; \
                    _Pragma("unroll") for (int i = 0; i < 4; ++i) { s0[i] = s0[i] * wv[i] + sa0v * bv[i] + v0v * kv[i]; s1[i] = s1[i] * wv[i] + sa1v * bv[i] + v1v * kv[i]; } \
                    f32x2 y0 = s0[0] * rv[0], y1 = s1[0] * rv[0]; \
                    y0 += s0[1] * rv[1]; y1 += s1[1] * rv[1]; y0 += s0[2] * rv[2]; y1 += s1[2] * rv[2]; y0 += s0[3] * rv[3]; y1 += s1[3] * rv[3]; \
                    yp0 = y0.x + y0.y; yp1 = y1.x + y1.y; } while (0)
            for (int q = 0; q < NCH; ++q) {
                const LAS unsigned char* bp = lds + (q & 1) * BUF_B + ks * 32;
                const LAS unsigned char* vp = lds + (q & 1) * BUF_B + 5 * 256 + v0i * 4;
                LAS float* yb = (LAS float*)(lds + 2 * BUF_B + (q & 1) * YB_B);
                Vecs VA, VB; float yp0 = 0.f, yp1 = 0.f;
                LOADV(VA, 0); LOADV(VB, 1);
                STEPV(VA, 0, false);
                LOADV(VA, 2);
                STEPV(VB, 1, true);
#pragma unroll 1
                for (int t = 2; t < CH; t += 2) {
                    LOADV(VB, t + 1);
                    STEPV(VA, t, true);
                    LOADV(VA, t + 2);
                    STEPV(VB, t + 1, true);
                }
                yp0 = red8(yp0); yp1 = red8(yp1);
                yb[(CH - 1) * 64 + v0i + (ks & 1)] = (ks & 1) ? yp1 : yp0;
                __syncthreads();
            }
#undef LOADV
#undef STEPV
        }
        mt_round += NCH - 2;
        __syncthreads();
    }
}

namespace cs {
constexpr int C = 32, NCK = SEG / C;
constexpr int TM = 72, CM = 40, TMB = TM * 2, CMB = CM * 2;
constexpr int SZ_TM = 32 * TMB, SZ_CM = 64 * CMB, SZ_C32 = 32 * CMB;
constexpr int X_ATM = 0, X_RTM = SZ_TM, X_BHTM = 2 * SZ_TM, X_KHTM = 3 * SZ_TM, X_ACM = 4 * SZ_TM, X_RCM = X_ACM + SZ_CM, X_BBCM = X_RCM + SZ_CM, X_KBCM = X_BBCM + SZ_CM, X_B = X_KBCM + SZ_CM;
constexpr int Y_VCM = 0, Y_GC = SZ_CM, Y_B = SZ_CM + 256;
constexpr int OFF_X = 0, OFF_Y = 2 * X_B, OFF_MID = OFF_Y + 2 * Y_B;
constexpr int M_NL = 0, M_NR = SZ_C32, M_TT = 2 * SZ_C32, M_ARBT = 3 * SZ_C32, M_AAK = 4 * SZ_C32, M_UP = 5 * SZ_C32, M_W = 6 * SZ_C32, M_ARK = M_W + SZ_CM, MID_B = M_ARK + 4096;
constexpr int OFF_OUT = OFF_MID + MID_B;
constexpr int O_PST = 0, O_QST = 64 * TMB, O_PYT = O_QST + SZ_CM, O_QYT = O_PYT + SZ_TM, OUT_B = O_QYT + SZ_C32;
constexpr int OFF_YB = OFF_OUT + OUT_B, OFF_ES = OFF_YB + 8192, OFF_WT = OFF_ES + 2048, LDS_END = OFF_WT + 64 * 65 * 4;
__device__ __forceinline__ int rho(int r, int h) { return (r & 3) + 8 * (r >> 2) + 4 * h; }
__device__ __forceinline__ int perm16(int k) { return (k & ~0xC) | ((k & 4) << 1) | ((k & 8) >> 1); }
typedef __bf16 bf16v2 __attribute__((ext_vector_type(2)));
__device__ __forceinline__ unsigned cvt_pk_bf16_c(float lo, float hi) { const bf16v2 v = __builtin_convertvector((f32x2){lo, hi}, bf16v2); return __builtin_bit_cast(unsigned, v); }
__device__ __forceinline__ bf16_t f2bf(float x) { const __bf16 b = (__bf16)x; return __builtin_bit_cast(bf16_t, b); }
__device__ __forceinline__ float bf2f(bf16_t x) { return __uint_as_float((unsigned)x << 16); }
template <int KS> __device__ __forceinline__ void mma32t(f32x16& acc, const LAS unsigned char* A, int lda, const LAS unsigned char* B, int ldb, int r32, int h) {
    bf16x8 a[KS], b[KS];
#pragma unroll
    for (int s = 0; s < KS; ++s) { a[s] = *(const LAS bf16x8*)(A + r32 * lda + s * 32 + h * 16); b[s] = *(const LAS bf16x8*)(B + r32 * ldb + s * 32 + h * 16); }
#pragma unroll
    for (int s = 0; s < KS; ++s) acc = __builtin_amdgcn_mfma_f32_32x32x16_bf16(a[s], b[s], acc, 0, 0, 0);
}
__device__ __forceinline__ void mma32(f32x16& acc, const LAS unsigned char* A, int lda, const LAS unsigned char* B, int ldb, int ksteps, int r32, int h) {
    if (ksteps == 4) mma32t<4>(acc, A, lda, B, ldb, r32, h); else mma32t<2>(acc, A, lda, B, ldb, r32, h);
}
__device__ __forceinline__ void st_bf(const f32x16& acc, LAS unsigned char* dst, int sr, int sc, int r32, int h) {
#pragma unroll
    for (int r = 0; r < 16; ++r) *(LAS bf16_t*)(dst + rho(r, h) * sr + r32 * sc) = f2bf(acc[r]);
}
template <bool PERM> __device__ __forceinline__ void st_bf_T(const f32x16& acc, LAS unsigned char* dst, int sc, int r32, int h) {
#pragma unroll
    for (int m = 0; m < 4; ++m) { const int row0 = 8 * m + 4 * h, pos = PERM ? perm16(row0) : row0; u32x2 w; w.x = cvt_pk_bf16_c(acc[4 * m], acc[4 * m + 1]); w.y = cvt_pk_bf16_c(acc[4 * m + 2], acc[4 * m + 3]);
        *(LAS u32x2*)(dst + r32 * sc + pos * 2) = w; }
}
}
#define CS_BAR() do { asm volatile("s_waitcnt lgkmcnt(0)" ::: "memory"); __builtin_amdgcn_s_barrier(); asm volatile("" ::: "memory"); } while (0)
__device__ __forceinline__ void scan_chunked(const Args& a, int jl, const bf16_t* Vsrc, const bool vres, LAS unsigned char* lds, int G, int c) {
    using namespace cs;
    const int tid0 = ltid(), wave = __builtin_amdgcn_readfirstlane(tid0 >> 6);
    typedef const __attribute__((address_space(1))) bf16_t* gcp; typedef __attribute__((address_space(1))) bf16_t* gwp;
    gcp RR = (gcp)(a.ws + WS_ARENA + A_RR); gcp RK = (gcp)(a.ws + WS_ARENA + A_RK);
    gcp VFp = (gcp)(a.ws + WS_VF); gcp VLp = (gcp)(a.ws + WS_ARENA + A_VL); gcp Vg = (gcp)Vsrc;
    int mt0 = 0;
    for (int chain = c; chain < 256; chain += G) {
        const int b = chain >> 5, hd = (chain >> 1) & 15, dir = chain & 1;
        gcp WL = (gcp)(a.ws + WS_ARENA + (dir ? A_WL1 : A_WL0)); gcp AL = (gcp)(a.ws + WS_ARENA + (dir ? A_AL1 : A_AL0));
        gwp Y = (gwp)(a.ws + WS_ARENA + (dir ? A_YCR : A_YCF));
        const int gcol0 = hd * 64 + (tid0 & 63);
        const float kkp = a.in[I_KK][(size_t)jl * D + gcol0], kap = a.in[I_KA][(size_t)jl * D + gcol0], v0p = vres ? a.in[I_V0][gcol0] : 0.f;
        f32x16 S0 = {}, S1 = {};
        f32x4 wreg[8];
        constexpr int ntok = 4; const int tok0 = 4 * wave;
        bf16_t rk_[4], rr_[4], ra_[4], rv_[4], re_[4], rf_[4], rl_[4];
        bf16_t qk_[4], qr_[4], qa_[4], qv_[4], qe_[4], qf_[4], ql_[4];
#define CS_LOAD(q) do { _Pragma("unroll") for (int tk_ = 0; tk_ < 4; ++tk_) { const unsigned off_ = (unsigned)scan::step_row(b, dir, (q) * 32 + tok0 + tk_) * 1024u + (unsigned)gcol; \
                qk_[tk_] = RK[off_]; qr_[tk_] = RR[off_]; qa_[tk_] = AL[off_]; qe_[tk_] = WL[off_]; qv_[tk_] = Vg[off_]; if (vres) { qf_[tk_] = VFp[off_]; ql_[tk_] = VLp[off_]; } } } while (0)
#define CS_COPY() do { _Pragma("unroll") for (int tk_ = 0; tk_ < 4; ++tk_) { rk_[tk_] = qk_[tk_]; rr_[tk_] = qr_[tk_]; ra_[tk_] = qa_[tk_]; re_[tk_] = qe_[tk_]; rv_[tk_] = qv_[tk_]; rf_[tk_] = qf_[tk_]; rl_[tk_] = ql_[tk_]; } } while (0)
#define CS_ESUM() do { float es_ = 0.f; _Pragma("unroll") for (int tk_ = 0; tk_ < 4; ++tk_) es_ += bf2f(re_[tk_]); *(LAS float*)(lds + OFF_ES + wave * 256 + lane * 4) = es_; } while (0)
#define CS_MAIN(q) do { \
            LAS unsigned char* X_ = lds + OFF_X + ((q) & 1) * X_B; LAS unsigned char* Yb_ = lds + OFF_Y + ((q) & 1) * Y_B; \
            float before_ = 0.f, tot_ = 0.f; \
            _Pragma("unroll") for (int w_ = 0; w_ < 8; ++w_) { const float es_ = *(const LAS float*)(lds + OFF_ES + w_ * 256 + lane * 4); before_ += (w_ < wave) ? es_ : 0.f; tot_ += es_; } \
            float erun_ = __expf(-before_); const float gct_ = __expf(-tot_); \
            _Pragma("unroll") for (int p_ = 0; p_ < 2; ++p_) { const int t_ = tok0 + 2 * p_;            \
                const f32x2 kraw_ = {bf2f(rk_[2 * p_]), bf2f(rk_[2 * p_ + 1])}, rr2_ = {bf2f(rr_[2 * p_]), bf2f(rr_[2 * p_ + 1])}, ad_ = {bf2f(ra_[2 * p_]), bf2f(ra_[2 * p_ + 1])}; \
                f32x2 vv_ = {bf2f(rv_[2 * p_]), bf2f(rv_[2 * p_ + 1])}; \
                if (vres) { const f32x2 vf_ = {bf2f(rf_[2 * p_]), bf2f(rf_[2 * p_ + 1])}; const float s0_ = sigmoidf_(v0p + bf2f(rl_[2 * p_])), s1_ = sigmoidf_(v0p + bf2f(rl_[2 * p_ + 1])); \
                    vv_ = vv_ + (vf_ - vv_) * (f32x2){s0_, s1_}; } \
                const f32x2 kd_ = kraw_ * ((ad_ - 1.0f) * kap + 1.0f), kkr_ = kraw_ * kkp, sq_ = kkr_ * kkr_; \
                float s0 = sq_.x, s1 = sq_.y; \
                s0 += dpp_f<0xB1>(s0); s1 += dpp_f<0xB1>(s1); s0 += dpp_f<0x4E>(s0); s1 += dpp_f<0x4E>(s1); s0 += dpp_f<0x141>(s0); s1 += dpp_f<0x141>(s1); s0 += dpp_f<0x140>(s0); s1 += dpp_f<0x140>(s1); \
                const int i0_ = __float_as_int(s0), i1_ = __float_as_int(s1); \
                const float ss0_ = (__int_as_float(__builtin_amdgcn_readlane(i0_, 0)) + __int_as_float(__builtin_amdgcn_readlane(i0_, 16))) + (__int_as_float(__builtin_amdgcn_readlane(i0_, 32)) + __int_as_float(__builtin_amdgcn_readlane(i0_, 48))); \
                const float ss1_ = (__int_as_float(__builtin_amdgcn_readlane(i1_, 0)) + __int_as_float(__builtin_amdgcn_readlane(i1_, 16))) + (__int_as_float(__builtin_amdgcn_readlane(i1_, 32)) + __int_as_float(__builtin_amdgcn_readlane(i1_, 48))); \
                const f32x2 kk_ = kkr_ * (f32x2){__builtin_amdgcn_rsqf(fmaxf(ss0_, 1e-24f)), __builtin_amdgcn_rsqf(fmaxf(ss1_, 1e-24f))}; \
                const float w0_ = __expf(-bf2f(re_[2 * p_])), w1_ = __expf(-bf2f(re_[2 * p_ + 1])); \
                f32x2 E1_, E2_; E1_.x = erun_; E2_.x = erun_ * w0_; E1_.y = E2_.x; E2_.y = E2_.x * w1_; erun_ = E2_.y; \
                const f32x2 Ei_ = {__builtin_amdgcn_rcpf(E2_.x), __builtin_amdgcn_rcpf(E2_.y)}, E3_ = Ei_ * gct_, bv_ = kk_ * ad_; \
                const f32x2 at2_ = -(kk_ * E1_), rt2_ = rr2_ * E2_, bh2_ = bv_ * Ei_, kh2_ = kd_ * Ei_, kb2_ = kd_ * E3_, bb2_ = bv_ * E3_; \
                const unsigned pa_ = cvt_pk_bf16_c(at2_.x, at2_.y), pr_ = cvt_pk_bf16_c(rt2_.x, rt2_.y), pbh_ = cvt_pk_bf16_c(bh2_.x, bh2_.y), pkh_ = cvt_pk_bf16_c(kh2_.x, kh2_.y); \
                *(LAS unsigned*)(X_ + X_ACM + lane * CMB + t_ * 2) = pa_; *(LAS unsigned*)(X_ + X_RCM + lane * CMB + t_ * 2) = pr_; \
                *(LAS unsigned*)(X_ + X_KBCM + lane * CMB + t_ * 2) = cvt_pk_bf16_c(kb2_.x, kb2_.y); *(LAS unsigned*)(X_ + X_BBCM + lane * CMB + t_ * 2) = cvt_pk_bf16_c(bb2_.x, bb2_.y); \
                *(LAS unsigned*)(Yb_ + Y_VCM + lane * CMB + t_ * 2) = cvt_pk_bf16_c(vv_.x, vv_.y); \
                *(LAS bf16_t*)(X_ + X_ATM + t_ * TMB + lane * 2) = (bf16_t)pa_; *(LAS bf16_t*)(X_ + X_ATM + (t_ + 1) * TMB + lane * 2) = (bf16_t)(pa_ >> 16); \
                *(LAS bf16_t*)(X_ + X_RTM + t_ * TMB + lane * 2) = (bf16_t)pr_; *(LAS bf16_t*)(X_ + X_RTM + (t_ + 1) * TMB + lane * 2) = (bf16_t)(pr_ >> 16); \
                *(LAS bf16_t*)(X_ + X_BHTM + t_ * TMB + lane * 2) = (bf16_t)pbh_; *(LAS bf16_t*)(X_ + X_BHTM + (t_ + 1) * TMB + lane * 2) = (bf16_t)(pbh_ >> 16); \
                *(LAS bf16_t*)(X_ + X_KHTM + t_ * TMB + lane * 2) = (bf16_t)pkh_; *(LAS bf16_t*)(X_ + X_KHTM + (t_ + 1) * TMB + lane * 2) = (bf16_t)(pkh_ >> 16); } \
            if (wave == 7) *(LAS float*)(Yb_ + Y_GC + lane * 4) = gct_; } while (0)
        { const int tid = ltid(), lane = tid & 63, gcol = hd * 64 + lane;
          { CS_LOAD(0); CS_COPY(); CS_ESUM(); }
          CS_BAR();
          { CS_LOAD(1); CS_MAIN(0); } }
        CS_BAR();
        for (int it = -1; it < NCK; ++it) {
            const bool have_next = (it + 1 < NCK);
            const int tid = ltid(), lane = tid & 63, r32 = lane & 31, h = lane >> 5, gcol = hd * 64 + lane;
            LAS unsigned char* X = lds + OFF_X + ((it + 1) & 1) * X_B; LAS unsigned char* M = lds + OFF_MID; LAS unsigned char* O = lds + OFF_OUT;
            f32x16 acc = {}, accT = {};
            if (have_next && wave < 4) {
                if (wave == 0) {
                    bf16x8 fb[4], fa[4];
#pragma unroll
                    for (int s4 = 0; s4 < 4; ++s4) { fb[s4] = *(const LAS bf16x8*)(X + X_BHTM + r32 * TMB + s4 * 32 + h * 16); fa[s4] = *(const LAS bf16x8*)(X + X_ATM + r32 * TMB + s4 * 32 + h * 16); }
#pragma unroll
                    for (int s4 = 0; s4 < 4; ++s4) { acc = __builtin_amdgcn_mfma_f32_32x32x16_bf16(fb[s4], fa[s4], acc, 0, 0, 0); accT = __builtin_amdgcn_mfma_f32_32x32x16_bf16(fa[s4], fb[s4], accT, 0, 0, 0); }
#pragma unroll
                    for (int r = 0; r < 16; ++r) accT[r] = (r32 < rho(r, h)) ? accT[r] : 0.f; }
                else if (wave == 2) mma32(acc, X + X_ATM, TMB, X + X_KHTM, TMB, 4, r32, h);
                else mma32(acc, X + ((wave & 2) ? X_KHTM : X_BHTM), TMB, X + ((wave & 1) ? X_RTM : X_ATM), TMB, 4, r32, h);
#pragma unroll
                for (int r = 0; r < 16; ++r) { const int i = rho(r, h); const bool keep = (wave == 2) ? (r32 < i) : ((wave & 1) ? (i <= r32) : (i < r32)); acc[r] = keep ? acc[r] : 0.f; }
                if (wave == 0) { }
                else if (wave == 1) st_bf_T<false>(acc, M + M_ARBT, CMB, r32, h);
                else if (wave == 2) st_bf_T<false>(acc, M + M_AAK, CMB, r32, h);
                else {
#pragma unroll
                    for (int m = 0; m < 4; ++m) *(LAS f32x4*)(M + M_ARK + r32 * 128 + (8 * m + 4 * h) * 4) = (f32x4){acc[4 * m], acc[4 * m + 1], acc[4 * m + 2], acc[4 * m + 3]}; }
            }
            if (CS_SERIAL) CS_BAR();
            if (it >= 0 && wave >= 6) {
                const int vb = wave - 6; const LAS unsigned char* Yb = lds + OFF_Y + (it & 1) * Y_B;
                bf16x8 bs[4];
#pragma unroll
                for (int s = 0; s < 2; ++s) { u32x4 w0, w1;
                    w0.x = cvt_pk_bf16_c(S0[8 * s + 0], S0[8 * s + 1]); w0.y = cvt_pk_bf16_c(S0[8 * s + 2], S0[8 * s + 3]); w0.z = cvt_pk_bf16_c(S0[8 * s + 4], S0[8 * s + 5]); w0.w = cvt_pk_bf16_c(S0[8 * s + 6], S0[8 * s + 7]);
                    w1.x = cvt_pk_bf16_c(S1[8 * s + 0], S1[8 * s + 1]); w1.y = cvt_pk_bf16_c(S1[8 * s + 2], S1[8 * s + 3]); w1.z = cvt_pk_bf16_c(S1[8 * s + 4], S1[8 * s + 5]); w1.w = cvt_pk_bf16_c(S1[8 * s + 6], S1[8 * s + 7]);
                    bs[s] = *reinterpret_cast<bf16x8*>(&w0); bs[2 + s] = *reinterpret_cast<bf16x8*>(&w1); }
                const LAS unsigned char* Vr = Yb + Y_VCM + (vb * 32 + r32) * CMB + h * 16;
                const bf16x8 bv0 = *(const LAS bf16x8*)Vr, bv1 = *(const LAS bf16x8*)(Vr + 32);
                bf16x8 fy[6], fs[6];
#pragma unroll
                for (int s = 0; s < 4; ++s) { fy[s] = *(const LAS bf16x8*)(O + O_PYT + r32 * TMB + s * 32 + h * 16); fs[s] = *(const LAS bf16x8*)(O + O_PST + r32 * TMB + s * 32 + h * 16); }
#pragma unroll
                for (int s = 0; s < 2; ++s) { fy[4 + s] = *(const LAS bf16x8*)(O + O_QYT + r32 * CMB + s * 32 + h * 16); fs[4 + s] = *(const LAS bf16x8*)(O + O_QST + r32 * CMB + s * 32 + h * 16); }
                f32x16 n0, n1;
#pragma unroll
                for (int m = 0; m < 4; ++m) { const f32x4 g0 = *(const LAS f32x4*)(Yb + Y_GC + (8 * m + 4 * h) * 4), g1 = *(const LAS f32x4*)(Yb + Y_GC + (32 + 8 * m + 4 * h) * 4);
#pragma unroll
                    for (int i = 0; i < 4; ++i) { n0[4 * m + i] = S0[4 * m + i] * g0[i]; n1[4 * m + i] = S1[4 * m + i] * g1[i]; } }
                f32x16 ya = {};
#pragma unroll
                for (int s = 0; s < 4; ++s) { ya = __builtin_amdgcn_mfma_f32_32x32x16_bf16(fy[s], bs[s], ya, 0, 0, 0); n0 = __builtin_amdgcn_mfma_f32_32x32x16_bf16(fs[s], bs[s], n0, 0, 0, 0); }
                ya = __builtin_amdgcn_mfma_f32_32x32x16_bf16(fy[4], bv0, ya, 0, 0, 0); n0 = __builtin_amdgcn_mfma_f32_32x32x16_bf16(fs[4], bv0, n0, 0, 0, 0);
                ya = __builtin_amdgcn_mfma_f32_32x32x16_bf16(fy[5], bv1, ya, 0, 0, 0); n0 = __builtin_amdgcn_mfma_f32_32x32x16_bf16(fs[5], bv1, n0, 0, 0, 0);
#pragma unroll
                for (int s = 0; s < 4; ++s) fs[s] = *(const LAS bf16x8*)(O + O_PST + (32 + r32) * TMB + s * 32 + h * 16);
#pragma unroll
                for (int s = 0; s < 2; ++s) fs[4 + s] = *(const LAS bf16x8*)(O + O_QST + (32 + r32) * CMB + s * 32 + h * 16);
#pragma unroll
                for (int r = 0; r < 16; ++r) *(LAS float*)(lds + OFF_YB + rho(r, h) * 256 + (vb * 32 + r32) * 4) = ya[r];
#pragma unroll
                for (int s = 0; s < 4; ++s) n1 = __builtin_amdgcn_mfma_f32_32x32x16_bf16(fs[s], bs[s], n1, 0, 0, 0);
                n1 = __builtin_amdgcn_mfma_f32_32x32x16_bf16(fs[4], bv0, n1, 0, 0, 0); n1 = __builtin_amdgcn_mfma_f32_32x32x16_bf16(fs[5], bv1, n1, 0, 0, 0);
                S0 = n0; S1 = n1;
            }
            if (it + 2 < NCK) { CS_COPY(); CS_ESUM(); }
            if (wave == 4 || wave == 5) {
                const int pt = tid - 256; scan::MTile m;
                if (it >= 0 && it <= NCK - 2 && moe_tile(a, jl, c + (mt0 + it) * G, m)) {
                    const LAS float* tl_ = (const LAS float*)(lds + OFF_WT); const int sn = pt >> 1, sk = (pt & 1) * 32;
                    const int n = m.n0 + sn, dr = m.grpd ? ((n >> 7) * 256 + (n & 127)) : n; bf16_t* dp = m.dst + (size_t)dr * m.ldd + m.k0 + sk;
#pragma unroll
                    for (int q8 = 0; q8 < 4; ++q8) { float f[8];
#pragma unroll
                        for (int e = 0; e < 8; ++e) f[e] = tl_[(sk + q8 * 8 + e) * 65 + sn];
                        *(__attribute__((address_space(1))) u32x4*)(dp + q8 * 8) = pack8(f); } }
                if (it + 1 < NCK - 1 && moe_tile(a, jl, c + (mt0 + it + 1) * G, m)) { const int kl = pt >> 4, nq = (pt & 15) * 4;
#pragma unroll
                    for (int p8 = 0; p8 < 8; ++p8) wreg[p8] = *(const __attribute__((address_space(1))) f32x4*)(m.src + (size_t)(m.k0 + kl + 8 * p8) * m.sld + m.n0 + nq); }
            }
            CS_BAR();
            if (have_next && wave == 0) {
                f32x16 Tm = acc, Mm = acc, Mt = accT;
#pragma unroll
                for (int r = 0; r < 16; ++r) Tm[r] += (rho(r, h) == r32) ? 1.0f : 0.f;
#define CS_SLAB(tile, s) ({ u32x4 w_; w_.x = cvt_pk_bf16_c(tile[8 * (s) + 0], tile[8 * (s) + 1]); w_.y = cvt_pk_bf16_c(tile[8 * (s) + 2], tile[8 * (s) + 3]); \
                    w_.z = cvt_pk_bf16_c(tile[8 * (s) + 4], tile[8 * (s) + 5]); w_.w = cvt_pk_bf16_c(tile[8 * (s) + 6], tile[8 * (s) + 7]); *reinterpret_cast<bf16x8*>(&w_); })
                for (int lvl = 0; lvl < 4; ++lvl) {
                    const bf16x8 m0 = CS_SLAB(Mm, 0), m1 = CS_SLAB(Mm, 1), t0_ = CS_SLAB(Mt, 0), t1_ = CS_SLAB(Mt, 1);
                    f32x16 m2 = {}, m2t = {};
                    m2 = __builtin_amdgcn_mfma_f32_32x32x16_bf16(t0_, m0, m2, 0, 0, 0); m2t = __builtin_amdgcn_mfma_f32_32x32x16_bf16(m0, t0_, m2t, 0, 0, 0);
                    m2 = __builtin_amdgcn_mfma_f32_32x32x16_bf16(t1_, m1, m2, 0, 0, 0); m2t = __builtin_amdgcn_mfma_f32_32x32x16_bf16(m1, t1_, m2t, 0, 0, 0);
                    Mm = m2; Mt = m2t;
                    { const bf16x8 a0 = CS_SLAB(Mt, 0), a1 = CS_SLAB(Mt, 1), bt0 = CS_SLAB(Tm, 0), bt1 = CS_SLAB(Tm, 1);
                      Tm = __builtin_amdgcn_mfma_f32_32x32x16_bf16(a0, bt0, Tm, 0, 0, 0); Tm = __builtin_amdgcn_mfma_f32_32x32x16_bf16(a1, bt1, Tm, 0, 0, 0); }
                }
                st_bf_T<false>(Tm, M + M_TT, CMB, r32, h);
            }
            if (CS_SERIAL) CS_BAR();
            if (it + 3 < NCK) CS_LOAD(it + 3);
            if (it + 2 < NCK) CS_MAIN(it + 2);
            if (CS_SERIAL) CS_BAR();
            if (it >= 0 && wave >= 5) {
                for (int item = tid - 320; item < 256; item += 192) { const int t = item >> 3, seg = item & 7;
                    const LAS f32x4* yp = (const LAS f32x4*)(lds + OFF_YB + t * 256 + seg * 32); const f32x4 y0 = yp[0], y1 = yp[1];
                    u32x4 w; w.x = cvt_pk_bf16(y0[0], y0[1]); w.y = cvt_pk_bf16(y0[2], y0[3]); w.z = cvt_pk_bf16(y1[0], y1[1]); w.w = cvt_pk_bf16(y1[2], y1[3]);
                    *(__attribute__((address_space(1))) u32x4*)(Y + (size_t)scan::step_row(b, dir, it * 32 + t) * 1024 + hd * 64 + seg * 8) = w; }
            }
            CS_BAR();
            if (have_next && wave < 3) {
                f32x16 d = {};
                if (wave < 2) { mma32(d, M + M_TT, CMB, X + X_ACM + wave * 32 * CMB, CMB, 2, r32, h); st_bf_T<false>(d, M + M_W + wave * 32 * CMB, CMB, r32, h); }
                else { mma32(d, M + M_TT, CMB, M + M_AAK, CMB, 2, r32, h); st_bf_T<false>(d, M + M_UP, CMB, r32, h); }
            }
            if (wave == 4 || wave == 5) { const int pt = tid - 256, kl = pt >> 4, nq = (pt & 15) * 4; scan::MTile m;
                if (it + 1 < NCK - 1 && moe_tile(a, jl, c + (mt0 + it + 1) * G, m)) { LAS float* tl_ = (LAS float*)(lds + OFF_WT);
#pragma unroll
                    for (int p8 = 0; p8 < 8; ++p8) { LAS float* tp = tl_ + (kl + 8 * p8) * 65 + nq; tp[0] = wreg[p8][0]; tp[1] = wreg[p8][1]; tp[2] = wreg[p8][2]; tp[3] = wreg[p8][3]; } } }
            CS_BAR();
            if (have_next) {
                f32x16 d = {};
                if (wave < 4) { const int kt = wave & 1, kpt = wave >> 1;
                    mma32(d, M + M_W + kt * 32 * CMB, CMB, X + X_BBCM + kpt * 32 * CMB, CMB, 2, r32, h);
                    st_bf_T<true>(d, O + O_PST + kpt * 32 * TMB + kt * 64, TMB, r32, h); }
                else if (wave < 6) { const int kt = wave - 4;
                    u32x2 ra[4];
#pragma unroll
                    for (int m = 0; m < 4; ++m) ra[m] = *(const LAS u32x2*)(X + X_RTM + r32 * TMB + (kt * 32 + 8 * m + 4 * h) * 2);
                    mma32(d, M + M_W + kt * 32 * CMB, CMB, M + M_ARBT, CMB, 2, r32, h);
#pragma unroll
                    for (int m = 0; m < 4; ++m) { d[4 * m] += bflo(ra[m].x); d[4 * m + 1] += bfhi(ra[m].x); d[4 * m + 2] += bflo(ra[m].y); d[4 * m + 3] += bfhi(ra[m].y); }
                    st_bf_T<true>(d, O + O_PYT + kt * 64, TMB, r32, h); }
                else { const int kpt = wave - 6;
                    u32x2 ka[4];
#pragma unroll
                    for (int m = 0; m < 4; ++m) ka[m] = *(const LAS u32x2*)(X + X_KBCM + (kpt * 32 + r32) * CMB + (8 * m + 4 * h) * 2);
                    mma32(d, M + M_UP, CMB, X + X_BBCM + kpt * 32 * CMB, CMB, 2, r32, h);
#pragma unroll
                    for (int m = 0; m < 4; ++m) { d[4 * m] += bflo(ka[m].x); d[4 * m + 1] += bfhi(ka[m].x); d[4 * m + 2] += bflo(ka[m].y); d[4 * m + 3] += bfhi(ka[m].y); }
                    st_bf_T<false>(d, O + O_QST + kpt * 32 * CMB, CMB, r32, h);
                    if (wave == 7) { f32x16 e = {}; f32x4 aa[4];
#pragma unroll
                        for (int m = 0; m < 4; ++m) aa[m] = *(const LAS f32x4*)(M + M_ARK + r32 * 128 + (8 * m + 4 * h) * 4);
                        mma32(e, M + M_UP, CMB, M + M_ARBT, CMB, 2, r32, h);
#pragma unroll
                        for (int m = 0; m < 4; ++m) { e[4 * m] += aa[m][0]; e[4 * m + 1] += aa[m][1]; e[4 * m + 2] += aa[m][2]; e[4 * m + 3] += aa[m][3]; }
                        st_bf_T<false>(e, O + O_QYT, CMB, r32, h); } }
            }
            CS_BAR();
        }
#undef CS_LOAD
#undef CS_COPY
#undef CS_ESUM
#undef CS_MAIN
        mt0 += NCK - 1;
    }
}


__device__ __forceinline__ void scan_compare(const Args& a, LAS unsigned char* lds, int G, int c) {
    const int tid = ltid();
    asm volatile("s_waitcnt vmcnt(0)" ::: "memory"); __syncthreads();
    for (int chain = c; chain < 256; chain += G) {
        const int b = chain >> 5, hd = (chain >> 1) & 15, dir = chain & 1;
        const bf16_t* Yo = (const bf16_t*)(a.ws + WS_ARENA + (dir ? A_YR : A_YF)); const bf16_t* Yc = (const bf16_t*)(a.ws + WS_ARENA + (dir ? A_YCR : A_YCF));
        float md = 0.f, mo = 0.f;
        for (int i = tid; i < SEG * 8; i += NTHR) { const int r = i >> 3, seg = i & 7; const size_t off = (size_t)(b * SEG + r) * 1024 + hd * 64 + seg * 8;
            u32x4 wo, wc; const unsigned* po = (const unsigned*)(Yo + off); const unsigned* pc = (const unsigned*)(Yc + off);
#pragma unroll
            for (int q = 0; q < 4; ++q) { wo[q] = __hip_atomic_load(po + q, __ATOMIC_RELAXED, __HIP_MEMORY_SCOPE_AGENT); wc[q] = __hip_atomic_load(pc + q, __ATOMIC_RELAXED, __HIP_MEMORY_SCOPE_AGENT); }
            float yo[8], yc[8]; unpack8(wo, yo); unpack8(wc, yc);
#pragma unroll
            for (int e = 0; e < 8; ++e) { md = fmaxf(md, fabsf(yo[e] - yc[e])); mo = fmaxf(mo, fabsf(yo[e])); } }
#pragma unroll
        for (int o = 32; o >= 1; o >>= 1) { md = fmaxf(md, __shfl_xor(md, o)); mo = fmaxf(mo, __shfl_xor(mo, o)); }
        LAS float* red = (LAS float*)lds;
        if ((tid & 63) == 0) { red[(tid >> 6) * 2] = md; red[(tid >> 6) * 2 + 1] = mo; }
        __syncthreads();
        if (tid == 0) { float d = 0.f, o = 0.f; for (int w = 0; w < 8; ++w) { d = fmaxf(d, red[w * 2]); o = fmaxf(o, red[w * 2 + 1]); }
            if (!(d <= CS_TOL * o)) { bf16_t* Yw = (bf16_t*)(a.ws + WS_ARENA + (dir ? A_YR : A_YF)); Yw[(size_t)(b * SEG + CTX) * 1024 + hd * 64] = (bf16_t)0x7fc0u; } }
        __syncthreads();
    }
}

__device__ __forceinline__ void rwkv_outprep(const Args& a, int j, const bf16_t* Vsrc, const bool vres, int G, int c) {
    const int lane = ltid() & 63; int r0, r1; wave_rows(G, c, r0, r1);
    const bf16_t* YF = (const bf16_t*)(a.ws + WS_ARENA + A_YF); const bf16_t* YR = (const bf16_t*)(a.ws + WS_ARENA + A_YR);
    const bf16_t* RR = (const bf16_t*)(a.ws + WS_ARENA + A_RR); const bf16_t* RK = (const bf16_t*)(a.ws + WS_ARENA + A_RK);
    const bf16_t* AL0 = (const bf16_t*)(a.ws + WS_ARENA + A_AL0); const bf16_t* AL1 = (const bf16_t*)(a.ws + WS_ARENA + A_AL1); const bf16_t* GG = (const bf16_t*)(a.ws + WS_ARENA + A_G);
    bf16_t* O = (bf16_t*)(a.ws + WS_ARENA + A_RO);
    float lnw[16], lnb[16], rk[16], ka[16];
#pragma unroll
    for (int jj = 0; jj < 2; ++jj)
#pragma unroll
        for (int e = 0; e < 8; ++e) { const int col = jj * 512 + lane * 8 + e, i = jj * 8 + e; lnw[i] = a.in[I_LNW][j * D + col]; lnb[i] = a.in[I_LNB][j * D + col]; rk[i] = a.in[I_RK][j * D + col];
            ka[i] = a.in[I_KA][j * D + col]; }
    for (int row = r0; row < r1; ++row) {
        u32x4 out[2];
#pragma unroll
        for (int jj = 0; jj < 2; ++jj) { const size_t off = (size_t)row * 1024 + jj * 512 + lane * 8;
            float yf[8], yr[8], r[8], k[8], v[8], l0[8], l1[8], g[8], y[8];
            unpack8(*(const u32x4*)(YF + off), yf); unpack8(*(const u32x4*)(YR + off), yr); unpack8(*(const u32x4*)(RR + off), r); unpack8(*(const u32x4*)(RK + off), k);
            unpack8(*(const u32x4*)(Vsrc + off), v);
            if (vres) { float vf[8], vl[8]; unpack8(*(const u32x4*)((const bf16_t*)(a.ws + WS_VF) + off), vf); unpack8(*(const u32x4*)((const bf16_t*)(a.ws + WS_ARENA + A_VL) + off), vl);
#pragma unroll
                for (int e = 0; e < 8; ++e) v[e] = v[e] + (vf[e] - v[e]) * sigmoidf_(a.in[I_V0][jj * 512 + lane * 8 + e] + vl[e]); }
            unpack8(*(const u32x4*)(AL0 + off), l0); unpack8(*(const u32x4*)(AL1 + off), l1); unpack8(*(const u32x4*)(GG + off), g);
            float sm = 0.f, dot = 0.f;
#pragma unroll
            for (int e = 0; e < 8; ++e) { const int i = jj * 8 + e; y[e] = yf[e] + yr[e]; sm += y[e];
                const float adm = 0.5f * (l0[e] + l1[e]); const float kb = k[e] * (1.0f + (adm - 1.0f) * ka[i]); dot += r[e] * kb * rk[i]; }
            sm = red8(sm); dot = red8(dot); const float mu = sm * (1.0f / 64.0f); float var = 0.f;
#pragma unroll
            for (int e = 0; e < 8; ++e) { const float d = y[e] - mu; var += d * d; }
            var = red8(var) * (1.0f / 64.0f); const float rstd = 1.0f / sqrtf(var + LNX_EPS);
            float o[8];
#pragma unroll
            for (int e = 0; e < 8; ++e) { const int i = jj * 8 + e; o[e] = ((y[e] - mu) * rstd * lnw[i] + lnb[i] + dot * v[e]) * g[e]; }
            out[jj] = pack8(o); }
        *(u32x4*)(O + (size_t)row * 1024 + lane * 8) = out[0]; *(u32x4*)(O + (size_t)row * 1024 + 512 + lane * 8) = out[1];
    }
}

__device__ __forceinline__ void moe_gather(const Args& a, LAS unsigned char* lds, int G, int c) {
    const int tid = ltid(), wave = tid >> 6, lane = tid & 63; int r0, r1; wave_rows(G, c, r0, r1);
    LAS int* cnt = (LAS int*)lds;
    if (tid < 16) cnt[tid] = 0;
    __syncthreads();
    const int* hist = (const int*)(a.ws + WS_HIST); const int nchunk = G * NWAVE, first = c * NWAVE;
    int pre[8], tot[8];
#pragma unroll
    for (int e = 0; e < 8; ++e) { pre[e] = 0; tot[e] = 0; }
    for (int ch = tid; ch < nchunk; ch += NTHR) { const u32x4 h0 = *(const u32x4*)(hist + (size_t)ch * 8), h1 = *(const u32x4*)(hist + (size_t)ch * 8 + 4); const int m = ch < first ? 1 : 0;
        tot[0] += h0[0]; tot[1] += h0[1]; tot[2] += h0[2]; tot[3] += h0[3]; tot[4] += h1[0]; tot[5] += h1[1]; tot[6] += h1[2]; tot[7] += h1[3];
        pre[0] += m * h0[0]; pre[1] += m * h0[1]; pre[2] += m * h0[2]; pre[3] += m * h0[3]; pre[4] += m * h1[0]; pre[5] += m * h1[1]; pre[6] += m * h1[2]; pre[7] += m * h1[3]; }
#pragma unroll
    for (int e = 0; e < 8; ++e) { int p = pre[e], t = tot[e];
#pragma unroll
        for (int o = 32; o >= 1; o >>= 1) { p += __shfl_xor(p, o); t += __shfl_xor(t, o); }
        if (lane == 0) { __hip_atomic_fetch_add(&cnt[e], p, __ATOMIC_RELAXED, __HIP_MEMORY_SCOPE_WORKGROUP); __hip_atomic_fetch_add(&cnt[8 + e], t, __ATOMIC_RELAXED, __HIP_MEMORY_SCOPE_WORKGROUP); } }
    __syncthreads();
    int base[9], run[8]; base[0] = 0;
#pragma unroll
    for (int e = 0; e < 8; ++e) base[e + 1] = base[e] + ((cnt[8 + e] + 255) & ~255);
    if (c == 0 && tid < 9) { int v = 0;
#pragma unroll
        for (int e = 0; e < 9; ++e) v = (tid == e) ? base[e] : v;
        ((int*)(a.ws + WS_META))[tid] = v; }
#pragma unroll
    for (int e = 0; e < 8; ++e) { int p = cnt[e];
        for (int w = 0; w < wave; ++w) p += hist[(size_t)(first + w) * 8 + e];
        run[e] = base[e] + p; }
    const bf16_t* H = (const bf16_t*)(a.ws + WS_ARENA + A_H); bf16_t* HS = (bf16_t*)(a.ws + WS_ARENA + A_HS);
    for (int row = r0; row < r1; ++row) {
        const u32x4 rt = *(const u32x4*)(a.ws + WS_ROUTE + (size_t)row * 16); const int e0 = (int)rt[0], e1 = (int)rt[1];
        if (e0 < 0) continue;
        int s0 = 0, s1 = 0;
#pragma unroll
        for (int e = 0; e < 8; ++e) { if (e == e0) { s0 = run[e]; run[e] += 1; } if (e == e1) { s1 = run[e]; run[e] += 1; } }
        const u32x4 h0 = *(const u32x4*)(H + (size_t)row * 1024 + lane * 8), h1 = *(const u32x4*)(H + (size_t)row * 1024 + 512 + lane * 8);
        *(u32x4*)(HS + (size_t)s0 * 1024 + lane * 8) = h0; *(u32x4*)(HS + (size_t)s0 * 1024 + 512 + lane * 8) = h1;
        *(u32x4*)(HS + (size_t)s1 * 1024 + lane * 8) = h0; *(u32x4*)(HS + (size_t)s1 * 1024 + 512 + lane * 8) = h1;
        if (lane == 0) { int* sl = (int*)(a.ws + WS_RSLOT) + (size_t)row * 2; sl[0] = s0; sl[1] = s1; }
    }
}
__device__ __forceinline__ void final_combine(const Args& a, int layer, int G, int c) {
    const int lane = ltid() & 63; int r0, r1; wave_rows(G, c, r0, r1);
    for (int row = r0; row < r1; ++row) { if (row % SEG < CTX) continue;
        float* xp = xrow(a, row); float x[16]; load_x16(xp, lane, x); moe_combine16(a, row, layer, lane, x); store_x16(xp, lane, x); }
}

constexpr int NPH = 42;
#define CT(k) (((PSEL) >> (k)) & 1u)
#ifndef PROBE_MASK
#define PROBE_MASK 0u
#endif
#define REPS(k) for (int rep_ = 0; rep_ <= (int)(((PROBE_MASK) >> (k)) & 1u); ++rep_)
constexpr int LDS_ST_OFF = 161792;
constexpr int LDS_BYTES = LDS_ST_OFF + 64;
constexpr int TILE_OFF = 73728;
#define WSP(off) (a.ws + WS_ARENA + (off))
template <unsigned PSEL>
__global__ void __launch_bounds__(NTHR, 2) fwd(Args ka) {
    extern __shared__ __attribute__((aligned(16))) unsigned char lds_raw[];
    LAS unsigned char* lds = (LAS unsigned char*)lds_raw;
    const int Gk = gridDim.x, ck = blockIdx.x, tid = ltid();
    volatile LAS unsigned* st = (volatile LAS unsigned*)(lds + LDS_ST_OFF);
    if (tid < 4) st[tid] = 0u;
    __syncthreads();
    XcdBarrier bar; bar.bar = (unsigned*)(ka.ws + WS_CTL); bar.x = 0; bar.st = st;
    if (ka.ph_hi - ka.ph_lo > 1) bar = xcd_barrier_post((unsigned*)(ka.ws + WS_CTL), st);
#define IN(p) (ka.ph_lo <= (p) && (p) < ka.ph_hi)
#define PHB const Args a = launder_args(ka); const int G = launder_s(Gk), c = launder_s(ck); (void)G; (void)c;
#define SEAM(p) do { if (IN(p) && IN((p) + 1)) xcd_barrier(bar); } while (0)
    const size_t P1K = (size_t)256 * 1024 * 2;

    { const int jj_ = 0; const bool last_ = false;
    if (CT(20) && IN(0)) REPS(20) { PHB const bf16_t* wm = wmla(a, jj_); const bf16_t* wr_ = wrwkv(a, jj_); const bf16_t* wf = wffn(a, jj_); bf16_t* Vb = last_ ? (bf16_t*)WSP(A_RV) : (bf16_t*)(a.ws + WS_VF); (void)wm; (void)wr_; (void)wf; (void)Vb;
            { prologue_misc(a, lds, G, c); run_prep(a, lds + TILE_OFF, -1, 0, G, c); } }
    }
    SEAM(0);

    for (int jj = 0; jj < 2; ++jj) {
        const int pb = 1 + jj * 20, lm = 2 * jj, lr = 2 * jj + 1, jj_ = jj; const bool last = (jj == 1), last_ = last;

        if (CT(0) && IN(pb + 0)) REPS(0) { PHB const bf16_t* wm = wmla(a, jj_); const bf16_t* wr_ = wrwkv(a, jj_); const bf16_t* wf = wffn(a, jj_); bf16_t* Vb = last_ ? (bf16_t*)WSP(A_RV) : (bf16_t*)(a.ws + WS_VF); (void)wm; (void)wr_; (void)wf; (void)Vb;
            { if (jj == 0) norm_plain<false, true>(a, lm, a.in[I_N1G] + lm * D, 0, (bf16_t*)WSP(A_H), G, c); else norm_plain<true>(a, lm, a.in[I_N1G] + lm * D, 0, (bf16_t*)WSP(A_H), G, c); } }
        SEAM(pb + 0);
        if (CT(1) && IN(pb + 1)) REPS(1) { PHB const bf16_t* wm = wmla(a, jj_); const bf16_t* wr_ = wrwkv(a, jj_); const bf16_t* wf = wffn(a, jj_); bf16_t* Vb = last_ ? (bf16_t*)WSP(A_RV) : (bf16_t*)(a.ws + WS_VF); (void)wm; (void)wr_; (void)wf; (void)Vb;
            { MapSimple S{(const char*)WSP(A_H), (const char*)wm, P1K, P1K, 3, 16, 0}; EpiBf<FPlain> E{{(bf16_t*)WSP(A_QKVA), 768}};
            pg8::gemm_phase(lds, 1024, 1024, S, E, G, c); } }
        SEAM(pb + 1);
        if (CT(2) && IN(pb + 2)) REPS(2) { PHB const bf16_t* wm = wmla(a, jj_); const bf16_t* wr_ = wrwkv(a, jj_); const bf16_t* wf = wffn(a, jj_); bf16_t* Vb = last_ ? (bf16_t*)WSP(A_RV) : (bf16_t*)(a.ws + WS_VF); (void)wm; (void)wr_; (void)wf; (void)Vb;
            mla_stats(a, G, c); }
        SEAM(pb + 2);
        if (CT(3) && IN(pb + 3)) REPS(3) { PHB const bf16_t* wm = wmla(a, jj_); const bf16_t* wr_ = wrwkv(a, jj_); const bf16_t* wf = wffn(a, jj_); bf16_t* Vb = last_ ? (bf16_t*)WSP(A_RV) : (bf16_t*)(a.ws + WS_VF); (void)wm; (void)wr_; (void)wf; (void)Vb;
            { MapQKV S{(const char*)WSP(A_QKVA), (const char*)(wm + E_QKVA), (const char*)(wm + E_QKVA + E_QB)};
            EpiQKV E{(bf16_t*)WSP(A_Q), (bf16_t*)WSP(A_KV), (const float*)(a.ws + WS_RS), (const float*)(a.ws + WS_RS) + R};
            pg8::gemm_phase(lds, 768, 384, S, E, G, c); } }
        SEAM(pb + 3);
        if (CT(4) && IN(pb + 4)) REPS(4) { PHB const bf16_t* wm = wmla(a, jj_); const bf16_t* wr_ = wrwkv(a, jj_); const bf16_t* wf = wffn(a, jj_); bf16_t* Vb = last_ ? (bf16_t*)WSP(A_RV) : (bf16_t*)(a.ws + WS_VF); (void)wm; (void)wr_; (void)wf; (void)Vb;
            mla_qkpost(a, jj, G, c); }
        SEAM(pb + 4);
        if (CT(5) && IN(pb + 5)) REPS(5) { PHB const bf16_t* wm = wmla(a, jj_); const bf16_t* wr_ = wrwkv(a, jj_); const bf16_t* wf = wffn(a, jj_); bf16_t* Vb = last_ ? (bf16_t*)WSP(A_RV) : (bf16_t*)(a.ws + WS_VF); (void)wm; (void)wr_; (void)wf; (void)Vb;
            attn_phase(a, lds, G, c); }
        SEAM(pb + 5);
        if (CT(6) && IN(pb + 6)) REPS(6) { PHB const bf16_t* wm = wmla(a, jj_); const bf16_t* wr_ = wrwkv(a, jj_); const bf16_t* wf = wffn(a, jj_); bf16_t* Vb = last_ ? (bf16_t*)WSP(A_RV) : (bf16_t*)(a.ws + WS_VF); (void)wm; (void)wr_; (void)wf; (void)Vb;
            { MapSimple S{(const char*)WSP(A_O), (const char*)(wm + E_QKVA + E_QB + E_KVB), P1K, P1K, 4, 16, 0}; EpiResid E{(float*)(a.ws + WS_CS), a.out, (const float*)(a.ws + WS_MODS), lm, 2, jj == 0 ? a.in[I_CTX] : (const float*)(a.ws + WS_CS), jj == 0 ? a.in[I_X] : (const float*)a.out};
            pg8::gemm_phase(lds, 1024, 1024, S, E, G, c); } }
        SEAM(pb + 6);
        if (CT(7) && IN(pb + 7)) REPS(7) { PHB const bf16_t* wm = wmla(a, jj_); const bf16_t* wr_ = wrwkv(a, jj_); const bf16_t* wf = wffn(a, jj_); bf16_t* Vb = last_ ? (bf16_t*)WSP(A_RV) : (bf16_t*)(a.ws + WS_VF); (void)wm; (void)wr_; (void)wf; (void)Vb;
            norm_plain<false>(a, lm, a.in[I_N2G] + lm * D, 3, (bf16_t*)WSP(A_H), G, c); }
        SEAM(pb + 7);
        if (CT(8) && IN(pb + 8)) REPS(8) { PHB const bf16_t* wm = wmla(a, jj_); const bf16_t* wr_ = wrwkv(a, jj_); const bf16_t* wf = wffn(a, jj_); bf16_t* Vb = last_ ? (bf16_t*)WSP(A_RV) : (bf16_t*)(a.ws + WS_VF); (void)wm; (void)wr_; (void)wf; (void)Vb;
            { MapSimple S{(const char*)WSP(A_H), (const char*)wf, P1K, P1K, 22, 16, 0}; EpiSwiGLU E{(bf16_t*)WSP(A_FHID), DFF};
            pg8::gemm_phase(lds, 1024, 1024, S, E, G, c); } }
        SEAM(pb + 8);
        if (CT(9) && IN(pb + 9)) REPS(9) { PHB const bf16_t* wm = wmla(a, jj_); const bf16_t* wr_ = wrwkv(a, jj_); const bf16_t* wf = wffn(a, jj_); bf16_t* Vb = last_ ? (bf16_t*)WSP(A_RV) : (bf16_t*)(a.ws + WS_VF); (void)wm; (void)wr_; (void)wf; (void)Vb;
            { MapSimple S{(const char*)WSP(A_FHID), (const char*)(wf + E_F13), (size_t)256 * DFF * 2, (size_t)256 * DFF * 2, 4, 44, 0}; EpiResid E{(float*)(a.ws + WS_CS), a.out, (const float*)(a.ws + WS_MODS), lm, 5, (const float*)(a.ws + WS_CS), (const float*)a.out};
            pg8::gemm_phase(lds, DFF, DFF, S, E, G, c); } }
        SEAM(pb + 9);
        if (CT(10) && IN(pb + 10)) REPS(10) { PHB const bf16_t* wm = wmla(a, jj_); const bf16_t* wr_ = wrwkv(a, jj_); const bf16_t* wf = wffn(a, jj_); bf16_t* Vb = last_ ? (bf16_t*)WSP(A_RV) : (bf16_t*)(a.ws + WS_VF); (void)wm; (void)wr_; (void)wf; (void)Vb;
            norm_mix(a, lr, jj, G, c); }
        SEAM(pb + 10);
        if (CT(11) && IN(pb + 11)) REPS(11) { PHB const bf16_t* wm = wmla(a, jj_); const bf16_t* wr_ = wrwkv(a, jj_); const bf16_t* wf = wffn(a, jj_); bf16_t* Vb = last_ ? (bf16_t*)WSP(A_RV) : (bf16_t*)(a.ws + WS_VF); (void)wm; (void)wr_; (void)wf; (void)Vb;
            { MapRw1 S{(const char*)WSP(A_AX), (const char*)wr_, (const char*)(wr_ + E_B1), (const char*)(wr_ + E_B1 + E_B2)};
            EpiBf<FRw1> E{{(bf16_t*)WSP(A_L1), (bf16_t*)WSP(A_RR), (bf16_t*)WSP(A_RK), Vb}};
            pg8::gemm_phase(lds, 5120, 2048, S, E, G, c); } }
        SEAM(pb + 11);
        if (CT(12) && IN(pb + 12)) REPS(12) { PHB const bf16_t* wm = wmla(a, jj_); const bf16_t* wr_ = wrwkv(a, jj_); const bf16_t* wf = wffn(a, jj_); bf16_t* Vb = last_ ? (bf16_t*)WSP(A_RV) : (bf16_t*)(a.ws + WS_VF); (void)wm; (void)wr_; (void)wf; (void)Vb;
            { int nt4 = 4; asm volatile("" : "+s"(nt4));
            MapRw2 S{(const char*)WSP(A_L1), (const char*)(wr_ + E_B1 + E_B2 + E_L1), (const char*)(wr_ + E_B1 + E_B2 + E_L1 + E_L2A), 0, last ? 24 : 20, nt4};
            EpiRw2 E{(bf16_t*)WSP(A_WL0), (bf16_t*)WSP(A_VL), a.in[I_W0] + (size_t)jj * 2 * D, a.in[I_A0] + (size_t)jj * 2 * D}; pg8::gemm_phase(lds, 512, 256, S, E, G, c); } }
        SEAM(pb + 12);
        if (CT(13) && IN(pb + 13)) REPS(13) { PHB const bf16_t* wm = wmla(a, jj_); const bf16_t* wr_ = wrwkv(a, jj_); const bf16_t* wf = wffn(a, jj_); bf16_t* Vb = last_ ? (bf16_t*)WSP(A_RV) : (bf16_t*)(a.ws + WS_VF); (void)wm; (void)wr_; (void)wf; (void)Vb;
            { if (SCAN_CHUNKED) scan_chunked(a, jj, Vb, last, lds, G, c); if (!SCAN_CHUNKED || CS_BOTH) { __syncthreads(); scan_phase(a, jj, Vb, last, lds, G, c); }
              if (SCAN_CHUNKED && CS_BOTH) scan_compare(a, lds, G, c); } }
        SEAM(pb + 13);
        if (CT(14) && IN(pb + 14)) REPS(14) { PHB const bf16_t* wm = wmla(a, jj_); const bf16_t* wr_ = wrwkv(a, jj_); const bf16_t* wf = wffn(a, jj_); bf16_t* Vb = last_ ? (bf16_t*)WSP(A_RV) : (bf16_t*)(a.ws + WS_VF); (void)wm; (void)wr_; (void)wf; (void)Vb;
            rwkv_outprep(a, jj, Vb, last, G, c); }
        SEAM(pb + 14);
        if (CT(15) && IN(pb + 15)) REPS(15) { PHB const bf16_t* wm = wmla(a, jj_); const bf16_t* wr_ = wrwkv(a, jj_); const bf16_t* wf = wffn(a, jj_); bf16_t* Vb = last_ ? (bf16_t*)WSP(A_RV) : (bf16_t*)(a.ws + WS_VF); (void)wm; (void)wr_; (void)wf; (void)Vb;
            { MapSimple S{(const char*)WSP(A_RO), (const char*)(wr_ + E_B1 + 1024), P1K, (size_t)256 * 2048 * 2, 4, 16, last ? 1 : 0}; EpiResid E{(float*)(a.ws + WS_CS), a.out, (const float*)(a.ws + WS_MODS), lr, 2, (const float*)(a.ws + WS_CS), (const float*)a.out};
            pg8::gemm_phase(lds, 1024, 2048, S, E, G, c); } }
        SEAM(pb + 15);
        if (CT(16) && IN(pb + 16)) REPS(16) { PHB const bf16_t* wm = wmla(a, jj_); const bf16_t* wr_ = wrwkv(a, jj_); const bf16_t* wf = wffn(a, jj_); bf16_t* Vb = last_ ? (bf16_t*)WSP(A_RV) : (bf16_t*)(a.ws + WS_VF); (void)wm; (void)wr_; (void)wf; (void)Vb;
            { norm_router(a, lr, jj, last, lds, G, c); run_prep(a, lds + TILE_OFF, jj, CS_NOTILE ? 0 : (SCAN_CHUNKED ? cs::NCK - 1 : scan::NCH - 2), G, c);   } }
        SEAM(pb + 16);
        if (CT(17) && IN(pb + 17)) REPS(17) { PHB const bf16_t* wm = wmla(a, jj_); const bf16_t* wr_ = wrwkv(a, jj_); const bf16_t* wf = wffn(a, jj_); bf16_t* Vb = last_ ? (bf16_t*)WSP(A_RV) : (bf16_t*)(a.ws + WS_VF); (void)wm; (void)wr_; (void)wf; (void)Vb;
            moe_gather(a, lds, G, c); }
        SEAM(pb + 17);
        if (CT(18) && IN(pb + 18)) REPS(18) { PHB const bf16_t* wm = wmla(a, jj_); const bf16_t* wr_ = wrwkv(a, jj_); const bf16_t* wf = wffn(a, jj_); bf16_t* Vb = last_ ? (bf16_t*)WSP(A_RV) : (bf16_t*)(a.ws + WS_VF); (void)wm; (void)wr_; (void)wf; (void)Vb;
            { MapMoe S{(const char*)WSP(A_HS), (const char*)WSP(A_WM13), P1K, E_M13 * 2, P1K, 28, 16, (const int*)(a.ws + WS_META)}; EpiSwiGLU E{(bf16_t*)WSP(A_MHID), DFE};
            pg8::gemm_phase(lds, 1024, 1024, S, E, G, c); } }
        SEAM(pb + 18);
        if (CT(19) && IN(pb + 19)) REPS(19) { PHB const bf16_t* wm = wmla(a, jj_); const bf16_t* wr_ = wrwkv(a, jj_); const bf16_t* wf = wffn(a, jj_); bf16_t* Vb = last_ ? (bf16_t*)WSP(A_RV) : (bf16_t*)(a.ws + WS_VF); (void)wm; (void)wr_; (void)wf; (void)Vb;
            { MapMoe S{(const char*)WSP(A_MHID), (const char*)WSP(A_WM2), (size_t)256 * DFE * 2, E_M2 * 2, (size_t)256 * DFE * 2, 4, 56, (const int*)(a.ws + WS_META)}; EpiBf<FPlain> E{{(bf16_t*)WSP(A_Y2), 1024}};
            pg8::gemm_phase(lds, DFE, DFE, S, E, G, c); } }
        SEAM(pb + 19);
    }
    { const int jj_ = 1; const bool last_ = true;
    if (CT(21) && IN(41)) REPS(21) { PHB const bf16_t* wm = wmla(a, jj_); const bf16_t* wr_ = wrwkv(a, jj_); const bf16_t* wf = wffn(a, jj_); bf16_t* Vb = last_ ? (bf16_t*)WSP(A_RV) : (bf16_t*)(a.ws + WS_VF); (void)wm; (void)wr_; (void)wf; (void)Vb;
            final_combine(a, 3, G, c); }
    }
#undef IN
#undef SEAM
}

typedef void (*KernFn)(Args);
#if MK_ONE_LAUNCH
#ifndef PMASK
#define PMASK 0x3fffffu
#endif
static KernFn kern_of(int) { return fwd<PMASK>; }
#else
static KernFn kern_of(int p) {
    static const KernFn tab[22] = { fwd<1u << 0>, fwd<1u << 1>, fwd<1u << 2>, fwd<1u << 3>, fwd<1u << 4>, fwd<1u << 5>, fwd<1u << 6>, fwd<1u << 7>, fwd<1u << 8>, fwd<1u << 9>, fwd<1u << 10>, fwd<1u << 11>, fwd<1u << 12>, fwd<1u << 13>, fwd<1u << 14>, fwd<1u << 15>, fwd<1u << 16>, fwd<1u << 17>, fwd<1u << 18>, fwd<1u << 19>, fwd<1u << 20>, fwd<1u << 21> };
    return tab[p == 0 ? 20 : (p == NPH - 1 ? 21 : (p - 1) % 20)];
}
#endif
extern "C" void kernel_launch(void* const* d_in, const int* in_sizes, int n_in, void* d_out, int out_size, void* d_ws, size_t ws_size, hipStream_t stream) {
    static int grid = 0;
    if (grid == 0) {
        if (n_in != N_IN || out_size != NB * SEQ * D || ws_size < WS_NEED) { fprintf(stderr, "kernel_launch: unexpected shapes: n_in %d out %d ws %zu (need %zu)\n", n_in, out_size, ws_size, (size_t)WS_NEED); grid = -1; return; }
        int dev = 0, cus = 0;
        if (hipGetDevice(&dev) != hipSuccess || hipDeviceGetAttribute(&cus, hipDeviceAttributeMultiprocessorCount, dev) != hipSuccess) { grid = -1; return; }
        for (int p = 0; p < NPH; ++p)
            if (hipFuncSetAttribute((const void*)kern_of(p), hipFuncAttributeMaxDynamicSharedMemorySize, LDS_BYTES) != hipSuccess) { fprintf(stderr, "kernel_launch: hipFuncSetAttribute failed\n"); grid = -1; return; }
        int per_cu = 0;
        if (hipOccupancyMaxActiveBlocksPerMultiprocessor(&per_cu, (const void*)kern_of(1), NTHR, LDS_BYTES) != hipSuccess || per_cu < 1) { fprintf(stderr, "kernel_launch: occupancy query says %d blocks per CU\n", per_cu); (void)hipGetLastError(); }
        grid = cus < 256 ? cus : 256;
    }
    if (grid < 0) return;
    (void)in_sizes;
    (void)hipMemsetAsync((char*)d_ws + WS_CTL, 0, CTL_BYTES, stream);
    Args a{};
    for (int i = 0; i < N_IN; ++i) a.in[i] = (const float*)d_in[i];
    a.out = (float*)d_out; a.ws = (unsigned char*)d_ws;
#if MK_ONE_LAUNCH
    a.ph_lo = 0; a.ph_hi = NPH;
    hipLaunchKernelGGL(kern_of(0), dim3(grid), dim3(NTHR), LDS_BYTES, stream, a);
#else
    for (int p = 0; p < NPH; ++p) { a.ph_lo = p; a.ph_hi = p + 1; hipLaunchKernelGGL(kern_of(p), dim3(grid), dim3(NTHR), LDS_BYTES, stream, a); }
#endif
    const hipError_t le = hipPeekAtLastError();
    if (le != hipSuccess) fprintf(stderr, "kernel_launch: launch failed: %s\n", hipGetErrorName(le));
}
```

```cpp
#include <hip/hip_runtime.h>
#include <cstdio>
#include <cstdint>
#ifndef SCAN_CHUNKED
#define SCAN_CHUNKED 1
#endif
#ifndef CS_SERIAL
#define CS_SERIAL 0
#endif
#ifndef CS_BOTH
#define CS_BOTH 0
#endif
#ifndef CS_NOTILE
#define CS_NOTILE 0
#endif
#ifndef CS_OOP
#define CS_OOP 0
#endif
#ifndef CS_TOL
#define CS_TOL 0.05f
#endif

#ifndef MK_ONE_LAUNCH
#define MK_ONE_LAUNCH 1
#endif

#define LAS __attribute__((address_space(3)))
typedef unsigned short bf16_t;
typedef short bf16x8 __attribute__((ext_vector_type(8)));
typedef short s16x4 __attribute__((ext_vector_type(4)));
typedef float f32x2 __attribute__((ext_vector_type(2)));
typedef float f32x4 __attribute__((ext_vector_type(4)));
typedef float f32x16 __attribute__((ext_vector_type(16)));
typedef unsigned u32x2 __attribute__((ext_vector_type(2)));
typedef unsigned u32x4 __attribute__((ext_vector_type(4)));

constexpr int D = 1024, NB = 8, SEQ = 4096, CTX = 256, SEG = SEQ + CTX, R = NB * SEG;
constexpr int NPAN = R / 256;
constexpr int NTHR = 512, NWAVE = 8;
constexpr int QL = 384, KVL = 256, ROPE = 64, NOPE = 128, QKH = 192, VH = 128, NH = 8;
constexpr int DFF = 2816, NE = 8, DFE = 3584;
constexpr int MP_MAX = 71680;
constexpr float NORM_EPS = 1e-6f, LNX_EPS = 64e-5f;
constexpr float QSCALE = 0.07216878364870322f * 1.4426950408889634f;

enum { I_X = 0, I_C, I_CTX, I_CCTX, I_ADAW, I_ADAB, I_N1G, I_N2G, I_WQA, I_QAN, I_WQB, I_WKVA, I_KVAN, I_WKVB, I_QN, I_KN, I_MWO,
       I_MIX, I_WR, I_WK, I_WV, I_RWO, I_W0, I_W1, I_W2, I_A0, I_A1, I_A2, I_G1, I_G2, I_KK, I_KA, I_RK, I_LNW, I_LNB, I_V0, I_V1, I_V2,
       I_F1, I_F3, I_F2, I_ROUTER, I_M1, I_M3, I_M2, N_IN };

constexpr size_t U = (size_t)R * 1024 * 2;
constexpr size_t al256(size_t x) { return (x + 255) / 256 * 256; }
constexpr size_t WS_CTL = 0;
constexpr size_t CTL_BYTES = 65536;
constexpr size_t WS_MODS = WS_CTL + CTL_BYTES;
constexpr size_t WS_ROPE = WS_MODS + al256((size_t)4 * 9 * 6144 * 4);
constexpr size_t WS_CS = WS_ROPE + 8192;
constexpr size_t WS_RS = WS_CS + (size_t)NB * CTX * D * 4;
constexpr size_t WS_ROUTE = WS_RS + al256((size_t)R * 8);
constexpr size_t WS_RSLOT = WS_ROUTE + (size_t)R * 16;
constexpr size_t WS_HIST = WS_RSLOT + (size_t)R * 8;
constexpr size_t WS_META = WS_HIST + 2048 * 8 * 4;
constexpr size_t WS_WSM = WS_META + 256;
constexpr size_t E_QKVA = 768 * 1024, E_QB = 1536 * 384, E_KVB = 2048 * 384, E_MWO = 1024 * 1024, E_MLA = E_QKVA + E_QB + E_KVB + E_MWO;
constexpr size_t E_B1 = 1024 * 2048, E_B2 = 1024 * 2048, E_L1 = 512 * 2048, E_L2A = 4096 * 256, E_L2B = 2048 * 256, E_RWKV = E_B1 + E_B2 + E_L1 + E_L2A + E_L2B;
constexpr size_t E_F13 = 5632 * 1024, E_F2 = 1024 * 2816, E_FFN = E_F13 + E_F2;
constexpr size_t WS_WMLA = WS_WSM, WS_WRWKV = WS_WMLA + 2 * E_MLA * 2, WS_WFFN = WS_WRWKV + 2 * E_RWKV * 2;
constexpr size_t WS_VF = WS_WFFN + 2 * E_FFN * 2;
constexpr size_t WS_ARENA = WS_VF + U;
constexpr size_t A_H = 0;
constexpr size_t A_QKVA = U, A_Q = 2 * U, A_KV = 2 * U + U * 3 / 2, A_K = A_KV + 2 * U, A_O = A_K + U * 3 / 2;
constexpr size_t A_FHID = U;
constexpr size_t A_AX = 0, A_L1 = 5 * U, A_RR = A_L1 + U / 2, A_RK = A_RR + U, A_RV = A_RK + U, A_VL = A_RV + U, A_REND = A_VL + U;
constexpr size_t A_WL0 = 0, A_WL1 = U, A_AL0 = 2 * U, A_AL1 = 3 * U, A_G = 4 * U, A_RO = 0;
constexpr size_t A_YF = (SCAN_CHUNKED && CS_OOP && !CS_BOTH) ? A_REND : A_WL0, A_YR = (SCAN_CHUNKED && CS_OOP && !CS_BOTH) ? A_REND + U : A_WL1;
constexpr size_t A_YCF = CS_BOTH ? A_REND : A_YF, A_YCR = CS_BOTH ? A_REND + U : A_YR;
constexpr size_t A_HS = U, A_Y2 = U, A_MHID = A_HS + (size_t)MP_MAX * 1024 * 2, A_MEND = A_MHID + (size_t)MP_MAX * DFE * 2;
constexpr size_t E_M13 = (size_t)7168 * 1024, E_M2 = (size_t)1024 * 3584;
constexpr size_t A_WM13 = A_MEND, A_WM2 = A_WM13 + NE * E_M13 * 2, A_END = A_WM2 + NE * E_M2 * 2;
constexpr size_t WS_NEED = WS_ARENA + (A_END > A_REND ? A_END : A_REND);
static_assert(WS_NEED <= 1081188352ull, "workspace budget (sum of inputs)");
static_assert(CS_OOP || CS_BOTH || A_WM13 >= A_REND, "the MoE weight region must be free during the RWKV mixer (weights are converted inside the scan phase)");

struct Args { const float* in[N_IN]; float* out; unsigned char* ws; int ph_lo, ph_hi; };

__device__ __forceinline__ unsigned cvt_pk_bf16(float lo, float hi) { unsigned r; asm("v_cvt_pk_bf16_f32 %0, %1, %2" : "=v"(r) : "v"(lo), "v"(hi)); return r; }
__device__ __forceinline__ float bflo(unsigned w) { return __uint_as_float(w << 16); }
__device__ __forceinline__ float bfhi(unsigned w) { return __uint_as_float(w & 0xffff0000u); }
__device__ __forceinline__ void unpack8(const u32x4 w, float (&f)[8]) { f[0] = bflo(w.x); f[1] = bfhi(w.x); f[2] = bflo(w.y); f[3] = bfhi(w.y); f[4] = bflo(w.z); f[5] = bfhi(w.z); f[6] = bflo(w.w); f[7] = bfhi(w.w); }
__device__ __forceinline__ u32x4 pack8(const float (&f)[8]) { u32x4 w; w.x = cvt_pk_bf16(f[0], f[1]); w.y = cvt_pk_bf16(f[2], f[3]); w.z = cvt_pk_bf16(f[4], f[5]); w.w = cvt_pk_bf16(f[6], f[7]); return w; }
__device__ __forceinline__ float wave_sum(float v) {
#pragma unroll
    for (int o = 32; o >= 1; o >>= 1) v += __shfl_xor(v, o);
    return v;
}
template <int CTRL> __device__ __forceinline__ float dpp_f(float v) { return __int_as_float(__builtin_amdgcn_update_dpp(0, __float_as_int(v), CTRL, 0xF, 0xF, true)); }
__device__ __forceinline__ float red8(float v) { v += dpp_f<0xB1>(v); v += dpp_f<0x4E>(v); v += dpp_f<0x141>(v); return v; }
__device__ __forceinline__ int ltid() { int t = threadIdx.x; asm volatile("" : "+v"(t)); return t; }
template <class T> __device__ __forceinline__ T launder_s(T x) { asm volatile("" : "+s"(x)); return x; }
__device__ __forceinline__ Args launder_args(const Args& k) { Args a = k; a.ws = launder_s(k.ws); a.out = launder_s(k.out); return a; }
__device__ __forceinline__ float wave_sum_dpp(float v) {
    v += dpp_f<0xB1>(v); v += dpp_f<0x4E>(v); v += dpp_f<0x141>(v); v += dpp_f<0x140>(v);
    const int iv = __float_as_int(v);
    return (__int_as_float(__builtin_amdgcn_readlane(iv, 0)) + __int_as_float(__builtin_amdgcn_readlane(iv, 16))) + (__int_as_float(__builtin_amdgcn_readlane(iv, 32)) + __int_as_float(__builtin_amdgcn_readlane(iv, 48)));
}
__device__ __forceinline__ float sigmoidf_(float x) { return __builtin_amdgcn_rcpf(1.0f + __expf(-x)); }
__device__ __forceinline__ float* xrow(const Args& a, int row) {
    const int b = row / SEG, r = row - b * SEG;
    return r < CTX ? (float*)(a.ws + WS_CS) + (size_t)(b * CTX + r) * D : a.out + (size_t)(b * SEQ + r - CTX) * D;
}
__device__ __forceinline__ const float* xrow_in(const Args& a, int row) {
    const int b = row / SEG, r = row - b * SEG;
    return r < CTX ? a.in[I_CTX] + (size_t)(b * CTX + r) * D : a.in[I_X] + (size_t)(b * SEQ + r - CTX) * D;
}
__device__ __forceinline__ int mod_index(int row) { const int b = row / SEG, r = row - b * SEG; return r < CTX ? 8 : b; }
__device__ __forceinline__ const float* mods_ptr(const Args& a, int layer, int mi, int which) { return (const float*)(a.ws + WS_MODS) + ((size_t)(layer * 9 + mi) * 6 + which) * 1024; }

#define XB_TMO      128
#define XB_XCNT(j)  (256  + 64 * (j))
#define XB_XSUB(j)  (1280 + 64 * (j))
#define XB_XGEN(j)  (2304 + 64 * (j))
#define XB_TOP      3328
#define XB_TOPGEN   3392
#define XCD_BAR_WORDS 3456
#define XB_SPIN_CAP (1u << 22)
__device__ __forceinline__ unsigned xb_ld(unsigned* p)              { return __hip_atomic_load(p, __ATOMIC_RELAXED, __HIP_MEMORY_SCOPE_AGENT); }
__device__ __forceinline__ unsigned xb_add(unsigned* p, unsigned v) { return __hip_atomic_fetch_add(p, v, __ATOMIC_RELAXED, __HIP_MEMORY_SCOPE_AGENT); }
__device__ __forceinline__ unsigned xb_xcc_id() { return (unsigned)__builtin_amdgcn_s_getreg((3 << 11) | 20) & 0xFu; }
#define XB_SPIN(cond, bar) do { unsigned _sp = 0; while (cond) { __builtin_amdgcn_s_sleep(1); \
    if ((++_sp & 255u) == 0u) { if (xb_ld(&(bar)[XB_TMO])) break; if (_sp > XB_SPIN_CAP) { atomicAdd(&(bar)[XB_TMO], 1u); break; } } } } while (0)
struct XcdBarrier { unsigned* bar; unsigned x; volatile LAS unsigned* st; };
__device__ __forceinline__ XcdBarrier xcd_barrier_post(unsigned* bar, volatile LAS unsigned* st) {
    XcdBarrier b; b.bar = bar; b.x = xb_xcc_id(); b.st = st;
    if (threadIdx.x == 0) (void)xb_add(&bar[XB_XCNT(b.x)], 1u);
    return b;
}
__device__ __forceinline__ void xcd_barrier_complete(unsigned* bar, unsigned x, unsigned& nloc, unsigned& nx) {
    const unsigned G = gridDim.x * gridDim.y * gridDim.z;
    unsigned sum, cnt, mine, sp = 0u;
    for (;;) {
        sum = 0u; cnt = 0u; mine = 0u;
#pragma unroll
        for (unsigned j = 0; j < 16; ++j) { const unsigned c = xb_ld(&bar[XB_XCNT(j)]); sum += c; cnt += (c > 0u) ? 1u : 0u; mine = (j == x) ? c : mine; }
        if (sum == G) break;
        __builtin_amdgcn_s_sleep(1);
        if ((++sp & 255u) == 0u) { if (xb_ld(&bar[XB_TMO])) break; if (sp > XB_SPIN_CAP) { atomicAdd(&bar[XB_TMO], 1u); break; } }
    }
    nloc = mine > 0u ? mine : 1u; nx = cnt > 0u ? cnt : 1u;
}
__device__ __forceinline__ void xcd_barrier(const XcdBarrier& b) {
    asm volatile("s_waitcnt vmcnt(0)" ::: "memory");
    __syncthreads();
    if (threadIdx.x == 0) {
        unsigned* bar = b.bar;
        __builtin_amdgcn_s_waitcnt(0);
        unsigned nloc = b.st[0], nx = b.st[1];
        if (nloc == 0u) { xcd_barrier_complete(bar, b.x, nloc, nx); b.st[0] = nloc; b.st[1] = nx; }
        const unsigned old = xb_add(&bar[XB_XSUB(b.x)], 1u);
        const unsigned gen = old / nloc;
        if (old + 1u == (gen + 1u) * nloc) {
            __builtin_amdgcn_fence(__ATOMIC_RELEASE, "agent");
            asm volatile("s_waitcnt vmcnt(0)" ::: "memory");
            const unsigned og = xb_add(&bar[XB_TOP], 1u);
            const unsigned tg = og / nx;
            if (og + 1u == (tg + 1u) * nx) xb_add(&bar[XB_TOPGEN], 1u);
            else XB_SPIN(xb_ld(&bar[XB_TOPGEN]) == tg, bar);
            __builtin_amdgcn_fence(__ATOMIC_ACQUIRE, "agent");
            xb_add(&bar[XB_XGEN(b.x)], 1u);
            asm volatile("s_waitcnt vmcnt(0)" ::: "memory");
        } else {
            XB_SPIN(xb_ld(&bar[XB_XGEN(b.x)]) == gen, bar);
            __builtin_amdgcn_fence(__ATOMIC_ACQUIRE, "agent");
            asm volatile("s_waitcnt vmcnt(0)" ::: "memory");
        }
    }
    __syncthreads();
}

namespace pg8 {
constexpr int BM = 256, BK = 64, HALF = 128, HTB = HALF * BK * 2, STAGE_BYTES = 8 * HTB;
__device__ __forceinline__ int lds_byte(int r, int c) { const int st = (r >> 4) * 2 + (c >> 5), rr = r & 15, cc = c & 31, ob = rr * 64 + cc * 2; return st * 1024 + (ob ^ (((ob >> 9) & 1) << 5)); }
__device__ __forceinline__ void stage_rc(int b, int& Rr, int& C) { const int st = b / 1024, sb = b % 1024, swz = sb ^ (((sb >> 9) & 1) << 5); Rr = (st >> 1) * 16 + swz / 64; C = (st & 1) * 32 + (swz % 64) / 2; }
__device__ __forceinline__ int perm32(int rho) { const int n = rho >> 4, i = rho & 15; return 8 * (i >> 2) + 4 * n + (i & 3); }
struct GUnit { const char* A; const char* B; int nt, pm, pn, aux; };
__device__ __forceinline__ void tile_order(int L, int nM, int nN, int& pm, int& pn) {
    const int nwg = nM * nN; int wgid = L;
    { const int q = nwg / 8, r = nwg % 8, xcd = wgid % 8, off = wgid / 8; wgid = (xcd < r ? xcd * (q + 1) : r * (q + 1) + (xcd - r) * q) + off; }
    const int nig = 8 * nN, gid = wgid / nig, fm = gid * 8, gsz = (nM - fm) < 8 ? (nM - fm) : 8;
    pm = fm + ((wgid % nig) % gsz); pn = (wgid % nig) / gsz;
}
template <class Epi, class Map>
__device__ __forceinline__ void gemm_phase(LAS unsigned char* lds, const int lda, const int ldb, const Map& S, const Epi& E, const int G, const int c) {
    const int tid = ltid(), wid = __builtin_amdgcn_readfirstlane(tid >> 6), lane = tid & 63, wr = wid >> 2, wc = wid & 3, fr = lane & 15, fq = lane >> 4;
    unsigned voffA[2], voffB[2];
#pragma unroll
    for (int i = 0; i < 2; ++i) { int Rr, C; stage_rc(tid * 16 + i * 8192, Rr, C); const int Rb = Epi::PERM ? ((Rr & ~31) + perm32(Rr & 31)) : Rr;
        voffA[i] = (unsigned)(Rr * lda + C) * 2u; voffB[i] = (unsigned)(Rb * ldb + C) * 2u; }
    const size_t kstep = (size_t)(BK * 2);
    const size_t hA = (size_t)HALF * lda * 2, hB = (size_t)HALF * ldb * 2;
    const unsigned ldsw = (unsigned)wid * 1024u;
    const int aoff = lds_byte(wr * 64 + fr, fq * 8), boff = lds_byte(wc * 32 + fr, fq * 8);
#define PG8_SA(b, h) (((b) * 2 + (h)) * HTB)
#define PG8_SB(b, h) ((4 + (b) * 2 + (h)) * HTB)
#define PG8_STAGE(bufoff, gbase, voff) do { _Pragma("unroll") for (int _i = 0; _i < 2; ++_i) \
        __builtin_amdgcn_global_load_lds((const unsigned*)((const char*)(gbase) + (voff)[_i]), (LAS unsigned*)(lds + (bufoff) + ldsw + _i * 8192), 16, 0, 0); } while (0)
#define PG8_LDA(dst, b, h) do { _Pragma("unroll") for (int m = 0; m < 4; ++m) _Pragma("unroll") for (int k = 0; k < 2; ++k) dst[m][k] = *(const LAS bf16x8*)(lds + PG8_SA(b, h) + aoff + m * 2048 + k * 1024); } while (0)
#define PG8_LDB(dst, b, h) do { _Pragma("unroll") for (int n = 0; n < 2; ++n) _Pragma("unroll") for (int k = 0; k < 2; ++k) dst[n][k] = *(const LAS bf16x8*)(lds + PG8_SB(b, h) + boff + n * 2048 + k * 1024); } while (0)
#define PG8_MMA(ai, bj, At, Bt) do { __builtin_amdgcn_s_setprio(1); _Pragma("unroll") for (int m = 0; m < 4; ++m) _Pragma("unroll") for (int n = 0; n < 2; ++n) _Pragma("unroll") for (int k = 0; k < 2; ++k) \
        acc[ai][bj][m][n] = __builtin_amdgcn_mfma_f32_16x16x32_bf16(Bt[n][k], At[m][k], acc[ai][bj][m][n], 0, 0, 0); __builtin_amdgcn_s_setprio(0); } while (0)
#define PG8_WAIT_V(n) asm volatile("s_waitcnt vmcnt(" #n ")" ::: "memory")
#define PG8_WAIT_L(n) asm volatile("s_waitcnt lgkmcnt(" #n ")" ::: "memory")
#define PG8_BAR __builtin_amdgcn_s_barrier()
#define PG8_SCHED __builtin_amdgcn_sched_barrier(0)
    GUnit cur, nxt; int ui = 0;
    if (!S(c, cur)) return;
    f32x4 acc[2][2][4][2];
#pragma unroll
    for (int a = 0; a < 2; ++a)
#pragma unroll
        for (int b = 0; b < 2; ++b)
#pragma unroll
            for (int m = 0; m < 4; ++m)
#pragma unroll
                for (int n = 0; n < 2; ++n) acc[a][b][m][n] = (f32x4){0.f, 0.f, 0.f, 0.f};
    bf16x8 At[4][2], B0[2][2], B1[2][2];
    const char* cA = cur.A; const char* cB = cur.B;
    PG8_STAGE(PG8_SB(0, 0), cB, voffB); PG8_STAGE(PG8_SB(0, 1), cB + hB, voffB); PG8_STAGE(PG8_SA(0, 0), cA, voffA); PG8_STAGE(PG8_SA(0, 1), cA + hA, voffA);
    if (wr == 1) PG8_BAR;
    PG8_WAIT_V(2); PG8_BAR;
    PG8_STAGE(PG8_SB(1, 0), cB + kstep, voffB); PG8_STAGE(PG8_SA(1, 0), cA + kstep, voffA); PG8_STAGE(PG8_SB(1, 1), cB + hB + kstep, voffB);
    PG8_WAIT_V(6); PG8_BAR;
    for (;;) {
        const bool has_next = S((ui + 1) * G + c, nxt);
        const char* nA = has_next ? nxt.A : cA; const char* nB = has_next ? nxt.B : cB;
        const int nt = cur.nt;
        for (int t = 0; t < nt; t += 2) {
            const bool last = (t == nt - 2);
            const char* a1 = cA + (size_t)(t + 1) * kstep;
            const char* a2 = last ? nA : cA + (size_t)(t + 2) * kstep; const char* b2 = last ? nB : cB + (size_t)(t + 2) * kstep;
            const char* a3 = a2 + kstep; const char* b3 = b2 + kstep;
            PG8_LDB(B0, 0, 0); PG8_LDB(B1, 0, 1); PG8_SCHED; PG8_LDA(At, 0, 0); PG8_STAGE(PG8_SA(1, 1), a1 + hA, voffA);
            PG8_WAIT_V(8); PG8_WAIT_L(0); PG8_BAR; PG8_MMA(0, 0, At, B0); PG8_MMA(0, 1, At, B1); PG8_BAR; PG8_SCHED;
            PG8_LDA(At, 0, 1); PG8_STAGE(PG8_SB(0, 0), b2, voffB); PG8_STAGE(PG8_SB(0, 1), b2 + hB, voffB); PG8_STAGE(PG8_SA(0, 0), a2, voffA);
            PG8_WAIT_V(8); PG8_WAIT_L(0); PG8_BAR; PG8_MMA(1, 0, At, B0); PG8_MMA(1, 1, At, B1); PG8_BAR; PG8_SCHED;
            PG8_LDB(B0, 1, 0); PG8_LDB(B1, 1, 1); PG8_SCHED; PG8_LDA(At, 1, 0); PG8_STAGE(PG8_SA(0, 1), a2 + hA, voffA);
            PG8_WAIT_V(8); PG8_WAIT_L(0); PG8_BAR; PG8_MMA(0, 0, At, B0); PG8_MMA(0, 1, At, B1); PG8_BAR; PG8_SCHED;
            PG8_LDA(At, 1, 1); PG8_STAGE(PG8_SB(1, 0), b3, voffB); PG8_STAGE(PG8_SB(1, 1), b3 + hB, voffB); PG8_STAGE(PG8_SA(1, 0), a3, voffA);
            PG8_WAIT_V(8); PG8_WAIT_L(0); PG8_BAR; PG8_MMA(1, 0, At, B0); PG8_MMA(1, 1, At, B1); PG8_BAR; PG8_SCHED;
        }
        if (wr == 0) PG8_BAR;
        E(acc, cur, wr, wc, fr, fq);
        if (!has_next) break;
#pragma unroll
        for (int a = 0; a < 2; ++a)
#pragma unroll
            for (int b = 0; b < 2; ++b)
#pragma unroll
                for (int m = 0; m < 4; ++m)
#pragma unroll
                    for (int n = 0; n < 2; ++n) acc[a][b][m][n] = (f32x4){0.f, 0.f, 0.f, 0.f};
        cur = nxt; cA = nA; cB = nB; ++ui;
        if (wr == 1) PG8_BAR;
    }
    PG8_WAIT_V(0);
    PG8_BAR;
#undef PG8_SA
#undef PG8_SB
#undef PG8_STAGE
#undef PG8_LDA
#undef PG8_LDB
#undef PG8_MMA
#undef PG8_WAIT_V
#undef PG8_WAIT_L
#undef PG8_BAR
#undef PG8_SCHED
}
}

using pg8::GUnit;
typedef f32x4 Acc[2][2][4][2];
template <class F> struct EpiBf {
    static constexpr bool PERM = true;
    F f;
    __device__ __forceinline__ void operator()(const Acc& acc, const GUnit& u, int wr, int wc, int fr, int fq) const {
#pragma unroll
        for (int ai = 0; ai < 2; ++ai)
#pragma unroll
            for (int m = 0; m < 4; ++m) { const int trow = ai * 128 + wr * 64 + m * 16 + fr;
#pragma unroll
                for (int bj = 0; bj < 2; ++bj) f(acc[ai][bj][m][0], acc[ai][bj][m][1], u, trow, bj * 128 + wc * 32 + 8 * fq); }
    }
};
__device__ __forceinline__ void st8(bf16_t* p, f32x4 v0, f32x4 v1) { u32x4 w; w.x = cvt_pk_bf16(v0[0], v0[1]); w.y = cvt_pk_bf16(v0[2], v0[3]); w.z = cvt_pk_bf16(v1[0], v1[1]); w.w = cvt_pk_bf16(v1[2], v1[3]); *(u32x4*)p = w; }

struct FPlain { bf16_t* O; int ldc;
    __device__ __forceinline__ void operator()(f32x4 v0, f32x4 v1, const GUnit& u, int trow, int tcol) const { st8(O + (size_t)(u.pm * 256 + trow) * ldc + u.pn * 256 + tcol, v0, v1); } };
struct FQKV { bf16_t* Q; bf16_t* KV; const float* rsq; const float* rskv;
    __device__ __forceinline__ void operator()(f32x4 v0, f32x4 v1, const GUnit& u, int trow, int tcol) const {
        const int row = u.pm * 256 + trow;
        if (u.aux == 0) { const float s = rsq[row]; st8(Q + (size_t)row * 1536 + u.pn * 256 + tcol, v0 * s, v1 * s); }
        else { const float s = rskv[row]; st8(KV + (size_t)row * 2048 + u.pn * 256 + tcol, v0 * s, v1 * s); } } };
struct EpiQKV {
    static constexpr bool PERM = true;
    bf16_t* Q; bf16_t* KV; const float* rsq; const float* rskv;
    __device__ __forceinline__ void operator()(const Acc& acc, const GUnit& u, int wr, int wc, int fr, int fq) const {
        const float* rs = (u.aux == 0) ? rsq : rskv; bf16_t* O = (u.aux == 0) ? Q : KV; const int ldc = (u.aux == 0) ? 1536 : 2048;
        float sc[2][4];
#pragma unroll
        for (int ai = 0; ai < 2; ++ai)
#pragma unroll
            for (int m = 0; m < 4; ++m) sc[ai][m] = rs[u.pm * 256 + ai * 128 + wr * 64 + m * 16 + fr];
#pragma unroll
        for (int ai = 0; ai < 2; ++ai)
#pragma unroll
            for (int m = 0; m < 4; ++m) { const int row = u.pm * 256 + ai * 128 + wr * 64 + m * 16 + fr; const float s = sc[ai][m];
#pragma unroll
                for (int bj = 0; bj < 2; ++bj) st8(O + (size_t)row * ldc + u.pn * 256 + bj * 128 + wc * 32 + 8 * fq, acc[ai][bj][m][0] * s, acc[ai][bj][m][1] * s); }
    }
};
struct EpiRw2 {
    static constexpr bool PERM = true;
    bf16_t* base; bf16_t* vl; const float* w0; const float* a0;
    __device__ __forceinline__ void operator()(const Acc& acc, const GUnit& u, int wr, int wc, int fr, int fq) const {
        bf16_t* o = (u.aux < 5) ? base + (size_t)u.aux * ((size_t)R * 1024) : vl;
        const bool act = u.aux < 4; const float scl = (u.aux < 2) ? 0.6065306597126334f : 1.0f;
        f32x4 bv[2][2];
#pragma unroll
        for (int bj = 0; bj < 2; ++bj) { const int col = u.pn * 256 + bj * 128 + wc * 32 + 8 * fq; const float* bp = (u.aux < 2 ? w0 : a0) + (u.aux & 1) * 1024 + col;
            bv[bj][0] = act ? *(const f32x4*)bp : (f32x4){0.f, 0.f, 0.f, 0.f}; bv[bj][1] = act ? *(const f32x4*)(bp + 4) : (f32x4){0.f, 0.f, 0.f, 0.f}; }
#pragma unroll
        for (int ai = 0; ai < 2; ++ai)
#pragma unroll
            for (int m = 0; m < 4; ++m) { const int row = u.pm * 256 + ai * 128 + wr * 64 + m * 16 + fr;
#pragma unroll
                for (int bj = 0; bj < 2; ++bj) { f32x4 v0 = acc[ai][bj][m][0], v1 = acc[ai][bj][m][1];
                    if (act) {
#pragma unroll
                        for (int j = 0; j < 4; ++j) { v0[j] = scl * sigmoidf_(bv[bj][0][j] + v0[j]); v1[j] = scl * sigmoidf_(bv[bj][1][j] + v1[j]); } }
                    st8(o + (size_t)row * 1024 + u.pn * 256 + bj * 128 + wc * 32 + 8 * fq, v0, v1); } }
    }
};
struct FRw1 { bf16_t* L1; bf16_t* RR; bf16_t* RK; bf16_t* RV;
    __device__ __forceinline__ void operator()(f32x4 v0, f32x4 v1, const GUnit& u, int trow, int tcol) const {
        const int row = u.pm * 256 + trow;
        if (u.aux == 0) { const int col = u.pn * 256 + tcol;
            if (col < 128) {
#pragma unroll
                for (int j = 0; j < 4; ++j) { v0[j] = 1.0f - 2.0f * __builtin_amdgcn_rcpf(1.0f + __expf(2.0f * v0[j])); v1[j] = 1.0f - 2.0f * __builtin_amdgcn_rcpf(1.0f + __expf(2.0f * v1[j])); } }
            else if (col >= 320) {
#pragma unroll
                for (int j = 0; j < 4; ++j) { v0[j] = sigmoidf_(v0[j]); v1[j] = sigmoidf_(v1[j]); } }
            st8(L1 + (size_t)row * 512 + col, v0, v1); }
        else { bf16_t* o = u.aux == 1 ? RR : (u.aux == 2 ? RK : RV); st8(o + (size_t)row * 1024 + u.pn * 256 + tcol, v0, v1); } } };
struct FRw2 { bf16_t* base; bf16_t* vl; const float* w0; const float* a0;
    __device__ __forceinline__ void operator()(f32x4 v0, f32x4 v1, const GUnit& u, int trow, int tcol) const {
        const int col = u.pn * 256 + tcol;
        const unsigned off = (unsigned)(u.pm * 256 + trow) * 1024u + (unsigned)col + (u.aux < 5 ? (unsigned)u.aux * (unsigned)(R * 1024) : 0u);
        bf16_t* o = (u.aux < 5) ? base : vl;
        if (u.aux < 4) {
            const float* bp = (u.aux < 2 ? w0 : a0) + (u.aux & 1) * 1024 + col; const f32x4 b0 = *(const f32x4*)bp, b1 = *(const f32x4*)(bp + 4);
            const float sc = (u.aux < 2) ? 0.6065306597126334f : 1.0f;
#pragma unroll
            for (int j = 0; j < 4; ++j) { v0[j] = sc * sigmoidf_(b0[j] + v0[j]); v1[j] = sc * sigmoidf_(b1[j] + v1[j]); } }
        st8(o + off, v0, v1); } };
struct EpiSwiGLU {
    static constexpr bool PERM = true;
    bf16_t* O; int ldc;
    __device__ __forceinline__ void operator()(const Acc& acc, const GUnit& u, int wr, int wc, int fr, int fq) const {
#pragma unroll
        for (int ai = 0; ai < 2; ++ai)
#pragma unroll
            for (int m = 0; m < 4; ++m) { const int trow = ai * 128 + wr * 64 + m * 16 + fr; f32x4 h0, h1;
#pragma unroll
                for (int j = 0; j < 4; ++j) { const float g0 = acc[ai][0][m][0][j], g1 = acc[ai][0][m][1][j];
                    h0[j] = g0 * sigmoidf_(g0) * acc[ai][1][m][0][j]; h1[j] = g1 * sigmoidf_(g1) * acc[ai][1][m][1][j]; }
                st8(O + (size_t)(u.pm * 256 + trow) * ldc + u.pn * 128 + wc * 32 + 8 * fq, h0, h1); }
    }
};
struct EpiResid {
    static constexpr bool PERM = false;
    float* cs; float* out; const float* mods; int layer, which;
    const float* scs; const float* sout;
    __device__ __forceinline__ void operator()(const Acc& acc, const GUnit& u, int wr, int wc, int fr, int fq) const {
        const int b = u.pm / 17, isctx = (u.pm % 17 == 0);
        float* xp = isctx ? cs + (size_t)b * CTX * D : out + (size_t)(b * SEQ + (u.pm % 17 - 1) * 256) * D;
        const float* sp = isctx ? scs + (size_t)b * CTX * D : sout + (size_t)(b * SEQ + (u.pm % 17 - 1) * 256) * D;
        const float* gp = mods + ((size_t)(layer * 9 + (isctx ? 8 : b)) * 6 + which) * 1024;
        const int col0 = u.pn * 256 + wc * 32 + 4 * fq;
        f32x4 gv[2][2];
#pragma unroll
        for (int bj = 0; bj < 2; ++bj)
#pragma unroll
            for (int n = 0; n < 2; ++n) gv[bj][n] = *(const f32x4*)(gp + col0 + bj * 128 + n * 16);
#pragma unroll
        for (int ai = 0; ai < 2; ++ai)
#pragma unroll
            for (int mh = 0; mh < 2; ++mh) {
                f32x4 xv[2][2][2];
#pragma unroll
                for (int mm = 0; mm < 2; ++mm) { const float* srow = sp + (size_t)(ai * 128 + wr * 64 + (mh * 2 + mm) * 16 + fr) * D + col0;
#pragma unroll
                    for (int bj = 0; bj < 2; ++bj)
#pragma unroll
                        for (int n = 0; n < 2; ++n) xv[mm][bj][n] = *(const f32x4*)(srow + bj * 128 + n * 16); }
#pragma unroll
                for (int mm = 0; mm < 2; ++mm) { float* rowp = xp + (size_t)(ai * 128 + wr * 64 + (mh * 2 + mm) * 16 + fr) * D + col0;
#pragma unroll
                    for (int bj = 0; bj < 2; ++bj)
#pragma unroll
                        for (int n = 0; n < 2; ++n) *(f32x4*)(rowp + bj * 128 + n * 16) = xv[mm][bj][n] + gv[bj][n] * acc[ai][bj][mh * 2 + mm][n]; }
                asm volatile("" ::: "memory"); }
    }
};

struct MapSimple {
    const char* A; const char* B; size_t sa, sb; int nN, nt, lat;
    __device__ __forceinline__ bool operator()(int L, GUnit& u) const { const int nM = lat ? 128 : NPAN; if (L >= nM * nN) return false; int q; pg8::tile_order(L, nM, nN, q, u.pn);
        u.pm = lat ? (q / 16) * 17 + 1 + (q % 16) : q;
        u.A = A + (size_t)u.pm * sa; u.B = B + (size_t)u.pn * sb; u.nt = nt; u.aux = 0; return true; }
};
struct MapQKV {
    const char* QKVA; const char* QB; const char* KVB;
    __device__ __forceinline__ bool operator()(int L, GUnit& u) const { if (L >= NPAN * 14) return false; int pn; pg8::tile_order(L, NPAN, 14, u.pm, pn);
        const char* ap = QKVA + (size_t)u.pm * 256 * 768 * 2;
        if (pn < 6) { u.A = ap; u.B = QB + (size_t)pn * 256 * 384 * 2; u.nt = 6; u.pn = pn; u.aux = 0; }
        else { u.A = ap + 384 * 2; u.B = KVB + (size_t)(pn - 6) * 256 * 384 * 2; u.nt = 4; u.pn = pn - 6; u.aux = 1; }
        return true; }
};
struct MapRw1 {
    const char* AX; const char* B1; const char* B2; const char* L1;
    __device__ __forceinline__ bool operator()(int L, GUnit& u) const { if (L >= NPAN * 14) return false; int pn; pg8::tile_order(L, NPAN, 14, u.pm, pn);
        const char* ap = AX + (size_t)u.pm * 256 * 5120 * 2;
        if (pn < 2) { u.A = ap; u.B = L1 + (size_t)pn * 256 * 2048 * 2; u.nt = 32; u.pn = pn; u.aux = 0; }
        else if (pn < 6) { u.A = ap + 2048 * 2; u.B = B1 + (size_t)(pn - 2) * 256 * 2048 * 2; u.nt = 16; u.pn = pn - 2; u.aux = 1; }
        else if (pn < 10) { u.A = ap + 3072 * 2; u.B = B1 + (size_t)(pn - 6) * 256 * 2048 * 2 + 1024 * 2; u.nt = 16; u.pn = pn - 6; u.aux = 2; }
        else { u.A = ap + 4096 * 2; u.B = B2 + (size_t)(pn - 10) * 256 * 2048 * 2; u.nt = 16; u.pn = pn - 10; u.aux = 3; }
        return true; }
};
struct MapRw2 {
    const char* L1; const char* L2A; const char* L2B; int pn0, nN, nt;
    __device__ __forceinline__ bool operator()(int L, GUnit& u) const { if (L >= NPAN * nN) return false; int pn; pg8::tile_order(L, NPAN, nN, u.pm, pn); pn += pn0;
        const char* ap = L1 + (size_t)u.pm * 256 * 512 * 2; u.nt = nt; u.pn = pn & 3; u.aux = pn >> 2;
        if (pn < 16) { const int koff = (pn < 8) ? 0 : 128 * 2;
            u.A = ap + koff; u.B = L2A + (size_t)pn * 256 * 256 * 2 + koff; u.nt = nt >> 1; }
        else { u.A = ap + 256 * 2; u.B = L2B + (size_t)(pn - 16) * 256 * 256 * 2; if (pn >= 20) u.nt = nt >> 1; }
        return true; }
};
struct MapMoe {
    const char* A; const char* B; size_t sa, sbe, sb; int nN, nt; const int* base;
    __device__ __forceinline__ bool operator()(int L, GUnit& u) const { const int nM = base[8] >> 8; if (L >= nM * nN) return false; pg8::tile_order(L, nM, nN, u.pm, u.pn);
        int e = 0;
#pragma unroll
        for (int j = 1; j < 8; ++j) e += (u.pm * 256 >= base[j]) ? 1 : 0;
        u.A = A + (size_t)u.pm * sa; u.B = B + (size_t)e * sbe + (size_t)u.pn * sb; u.nt = nt; u.aux = e; return true; }
};

struct Job { const float* src; const float* kscale; bf16_t* dst; int sld, srcK, srcN, ldd, Nd, Kd, koff, grp, gstride, tn, tile0, pad; };
constexpr int MAXJOB = 96;
#define NOGRP (1 << 30)
struct JobList { LAS Job* jobs; int n, tiles, z; };
__device__ __forceinline__ void addjob(JobList& L, const float* src, int sld, int srcK, int srcN, const float* kscale, bf16_t* dst, int ldd, int Nd, int Kd, int koff, int grp, int gstride) {
    LAS Job* j = L.jobs + L.n; j->src = src; j->kscale = kscale; j->dst = dst; j->sld = sld + L.z; j->srcK = srcK + L.z; j->srcN = srcN + L.z; j->ldd = ldd + L.z; j->Nd = Nd + L.z; j->Kd = Kd + L.z; j->koff = koff + L.z; j->grp = grp + L.z; j->gstride = gstride + L.z;
    const int tn = ((Nd + 63) >> 6) + L.z; j->tn = tn; j->tile0 = L.tiles; L.tiles += tn * (Kd >> 6); L.n += 1;
}
__device__ __forceinline__ bf16_t* wmla(const Args& a, int j) { return (bf16_t*)(a.ws + WS_WMLA) + (size_t)j * E_MLA; }
__device__ __forceinline__ bf16_t* wrwkv(const Args& a, int j) { return (bf16_t*)(a.ws + WS_WRWKV) + (size_t)j * E_RWKV; }
__device__ __forceinline__ bf16_t* wffn(const Args& a, int j) { return (bf16_t*)(a.ws + WS_WFFN) + (size_t)j * E_FFN; }
__device__ __forceinline__ void jobs_small(const Args& a, JobList& L) {
#pragma unroll 1
    for (int j = 0; j < 2; ++j) {
        {
            bf16_t* w = wmla(a, j); bf16_t* qkva = w; bf16_t* qb = w + E_QKVA; bf16_t* kvb = qb + E_QB; bf16_t* wo = kvb + E_KVB;
            addjob(L, a.in[I_WQA] + (size_t)j * D * QL, QL, D, QL, nullptr, qkva, 1024, 384, 1024, 0, NOGRP, 0);
            addjob(L, a.in[I_WKVA] + (size_t)j * D * 320, 320, D, 320, nullptr, qkva + (size_t)384 * 1024, 1024, 384, 1024, 0, NOGRP, 0);
            addjob(L, a.in[I_WQB] + (size_t)j * QL * 1536, 1536, QL, 1536, a.in[I_QAN] + j * QL, qb, 384, 1536, 384, 0, NOGRP, 0);
            addjob(L, a.in[I_WKVB] + (size_t)j * KVL * 2048, 2048, KVL, 2048, a.in[I_KVAN] + j * KVL, kvb, 384, 2048, 256, 0, NOGRP, 0);
            addjob(L, a.in[I_MWO] + (size_t)j * D * D, D, D, D, nullptr, wo, 1024, 1024, 1024, 0, NOGRP, 0);
        }
        {
            bf16_t* w = wrwkv(a, j); bf16_t* b1 = w; bf16_t* b2 = b1 + E_B1; bf16_t* l1 = b2 + E_B2; bf16_t* l2a = l1 + E_L1; bf16_t* l2b = l2a + E_L2A;
            const float* mix = a.in[I_MIX] + (size_t)j * 6 * D;
            addjob(L, a.in[I_WR] + (size_t)j * D * D, D, D, D, nullptr, b1, 2048, 1024, 1024, 0, NOGRP, 0);
            addjob(L, a.in[I_WK] + (size_t)j * D * D, D, D, D, nullptr, b1 + 1024, 2048, 1024, 1024, 0, NOGRP, 0);
            addjob(L, a.in[I_WV] + (size_t)j * D * D, D, D, D, nullptr, b2, 2048, 1024, 1024, 0, NOGRP, 0);
            addjob(L, a.in[I_RWO] + (size_t)j * D * D, D, D, D, nullptr, b2 + 1024, 2048, 1024, 1024, 0, NOGRP, 0);
            for (int d = 0; d < 2; ++d) {
                const float* w1 = a.in[I_W1] + (size_t)(j * 2 + d) * D * 64; const float* a1 = a.in[I_A1] + (size_t)(j * 2 + d) * D * 64;
                addjob(L, w1, 64, D, 64, nullptr, l1 + (size_t)(d * 64) * 2048, 2048, 64, 1024, 0, NOGRP, 0);
                addjob(L, w1, 64, D, 64, mix + 1 * D, l1 + (size_t)(d * 64) * 2048 + 1024, 2048, 64, 1024, 0, NOGRP, 0);
                addjob(L, a1, 64, D, 64, nullptr, l1 + (size_t)(128 + d * 64) * 2048, 2048, 64, 1024, 0, NOGRP, 0);
                addjob(L, a1, 64, D, 64, mix + 4 * D, l1 + (size_t)(128 + d * 64) * 2048 + 1024, 2048, 64, 1024, 0, NOGRP, 0);
            }
            const float* v1 = (j == 1) ? a.in[I_V1] : nullptr;
            addjob(L, v1, 32, D, 32, nullptr, l1 + (size_t)256 * 2048, 2048, 64, 1024, 0, NOGRP, 0);
            addjob(L, v1, 32, D, 32, mix + 3 * D, l1 + (size_t)256 * 2048 + 1024, 2048, 64, 1024, 0, NOGRP, 0);
            addjob(L, a.in[I_G1] + (size_t)j * D * 160, 160, D, 160, nullptr, l1 + (size_t)320 * 2048, 2048, 192, 1024, 0, NOGRP, 0);
            addjob(L, a.in[I_G1] + (size_t)j * D * 160, 160, D, 160, mix + 5 * D, l1 + (size_t)320 * 2048 + 1024, 2048, 192, 1024, 0, NOGRP, 0);
            for (int d = 0; d < 2; ++d) {
                addjob(L, a.in[I_W2] + (size_t)(j * 2 + d) * 64 * D, D, 64, D, nullptr, l2a + (size_t)(d * 1024) * 256, 256, 1024, 256, d * 64, NOGRP, 0);
                addjob(L, a.in[I_A2] + (size_t)(j * 2 + d) * 64 * D, D, 64, D, nullptr, l2a + (size_t)(2048 + d * 1024) * 256, 256, 1024, 256, 128 + d * 64, NOGRP, 0);
            }
            addjob(L, a.in[I_G2] + (size_t)j * 160 * D, D, 160, D, nullptr, l2b, 256, 1024, 256, 64, NOGRP, 0);
            addjob(L, (j == 1) ? a.in[I_V2] : nullptr, D, 32, D, nullptr, l2b + (size_t)1024 * 256, 256, 1024, 256, 0, NOGRP, 0);
        }
        {
            bf16_t* w = wffn(a, j);
            addjob(L, a.in[I_F1] + (size_t)j * D * DFF, DFF, D, DFF, nullptr, w, 1024, DFF, 1024, 0, 128, 256);
            addjob(L, a.in[I_F3] + (size_t)j * D * DFF, DFF, D, DFF, nullptr, w + (size_t)128 * 1024, 1024, DFF, 1024, 0, 128, 256);
            addjob(L, a.in[I_F2] + (size_t)j * DFF * D, D, DFF, D, nullptr, w + E_F13, DFF, 1024, DFF, 0, NOGRP, 0);
        }
    }
}
__device__ __forceinline__ void jobs_moe(const Args& a, JobList& L, int k) {
    bf16_t* w13 = (bf16_t*)(a.ws + WS_ARENA + A_WM13); bf16_t* w2 = (bf16_t*)(a.ws + WS_ARENA + A_WM2);
#pragma unroll 1
    for (int e = 0; e < NE; ++e) {
        const size_t so = (size_t)(k * NE + e) * D * DFE;
        addjob(L, a.in[I_M1] + so, DFE, D, DFE, nullptr, w13 + (size_t)e * E_M13, 1024, DFE, 1024, 0, 128, 256);
        addjob(L, a.in[I_M3] + so, DFE, D, DFE, nullptr, w13 + (size_t)e * E_M13 + (size_t)128 * 1024, 1024, DFE, 1024, 0, 128, 256);
        addjob(L, a.in[I_M2] + so, D, DFE, D, nullptr, w2 + (size_t)e * E_M2, DFE, 1024, DFE, 0, NOGRP, 0);
    }
}
__device__ __forceinline__ void run_prep(const Args& a, LAS unsigned char* jl, int which  , int j0  , int G, int c) {
    const int tid = ltid();
    LAS Job* jobs = (LAS Job*)jl; LAS int* hdr = (LAS int*)(jl + MAXJOB * sizeof(Job)); LAS float* tile = (LAS float*)(jl + MAXJOB * sizeof(Job) + 64);
    if (tid == 0) { JobList L{jobs, 0, 0, launder_s(0)}; if (which < 0) jobs_small(a, L); else jobs_moe(a, L, which); hdr[0] = L.n + L.z; hdr[1] = L.tiles + L.z; }
    __syncthreads();
    const int nj = hdr[0], ntile = hdr[1];
    const int kl = tid >> 4, nq = (tid & 15) * 4, sn = tid >> 3, sk = (tid & 7) * 8;
    int jcur = 0;
#define PREP_BAR() do { asm volatile("s_waitcnt lgkmcnt(0)" ::: "memory"); __builtin_amdgcn_s_barrier(); asm volatile("" ::: "memory"); } while (0)
    f32x4 vcur[2], vnxt[2];
#define PREP_FETCH(t_, dstv) do { while (jcur + 1 < nj && jobs[jcur + 1].tile0 <= (t_)) ++jcur; const LAS Job* J_ = jobs + jcur; \
        const float* src_ = J_->src; const float* ks_ = J_->kscale; const int sld_ = J_->sld, srcK_ = J_->srcK, srcN_ = J_->srcN, koff_ = J_->koff, tn_ = J_->tn, tl_ = (t_) - J_->tile0; \
        const int n0_ = (tl_ % tn_) * 64, k0_ = (tl_ / tn_) * 64; \
        _Pragma("unroll") for (int p = 0; p < 2; ++p) { const int kk = k0_ + kl + 32 * p, ksi = kk - koff_, n = n0_ + nq; f32x4 v = (f32x4){0.f, 0.f, 0.f, 0.f}; \
            if (src_ != nullptr && ksi >= 0 && ksi < srcK_ && n < srcN_) { v = *(const __attribute__((address_space(1))) f32x4*)(src_ + (size_t)ksi * sld_ + n); if (ks_) v = v * *(const __attribute__((address_space(1))) float*)(ks_ + ksi); } dstv[p] = v; } } while (0)
    int t = c + j0 * G;
    if (t < ntile) PREP_FETCH(t, vcur);
    for (; t < ntile; t += G) {
        const int jthis = jcur;
        if (t + G < ntile) PREP_FETCH(t + G, vnxt);
        const LAS Job* J = jobs + jthis;
        bf16_t* __restrict__ dst = J->dst;
        const int ldd = J->ldd, Nd = J->Nd, grp = J->grp, gstride = J->gstride, tn = J->tn, tl = t - J->tile0;
        const int n0 = (tl % tn) * 64, k0 = (tl / tn) * 64;
#pragma unroll
        for (int p = 0; p < 2; ++p) { LAS float* tp = tile + (kl + 32 * p) * 65 + nq; tp[0] = vcur[p][0]; tp[1] = vcur[p][1]; tp[2] = vcur[p][2]; tp[3] = vcur[p][3]; }
        PREP_BAR();
        { const int n = n0 + sn;
            if (n < Nd) { float f[8];
#pragma unroll
                for (int e = 0; e < 8; ++e) f[e] = tile[(sk + e) * 65 + sn];
                const int dr = (n / grp) * gstride + (n % grp);
                *(__attribute__((address_space(1))) u32x4*)(dst + (size_t)dr * ldd + k0 + sk) = pack8(f); } }
        PREP_BAR();
        vcur[0] = vnxt[0]; vcur[1] = vnxt[1];
    }
#undef PREP_FETCH
#undef PREP_BAR
    asm volatile("s_waitcnt vmcnt(0)" ::: "memory"); __syncthreads();
}

__device__ __forceinline__ void prologue_misc(const Args& a, LAS unsigned char* lds, int G, int c) {
    const int tid = ltid();
    if (c == 0) { float* rt = (float*)(a.ws + WS_ROPE);
      for (int i = tid; i < 1024; i += NTHR) { const int pos = i >> 4, j = i & 15; const double inv = 1.0 / pow(10000.0, (double)j / 16.0), ang = (double)pos * inv; rt[i] = (float)cos(ang); rt[1024 + i] = (float)sin(ang); } }
    LAS float* sc = (LAS float*)lds;
    LAS float* red = (LAS float*)(lds + 49152);
    for (int i = tid; i < 1024 * 12; i += NTHR) { const int k = i / 12, m = i % 12; float v = 0.f;
        if (m < 9) { const float x = (m < 8) ? a.in[I_C][m * D + k] : a.in[I_CCTX][k]; v = x / (1.0f + expf(-x)); } sc[i] = v; }
    __syncthreads();
    const int kq = tid >> 6, col = tid & 63;
    for (int u = c; u < 4 * 96; u += G) {
        const int layer = u / 96, n0 = (u % 96) * 64;
        const float* w = a.in[I_ADAW] + (size_t)layer * D * 6144 + n0 + col;
        float acc[9];
#pragma unroll
        for (int m = 0; m < 9; ++m) acc[m] = 0.f;
        for (int k8 = 0; k8 < 128; k8 += 8) {
            float wv[8];
#pragma unroll
            for (int e = 0; e < 8; ++e) wv[e] = w[(size_t)(kq * 128 + k8 + e) * 6144];
#pragma unroll
            for (int e = 0; e < 8; ++e) { const LAS f32x4* sp = (const LAS f32x4*)(sc + (kq * 128 + k8 + e) * 12); const f32x4 s0 = sp[0], s1 = sp[1], s2 = sp[2];
                acc[0] += s0[0] * wv[e]; acc[1] += s0[1] * wv[e]; acc[2] += s0[2] * wv[e]; acc[3] += s0[3] * wv[e];
                acc[4] += s1[0] * wv[e]; acc[5] += s1[1] * wv[e]; acc[6] += s1[2] * wv[e]; acc[7] += s1[3] * wv[e]; acc[8] += s2[0] * wv[e]; }
        }
#pragma unroll
        for (int m = 0; m < 9; ++m) red[(kq * 9 + m) * 64 + col] = acc[m];
        __syncthreads();
        for (int i = tid; i < 9 * 64; i += NTHR) { const int m = i >> 6, cc = i & 63; float s = 0.f;
#pragma unroll
            for (int q = 0; q < 8; ++q) s += red[(q * 9 + m) * 64 + cc];
            ((float*)(a.ws + WS_MODS))[(size_t)(layer * 9 + m) * 6144 + n0 + cc] = s + a.in[I_ADAB][layer * 6144 + n0 + cc]; }
        __syncthreads();
    }
}

struct RowParams { float A[16], Bv[16]; int mi; };
__device__ __forceinline__ void load_params(const Args& a, RowParams& P, int layer, int mi, const float* gain, int which, int lane) {
    const float* sh = mods_ptr(a, layer, mi, which); const float* scl = mods_ptr(a, layer, mi, which + 1);
#pragma unroll
    for (int j = 0; j < 2; ++j) { const int col = j * 512 + lane * 8;
#pragma unroll
        for (int q = 0; q < 2; ++q) { const f32x4 g = *(const f32x4*)(gain + col + 4 * q), s = *(const f32x4*)(scl + col + 4 * q), t = *(const f32x4*)(sh + col + 4 * q);
#pragma unroll
            for (int e = 0; e < 4; ++e) { P.A[j * 8 + q * 4 + e] = g[e] * (1.0f + s[e]); P.Bv[j * 8 + q * 4 + e] = t[e]; } } }
    P.mi = mi;
}
__device__ __forceinline__ void load_x16(const float* xp, int lane, float (&x)[16]) {
#pragma unroll
    for (int j = 0; j < 2; ++j)
#pragma unroll
        for (int q = 0; q < 2; ++q) { const f32x4 v = *(const f32x4*)(xp + j * 512 + lane * 8 + 4 * q); x[j * 8 + q * 4 + 0] = v[0]; x[j * 8 + q * 4 + 1] = v[1]; x[j * 8 + q * 4 + 2] = v[2]; x[j * 8 + q * 4 + 3] = v[3]; }
}
__device__ __forceinline__ void store_bf16_row(bf16_t* p, int lane, const float (&h)[16]) {
#pragma unroll
    for (int j = 0; j < 2; ++j) { u32x4 w; w.x = cvt_pk_bf16(h[j * 8 + 0], h[j * 8 + 1]); w.y = cvt_pk_bf16(h[j * 8 + 2], h[j * 8 + 3]); w.z = cvt_pk_bf16(h[j * 8 + 4], h[j * 8 + 5]); w.w = cvt_pk_bf16(h[j * 8 + 6], h[j * 8 + 7]);
        *(u32x4*)(p + j * 512 + lane * 8) = w; }
}
__device__ __forceinline__ void moe_combine16(const Args& a, int row, int layer_prev, int lane, float (&x)[16]) {
    const u32x4 rt = *(const u32x4*)(a.ws + WS_ROUTE + (size_t)row * 16);
    const int e0 = (int)rt[0];
    if (e0 < 0) return;
    const float p0 = __uint_as_float(rt[2]), p1 = __uint_as_float(rt[3]);
    const int* sl = (const int*)(a.ws + WS_RSLOT) + (size_t)row * 2; const int s0 = sl[0], s1 = sl[1];
    const bf16_t* y2 = (const bf16_t*)(a.ws + WS_ARENA + A_Y2);
    const float* g5 = mods_ptr(a, layer_prev, mod_index(row), 5);
#pragma unroll
    for (int j = 0; j < 2; ++j) { const int col = j * 512 + lane * 8; float ya[8], yb[8];
        unpack8(*(const u32x4*)(y2 + (size_t)s0 * 1024 + col), ya); unpack8(*(const u32x4*)(y2 + (size_t)s1 * 1024 + col), yb);
        const f32x4 g0 = *(const f32x4*)(g5 + col), g1 = *(const f32x4*)(g5 + col + 4);
#pragma unroll
        for (int e = 0; e < 8; ++e) x[j * 8 + e] += (e < 4 ? g0[e] : g1[e - 4]) * (p0 * ya[e] + p1 * yb[e]); }
}
__device__ __forceinline__ void store_x16(float* xp, int lane, const float (&x)[16]) {
#pragma unroll
    for (int j = 0; j < 2; ++j)
#pragma unroll
        for (int q = 0; q < 2; ++q) *(f32x4*)(xp + j * 512 + lane * 8 + 4 * q) = (f32x4){x[j * 8 + q * 4], x[j * 8 + q * 4 + 1], x[j * 8 + q * 4 + 2], x[j * 8 + q * 4 + 3]};
}
__device__ __forceinline__ void norm_row(const float (&x)[16], const RowParams& P, float (&h)[16]) {
    float ss = 0.f;
#pragma unroll
    for (int e = 0; e < 16; ++e) ss += x[e] * x[e];
    ss = wave_sum(ss);
    const float rstd = 1.0f / sqrtf(ss * (1.0f / 1024.0f) + NORM_EPS);
#pragma unroll
    for (int e = 0; e < 16; ++e) h[e] = x[e] * rstd * P.A[e] + P.Bv[e];
}
__device__ __forceinline__ void wave_rows(int G, int c, int& r0, int& r1) {
    const int nw = G * NWAVE, per = (R + nw - 1) / nw, gw = c * NWAVE + (ltid() >> 6);
    r0 = gw * per; r1 = r0 + per; if (r0 > R) r0 = R; if (r1 > R) r1 = R;
}
template <bool COMBINE, bool FIRST = false>
__device__ __forceinline__ void norm_plain(const Args& a, int layer, const float* gain, int which, bf16_t* Hout, int G, int c) {
    const int lane = ltid() & 63; int r0, r1; wave_rows(G, c, r0, r1);
    RowParams P; P.mi = -1;
    for (int row = r0; row < r1; ++row) {
        const int mi = mod_index(row); if (mi != P.mi) load_params(a, P, layer, mi, gain, which, lane);
        float* xp = xrow(a, row); float x[16], h[16]; load_x16(FIRST ? xrow_in(a, row) : xp, lane, x);
        if (COMBINE) { moe_combine16(a, row, layer - 1, lane, x); store_x16(xp, lane, x); }
        norm_row(x, P, h); store_bf16_row(Hout + (size_t)row * 1024, lane, h);
    }
}
__device__ __forceinline__ bool seg_first(int row) { const int r = row % SEG; return r == 0 || r == CTX; }
__device__ __forceinline__ bool seg_last(int row) { const int r = row % SEG; return r == CTX - 1 || r == SEG - 1; }
__device__ __forceinline__ void norm_mix(const Args& a, int layer, int j, int G, int c) {
    const int lane = ltid() & 63; int r0, r1; wave_rows(G, c, r0, r1); if (r0 >= r1) return;
    const float* gain = a.in[I_N1G] + layer * D; const float* mix = a.in[I_MIX] + (size_t)j * 6 * D;
    bf16_t* AX = (bf16_t*)(a.ws + WS_ARENA + A_AX);
    float mr[16], mk[16], mv[16];
#pragma unroll
    for (int jj = 0; jj < 2; ++jj)
#pragma unroll
        for (int e = 0; e < 8; ++e) { const int col = jj * 512 + lane * 8 + e; mr[jj * 8 + e] = mix[col]; mk[jj * 8 + e] = mix[2 * D + col]; mv[jj * 8 + e] = mix[3 * D + col]; }
    RowParams P; P.mi = -1;
    float hp[16], hc[16], hn[16], x[16];
    if (!seg_first(r0)) { const int mi = mod_index(r0 - 1); if (mi != P.mi) load_params(a, P, layer, mi, gain, 0, lane); load_x16(xrow(a, r0 - 1), lane, x); norm_row(x, P, hp); }
    else {
#pragma unroll
        for (int e = 0; e < 16; ++e) hp[e] = 0.f; }
    { const int mi = mod_index(r0); if (mi != P.mi) load_params(a, P, layer, mi, gain, 0, lane); load_x16(xrow(a, r0), lane, x); norm_row(x, P, hc); }
    for (int row = r0; row < r1; ++row) {
        if (row + 1 < R) { const int mi = mod_index(row + 1); if (mi != P.mi) load_params(a, P, layer, mi, gain, 0, lane); load_x16(xrow(a, row + 1), lane, x); norm_row(x, P, hn); }
        else {
#pragma unroll
            for (int e = 0; e < 16; ++e) hn[e] = 0.f; }
        const float fp = seg_first(row) ? 0.f : 0.5f, fn = seg_last(row) ? 0.f : 0.5f;
        float xx[16], t[16];
#pragma unroll
        for (int e = 0; e < 16; ++e) xx[e] = fp * hp[e] + fn * hn[e] - hc[e];
        bf16_t* o = AX + (size_t)row * 5120;
        store_bf16_row(o, lane, hc); store_bf16_row(o + 1024, lane, xx);
#pragma unroll
        for (int e = 0; e < 16; ++e) t[e] = hc[e] + xx[e] * mr[e];
        store_bf16_row(o + 2048, lane, t);
#pragma unroll
        for (int e = 0; e < 16; ++e) t[e] = hc[e] + xx[e] * mk[e];
        store_bf16_row(o + 3072, lane, t);
#pragma unroll
        for (int e = 0; e < 16; ++e) t[e] = hc[e] + xx[e] * mv[e];
        store_bf16_row(o + 4096, lane, t);
#pragma unroll
        for (int e = 0; e < 16; ++e) { hp[e] = hc[e]; hc[e] = hn[e]; }
    }
}
__device__ __forceinline__ void norm_router(const Args& a, int layer, int k, bool last, LAS unsigned char* lds, int G, int c) {
    const int tid = ltid(), lane = tid & 63; int r0, r1; wave_rows(G, c, r0, r1);
    LAS float* rw = (LAS float*)lds;
    { const float* rsrc = a.in[I_ROUTER] + (size_t)k * D * NE; for (int i = tid; i < D * NE; i += NTHR) rw[i] = rsrc[i]; }
    __syncthreads();
    const float* gain = a.in[I_N2G] + layer * D;
    bf16_t* Hout = (bf16_t*)(a.ws + WS_ARENA + A_H);
    RowParams P; P.mi = -1;
    int hist[8];
#pragma unroll
    for (int e = 0; e < 8; ++e) hist[e] = 0;
    for (int row = r0; row < r1; ++row) {
        const int mi = mod_index(row); if (mi != P.mi) load_params(a, P, layer, mi, gain, 3, lane);
        float x[16], h[16]; load_x16(xrow(a, row), lane, x); norm_row(x, P, h); store_bf16_row(Hout + (size_t)row * 1024, lane, h);
        const bool routed = !(last && mi == 8);
        float lg[8];
#pragma unroll
        for (int e = 0; e < 8; ++e) lg[e] = 0.f;
#pragma unroll
        for (int jj = 0; jj < 2; ++jj)
#pragma unroll
            for (int q = 0; q < 8; ++q) { const LAS f32x4* rp = (const LAS f32x4*)(rw + (jj * 512 + lane * 8 + q) * 8); const f32x4 w0 = rp[0], w1 = rp[1]; const float hv = h[jj * 8 + q];
                lg[0] += hv * w0[0]; lg[1] += hv * w0[1]; lg[2] += hv * w0[2]; lg[3] += hv * w0[3]; lg[4] += hv * w1[0]; lg[5] += hv * w1[1]; lg[6] += hv * w1[2]; lg[7] += hv * w1[3]; }
#pragma unroll
        for (int e = 0; e < 8; ++e) lg[e] = wave_sum(lg[e]);
        int e0 = 0; float v0 = lg[0];
#pragma unroll
        for (int e = 1; e < 8; ++e) if (lg[e] > v0) { v0 = lg[e]; e0 = e; }
        int e1 = -1; float v1 = -3.0e38f;
#pragma unroll
        for (int e = 0; e < 8; ++e) if (e != e0 && lg[e] > v1) { v1 = lg[e]; e1 = e; }
        const float p0 = 1.0f / (1.0f + expf(v1 - v0)), p1 = 1.0f - p0;
        if (routed) {
#pragma unroll
            for (int e = 0; e < 8; ++e) hist[e] += (e == e0 || e == e1) ? 1 : 0; }
        if (lane == 0) *(u32x4*)(a.ws + WS_ROUTE + (size_t)row * 16) = (u32x4){(unsigned)(routed ? e0 : -1), (unsigned)(routed ? e1 : -1), __float_as_uint(p0), __float_as_uint(p1)};
    }
    const int gw = c * NWAVE + (tid >> 6);
    if (lane == 0) { int* hp = (int*)(a.ws + WS_HIST) + (size_t)gw * 8;
#pragma unroll
        for (int e = 0; e < 8; ++e) hp[e] = hist[e]; }
}

__device__ __forceinline__ void mla_stats(const Args& a, int G, int c) {
    const int lane = ltid() & 63; int r0, r1; wave_rows(G, c, r0, r1);
    const bf16_t* QKVA = (const bf16_t*)(a.ws + WS_ARENA + A_QKVA); float* rs = (float*)(a.ws + WS_RS);
    for (int row = r0; row < r1; ++row) {
        float sq = 0.f, skv = 0.f; float f[8];
        if (lane < 48) { unpack8(*(const u32x4*)(QKVA + (size_t)row * 768 + lane * 8), f);
#pragma unroll
            for (int e = 0; e < 8; ++e) sq += f[e] * f[e]; }
        if (lane < 32) { unpack8(*(const u32x4*)(QKVA + (size_t)row * 768 + 384 + lane * 8), f);
#pragma unroll
            for (int e = 0; e < 8; ++e) skv += f[e] * f[e]; }
        sq = wave_sum(sq); skv = wave_sum(skv);
        if (lane == 0) { rs[row] = 1.0f / sqrtf(sq * (1.0f / 384.0f) + NORM_EPS); rs[R + row] = 1.0f / sqrtf(skv * (1.0f / 256.0f) + NORM_EPS); }
    }
}
__device__ __forceinline__ void mla_qkpost(const Args& a, int j, int G, int c) {
    const int lane = ltid() & 63, hd = lane >> 3, sub = lane & 7; int r0, r1; wave_rows(G, c, r0, r1);
    bf16_t* Q = (bf16_t*)(a.ws + WS_ARENA + A_Q); const bf16_t* KV = (const bf16_t*)(a.ws + WS_ARENA + A_KV); const bf16_t* QKVA = (const bf16_t*)(a.ws + WS_ARENA + A_QKVA);
    bf16_t* K = (bf16_t*)(a.ws + WS_ARENA + A_K); const float* rt = (const float*)(a.ws + WS_ROPE);
    float gq[3][8], gk[3][8];
#pragma unroll
    for (int cc = 0; cc < 3; ++cc)
#pragma unroll
        for (int e = 0; e < 8; ++e) { gq[cc][e] = a.in[I_QN][j * QKH + cc * 64 + sub * 8 + e]; gk[cc][e] = a.in[I_KN][j * QKH + cc * 64 + sub * 8 + e]; }
    const float sgn = (sub & 2) ? 1.0f : -1.0f;
    for (int row = r0; row < r1; ++row) {
        const int r = row % SEG; const bool lat = r >= CTX; const int t = r - CTX, pos = (sub & 4) ? (t & 63) : (t >> 6);
        float cs[8], sn[8];
        if (lat) {
#pragma unroll
            for (int q = 0; q < 2; ++q) { const f32x4 cv = *(const f32x4*)(rt + pos * 16 + (sub & 1) * 8 + 4 * q), sv = *(const f32x4*)(rt + 1024 + pos * 16 + (sub & 1) * 8 + 4 * q);
#pragma unroll
                for (int e = 0; e < 4; ++e) { cs[q * 4 + e] = cv[e]; sn[q * 4 + e] = sv[e]; } } }
        float v[3][8];
        bf16_t* qp = Q + (size_t)row * 1536 + hd * QKH + sub * 8;
#pragma unroll
        for (int cc = 0; cc < 3; ++cc) unpack8(*(const u32x4*)(qp + cc * 64), v[cc]);
        { float ss = 0.f;
#pragma unroll
          for (int cc = 0; cc < 3; ++cc)
#pragma unroll
              for (int e = 0; e < 8; ++e) ss += v[cc][e] * v[cc][e];
          ss = red8(ss); const float rstd = 1.0f / sqrtf(ss * (1.0f / 192.0f) + NORM_EPS);
#pragma unroll
          for (int cc = 0; cc < 3; ++cc)
#pragma unroll
              for (int e = 0; e < 8; ++e) v[cc][e] = v[cc][e] * rstd * gq[cc][e];
          if (lat) {
#pragma unroll
              for (int e = 0; e < 8; ++e) { const float pr = __shfl_xor(v[2][e], 2); v[2][e] = v[2][e] * cs[e] + sgn * pr * sn[e]; } }
#pragma unroll
          for (int cc = 0; cc < 3; ++cc) {
#pragma unroll
              for (int e = 0; e < 8; ++e) v[cc][e] *= QSCALE;
              *(u32x4*)(qp + cc * 64) = pack8(v[cc]); } }
        const bf16_t* kp = KV + (size_t)row * 2048 + hd * 256 + sub * 8;
        unpack8(*(const u32x4*)(kp), v[0]); unpack8(*(const u32x4*)(kp + 64), v[1]); unpack8(*(const u32x4*)(QKVA + (size_t)row * 768 + 640 + sub * 8), v[2]);
        { float ss = 0.f;
#pragma unroll
          for (int cc = 0; cc < 3; ++cc)
#pragma unroll
              for (int e = 0; e < 8; ++e) ss += v[cc][e] * v[cc][e];
          ss = red8(ss); const float rstd = 1.0f / sqrtf(ss * (1.0f / 192.0f) + NORM_EPS);
#pragma unroll
          for (int cc = 0; cc < 3; ++cc)
#pragma unroll
              for (int e = 0; e < 8; ++e) v[cc][e] = v[cc][e] * rstd * gk[cc][e];
          if (lat) {
#pragma unroll
              for (int e = 0; e < 8; ++e) { const float pr = __shfl_xor(v[2][e], 2); v[2][e] = v[2][e] * cs[e] + sgn * pr * sn[e]; } }
          bf16_t* ko = K + (size_t)row * 1536 + hd * QKH + sub * 8;
#pragma unroll
          for (int cc = 0; cc < 3; ++cc) *(u32x4*)(ko + cc * 64) = pack8(v[cc]); }
    }
}

namespace att {
constexpr int KVBLK = 64, KROWB = 384;
constexpr int SHM_V = KVBLK * 128 * 2, SHM_K = KVBLK * KROWB;
constexpr int SHM_ATTN = 2 * SHM_V + 2 * SHM_K + NWAVE * 64 * 4;
constexpr float THR = 11.5f;
#define KSWZ(row, colB) ((row) * att::KROWB + ((colB) ^ (((row) & 7) << 4)))
#define SBAR() __builtin_amdgcn_sched_barrier(0)
__device__ __forceinline__ int crow(int r, int hi) { return (r & 3) + 8 * (r >> 2) + 4 * hi; }
__device__ __forceinline__ void partialSM(f32x16& p0, f32x16& p1, float& m_reg, float& mn, float& alpha) {
    float pmax = p0[0];
#pragma unroll
    for (int r = 1; r < 16; ++r) pmax = fmaxf(pmax, p0[r]);
#pragma unroll
    for (int r = 0; r < 16; ++r) pmax = fmaxf(pmax, p1[r]);
    { auto rr = __builtin_amdgcn_permlane32_swap(__float_as_uint(pmax), __float_as_uint(pmax), false, false); pmax = fmaxf(__uint_as_float(rr[0]), __uint_as_float(rr[1])); }
    if (__builtin_expect(__all(pmax - m_reg <= THR), 1)) { mn = m_reg; alpha = 1.f; }
    else { mn = fmaxf(m_reg, pmax); alpha = __builtin_amdgcn_exp2f(m_reg - mn); m_reg = mn; }
#pragma unroll
    for (int r = 0; r < 16; ++r) { p0[r] -= mn; p1[r] -= mn; }
#pragma unroll
    for (int r = 0; r < 16; ++r) p0[r] = __builtin_amdgcn_exp2f(p0[r]);
}
__device__ __forceinline__ void finishSM(f32x16& p0, f32x16& p1, float alpha, float& l_reg, bf16x8& pa0, bf16x8& pa1, bf16x8& pa2, bf16x8& pa3) {
#pragma unroll
    for (int r = 0; r < 16; ++r) p1[r] = __builtin_amdgcn_exp2f(p1[r]);
    float ps = 0;
#pragma unroll
    for (int r = 0; r < 16; ++r) ps += p0[r];
#pragma unroll
    for (int r = 0; r < 16; ++r) ps += p1[r];
    { auto rr = __builtin_amdgcn_permlane32_swap(__float_as_uint(ps), __float_as_uint(ps), false, false); ps = __uint_as_float(rr[0]) + __uint_as_float(rr[1]); }
    l_reg = l_reg * alpha + ps;
#define PK4(P, BASE, OUT) do { unsigned a0 = cvt_pk_bf16(P[BASE + 0], P[BASE + 1]), a1 = cvt_pk_bf16(P[BASE + 2], P[BASE + 3]);   \
    unsigned b0 = cvt_pk_bf16(P[BASE + 4], P[BASE + 5]), b1 = cvt_pk_bf16(P[BASE + 6], P[BASE + 7]);                              \
    auto r0 = __builtin_amdgcn_permlane32_swap(a0, b0, false, false); auto r1 = __builtin_amdgcn_permlane32_swap(a1, b1, false, false); \
    u32x4 w = {r0[0], r1[0], r0[1], r1[1]}; OUT = *reinterpret_cast<bf16x8*>(&w); } while (0)
    PK4(p0, 0, pa0); PK4(p0, 8, pa1); PK4(p1, 0, pa2); PK4(p1, 8, pa3);
#undef PK4
}
__device__ __forceinline__ void qkt(f32x16& p0, f32x16& p1, const char* Ks, const bf16x8* qr, int r32, int hi) {
    p0 = f32x16{}; p1 = f32x16{};
    bf16x8 ka[4], kb[4];
#define QK_LD(buf, g) do { _Pragma("unroll") for (int q_ = 0; q_ < 2; ++q_) { const int cb_ = ((2 * (g) + q_) * 16 + hi * 8) * 2; \
        buf[2 * q_] = *reinterpret_cast<const bf16x8*>(Ks + KSWZ(r32, cb_)); buf[2 * q_ + 1] = *reinterpret_cast<const bf16x8*>(Ks + KSWZ(32 + r32, cb_)); } } while (0)
#define QK_MM(buf, g) do { _Pragma("unroll") for (int q_ = 0; q_ < 2; ++q_) { p0 = __builtin_amdgcn_mfma_f32_32x32x16_bf16(buf[2 * q_], qr[2 * (g) + q_], p0, 0, 0, 0); \
        p1 = __builtin_amdgcn_mfma_f32_32x32x16_bf16(buf[2 * q_ + 1], qr[2 * (g) + q_], p1, 0, 0, 0); } } while (0)
    QK_LD(ka, 0); SBAR();
    QK_LD(kb, 1); SBAR(); QK_MM(ka, 0); SBAR();
    QK_LD(ka, 2); SBAR(); QK_MM(kb, 1); SBAR();
    QK_LD(kb, 3); SBAR(); QK_MM(ka, 2); SBAR();
    QK_LD(ka, 4); SBAR(); QK_MM(kb, 3); SBAR();
    QK_LD(kb, 5); SBAR(); QK_MM(ka, 4); SBAR();
    QK_MM(kb, 5); SBAR();
#undef QK_LD
#undef QK_MM
}
__device__ __forceinline__ int v_st(int k, int c) { const int kk = (k & ~0xC) | ((k & 4) << 1) | ((k & 8) >> 1); return ((kk >> 3) * 4 + (c >> 5)) * 512 + ((kk & 7) * 32 + (c & 31)) * 2; }
__device__ __forceinline__ int v_rd_base(int lane) { return ((lane & 3) << 3) | (((lane >> 2) & 3) << 6) | (((lane >> 4) & 1) << 5) | (((lane >> 5) & 1) << 8); }
constexpr int v_rd_off(int d0, int ks, int half) { return d0 * 512 + ks * 4096 + half * 2048; }
template <int OFF> __device__ __forceinline__ s16x4 tr_read(int vb) { s16x4 r; asm volatile("ds_read_b64_tr_b16 %0, %1 offset:%2" : "=&v"(r) : "v"(vb), "i"(OFF) : "memory"); return r; }
struct VFrag { s16x4 l0, h0, l1, h1, l2, h2, l3, h3; };
template <int D0> __device__ __forceinline__ void pv_issue(VFrag& f, int vb) {
    f.l0 = tr_read<v_rd_off(D0, 0, 0)>(vb); f.h0 = tr_read<v_rd_off(D0, 0, 1)>(vb); f.l1 = tr_read<v_rd_off(D0, 1, 0)>(vb); f.h1 = tr_read<v_rd_off(D0, 1, 1)>(vb);
    f.l2 = tr_read<v_rd_off(D0, 2, 0)>(vb); f.h2 = tr_read<v_rd_off(D0, 2, 1)>(vb); f.l3 = tr_read<v_rd_off(D0, 3, 0)>(vb); f.h3 = tr_read<v_rd_off(D0, 3, 1)>(vb);
}
__device__ __forceinline__ void pv_mma(f32x16& od, const VFrag& f, bf16x8 pa0, bf16x8 pa1, bf16x8 pa2, bf16x8 pa3) {
#define PK(L, H) (bf16x8){L[0], L[1], L[2], L[3], H[0], H[1], H[2], H[3]}
    od = __builtin_amdgcn_mfma_f32_32x32x16_bf16(pa0, PK(f.l0, f.h0), od, 0, 0, 0);
    od = __builtin_amdgcn_mfma_f32_32x32x16_bf16(pa1, PK(f.l1, f.h1), od, 0, 0, 0);
    od = __builtin_amdgcn_mfma_f32_32x32x16_bf16(pa2, PK(f.l2, f.h2), od, 0, 0, 0);
    od = __builtin_amdgcn_mfma_f32_32x32x16_bf16(pa3, PK(f.l3, f.h3), od, 0, 0, 0);
#undef PK
}
__device__ __forceinline__ void pv_d0(f32x16* o, int vb, bf16x8 pa0, bf16x8 pa1, bf16x8 pa2, bf16x8 pa3) {
    VFrag fa, fb;
    pv_issue<0>(fa, vb); pv_issue<1>(fb, vb);
    asm volatile("s_waitcnt lgkmcnt(8)" ::: "memory"); SBAR(); pv_mma(o[0], fa, pa0, pa1, pa2, pa3); SBAR();
    pv_issue<2>(fa, vb);
    asm volatile("s_waitcnt lgkmcnt(8)" ::: "memory"); SBAR(); pv_mma(o[1], fb, pa0, pa1, pa2, pa3); SBAR();
    pv_issue<3>(fb, vb);
    asm volatile("s_waitcnt lgkmcnt(8)" ::: "memory"); SBAR(); pv_mma(o[2], fa, pa0, pa1, pa2, pa3); SBAR();
    asm volatile("s_waitcnt lgkmcnt(0)" ::: "memory"); SBAR(); pv_mma(o[3], fb, pa0, pa1, pa2, pa3);
}
__device__ __forceinline__ void attn_unit(const bf16_t* __restrict__ Qb, const bf16_t* __restrict__ Kh, const bf16_t* __restrict__ Vh, bf16_t* __restrict__ Ob, int seq, char* lds) {
    constexpr int LDQ = 1536, LDK = 1536, LDV = 2048, LDO = 1024;
    const int tid = ltid(), wid = tid >> 6, lane = tid & 63, r32 = lane & 31, hi = lane >> 5;
    char* V_lds = lds; char* K_lds = lds + 2 * SHM_V;
    float* wsp = (float*)(lds + 2 * SHM_V + 2 * SHM_K) + wid * 64; float* li_l = wsp; float* al_l = wsp + 32;
    float m_reg = -1e30f, l_reg = 0; f32x16 o[4] = {}; bf16x8 qr[12];
    const bf16_t* Qw = Qb + (long)(wid * 32 + r32) * LDQ + hi * 8;
#pragma unroll
    for (int d0 = 0; d0 < 12; ++d0) qr[d0] = *(const __attribute__((address_space(1))) bf16x8*)((const __attribute__((address_space(1))) bf16_t*)Qw + d0 * 16);
    const int sr = tid >> 4, sc = (tid & 15) * 8, vst0 = v_st(sr, sc), vst1 = v_st(32 + sr, sc);
    int kkey[3], kcb[3];
#pragma unroll
    for (int i = 0; i < 3; ++i) { const int ci = tid + i * 512; kkey[i] = ci / 24; kcb[i] = (ci % 24) * 16; }
    const int vb0 = (int)(uintptr_t)(LAS char*)V_lds + v_rd_base(lane);
    bf16x8 vs0, vs1, ks0, ks1, ks2;
#define GAS __attribute__((address_space(1)))
#define SLOAD(k0) do { vs0 = *(const GAS bf16x8*)((const GAS bf16_t*)Vh + (long)((k0) + sr) * LDV + sc); vs1 = *(const GAS bf16x8*)((const GAS bf16_t*)Vh + (long)((k0) + 32 + sr) * LDV + sc); \
    ks0 = *(const GAS bf16x8*)((const GAS char*)Kh + (long)((k0) + kkey[0]) * (LDK * 2) + kcb[0]); ks1 = *(const GAS bf16x8*)((const GAS char*)Kh + (long)((k0) + kkey[1]) * (LDK * 2) + kcb[1]); \
    ks2 = *(const GAS bf16x8*)((const GAS char*)Kh + (long)((k0) + kkey[2]) * (LDK * 2) + kcb[2]); } while (0)
#define SWRITE(b) do { *(bf16x8*)(V_lds + (b) * SHM_V + vst0) = vs0; *(bf16x8*)(V_lds + (b) * SHM_V + vst1) = vs1; \
    *(bf16x8*)(K_lds + (b) * SHM_K + KSWZ(kkey[0], kcb[0])) = ks0; *(bf16x8*)(K_lds + (b) * SHM_K + KSWZ(kkey[1], kcb[1])) = ks1; *(bf16x8*)(K_lds + (b) * SHM_K + KSWZ(kkey[2], kcb[2])) = ks2; } while (0)
#define SWAIT() asm volatile("s_waitcnt vmcnt(0)" ::: "memory")
#define RESC(al) do { if (__any((al) < 1.f)) { if (hi == 0) al_l[r32] = (al); asm volatile("s_waitcnt lgkmcnt(0)" ::: "memory"); \
    _Pragma("unroll") for (int d = 0; d < 4; ++d) _Pragma("unroll") for (int r = 0; r < 16; ++r) o[d][r] *= al_l[crow(r, hi)]; } } while (0)
    f32x16 p0, p1; float mn, al; bf16x8 pa0, pa1, pa2, pa3; const int NT = seq / KVBLK;
    SLOAD(0); SWAIT(); SWRITE(0); __syncthreads();
    for (int j = 0; j < NT; ++j) {
        const int bsel = j & 1;
        if (j + 1 < NT) SLOAD((j + 1) * KVBLK);
        SBAR(); qkt(p0, p1, K_lds + bsel * SHM_K, qr, r32, hi);
        partialSM(p0, p1, m_reg, mn, al);
        RESC(al);
        finishSM(p0, p1, al, l_reg, pa0, pa1, pa2, pa3); SBAR();
        pv_d0(o, vb0 + bsel * SHM_V, pa0, pa1, pa2, pa3);
        if (j + 1 < NT) { SWAIT(); SWRITE(bsel ^ 1); }
        __syncthreads();
    }
    if (hi == 0) li_l[r32] = l_reg; asm volatile("s_waitcnt lgkmcnt(0)" ::: "memory");
    float rli[16];
#pragma unroll
    for (int r = 0; r < 16; ++r) rli[r] = __builtin_amdgcn_rcpf(li_l[crow(r, hi)]);
    bf16_t* Ow = Ob + (long)(wid * 32) * LDO;
#pragma unroll
    for (int r = 0; r < 16; ++r) { const int orow = crow(r, hi);
#pragma unroll
        for (int d0 = 0; d0 < 4; ++d0) { const float val = o[d0][r] * rli[r]; ((__attribute__((address_space(1))) bf16_t*)Ow)[(long)orow * LDO + d0 * 32 + r32] = (bf16_t)(cvt_pk_bf16(val, val) & 0xffffu); } }
    __syncthreads();
#undef SLOAD
#undef SWRITE
#undef SWAIT
#undef RESC
}
}
__device__ __forceinline__ void attn_phase(const Args& a, LAS unsigned char* lds, int G, int c) {
    const bf16_t* Q = (const bf16_t*)(a.ws + WS_ARENA + A_Q); const bf16_t* K = (const bf16_t*)(a.ws + WS_ARENA + A_K); const bf16_t* KV = (const bf16_t*)(a.ws + WS_ARENA + A_KV);
    bf16_t* O = (bf16_t*)(a.ws + WS_ARENA + A_O);
    const int vcu = (G % 8 == 0) ? (c % 8) * (G / 8) + c / 8 : c;
    for (int L = vcu; L < 1024 + 64; L += G) {
        int b, h, q0, seq;
        if (L < 1024) { b = L >> 7; h = (L >> 4) & 7; q0 = CTX + (L & 15) * 256; seq = SEG; } else { const int l2 = L - 1024; b = l2 >> 3; h = l2 & 7; q0 = 0; seq = CTX; }
        const size_t rb = (size_t)b * SEG;
        att::attn_unit(Q + (rb + q0) * 1536 + h * QKH, K + rb * 1536 + h * QKH, KV + rb * 2048 + h * 256 + 128, O + (rb + q0) * 1024 + h * VH, seq, (char*)lds);
    }
}

namespace scan {
constexpr int CH = 32, STEP_B = 6 * 256, BUF_B = CH * STEP_B  , YB_B = CH * 64 * 4  , LDS_B = 2 * BUF_B + 2 * YB_B  , NCH = SEG / CH  ;
constexpr int TILE_B = 64 * 65 * 4, MT_TILES = 24 * 896;
struct MTile { const float* src; bf16_t* dst; int sld, ldd, n0, k0, grpd; };
__device__ __forceinline__ int step_row(int b, int dir, int gs) {
    const int base = b * SEG;
    if (dir == 0) return base + gs;
    return gs < CTX ? base + (CTX - 1 - gs) : base + CTX + (SEG - 1 - gs);
}
struct Raw { u32x4 k, r, v, wl, al, vf, vl; };
}
__device__ __forceinline__ bool moe_tile(const Args& a, int k, int t, scan::MTile& m) {
    if (CS_NOTILE || t >= scan::MT_TILES) return false;
    const int j = t / 896, tl = t - j * 896, e = j / 3, kind = j - e * 3; int tn;
    const size_t so = (size_t)(k * NE + e) * D * DFE;
    if (kind < 2) { m.src = a.in[kind == 0 ? I_M1 : I_M3] + so; m.sld = DFE; m.dst = (bf16_t*)(a.ws + WS_ARENA + A_WM13) + (size_t)e * E_M13 + (kind ? (size_t)128 * 1024 : 0); m.ldd = 1024; tn = 56; m.grpd = 1; }
    else { m.src = a.in[I_M2] + so; m.sld = D; m.dst = (bf16_t*)(a.ws + WS_ARENA + A_WM2) + (size_t)e * E_M2; m.ldd = DFE; tn = 16; m.grpd = 0; }
    m.n0 = (tl % tn) * 64; m.k0 = (tl / tn) * 64; return true;
}
__device__ __forceinline__ void scan_phase(const Args& a, int j, const bf16_t* Vsrc, const bool vres, LAS unsigned char* lds, int G, int c) {
    using namespace scan;
    int mt_round = 0;
    const int tid = ltid(), wave = tid >> 6, lane = tid & 63;
    const bf16_t* RR = (const bf16_t*)(a.ws + WS_ARENA + A_RR); const bf16_t* RK = (const bf16_t*)(a.ws + WS_ARENA + A_RK);
    for (int chain = c; chain < 256; chain += G) {
        const int b = chain >> 5, h = (chain >> 1) & 15, dir = chain & 1;
        const bf16_t* WL = (const bf16_t*)(a.ws + WS_ARENA + (dir ? A_WL1 : A_WL0)); const bf16_t* AL = (const bf16_t*)(a.ws + WS_ARENA + (dir ? A_AL1 : A_AL0));
        bf16_t* Y = (bf16_t*)(a.ws + WS_ARENA + (dir ? A_YR : A_YF));
        if (wave >= 4) {
            const int pt = tid - 256, s = pt >> 3, seg = pt & 7, ch0 = h * 64 + seg * 8;
            float kkp[8], kap[8], v0p[8];
            const bf16_t* VFp = (const bf16_t*)(a.ws + WS_VF); const bf16_t* VLp = (const bf16_t*)(a.ws + WS_ARENA + A_VL);
#pragma unroll
            for (int e = 0; e < 8; ++e) v0p[e] = vres ? a.in[I_V0][ch0 + e] : 0.f;
#pragma unroll
            for (int e = 0; e < 8; ++e) { kkp[e] = a.in[I_KK][(size_t)j * D + ch0 + e]; kap[e] = a.in[I_KA][(size_t)j * D + ch0 + e]; }
            Raw raw;
#define GLOAD(q) do { const size_t off_ = (size_t)step_row(b, dir, (q) * CH + s) * 1024 + ch0; \
                raw.k = *(const u32x4*)(RK + off_); raw.r = *(const u32x4*)(RR + off_); raw.v = *(const u32x4*)(Vsrc + off_); raw.wl = *(const u32x4*)(WL + off_); raw.al = *(const u32x4*)(AL + off_); \
                if (vres) { raw.vf = *(const u32x4*)(VFp + off_); raw.vl = *(const u32x4*)(VLp + off_); } } while (0)
#define PRODUCE(buf) do { \
                float k[8], r[8], v[8], wl[8], al[8]; unpack8(raw.k, k); unpack8(raw.r, r); unpack8(raw.v, v); unpack8(raw.wl, wl); unpack8(raw.al, al); \
                if (vres) { float vf[8], vl[8]; unpack8(raw.vf, vf); unpack8(raw.vl, vl); _Pragma("unroll") for (int e = 0; e < 8; ++e) v[e] = v[e] + (vf[e] - v[e]) * sigmoidf_(v0p[e] + vl[e]); } \
                float ad[8], kd[8], kk[8], ww[8], ss = 0.f; \
                _Pragma("unroll") for (int e = 0; e < 8; ++e) { ad[e] = al[e]; kd[e] = k[e] * (1.0f + (ad[e] - 1.0f) * kap[e]); kk[e] = k[e] * kkp[e]; ss += kk[e] * kk[e]; \
                    ww[e] = __expf(-wl[e]); } \
                ss = red8(ss); const float inv = 1.0f / fmaxf(sqrtf(ss), 1e-12f); \
                LAS f32x4* o = (LAS f32x4*)(lds + (buf) * BUF_B + s * STEP_B + seg * 32); \
                _Pragma("unroll") for (int e = 0; e < 8; ++e) kk[e] *= inv; \
                o[0] = (f32x4){ww[0], ww[1], ww[2], ww[3]}; o[1] = (f32x4){ww[4], ww[5], ww[6], ww[7]}; \
                o[16] = (f32x4){kd[0], kd[1], kd[2], kd[3]}; o[17] = (f32x4){kd[4], kd[5], kd[6], kd[7]}; \
                o[32] = (f32x4){-kk[0], -kk[1], -kk[2], -kk[3]}; o[33] = (f32x4){-kk[4], -kk[5], -kk[6], -kk[7]}; \
                o[48] = (f32x4){kk[0] * ad[0], kk[1] * ad[1], kk[2] * ad[2], kk[3] * ad[3]}; o[49] = (f32x4){kk[4] * ad[4], kk[5] * ad[5], kk[6] * ad[6], kk[7] * ad[7]}; \
                o[64] = (f32x4){r[0], r[1], r[2], r[3]}; o[65] = (f32x4){r[4], r[5], r[6], r[7]}; \
                o[80] = (f32x4){v[0], v[1], v[2], v[3]}; o[81] = (f32x4){v[4], v[5], v[6], v[7]}; } while (0)
#define YSTORE(q) do { const LAS f32x4* yp = (const LAS f32x4*)(lds + 2 * BUF_B + ((q) & 1) * YB_B + s * 256 + seg * 32); const f32x4 y0 = yp[0], y1 = yp[1]; \
                u32x4 w; w.x = cvt_pk_bf16(y0[0], y0[1]); w.y = cvt_pk_bf16(y0[2], y0[3]); w.z = cvt_pk_bf16(y1[0], y1[1]); w.w = cvt_pk_bf16(y1[2], y1[3]); \
                *(u32x4*)(Y + (size_t)step_row(b, dir, (q) * CH + s) * 1024 + ch0) = w; } while (0)
            GLOAD(0); PRODUCE(0); GLOAD(1);
            __syncthreads();
            f32x4 treg[4]; const int kl = pt >> 4, nq = (pt & 15) * 4, sn = pt >> 2, sk = (pt & 3) * 16;
            for (int q = 0; q < NCH; ++q) {
                if (q + 1 < NCH) { PRODUCE((q + 1) & 1); if (q + 2 < NCH) GLOAD(q + 2); }
                if (q >= 1) YSTORE(q - 1);
                MTile m;
                if (q >= 2 && moe_tile(a, j, c + (mt_round + q - 2) * G, m)) {
                    const LAS float* tl_ = (const LAS float*)(lds + LDS_B + (q & 1) * TILE_B); float f0[8], f1[8];
#pragma unroll
                    for (int e = 0; e < 8; ++e) { f0[e] = tl_[(sk + e) * 65 + sn]; f1[e] = tl_[(sk + 8 + e) * 65 + sn]; }
                    const int n = m.n0 + sn, dr = m.grpd ? ((n >> 7) * 256 + (n & 127)) : n; bf16_t* dp = m.dst + (size_t)dr * m.ldd + m.k0 + sk;
                    *(u32x4*)dp = pack8(f0); *(u32x4*)(dp + 8) = pack8(f1); }
                if (q >= 1 && q <= NCH - 2 && moe_tile(a, j, c + (mt_round + q - 1) * G, m)) {
                    LAS float* tl_ = (LAS float*)(lds + LDS_B + ((q - 1) & 1) * TILE_B);
#pragma unroll
                    for (int p = 0; p < 4; ++p) { LAS float* tp = tl_ + (kl + 16 * p) * 65 + nq; tp[0] = treg[p][0]; tp[1] = treg[p][1]; tp[2] = treg[p][2]; tp[3] = treg[p][3]; } }
                if (q <= NCH - 3 && moe_tile(a, j, c + (mt_round + q) * G, m)) {
#pragma unroll
                    for (int p = 0; p < 4; ++p) treg[p] = *(const f32x4*)(m.src + (size_t)(m.k0 + kl + 16 * p) * m.sld + m.n0 + nq); }
                __syncthreads();
            }
            YSTORE(NCH - 1);
#undef GLOAD
#undef PRODUCE
#undef YSTORE
        } else {
            const int rp = lane >> 3, ks = lane & 7, v0i = wave * 16 + rp * 2;
            f32x2 s0[4], s1[4];
#pragma unroll
            for (int i = 0; i < 4; ++i) { s0[i] = (f32x2){0.f, 0.f}; s1[i] = (f32x2){0.f, 0.f}; }
            __syncthreads();
            struct Vecs { f32x4 w0, w1, k0, k1, a0, a1, b0, b1, r0, r1; f32x2 vv; };
#define LOADV(V, t) do { const LAS f32x4* p_ = (const LAS f32x4*)(bp + (t) * STEP_B); V.w0 = p_[0]; V.w1 = p_[1]; V.k0 = p_[16]; V.k1 = p_[17]; V.a0 = p_[32]; V.a1 = p_[33]; \
                    V.b0 = p_[48]; V.b1 = p_[49]; V.r0 = p_[64]; V.r1 = p_[65]; V.vv = *(const LAS f32x2*)(vp + (t) * STEP_B); } while (0)
#define STEPV(V, t, HAVEPREV) do { \
                    const f32x2 wv[4] = {{V.w0[0], V.w0[1]}, {V.w0[2], V.w0[3]}, {V.w1[0], V.w1[1]}, {V.w1[2], V.w1[3]}}, kv[4] = {{V.k0[0], V.k0[1]}, {V.k0[2], V.k0[3]}, {V.k1[0], V.k1[1]}, {V.k1[2], V.k1[3]}}; \
                    const f32x2 av[4] = {{V.a0[0], V.a0[1]}, {V.a0[2], V.a0[3]}, {V.a1[0], V.a1[1]}, {V.a1[2], V.a1[3]}}, bv[4] = {{V.b0[0], V.b0[1]}, {V.b0[2], V.b0[3]}, {V.b1[0], V.b1[1]}, {V.b1[2], V.b1[3]}}; \
                    const f32x2 rv[4] = {{V.r0[0], V.r0[1]}, {V.r0[2], V.r0[3]}, {V.r1[0], V.r1[1]}, {V.r1[2], V.r1[3]}}; \
                    f32x2 d0 = s0[0] * av[0], d1 = s1[0] * av[0]; \
                    d0 += s0[1] * av[1]; d1 += s1[1] * av[1]; d0 += s0[2] * av[2]; d1 += s1[2] * av[2]; d0 += s0[3] * av[3]; d1 += s1[3] * av[3]; \
                    float h0 = d0.x + d0.y, h1 = d1.x + d1.y; \
                    h0 += dpp_f<0xB1>(h0); h1 += dpp_f<0xB1>(h1); yp0 += dpp_f<0xB1>(yp0); yp1 += dpp_f<0xB1>(yp1); \
                    h0 += dpp_f<0x4E>(h0); h1 += dpp_f<0x4E>(h1); yp0 += dpp_f<0x4E>(yp0); yp1 += dpp_f<0x4E>(yp1); \
                    h0 += dpp_f<0x141>(h0); h1 += dpp_f<0x141>(h1); yp0 += dpp_f<0x141>(yp0); yp1 += dpp_f<0x141>(yp1); \
                    if (HAVEPREV) yb[((t) - 1) * 64 + v0i + (ks & 1)] = (ks & 1) ? yp1 : yp0; \
                    const f32x2 sa0v = {h0, h0}, sa1v = {h1, h1}, v0v = {V.vv.x, V.vv.x}, v1v = {V.vv.y, V.vv.y}; \
                    _Pragma("unroll") for (int i = 0; i < 4; ++i) { s0[i] = s0[i] * wv[i] + sa0v * bv[i] + v0v * kv[i]; s1[i] = s1[i] * wv[i] + sa1v * bv[i] + v1v * kv[i]; } \
                    f32x2 y0 = s0[0] * rv[0], y1 = s1[0] * rv[0]; \
                    y0 += s0[1] * rv[1]; y1 += s1[1] * rv[1]; y0 += s0[2] * rv[2]; y1 += s1[2] * rv[2]; y0 += s0[3] * rv[3]; y1 += s1[3] * rv[3]; \
                    yp0 = y0.x + y0.y; yp1 = y1.x + y1.y; } while (0)
            for (int q = 0; q < NCH; ++q) {
                const LAS unsigned char* bp = lds + (q & 1) * BUF_B + ks * 32;
                const LAS unsigned char* vp = lds + (q & 1) * BUF_B + 5 * 256 + v0i * 4;
                LAS float* yb = (LAS float*)(lds + 2 * BUF_B + (q & 1) * YB_B);
                Vecs VA, VB; float yp0 = 0.f, yp1 = 0.f;
                LOADV(VA, 0); LOADV(VB, 1);
                STEPV(VA, 0, false);
                LOADV(VA, 2);
                STEPV(VB, 1, true);
#pragma unroll 1
                for (int t = 2; t < CH; t += 2) {
                    LOADV(VB, t + 1);
                    STEPV(VA, t, true);
                    LOADV(VA, t + 2);
                    STEPV(VB, t + 1, true);
                }
                yp0 = red8(yp0); yp1 = red8(yp1);
                yb[(CH - 1) * 64 + v0i + (ks & 1)] = (ks & 1) ? yp1 : yp0;
                __syncthreads();
            }
#undef LOADV
#undef STEPV
        }
        mt_round += NCH - 2;
        __syncthreads();
    }
}

namespace cs {
constexpr int C = 32, NCK = SEG / C;
constexpr int TM = 72, CM = 40, TMB = TM * 2, CMB = CM * 2;
constexpr int SZ_TM = 32 * TMB, SZ_CM = 64 * CMB, SZ_C32 = 32 * CMB;
constexpr int X_ATM = 0, X_RTM = SZ_TM, X_BHTM = 2 * SZ_TM, X_KHTM = 3 * SZ_TM, X_ACM = 4 * SZ_TM, X_RCM = X_ACM + SZ_CM, X_BBCM = X_RCM + SZ_CM, X_KBCM = X_BBCM + SZ_CM, X_B = X_KBCM + SZ_CM;
constexpr int Y_VCM = 0, Y_GC = SZ_CM, Y_B = SZ_CM + 256;
constexpr int OFF_X = 0, OFF_Y = 2 * X_B, OFF_MID = OFF_Y + 2 * Y_B;
constexpr int M_NL = 0, M_NR = SZ_C32, M_TT = 2 * SZ_C32, M_ARBT = 3 * SZ_C32, M_AAK = 4 * SZ_C32, M_UP = 5 * SZ_C32, M_W = 6 * SZ_C32, M_ARK = M_W + SZ_CM, MID_B = M_ARK + 4096;
constexpr int OFF_OUT = OFF_MID + MID_B;
constexpr int O_PST = 0, O_QST = 64 * TMB, O_PYT = O_QST + SZ_CM, O_QYT = O_PYT + SZ_TM, OUT_B = O_QYT + SZ_C32;
constexpr int OFF_YB = OFF_OUT + OUT_B, OFF_ES = OFF_YB + 8192, OFF_WT = OFF_ES + 2048, LDS_END = OFF_WT + 64 * 65 * 4;
__device__ __forceinline__ int rho(int r, int h) { return (r & 3) + 8 * (r >> 2) + 4 * h; }
__device__ __forceinline__ int perm16(int k) { return (k & ~0xC) | ((k & 4) << 1) | ((k & 8) >> 1); }
typedef __bf16 bf16v2 __attribute__((ext_vector_type(2)));
__device__ __forceinline__ unsigned cvt_pk_bf16_c(float lo, float hi) { const bf16v2 v = __builtin_convertvector((f32x2){lo, hi}, bf16v2); return __builtin_bit_cast(unsigned, v); }
__device__ __forceinline__ bf16_t f2bf(float x) { const __bf16 b = (__bf16)x; return __builtin_bit_cast(bf16_t, b); }
__device__ __forceinline__ float bf2f(bf16_t x) { return __uint_as_float((unsigned)x << 16); }
template <int KS> __device__ __forceinline__ void mma32t(f32x16& acc, const LAS unsigned char* A, int lda, const LAS unsigned char* B, int ldb, int r32, int h) {
    bf16x8 a[KS], b[KS];
#pragma unroll
    for (int s = 0; s < KS; ++s) { a[s] = *(const LAS bf16x8*)(A + r32 * lda + s * 32 + h * 16); b[s] = *(const LAS bf16x8*)(B + r32 * ldb + s * 32 + h * 16); }
#pragma unroll
    for (int s = 0; s < KS; ++s) acc = __builtin_amdgcn_mfma_f32_32x32x16_bf16(a[s], b[s], acc, 0, 0, 0);
}
__device__ __forceinline__ void mma32(f32x16& acc, const LAS unsigned char* A, int lda, const LAS unsigned char* B, int ldb, int ksteps, int r32, int h) {
    if (ksteps == 4) mma32t<4>(acc, A, lda, B, ldb, r32, h); else mma32t<2>(acc, A, lda, B, ldb, r32, h);
}
__device__ __forceinline__ void st_bf(const f32x16& acc, LAS unsigned char* dst, int sr, int sc, int r32, int h) {
#pragma unroll
    for (int r = 0; r < 16; ++r) *(LAS bf16_t*)(dst + rho(r, h) * sr + r32 * sc) = f2bf(acc[r]);
}
template <bool PERM> __device__ __forceinline__ void st_bf_T(const f32x16& acc, LAS unsigned char* dst, int sc, int r32, int h) {
#pragma unroll
    for (int m = 0; m < 4; ++m) { const int row0 = 8 * m + 4 * h, pos = PERM ? perm16(row0) : row0; u32x2 w; w.x = cvt_pk_bf16_c(acc[4 * m], acc[4 * m + 1]); w.y = cvt_pk_bf16_c(acc[4 * m + 2], acc[4 * m + 3]);
        *(LAS u32x2*)(dst + r32 * sc + pos * 2) = w; }
}
}
#define CS_BAR() do { asm volatile("s_waitcnt lgkmcnt(0)" ::: "memory"); __builtin_amdgcn_s_barrier(); asm volatile("" ::: "memory"); } while (0)
__device__ __forceinline__ void scan_chunked(const Args& a, int jl, const bf16_t* Vsrc, const bool vres, LAS unsigned char* lds, int G, int c) {
    using namespace cs;
    const int tid0 = ltid(), wave = __builtin_amdgcn_readfirstlane(tid0 >> 6);
    typedef const __attribute__((address_space(1))) bf16_t* gcp; typedef __attribute__((address_space(1))) bf16_t* gwp;
    gcp RR = (gcp)(a.ws + WS_ARENA + A_RR); gcp RK = (gcp)(a.ws + WS_ARENA + A_RK);
    gcp VFp = (gcp)(a.ws + WS_VF); gcp VLp = (gcp)(a.ws + WS_ARENA + A_VL); gcp Vg = (gcp)Vsrc;
    int mt0 = 0;
    for (int chain = c; chain < 256; chain += G) {
        const int b = chain >> 5, hd = (chain >> 1) & 15, dir = chain & 1;
        gcp WL = (gcp)(a.ws + WS_ARENA + (dir ? A_WL1 : A_WL0)); gcp AL = (gcp)(a.ws + WS_ARENA + (dir ? A_AL1 : A_AL0));
        gwp Y = (gwp)(a.ws + WS_ARENA + (dir ? A_YCR : A_YCF));
        const int gcol0 = hd * 64 + (tid0 & 63);
        const float kkp = a.in[I_KK][(size_t)jl * D + gcol0], kap = a.in[I_KA][(size_t)jl * D + gcol0], v0p = vres ? a.in[I_V0][gcol0] : 0.f;
        f32x16 S0 = {}, S1 = {};
        f32x4 wreg[8];
        constexpr int ntok = 4; const int tok0 = 4 * wave;
        bf16_t rk_[4], rr_[4], ra_[4], rv_[4], re_[4], rf_[4], rl_[4];
        bf16_t qk_[4], qr_[4], qa_[4], qv_[4], qe_[4], qf_[4], ql_[4];
#define CS_LOAD(q) do { _Pragma("unroll") for (int tk_ = 0; tk_ < 4; ++tk_) { const unsigned off_ = (unsigned)scan::step_row(b, dir, (q) * 32 + tok0 + tk_) * 1024u + (unsigned)gcol; \
                qk_[tk_] = RK[off_]; qr_[tk_] = RR[off_]; qa_[tk_] = AL[off_]; qe_[tk_] = WL[off_]; qv_[tk_] = Vg[off_]; if (vres) { qf_[tk_] = VFp[off_]; ql_[tk_] = VLp[off_]; } } } while (0)
#define CS_COPY() do { _Pragma("unroll") for (int tk_ = 0; tk_ < 4; ++tk_) { rk_[tk_] = qk_[tk_]; rr_[tk_] = qr_[tk_]; ra_[tk_] = qa_[tk_]; re_[tk_] = qe_[tk_]; rv_[tk_] = qv_[tk_]; rf_[tk_] = qf_[tk_]; rl_[tk_] = ql_[tk_]; } } while (0)
#define CS_ESUM() do { float es_ = 0.f; _Pragma("unroll") for (int tk_ = 0; tk_ < 4; ++tk_) es_ += bf2f(re_[tk_]); *(LAS float*)(lds + OFF_ES + wave * 256 + lane * 4) = es_; } while (0)
#define CS_MAIN(q) do { \
            LAS unsigned char* X_ = lds + OFF_X + ((q) & 1) * X_B; LAS unsigned char* Yb_ = lds + OFF_Y + ((q) & 1) * Y_B; \
            float before_ = 0.f, tot_ = 0.f; \
            _Pragma("unroll") for (int w_ = 0; w_ < 8; ++w_) { const float es_ = *(const LAS float*)(lds + OFF_ES + w_ * 256 + lane * 4); before_ += (w_ < wave) ? es_ : 0.f; tot_ += es_; } \
            float erun_ = __expf(-before_); const float gct_ = __expf(-tot_); \
            _Pragma("unroll") for (int p_ = 0; p_ < 2; ++p_) { const int t_ = tok0 + 2 * p_;            \
                const f32x2 kraw_ = {bf2f(rk_[2 * p_]), bf2f(rk_[2 * p_ + 1])}, rr2_ = {bf2f(rr_[2 * p_]), bf2f(rr_[2 * p_ + 1])}, ad_ = {bf2f(ra_[2 * p_]), bf2f(ra_[2 * p_ + 1])}; \
                f32x2 vv_ = {bf2f(rv_[2 * p_]), bf2f(rv_[2 * p_ + 1])}; \
                if (vres) { const f32x2 vf_ = {bf2f(rf_[2 * p_]), bf2f(rf_[2 * p_ + 1])}; const float s0_ = sigmoidf_(v0p + bf2f(rl_[2 * p_])), s1_ = sigmoidf_(v0p + bf2f(rl_[2 * p_ + 1])); \
                    vv_ = vv_ + (vf_ - vv_) * (f32x2){s0_, s1_}; } \
                const f32x2 kd_ = kraw_ * ((ad_ - 1.0f) * kap + 1.0f), kkr_ = kraw_ * kkp, sq_ = kkr_ * kkr_; \
                float s0 = sq_.x, s1 = sq_.y; \
                s0 += dpp_f<0xB1>(s0); s1 += dpp_f<0xB1>(s1); s0 += dpp_f<0x4E>(s0); s1 += dpp_f<0x4E>(s1); s0 += dpp_f<0x141>(s0); s1 += dpp_f<0x141>(s1); s0 += dpp_f<0x140>(s0); s1 += dpp_f<0x140>(s1); \
                const int i0_ = __float_as_int(s0), i1_ = __float_as_int(s1); \
                const float ss0_ = (__int_as_float(__builtin_amdgcn_readlane(i0_, 0)) + __int_as_float(__builtin_amdgcn_readlane(i0_, 16))) + (__int_as_float(__builtin_amdgcn_readlane(i0_, 32)) + __int_as_float(__builtin_amdgcn_readlane(i0_, 48))); \
                const float ss1_ = (__int_as_float(__builtin_amdgcn_readlane(i1_, 0)) + __int_as_float(__builtin_amdgcn_readlane(i1_, 16))) + (__int_as_float(__builtin_amdgcn_readlane(i1_, 32)) + __int_as_float(__builtin_amdgcn_readlane(i1_, 48))); \
                const f32x2 kk_ = kkr_ * (f32x2){__builtin_amdgcn_rsqf(fmaxf(ss0_, 1e-24f)), __builtin_amdgcn_rsqf(fmaxf(ss1_, 1e-24f))}; \
                const float w0_ = __expf(-bf2f(re_[2 * p_])), w1_ = __expf(-bf2f(re_[2 * p_ + 1])); \
                f32x2 E1_, E2_; E1_.x = erun_; E2_.x = erun_ * w0_; E1_.y = E2_.x; E2_.y = E2_.x * w1_; erun_ = E2_.y; \
                const f32x2 Ei_ = {__builtin_amdgcn_rcpf(E2_.x), __builtin_amdgcn_rcpf(E2_.y)}, E3_ = Ei_ * gct_, bv_ = kk_ * ad_; \
                const f32x2 at2_ = -(kk_ * E1_), rt2_ = rr2_ * E2_, bh2_ = bv_ * Ei_, kh2_ = kd_ * Ei_, kb2_ = kd_ * E3_, bb2_ = bv_ * E3_; \
                const unsigned pa_ = cvt_pk_bf16_c(at2_.x, at2_.y), pr_ = cvt_pk_bf16_c(rt2_.x, rt2_.y), pbh_ = cvt_pk_bf16_c(bh2_.x, bh2_.y), pkh_ = cvt_pk_bf16_c(kh2_.x, kh2_.y); \
                *(LAS unsigned*)(X_ + X_ACM + lane * CMB + t_ * 2) = pa_; *(LAS unsigned*)(X_ + X_RCM + lane * CMB + t_ * 2) = pr_; \
                *(LAS unsigned*)(X_ + X_KBCM + lane * CMB + t_ * 2) = cvt_pk_bf16_c(kb2_.x, kb2_.y); *(LAS unsigned*)(X_ + X_BBCM + lane * CMB + t_ * 2) = cvt_pk_bf16_c(bb2_.x, bb2_.y); \
                *(LAS unsigned*)(Yb_ + Y_VCM + lane * CMB + t_ * 2) = cvt_pk_bf16_c(vv_.x, vv_.y); \
                *(LAS bf16_t*)(X_ + X_ATM + t_ * TMB + lane * 2) = (bf16_t)pa_; *(LAS bf16_t*)(X_ + X_ATM + (t_ + 1) * TMB + lane * 2) = (bf16_t)(pa_ >> 16); \
                *(LAS bf16_t*)(X_ + X_RTM + t_ * TMB + lane * 2) = (bf16_t)pr_; *(LAS bf16_t*)(X_ + X_RTM + (t_ + 1) * TMB + lane * 2) = (bf16_t)(pr_ >> 16); \
                *(LAS bf16_t*)(X_ + X_BHTM + t_ * TMB + lane * 2) = (bf16_t)pbh_; *(LAS bf16_t*)(X_ + X_BHTM + (t_ + 1) * TMB + lane * 2) = (bf16_t)(pbh_ >> 16); \
                *(LAS bf16_t*)(X_ + X_KHTM + t_ * TMB + lane * 2) = (bf16_t)pkh_; *(LAS bf16_t*)(X_ + X_KHTM + (t_ + 1) * TMB + lane * 2) = (bf16_t)(pkh_ >> 16); } \
            if (wave == 7) *(LAS float*)(Yb_ + Y_GC + lane * 4) = gct_; } while (0)
        { const int tid = ltid(), lane = tid & 63, gcol = hd * 64 + lane;
          { CS_LOAD(0); CS_COPY(); CS_ESUM(); }
          CS_BAR();
          { CS_LOAD(1); CS_MAIN(0); } }
        CS_BAR();
        for (int it = -1; it < NCK; ++it) {
            const bool have_next = (it + 1 < NCK);
            const int tid = ltid(), lane = tid & 63, r32 = lane & 31, h = lane >> 5, gcol = hd * 64 + lane;
            LAS unsigned char* X = lds + OFF_X + ((it + 1) & 1) * X_B; LAS unsigned char* M = lds + OFF_MID; LAS unsigned char* O = lds + OFF_OUT;
            f32x16 acc = {}, accT = {};
            if (have_next && wave < 4) {
                if (wave == 0) {
                    bf16x8 fb[4], fa[4];
#pragma unroll
                    for (int s4 = 0; s4 < 4; ++s4) { fb[s4] = *(const LAS bf16x8*)(X + X_BHTM + r32 * TMB + s4 * 32 + h * 16); fa[s4] = *(const LAS bf16x8*)(X + X_ATM + r32 * TMB + s4 * 32 + h * 16); }
#pragma unroll
                    for (int s4 = 0; s4 < 4; ++s4) { acc = __builtin_amdgcn_mfma_f32_32x32x16_bf16(fb[s4], fa[s4], acc, 0, 0, 0); accT = __builtin_amdgcn_mfma_f32_32x32x16_bf16(fa[s4], fb[s4], accT, 0, 0, 0); }
#pragma unroll
                    for (int r = 0; r < 16; ++r) accT[r] = (r32 < rho(r, h)) ? accT[r] : 0.f; }
                else if (wave == 2) mma32(acc, X + X_ATM, TMB, X + X_KHTM, TMB, 4, r32, h);
                else mma32(acc, X + ((wave & 2) ? X_KHTM : X_BHTM), TMB, X + ((wave & 1) ? X_RTM : X_ATM), TMB, 4, r32, h);
#pragma unroll
                for (int r = 0; r < 16; ++r) { const int i = rho(r, h); const bool keep = (wave == 2) ? (r32 < i) : ((wave & 1) ? (i <= r32) : (i < r32)); acc[r] = keep ? acc[r] : 0.f; }
                if (wave == 0) { }
                else if (wave == 1) st_bf_T<false>(acc, M + M_ARBT, CMB, r32, h);
                else if (wave == 2) st_bf_T<false>(acc, M + M_AAK, CMB, r32, h);
                else {
#pragma unroll
                    for (int m = 0; m < 4; ++m) *(LAS f32x4*)(M + M_ARK + r32 * 128 + (8 * m + 4 * h) * 4) = (f32x4){acc[4 * m], acc[4 * m + 1], acc[4 * m + 2], acc[4 * m + 3]}; }
            }
            if (CS_SERIAL) CS_BAR();
            if (it >= 0 && wave >= 6) {
                const int vb = wave - 6; const LAS unsigned char* Yb = lds + OFF_Y + (it & 1) * Y_B;
                bf16x8 bs[4];
#pragma unroll
                for (int s = 0; s < 2; ++s) { u32x4 w0, w1;
                    w0.x = cvt_pk_bf16_c(S0[8 * s + 0], S0[8 * s + 1]); w0.y = cvt_pk_bf16_c(S0[8 * s + 2], S0[8 * s + 3]); w0.z = cvt_pk_bf16_c(S0[8 * s + 4], S0[8 * s + 5]); w0.w = cvt_pk_bf16_c(S0[8 * s + 6], S0[8 * s + 7]);
                    w1.x = cvt_pk_bf16_c(S1[8 * s + 0], S1[8 * s + 1]); w1.y = cvt_pk_bf16_c(S1[8 * s + 2], S1[8 * s + 3]); w1.z = cvt_pk_bf16_c(S1[8 * s + 4], S1[8 * s + 5]); w1.w = cvt_pk_bf16_c(S1[8 * s + 6], S1[8 * s + 7]);
                    bs[s] = *reinterpret_cast<bf16x8*>(&w0); bs[2 + s] = *reinterpret_cast<bf16x8*>(&w1); }
                const LAS unsigned char* Vr = Yb + Y_VCM + (vb * 32 + r32) * CMB + h * 16;
                const bf16x8 bv0 = *(const LAS bf16x8*)Vr, bv1 = *(const LAS bf16x8*)(Vr + 32);
                bf16x8 fy[6], fs[6];
#pragma unroll
                for (int s = 0; s < 4; ++s) { fy[s] = *(const LAS bf16x8*)(O + O_PYT + r32 * TMB + s * 32 + h * 16); fs[s] = *(const LAS bf16x8*)(O + O_PST + r32 * TMB + s * 32 + h * 16); }
#pragma unroll
                for (int s = 0; s < 2; ++s) { fy[4 + s] = *(const LAS bf16x8*)(O + O_QYT + r32 * CMB + s * 32 + h * 16); fs[4 + s] = *(const LAS bf16x8*)(O + O_QST + r32 * CMB + s * 32 + h * 16); }
                f32x16 n0, n1;
#pragma unroll
                for (int m = 0; m < 4; ++m) { const f32x4 g0 = *(const LAS f32x4*)(Yb + Y_GC + (8 * m + 4 * h) * 4), g1 = *(const LAS f32x4*)(Yb + Y_GC + (32 + 8 * m + 4 * h) * 4);
#pragma unroll
                    for (int i = 0; i < 4; ++i) { n0[4 * m + i] = S0[4 * m + i] * g0[i]; n1[4 * m + i] = S1[4 * m + i] * g1[i]; } }
                f32x16 ya = {};
#pragma unroll
                for (int s = 0; s < 4; ++s) { ya = __builtin_amdgcn_mfma_f32_32x32x16_bf16(fy[s], bs[s], ya, 0, 0, 0); n0 = __builtin_amdgcn_mfma_f32_32x32x16_bf16(fs[s], bs[s], n0, 0, 0, 0); }
                ya = __builtin_amdgcn_mfma_f32_32x32x16_bf16(fy[4], bv0, ya, 0, 0, 0); n0 = __builtin_amdgcn_mfma_f32_32x32x16_bf16(fs[4], bv0, n0, 0, 0, 0);
                ya = __builtin_amdgcn_mfma_f32_32x32x16_bf16(fy[5], bv1, ya, 0, 0, 0); n0 = __builtin_amdgcn_mfma_f32_32x32x16_bf16(fs[5], bv1, n0, 0, 0, 0);
#pragma unroll
                for (int s = 0; s < 4; ++s) fs[s] = *(const LAS bf16x8*)(O + O_PST + (32 + r32) * TMB + s * 32 + h * 16);
#pragma unroll
                for (int s = 0; s < 2; ++s) fs[4 + s] = *(const LAS bf16x8*)(O + O_QST + (32 + r32) * CMB + s * 32 + h * 16);
#pragma unroll
                for (int r = 0; r < 16; ++r) *(LAS float*)(lds + OFF_YB + rho(r, h) * 256 + (vb * 32 + r32) * 4) = ya[r];
#pragma unroll
                for (int s = 0; s < 4; ++s) n1 = __builtin_amdgcn_mfma_f32_32x32x16_bf16(fs[s], bs[s], n1, 0, 0, 0);
                n1 = __builtin_amdgcn_mfma_f32_32x32x16_bf16(fs[4], bv0, n1, 0, 0, 0); n1 = __builtin_amdgcn_mfma_f32_32x32x16_bf16(fs[5], bv1, n1, 0, 0, 0);
                S0 = n0; S1 = n1;
            }
            if (it + 2 < NCK) { CS_COPY(); CS_ESUM(); }
            if (wave == 4 || wave == 5) {
                const int pt = tid - 256; scan::MTile m;
                if (it >= 0 && it <= NCK - 2 && moe_tile(a, jl, c + (mt0 + it) * G, m)) {
                    const LAS float* tl_ = (const LAS float*)(lds + OFF_WT); const int sn = pt >> 1, sk = (pt & 1) * 32;
                    const int n = m.n0 + sn, dr = m.grpd ? ((n >> 7) * 256 + (n & 127)) : n; bf16_t* dp = m.dst + (size_t)dr * m.ldd + m.k0 + sk;
#pragma unroll
                    for (int q8 = 0; q8 < 4; ++q8) { float f[8];
#pragma unroll
                        for (int e = 0; e < 8; ++e) f[e] = tl_[(sk + q8 * 8 + e) * 65 + sn];
                        *(__attribute__((address_space(1))) u32x4*)(dp + q8 * 8) = pack8(f); } }
                if (it + 1 < NCK - 1 && moe_tile(a, jl, c + (mt0 + it + 1) * G, m)) { const int kl = pt >> 4, nq = (pt & 15) * 4;
#pragma unroll
                    for (int p8 = 0; p8 < 8; ++p8) wreg[p8] = *(const __attribute__((address_space(1))) f32x4*)(m.src + (size_t)(m.k0 + kl + 8 * p8) * m.sld + m.n0 + nq); }
            }
            CS_BAR();
            if (have_next && wave == 0) {
                f32x16 Tm = acc, Mm = acc, Mt = accT;
#pragma unroll
                for (int r = 0; r < 16; ++r) Tm[r] += (rho(r, h) == r32) ? 1.0f : 0.f;
#define CS_SLAB(tile, s) ({ u32x4 w_; w_.x = cvt_pk_bf16_c(tile[8 * (s) + 0], tile[8 * (s) + 1]); w_.y = cvt_pk_bf16_c(tile[8 * (s) + 2], tile[8 * (s) + 3]); \
                    w_.z = cvt_pk_bf16_c(tile[8 * (s) + 4], tile[8 * (s) + 5]); w_.w = cvt_pk_bf16_c(tile[8 * (s) + 6], tile[8 * (s) + 7]); *reinterpret_cast<bf16x8*>(&w_); })
                for (int lvl = 0; lvl < 4; ++lvl) {
                    const bf16x8 m0 = CS_SLAB(Mm, 0), m1 = CS_SLAB(Mm, 1), t0_ = CS_SLAB(Mt, 0), t1_ = CS_SLAB(Mt, 1);
                    f32x16 m2 = {}, m2t = {};
                    m2 = __builtin_amdgcn_mfma_f32_32x32x16_bf16(t0_, m0, m2, 0, 0, 0); m2t = __builtin_amdgcn_mfma_f32_32x32x16_bf16(m0, t0_, m2t, 0, 0, 0);
                    m2 = __builtin_amdgcn_mfma_f32_32x32x16_bf16(t1_, m1, m2, 0, 0, 0); m2t = __builtin_amdgcn_mfma_f32_32x32x16_bf16(m1, t1_, m2t, 0, 0, 0);
                    Mm = m2; Mt = m2t;
                    { const bf16x8 a0 = CS_SLAB(Mt, 0), a1 = CS_SLAB(Mt, 1), bt0 = CS_SLAB(Tm, 0), bt1 = CS_SLAB(Tm, 1);
                      Tm = __builtin_amdgcn_mfma_f32_32x32x16_bf16(a0, bt0, Tm, 0, 0, 0); Tm = __builtin_amdgcn_mfma_f32_32x32x16_bf16(a1, bt1, Tm, 0, 0, 0); }
                }
                st_bf_T<false>(Tm, M + M_TT, CMB, r32, h);
            }
            if (CS_SERIAL) CS_BAR();
            if (it + 3 < NCK) CS_LOAD(it + 3);
            if (it + 2 < NCK) CS_MAIN(it + 2);
            if (CS_SERIAL) CS_BAR();
            if (it >= 0 && wave >= 5) {
                for (int item = tid - 320; item < 256; item += 192) { const int t = item >> 3, seg = item & 7;
                    const LAS f32x4* yp = (const LAS f32x4*)(lds + OFF_YB + t * 256 + seg * 32); const f32x4 y0 = yp[0], y1 = yp[1];
                    u32x4 w; w.x = cvt_pk_bf16(y0[0], y0[1]); w.y = cvt_pk_bf16(y0[2], y0[3]); w.z = cvt_pk_bf16(y1[0], y1[1]); w.w = cvt_pk_bf16(y1[2], y1[3]);
                    *(__attribute__((address_space(1))) u32x4*)(Y + (size_t)scan::step_row(b, dir, it * 32 + t) * 1024 + hd * 64 + seg * 8) = w; }
            }
            CS_BAR();
            if (have_next && wave < 3) {
                f32x16 d = {};
                if (wave < 2) { mma32(d, M + M_TT, CMB, X + X_ACM + wave * 32 * CMB, CMB, 2, r32, h); st_bf_T<false>(d, M + M_W + wave * 32 * CMB, CMB, r32, h); }
                else { mma32(d, M + M_TT, CMB, M + M_AAK, CMB, 2, r32, h); st_bf_T<false>(d, M + M_UP, CMB, r32, h); }
            }
            if (wave == 4 || wave == 5) { const int pt = tid - 256, kl = pt >> 4, nq = (pt & 15) * 4; scan::MTile m;
                if (it + 1 < NCK - 1 && moe_tile(a, jl, c + (mt0 + it + 1) * G, m)) { LAS float* tl_ = (LAS float*)(lds + OFF_WT);
#pragma unroll
                    for (int p8 = 0; p8 < 8; ++p8) { LAS float* tp = tl_ + (kl + 8 * p8) * 65 + nq; tp[0] = wreg[p8][0]; tp[1] = wreg[p8][1]; tp[2] = wreg[p8][2]; tp[3] = wreg[p8][3]; } } }
            CS_BAR();
            if (have_next) {
                f32x16 d = {};
                if (wave < 4) { const int kt = wave & 1, kpt = wave >> 1;
                    mma32(d, M + M_W + kt * 32 * CMB, CMB, X + X_BBCM + kpt * 32 * CMB, CMB, 2, r32, h);
                    st_bf_T<true>(d, O + O_PST + kpt * 32 * TMB + kt * 64, TMB, r32, h); }
                else if (wave < 6) { const int kt = wave - 4;
                    u32x2 ra[4];
#pragma unroll
                    for (int m = 0; m < 4; ++m) ra[m] = *(const LAS u32x2*)(X + X_RTM + r32 * TMB + (kt * 32 + 8 * m + 4 * h) * 2);
                    mma32(d, M + M_W + kt * 32 * CMB, CMB, M + M_ARBT, CMB, 2, r32, h);
#pragma unroll
                    for (int m = 0; m < 4; ++m) { d[4 * m] += bflo(ra[m].x); d[4 * m + 1] += bfhi(ra[m].x); d[4 * m + 2] += bflo(ra[m].y); d[4 * m + 3] += bfhi(ra[m].y); }
                    st_bf_T<true>(d, O + O_PYT + kt * 64, TMB, r32, h); }
                else { const int kpt = wave - 6;
                    u32x2 ka[4];
#pragma unroll
                    for (int m = 0; m < 4; ++m) ka[m] = *(const LAS u32x2*)(X + X_KBCM + (kpt * 32 + r32) * CMB + (8 * m + 4 * h) * 2);
                    mma32(d, M + M_UP, CMB, X + X_BBCM + kpt * 32 * CMB, CMB, 2, r32, h);
#pragma unroll
                    for (int m = 0; m < 4; ++m) { d[4 * m] += bflo(ka[m].x); d[4 * m + 1] += bfhi(ka[m].x); d[4 * m + 2] += bflo(ka[m].y); d[4 * m + 3] += bfhi(ka[m].y); }
                    st_bf_T<false>(d, O + O_QST + kpt * 32 * CMB, CMB, r32, h);
                    if (wave == 7) { f32x16 e = {}; f32x4 aa[4];
#pragma unroll
                        for (int m = 0; m < 4; ++m) aa[m] = *(const LAS f32x4*)(M + M_ARK + r32 * 128 + (8 * m + 4 * h) * 4);
                        mma32(e, M + M_UP, CMB, M + M_ARBT, CMB, 2, r32, h);
#pragma unroll
                        for (int m = 0; m < 4; ++m) { e[4 * m] += aa[m][0]; e[4 * m + 1] += aa[m][1]; e[4 * m + 2] += aa[m][2]; e[4 * m + 3] += aa[m][3]; }
                        st_bf_T<false>(e, O + O_QYT, CMB, r32, h); } }
            }
            CS_BAR();
        }
#undef CS_LOAD
#undef CS_COPY
#undef CS_ESUM
#undef CS_MAIN
        mt0 += NCK - 1;
    }
}


__device__ __forceinline__ void scan_compare(const Args& a, LAS unsigned char* lds, int G, int c) {
    const int tid = ltid();
    asm volatile("s_waitcnt vmcnt(0)" ::: "memory"); __syncthreads();
    for (int chain = c; chain < 256; chain += G) {
        const int b = chain >> 5, hd = (chain >> 1) & 15, dir = chain & 1;
        const bf16_t* Yo = (const bf16_t*)(a.ws + WS_ARENA + (dir ? A_YR : A_YF)); const bf16_t* Yc = (const bf16_t*)(a.ws + WS_ARENA + (dir ? A_YCR : A_YCF));
        float md = 0.f, mo = 0.f;
        for (int i = tid; i < SEG * 8; i += NTHR) { const int r = i >> 3, seg = i & 7; const size_t off = (size_t)(b * SEG + r) * 1024 + hd * 64 + seg * 8;
            u32x4 wo, wc; const unsigned* po = (const unsigned*)(Yo + off); const unsigned* pc = (const unsigned*)(Yc + off);
#pragma unroll
            for (int q = 0; q < 4; ++q) { wo[q] = __hip_atomic_load(po + q, __ATOMIC_RELAXED, __HIP_MEMORY_SCOPE_AGENT); wc[q] = __hip_atomic_load(pc + q, __ATOMIC_RELAXED, __HIP_MEMORY_SCOPE_AGENT); }
            float yo[8], yc[8]; unpack8(wo, yo); unpack8(wc, yc);
#pragma unroll
            for (int e = 0; e < 8; ++e) { md = fmaxf(md, fabsf(yo[e] - yc[e])); mo = fmaxf(mo, fabsf(yo[e])); } }
#pragma unroll
        for (int o = 32; o >= 1; o >>= 1) { md = fmaxf(md, __shfl_xor(md, o)); mo = fmaxf(mo, __shfl_xor(mo, o)); }
        LAS float* red = (LAS float*)lds;
        if ((tid & 63) == 0) { red[(tid >> 6) * 2] = md; red[(tid >> 6) * 2 + 1] = mo; }
        __syncthreads();
        if (tid == 0) { float d = 0.f, o = 0.f; for (int w = 0; w < 8; ++w) { d = fmaxf(d, red[w * 2]); o = fmaxf(o, red[w * 2 + 1]); }
            if (!(d <= CS_TOL * o)) { bf16_t* Yw = (bf16_t*)(a.ws + WS_ARENA + (dir ? A_YR : A_YF)); Yw[(size_t)(b * SEG + CTX) * 1024 + hd * 64] = (bf16_t)0x7fc0u; } }
        __syncthreads();
    }
}

__device__ __forceinline__ void rwkv_outprep(const Args& a, int j, const bf16_t* Vsrc, const bool vres, int G, int c) {
    const int lane = ltid() & 63; int r0, r1; wave_rows(G, c, r0, r1);
    const bf16_t* YF = (const bf16_t*)(a.ws + WS_ARENA + A_YF); const bf16_t* YR = (const bf16_t*)(a.ws + WS_ARENA + A_YR);
    const bf16_t* RR = (const bf16_t*)(a.ws + WS_ARENA + A_RR); const bf16_t* RK = (const bf16_t*)(a.ws + WS_ARENA + A_RK);
    const bf16_t* AL0 = (const bf16_t*)(a.ws + WS_ARENA + A_AL0); const bf16_t* AL1 = (const bf16_t*)(a.ws + WS_ARENA + A_AL1); const bf16_t* GG = (const bf16_t*)(a.ws + WS_ARENA + A_G);
    bf16_t* O = (bf16_t*)(a.ws + WS_ARENA + A_RO);
    float lnw[16], lnb[16], rk[16], ka[16];
#pragma unroll
    for (int jj = 0; jj < 2; ++jj)
#pragma unroll
        for (int e = 0; e < 8; ++e) { const int col = jj * 512 + lane * 8 + e, i = jj * 8 + e; lnw[i] = a.in[I_LNW][j * D + col]; lnb[i] = a.in[I_LNB][j * D + col]; rk[i] = a.in[I_RK][j * D + col];
            ka[i] = a.in[I_KA][j * D + col]; }
    for (int row = r0; row < r1; ++row) {
        u32x4 out[2];
#pragma unroll
        for (int jj = 0; jj < 2; ++jj) { const size_t off = (size_t)row * 1024 + jj * 512 + lane * 8;
            float yf[8], yr[8], r[8], k[8], v[8], l0[8], l1[8], g[8], y[8];
            unpack8(*(const u32x4*)(YF + off), yf); unpack8(*(const u32x4*)(YR + off), yr); unpack8(*(const u32x4*)(RR + off), r); unpack8(*(const u32x4*)(RK + off), k);
            unpack8(*(const u32x4*)(Vsrc + off), v);
            if (vres) { float vf[8], vl[8]; unpack8(*(const u32x4*)((const bf16_t*)(a.ws + WS_VF) + off), vf); unpack8(*(const u32x4*)((const bf16_t*)(a.ws + WS_ARENA + A_VL) + off), vl);
#pragma unroll
                for (int e = 0; e < 8; ++e) v[e] = v[e] + (vf[e] - v[e]) * sigmoidf_(a.in[I_V0][jj * 512 + lane * 8 + e] + vl[e]); }
            unpack8(*(const u32x4*)(AL0 + off), l0); unpack8(*(const u32x4*)(AL1 + off), l1); unpack8(*(const u32x4*)(GG + off), g);
            float sm = 0.f, dot = 0.f;
#pragma unroll
            for (int e = 0; e < 8; ++e) { const int i = jj * 8 + e; y[e] = yf[e] + yr[e]; sm += y[e];
                const float adm = 0.5f * (l0[e] + l1[e]); const float kb = k[e] * (1.0f + (adm - 1.0f) * ka[i]); dot += r[e] * kb * rk[i]; }
            sm = red8(sm); dot = red8(dot); const float mu = sm * (1.0f / 64.0f); float var = 0.f;
#pragma unroll
            for (int e = 0; e < 8; ++e) { const float d = y[e] - mu; var += d * d; }
            var = red8(var) * (1.0f / 64.0f); const float rstd = 1.0f / sqrtf(var + LNX_EPS);
            float o[8];
#pragma unroll
            for (int e = 0; e < 8; ++e) { const int i = jj * 8 + e; o[e] = ((y[e] - mu) * rstd * lnw[i] + lnb[i] + dot * v[e]) * g[e]; }
            out[jj] = pack8(o); }
        *(u32x4*)(O + (size_t)row * 1024 + lane * 8) = out[0]; *(u32x4*)(O + (size_t)row * 1024 + 512 + lane * 8) = out[1];
    }
}

__device__ __forceinline__ void moe_gather(const Args& a, LAS unsigned char* lds, int G, int c) {
    const int tid = ltid(), wave = tid >> 6, lane = tid & 63; int r0, r1; wave_rows(G, c, r0, r1);
    LAS int* cnt = (LAS int*)lds;
    if (tid < 16) cnt[tid] = 0;
    __syncthreads();
    const int* hist = (const int*)(a.ws + WS_HIST); const int nchunk = G * NWAVE, first = c * NWAVE;
    int pre[8], tot[8];
#pragma unroll
    for (int e = 0; e < 8; ++e) { pre[e] = 0; tot[e] = 0; }
    for (int ch = tid; ch < nchunk; ch += NTHR) { const u32x4 h0 = *(const u32x4*)(hist + (size_t)ch * 8), h1 = *(const u32x4*)(hist + (size_t)ch * 8 + 4); const int m = ch < first ? 1 : 0;
        tot[0] += h0[0]; tot[1] += h0[1]; tot[2] += h0[2]; tot[3] += h0[3]; tot[4] += h1[0]; tot[5] += h1[1]; tot[6] += h1[2]; tot[7] += h1[3];
        pre[0] += m * h0[0]; pre[1] += m * h0[1]; pre[2] += m * h0[2]; pre[3] += m * h0[3]; pre[4] += m * h1[0]; pre[5] += m * h1[1]; pre[6] += m * h1[2]; pre[7] += m * h1[3]; }
#pragma unroll
    for (int e = 0; e < 8; ++e) { int p = pre[e], t = tot[e];
#pragma unroll
        for (int o = 32; o >= 1; o >>= 1) { p += __shfl_xor(p, o); t += __shfl_xor(t, o); }
        if (lane == 0) { __hip_atomic_fetch_add(&cnt[e], p, __ATOMIC_RELAXED, __HIP_MEMORY_SCOPE_WORKGROUP); __hip_atomic_fetch_add(&cnt[8 + e], t, __ATOMIC_RELAXED, __HIP_MEMORY_SCOPE_WORKGROUP); } }
    __syncthreads();
    int base[9], run[8]; base[0] = 0;
#pragma unroll
    for (int e = 0; e < 8; ++e) base[e + 1] = base[e] + ((cnt[8 + e] + 255) & ~255);
    if (c == 0 && tid < 9) { int v = 0;
#pragma unroll
        for (int e = 0; e < 9; ++e) v = (tid == e) ? base[e] : v;
        ((int*)(a.ws + WS_META))[tid] = v; }
#pragma unroll
    for (int e = 0; e < 8; ++e) { int p = cnt[e];
        for (int w = 0; w < wave; ++w) p += hist[(size_t)(first + w) * 8 + e];
        run[e] = base[e] + p; }
    const bf16_t* H = (const bf16_t*)(a.ws + WS_ARENA + A_H); bf16_t* HS = (bf16_t*)(a.ws + WS_ARENA + A_HS);
    for (int row = r0; row < r1; ++row) {
        const u32x4 rt = *(const u32x4*)(a.ws + WS_ROUTE + (size_t)row * 16); const int e0 = (int)rt[0], e1 = (int)rt[1];
        if (e0 < 0) continue;
        int s0 = 0, s1 = 0;
#pragma unroll
        for (int e = 0; e < 8; ++e) { if (e == e0) { s0 = run[e]; run[e] += 1; } if (e == e1) { s1 = run[e]; run[e] += 1; } }
        const u32x4 h0 = *(const u32x4*)(H + (size_t)row * 1024 + lane * 8), h1 = *(const u32x4*)(H + (size_t)row * 1024 + 512 + lane * 8);
        *(u32x4*)(HS + (size_t)s0 * 1024 + lane * 8) = h0; *(u32x4*)(HS + (size_t)s0 * 1024 + 512 + lane * 8) = h1;
        *(u32x4*)(HS + (size_t)s1 * 1024 + lane * 8) = h0; *(u32x4*)(HS + (size_t)s1 * 1024 + 512 + lane * 8) = h1;
        if (lane == 0) { int* sl = (int*)(a.ws + WS_RSLOT) + (size_t)row * 2; sl[0] = s0; sl[1] = s1; }
    }
}
__device__ __forceinline__ void final_combine(const Args& a, int layer, int G, int c) {
    const int lane = ltid() & 63; int r0, r1; wave_rows(G, c, r0, r1);
    for (int row = r0; row < r1; ++row) { if (row % SEG < CTX) continue;
        float* xp = xrow(a, row); float x[16]; load_x16(xp, lane, x); moe_combine16(a, row, layer, lane, x); store_x16(xp, lane, x); }
}

constexpr int NPH = 42;
#define CT(k) (((PSEL) >> (k)) & 1u)
#ifndef PROBE_MASK
#define PROBE_MASK 0u
#endif
#define REPS(k) for (int rep_ = 0; rep_ <= (int)(((PROBE_MASK) >> (k)) & 1u); ++rep_)
constexpr int LDS_ST_OFF = 161792;
constexpr int LDS_BYTES = LDS_ST_OFF + 64;
constexpr int TILE_OFF = 73728;
#define WSP(off) (a.ws + WS_ARENA + (off))
template <unsigned PSEL>
__global__ void __launch_bounds__(NTHR, 2) fwd(Args ka) {
    extern __shared__ __attribute__((aligned(16))) unsigned char lds_raw[];
    LAS unsigned char* lds = (LAS unsigned char*)lds_raw;
    const int Gk = gridDim.x, ck = blockIdx.x, tid = ltid();
    volatile LAS unsigned* st = (volatile LAS unsigned*)(lds + LDS_ST_OFF);
    if (tid < 4) st[tid] = 0u;
    __syncthreads();
    XcdBarrier bar; bar.bar = (unsigned*)(ka.ws + WS_CTL); bar.x = 0; bar.st = st;
    if (ka.ph_hi - ka.ph_lo > 1) bar = xcd_barrier_post((unsigned*)(ka.ws + WS_CTL), st);
#define IN(p) (ka.ph_lo <= (p) && (p) < ka.ph_hi)
#define PHB const Args a = launder_args(ka); const int G = launder_s(Gk), c = launder_s(ck); (void)G; (void)c;
#define SEAM(p) do { if (IN(p) && IN((p) + 1)) xcd_barrier(bar); } while (0)
    const size_t P1K = (size_t)256 * 1024 * 2;

    { const int jj_ = 0; const bool last_ = false;
    if (CT(20) && IN(0)) REPS(20) { PHB const bf16_t* wm = wmla(a, jj_); const bf16_t* wr_ = wrwkv(a, jj_); const bf16_t* wf = wffn(a, jj_); bf16_t* Vb = last_ ? (bf16_t*)WSP(A_RV) : (bf16_t*)(a.ws + WS_VF); (void)wm; (void)wr_; (void)wf; (void)Vb;
            { prologue_misc(a, lds, G, c); run_prep(a, lds + TILE_OFF, -1, 0, G, c); } }
    }
    SEAM(0);

    for (int jj = 0; jj < 2; ++jj) {
        const int pb = 1 + jj * 20, lm = 2 * jj, lr = 2 * jj + 1, jj_ = jj; const bool last = (jj == 1), last_ = last;

        if (CT(0) && IN(pb + 0)) REPS(0) { PHB const bf16_t* wm = wmla(a, jj_); const bf16_t* wr_ = wrwkv(a, jj_); const bf16_t* wf = wffn(a, jj_); bf16_t* Vb = last_ ? (bf16_t*)WSP(A_RV) : (bf16_t*)(a.ws + WS_VF); (void)wm; (void)wr_; (void)wf; (void)Vb;
            { if (jj == 0) norm_plain<false, true>(a, lm, a.in[I_N1G] + lm * D, 0, (bf16_t*)WSP(A_H), G, c); else norm_plain<true>(a, lm, a.in[I_N1G] + lm * D, 0, (bf16_t*)WSP(A_H), G, c); } }
        SEAM(pb + 0);
        if (CT(1) && IN(pb + 1)) REPS(1) { PHB const bf16_t* wm = wmla(a, jj_); const bf16_t* wr_ = wrwkv(a, jj_); const bf16_t* wf = wffn(a, jj_); bf16_t* Vb = last_ ? (bf16_t*)WSP(A_RV) : (bf16_t*)(a.ws + WS_VF); (void)wm; (void)wr_; (void)wf; (void)Vb;
            { MapSimple S{(const char*)WSP(A_H), (const char*)wm, P1K, P1K, 3, 16, 0}; EpiBf<FPlain> E{{(bf16_t*)WSP(A_QKVA), 768}};
            pg8::gemm_phase(lds, 1024, 1024, S, E, G, c); } }
        SEAM(pb + 1);
        if (CT(2) && IN(pb + 2)) REPS(2) { PHB const bf16_t* wm = wmla(a, jj_); const bf16_t* wr_ = wrwkv(a, jj_); const bf16_t* wf = wffn(a, jj_); bf16_t* Vb = last_ ? (bf16_t*)WSP(A_RV) : (bf16_t*)(a.ws + WS_VF); (void)wm; (void)wr_; (void)wf; (void)Vb;
            mla_stats(a, G, c); }
        SEAM(pb + 2);
        if (CT(3) && IN(pb + 3)) REPS(3) { PHB const bf16_t* wm = wmla(a, jj_); const bf16_t* wr_ = wrwkv(a, jj_); const bf16_t* wf = wffn(a, jj_); bf16_t* Vb = last_ ? (bf16_t*)WSP(A_RV) : (bf16_t*)(a.ws + WS_VF); (void)wm; (void)wr_; (void)wf; (void)Vb;
            { MapQKV S{(const char*)WSP(A_QKVA), (const char*)(wm + E_QKVA), (const char*)(wm + E_QKVA + E_QB)};
            EpiQKV E{(bf16_t*)WSP(A_Q), (bf16_t*)WSP(A_KV), (const float*)(a.ws + WS_RS), (const float*)(a.ws + WS_RS) + R};
            pg8::gemm_phase(lds, 768, 384, S, E, G, c); } }
        SEAM(pb + 3);
        if (CT(4) && IN(pb + 4)) REPS(4) { PHB const bf16_t* wm = wmla(a, jj_); const bf16_t* wr_ = wrwkv(a, jj_); const bf16_t* wf = wffn(a, jj_); bf16_t* Vb = last_ ? (bf16_t*)WSP(A_RV) : (bf16_t*)(a.ws + WS_VF); (void)wm; (void)wr_; (void)wf; (void)Vb;
            mla_qkpost(a, jj, G, c); }
        SEAM(pb + 4);
        if (CT(5) && IN(pb + 5)) REPS(5) { PHB const bf16_t* wm = wmla(a, jj_); const bf16_t* wr_ = wrwkv(a, jj_); const bf16_t* wf = wffn(a, jj_); bf16_t* Vb = last_ ? (bf16_t*)WSP(A_RV) : (bf16_t*)(a.ws + WS_VF); (void)wm; (void)wr_; (void)wf; (void)Vb;
            attn_phase(a, lds, G, c); }
        SEAM(pb + 5);
        if (CT(6) && IN(pb + 6)) REPS(6) { PHB const bf16_t* wm = wmla(a, jj_); const bf16_t* wr_ = wrwkv(a, jj_); const bf16_t* wf = wffn(a, jj_); bf16_t* Vb = last_ ? (bf16_t*)WSP(A_RV) : (bf16_t*)(a.ws + WS_VF); (void)wm; (void)wr_; (void)wf; (void)Vb;
            { MapSimple S{(const char*)WSP(A_O), (const char*)(wm + E_QKVA + E_QB + E_KVB), P1K, P1K, 4, 16, 0}; EpiResid E{(float*)(a.ws + WS_CS), a.out, (const float*)(a.ws + WS_MODS), lm, 2, jj == 0 ? a.in[I_CTX] : (const float*)(a.ws + WS_CS), jj == 0 ? a.in[I_X] : (const float*)a.out};
            pg8::gemm_phase(lds, 1024, 1024, S, E, G, c); } }
        SEAM(pb + 6);
        if (CT(7) && IN(pb + 7)) REPS(7) { PHB const bf16_t* wm = wmla(a, jj_); const bf16_t* wr_ = wrwkv(a, jj_); const bf16_t* wf = wffn(a, jj_); bf16_t* Vb = last_ ? (bf16_t*)WSP(A_RV) : (bf16_t*)(a.ws + WS_VF); (void)wm; (void)wr_; (void)wf; (void)Vb;
            norm_plain<false>(a, lm, a.in[I_N2G] + lm * D, 3, (bf16_t*)WSP(A_H), G, c); }
        SEAM(pb + 7);
        if (CT(8) && IN(pb + 8)) REPS(8) { PHB const bf16_t* wm = wmla(a, jj_); const bf16_t* wr_ = wrwkv(a, jj_); const bf16_t* wf = wffn(a, jj_); bf16_t* Vb = last_ ? (bf16_t*)WSP(A_RV) : (bf16_t*)(a.ws + WS_VF); (void)wm; (void)wr_; (void)wf; (void)Vb;
            { MapSimple S{(const char*)WSP(A_H), (const char*)wf, P1K, P1K, 22, 16, 0}; EpiSwiGLU E{(bf16_t*)WSP(A_FHID), DFF};
            pg8::gemm_phase(lds, 1024, 1024, S, E, G, c); } }
        SEAM(pb + 8);
        if (CT(9) && IN(pb + 9)) REPS(9) { PHB const bf16_t* wm = wmla(a, jj_); const bf16_t* wr_ = wrwkv(a, jj_); const bf16_t* wf = wffn(a, jj_); bf16_t* Vb = last_ ? (bf16_t*)WSP(A_RV) : (bf16_t*)(a.ws + WS_VF); (void)wm; (void)wr_; (void)wf; (void)Vb;
            { MapSimple S{(const char*)WSP(A_FHID), (const char*)(wf + E_F13), (size_t)256 * DFF * 2, (size_t)256 * DFF * 2, 4, 44, 0}; EpiResid E{(float*)(a.ws + WS_CS), a.out, (const float*)(a.ws + WS_MODS), lm, 5, (const float*)(a.ws + WS_CS), (const float*)a.out};
            pg8::gemm_phase(lds, DFF, DFF, S, E, G, c); } }
        SEAM(pb + 9);
        if (CT(10) && IN(pb + 10)) REPS(10) { PHB const bf16_t* wm = wmla(a, jj_); const bf16_t* wr_ = wrwkv(a, jj_); const bf16_t* wf = wffn(a, jj_); bf16_t* Vb = last_ ? (bf16_t*)WSP(A_RV) : (bf16_t*)(a.ws + WS_VF); (void)wm; (void)wr_; (void)wf; (void)Vb;
            norm_mix(a, lr, jj, G, c); }
        SEAM(pb + 10);
        if (CT(11) && IN(pb + 11)) REPS(11) { PHB const bf16_t* wm = wmla(a, jj_); const bf16_t* wr_ = wrwkv(a, jj_); const bf16_t* wf = wffn(a, jj_); bf16_t* Vb = last_ ? (bf16_t*)WSP(A_RV) : (bf16_t*)(a.ws + WS_VF); (void)wm; (void)wr_; (void)wf; (void)Vb;
            { MapRw1 S{(const char*)WSP(A_AX), (const char*)wr_, (const char*)(wr_ + E_B1), (const char*)(wr_ + E_B1 + E_B2)};
            EpiBf<FRw1> E{{(bf16_t*)WSP(A_L1), (bf16_t*)WSP(A_RR), (bf16_t*)WSP(A_RK), Vb}};
            pg8::gemm_phase(lds, 5120, 2048, S, E, G, c); } }
        SEAM(pb + 11);
        if (CT(12) && IN(pb + 12)) REPS(12) { PHB const bf16_t* wm = wmla(a, jj_); const bf16_t* wr_ = wrwkv(a, jj_); const bf16_t* wf = wffn(a, jj_); bf16_t* Vb = last_ ? (bf16_t*)WSP(A_RV) : (bf16_t*)(a.ws + WS_VF); (void)wm; (void)wr_; (void)wf; (void)Vb;
            { int nt4 = 4; asm volatile("" : "+s"(nt4));
            MapRw2 S{(const char*)WSP(A_L1), (const char*)(wr_ + E_B1 + E_B2 + E_L1), (const char*)(wr_ + E_B1 + E_B2 + E_L1 + E_L2A), 0, last ? 24 : 20, nt4};
            EpiRw2 E{(bf16_t*)WSP(A_WL0), (bf16_t*)WSP(A_VL), a.in[I_W0] + (size_t)jj * 2 * D, a.in[I_A0] + (size_t)jj * 2 * D}; pg8::gemm_phase(lds, 512, 256, S, E, G, c); } }
        SEAM(pb + 12);
        if (CT(13) && IN(pb + 13)) REPS(13) { PHB const bf16_t* wm = wmla(a, jj_); const bf16_t* wr_ = wrwkv(a, jj_); const bf16_t* wf = wffn(a, jj_); bf16_t* Vb = last_ ? (bf16_t*)WSP(A_RV) : (bf16_t*)(a.ws + WS_VF); (void)wm; (void)wr_; (void)wf; (void)Vb;
            { if (SCAN_CHUNKED) scan_chunked(a, jj, Vb, last, lds, G, c); if (!SCAN_CHUNKED || CS_BOTH) { __syncthreads(); scan_phase(a, jj, Vb, last, lds, G, c); }
              if (SCAN_CHUNKED && CS_BOTH) scan_compare(a, lds, G, c); } }
        SEAM(pb + 13);
        if (CT(14) && IN(pb + 14)) REPS(14) { PHB const bf16_t* wm = wmla(a, jj_); const bf16_t* wr_ = wrwkv(a, jj_); const bf16_t* wf = wffn(a, jj_); bf16_t* Vb = last_ ? (bf16_t*)WSP(A_RV) : (bf16_t*)(a.ws + WS_VF); (void)wm; (void)wr_; (void)wf; (void)Vb;
            rwkv_outprep(a, jj, Vb, last, G, c); }
        SEAM(pb + 14);
        if (CT(15) && IN(pb + 15)) REPS(15) { PHB const bf16_t* wm = wmla(a, jj_); const bf16_t* wr_ = wrwkv(a, jj_); const bf16_t* wf = wffn(a, jj_); bf16_t* Vb = last_ ? (bf16_t*)WSP(A_RV) : (bf16_t*)(a.ws + WS_VF); (void)wm; (void)wr_; (void)wf; (void)Vb;
            { MapSimple S{(const char*)WSP(A_RO), (const char*)(wr_ + E_B1 + 1024), P1K, (size_t)256 * 2048 * 2, 4, 16, last ? 1 : 0}; EpiResid E{(float*)(a.ws + WS_CS), a.out, (const float*)(a.ws + WS_MODS), lr, 2, (const float*)(a.ws + WS_CS), (const float*)a.out};
            pg8::gemm_phase(lds, 1024, 2048, S, E, G, c); } }
        SEAM(pb + 15);
        if (CT(16) && IN(pb + 16)) REPS(16) { PHB const bf16_t* wm = wmla(a, jj_); const bf16_t* wr_ = wrwkv(a, jj_); const bf16_t* wf = wffn(a, jj_); bf16_t* Vb = last_ ? (bf16_t*)WSP(A_RV) : (bf16_t*)(a.ws + WS_VF); (void)wm; (void)wr_; (void)wf; (void)Vb;
            { norm_router(a, lr, jj, last, lds, G, c); run_prep(a, lds + TILE_OFF, jj, CS_NOTILE ? 0 : (SCAN_CHUNKED ? cs::NCK - 1 : scan::NCH - 2), G, c);   } }
        SEAM(pb + 16);
        if (CT(17) && IN(pb + 17)) REPS(17) { PHB const bf16_t* wm = wmla(a, jj_); const bf16_t* wr_ = wrwkv(a, jj_); const bf16_t* wf = wffn(a, jj_); bf16_t* Vb = last_ ? (bf16_t*)WSP(A_RV) : (bf16_t*)(a.ws + WS_VF); (void)wm; (void)wr_; (void)wf; (void)Vb;
            moe_gather(a, lds, G, c); }
        SEAM(pb + 17);
        if (CT(18) && IN(pb + 18)) REPS(18) { PHB const bf16_t* wm = wmla(a, jj_); const bf16_t* wr_ = wrwkv(a, jj_); const bf16_t* wf = wffn(a, jj_); bf16_t* Vb = last_ ? (bf16_t*)WSP(A_RV) : (bf16_t*)(a.ws + WS_VF); (void)wm; (void)wr_; (void)wf; (void)Vb;
            { MapMoe S{(const char*)WSP(A_HS), (const char*)WSP(A_WM13), P1K, E_M13 * 2, P1K, 28, 16, (const int*)(a.ws + WS_META)}; EpiSwiGLU E{(bf16_t*)WSP(A_MHID), DFE};
            pg8::gemm_phase(lds, 1024, 1024, S, E, G, c); } }
        SEAM(pb + 18);
        if (CT(19) && IN(pb + 19)) REPS(19) { PHB const bf16_t* wm = wmla(a, jj_); const bf16_t* wr_ = wrwkv(a, jj_); const bf16_t* wf = wffn(a, jj_); bf16_t* Vb = last_ ? (bf16_t*)WSP(A_RV) : (bf16_t*)(a.ws + WS_VF); (void)wm; (void)wr_; (void)wf; (void)Vb;
            { MapMoe S{(const char*)WSP(A_MHID), (const char*)WSP(A_WM2), (size_t)256 * DFE * 2, E_M2 * 2, (size_t)256 * DFE * 2, 4, 56, (const int*)(a.ws + WS_META)}; EpiBf<FPlain> E{{(bf16_t*)WSP(A_Y2), 1024}};
            pg8::gemm_phase(lds, DFE, DFE, S, E, G, c); } }
        SEAM(pb + 19);
    }
    { const int jj_ = 1; const bool last_ = true;
    if (CT(21) && IN(41)) REPS(21) { PHB const bf16_t* wm = wmla(a, jj_); const bf16_t* wr_ = wrwkv(a, jj_); const bf16_t* wf = wffn(a, jj_); bf16_t* Vb = last_ ? (bf16_t*)WSP(A_RV) : (bf16_t*)(a.ws + WS_VF); (void)wm; (void)wr_; (void)wf; (void)Vb;
            final_combine(a, 3, G, c); }
    }
#undef IN
#undef SEAM
}

typedef void (*KernFn)(Args);
#if MK_ONE_LAUNCH
#ifndef PMASK
#define PMASK 0x3fffffu
#endif
static KernFn kern_of(int) { return fwd<PMASK>; }
#else
static KernFn kern_of(int p) {
    static const KernFn tab[22] = { fwd<1u << 0>, fwd<1u << 1>, fwd<1u << 2>, fwd<1u << 3>, fwd<1u << 4>, fwd<1u << 5>, fwd<1u << 6>, fwd<1u << 7>, fwd<1u << 8>, fwd<1u << 9>, fwd<1u << 10>, fwd<1u << 11>, fwd<1u << 12>, fwd<1u << 13>, fwd<1u << 14>, fwd<1u << 15>, fwd<1u << 16>, fwd<1u << 17>, fwd<1u << 18>, fwd<1u << 19>, fwd<1u << 20>, fwd<1u << 21> };
    return tab[p == 0 ? 20 : (p == NPH - 1 ? 21 : (p - 1) % 20)];
}
#endif
extern "C" void kernel_launch(void* const* d_in, const int* in_sizes, int n_in, void* d_out, int out_size, void* d_ws, size_t ws_size, hipStream_t stream) {
    static int grid = 0;
    if (grid == 0) {
        if (n_in != N_IN || out_size != NB * SEQ * D || ws_size < WS_NEED) { fprintf(stderr, "kernel_launch: unexpected shapes: n_in %d out %d ws %zu (need %zu)\n", n_in, out_size, ws_size, (size_t)WS_NEED); grid = -1; return; }
        int dev = 0, cus = 0;
        if (hipGetDevice(&dev) != hipSuccess || hipDeviceGetAttribute(&cus, hipDeviceAttributeMultiprocessorCount, dev) != hipSuccess) { grid = -1; return; }
        for (int p = 0; p < NPH; ++p)
            if (hipFuncSetAttribute((const void*)kern_of(p), hipFuncAttributeMaxDynamicSharedMemorySize, LDS_BYTES) != hipSuccess) { fprintf(stderr, "kernel_launch: hipFuncSetAttribute failed\n"); grid = -1; return; }
        int per_cu = 0;
        if (hipOccupancyMaxActiveBlocksPerMultiprocessor(&per_cu, (const void*)kern_of(1), NTHR, LDS_BYTES) != hipSuccess || per_cu < 1) { fprintf(stderr, "kernel_launch: occupancy query says %d blocks per CU\n", per_cu); (void)hipGetLastError(); }
        grid = cus < 256 ? cus : 256;
    }
    if (grid < 0) return;
    (void)in_sizes;
    (void)hipMemsetAsync((char*)d_ws + WS_CTL, 0, CTL_BYTES, stream);
    Args a{};
    for (int i = 0; i < N_IN; ++i) a.in[i] = (const float*)d_in[i];
    a.out = (float*)d_out; a.ws = (unsigned char*)d_ws;
#if MK_ONE_LAUNCH
    a.ph_lo = 0; a.ph_hi = NPH;
    hipLaunchKernelGGL(kern_of(0), dim3(grid), dim3(NTHR), LDS_BYTES, stream, a);
#else
    for (int p = 0; p < NPH; ++p) { a.ph_lo = p; a.ph_hi = p + 1; hipLaunchKernelGGL(kern_of(p), dim3(grid), dim3(NTHR), LDS_BYTES, stream, a); }
#endif
    const hipError_t le = hipPeekAtLastError();
    if (le != hipSuccess) fprintf(stderr, "kernel_launch: launch failed: %s\n", hipGetErrorName(le));
}
```

```cpp
#include <hip/hip_runtime.h>
#include <cstdio>
#include <cstdint>
#ifndef SCAN_CHUNKED
#define SCAN_CHUNKED 1
#endif
#ifndef CS_SERIAL
#define CS_SERIAL 0
#endif
#ifndef CS_BOTH
#define CS_BOTH 0
#endif
#ifndef CS_NOTILE
#define CS_NOTILE 0
#endif
#ifndef CS_OOP
#define CS_OOP 0
#endif
#ifndef CS_TOL
#define CS_TOL 0.05f
#endif

#ifndef MK_ONE_LAUNCH
#define MK_ONE_LAUNCH 1
#endif

#define LAS __attribute__((address_space(3)))
typedef unsigned short bf16_t;
typedef short bf16x8 __attribute__((ext_vector_type(8)));
typedef short s16x4 __attribute__((ext_vector_type(4)));
typedef float f32x2 __attribute__((ext_vector_type(2)));
typedef float f32x4 __attribute__((ext_vector_type(4)));
typedef float f32x16 __attribute__((ext_vector_type(16)));
typedef unsigned u32x2 __attribute__((ext_vector_type(2)));
typedef unsigned u32x4 __attribute__((ext_vector_type(4)));

constexpr int D = 1024, NB = 8, SEQ = 4096, CTX = 256, SEG = SEQ + CTX, R = NB * SEG;
constexpr int NPAN = R / 256;
constexpr int NTHR = 512, NWAVE = 8;
constexpr int QL = 384, KVL = 256, ROPE = 64, NOPE = 128, QKH = 192, VH = 128, NH = 8;
constexpr int DFF = 2816, NE = 8, DFE = 3584;
constexpr int MP_MAX = 71680;
constexpr float NORM_EPS = 1e-6f, LNX_EPS = 64e-5f;
constexpr float QSCALE = 0.07216878364870322f * 1.4426950408889634f;

enum { I_X = 0, I_C, I_CTX, I_CCTX, I_ADAW, I_ADAB, I_N1G, I_N2G, I_WQA, I_QAN, I_WQB, I_WKVA, I_KVAN, I_WKVB, I_QN, I_KN, I_MWO,
       I_MIX, I_WR, I_WK, I_WV, I_RWO, I_W0, I_W1, I_W2, I_A0, I_A1, I_A2, I_G1, I_G2, I_KK, I_KA, I_RK, I_LNW, I_LNB, I_V0, I_V1, I_V2,
       I_F1, I_F3, I_F2, I_ROUTER, I_M1, I_M3, I_M2, N_IN };

constexpr size_t U = (size_t)R * 1024 * 2;
constexpr size_t al256(size_t x) { return (x + 255) / 256 * 256; }
constexpr size_t WS_CTL = 0;
constexpr size_t CTL_BYTES = 65536;
constexpr size_t WS_MODS = WS_CTL + CTL_BYTES;
constexpr size_t WS_ROPE = WS_MODS + al256((size_t)4 * 9 * 6144 * 4);
constexpr size_t WS_CS = WS_ROPE + 8192;
constexpr size_t WS_RS = WS_CS + (size_t)NB * CTX * D * 4;
constexpr size_t WS_ROUTE = WS_RS + al256((size_t)R * 8);
constexpr size_t WS_RSLOT = WS_ROUTE + (size_t)R * 16;
constexpr size_t WS_HIST = WS_RSLOT + (size_t)R * 8;
constexpr size_t WS_META = WS_HIST + 2048 * 8 * 4;
constexpr size_t WS_WSM = WS_META + 256;
constexpr size_t E_QKVA = 768 * 1024, E_QB = 1536 * 384, E_KVB = 2048 * 384, E_MWO = 1024 * 1024, E_MLA = E_QKVA + E_QB + E_KVB + E_MWO;
constexpr size_t E_B1 = 1024 * 2048, E_B2 = 1024 * 2048, E_L1 = 512 * 2048, E_L2A = 4096 * 256, E_L2B = 2048 * 256, E_RWKV = E_B1 + E_B2 + E_L1 + E_L2A + E_L2B;
constexpr size_t E_F13 = 5632 * 1024, E_F2 = 1024 * 2816, E_FFN = E_F13 + E_F2;
constexpr size_t WS_WMLA = WS_WSM, WS_WRWKV = WS_WMLA + 2 * E_MLA * 2, WS_WFFN = WS_WRWKV + 2 * E_RWKV * 2;
constexpr size_t WS_VF = WS_WFFN + 2 * E_FFN * 2;
constexpr size_t WS_ARENA = WS_VF + U;
constexpr size_t A_H = 0;
constexpr size_t A_QKVA = U, A_Q = 2 * U, A_KV = 2 * U + U * 3 / 2, A_K = A_KV + 2 * U, A_O = A_K + U * 3 / 2;
constexpr size_t A_FHID = U;
constexpr size_t A_AX = 0, A_L1 = 5 * U, A_RR = A_L1 + U / 2, A_RK = A_RR + U, A_RV = A_RK + U, A_VL = A_RV + U, A_REND = A_VL + U;
constexpr size_t A_WL0 = 0, A_WL1 = U, A_AL0 = 2 * U, A_AL1 = 3 * U, A_G = 4 * U, A_RO = 0;
constexpr size_t A_YF = (SCAN_CHUNKED && CS_OOP && !CS_BOTH) ? A_REND : A_WL0, A_YR = (SCAN_CHUNKED && CS_OOP && !CS_BOTH) ? A_REND + U : A_WL1;
constexpr size_t A_YCF = CS_BOTH ? A_REND : A_YF, A_YCR = CS_BOTH ? A_REND + U : A_YR;
constexpr size_t A_HS = U, A_Y2 = U, A_MHID = A_HS + (size_t)MP_MAX * 1024 * 2, A_MEND = A_MHID + (size_t)MP_MAX * DFE * 2;
constexpr size_t E_M13 = (size_t)7168 * 1024, E_M2 = (size_t)1024 * 3584;
constexpr size_t A_WM13 = A_MEND, A_WM2 = A_WM13 + NE * E_M13 * 2, A_END = A_WM2 + NE * E_M2 * 2;
constexpr size_t WS_NEED = WS_ARENA + (A_END > A_REND ? A_END : A_REND);
static_assert(WS_NEED <= 1081188352ull, "workspace budget (sum of inputs)");
static_assert(CS_OOP || CS_BOTH || A_WM13 >= A_REND, "the MoE weight region must be free during the RWKV mixer (weights are converted inside the scan phase)");

struct Args { const float* in[N_IN]; float* out; unsigned char* ws; int ph_lo, ph_hi; };

__device__ __forceinline__ unsigned cvt_pk_bf16(float lo, float hi) { unsigned r; asm("v_cvt_pk_bf16_f32 %0, %1, %2" : "=v"(r) : "v"(lo), "v"(hi)); return r; }
__device__ __forceinline__ float bflo(unsigned w) { return __uint_as_float(w << 16); }
__device__ __forceinline__ float bfhi(unsigned w) { return __uint_as_float(w & 0xffff0000u); }
__device__ __forceinline__ void unpack8(const u32x4 w, float (&f)[8]) { f[0] = bflo(w.x); f[1] = bfhi(w.x); f[2] = bflo(w.y); f[3] = bfhi(w.y); f[4] = bflo(w.z); f[5] = bfhi(w.z); f[6] = bflo(w.w); f[7] = bfhi(w.w); }
__device__ __forceinline__ u32x4 pack8(const float (&f)[8]) { u32x4 w; w.x = cvt_pk_bf16(f[0], f[1]); w.y = cvt_pk_bf16(f[2], f[3]); w.z = cvt_pk_bf16(f[4], f[5]); w.w = cvt_pk_bf16(f[6], f[7]); return w; }
__device__ __forceinline__ float wave_sum(float v) {
#pragma unroll
    for (int o = 32; o >= 1; o >>= 1) v += __shfl_xor(v, o);
    return v;
}
template <int CTRL> __device__ __forceinline__ float dpp_f(float v) { return __int_as_float(__builtin_amdgcn_update_dpp(0, __float_as_int(v), CTRL, 0xF, 0xF, true)); }
__device__ __forceinline__ float red8(float v) { v += dpp_f<0xB1>(v); v += dpp_f<0x4E>(v); v += dpp_f<0x141>(v); return v; }
__device__ __forceinline__ int ltid() { int t = threadIdx.x; asm volatile("" : "+v"(t)); return t; }
template <class T> __device__ __forceinline__ T launder_s(T x) { asm volatile("" : "+s"(x)); return x; }
__device__ __forceinline__ Args launder_args(const Args& k) { Args a = k; a.ws = launder_s(k.ws); a.out = launder_s(k.out); return a; }
__device__ __forceinline__ float wave_sum_dpp(float v) {
    v += dpp_f<0xB1>(v); v += dpp_f<0x4E>(v); v += dpp_f<0x141>(v); v += dpp_f<0x140>(v);
    const int iv = __float_as_int(v);
    return (__int_as_float(__builtin_amdgcn_readlane(iv, 0)) + __int_as_float(__builtin_amdgcn_readlane(iv, 16))) + (__int_as_float(__builtin_amdgcn_readlane(iv, 32)) + __int_as_float(__builtin_amdgcn_readlane(iv, 48)));
}
__device__ __forceinline__ float sigmoidf_(float x) { return __builtin_amdgcn_rcpf(1.0f + __expf(-x)); }
__device__ __forceinline__ float* xrow(const Args& a, int row) {
    const int b = row / SEG, r = row - b * SEG;
    return r < CTX ? (float*)(a.ws + WS_CS) + (size_t)(b * CTX + r) * D : a.out + (size_t)(b * SEQ + r - CTX) * D;
}
__device__ __forceinline__ const float* xrow_in(const Args& a, int row) {
    const int b = row / SEG, r = row - b * SEG;
    return r < CTX ? a.in[I_CTX] + (size_t)(b * CTX + r) * D : a.in[I_X] + (size_t)(b * SEQ + r - CTX) * D;
}
__device__ __forceinline__ int mod_index(int row) { const int b = row / SEG, r = row - b * SEG; return r < CTX ? 8 : b; }
__device__ __forceinline__ const float* mods_ptr(const Args& a, int layer, int mi, int which) { return (const float*)(a.ws + WS_MODS) + ((size_t)(layer * 9 + mi) * 6 + which) * 1024; }

#define XB_TMO      128
#define XB_XCNT(j)  (256  + 64 * (j))
#define XB_XSUB(j)  (1280 + 64 * (j))
#define XB_XGEN(j)  (2304 + 64 * (j))
#define XB_TOP      3328
#define XB_TOPGEN   3392
#define XCD_BAR_WORDS 3456
#define XB_SPIN_CAP (1u << 22)
__device__ __forceinline__ unsigned xb_ld(unsigned* p)              { return __hip_atomic_load(p, __ATOMIC_RELAXED, __HIP_MEMORY_SCOPE_AGENT); }
__device__ __forceinline__ unsigned xb_add(unsigned* p, unsigned v) { return __hip_atomic_fetch_add(p, v, __ATOMIC_RELAXED, __HIP_MEMORY_SCOPE_AGENT); }
__device__ __forceinline__ unsigned xb_xcc_id() { return (unsigned)__builtin_amdgcn_s_getreg((3 << 11) | 20) & 0xFu; }
#define XB_SPIN(cond, bar) do { unsigned _sp = 0; while (cond) { __builtin_amdgcn_s_sleep(1); \
    if ((++_sp & 255u) == 0u) { if (xb_ld(&(bar)[XB_TMO])) break; if (_sp > XB_SPIN_CAP) { atomicAdd(&(bar)[XB_TMO], 1u); break; } } } } while (0)
struct XcdBarrier { unsigned* bar; unsigned x; volatile LAS unsigned* st; };
__device__ __forceinline__ XcdBarrier xcd_barrier_post(unsigned* bar, volatile LAS unsigned* st) {
    XcdBarrier b; b.bar = bar; b.x = xb_xcc_id(); b.st = st;
    if (threadIdx.x == 0) (void)xb_add(&bar[XB_XCNT(b.x)], 1u);
    return b;
}
__device__ __forceinline__ void xcd_barrier_complete(unsigned* bar, unsigned x, unsigned& nloc, unsigned& nx) {
    const unsigned G = gridDim.x * gridDim.y * gridDim.z;
    unsigned sum, cnt, mine, sp = 0u;
    for (;;) {
        sum = 0u; cnt = 0u; mine = 0u;
#pragma unroll
        for (unsigned j = 0; j < 16; ++j) { const unsigned c = xb_ld(&bar[XB_XCNT(j)]); sum += c; cnt += (c > 0u) ? 1u : 0u; mine = (j == x) ? c : mine; }
        if (sum == G) break;
        __builtin_amdgcn_s_sleep(1);
        if ((++sp & 255u) == 0u) { if (xb_ld(&bar[XB_TMO])) break; if (sp > XB_SPIN_CAP) { atomicAdd(&bar[XB_TMO], 1u); break; } }
    }
    nloc = mine > 0u ? mine : 1u; nx = cnt > 0u ? cnt : 1u;
}
__device__ __forceinline__ void xcd_barrier(const XcdBarrier& b) {
    asm volatile("s_waitcnt vmcnt(0)" ::: "memory");
    __syncthreads();
    if (threadIdx.x == 0) {
        unsigned* bar = b.bar;
        __builtin_amdgcn_s_waitcnt(0);
        unsigned nloc = b.st[0], nx = b.st[1];
        if (nloc == 0u) { xcd_barrier_complete(bar, b.x, nloc, nx); b.st[0] = nloc; b.st[1] = nx; }
        const unsigned old = xb_add(&bar[XB_XSUB(b.x)], 1u);
        const unsigned gen = old / nloc;
        if (old + 1u == (gen + 1u) * nloc) {
            __builtin_amdgcn_fence(__ATOMIC_RELEASE, "agent");
            asm volatile("s_waitcnt vmcnt(0)" ::: "memory");
            const unsigned og = xb_add(&bar[XB_TOP], 1u);
            const unsigned tg = og / nx;
            if (og + 1u == (tg + 1u) * nx) xb_add(&bar[XB_TOPGEN], 1u);
            else XB_SPIN(xb_ld(&bar[XB_TOPGEN]) == tg, bar);
            __builtin_amdgcn_fence(__ATOMIC_ACQUIRE, "agent");
            xb_add(&bar[XB_XGEN(b.x)], 1u);
            asm volatile("s_waitcnt vmcnt(0)" ::: "memory");
        } else {
            XB_SPIN(xb_ld(&bar[XB_XGEN(b.x)]) == gen, bar);
            __builtin_amdgcn_fence(__ATOMIC_ACQUIRE, "agent");
            asm volatile("s_waitcnt vmcnt(0)" ::: "memory");
        }
    }
    __syncthreads();
}

namespace pg8 {
constexpr int BM = 256, BK = 64, HALF = 128, HTB = HALF * BK * 2, STAGE_BYTES = 8 * HTB;
__device__ __forceinline__ int lds_byte(int r, int c) { const int st = (r >> 4) * 2 + (c >> 5), rr = r & 15, cc = c & 31, ob = rr * 64 + cc * 2; return st * 1024 + (ob ^ (((ob >> 9) & 1) << 5)); }
__device__ __forceinline__ void stage_rc(int b, int& Rr, int& C) { const int st = b / 1024, sb = b % 1024, swz = sb ^ (((sb >> 9) & 1) << 5); Rr = (st >> 1) * 16 + swz / 64; C = (st & 1) * 32 + (swz % 64) / 2; }
__device__ __forceinline__ int perm32(int rho) { const int n = rho >> 4, i = rho & 15; return 8 * (i >> 2) + 4 * n + (i & 3); }
struct GUnit { const char* A; const char* B; int nt, pm, pn, aux; };
__device__ __forceinline__ void tile_order(int L, int nM, int nN, int& pm, int& pn) {
    const int nwg = nM * nN; int wgid = L;
    { const int q = nwg / 8, r = nwg % 8, xcd = wgid % 8, off = wgid / 8; wgid = (xcd < r ? xcd * (q + 1) : r * (q + 1) + (xcd - r) * q) + off; }
    const int nig = 8 * nN, gid = wgid / nig, fm = gid * 8, gsz = (nM - fm) < 8 ? (nM - fm) : 8;
    pm = fm + ((wgid % nig) % gsz); pn = (wgid % nig) / gsz;
}
template <class Epi, class Map>
__device__ __forceinline__ void gemm_phase(LAS unsigned char* lds, const int lda, const int ldb, const Map& S, const Epi& E, const int G, const int c) {
    const int tid = ltid(), wid = __builtin_amdgcn_readfirstlane(tid >> 6), lane = tid & 63, wr = wid >> 2, wc = wid & 3, fr = lane & 15, fq = lane >> 4;
    unsigned voffA[2], voffB[2];
#pragma unroll
    for (int i = 0; i < 2; ++i) { int Rr, C; stage_rc(tid * 16 + i * 8192, Rr, C); const int Rb = Epi::PERM ? ((Rr & ~31) + perm32(Rr & 31)) : Rr;
        voffA[i] = (unsigned)(Rr * lda + C) * 2u; voffB[i] = (unsigned)(Rb * ldb + C) * 2u; }
    const size_t kstep = (size_t)(BK * 2);
    const size_t hA = (size_t)HALF * lda * 2, hB = (size_t)HALF * ldb * 2;
    const unsigned ldsw = (unsigned)wid * 1024u;
    const int aoff = lds_byte(wr * 64 + fr, fq * 8), boff = lds_byte(wc * 32 + fr, fq * 8);
#define PG8_SA(b, h) (((b) * 2 + (h)) * HTB)
#define PG8_SB(b, h) ((4 + (b) * 2 + (h)) * HTB)
#define PG8_STAGE(bufoff, gbase, voff) do { _Pragma("unroll") for (int _i = 0; _i < 2; ++_i) \
        __builtin_amdgcn_global_load_lds((const unsigned*)((const char*)(gbase) + (voff)[_i]), (LAS unsigned*)(lds + (bufoff) + ldsw + _i * 8192), 16, 0, 0); } while (0)
#define PG8_LDA(dst, b, h) do { _Pragma("unroll") for (int m = 0; m < 4; ++m) _Pragma("unroll") for (int k = 0; k < 2; ++k) dst[m][k] = *(const LAS bf16x8*)(lds + PG8_SA(b, h) + aoff + m * 2048 + k * 1024); } while (0)
#define PG8_LDB(dst, b, h) do { _Pragma("unroll") for (int n = 0; n < 2; ++n) _Pragma("unroll") for (int k = 0; k < 2; ++k) dst[n][k] = *(const LAS bf16x8*)(lds + PG8_SB(b, h) + boff + n * 2048 + k * 1024); } while (0)
#define PG8_MMA(ai, bj, At, Bt) do { __builtin_amdgcn_s_setprio(1); _Pragma("unroll") for (int m = 0; m < 4; ++m) _Pragma("unroll") for (int n = 0; n < 2; ++n) _Pragma("unroll") for (int k = 0; k < 2; ++k) \
        acc[ai][bj][m][n] = __builtin_amdgcn_mfma_f32_16x16x32_bf16(Bt[n][k], At[m][k], acc[ai][bj][m][n], 0, 0, 0); __builtin_amdgcn_s_setprio(0); } while (0)
#define PG8_WAIT_V(n) asm volatile("s_waitcnt vmcnt(" #n ")" ::: "memory")
#define PG8_WAIT_L(n) asm volatile("s_waitcnt lgkmcnt(" #n ")" ::: "memory")
#define PG8_BAR __builtin_amdgcn_s_barrier()
#define PG8_SCHED __builtin_amdgcn_sched_barrier(0)
    GUnit cur, nxt; int ui = 0;
    if (!S(c, cur)) return;
    f32x4 acc[2][2][4][2];
#pragma unroll
    for (int a = 0; a < 2; ++a)
#pragma unroll
        for (int b = 0; b < 2; ++b)
#pragma unroll
            for (int m = 0; m < 4; ++m)
#pragma unroll
                for (int n = 0; n < 2; ++n) acc[a][b][m][n] = (f32x4){0.f, 0.f, 0.f, 0.f};
    bf16x8 At[4][2], B0[2][2], B1[2][2];
    const char* cA = cur.A; const char* cB = cur.B;
    PG8_STAGE(PG8_SB(0, 0), cB, voffB); PG8_STAGE(PG8_SB(0, 1), cB + hB, voffB); PG8_STAGE(PG8_SA(0, 0), cA, voffA); PG8_STAGE(PG8_SA(0, 1), cA + hA, voffA);
    if (wr == 1) PG8_BAR;
    PG8_WAIT_V(2); PG8_BAR;
    PG8_STAGE(PG8_SB(1, 0), cB + kstep, voffB); PG8_STAGE(PG8_SA(1, 0), cA + kstep, voffA); PG8_STAGE(PG8_SB(1, 1), cB + hB + kstep, voffB);
    PG8_WAIT_V(6); PG8_BAR;
    for (;;) {
        const bool has_next = S((ui + 1) * G + c, nxt);
        const char* nA = has_next ? nxt.A : cA; const char* nB = has_next ? nxt.B : cB;
        const int nt = cur.nt;
        for (int t = 0; t < nt; t += 2) {
            const bool last = (t == nt - 2);
            const char* a1 = cA + (size_t)(t + 1) * kstep;
            const char* a2 = last ? nA : cA + (size_t)(t + 2) * kstep; const char* b2 = last ? nB : cB + (size_t)(t + 2) * kstep;
            const char* a3 = a2 + kstep; const char* b3 = b2 + kstep;
            PG8_LDB(B0, 0, 0); PG8_LDB(B1, 0, 1); PG8_SCHED; PG8_LDA(At, 0, 0); PG8_STAGE(PG8_SA(1, 1), a1 + hA, voffA);
            PG8_WAIT_V(8); PG8_WAIT_L(0); PG8_BAR; PG8_MMA(0, 0, At, B0); PG8_MMA(0, 1, At, B1); PG8_BAR; PG8_SCHED;
            PG8_LDA(At, 0, 1); PG8_STAGE(PG8_SB(0, 0), b2, voffB); PG8_STAGE(PG8_SB(0, 1), b2 + hB, voffB); PG8_STAGE(PG8_SA(0, 0), a2, voffA);
            PG8_WAIT_V(8); PG8_WAIT_L(0); PG8_BAR; PG8_MMA(1, 0, At, B0); PG8_MMA(1, 1, At, B1); PG8_BAR; PG8_SCHED;
            PG8_LDB(B0, 1, 0); PG8_LDB(B1, 1, 1); PG8_SCHED; PG8_LDA(At, 1, 0); PG8_STAGE(PG8_SA(0, 1), a2 + hA, voffA);
            PG8_WAIT_V(8); PG8_WAIT_L(0); PG8_BAR; PG8_MMA(0, 0, At, B0); PG8_MMA(0, 1, At, B1); PG8_BAR; PG8_SCHED;
            PG8_LDA(At, 1, 1); PG8_STAGE(PG8_SB(1, 0), b3, voffB); PG8_STAGE(PG8_SB(1, 1), b3 + hB, voffB); PG8_STAGE(PG8_SA(1, 0), a3, voffA);
            PG8_WAIT_V(8); PG8_WAIT_L(0); PG8_BAR; PG8_MMA(1, 0, At, B0); PG8_MMA(1, 1, At, B1); PG8_BAR; PG8_SCHED;
        }
        if (wr == 0) PG8_BAR;
        E(acc, cur, wr, wc, fr, fq);
        if (!has_next) break;
#pragma unroll
        for (int a = 0; a < 2; ++a)
#pragma unroll
            for (int b = 0; b < 2; ++b)
#pragma unroll
                for (int m = 0; m < 4; ++m)
#pragma unroll
                    for (int n = 0; n < 2; ++n) acc[a][b][m][n] = (f32x4){0.f, 0.f, 0.f, 0.f};
        cur = nxt; cA = nA; cB = nB; ++ui;
        if (wr == 1) PG8_BAR;
    }
    PG8_WAIT_V(0);
    PG8_BAR;
#undef PG8_SA
#undef PG8_SB
#undef PG8_STAGE
#undef PG8_LDA
#undef PG8_LDB
#undef PG8_MMA
#undef PG8_WAIT_V
#undef PG8_WAIT_L
#undef PG8_BAR
#undef PG8_SCHED
}
}

using pg8::GUnit;
typedef f32x4 Acc[2][2][4][2];
template <class F> struct EpiBf {
    static constexpr bool PERM = true;
    F f;
    __device__ __forceinline__ void operator()(const Acc& acc, const GUnit& u, int wr, int wc, int fr, int fq) const {
#pragma unroll
        for (int ai = 0; ai < 2; ++ai)
#pragma unroll
            for (int m = 0; m < 4; ++m) { const int trow = ai * 128 + wr * 64 + m * 16 + fr;
#pragma unroll
                for (int bj = 0; bj < 2; ++bj) f(acc[ai][bj][m][0], acc[ai][bj][m][1], u, trow, bj * 128 + wc * 32 + 8 * fq); }
    }
};
__device__ __forceinline__ void st8(bf16_t* p, f32x4 v0, f32x4 v1) { u32x4 w; w.x = cvt_pk_bf16(v0[0], v0[1]); w.y = cvt_pk_bf16(v0[2], v0[3]); w.z = cvt_pk_bf16(v1[0], v1[1]); w.w = cvt_pk_bf16(v1[2], v1[3]); *(u32x4*)p = w; }

struct FPlain { bf16_t* O; int ldc;
    __device__ __forceinline__ void operator()(f32x4 v0, f32x4 v1, const GUnit& u, int trow, int tcol) const { st8(O + (size_t)(u.pm * 256 + trow) * ldc + u.pn * 256 + tcol, v0, v1); } };
struct FQKV { bf16_t* Q; bf16_t* KV; const float* rsq; const float* rskv;
    __device__ __forceinline__ void operator()(f32x4 v0, f32x4 v1, const GUnit& u, int trow, int tcol) const {
        const int row = u.pm * 256 + trow;
        if (u.aux == 0) { const float s = rsq[row]; st8(Q + (size_t)row * 1536 + u.pn * 256 + tcol, v0 * s, v1 * s); }
        else { const float s = rskv[row]; st8(KV + (size_t)row * 2048 + u.pn * 256 + tcol, v0 * s, v1 * s); } } };
struct EpiQKV {
    static constexpr bool PERM = true;
    bf16_t* Q; bf16_t* KV; const float* rsq; const float* rskv;
    __device__ __forceinline__ void operator()(const Acc& acc, const GUnit& u, int wr, int wc, int fr, int fq) const {
        const float* rs = (u.aux == 0) ? rsq : rskv; bf16_t* O = (u.aux == 0) ? Q : KV; const int ldc = (u.aux == 0) ? 1536 : 2048;
        float sc[2][4];
#pragma unroll
        for (int ai = 0; ai < 2; ++ai)
#pragma unroll
            for (int m = 0; m < 4; ++m) sc[ai][m] = rs[u.pm * 256 + ai * 128 + wr * 64 + m * 16 + fr];
#pragma unroll
        for (int ai = 0; ai < 2; ++ai)
#pragma unroll
            for (int m = 0; m < 4; ++m) { const int row = u.pm * 256 + ai * 128 + wr * 64 + m * 16 + fr; const float s = sc[ai][m];
#pragma unroll
                for (int bj = 0; bj < 2; ++bj) st8(O + (size_t)row * ldc + u.pn * 256 + bj * 128 + wc * 32 + 8 * fq, acc[ai][bj][m][0] * s, acc[ai][bj][m][1] * s); }
    }
};
struct EpiRw2 {
    static constexpr bool PERM = true;
    bf16_t* base; bf16_t* vl; const float* w0; const float* a0;
    __device__ __forceinline__ void operator()(const Acc& acc, const GUnit& u, int wr, int wc, int fr, int fq) const {
        bf16_t* o = (u.aux < 5) ? base + (size_t)u.aux * ((size_t)R * 1024) : vl;
        const bool act = u.aux < 4; const float scl = (u.aux < 2) ? 0.6065306597126334f : 1.0f;
        f32x4 bv[2][2];
#pragma unroll
        for (int bj = 0; bj < 2; ++bj) { const int col = u.pn * 256 + bj * 128 + wc * 32 + 8 * fq; const float* bp = (u.aux < 2 ? w0 : a0) + (u.aux & 1) * 1024 + col;
            bv[bj][0] = act ? *(const f32x4*)bp : (f32x4){0.f, 0.f, 0.f, 0.f}; bv[bj][1] = act ? *(const f32x4*)(bp + 4) : (f32x4){0.f, 0.f, 0.f, 0.f}; }
#pragma unroll
        for (int ai = 0; ai < 2; ++ai)
#pragma unroll
            for (int m = 0; m < 4; ++m) { const int row = u.pm * 256 + ai * 128 + wr * 64 + m * 16 + fr;
#pragma unroll
                for (int bj = 0; bj < 2; ++bj) { f32x4 v0 = acc[ai][bj][m][0], v1 = acc[ai][bj][m][1];
                    if (act) {
#pragma unroll
                        for (int j = 0; j < 4; ++j) { v0[j] = scl * sigmoidf_(bv[bj][0][j] + v0[j]); v1[j] = scl * sigmoidf_(bv[bj][1][j] + v1[j]); } }
                    st8(o + (size_t)row * 1024 + u.pn * 256 + bj * 128 + wc * 32 + 8 * fq, v0, v1); } }
    }
};
struct FRw1 { bf16_t* L1; bf16_t* RR; bf16_t* RK; bf16_t* RV;
    __device__ __forceinline__ void operator()(f32x4 v0, f32x4 v1, const GUnit& u, int trow, int tcol) const {
        const int row = u.pm * 256 + trow;
        if (u.aux == 0) { const int col = u.pn * 256 + tcol;
            if (col < 128) {
#pragma unroll
                for (int j = 0; j < 4; ++j) { v0[j] = 1.0f - 2.0f * __builtin_amdgcn_rcpf(1.0f + __expf(2.0f * v0[j])); v1[j] = 1.0f - 2.0f * __builtin_amdgcn_rcpf(1.0f + __expf(2.0f * v1[j])); } }
            else if (col >= 320) {
#pragma unroll
                for (int j = 0; j < 4; ++j) { v0[j] = sigmoidf_(v0[j]); v1[j] = sigmoidf_(v1[j]); } }
            st8(L1 + (size_t)row * 512 + col, v0, v1); }
        else { bf16_t* o = u.aux == 1 ? RR : (u.aux == 2 ? RK : RV); st8(o + (size_t)row * 1024 + u.pn * 256 + tcol, v0, v1); } } };
struct FRw2 { bf16_t* base; bf16_t* vl; const float* w0; const float* a0;
    __device__ __forceinline__ void operator()(f32x4 v0, f32x4 v1, const GUnit& u, int trow, int tcol) const {
        const int col = u.pn * 256 + tcol;
        const unsigned off = (unsigned)(u.pm * 256 + trow) * 1024u + (unsigned)col + (u.aux < 5 ? (unsigned)u.aux * (unsigned)(R * 1024) : 0u);
        bf16_t* o = (u.aux < 5) ? base : vl;
        if (u.aux < 4) {
            const float* bp = (u.aux < 2 ? w0 : a0) + (u.aux & 1) * 1024 + col; const f32x4 b0 = *(const f32x4*)bp, b1 = *(const f32x4*)(bp + 4);
            const float sc = (u.aux < 2) ? 0.6065306597126334f : 1.0f;
#pragma unroll
            for (int j = 0; j < 4; ++j) { v0[j] = sc * sigmoidf_(b0[j] + v0[j]); v1[j] = sc * sigmoidf_(b1[j] + v1[j]); } }
        st8(o + off, v0, v1); } };
struct EpiSwiGLU {
    static constexpr bool PERM = true;
    bf16_t* O; int ldc;
    __device__ __forceinline__ void operator()(const Acc& acc, const GUnit& u, int wr, int wc, int fr, int fq) const {
#pragma unroll
        for (int ai = 0; ai < 2; ++ai)
#pragma unroll
            for (int m = 0; m < 4; ++m) { const int trow = ai * 128 + wr * 64 + m * 16 + fr; f32x4 h0, h1;
#pragma unroll
                for (int j = 0; j < 4; ++j) { const float g0 = acc[ai][0][m][0][j], g1 = acc[ai][0][m][1][j];
                    h0[j] = g0 * sigmoidf_(g0) * acc[ai][1][m][0][j]; h1[j] = g1 * sigmoidf_(g1) * acc[ai][1][m][1][j]; }
                st8(O + (size_t)(u.pm * 256 + trow) * ldc + u.pn * 128 + wc * 32 + 8 * fq, h0, h1); }
    }
};
struct EpiResid {
    static constexpr bool PERM = false;
    float* cs; float* out; const float* mods; int layer, which;
    const float* scs; const float* sout;
    __device__ __forceinline__ void operator()(const Acc& acc, const GUnit& u, int wr, int wc, int fr, int fq) const {
        const int b = u.pm / 17, isctx = (u.pm % 17 == 0);
        float* xp = isctx ? cs + (size_t)b * CTX * D : out + (size_t)(b * SEQ + (u.pm % 17 - 1) * 256) * D;
        const float* sp = isctx ? scs + (size_t)b * CTX * D : sout + (size_t)(b * SEQ + (u.pm % 17 - 1) * 256) * D;
        const float* gp = mods + ((size_t)(layer * 9 + (isctx ? 8 : b)) * 6 + which) * 1024;
        const int col0 = u.pn * 256 + wc * 32 + 4 * fq;
        f32x4 gv[2][2];
#pragma unroll
        for (int bj = 0; bj < 2; ++bj)
#pragma unroll
            for (int n = 0; n < 2; ++n) gv[bj][n] = *(const f32x4*)(gp + col0 + bj * 128 + n * 16);
#pragma unroll
        for (int ai = 0; ai < 2; ++ai)
#pragma unroll
            for (int mh = 0; mh < 2; ++mh) {
                f32x4 xv[2][2][2];
#pragma unroll
                for (int mm = 0; mm < 2; ++mm) { const float* srow = sp + (size_t)(ai * 128 + wr * 64 + (mh * 2 + mm) * 16 + fr) * D + col0;
#pragma unroll
                    for (int bj = 0; bj < 2; ++bj)
#pragma unroll
                        for (int n = 0; n < 2; ++n) xv[mm][bj][n] = *(const f32x4*)(srow + bj * 128 + n * 16); }
#pragma unroll
                for (int mm = 0; mm < 2; ++mm) { float* rowp = xp + (size_t)(ai * 128 + wr * 64 + (mh * 2 + mm) * 16 + fr) * D + col0;
#pragma unroll
                    for (int bj = 0; bj < 2; ++bj)
#pragma unroll
                        for (int n = 0; n < 2; ++n) *(f32x4*)(rowp + bj * 128 + n * 16) = xv[mm][bj][n] + gv[bj][n] * acc[ai][bj][mh * 2 + mm][n]; }
                asm volatile("" ::: "memory"); }
    }
};

struct MapSimple {
    const char* A; const char* B; size_t sa, sb; int nN, nt, lat;
    __device__ __forceinline__ bool operator()(int L, GUnit& u) const { const int nM = lat ? 128 : NPAN; if (L >= nM * nN) return false; int q; pg8::tile_order(L, nM, nN, q, u.pn);
        u.pm = lat ? (q / 16) * 17 + 1 + (q % 16) : q;
        u.A = A + (size_t)u.pm * sa; u.B = B + (size_t)u.pn * sb; u.nt = nt; u.aux = 0; return true; }
};
struct MapQKV {
    const char* QKVA; const char* QB; const char* KVB;
    __device__ __forceinline__ bool operator()(int L, GUnit& u) const { if (L >= NPAN * 14) return false; int pn; pg8::tile_order(L, NPAN, 14, u.pm, pn);
        const char* ap = QKVA + (size_t)u.pm * 256 * 768 * 2;
        if (pn < 6) { u.A = ap; u.B = QB + (size_t)pn * 256 * 384 * 2; u.nt = 6; u.pn = pn; u.aux = 0; }
        else { u.A = ap + 384 * 2; u.B = KVB + (size_t)(pn - 6) * 256 * 384 * 2; u.nt = 4; u.pn = pn - 6; u.aux = 1; }
        return true; }
};
struct MapRw1 {
    const char* AX; const char* B1; const char* B2; const char* L1;
    __device__ __forceinline__ bool operator()(int L, GUnit& u) const { if (L >= NPAN * 14) return false; int pn; pg8::tile_order(L, NPAN, 14, u.pm, pn);
        const char* ap = AX + (size_t)u.pm * 256 * 5120 * 2;
        if (pn < 2) { u.A = ap; u.B = L1 + (size_t)pn * 256 * 2048 * 2; u.nt = 32; u.pn = pn; u.aux = 0; }
        else if (pn < 6) { u.A = ap + 2048 * 2; u.B = B1 + (size_t)(pn - 2) * 256 * 2048 * 2; u.nt = 16; u.pn = pn - 2; u.aux = 1; }
        else if (pn < 10) { u.A = ap + 3072 * 2; u.B = B1 + (size_t)(pn - 6) * 256 * 2048 * 2 + 1024 * 2; u.nt = 16; u.pn = pn - 6; u.aux = 2; }
        else { u.A = ap + 4096 * 2; u.B = B2 + (size_t)(pn - 10) * 256 * 2048 * 2; u.nt = 16; u.pn = pn - 10; u.aux = 3; }
        return true; }
};
struct MapRw2 {
    const char* L1; const char* L2A; const char* L2B; int pn0, nN, nt;
    __device__ __forceinline__ bool operator()(int L, GUnit& u) const { if (L >= NPAN * nN) return false; int pn; pg8::tile_order(L, NPAN, nN, u.pm, pn); pn += pn0;
        const char* ap = L1 + (size_t)u.pm * 256 * 512 * 2; u.nt = nt; u.pn = pn & 3; u.aux = pn >> 2;
        if (pn < 16) { const int koff = (pn < 8) ? 0 : 128 * 2;
            u.A = ap + koff; u.B = L2A + (size_t)pn * 256 * 256 * 2 + koff; u.nt = nt >> 1; }
        else { u.A = ap + 256 * 2; u.B = L2B + (size_t)(pn - 16) * 256 * 256 * 2; if (pn >= 20) u.nt = nt >> 1; }
        return true; }
};
struct MapMoe {
    const char* A; const char* B; size_t sa, sbe, sb; int nN, nt; const int* base;
    __device__ __forceinline__ bool operator()(int L, GUnit& u) const { const int nM = base[8] >> 8; if (L >= nM * nN) return false; pg8::tile_order(L, nM, nN, u.pm, u.pn);
        int e = 0;
#pragma unroll
        for (int j = 1; j < 8; ++j) e += (u.pm * 256 >= base[j]) ? 1 : 0;
        u.A = A + (size_t)u.pm * sa; u.B = B + (size_t)e * sbe + (size_t)u.pn * sb; u.nt = nt; u.aux = e; return true; }
};

struct MoeSplit { int nMf, nT, S; };
__device__ __forceinline__ MoeSplit moe_split(int total_slots) { const int nM = total_slots >> 8; MoeSplit s; s.nMf = (nM >> 6) << 6; s.nT = nM - s.nMf; int S = s.nT > 0 ? 64 / s.nT : 1; S = S > 8 ? 8 : S; s.S = S < 1 ? 1 : S; return s; }
constexpr int XP0 = (int)((A_WM13 - A_Y2) / ((size_t)256 * 1024 * 2));
static_assert((A_WM13 - A_Y2) % ((size_t)256 * 1024 * 2) == 0, "partial-tile panels are addressed relative to Y2");
struct MapMoeDown {
    const char* A; const char* B; size_t sa, sbe, sb; const int* base;
    __device__ __forceinline__ bool operator()(int L, GUnit& u) const { const MoeSplit sp = moe_split(base[8]); const int nfull = sp.nMf * 4;
        int k0 = 0, nt = 56, opan;
        if (L < nfull) { pg8::tile_order(L, sp.nMf, 4, u.pm, u.pn); opan = u.pm; }
        else { const int i = L - nfull, ntu = sp.nT * 4; if (i >= ntu * sp.S) return false;
            const int sl = i / ntu, t = i - sl * ntu; pg8::tile_order(t, sp.nT, 4, u.pm, u.pn); u.pm += sp.nMf;
            const int q = 28 / sp.S, r = 28 - q * sp.S, p0 = sl * q + (sl < r ? sl : r), np = q + (sl < r ? 1 : 0); k0 = p0 * 2; nt = np * 2;
            opan = sl == 0 ? u.pm : XP0 + (sl - 1) * sp.nT + (u.pm - sp.nMf); }
        int e = 0;
#pragma unroll
        for (int j = 1; j < 8; ++j) e += (u.pm * 256 >= base[j]) ? 1 : 0;
        u.A = A + (size_t)u.pm * sa + (size_t)k0 * 128; u.B = B + (size_t)e * sbe + (size_t)u.pn * sb + (size_t)k0 * 128; u.nt = nt; u.aux = opan; return true; }
};
struct FPlainAux { bf16_t* O; int ldc;
    __device__ __forceinline__ void operator()(f32x4 v0, f32x4 v1, const GUnit& u, int trow, int tcol) const { st8(O + (size_t)(u.aux * 256 + trow) * ldc + u.pn * 256 + tcol, v0, v1); } };

struct Job { const float* src; const float* kscale; bf16_t* dst; int sld, srcK, srcN, ldd, Nd, Kd, koff, grp, gstride, tn, tile0, pad; };
constexpr int MAXJOB = 96;
#define NOGRP (1 << 30)
struct JobList { LAS Job* jobs; int n, tiles, z; };
__device__ __forceinline__ void addjob(JobList& L, const float* src, int sld, int srcK, int srcN, const float* kscale, bf16_t* dst, int ldd, int Nd, int Kd, int koff, int grp, int gstride) {
    LAS Job* j = L.jobs + L.n; j->src = src; j->kscale = kscale; j->dst = dst; j->sld = sld + L.z; j->srcK = srcK + L.z; j->srcN = srcN + L.z; j->ldd = ldd + L.z; j->Nd = Nd + L.z; j->Kd = Kd + L.z; j->koff = koff + L.z; j->grp = grp + L.z; j->gstride = gstride + L.z;
    const int tn = ((Nd + 63) >> 6) + L.z; j->tn = tn; j->tile0 = L.tiles; L.tiles += tn * (Kd >> 6); L.n += 1;
}
__device__ __forceinline__ bf16_t* wmla(const Args& a, int j) { return (bf16_t*)(a.ws + WS_WMLA) + (size_t)j * E_MLA; }
__device__ __forceinline__ bf16_t* wrwkv(const Args& a, int j) { return (bf16_t*)(a.ws + WS_WRWKV) + (size_t)j * E_RWKV; }
__device__ __forceinline__ bf16_t* wffn(const Args& a, int j) { return (bf16_t*)(a.ws + WS_WFFN) + (size_t)j * E_FFN; }
__device__ __forceinline__ void jobs_small(const Args& a, JobList& L) {
#pragma unroll 1
    for (int j = 0; j < 2; ++j) {
        {
            bf16_t* w = wmla(a, j); bf16_t* qkva = w; bf16_t* qb = w + E_QKVA; bf16_t* kvb = qb + E_QB; bf16_t* wo = kvb + E_KVB;
            addjob(L, a.in[I_WQA] + (size_t)j * D * QL, QL, D, QL, nullptr, qkva, 1024, 384, 1024, 0, NOGRP, 0);
            addjob(L, a.in[I_WKVA] + (size_t)j * D * 320, 320, D, 320, nullptr, qkva + (size_t)384 * 1024, 1024, 384, 1024, 0, NOGRP, 0);
            addjob(L, a.in[I_WQB] + (size_t)j * QL * 1536, 1536, QL, 1536, a.in[I_QAN] + j * QL, qb, 384, 1536, 384, 0, NOGRP, 0);
            addjob(L, a.in[I_WKVB] + (size_t)j * KVL * 2048, 2048, KVL, 2048, a.in[I_KVAN] + j * KVL, kvb, 384, 2048, 256, 0, NOGRP, 0);
            addjob(L, a.in[I_MWO] + (size_t)j * D * D, D, D, D, nullptr, wo, 1024, 1024, 1024, 0, NOGRP, 0);
        }
        {
            bf16_t* w = wrwkv(a, j); bf16_t* b1 = w; bf16_t* b2 = b1 + E_B1; bf16_t* l1 = b2 + E_B2; bf16_t* l2a = l1 + E_L1; bf16_t* l2b = l2a + E_L2A;
            const float* mix = a.in[I_MIX] + (size_t)j * 6 * D;
            addjob(L, a.in[I_WR] + (size_t)j * D * D, D, D, D, nullptr, b1, 2048, 1024, 1024, 0, NOGRP, 0);
            addjob(L, a.in[I_WK] + (size_t)j * D * D, D, D, D, nullptr, b1 + 1024, 2048, 1024, 1024, 0, NOGRP, 0);
            addjob(L, a.in[I_WV] + (size_t)j * D * D, D, D, D, nullptr, b2, 2048, 1024, 1024, 0, NOGRP, 0);
            addjob(L, a.in[I_RWO] + (size_t)j * D * D, D, D, D, nullptr, b2 + 1024, 2048, 1024, 1024, 0, NOGRP, 0);
            for (int d = 0; d < 2; ++d) {
                const float* w1 = a.in[I_W1] + (size_t)(j * 2 + d) * D * 64; const float* a1 = a.in[I_A1] + (size_t)(j * 2 + d) * D * 64;
                addjob(L, w1, 64, D, 64, nullptr, l1 + (size_t)(d * 64) * 2048, 2048, 64, 1024, 0, NOGRP, 0);
                addjob(L, w1, 64, D, 64, mix + 1 * D, l1 + (size_t)(d * 64) * 2048 + 1024, 2048, 64, 1024, 0, NOGRP, 0);
                addjob(L, a1, 64, D, 64, nullptr, l1 + (size_t)(128 + d * 64) * 2048, 2048, 64, 1024, 0, NOGRP, 0);
                addjob(L, a1, 64, D, 64, mix + 4 * D, l1 + (size_t)(128 + d * 64) * 2048 + 1024, 2048, 64, 1024, 0, NOGRP, 0);
            }
            const float* v1 = (j == 1) ? a.in[I_V1] : nullptr;
            addjob(L, v1, 32, D, 32, nullptr, l1 + (size_t)256 * 2048, 2048, 64, 1024, 0, NOGRP, 0);
            addjob(L, v1, 32, D, 32, mix + 3 * D, l1 + (size_t)256 * 2048 + 1024, 2048, 64, 1024, 0, NOGRP, 0);
            addjob(L, a.in[I_G1] + (size_t)j * D * 160, 160, D, 160, nullptr, l1 + (size_t)320 * 2048, 2048, 192, 1024, 0, NOGRP, 0);
            addjob(L, a.in[I_G1] + (size_t)j * D * 160, 160, D, 160, mix + 5 * D, l1 + (size_t)320 * 2048 + 1024, 2048, 192, 1024, 0, NOGRP, 0);
            for (int d = 0; d < 2; ++d) {
                addjob(L, a.in[I_W2] + (size_t)(j * 2 + d) * 64 * D, D, 64, D, nullptr, l2a + (size_t)(d * 1024) * 256, 256, 1024, 256, d * 64, NOGRP, 0);
                addjob(L, a.in[I_A2] + (size_t)(j * 2 + d) * 64 * D, D, 64, D, nullptr, l2a + (size_t)(2048 + d * 1024) * 256, 256, 1024, 256, 128 + d * 64, NOGRP, 0);
            }
            addjob(L, a.in[I_G2] + (size_t)j * 160 * D, D, 160, D, nullptr, l2b, 256, 1024, 256, 64, NOGRP, 0);
            addjob(L, (j == 1) ? a.in[I_V2] : nullptr, D, 32, D, nullptr, l2b + (size_t)1024 * 256, 256, 1024, 256, 0, NOGRP, 0);
        }
        {
            bf16_t* w = wffn(a, j);
            addjob(L, a.in[I_F1] + (size_t)j * D * DFF, DFF, D, DFF, nullptr, w, 1024, DFF, 1024, 0, 128, 256);
            addjob(L, a.in[I_F3] + (size_t)j * D * DFF, DFF, D, DFF, nullptr, w + (size_t)128 * 1024, 1024, DFF, 1024, 0, 128, 256);
            addjob(L, a.in[I_F2] + (size_t)j * DFF * D, D, DFF, D, nullptr, w + E_F13, DFF, 1024, DFF, 0, NOGRP, 0);
        }
    }
}
__device__ __forceinline__ void jobs_moe(const Args& a, JobList& L, int k) {
    bf16_t* w13 = (bf16_t*)(a.ws + WS_ARENA + A_WM13); bf16_t* w2 = (bf16_t*)(a.ws + WS_ARENA + A_WM2);
#pragma unroll 1
    for (int e = 0; e < NE; ++e) {
        const size_t so = (size_t)(k * NE + e) * D * DFE;
        addjob(L, a.in[I_M1] + so, DFE, D, DFE, nullptr, w13 + (size_t)e * E_M13, 1024, DFE, 1024, 0, 128, 256);
        addjob(L, a.in[I_M3] + so, DFE, D, DFE, nullptr, w13 + (size_t)e * E_M13 + (size_t)128 * 1024, 1024, DFE, 1024, 0, 128, 256);
        addjob(L, a.in[I_M2] + so, D, DFE, D, nullptr, w2 + (size_t)e * E_M2, DFE, 1024, DFE, 0, NOGRP, 0);
    }
}
__device__ __forceinline__ void run_prep(const Args& a, LAS unsigned char* jl, int which  , int j0  , int G, int c) {
    const int tid = ltid();
    LAS Job* jobs = (LAS Job*)jl; LAS int* hdr = (LAS int*)(jl + MAXJOB * sizeof(Job)); LAS float* tile = (LAS float*)(jl + MAXJOB * sizeof(Job) + 64);
    if (tid == 0) { JobList L{jobs, 0, 0, launder_s(0)}; if (which < 0) jobs_small(a, L); else jobs_moe(a, L, which); hdr[0] = L.n + L.z; hdr[1] = L.tiles + L.z; }
    __syncthreads();
    const int nj = hdr[0], ntile = hdr[1];
    const int kl = tid >> 4, nq = (tid & 15) * 4, sn = tid >> 3, sk = (tid & 7) * 8;
    int jcur = 0;
#define PREP_BAR() do { asm volatile("s_waitcnt lgkmcnt(0)" ::: "memory"); __builtin_amdgcn_s_barrier(); asm volatile("" ::: "memory"); } while (0)
    f32x4 vcur[2], vnxt[2];
#define PREP_FETCH(t_, dstv) do { while (jcur + 1 < nj && jobs[jcur + 1].tile0 <= (t_)) ++jcur; const LAS Job* J_ = jobs + jcur; \
        const float* src_ = J_->src; const float* ks_ = J_->kscale; const int sld_ = J_->sld, srcK_ = J_->srcK, srcN_ = J_->srcN, koff_ = J_->koff, tn_ = J_->tn, tl_ = (t_) - J_->tile0; \
        const int n0_ = (tl_ % tn_) * 64, k0_ = (tl_ / tn_) * 64; \
        _Pragma("unroll") for (int p = 0; p < 2; ++p) { const int kk = k0_ + kl + 32 * p, ksi = kk - koff_, n = n0_ + nq; f32x4 v = (f32x4){0.f, 0.f, 0.f, 0.f}; \
            if (src_ != nullptr && ksi >= 0 && ksi < srcK_ && n < srcN_) { v = *(const __attribute__((address_space(1))) f32x4*)(src_ + (size_t)ksi * sld_ + n); if (ks_) v = v * *(const __attribute__((address_space(1))) float*)(ks_ + ksi); } dstv[p] = v; } } while (0)
    int t = c + j0 * G;
    if (t < ntile) PREP_FETCH(t, vcur);
    for (; t < ntile; t += G) {
        const int jthis = jcur;
        if (t + G < ntile) PREP_FETCH(t + G, vnxt);
        const LAS Job* J = jobs + jthis;
        bf16_t* __restrict__ dst = J->dst;
        const int ldd = J->ldd, Nd = J->Nd, grp = J->grp, gstride = J->gstride, tn = J->tn, tl = t - J->tile0;
        const int n0 = (tl % tn) * 64, k0 = (tl / tn) * 64;
#pragma unroll
        for (int p = 0; p < 2; ++p) { LAS float* tp = tile + (kl + 32 * p) * 65 + nq; tp[0] = vcur[p][0]; tp[1] = vcur[p][1]; tp[2] = vcur[p][2]; tp[3] = vcur[p][3]; }
        PREP_BAR();
        { const int n = n0 + sn;
            if (n < Nd) { float f[8];
#pragma unroll
                for (int e = 0; e < 8; ++e) f[e] = tile[(sk + e) * 65 + sn];
                const int dr = (n / grp) * gstride + (n % grp);
                *(__attribute__((address_space(1))) u32x4*)(dst + (size_t)dr * ldd + k0 + sk) = pack8(f); } }
        PREP_BAR();
        vcur[0] = vnxt[0]; vcur[1] = vnxt[1];
    }
#undef PREP_FETCH
#undef PREP_BAR
    asm volatile("s_waitcnt vmcnt(0)" ::: "memory"); __syncthreads();
}

__device__ __forceinline__ void prologue_misc(const Args& a, LAS unsigned char* lds, int G, int c) {
    const int tid = ltid();
    if (c == 0) { float* rt = (float*)(a.ws + WS_ROPE);
      for (int i = tid; i < 1024; i += NTHR) { const int pos = i >> 4, j = i & 15; const double inv = 1.0 / pow(10000.0, (double)j / 16.0), ang = (double)pos * inv; rt[i] = (float)cos(ang); rt[1024 + i] = (float)sin(ang); } }
    LAS float* sc = (LAS float*)lds;
    LAS float* red = (LAS float*)(lds + 49152);
    for (int i = tid; i < 1024 * 12; i += NTHR) { const int k = i / 12, m = i % 12; float v = 0.f;
        if (m < 9) { const float x = (m < 8) ? a.in[I_C][m * D + k] : a.in[I_CCTX][k]; v = x / (1.0f + expf(-x)); } sc[i] = v; }
    __syncthreads();
    const int kq = tid >> 6, col = tid & 63;
    for (int u = c; u < 4 * 96; u += G) {
        const int layer = u / 96, n0 = (u % 96) * 64;
        const float* w = a.in[I_ADAW] + (size_t)layer * D * 6144 + n0 + col;
        float acc[9];
#pragma unroll
        for (int m = 0; m < 9; ++m) acc[m] = 0.f;
        for (int k8 = 0; k8 < 128; k8 += 8) {
            float wv[8];
#pragma unroll
            for (int e = 0; e < 8; ++e) wv[e] = w[(size_t)(kq * 128 + k8 + e) * 6144];
#pragma unroll
            for (int e = 0; e < 8; ++e) { const LAS f32x4* sp = (const LAS f32x4*)(sc + (kq * 128 + k8 + e) * 12); const f32x4 s0 = sp[0], s1 = sp[1], s2 = sp[2];
                acc[0] += s0[0] * wv[e]; acc[1] += s0[1] * wv[e]; acc[2] += s0[2] * wv[e]; acc[3] += s0[3] * wv[e];
                acc[4] += s1[0] * wv[e]; acc[5] += s1[1] * wv[e]; acc[6] += s1[2] * wv[e]; acc[7] += s1[3] * wv[e]; acc[8] += s2[0] * wv[e]; }
        }
#pragma unroll
        for (int m = 0; m < 9; ++m) red[(kq * 9 + m) * 64 + col] = acc[m];
        __syncthreads();
        for (int i = tid; i < 9 * 64; i += NTHR) { const int m = i >> 6, cc = i & 63; float s = 0.f;
#pragma unroll
            for (int q = 0; q < 8; ++q) s += red[(q * 9 + m) * 64 + cc];
            ((float*)(a.ws + WS_MODS))[(size_t)(layer * 9 + m) * 6144 + n0 + cc] = s + a.in[I_ADAB][layer * 6144 + n0 + cc]; }
        __syncthreads();
    }
}

struct RowParams { float A[16], Bv[16]; int mi; };
__device__ __forceinline__ void load_params(const Args& a, RowParams& P, int layer, int mi, const float* gain, int which, int lane) {
    const float* sh = mods_ptr(a, layer, mi, which); const float* scl = mods_ptr(a, layer, mi, which + 1);
#pragma unroll
    for (int j = 0; j < 2; ++j) { const int col = j * 512 + lane * 8;
#pragma unroll
        for (int q = 0; q < 2; ++q) { const f32x4 g = *(const f32x4*)(gain + col + 4 * q), s = *(const f32x4*)(scl + col + 4 * q), t = *(const f32x4*)(sh + col + 4 * q);
#pragma unroll
            for (int e = 0; e < 4; ++e) { P.A[j * 8 + q * 4 + e] = g[e] * (1.0f + s[e]); P.Bv[j * 8 + q * 4 + e] = t[e]; } } }
    P.mi = mi;
}
__device__ __forceinline__ void load_x16(const float* xp, int lane, float (&x)[16]) {
#pragma unroll
    for (int j = 0; j < 2; ++j)
#pragma unroll
        for (int q = 0; q < 2; ++q) { const f32x4 v = *(const f32x4*)(xp + j * 512 + lane * 8 + 4 * q); x[j * 8 + q * 4 + 0] = v[0]; x[j * 8 + q * 4 + 1] = v[1]; x[j * 8 + q * 4 + 2] = v[2]; x[j * 8 + q * 4 + 3] = v[3]; }
}
__device__ __forceinline__ void store_bf16_row(bf16_t* p, int lane, const float (&h)[16]) {
#pragma unroll
    for (int j = 0; j < 2; ++j) { u32x4 w; w.x = cvt_pk_bf16(h[j * 8 + 0], h[j * 8 + 1]); w.y = cvt_pk_bf16(h[j * 8 + 2], h[j * 8 + 3]); w.z = cvt_pk_bf16(h[j * 8 + 4], h[j * 8 + 5]); w.w = cvt_pk_bf16(h[j * 8 + 6], h[j * 8 + 7]);
        *(u32x4*)(p + j * 512 + lane * 8) = w; }
}
__device__ __forceinline__ void moe_combine16(const Args& a, int row, int layer_prev, int lane, float (&x)[16]) {
    const u32x4 rt = *(const u32x4*)(a.ws + WS_ROUTE + (size_t)row * 16);
    const int e0 = (int)rt[0];
    if (e0 < 0) return;
    const float p0 = __uint_as_float(rt[2]), p1 = __uint_as_float(rt[3]);
    const int* sl = (const int*)(a.ws + WS_RSLOT) + (size_t)row * 2; const int s0 = sl[0], s1 = sl[1];
    const bf16_t* y2 = (const bf16_t*)(a.ws + WS_ARENA + A_Y2);
    const float* g5 = mods_ptr(a, layer_prev, mod_index(row), 5);
    const MoeSplit sp = moe_split(((const int*)(a.ws + WS_META))[8]);
    const int x0 = (s0 >> 8) >= sp.nMf ? sp.S : 1, x1 = (s1 >> 8) >= sp.nMf ? sp.S : 1;
    const size_t o0 = ((size_t)(XP0 + (s0 >> 8) - sp.nMf) * 256 + (s0 & 255)) * 1024, o1 = ((size_t)(XP0 + (s1 >> 8) - sp.nMf) * 256 + (s1 & 255)) * 1024, ostep = (size_t)sp.nT * 256 * 1024;
#pragma unroll
    for (int j = 0; j < 2; ++j) { const int col = j * 512 + lane * 8; float ya[8], yb[8];
        unpack8(*(const u32x4*)(y2 + (size_t)s0 * 1024 + col), ya); unpack8(*(const u32x4*)(y2 + (size_t)s1 * 1024 + col), yb);
        for (int sl = 1; sl < x0; ++sl) { float t[8]; unpack8(*(const u32x4*)(y2 + o0 + (size_t)(sl - 1) * ostep + col), t);
#pragma unroll
            for (int e = 0; e < 8; ++e) ya[e] += t[e]; }
        for (int sl = 1; sl < x1; ++sl) { float t[8]; unpack8(*(const u32x4*)(y2 + o1 + (size_t)(sl - 1) * ostep + col), t);
#pragma unroll
            for (int e = 0; e < 8; ++e) yb[e] += t[e]; }
        const f32x4 g0 = *(const f32x4*)(g5 + col), g1 = *(const f32x4*)(g5 + col + 4);
#pragma unroll
        for (int e = 0; e < 8; ++e) x[j * 8 + e] += (e < 4 ? g0[e] : g1[e - 4]) * (p0 * ya[e] + p1 * yb[e]); }
}
__device__ __forceinline__ void store_x16(float* xp, int lane, const float (&x)[16]) {
#pragma unroll
    for (int j = 0; j < 2; ++j)
#pragma unroll
        for (int q = 0; q < 2; ++q) *(f32x4*)(xp + j * 512 + lane * 8 + 4 * q) = (f32x4){x[j * 8 + q * 4], x[j * 8 + q * 4 + 1], x[j * 8 + q * 4 + 2], x[j * 8 + q * 4 + 3]};
}
__device__ __forceinline__ void norm_row(const float (&x)[16], const RowParams& P, float (&h)[16]) {
    float ss = 0.f;
#pragma unroll
    for (int e = 0; e < 16; ++e) ss += x[e] * x[e];
    ss = wave_sum(ss);
    const float rstd = 1.0f / sqrtf(ss * (1.0f / 1024.0f) + NORM_EPS);
#pragma unroll
    for (int e = 0; e < 16; ++e) h[e] = x[e] * rstd * P.A[e] + P.Bv[e];
}
__device__ __forceinline__ void wave_rows(int G, int c, int& r0, int& r1) {
    const int nw = G * NWAVE, per = (R + nw - 1) / nw, gw = c * NWAVE + (ltid() >> 6);
    r0 = gw * per; r1 = r0 + per; if (r0 > R) r0 = R; if (r1 > R) r1 = R;
}
template <bool COMBINE, bool FIRST = false>
__device__ __forceinline__ void norm_plain(const Args& a, int layer, const float* gain, int which, bf16_t* Hout, int G, int c) {
    const int lane = ltid() & 63; int r0, r1; wave_rows(G, c, r0, r1);
    RowParams P; P.mi = -1;
    for (int row = r0; row < r1; ++row) {
        const int mi = mod_index(row); if (mi != P.mi) load_params(a, P, layer, mi, gain, which, lane);
        float* xp = xrow(a, row); float x[16], h[16]; load_x16(FIRST ? xrow_in(a, row) : xp, lane, x);
        if (COMBINE) { moe_combine16(a, row, layer - 1, lane, x); store_x16(xp, lane, x); }
        norm_row(x, P, h); store_bf16_row(Hout + (size_t)row * 1024, lane, h);
    }
}
__device__ __forceinline__ bool seg_first(int row) { const int r = row % SEG; return r == 0 || r == CTX; }
__device__ __forceinline__ bool seg_last(int row) { const int r = row % SEG; return r == CTX - 1 || r == SEG - 1; }
__device__ __forceinline__ void norm_mix(const Args& a, int layer, int j, int G, int c) {
    const int lane = ltid() & 63; int r0, r1; wave_rows(G, c, r0, r1); if (r0 >= r1) return;
    const float* gain = a.in[I_N1G] + layer * D; const float* mix = a.in[I_MIX] + (size_t)j * 6 * D;
    bf16_t* AX = (bf16_t*)(a.ws + WS_ARENA + A_AX);
    float mr[16], mk[16], mv[16];
#pragma unroll
    for (int jj = 0; jj < 2; ++jj)
#pragma unroll
        for (int e = 0; e < 8; ++e) { const int col = jj * 512 + lane * 8 + e; mr[jj * 8 + e] = mix[col]; mk[jj * 8 + e] = mix[2 * D + col]; mv[jj * 8 + e] = mix[3 * D + col]; }
    RowParams P; P.mi = -1;
    float hp[16], hc[16], hn[16], x[16];
    if (!seg_first(r0)) { const int mi = mod_index(r0 - 1); if (mi != P.mi) load_params(a, P, layer, mi, gain, 0, lane); load_x16(xrow(a, r0 - 1), lane, x); norm_row(x, P, hp); }
    else {
#pragma unroll
        for (int e = 0; e < 16; ++e) hp[e] = 0.f; }
    { const int mi = mod_index(r0); if (mi != P.mi) load_params(a, P, layer, mi, gain, 0, lane); load_x16(xrow(a, r0), lane, x); norm_row(x, P, hc); }
    for (int row = r0; row < r1; ++row) {
        if (row + 1 < R) { const int mi = mod_index(row + 1); if (mi != P.mi) load_params(a, P, layer, mi, gain, 0, lane); load_x16(xrow(a, row + 1), lane, x); norm_row(x, P, hn); }
        else {
#pragma unroll
            for (int e = 0; e < 16; ++e) hn[e] = 0.f; }
        const float fp = seg_first(row) ? 0.f : 0.5f, fn = seg_last(row) ? 0.f : 0.5f;
        float xx[16], t[16];
#pragma unroll
        for (int e = 0; e < 16; ++e) xx[e] = fp * hp[e] + fn * hn[e] - hc[e];
        bf16_t* o = AX + (size_t)row * 5120;
        store_bf16_row(o, lane, hc); store_bf16_row(o + 1024, lane, xx);
#pragma unroll
        for (int e = 0; e < 16; ++e) t[e] = hc[e] + xx[e] * mr[e];
        store_bf16_row(o + 2048, lane, t);
#pragma unroll
        for (int e = 0; e < 16; ++e) t[e] = hc[e] + xx[e] * mk[e];
        store_bf16_row(o + 3072, lane, t);
#pragma unroll
        for (int e = 0; e < 16; ++e) t[e] = hc[e] + xx[e] * mv[e];
        store_bf16_row(o + 4096, lane, t);
#pragma unroll
        for (int e = 0; e < 16; ++e) { hp[e] = hc[e]; hc[e] = hn[e]; }
    }
}
__device__ __forceinline__ void norm_router(const Args& a, int layer, int k, bool last, LAS unsigned char* lds, int G, int c) {
    const int tid = ltid(), lane = tid & 63; int r0, r1; wave_rows(G, c, r0, r1);
    LAS float* rw = (LAS float*)lds;
    { const float* rsrc = a.in[I_ROUTER] + (size_t)k * D * NE; for (int i = tid; i < D * NE; i += NTHR) rw[i] = rsrc[i]; }
    __syncthreads();
    const float* gain = a.in[I_N2G] + layer * D;
    bf16_t* Hout = (bf16_t*)(a.ws + WS_ARENA + A_H);
    RowParams P; P.mi = -1;
    int hist[8];
#pragma unroll
    for (int e = 0; e < 8; ++e) hist[e] = 0;
    for (int row = r0; row < r1; ++row) {
        const int mi = mod_index(row); if (mi != P.mi) load_params(a, P, layer, mi, gain, 3, lane);
        float x[16], h[16]; load_x16(xrow(a, row), lane, x); norm_row(x, P, h); store_bf16_row(Hout + (size_t)row * 1024, lane, h);
        const bool routed = !(last && mi == 8);
        float lg[8];
#pragma unroll
        for (int e = 0; e < 8; ++e) lg[e] = 0.f;
#pragma unroll
        for (int jj = 0; jj < 2; ++jj)
#pragma unroll
            for (int q = 0; q < 8; ++q) { const LAS f32x4* rp = (const LAS f32x4*)(rw + (jj * 512 + lane * 8 + q) * 8); const f32x4 w0 = rp[0], w1 = rp[1]; const float hv = h[jj * 8 + q];
                lg[0] += hv * w0[0]; lg[1] += hv * w0[1]; lg[2] += hv * w0[2]; lg[3] += hv * w0[3]; lg[4] += hv * w1[0]; lg[5] += hv * w1[1]; lg[6] += hv * w1[2]; lg[7] += hv * w1[3]; }
#pragma unroll
        for (int e = 0; e < 8; ++e) lg[e] = wave_sum(lg[e]);
        int e0 = 0; float v0 = lg[0];
#pragma unroll
        for (int e = 1; e < 8; ++e) if (lg[e] > v0) { v0 = lg[e]; e0 = e; }
        int e1 = -1; float v1 = -3.0e38f;
#pragma unroll
        for (int e = 0; e < 8; ++e) if (e != e0 && lg[e] > v1) { v1 = lg[e]; e1 = e; }
        const float p0 = 1.0f / (1.0f + expf(v1 - v0)), p1 = 1.0f - p0;
        if (routed) {
#pragma unroll
            for (int e = 0; e < 8; ++e) hist[e] += (e == e0 || e == e1) ? 1 : 0; }
        if (lane == 0) *(u32x4*)(a.ws + WS_ROUTE + (size_t)row * 16) = (u32x4){(unsigned)(routed ? e0 : -1), (unsigned)(routed ? e1 : -1), __float_as_uint(p0), __float_as_uint(p1)};
    }
    const int gw = c * NWAVE + (tid >> 6);
    if (lane == 0) { int* hp = (int*)(a.ws + WS_HIST) + (size_t)gw * 8;
#pragma unroll
        for (int e = 0; e < 8; ++e) hp[e] = hist[e]; }
}

__device__ __forceinline__ void mla_stats(const Args& a, int G, int c) {
    const int lane = ltid() & 63; int r0, r1; wave_rows(G, c, r0, r1);
    const bf16_t* QKVA = (const bf16_t*)(a.ws + WS_ARENA + A_QKVA); float* rs = (float*)(a.ws + WS_RS);
    for (int row = r0; row < r1; ++row) {
        float sq = 0.f, skv = 0.f; float f[8];
        if (lane < 48) { unpack8(*(const u32x4*)(QKVA + (size_t)row * 768 + lane * 8), f);
#pragma unroll
            for (int e = 0; e < 8; ++e) sq += f[e] * f[e]; }
        if (lane < 32) { unpack8(*(const u32x4*)(QKVA + (size_t)row * 768 + 384 + lane * 8), f);
#pragma unroll
            for (int e = 0; e < 8; ++e) skv += f[e] * f[e]; }
        sq = wave_sum(sq); skv = wave_sum(skv);
        if (lane == 0) { rs[row] = 1.0f / sqrtf(sq * (1.0f / 384.0f) + NORM_EPS); rs[R + row] = 1.0f / sqrtf(skv * (1.0f / 256.0f) + NORM_EPS); }
    }
}
__device__ __forceinline__ void mla_qkpost(const Args& a, int j, int G, int c) {
    const int lane = ltid() & 63, hd = lane >> 3, sub = lane & 7; int r0, r1; wave_rows(G, c, r0, r1);
    bf16_t* Q = (bf16_t*)(a.ws + WS_ARENA + A_Q); const bf16_t* KV = (const bf16_t*)(a.ws + WS_ARENA + A_KV); const bf16_t* QKVA = (const bf16_t*)(a.ws + WS_ARENA + A_QKVA);
    bf16_t* K = (bf16_t*)(a.ws + WS_ARENA + A_K); const float* rt = (const float*)(a.ws + WS_ROPE);
    float gq[3][8], gk[3][8];
#pragma unroll
    for (int cc = 0; cc < 3; ++cc)
#pragma unroll
        for (int e = 0; e < 8; ++e) { gq[cc][e] = a.in[I_QN][j * QKH + cc * 64 + sub * 8 + e]; gk[cc][e] = a.in[I_KN][j * QKH + cc * 64 + sub * 8 + e]; }
    const float sgn = (sub & 2) ? 1.0f : -1.0f;
    for (int row = r0; row < r1; ++row) {
        const int r = row % SEG; const bool lat = r >= CTX; const int t = r - CTX, pos = (sub & 4) ? (t & 63) : (t >> 6);
        float cs[8], sn[8];
        if (lat) {
#pragma unroll
            for (int q = 0; q < 2; ++q) { const f32x4 cv = *(const f32x4*)(rt + pos * 16 + (sub & 1) * 8 + 4 * q), sv = *(const f32x4*)(rt + 1024 + pos * 16 + (sub & 1) * 8 + 4 * q);
#pragma unroll
                for (int e = 0; e < 4; ++e) { cs[q * 4 + e] = cv[e]; sn[q * 4 + e] = sv[e]; } } }
        float v[3][8];
        bf16_t* qp = Q + (size_t)row * 1536 + hd * QKH + sub * 8;
#pragma unroll
        for (int cc = 0; cc < 3; ++cc) unpack8(*(const u32x4*)(qp + cc * 64), v[cc]);
        { float ss = 0.f;
#pragma unroll
          for (int cc = 0; cc < 3; ++cc)
#pragma unroll
              for (int e = 0; e < 8; ++e) ss += v[cc][e] * v[cc][e];
          ss = red8(ss); const float rstd = 1.0f / sqrtf(ss * (1.0f / 192.0f) + NORM_EPS);
#pragma unroll
          for (int cc = 0; cc < 3; ++cc)
#pragma unroll
              for (int e = 0; e < 8; ++e) v[cc][e] = v[cc][e] * rstd * gq[cc][e];
          if (lat) {
#pragma unroll
              for (int e = 0; e < 8; ++e) { const float pr = __shfl_xor(v[2][e], 2); v[2][e] = v[2][e] * cs[e] + sgn * pr * sn[e]; } }
#pragma unroll
          for (int cc = 0; cc < 3; ++cc) {
#pragma unroll
              for (int e = 0; e < 8; ++e) v[cc][e] *= QSCALE;
              *(u32x4*)(qp + cc * 64) = pack8(v[cc]); } }
        const bf16_t* kp = KV + (size_t)row * 2048 + hd * 256 + sub * 8;
        unpack8(*(const u32x4*)(kp), v[0]); unpack8(*(const u32x4*)(kp + 64), v[1]); unpack8(*(const u32x4*)(QKVA + (size_t)row * 768 + 640 + sub * 8), v[2]);
        { float ss = 0.f;
#pragma unroll
          for (int cc = 0; cc < 3; ++cc)
#pragma unroll
              for (int e = 0; e < 8; ++e) ss += v[cc][e] * v[cc][e];
          ss = red8(ss); const float rstd = 1.0f / sqrtf(ss * (1.0f / 192.0f) + NORM_EPS);
#pragma unroll
          for (int cc = 0; cc < 3; ++cc)
#pragma unroll
              for (int e = 0; e < 8; ++e) v[cc][e] = v[cc][e] * rstd * gk[cc][e];
          if (lat) {
#pragma unroll
              for (int e = 0; e < 8; ++e) { const float pr = __shfl_xor(v[2][e], 2); v[2][e] = v[2][e] * cs[e] + sgn * pr * sn[e]; } }
          bf16_t* ko = K + (size_t)row * 1536 + hd * QKH + sub * 8;
#pragma unroll
          for (int cc = 0; cc < 3; ++cc) *(u32x4*)(ko + cc * 64) = pack8(v[cc]); }
    }
}

namespace att {
constexpr int KVBLK = 64, KROWB = 384;
constexpr int SHM_V = KVBLK * 128 * 2, SHM_K = KVBLK * KROWB;
constexpr int SHM_ATTN = 2 * SHM_V + 2 * SHM_K + NWAVE * 64 * 4;
constexpr float THR = 11.5f;
#define KSWZ(row, colB) ((row) * att::KROWB + ((colB) ^ (((row) & 7) << 4)))
#define SBAR() __builtin_amdgcn_sched_barrier(0)
__device__ __forceinline__ int crow(int r, int hi) { return (r & 3) + 8 * (r >> 2) + 4 * hi; }
__device__ __forceinline__ void partialSM(f32x16& p0, f32x16& p1, float& m_reg, float& mn, float& alpha) {
    float pmax = p0[0];
#pragma unroll
    for (int r = 1; r < 16; ++r) pmax = fmaxf(pmax, p0[r]);
#pragma unroll
    for (int r = 0; r < 16; ++r) pmax = fmaxf(pmax, p1[r]);
    { auto rr = __builtin_amdgcn_permlane32_swap(__float_as_uint(pmax), __float_as_uint(pmax), false, false); pmax = fmaxf(__uint_as_float(rr[0]), __uint_as_float(rr[1])); }
    if (__builtin_expect(__all(pmax - m_reg <= THR), 1)) { mn = m_reg; alpha = 1.f; }
    else { mn = fmaxf(m_reg, pmax); alpha = __builtin_amdgcn_exp2f(m_reg - mn); m_reg = mn; }
#pragma unroll
    for (int r = 0; r < 16; ++r) { p0[r] -= mn; p1[r] -= mn; }
#pragma unroll
    for (int r = 0; r < 16; ++r) p0[r] = __builtin_amdgcn_exp2f(p0[r]);
}
__device__ __forceinline__ void finishSM(f32x16& p0, f32x16& p1, float alpha, float& l_reg, bf16x8& pa0, bf16x8& pa1, bf16x8& pa2, bf16x8& pa3) {
#pragma unroll
    for (int r = 0; r < 16; ++r) p1[r] = __builtin_amdgcn_exp2f(p1[r]);
    float ps = 0;
#pragma unroll
    for (int r = 0; r < 16; ++r) ps += p0[r];
#pragma unroll
    for (int r = 0; r < 16; ++r) ps += p1[r];
    { auto rr = __builtin_amdgcn_permlane32_swap(__float_as_uint(ps), __float_as_uint(ps), false, false); ps = __uint_as_float(rr[0]) + __uint_as_float(rr[1]); }
    l_reg = l_reg * alpha + ps;
#define PK4(P, BASE, OUT) do { unsigned a0 = cvt_pk_bf16(P[BASE + 0], P[BASE + 1]), a1 = cvt_pk_bf16(P[BASE + 2], P[BASE + 3]);   \
    unsigned b0 = cvt_pk_bf16(P[BASE + 4], P[BASE + 5]), b1 = cvt_pk_bf16(P[BASE + 6], P[BASE + 7]);                              \
    auto r0 = __builtin_amdgcn_permlane32_swap(a0, b0, false, false); auto r1 = __builtin_amdgcn_permlane32_swap(a1, b1, false, false); \
    u32x4 w = {r0[0], r1[0], r0[1], r1[1]}; OUT = *reinterpret_cast<bf16x8*>(&w); } while (0)
    PK4(p0, 0, pa0); PK4(p0, 8, pa1); PK4(p1, 0, pa2); PK4(p1, 8, pa3);
#undef PK4
}
__device__ __forceinline__ void qkt(f32x16& p0, f32x16& p1, const char* Ks, const bf16x8* qr, int r32, int hi) {
    p0 = f32x16{}; p1 = f32x16{};
    bf16x8 ka[4], kb[4];
#define QK_LD(buf, g) do { _Pragma("unroll") for (int q_ = 0; q_ < 2; ++q_) { const int cb_ = ((2 * (g) + q_) * 16 + hi * 8) * 2; \
        buf[2 * q_] = *reinterpret_cast<const bf16x8*>(Ks + KSWZ(r32, cb_)); buf[2 * q_ + 1] = *reinterpret_cast<const bf16x8*>(Ks + KSWZ(32 + r32, cb_)); } } while (0)
#define QK_MM(buf, g) do { _Pragma("unroll") for (int q_ = 0; q_ < 2; ++q_) { p0 = __builtin_amdgcn_mfma_f32_32x32x16_bf16(buf[2 * q_], qr[2 * (g) + q_], p0, 0, 0, 0); \
        p1 = __builtin_amdgcn_mfma_f32_32x32x16_bf16(buf[2 * q_ + 1], qr[2 * (g) + q_], p1, 0, 0, 0); } } while (0)
    QK_LD(ka, 0); SBAR();
    QK_LD(kb, 1); SBAR(); QK_MM(ka, 0); SBAR();
    QK_LD(ka, 2); SBAR(); QK_MM(kb, 1); SBAR();
    QK_LD(kb, 3); SBAR(); QK_MM(ka, 2); SBAR();
    QK_LD(ka, 4); SBAR(); QK_MM(kb, 3); SBAR();
    QK_LD(kb, 5); SBAR(); QK_MM(ka, 4); SBAR();
    QK_MM(kb, 5); SBAR();
#undef QK_LD
#undef QK_MM
}
__device__ __forceinline__ int v_st(int k, int c) { const int kk = (k & ~0xC) | ((k & 4) << 1) | ((k & 8) >> 1); return ((kk >> 3) * 4 + (c >> 5)) * 512 + ((kk & 7) * 32 + (c & 31)) * 2; }
__device__ __forceinline__ int v_rd_base(int lane) { return ((lane & 3) << 3) | (((lane >> 2) & 3) << 6) | (((lane >> 4) & 1) << 5) | (((lane >> 5) & 1) << 8); }
constexpr int v_rd_off(int d0, int ks, int half) { return d0 * 512 + ks * 4096 + half * 2048; }
template <int OFF> __device__ __forceinline__ s16x4 tr_read(int vb) { s16x4 r; asm volatile("ds_read_b64_tr_b16 %0, %1 offset:%2" : "=&v"(r) : "v"(vb), "i"(OFF) : "memory"); return r; }
struct VFrag { s16x4 l0, h0, l1, h1, l2, h2, l3, h3; };
template <int D0> __device__ __forceinline__ void pv_issue(VFrag& f, int vb) {
    f.l0 = tr_read<v_rd_off(D0, 0, 0)>(vb); f.h0 = tr_read<v_rd_off(D0, 0, 1)>(vb); f.l1 = tr_read<v_rd_off(D0, 1, 0)>(vb); f.h1 = tr_read<v_rd_off(D0, 1, 1)>(vb);
    f.l2 = tr_read<v_rd_off(D0, 2, 0)>(vb); f.h2 = tr_read<v_rd_off(D0, 2, 1)>(vb); f.l3 = tr_read<v_rd_off(D0, 3, 0)>(vb); f.h3 = tr_read<v_rd_off(D0, 3, 1)>(vb);
}
__device__ __forceinline__ void pv_mma(f32x16& od, const VFrag& f, bf16x8 pa0, bf16x8 pa1, bf16x8 pa2, bf16x8 pa3) {
#define PK(L, H) (bf16x8){L[0], L[1], L[2], L[3], H[0], H[1], H[2], H[3]}
    od = __builtin_amdgcn_mfma_f32_32x32x16_bf16(pa0, PK(f.l0, f.h0), od, 0, 0, 0);
    od = __builtin_amdgcn_mfma_f32_32x32x16_bf16(pa1, PK(f.l1, f.h1), od, 0, 0, 0);
    od = __builtin_amdgcn_mfma_f32_32x32x16_bf16(pa2, PK(f.l2, f.h2), od, 0, 0, 0);
    od = __builtin_amdgcn_mfma_f32_32x32x16_bf16(pa3, PK(f.l3, f.h3), od, 0, 0, 0);
#undef PK
}
__device__ __forceinline__ void pv_d0(f32x16* o, int vb, bf16x8 pa0, bf16x8 pa1, bf16x8 pa2, bf16x8 pa3) {
    VFrag fa, fb;
    pv_issue<0>(fa, vb); pv_issue<1>(fb, vb);
    asm volatile("s_waitcnt lgkmcnt(8)" ::: "memory"); SBAR(); pv_mma(o[0], fa, pa0, pa1, pa2, pa3); SBAR();
    pv_issue<2>(fa, vb);
    asm volatile("s_waitcnt lgkmcnt(8)" ::: "memory"); SBAR(); pv_mma(o[1], fb, pa0, pa1, pa2, pa3); SBAR();
    pv_issue<3>(fb, vb);
    asm volatile("s_waitcnt lgkmcnt(8)" ::: "memory"); SBAR(); pv_mma(o[2], fa, pa0, pa1, pa2, pa3); SBAR();
    asm volatile("s_waitcnt lgkmcnt(0)" ::: "memory"); SBAR(); pv_mma(o[3], fb, pa0, pa1, pa2, pa3);
}
__device__ __forceinline__ void attn_unit(const bf16_t* __restrict__ Qb, const bf16_t* __restrict__ Kh, const bf16_t* __restrict__ Vh, bf16_t* __restrict__ Ob, int seq, char* lds) {
    constexpr int LDQ = 1536, LDK = 1536, LDV = 2048, LDO = 1024;
    const int tid = ltid(), wid = tid >> 6, lane = tid & 63, r32 = lane & 31, hi = lane >> 5;
    char* V_lds = lds; char* K_lds = lds + 2 * SHM_V;
    float* wsp = (float*)(lds + 2 * SHM_V + 2 * SHM_K) + wid * 64; float* li_l = wsp; float* al_l = wsp + 32;
    float m_reg = -1e30f, l_reg = 0; f32x16 o[4] = {}; bf16x8 qr[12];
    const bf16_t* Qw = Qb + (long)(wid * 32 + r32) * LDQ + hi * 8;
#pragma unroll
    for (int d0 = 0; d0 < 12; ++d0) qr[d0] = *(const __attribute__((address_space(1))) bf16x8*)((const __attribute__((address_space(1))) bf16_t*)Qw + d0 * 16);
    const int sr = tid >> 4, sc = (tid & 15) * 8, vst0 = v_st(sr, sc), vst1 = v_st(32 + sr, sc);
    int kkey[3], kcb[3];
#pragma unroll
    for (int i = 0; i < 3; ++i) { const int ci = tid + i * 512; kkey[i] = ci / 24; kcb[i] = (ci % 24) * 16; }
    const int vb0 = (int)(uintptr_t)(LAS char*)V_lds + v_rd_base(lane);
    bf16x8 vs0, vs1, ks0, ks1, ks2;
#define GAS __attribute__((address_space(1)))
#define SLOAD(k0) do { vs0 = *(const GAS bf16x8*)((const GAS bf16_t*)Vh + (long)((k0) + sr) * LDV + sc); vs1 = *(const GAS bf16x8*)((const GAS bf16_t*)Vh + (long)((k0) + 32 + sr) * LDV + sc); \
    ks0 = *(const GAS bf16x8*)((const GAS char*)Kh + (long)((k0) + kkey[0]) * (LDK * 2) + kcb[0]); ks1 = *(const GAS bf16x8*)((const GAS char*)Kh + (long)((k0) + kkey[1]) * (LDK * 2) + kcb[1]); \
    ks2 = *(const GAS bf16x8*)((const GAS char*)Kh + (long)((k0) + kkey[2]) * (LDK * 2) + kcb[2]); } while (0)
#define SWRITE(b) do { *(bf16x8*)(V_lds + (b) * SHM_V + vst0) = vs0; *(bf16x8*)(V_lds + (b) * SHM_V + vst1) = vs1; \
    *(bf16x8*)(K_lds + (b) * SHM_K + KSWZ(kkey[0], kcb[0])) = ks0; *(bf16x8*)(K_lds + (b) * SHM_K + KSWZ(kkey[1], kcb[1])) = ks1; *(bf16x8*)(K_lds + (b) * SHM_K + KSWZ(kkey[2], kcb[2])) = ks2; } while (0)
#define SWAIT() asm volatile("s_waitcnt vmcnt(0)" ::: "memory")
#define RESC(al) do { if (__any((al) < 1.f)) { if (hi == 0) al_l[r32] = (al); asm volatile("s_waitcnt lgkmcnt(0)" ::: "memory"); \
    _Pragma("unroll") for (int d = 0; d < 4; ++d) _Pragma("unroll") for (int r = 0; r < 16; ++r) o[d][r] *= al_l[crow(r, hi)]; } } while (0)
    f32x16 p0, p1; float mn, al; bf16x8 pa0, pa1, pa2, pa3; const int NT = seq / KVBLK;
    SLOAD(0); SWAIT(); SWRITE(0); __syncthreads();
    for (int j = 0; j < NT; ++j) {
        const int bsel = j & 1;
        if (j + 1 < NT) SLOAD((j + 1) * KVBLK);
        SBAR(); qkt(p0, p1, K_lds + bsel * SHM_K, qr, r32, hi);
        partialSM(p0, p1, m_reg, mn, al);
        RESC(al);
        finishSM(p0, p1, al, l_reg, pa0, pa1, pa2, pa3); SBAR();
        pv_d0(o, vb0 + bsel * SHM_V, pa0, pa1, pa2, pa3);
        if (j + 1 < NT) { SWAIT(); SWRITE(bsel ^ 1); }
        __syncthreads();
    }
    if (hi == 0) li_l[r32] = l_reg; asm volatile("s_waitcnt lgkmcnt(0)" ::: "memory");
    float rli[16];
#pragma unroll
    for (int r = 0; r < 16; ++r) rli[r] = __builtin_amdgcn_rcpf(li_l[crow(r, hi)]);
    bf16_t* Ow = Ob + (long)(wid * 32) * LDO;
#pragma unroll
    for (int r = 0; r < 16; ++r) { const int orow = crow(r, hi);
#pragma unroll
        for (int d0 = 0; d0 < 4; ++d0) { const float val = o[d0][r] * rli[r]; ((__attribute__((address_space(1))) bf16_t*)Ow)[(long)orow * LDO + d0 * 32 + r32] = (bf16_t)(cvt_pk_bf16(val, val) & 0xffffu); } }
    __syncthreads();
#undef SLOAD
#undef SWRITE
#undef SWAIT
#undef RESC
}
}
__device__ __forceinline__ void attn_phase(const Args& a, LAS unsigned char* lds, int G, int c) {
    const bf16_t* Q = (const bf16_t*)(a.ws + WS_ARENA + A_Q); const bf16_t* K = (const bf16_t*)(a.ws + WS_ARENA + A_K); const bf16_t* KV = (const bf16_t*)(a.ws + WS_ARENA + A_KV);
    bf16_t* O = (bf16_t*)(a.ws + WS_ARENA + A_O);
    const int vcu = (G % 8 == 0) ? (c % 8) * (G / 8) + c / 8 : c;
    for (int L = vcu; L < 1024 + 64; L += G) {
        int b, h, q0, seq;
        if (L < 1024) { b = L >> 7; h = (L >> 4) & 7; q0 = CTX + (L & 15) * 256; seq = SEG; } else { const int l2 = L - 1024; b = l2 >> 3; h = l2 & 7; q0 = 0; seq = CTX; }
        const size_t rb = (size_t)b * SEG;
        att::attn_unit(Q + (rb + q0) * 1536 + h * QKH, K + rb * 1536 + h * QKH, KV + rb * 2048 + h * 256 + 128, O + (rb + q0) * 1024 + h * VH, seq, (char*)lds);
    }
}

namespace scan {
constexpr int CH = 32, STEP_B = 6 * 256, BUF_B = CH * STEP_B  , YB_B = CH * 64 * 4  , LDS_B = 2 * BUF_B + 2 * YB_B  , NCH = SEG / CH  ;
constexpr int TILE_B = 64 * 65 * 4, MT_TILES = 24 * 896;
struct MTile { const float* src; bf16_t* dst; int sld, ldd, n0, k0, grpd; };
__device__ __forceinline__ int step_row(int b, int dir, int gs) {
    const int base = b * SEG;
    if (dir == 0) return base + gs;
    return gs < CTX ? base + (CTX - 1 - gs) : base + CTX + (SEG - 1 - gs);
}
struct Raw { u32x4 k, r, v, wl, al, vf, vl; };
}
__device__ __forceinline__ bool moe_tile(const Args& a, int k, int t, scan::MTile& m) {
    if (CS_NOTILE || t >= scan::MT_TILES) return false;
    const int j = t / 896, tl = t - j * 896, e = j / 3, kind = j - e * 3; int tn;
    const size_t so = (size_t)(k * NE + e) * D * DFE;
    if (kind < 2) { m.src = a.in[kind == 0 ? I_M1 : I_M3] + so; m.sld = DFE; m.dst = (bf16_t*)(a.ws + WS_ARENA + A_WM13) + (size_t)e * E_M13 + (kind ? (size_t)128 * 1024 : 0); m.ldd = 1024; tn = 56; m.grpd = 1; }
    else { m.src = a.in[I_M2] + so; m.sld = D; m.dst = (bf16_t*)(a.ws + WS_ARENA + A_WM2) + (size_t)e * E_M2; m.ldd = DFE; tn = 16; m.grpd = 0; }
    m.n0 = (tl % tn) * 64; m.k0 = (tl / tn) * 64; return true;
}
__device__ __forceinline__ void scan_phase(const Args& a, int j, const bf16_t* Vsrc, const bool vres, LAS unsigned char* lds, int G, int c) {
    using namespace scan;
    int mt_round = 0;
    const int tid = ltid(), wave = tid >> 6, lane = tid & 63;
    const bf16_t* RR = (const bf16_t*)(a.ws + WS_ARENA + A_RR); const bf16_t* RK = (const bf16_t*)(a.ws + WS_ARENA + A_RK);
    for (int chain = c; chain < 256; chain += G) {
        const int b = chain >> 5, h = (chain >> 1) & 15, dir = chain & 1;
        const bf16_t* WL = (const bf16_t*)(a.ws + WS_ARENA + (dir ? A_WL1 : A_WL0)); const bf16_t* AL = (const bf16_t*)(a.ws + WS_ARENA + (dir ? A_AL1 : A_AL0));
        bf16_t* Y = (bf16_t*)(a.ws + WS_ARENA + (dir ? A_YR : A_YF));
        if (wave >= 4) {
            const int pt = tid - 256, s = pt >> 3, seg = pt & 7, ch0 = h * 64 + seg * 8;
            float kkp[8], kap[8], v0p[8];
            const bf16_t* VFp = (const bf16_t*)(a.ws + WS_VF); const bf16_t* VLp = (const bf16_t*)(a.ws + WS_ARENA + A_VL);
#pragma unroll
            for (int e = 0; e < 8; ++e) v0p[e] = vres ? a.in[I_V0][ch0 + e] : 0.f;
#pragma unroll
            for (int e = 0; e < 8; ++e) { kkp[e] = a.in[I_KK][(size_t)j * D + ch0 + e]; kap[e] = a.in[I_KA][(size_t)j * D + ch0 + e]; }
            Raw raw;
#define GLOAD(q) do { const size_t off_ = (size_t)step_row(b, dir, (q) * CH + s) * 1024 + ch0; \
                raw.k = *(const u32x4*)(RK + off_); raw.r = *(const u32x4*)(RR + off_); raw.v = *(const u32x4*)(Vsrc + off_); raw.wl = *(const u32x4*)(WL + off_); raw.al = *(const u32x4*)(AL + off_); \
                if (vres) { raw.vf = *(const u32x4*)(VFp + off_); raw.vl = *(const u32x4*)(VLp + off_); } } while (0)
#define PRODUCE(buf) do { \
                float k[8], r[8], v[8], wl[8], al[8]; unpack8(raw.k, k); unpack8(raw.r, r); unpack8(raw.v, v); unpack8(raw.wl, wl); unpack8(raw.al, al); \
                if (vres) { float vf[8], vl[8]; unpack8(raw.vf, vf); unpack8(raw.vl, vl); _Pragma("unroll") for (int e = 0; e < 8; ++e) v[e] = v[e] + (vf[e] - v[e]) * sigmoidf_(v0p[e] + vl[e]); } \
                float ad[8], kd[8], kk[8], ww[8], ss = 0.f; \
                _Pragma("unroll") for (int e = 0; e < 8; ++e) { ad[e] = al[e]; kd[e] = k[e] * (1.0f + (ad[e] - 1.0f) * kap[e]); kk[e] = k[e] * kkp[e]; ss += kk[e] * kk[e]; \
                    ww[e] = __expf(-wl[e]); } \
                ss = red8(ss); const float inv = 1.0f / fmaxf(sqrtf(ss), 1e-12f); \
                LAS f32x4* o = (LAS f32x4*)(lds + (buf) * BUF_B + s * STEP_B + seg * 32); \
                _Pragma("unroll") for (int e = 0; e < 8; ++e) kk[e] *= inv; \
                o[0] = (f32x4){ww[0], ww[1], ww[2], ww[3]}; o[1] = (f32x4){ww[4], ww[5], ww[6], ww[7]}; \
                o[16] = (f32x4){kd[0], kd[1], kd[2], kd[3]}; o[17] = (f32x4){kd[4], kd[5], kd[6], kd[7]}; \
                o[32] = (f32x4){-kk[0], -kk[1], -kk[2], -kk[3]}; o[33] = (f32x4){-kk[4], -kk[5], -kk[6], -kk[7]}; \
                o[48] = (f32x4){kk[0] * ad[0], kk[1] * ad[1], kk[2] * ad[2], kk[3] * ad[3]}; o[49] = (f32x4){kk[4] * ad[4], kk[5] * ad[5], kk[6] * ad[6], kk[7] * ad[7]}; \
                o[64] = (f32x4){r[0], r[1], r[2], r[3]}; o[65] = (f32x4){r[4], r[5], r[6], r[7]}; \
                o[80] = (f32x4){v[0], v[1], v[2], v[3]}; o[81] = (f32x4){v[4], v[5], v[6], v[7]}; } while (0)
#define YSTORE(q) do { const LAS f32x4* yp = (const LAS f32x4*)(lds + 2 * BUF_B + ((q) & 1) * YB_B + s * 256 + seg * 32); const f32x4 y0 = yp[0], y1 = yp[1]; \
                u32x4 w; w.x = cvt_pk_bf16(y0[0], y0[1]); w.y = cvt_pk_bf16(y0[2], y0[3]); w.z = cvt_pk_bf16(y1[0], y1[1]); w.w = cvt_pk_bf16(y1[2], y1[3]); \
                *(u32x4*)(Y + (size_t)step_row(b, dir, (q) * CH + s) * 1024 + ch0) = w; } while (0)
            GLOAD(0); PRODUCE(0); GLOAD(1);
            __syncthreads();
            f32x4 treg[4]; const int kl = pt >> 4, nq = (pt & 15) * 4, sn = pt >> 2, sk = (pt & 3) * 16;
            for (int q = 0; q < NCH; ++q) {
                if (q + 1 < NCH) { PRODUCE((q + 1) & 1); if (q + 2 < NCH) GLOAD(q + 2); }
                if (q >= 1) YSTORE(q - 1);
                MTile m;
                if (q >= 2 && moe_tile(a, j, c + (mt_round + q - 2) * G, m)) {
                    const LAS float* tl_ = (const LAS float*)(lds + LDS_B + (q & 1) * TILE_B); float f0[8], f1[8];
#pragma unroll
                    for (int e = 0; e < 8; ++e) { f0[e] = tl_[(sk + e) * 65 + sn]; f1[e] = tl_[(sk + 8 + e) * 65 + sn]; }
                    const int n = m.n0 + sn, dr = m.grpd ? ((n >> 7) * 256 + (n & 127)) : n; bf16_t* dp = m.dst + (size_t)dr * m.ldd + m.k0 + sk;
                    *(u32x4*)dp = pack8(f0); *(u32x4*)(dp + 8) = pack8(f1); }
                if (q >= 1 && q <= NCH - 2 && moe_tile(a, j, c + (mt_round + q - 1) * G, m)) {
                    LAS float* tl_ = (LAS float*)(lds + LDS_B + ((q - 1) & 1) * TILE_B);
#pragma unroll
                    for (int p = 0; p < 4; ++p) { LAS float* tp = tl_ + (kl + 16 * p) * 65 + nq; tp[0] = treg[p][0]; tp[1] = treg[p][1]; tp[2] = treg[p][2]; tp[3] = treg[p][3]; } }
                if (q <= NCH - 3 && moe_tile(a, j, c + (mt_round + q) * G, m)) {
#pragma unroll
                    for (int p = 0; p < 4; ++p) treg[p] = *(const f32x4*)(m.src + (size_t)(m.k0 + kl + 16 * p) * m.sld + m.n0 + nq); }
                __syncthreads();
            }
            YSTORE(NCH - 1);
#undef GLOAD
#undef PRODUCE
#undef YSTORE
        } else {
            const int rp = lane >> 3, ks = lane & 7, v0i = wave * 16 + rp * 2;
            f32x2 s0[4], s1[4];
#pragma unroll
            for (int i = 0; i < 4; ++i) { s0[i] = (f32x2){0.f, 0.f}; s1[i] = (f32x2){0.f, 0.f}; }
            __syncthreads();
            struct Vecs { f32x4 w0, w1, k0, k1, a0, a1, b0, b1, r0, r1; f32x2 vv; };
#define LOADV(V, t) do { const LAS f32x4* p_ = (const LAS f32x4*)(bp + (t) * STEP_B); V.w0 = p_[0]; V.w1 = p_[1]; V.k0 = p_[16]; V.k1 = p_[17]; V.a0 = p_[32]; V.a1 = p_[33]; \
                    V.b0 = p_[48]; V.b1 = p_[49]; V.r0 = p_[64]; V.r1 = p_[65]; V.vv = *(const LAS f32x2*)(vp + (t) * STEP_B); } while (0)
#define STEPV(V, t, HAVEPREV) do { \
                    const f32x2 wv[4] = {{V.w0[0], V.w0[1]}, {V.w0[2], V.w0[3]}, {V.w1[0], V.w1[1]}, {V.w1[2], V.w1[3]}}, kv[4] = {{V.k0[0], V.k0[1]}, {V.k0[2], V.k0[3]}, {V.k1[0], V.k1[1]}, {V.k1[2], V.k1[3]}}; \
                    const f32x2 av[4] = {{V.a0[0], V.a0[1]}, {V.a0[2], V.a0[3]}, {V.a1[0], V.a1[1]}, {V.a1[2], V.a1[3]}}, bv[4] = {{V.b0[0], V.b0[1]}, {V.b0[2], V.b0[3]}, {V.b1[0], V.b1[1]}, {V.b1[2], V.b1[3]}}; \
                    const f32x2 rv[4] = {{V.r0[0], V.r0[1]}, {V.r0[2], V.r0[3]}, {V.r1[0], V.r1[1]}, {V.r1[2], V.r1[3]}}; \
                    f32x2 d0 = s0[0] * av[0], d1 = s1[0] * av[0]; \
                    d0 += s0[1] * av[1]; d1 += s1[1] * av[1]; d0 += s0[2] * av[2]; d1 += s1[2] * av[2]; d0 += s0[3] * av[3]; d1 += s1[3] * av[3]; \
                    float h0 = d0.x + d0.y, h1 = d1.x + d1.y; \
                    h0 += dpp_f<0xB1>(h0); h1 += dpp_f<0xB1>(h1); yp0 += dpp_f<0xB1>(yp0); yp1 += dpp_f<0xB1>(yp1); \
                    h0 += dpp_f<0x4E>(h0); h1 += dpp_f<0x4E>(h1); yp0 += dpp_f<0x4E>(yp0); yp1 += dpp_f<0x4E>(yp1); \
                    h0 += dpp_f<0x141>(h0); h1 += dpp_f<0x141>(h1); yp0 += dpp_f<0x141>(yp0); yp1 += dpp_f<0x141>(yp1); \
                    if (HAVEPREV) yb[((t) - 1) * 64 + v0i + (ks & 1)] = (ks & 1) ? yp1 : yp0; \
                    const f32x2 sa0v = {h0, h0}, sa1v = {h1, h1}, v0v = {V.vv.x, V.vv.x}, v1v = {V.vv.y, V.vv.y}; \
                    _Pragma("unroll") for (int i = 0; i < 4; ++i) { s0[i] = s0[i] * wv[i] + sa0v * bv[i] + v0v * kv[i]; s1[i] = s1[i] * wv[i] + sa1v * bv[i] + v1v * kv[i]; } \
                    f32x2 y0 = s0[0] * rv[0], y1 = s1[0] * rv[0]; \
                    y0 += s0[1] * rv[1]; y1 += s1[1] * rv[1]; y0 += s0[2] * rv[2]; y1 += s1[2] * rv[2]; y0 += s0[3] * rv[3]; y1 += s1[3] * rv[3]; \
                    yp0 = y0.x + y0.y; yp1 = y1.x + y1.y; } while (0)
            for (int q = 0; q < NCH; ++q) {
                const LAS unsigned char* bp = lds + (q & 1) * BUF_B + ks * 32;
                const LAS unsigned char* vp = lds + (q & 1) * BUF_B + 5 * 256 + v0i * 4;
                LAS float* yb = (LAS float*)(lds + 2 * BUF_B + (q & 1) * YB_B);
                Vecs VA, VB; float yp0 = 0.f, yp1 = 0.f;
                LOADV(VA, 0); LOADV(VB, 1);
                STEPV(VA, 0, false);
                LOADV(VA, 2);
                STEPV(VB, 1, true);
#pragma unroll 1
                for (int t = 2; t < CH; t += 2) {
                    LOADV(VB, t + 1);
                    STEPV(VA, t, true);
                    LOADV(VA, t + 2);
                    STEPV(VB, t + 1, true);
                }
                yp0 = red8(yp0); yp1 = red8(yp1);
                yb[(CH - 1) * 64 + v0i + (ks & 1)] = (ks & 1) ? yp1 : yp0;
                __syncthreads();
            }
#undef LOADV
#undef STEPV
        }
        mt_round += NCH - 2;
        __syncthreads();
    }
}

namespace cs {
constexpr int C = 32, NCK = SEG / C;
constexpr int TM = 72, CM = 40, TMB = TM * 2, CMB = CM * 2;
constexpr int SZ_TM = 32 * TMB, SZ_CM = 64 * CMB, SZ_C32 = 32 * CMB;
constexpr int X_ATM = 0, X_RTM = SZ_TM, X_BHTM = 2 * SZ_TM, X_KHTM = 3 * SZ_TM, X_ACM = 4 * SZ_TM, X_RCM = X_ACM + SZ_CM, X_BBCM = X_RCM + SZ_CM, X_KBCM = X_BBCM + SZ_CM, X_B = X_KBCM + SZ_CM;
constexpr int Y_VCM = 0, Y_GC = SZ_CM, Y_B = SZ_CM + 256;
constexpr int OFF_X = 0, OFF_Y = 2 * X_B, OFF_MID = OFF_Y + 2 * Y_B;
constexpr int M_NL = 0, M_NR = SZ_C32, M_TT = 2 * SZ_C32, M_ARBT = 3 * SZ_C32, M_AAK = 4 * SZ_C32, M_UP = 5 * SZ_C32, M_W = 6 * SZ_C32, M_ARK = M_W + SZ_CM, MID_B = M_ARK + 4096;
constexpr int OFF_OUT = OFF_MID + MID_B;
constexpr int O_PST = 0, O_QST = 64 * TMB, O_PYT = O_QST + SZ_CM, O_QYT = O_PYT + SZ_TM, OUT_B = O_QYT + SZ_C32;
constexpr int OFF_YB = OFF_OUT + OUT_B, OFF_ES = OFF_YB + 8192, OFF_WT = OFF_ES + 2048, LDS_END = OFF_WT + 64 * 65 * 4;
__device__ __forceinline__ int rho(int r, int h) { return (r & 3) + 8 * (r >> 2) + 4 * h; }
__device__ __forceinline__ int perm16(int k) { return (k & ~0xC) | ((k & 4) << 1) | ((k & 8) >> 1); }
typedef __bf16 bf16v2 __attribute__((ext_vector_type(2)));
__device__ __forceinline__ unsigned cvt_pk_bf16_c(float lo, float hi) { const bf16v2 v = __builtin_convertvector((f32x2){lo, hi}, bf16v2); return __builtin_bit_cast(unsigned, v); }
__device__ __forceinline__ bf16_t f2bf(float x) { const __bf16 b = (__bf16)x; return __builtin_bit_cast(bf16_t, b); }
__device__ __forceinline__ float bf2f(bf16_t x) { return __uint_as_float((unsigned)x << 16); }
template <int KS> __device__ __forceinline__ void mma32t(f32x16& acc, const LAS unsigned char* A, int lda, const LAS unsigned char* B, int ldb, int r32, int h) {
    bf16x8 a[KS], b[KS];
#pragma unroll
    for (int s = 0; s < KS; ++s) { a[s] = *(const LAS bf16x8*)(A + r32 * lda + s * 32 + h * 16); b[s] = *(const LAS bf16x8*)(B + r32 * ldb + s * 32 + h * 16); }
#pragma unroll
    for (int s = 0; s < KS; ++s) acc = __builtin_amdgcn_mfma_f32_32x32x16_bf16(a[s], b[s], acc, 0, 0, 0);
}
__device__ __forceinline__ void mma32(f32x16& acc, const LAS unsigned char* A, int lda, const LAS unsigned char* B, int ldb, int ksteps, int r32, int h) {
    if (ksteps == 4) mma32t<4>(acc, A, lda, B, ldb, r32, h); else mma32t<2>(acc, A, lda, B, ldb, r32, h);
}
__device__ __forceinline__ void st_bf(const f32x16& acc, LAS unsigned char* dst, int sr, int sc, int r32, int h) {
#pragma unroll
    for (int r = 0; r < 16; ++r) *(LAS bf16_t*)(dst + rho(r, h) * sr + r32 * sc) = f2bf(acc[r]);
}
template <bool PERM> __device__ __forceinline__ void st_bf_T(const f32x16& acc, LAS unsigned char* dst, int sc, int r32, int h) {
#pragma unroll
    for (int m = 0; m < 4; ++m) { const int row0 = 8 * m + 4 * h, pos = PERM ? perm16(row0) : row0; u32x2 w; w.x = cvt_pk_bf16_c(acc[4 * m], acc[4 * m + 1]); w.y = cvt_pk_bf16_c(acc[4 * m + 2], acc[4 * m + 3]);
        *(LAS u32x2*)(dst + r32 * sc + pos * 2) = w; }
}
}
#define CS_BAR() do { asm volatile("s_waitcnt lgkmcnt(0)" ::: "memory"); __builtin_amdgcn_s_barrier(); asm volatile("" ::: "memory"); } while (0)
__device__ __forceinline__ void scan_chunked(const Args& a, int jl, const bf16_t* Vsrc, const bool vres, LAS unsigned char* lds, int G, int c) {
    using namespace cs;
    const int tid0 = ltid(), wave = __builtin_amdgcn_readfirstlane(tid0 >> 6);
    typedef const __attribute__((address_space(1))) bf16_t* gcp; typedef __attribute__((address_space(1))) bf16_t* gwp;
    gcp RR = (gcp)(a.ws + WS_ARENA + A_RR); gcp RK = (gcp)(a.ws + WS_ARENA + A_RK);
    gcp VFp = (gcp)(a.ws + WS_VF); gcp VLp = (gcp)(a.ws + WS_ARENA + A_VL); gcp Vg = (gcp)Vsrc;
    int mt0 = 0;
    for (int chain = c; chain < 256; chain += G) {
        const int b = chain >> 5, hd = (chain >> 1) & 15, dir = chain & 1;
        gcp WL = (gcp)(a.ws + WS_ARENA + (dir ? A_WL1 : A_WL0)); gcp AL = (gcp)(a.ws + WS_ARENA + (dir ? A_AL1 : A_AL0));
        gwp Y = (gwp)(a.ws + WS_ARENA + (dir ? A_YCR : A_YCF));
        const int gcol0 = hd * 64 + (tid0 & 63);
        const float kkp = a.in[I_KK][(size_t)jl * D + gcol0], kap = a.in[I_KA][(size_t)jl * D + gcol0], v0p = vres ? a.in[I_V0][gcol0] : 0.f;
        f32x16 S0 = {}, S1 = {};
        f32x4 wreg[8];
        constexpr int ntok = 4; const int tok0 = 4 * wave;
        bf16_t rk_[4], rr_[4], ra_[4], rv_[4], re_[4], rf_[4], rl_[4];
        bf16_t qk_[4], qr_[4], qa_[4], qv_[4], qe_[4], qf_[4], ql_[4];
#define CS_LOAD(q) do { _Pragma("unroll") for (int tk_ = 0; tk_ < 4; ++tk_) { const unsigned off_ = (unsigned)scan::step_row(b, dir, (q) * 32 + tok0 + tk_) * 1024u + (unsigned)gcol; \
                qk_[tk_] = RK[off_]; qr_[tk_] = RR[off_]; qa_[tk_] = AL[off_]; qe_[tk_] = WL[off_]; qv_[tk_] = Vg[off_]; if (vres) { qf_[tk_] = VFp[off_]; ql_[tk_] = VLp[off_]; } } } while (0)
#define CS_COPY() do { _Pragma("unroll") for (int tk_ = 0; tk_ < 4; ++tk_) { rk_[tk_] = qk_[tk_]; rr_[tk_] = qr_[tk_]; ra_[tk_] = qa_[tk_]; re_[tk_] = qe_[tk_]; rv_[tk_] = qv_[tk_]; rf_[tk_] = qf_[tk_]; rl_[tk_] = ql_[tk_]; } } while (0)
#define CS_ESUM() do { float es_ = 0.f; _Pragma("unroll") for (int tk_ = 0; tk_ < 4; ++tk_) es_ += bf2f(re_[tk_]); *(LAS float*)(lds + OFF_ES + wave * 256 + lane * 4) = es_; } while (0)
#define CS_MAIN(q) do { \
            LAS unsigned char* X_ = lds + OFF_X + ((q) & 1) * X_B; LAS unsigned char* Yb_ = lds + OFF_Y + ((q) & 1) * Y_B; \
            float before_ = 0.f, tot_ = 0.f; \
            _Pragma("unroll") for (int w_ = 0; w_ < 8; ++w_) { const float es_ = *(const LAS float*)(lds + OFF_ES + w_ * 256 + lane * 4); before_ += (w_ < wave) ? es_ : 0.f; tot_ += es_; } \
            float erun_ = __expf(-before_); const float gct_ = __expf(-tot_); \
            _Pragma("unroll") for (int p_ = 0; p_ < 2; ++p_) { const int t_ = tok0 + 2 * p_;            \
                const f32x2 kraw_ = {bf2f(rk_[2 * p_]), bf2f(rk_[2 * p_ + 1])}, rr2_ = {bf2f(rr_[2 * p_]), bf2f(rr_[2 * p_ + 1])}, ad_ = {bf2f(ra_[2 * p_]), bf2f(ra_[2 * p_ + 1])}; \
                f32x2 vv_ = {bf2f(rv_[2 * p_]), bf2f(rv_[2 * p_ + 1])}; \
                if (vres) { const f32x2 vf_ = {bf2f(rf_[2 * p_]), bf2f(rf_[2 * p_ + 1])}; const float s0_ = sigmoidf_(v0p + bf2f(rl_[2 * p_])), s1_ = sigmoidf_(v0p + bf2f(rl_[2 * p_ + 1])); \
                    vv_ = vv_ + (vf_ - vv_) * (f32x2){s0_, s1_}; } \
                const f32x2 kd_ = kraw_ * ((ad_ - 1.0f) * kap + 1.0f), kkr_ = kraw_ * kkp, sq_ = kkr_ * kkr_; \
                float s0 = sq_.x, s1 = sq_.y; \
                s0 += dpp_f<0xB1>(s0); s1 += dpp_f<0xB1>(s1); s0 += dpp_f<0x4E>(s0); s1 += dpp_f<0x4E>(s1); s0 += dpp_f<0x141>(s0); s1 += dpp_f<0x141>(s1); s0 += dpp_f<0x140>(s0); s1 += dpp_f<0x140>(s1); \
                const int i0_ = __float_as_int(s0), i1_ = __float_as_int(s1); \
                const float ss0_ = (__int_as_float(__builtin_amdgcn_readlane(i0_, 0)) + __int_as_float(__builtin_amdgcn_readlane(i0_, 16))) + (__int_as_float(__builtin_amdgcn_readlane(i0_, 32)) + __int_as_float(__builtin_amdgcn_readlane(i0_, 48))); \
                const float ss1_ = (__int_as_float(__builtin_amdgcn_readlane(i1_, 0)) + __int_as_float(__builtin_amdgcn_readlane(i1_, 16))) + (__int_as_float(__builtin_amdgcn_readlane(i1_, 32)) + __int_as_float(__builtin_amdgcn_readlane(i1_, 48))); \
                const f32x2 kk_ = kkr_ * (f32x2){__builtin_amdgcn_rsqf(fmaxf(ss0_, 1e-24f)), __builtin_amdgcn_rsqf(fmaxf(ss1_, 1e-24f))}; \
                const float w0_ = __expf(-bf2f(re_[2 * p_])), w1_ = __expf(-bf2f(re_[2 * p_ + 1])); \
                f32x2 E1_, E2_; E1_.x = erun_; E2_.x = erun_ * w0_; E1_.y = E2_.x; E2_.y = E2_.x * w1_; erun_ = E2_.y; \
                const f32x2 Ei_ = {__builtin_amdgcn_rcpf(E2_.x), __builtin_amdgcn_rcpf(E2_.y)}, E3_ = Ei_ * gct_, bv_ = kk_ * ad_; \
                const f32x2 at2_ = -(kk_ * E1_), rt2_ = rr2_ * E2_, bh2_ = bv_ * Ei_, kh2_ = kd_ * Ei_, kb2_ = kd_ * E3_, bb2_ = bv_ * E3_; \
                const unsigned pa_ = cvt_pk_bf16_c(at2_.x, at2_.y), pr_ = cvt_pk_bf16_c(rt2_.x, rt2_.y), pbh_ = cvt_pk_bf16_c(bh2_.x, bh2_.y), pkh_ = cvt_pk_bf16_c(kh2_.x, kh2_.y); \
                *(LAS unsigned*)(X_ + X_ACM + lane * CMB + t_ * 2) = pa_; *(LAS unsigned*)(X_ + X_RCM + lane * CMB + t_ * 2) = pr_; \
                *(LAS unsigned*)(X_ + X_KBCM + lane * CMB + t_ * 2) = cvt_pk_bf16_c(kb2_.x, kb2_.y); *(LAS unsigned*)(X_ + X_BBCM + lane * CMB + t_ * 2) = cvt_pk_bf16_c(bb2_.x, bb2_.y); \
                *(LAS unsigned*)(Yb_ + Y_VCM + lane * CMB + t_ * 2) = cvt_pk_bf16_c(vv_.x, vv_.y); \
                *(LAS bf16_t*)(X_ + X_ATM + t_ * TMB + lane * 2) = (bf16_t)pa_; *(LAS bf16_t*)(X_ + X_ATM + (t_ + 1) * TMB + lane * 2) = (bf16_t)(pa_ >> 16); \
                *(LAS bf16_t*)(X_ + X_RTM + t_ * TMB + lane * 2) = (bf16_t)pr_; *(LAS bf16_t*)(X_ + X_RTM + (t_ + 1) * TMB + lane * 2) = (bf16_t)(pr_ >> 16); \
                *(LAS bf16_t*)(X_ + X_BHTM + t_ * TMB + lane * 2) = (bf16_t)pbh_; *(LAS bf16_t*)(X_ + X_BHTM + (t_ + 1) * TMB + lane * 2) = (bf16_t)(pbh_ >> 16); \
                *(LAS bf16_t*)(X_ + X_KHTM + t_ * TMB + lane * 2) = (bf16_t)pkh_; *(LAS bf16_t*)(X_ + X_KHTM + (t_ + 1) * TMB + lane * 2) = (bf16_t)(pkh_ >> 16); } \
            if (wave == 7) *(LAS float*)(Yb_ + Y_GC + lane * 4) = gct_; } while (0)
        { const int tid = ltid(), lane = tid & 63, gcol = hd * 64 + lane;
          { CS_LOAD(0); CS_COPY(); CS_ESUM(); }
          CS_BAR();
          { CS_LOAD(1); CS_MAIN(0); } }
        CS_BAR();
        for (int it = -1; it < NCK; ++it) {
            const bool have_next = (it + 1 < NCK);
            const int tid = ltid(), lane = tid & 63, r32 = lane & 31, h = lane >> 5, gcol = hd * 64 + lane;
            LAS unsigned char* X = lds + OFF_X + ((it + 1) & 1) * X_B; LAS unsigned char* M = lds + OFF_MID; LAS unsigned char* O = lds + OFF_OUT;
            f32x16 acc = {}, accT = {};
            if (have_next && wave < 4) {
                if (wave == 0) {
                    bf16x8 fb[4], fa[4];
#pragma unroll
                    for (int s4 = 0; s4 < 4; ++s4) { fb[s4] = *(const LAS bf16x8*)(X + X_BHTM + r32 * TMB + s4 * 32 + h * 16); fa[s4] = *(const LAS bf16x8*)(X + X_ATM + r32 * TMB + s4 * 32 + h * 16); }
#pragma unroll
                    for (int s4 = 0; s4 < 4; ++s4) { acc = __builtin_amdgcn_mfma_f32_32x32x16_bf16(fb[s4], fa[s4], acc, 0, 0, 0); accT = __builtin_amdgcn_mfma_f32_32x32x16_bf16(fa[s4], fb[s4], accT, 0, 0, 0); }
#pragma unroll
                    for (int r = 0; r < 16; ++r) accT[r] = (r32 < rho(r, h)) ? accT[r] : 0.f; }
                else if (wave == 2) mma32(acc, X + X_ATM, TMB, X + X_KHTM, TMB, 4, r32, h);
                else mma32(acc, X + ((wave & 2) ? X_KHTM : X_BHTM), TMB, X + ((wave & 1) ? X_RTM : X_ATM), TMB, 4, r32, h);
#pragma unroll
                for (int r = 0; r < 16; ++r) { const int i = rho(r, h); const bool keep = (wave == 2) ? (r32 < i) : ((wave & 1) ? (i <= r32) : (i < r32)); acc[r] = keep ? acc[r] : 0.f; }
                if (wave == 0) { }
                else if (wave == 1) st_bf_T<false>(acc, M + M_ARBT, CMB, r32, h);
                else if (wave == 2) st_bf_T<false>(acc, M + M_AAK, CMB, r32, h);
                else {
#pragma unroll
                    for (int m = 0; m < 4; ++m) *(LAS f32x4*)(M + M_ARK + r32 * 128 + (8 * m + 4 * h) * 4) = (f32x4){acc[4 * m], acc[4 * m + 1], acc[4 * m + 2], acc[4 * m + 3]}; }
            }
            if (CS_SERIAL) CS_BAR();
            if (it >= 0 && wave >= 6) {
                const int vb = wave - 6; const LAS unsigned char* Yb = lds + OFF_Y + (it & 1) * Y_B;
                bf16x8 bs[4];
#pragma unroll
                for (int s = 0; s < 2; ++s) { u32x4 w0, w1;
                    w0.x = cvt_pk_bf16_c(S0[8 * s + 0], S0[8 * s + 1]); w0.y = cvt_pk_bf16_c(S0[8 * s + 2], S0[8 * s + 3]); w0.z = cvt_pk_bf16_c(S0[8 * s + 4], S0[8 * s + 5]); w0.w = cvt_pk_bf16_c(S0[8 * s + 6], S0[8 * s + 7]);
                    w1.x = cvt_pk_bf16_c(S1[8 * s + 0], S1[8 * s + 1]); w1.y = cvt_pk_bf16_c(S1[8 * s + 2], S1[8 * s + 3]); w1.z = cvt_pk_bf16_c(S1[8 * s + 4], S1[8 * s + 5]); w1.w = cvt_pk_bf16_c(S1[8 * s + 6], S1[8 * s + 7]);
                    bs[s] = *reinterpret_cast<bf16x8*>(&w0); bs[2 + s] = *reinterpret_cast<bf16x8*>(&w1); }
                const LAS unsigned char* Vr = Yb + Y_VCM + (vb * 32 + r32) * CMB + h * 16;
                const bf16x8 bv0 = *(const LAS bf16x8*)Vr, bv1 = *(const LAS bf16x8*)(Vr + 32);
                bf16x8 fy[6], fs[6];
#pragma unroll
                for (int s = 0; s < 4; ++s) { fy[s] = *(const LAS bf16x8*)(O + O_PYT + r32 * TMB + s * 32 + h * 16); fs[s] = *(const LAS bf16x8*)(O + O_PST + r32 * TMB + s * 32 + h * 16); }
#pragma unroll
                for (int s = 0; s < 2; ++s) { fy[4 + s] = *(const LAS bf16x8*)(O + O_QYT + r32 * CMB + s * 32 + h * 16); fs[4 + s] = *(const LAS bf16x8*)(O + O_QST + r32 * CMB + s * 32 + h * 16); }
                f32x16 n0, n1;
#pragma unroll
                for (int m = 0; m < 4; ++m) { const f32x4 g0 = *(const LAS f32x4*)(Yb + Y_GC + (8 * m + 4 * h) * 4), g1 = *(const LAS f32x4*)(Yb + Y_GC + (32 + 8 * m + 4 * h) * 4);
#pragma unroll
                    for (int i = 0; i < 4; ++i) { n0[4 * m + i] = S0[4 * m + i] * g0[i]; n1[4 * m + i] = S1[4 * m + i] * g1[i]; } }
                f32x16 ya = {};
#pragma unroll
                for (int s = 0; s < 4; ++s) { ya = __builtin_amdgcn_mfma_f32_32x32x16_bf16(fy[s], bs[s], ya, 0, 0, 0); n0 = __builtin_amdgcn_mfma_f32_32x32x16_bf16(fs[s], bs[s], n0, 0, 0, 0); }
                ya = __builtin_amdgcn_mfma_f32_32x32x16_bf16(fy[4], bv0, ya, 0, 0, 0); n0 = __builtin_amdgcn_mfma_f32_32x32x16_bf16(fs[4], bv0, n0, 0, 0, 0);
                ya = __builtin_amdgcn_mfma_f32_32x32x16_bf16(fy[5], bv1, ya, 0, 0, 0); n0 = __builtin_amdgcn_mfma_f32_32x32x16_bf16(fs[5], bv1, n0, 0, 0, 0);
#pragma unroll
                for (int s = 0; s < 4; ++s) fs[s] = *(const LAS bf16x8*)(O + O_PST + (32 + r32) * TMB + s * 32 + h * 16);
#pragma unroll
                for (int s = 0; s < 2; ++s) fs[4 + s] = *(const LAS bf16x8*)(O + O_QST + (32 + r32) * CMB + s * 32 + h * 16);
#pragma unroll
                for (int r = 0; r < 16; ++r) *(LAS float*)(lds + OFF_YB + rho(r, h) * 256 + (vb * 32 + r32) * 4) = ya[r];
#pragma unroll
                for (int s = 0; s < 4; ++s) n1 = __builtin_amdgcn_mfma_f32_32x32x16_bf16(fs[s], bs[s], n1, 0, 0, 0);
                n1 = __builtin_amdgcn_mfma_f32_32x32x16_bf16(fs[4], bv0, n1, 0, 0, 0); n1 = __builtin_amdgcn_mfma_f32_32x32x16_bf16(fs[5], bv1, n1, 0, 0, 0);
                S0 = n0; S1 = n1;
            }
            if (it + 2 < NCK) { CS_COPY(); CS_ESUM(); }
            if (wave == 4 || wave == 5) {
                const int pt = tid - 256; scan::MTile m;
                if (it >= 0 && it <= NCK - 2 && moe_tile(a, jl, c + (mt0 + it) * G, m)) {
                    const LAS float* tl_ = (const LAS float*)(lds + OFF_WT); const int sn = pt >> 1, sk = (pt & 1) * 32;
                    const int n = m.n0 + sn, dr = m.grpd ? ((n >> 7) * 256 + (n & 127)) : n; bf16_t* dp = m.dst + (size_t)dr * m.ldd + m.k0 + sk;
#pragma unroll
                    for (int q8 = 0; q8 < 4; ++q8) { float f[8];
#pragma unroll
                        for (int e = 0; e < 8; ++e) f[e] = tl_[(sk + q8 * 8 + e) * 65 + sn];
                        *(__attribute__((address_space(1))) u32x4*)(dp + q8 * 8) = pack8(f); } }
                if (it + 1 < NCK - 1 && moe_tile(a, jl, c + (mt0 + it + 1) * G, m)) { const int kl = pt >> 4, nq = (pt & 15) * 4;
#pragma unroll
                    for (int p8 = 0; p8 < 8; ++p8) wreg[p8] = *(const __attribute__((address_space(1))) f32x4*)(m.src + (size_t)(m.k0 + kl + 8 * p8) * m.sld + m.n0 + nq); }
            }
            CS_BAR();
            if (have_next && wave == 0) {
                f32x16 Tm = acc, Mm = acc, Mt = accT;
#pragma unroll
                for (int r = 0; r < 16; ++r) Tm[r] += (rho(r, h) == r32) ? 1.0f : 0.f;
#define CS_SLAB(tile, s) ({ u32x4 w_; w_.x = cvt_pk_bf16_c(tile[8 * (s) + 0], tile[8 * (s) + 1]); w_.y = cvt_pk_bf16_c(tile[8 * (s) + 2], tile[8 * (s) + 3]); \
                    w_.z = cvt_pk_bf16_c(tile[8 * (s) + 4], tile[8 * (s) + 5]); w_.w = cvt_pk_bf16_c(tile[8 * (s) + 6], tile[8 * (s) + 7]); *reinterpret_cast<bf16x8*>(&w_); })
                for (int lvl = 0; lvl < 4; ++lvl) {
                    const bf16x8 m0 = CS_SLAB(Mm, 0), m1 = CS_SLAB(Mm, 1), t0_ = CS_SLAB(Mt, 0), t1_ = CS_SLAB(Mt, 1);
                    f32x16 m2 = {}, m2t = {};
                    m2 = __builtin_amdgcn_mfma_f32_32x32x16_bf16(t0_, m0, m2, 0, 0, 0); m2t = __builtin_amdgcn_mfma_f32_32x32x16_bf16(m0, t0_, m2t, 0, 0, 0);
                    m2 = __builtin_amdgcn_mfma_f32_32x32x16_bf16(t1_, m1, m2, 0, 0, 0); m2t = __builtin_amdgcn_mfma_f32_32x32x16_bf16(m1, t1_, m2t, 0, 0, 0);
                    Mm = m2; Mt = m2t;
                    { const bf16x8 a0 = CS_SLAB(Mt, 0), a1 = CS_SLAB(Mt, 1), bt0 = CS_SLAB(Tm, 0), bt1 = CS_SLAB(Tm, 1);
                      Tm = __builtin_amdgcn_mfma_f32_32x32x16_bf16(a0, bt0, Tm, 0, 0, 0); Tm = __builtin_amdgcn_mfma_f32_32x32x16_bf16(a1, bt1, Tm, 0, 0, 0); }
                }
                st_bf_T<false>(Tm, M + M_TT, CMB, r32, h);
            }
            if (CS_SERIAL) CS_BAR();
            if (it + 3 < NCK) CS_LOAD(it + 3);
            if (it + 2 < NCK) CS_MAIN(it + 2);
            if (CS_SERIAL) CS_BAR();
            if (it >= 0 && wave >= 5) {
                for (int item = tid - 320; item < 256; item += 192) { const int t = item >> 3, seg = item & 7;
                    const LAS f32x4* yp = (const LAS f32x4*)(lds + OFF_YB + t * 256 + seg * 32); const f32x4 y0 = yp[0], y1 = yp[1];
                    u32x4 w; w.x = cvt_pk_bf16(y0[0], y0[1]); w.y = cvt_pk_bf16(y0[2], y0[3]); w.z = cvt_pk_bf16(y1[0], y1[1]); w.w = cvt_pk_bf16(y1[2], y1[3]);
                    *(__attribute__((address_space(1))) u32x4*)(Y + (size_t)scan::step_row(b, dir, it * 32 + t) * 1024 + hd * 64 + seg * 8) = w; }
            }
            CS_BAR();
            if (have_next && wave < 3) {
                f32x16 d = {};
                if (wave < 2) { mma32(d, M + M_TT, CMB, X + X_ACM + wave * 32 * CMB, CMB, 2, r32, h); st_bf_T<false>(d, M + M_W + wave * 32 * CMB, CMB, r32, h); }
                else { mma32(d, M + M_TT, CMB, M + M_AAK, CMB, 2, r32, h); st_bf_T<false>(d, M + M_UP, CMB, r32, h); }
            }
            if (wave == 4 || wave == 5) { const int pt = tid - 256, kl = pt >> 4, nq = (pt & 15) * 4; scan::MTile m;
                if (it + 1 < NCK - 1 && moe_tile(a, jl, c + (mt0 + it + 1) * G, m)) { LAS float* tl_ = (LAS float*)(lds + OFF_WT);
#pragma unroll
                    for (int p8 = 0; p8 < 8; ++p8) { LAS float* tp = tl_ + (kl + 8 * p8) * 65 + nq; tp[0] = wreg[p8][0]; tp[1] = wreg[p8][1]; tp[2] = wreg[p8][2]; tp[3] = wreg[p8][3]; } } }
            CS_BAR();
            if (have_next) {
                f32x16 d = {};
                if (wave < 4) { const int kt = wave & 1, kpt = wave >> 1;
                    mma32(d, M + M_W + kt * 32 * CMB, CMB, X + X_BBCM + kpt * 32 * CMB, CMB, 2, r32, h);
                    st_bf_T<true>(d, O + O_PST + kpt * 32 * TMB + kt * 64, TMB, r32, h); }
                else if (wave < 6) { const int kt = wave - 4;
                    u32x2 ra[4];
#pragma unroll
                    for (int m = 0; m < 4; ++m) ra[m] = *(const LAS u32x2*)(X + X_RTM + r32 * TMB + (kt * 32 + 8 * m + 4 * h) * 2);
                    mma32(d, M + M_W + kt * 32 * CMB, CMB, M + M_ARBT, CMB, 2, r32, h);
#pragma unroll
                    for (int m = 0; m < 4; ++m) { d[4 * m] += bflo(ra[m].x); d[4 * m + 1] += bfhi(ra[m].x); d[4 * m + 2] += bflo(ra[m].y); d[4 * m + 3] += bfhi(ra[m].y); }
                    st_bf_T<true>(d, O + O_PYT + kt * 64, TMB, r32, h); }
                else { const int kpt = wave - 6;
                    u32x2 ka[4];
#pragma unroll
                    for (int m = 0; m < 4; ++m) ka[m] = *(const LAS u32x2*)(X + X_KBCM + (kpt * 32 + r32) * CMB + (8 * m + 4 * h) * 2);
                    mma32(d, M + M_UP, CMB, X + X_BBCM + kpt * 32 * CMB, CMB, 2, r32, h);
#pragma unroll
                    for (int m = 0; m < 4; ++m) { d[4 * m] += bflo(ka[m].x); d[4 * m + 1] += bfhi(ka[m].x); d[4 * m + 2] += bflo(ka[m].y); d[4 * m + 3] += bfhi(ka[m].y); }
                    st_bf_T<false>(d, O + O_QST + kpt * 32 * CMB, CMB, r32, h);
                    if (wave == 7) { f32x16 e = {}; f32x4 aa[4];
#pragma unroll
                        for (int m = 0; m < 4; ++m) aa[m] = *(const LAS f32x4*)(M + M_ARK + r32 * 128 + (8 * m + 4 * h) * 4);
                        mma32(e, M + M_UP, CMB, M + M_ARBT, CMB, 2, r32, h);
#pragma unroll
                        for (int m = 0; m < 4; ++m) { e[4 * m] += aa[m][0]; e[4 * m + 1] += aa[m][1]; e[4 * m + 2] += aa[m][2]; e[4 * m + 3] += aa[m][3]; }
                        st_bf_T<false>(e, O + O_QYT, CMB, r32, h); } }
            }
            CS_BAR();
        }
#undef CS_LOAD
#undef CS_COPY
#undef CS_ESUM
#undef CS_MAIN
        mt0 += NCK - 1;
    }
}


__device__ __forceinline__ void scan_compare(const Args& a, LAS unsigned char* lds, int G, int c) {
    const int tid = ltid();
    asm volatile("s_waitcnt vmcnt(0)" ::: "memory"); __syncthreads();
    for (int chain = c; chain < 256; chain += G) {
        const int b = chain >> 5, hd = (chain >> 1) & 15, dir = chain & 1;
        const bf16_t* Yo = (const bf16_t*)(a.ws + WS_ARENA + (dir ? A_YR : A_YF)); const bf16_t* Yc = (const bf16_t*)(a.ws + WS_ARENA + (dir ? A_YCR : A_YCF));
        float md = 0.f, mo = 0.f;
        for (int i = tid; i < SEG * 8; i += NTHR) { const int r = i >> 3, seg = i & 7; const size_t off = (size_t)(b * SEG + r) * 1024 + hd * 64 + seg * 8;
            u32x4 wo, wc; const unsigned* po = (const unsigned*)(Yo + off); const unsigned* pc = (const unsigned*)(Yc + off);
#pragma unroll
            for (int q = 0; q < 4; ++q) { wo[q] = __hip_atomic_load(po + q, __ATOMIC_RELAXED, __HIP_MEMORY_SCOPE_AGENT); wc[q] = __hip_atomic_load(pc + q, __ATOMIC_RELAXED, __HIP_MEMORY_SCOPE_AGENT); }
            float yo[8], yc[8]; unpack8(wo, yo); unpack8(wc, yc);
#pragma unroll
            for (int e = 0; e < 8; ++e) { md = fmaxf(md, fabsf(yo[e] - yc[e])); mo = fmaxf(mo, fabsf(yo[e])); } }
#pragma unroll
        for (int o = 32; o >= 1; o >>= 1) { md = fmaxf(md, __shfl_xor(md, o)); mo = fmaxf(mo, __shfl_xor(mo, o)); }
        LAS float* red = (LAS float*)lds;
        if ((tid & 63) == 0) { red[(tid >> 6) * 2] = md; red[(tid >> 6) * 2 + 1] = mo; }
        __syncthreads();
        if (tid == 0) { float d = 0.f, o = 0.f; for (int w = 0; w < 8; ++w) { d = fmaxf(d, red[w * 2]); o = fmaxf(o, red[w * 2 + 1]); }
            if (!(d <= CS_TOL * o)) { bf16_t* Yw = (bf16_t*)(a.ws + WS_ARENA + (dir ? A_YR : A_YF)); Yw[(size_t)(b * SEG + CTX) * 1024 + hd * 64] = (bf16_t)0x7fc0u; } }
        __syncthreads();
    }
}

__device__ __forceinline__ void rwkv_outprep(const Args& a, int j, const bf16_t* Vsrc, const bool vres, int G, int c) {
    const int lane = ltid() & 63; int r0, r1; wave_rows(G, c, r0, r1);
    const bf16_t* YF = (const bf16_t*)(a.ws + WS_ARENA + A_YF); const bf16_t* YR = (const bf16_t*)(a.ws + WS_ARENA + A_YR);
    const bf16_t* RR = (const bf16_t*)(a.ws + WS_ARENA + A_RR); const bf16_t* RK = (const bf16_t*)(a.ws + WS_ARENA + A_RK);
    const bf16_t* AL0 = (const bf16_t*)(a.ws + WS_ARENA + A_AL0); const bf16_t* AL1 = (const bf16_t*)(a.ws + WS_ARENA + A_AL1); const bf16_t* GG = (const bf16_t*)(a.ws + WS_ARENA + A_G);
    bf16_t* O = (bf16_t*)(a.ws + WS_ARENA + A_RO);
    float lnw[16], lnb[16], rk[16], ka[16];
#pragma unroll
    for (int jj = 0; jj < 2; ++jj)
#pragma unroll
        for (int e = 0; e < 8; ++e) { const int col = jj * 512 + lane * 8 + e, i = jj * 8 + e; lnw[i] = a.in[I_LNW][j * D + col]; lnb[i] = a.in[I_LNB][j * D + col]; rk[i] = a.in[I_RK][j * D + col];
            ka[i] = a.in[I_KA][j * D + col]; }
    for (int row = r0; row < r1; ++row) {
        u32x4 out[2];
#pragma unroll
        for (int jj = 0; jj < 2; ++jj) { const size_t off = (size_t)row * 1024 + jj * 512 + lane * 8;
            float yf[8], yr[8], r[8], k[8], v[8], l0[8], l1[8], g[8], y[8];
            unpack8(*(const u32x4*)(YF + off), yf); unpack8(*(const u32x4*)(YR + off), yr); unpack8(*(const u32x4*)(RR + off), r); unpack8(*(const u32x4*)(RK + off), k);
            unpack8(*(const u32x4*)(Vsrc + off), v);
            if (vres) { float vf[8], vl[8]; unpack8(*(const u32x4*)((const bf16_t*)(a.ws + WS_VF) + off), vf); unpack8(*(const u32x4*)((const bf16_t*)(a.ws + WS_ARENA + A_VL) + off), vl);
#pragma unroll
                for (int e = 0; e < 8; ++e) v[e] = v[e] + (vf[e] - v[e]) * sigmoidf_(a.in[I_V0][jj * 512 + lane * 8 + e] + vl[e]); }
            unpack8(*(const u32x4*)(AL0 + off), l0); unpack8(*(const u32x4*)(AL1 + off), l1); unpack8(*(const u32x4*)(GG + off), g);
            float sm = 0.f, dot = 0.f;
#pragma unroll
            for (int e = 0; e < 8; ++e) { const int i = jj * 8 + e; y[e] = yf[e] + yr[e]; sm += y[e];
                const float adm = 0.5f * (l0[e] + l1[e]); const float kb = k[e] * (1.0f + (adm - 1.0f) * ka[i]); dot += r[e] * kb * rk[i]; }
            sm = red8(sm); dot = red8(dot); const float mu = sm * (1.0f / 64.0f); float var = 0.f;
#pragma unroll
            for (int e = 0; e < 8; ++e) { const float d = y[e] - mu; var += d * d; }
            var = red8(var) * (1.0f / 64.0f); const float rstd = 1.0f / sqrtf(var + LNX_EPS);
            float o[8];
#pragma unroll
            for (int e = 0; e < 8; ++e) { const int i = jj * 8 + e; o[e] = ((y[e] - mu) * rstd * lnw[i] + lnb[i] + dot * v[e]) * g[e]; }
            out[jj] = pack8(o); }
        *(u32x4*)(O + (size_t)row * 1024 + lane * 8) = out[0]; *(u32x4*)(O + (size_t)row * 1024 + 512 + lane * 8) = out[1];
    }
}

__device__ __forceinline__ void moe_gather(const Args& a, LAS unsigned char* lds, int G, int c) {
    const int tid = ltid(), wave = tid >> 6, lane = tid & 63; int r0, r1; wave_rows(G, c, r0, r1);
    LAS int* cnt = (LAS int*)lds;
    if (tid < 16) cnt[tid] = 0;
    __syncthreads();
    const int* hist = (const int*)(a.ws + WS_HIST); const int nchunk = G * NWAVE, first = c * NWAVE;
    int pre[8], tot[8];
#pragma unroll
    for (int e = 0; e < 8; ++e) { pre[e] = 0; tot[e] = 0; }
    for (int ch = tid; ch < nchunk; ch += NTHR) { const u32x4 h0 = *(const u32x4*)(hist + (size_t)ch * 8), h1 = *(const u32x4*)(hist + (size_t)ch * 8 + 4); const int m = ch < first ? 1 : 0;
        tot[0] += h0[0]; tot[1] += h0[1]; tot[2] += h0[2]; tot[3] += h0[3]; tot[4] += h1[0]; tot[5] += h1[1]; tot[6] += h1[2]; tot[7] += h1[3];
        pre[0] += m * h0[0]; pre[1] += m * h0[1]; pre[2] += m * h0[2]; pre[3] += m * h0[3]; pre[4] += m * h1[0]; pre[5] += m * h1[1]; pre[6] += m * h1[2]; pre[7] += m * h1[3]; }
#pragma unroll
    for (int e = 0; e < 8; ++e) { int p = pre[e], t = tot[e];
#pragma unroll
        for (int o = 32; o >= 1; o >>= 1) { p += __shfl_xor(p, o); t += __shfl_xor(t, o); }
        if (lane == 0) { __hip_atomic_fetch_add(&cnt[e], p, __ATOMIC_RELAXED, __HIP_MEMORY_SCOPE_WORKGROUP); __hip_atomic_fetch_add(&cnt[8 + e], t, __ATOMIC_RELAXED, __HIP_MEMORY_SCOPE_WORKGROUP); } }
    __syncthreads();
    int base[9], run[8]; base[0] = 0;
#pragma unroll
    for (int e = 0; e < 8; ++e) base[e + 1] = base[e] + ((cnt[8 + e] + 255) & ~255);
    if (c == 0 && tid < 9) { int v = 0;
#pragma unroll
        for (int e = 0; e < 9; ++e) v = (tid == e) ? base[e] : v;
        ((int*)(a.ws + WS_META))[tid] = v; }
#pragma unroll
    for (int e = 0; e < 8; ++e) { int p = cnt[e];
        for (int w = 0; w < wave; ++w) p += hist[(size_t)(first + w) * 8 + e];
        run[e] = base[e] + p; }
    const bf16_t* H = (const bf16_t*)(a.ws + WS_ARENA + A_H); bf16_t* HS = (bf16_t*)(a.ws + WS_ARENA + A_HS);
    for (int row = r0; row < r1; ++row) {
        const u32x4 rt = *(const u32x4*)(a.ws + WS_ROUTE + (size_t)row * 16); const int e0 = (int)rt[0], e1 = (int)rt[1];
        if (e0 < 0) continue;
        int s0 = 0, s1 = 0;
#pragma unroll
        for (int e = 0; e < 8; ++e) { if (e == e0) { s0 = run[e]; run[e] += 1; } if (e == e1) { s1 = run[e]; run[e] += 1; } }
        const u32x4 h0 = *(const u32x4*)(H + (size_t)row * 1024 + lane * 8), h1 = *(const u32x4*)(H + (size_t)row * 1024 + 512 + lane * 8);
        *(u32x4*)(HS + (size_t)s0 * 1024 + lane * 8) = h0; *(u32x4*)(HS + (size_t)s0 * 1024 + 512 + lane * 8) = h1;
        *(u32x4*)(HS + (size_t)s1 * 1024 + lane * 8) = h0; *(u32x4*)(HS + (size_t)s1 * 1024 + 512 + lane * 8) = h1;
        if (lane == 0) { int* sl = (int*)(a.ws + WS_RSLOT) + (size_t)row * 2; sl[0] = s0; sl[1] = s1; }
    }
}
__device__ __forceinline__ void final_combine(const Args& a, int layer, int G, int c) {
    const int lane = ltid() & 63; int r0, r1; wave_rows(G, c, r0, r1);
    for (int row = r0; row < r1; ++row) { if (row % SEG < CTX) continue;
        float* xp = xrow(a, row); float x[16]; load_x16(xp, lane, x); moe_combine16(a, row, layer, lane, x); store_x16(xp, lane, x); }
}

constexpr int NPH = 42;
#define CT(k) (((PSEL) >> (k)) & 1u)
#ifndef PROBE_MASK
#define PROBE_MASK 0u
#endif
#define REPS(k) for (int rep_ = 0; rep_ <= (int)(((PROBE_MASK) >> (k)) & 1u); ++rep_)
constexpr int LDS_ST_OFF = 161792;
constexpr int LDS_BYTES = LDS_ST_OFF + 64;
constexpr int TILE_OFF = 73728;
#define WSP(off) (a.ws + WS_ARENA + (off))
template <unsigned PSEL>
__global__ void __launch_bounds__(NTHR, 2) fwd(Args ka) {
    extern __shared__ __attribute__((aligned(16))) unsigned char lds_raw[];
    LAS unsigned char* lds = (LAS unsigned char*)lds_raw;
    const int Gk = gridDim.x, ck = blockIdx.x, tid = ltid();
    volatile LAS unsigned* st = (volatile LAS unsigned*)(lds + LDS_ST_OFF);
    if (tid < 4) st[tid] = 0u;
    __syncthreads();
    XcdBarrier bar; bar.bar = (unsigned*)(ka.ws + WS_CTL); bar.x = 0; bar.st = st;
    if (ka.ph_hi - ka.ph_lo > 1) bar = xcd_barrier_post((unsigned*)(ka.ws + WS_CTL), st);
#define IN(p) (ka.ph_lo <= (p) && (p) < ka.ph_hi)
#define PHB const Args a = launder_args(ka); const int G = launder_s(Gk), c = launder_s(ck); (void)G; (void)c;
#define SEAM(p) do { if (IN(p) && IN((p) + 1)) xcd_barrier(bar); } while (0)
    const size_t P1K = (size_t)256 * 1024 * 2;

    { const int jj_ = 0; const bool last_ = false;
    if (CT(20) && IN(0)) REPS(20) { PHB const bf16_t* wm = wmla(a, jj_); const bf16_t* wr_ = wrwkv(a, jj_); const bf16_t* wf = wffn(a, jj_); bf16_t* Vb = last_ ? (bf16_t*)WSP(A_RV) : (bf16_t*)(a.ws + WS_VF); (void)wm; (void)wr_; (void)wf; (void)Vb;
            { prologue_misc(a, lds, G, c); run_prep(a, lds + TILE_OFF, -1, 0, G, c); } }
    }
    SEAM(0);

    for (int jj = 0; jj < 2; ++jj) {
        const int pb = 1 + jj * 20, lm = 2 * jj, lr = 2 * jj + 1, jj_ = jj; const bool last = (jj == 1), last_ = last;

        if (CT(0) && IN(pb + 0)) REPS(0) { PHB const bf16_t* wm = wmla(a, jj_); const bf16_t* wr_ = wrwkv(a, jj_); const bf16_t* wf = wffn(a, jj_); bf16_t* Vb = last_ ? (bf16_t*)WSP(A_RV) : (bf16_t*)(a.ws + WS_VF); (void)wm; (void)wr_; (void)wf; (void)Vb;
            { if (jj == 0) norm_plain<false, true>(a, lm, a.in[I_N1G] + lm * D, 0, (bf16_t*)WSP(A_H), G, c); else norm_plain<true>(a, lm, a.in[I_N1G] + lm * D, 0, (bf16_t*)WSP(A_H), G, c); } }
        SEAM(pb + 0);
        if (CT(1) && IN(pb + 1)) REPS(1) { PHB const bf16_t* wm = wmla(a, jj_); const bf16_t* wr_ = wrwkv(a, jj_); const bf16_t* wf = wffn(a, jj_); bf16_t* Vb = last_ ? (bf16_t*)WSP(A_RV) : (bf16_t*)(a.ws + WS_VF); (void)wm; (void)wr_; (void)wf; (void)Vb;
            { MapSimple S{(const char*)WSP(A_H), (const char*)wm, P1K, P1K, 3, 16, 0}; EpiBf<FPlain> E{{(bf16_t*)WSP(A_QKVA), 768}};
            pg8::gemm_phase(lds, 1024, 1024, S, E, G, c); } }
        SEAM(pb + 1);
        if (CT(2) && IN(pb + 2)) REPS(2) { PHB const bf16_t* wm = wmla(a, jj_); const bf16_t* wr_ = wrwkv(a, jj_); const bf16_t* wf = wffn(a, jj_); bf16_t* Vb = last_ ? (bf16_t*)WSP(A_RV) : (bf16_t*)(a.ws + WS_VF); (void)wm; (void)wr_; (void)wf; (void)Vb;
            mla_stats(a, G, c); }
        SEAM(pb + 2);
        if (CT(3) && IN(pb + 3)) REPS(3) { PHB const bf16_t* wm = wmla(a, jj_); const bf16_t* wr_ = wrwkv(a, jj_); const bf16_t* wf = wffn(a, jj_); bf16_t* Vb = last_ ? (bf16_t*)WSP(A_RV) : (bf16_t*)(a.ws + WS_VF); (void)wm; (void)wr_; (void)wf; (void)Vb;
            { MapQKV S{(const char*)WSP(A_QKVA), (const char*)(wm + E_QKVA), (const char*)(wm + E_QKVA + E_QB)};
            EpiQKV E{(bf16_t*)WSP(A_Q), (bf16_t*)WSP(A_KV), (const float*)(a.ws + WS_RS), (const float*)(a.ws + WS_RS) + R};
            pg8::gemm_phase(lds, 768, 384, S, E, G, c); } }
        SEAM(pb + 3);
        if (CT(4) && IN(pb + 4)) REPS(4) { PHB const bf16_t* wm = wmla(a, jj_); const bf16_t* wr_ = wrwkv(a, jj_); const bf16_t* wf = wffn(a, jj_); bf16_t* Vb = last_ ? (bf16_t*)WSP(A_RV) : (bf16_t*)(a.ws + WS_VF); (void)wm; (void)wr_; (void)wf; (void)Vb;
            mla_qkpost(a, jj, G, c); }
        SEAM(pb + 4);
        if (CT(5) && IN(pb + 5)) REPS(5) { PHB const bf16_t* wm = wmla(a, jj_); const bf16_t* wr_ = wrwkv(a, jj_); const bf16_t* wf = wffn(a, jj_); bf16_t* Vb = last_ ? (bf16_t*)WSP(A_RV) : (bf16_t*)(a.ws + WS_VF); (void)wm; (void)wr_; (void)wf; (void)Vb;
            attn_phase(a, lds, G, c); }
        SEAM(pb + 5);
        if (CT(6) && IN(pb + 6)) REPS(6) { PHB const bf16_t* wm = wmla(a, jj_); const bf16_t* wr_ = wrwkv(a, jj_); const bf16_t* wf = wffn(a, jj_); bf16_t* Vb = last_ ? (bf16_t*)WSP(A_RV) : (bf16_t*)(a.ws + WS_VF); (void)wm; (void)wr_; (void)wf; (void)Vb;
            { MapSimple S{(const char*)WSP(A_O), (const char*)(wm + E_QKVA + E_QB + E_KVB), P1K, P1K, 4, 16, 0}; EpiResid E{(float*)(a.ws + WS_CS), a.out, (const float*)(a.ws + WS_MODS), lm, 2, jj == 0 ? a.in[I_CTX] : (const float*)(a.ws + WS_CS), jj == 0 ? a.in[I_X] : (const float*)a.out};
            pg8::gemm_phase(lds, 1024, 1024, S, E, G, c); } }
        SEAM(pb + 6);
        if (CT(7) && IN(pb + 7)) REPS(7) { PHB const bf16_t* wm = wmla(a, jj_); const bf16_t* wr_ = wrwkv(a, jj_); const bf16_t* wf = wffn(a, jj_); bf16_t* Vb = last_ ? (bf16_t*)WSP(A_RV) : (bf16_t*)(a.ws + WS_VF); (void)wm; (void)wr_; (void)wf; (void)Vb;
            norm_plain<false>(a, lm, a.in[I_N2G] + lm * D, 3, (bf16_t*)WSP(A_H), G, c); }
        SEAM(pb + 7);
        if (CT(8) && IN(pb + 8)) REPS(8) { PHB const bf16_t* wm = wmla(a, jj_); const bf16_t* wr_ = wrwkv(a, jj_); const bf16_t* wf = wffn(a, jj_); bf16_t* Vb = last_ ? (bf16_t*)WSP(A_RV) : (bf16_t*)(a.ws + WS_VF); (void)wm; (void)wr_; (void)wf; (void)Vb;
            { MapSimple S{(const char*)WSP(A_H), (const char*)wf, P1K, P1K, 22, 16, 0}; EpiSwiGLU E{(bf16_t*)WSP(A_FHID), DFF};
            pg8::gemm_phase(lds, 1024, 1024, S, E, G, c); } }
        SEAM(pb + 8);
        if (CT(9) && IN(pb + 9)) REPS(9) { PHB const bf16_t* wm = wmla(a, jj_); const bf16_t* wr_ = wrwkv(a, jj_); const bf16_t* wf = wffn(a, jj_); bf16_t* Vb = last_ ? (bf16_t*)WSP(A_RV) : (bf16_t*)(a.ws + WS_VF); (void)wm; (void)wr_; (void)wf; (void)Vb;
            { MapSimple S{(const char*)WSP(A_FHID), (const char*)(wf + E_F13), (size_t)256 * DFF * 2, (size_t)256 * DFF * 2, 4, 44, 0}; EpiResid E{(float*)(a.ws + WS_CS), a.out, (const float*)(a.ws + WS_MODS), lm, 5, (const float*)(a.ws + WS_CS), (const float*)a.out};
            pg8::gemm_phase(lds, DFF, DFF, S, E, G, c); } }
        SEAM(pb + 9);
        if (CT(10) && IN(pb + 10)) REPS(10) { PHB const bf16_t* wm = wmla(a, jj_); const bf16_t* wr_ = wrwkv(a, jj_); const bf16_t* wf = wffn(a, jj_); bf16_t* Vb = last_ ? (bf16_t*)WSP(A_RV) : (bf16_t*)(a.ws + WS_VF); (void)wm; (void)wr_; (void)wf; (void)Vb;
            norm_mix(a, lr, jj, G, c); }
        SEAM(pb + 10);
        if (CT(11) && IN(pb + 11)) REPS(11) { PHB const bf16_t* wm = wmla(a, jj_); const bf16_t* wr_ = wrwkv(a, jj_); const bf16_t* wf = wffn(a, jj_); bf16_t* Vb = last_ ? (bf16_t*)WSP(A_RV) : (bf16_t*)(a.ws + WS_VF); (void)wm; (void)wr_; (void)wf; (void)Vb;
            { MapRw1 S{(const char*)WSP(A_AX), (const char*)wr_, (const char*)(wr_ + E_B1), (const char*)(wr_ + E_B1 + E_B2)};
            EpiBf<FRw1> E{{(bf16_t*)WSP(A_L1), (bf16_t*)WSP(A_RR), (bf16_t*)WSP(A_RK), Vb}};
            pg8::gemm_phase(lds, 5120, 2048, S, E, G, c); } }
        SEAM(pb + 11);
        if (CT(12) && IN(pb + 12)) REPS(12) { PHB const bf16_t* wm = wmla(a, jj_); const bf16_t* wr_ = wrwkv(a, jj_); const bf16_t* wf = wffn(a, jj_); bf16_t* Vb = last_ ? (bf16_t*)WSP(A_RV) : (bf16_t*)(a.ws + WS_VF); (void)wm; (void)wr_; (void)wf; (void)Vb;
            { int nt4 = 4; asm volatile("" : "+s"(nt4));
            MapRw2 S{(const char*)WSP(A_L1), (const char*)(wr_ + E_B1 + E_B2 + E_L1), (const char*)(wr_ + E_B1 + E_B2 + E_L1 + E_L2A), 0, last ? 24 : 20, nt4};
            EpiRw2 E{(bf16_t*)WSP(A_WL0), (bf16_t*)WSP(A_VL), a.in[I_W0] + (size_t)jj * 2 * D, a.in[I_A0] + (size_t)jj * 2 * D}; pg8::gemm_phase(lds, 512, 256, S, E, G, c); } }
        SEAM(pb + 12);
        if (CT(13) && IN(pb + 13)) REPS(13) { PHB const bf16_t* wm = wmla(a, jj_); const bf16_t* wr_ = wrwkv(a, jj_); const bf16_t* wf = wffn(a, jj_); bf16_t* Vb = last_ ? (bf16_t*)WSP(A_RV) : (bf16_t*)(a.ws + WS_VF); (void)wm; (void)wr_; (void)wf; (void)Vb;
            { if (SCAN_CHUNKED) scan_chunked(a, jj, Vb, last, lds, G, c); if (!SCAN_CHUNKED || CS_BOTH) { __syncthreads(); scan_phase(a, jj, Vb, last, lds, G, c); }
              if (SCAN_CHUNKED && CS_BOTH) scan_compare(a, lds, G, c); } }
        SEAM(pb + 13);
        if (CT(14) && IN(pb + 14)) REPS(14) { PHB const bf16_t* wm = wmla(a, jj_); const bf16_t* wr_ = wrwkv(a, jj_); const bf16_t* wf = wffn(a, jj_); bf16_t* Vb = last_ ? (bf16_t*)WSP(A_RV) : (bf16_t*)(a.ws + WS_VF); (void)wm; (void)wr_; (void)wf; (void)Vb;
            rwkv_outprep(a, jj, Vb, last, G, c); }
        SEAM(pb + 14);
        if (CT(15) && IN(pb + 15)) REPS(15) { PHB const bf16_t* wm = wmla(a, jj_); const bf16_t* wr_ = wrwkv(a, jj_); const bf16_t* wf = wffn(a, jj_); bf16_t* Vb = last_ ? (bf16_t*)WSP(A_RV) : (bf16_t*)(a.ws + WS_VF); (void)wm; (void)wr_; (void)wf; (void)Vb;
            { MapSimple S{(const char*)WSP(A_RO), (const char*)(wr_ + E_B1 + 1024), P1K, (size_t)256 * 2048 * 2, 4, 16, last ? 1 : 0}; EpiResid E{(float*)(a.ws + WS_CS), a.out, (const float*)(a.ws + WS_MODS), lr, 2, (const float*)(a.ws + WS_CS), (const float*)a.out};
            pg8::gemm_phase(lds, 1024, 2048, S, E, G, c); } }
        SEAM(pb + 15);
        if (CT(16) && IN(pb + 16)) REPS(16) { PHB const bf16_t* wm = wmla(a, jj_); const bf16_t* wr_ = wrwkv(a, jj_); const bf16_t* wf = wffn(a, jj_); bf16_t* Vb = last_ ? (bf16_t*)WSP(A_RV) : (bf16_t*)(a.ws + WS_VF); (void)wm; (void)wr_; (void)wf; (void)Vb;
            { norm_router(a, lr, jj, last, lds, G, c); run_prep(a, lds + TILE_OFF, jj, CS_NOTILE ? 0 : (SCAN_CHUNKED ? cs::NCK - 1 : scan::NCH - 2), G, c);   } }
        SEAM(pb + 16);
        if (CT(17) && IN(pb + 17)) REPS(17) { PHB const bf16_t* wm = wmla(a, jj_); const bf16_t* wr_ = wrwkv(a, jj_); const bf16_t* wf = wffn(a, jj_); bf16_t* Vb = last_ ? (bf16_t*)WSP(A_RV) : (bf16_t*)(a.ws + WS_VF); (void)wm; (void)wr_; (void)wf; (void)Vb;
            moe_gather(a, lds, G, c); }
        SEAM(pb + 17);
        if (CT(18) && IN(pb + 18)) REPS(18) { PHB const bf16_t* wm = wmla(a, jj_); const bf16_t* wr_ = wrwkv(a, jj_); const bf16_t* wf = wffn(a, jj_); bf16_t* Vb = last_ ? (bf16_t*)WSP(A_RV) : (bf16_t*)(a.ws + WS_VF); (void)wm; (void)wr_; (void)wf; (void)Vb;
            { MapMoe S{(const char*)WSP(A_HS), (const char*)WSP(A_WM13), P1K, E_M13 * 2, P1K, 28, 16, (const int*)(a.ws + WS_META)}; EpiSwiGLU E{(bf16_t*)WSP(A_MHID), DFE};
            pg8::gemm_phase(lds, 1024, 1024, S, E, G, c); } }
        SEAM(pb + 18);
        if (CT(19) && IN(pb + 19)) REPS(19) { PHB const bf16_t* wm = wmla(a, jj_); const bf16_t* wr_ = wrwkv(a, jj_); const bf16_t* wf = wffn(a, jj_); bf16_t* Vb = last_ ? (bf16_t*)WSP(A_RV) : (bf16_t*)(a.ws + WS_VF); (void)wm; (void)wr_; (void)wf; (void)Vb;
            { MapMoeDown S{(const char*)WSP(A_MHID), (const char*)WSP(A_WM2), (size_t)256 * DFE * 2, E_M2 * 2, (size_t)256 * DFE * 2, (const int*)(a.ws + WS_META)}; EpiBf<FPlainAux> E{{(bf16_t*)WSP(A_Y2), 1024}};
            pg8::gemm_phase(lds, DFE, DFE, S, E, G, c); } }
        SEAM(pb + 19);
    }
    { const int jj_ = 1; const bool last_ = true;
    if (CT(21) && IN(41)) REPS(21) { PHB const bf16_t* wm = wmla(a, jj_); const bf16_t* wr_ = wrwkv(a, jj_); const bf16_t* wf = wffn(a, jj_); bf16_t* Vb = last_ ? (bf16_t*)WSP(A_RV) : (bf16_t*)(a.ws + WS_VF); (void)wm; (void)wr_; (void)wf; (void)Vb;
            final_combine(a, 3, G, c); }
    }
#undef IN
#undef SEAM
}

typedef void (*KernFn)(Args);
#if MK_ONE_LAUNCH
#ifndef PMASK
#define PMASK 0x3fffffu
#endif
static KernFn kern_of(int) { return fwd<PMASK>; }
#else
static KernFn kern_of(int p) {
    static const KernFn tab[22] = { fwd<1u << 0>, fwd<1u << 1>, fwd<1u << 2>, fwd<1u << 3>, fwd<1u << 4>, fwd<1u << 5>, fwd<1u << 6>, fwd<1u << 7>, fwd<1u << 8>, fwd<1u << 9>, fwd<1u << 10>, fwd<1u << 11>, fwd<1u << 12>, fwd<1u << 13>, fwd<1u << 14>, fwd<1u << 15>, fwd<1u << 16>, fwd<1u << 17>, fwd<1u << 18>, fwd<1u << 19>, fwd<1u << 20>, fwd<1u << 21> };
    return tab[p == 0 ? 20 : (p == NPH - 1 ? 21 : (p - 1) % 20)];
}
#endif
extern "C" void kernel_launch(void* const* d_in, const int* in_sizes, int n_in, void* d_out, int out_size, void* d_ws, size_t ws_size, hipStream_t stream) {
    static int grid = 0;
    if (grid == 0) {
        if (n_in != N_IN || out_size != NB * SEQ * D || ws_size < WS_NEED) { fprintf(stderr, "kernel_launch: unexpected shapes: n_in %d out %d ws %zu (need %zu)\n", n_in, out_size, ws_size, (size_t)WS_NEED); grid = -1; return; }
        int dev = 0, cus = 0;
        if (hipGetDevice(&dev) != hipSuccess || hipDeviceGetAttribute(&cus, hipDeviceAttributeMultiprocessorCount, dev) != hipSuccess) { grid = -1; return; }
        for (int p = 0; p < NPH; ++p)
            if (hipFuncSetAttribute((const void*)kern_of(p), hipFuncAttributeMaxDynamicSharedMemorySize, LDS_BYTES) != hipSuccess) { fprintf(stderr, "kernel_launch: hipFuncSetAttribute failed\n"); grid = -1; return; }
        int per_cu = 0;
        if (hipOccupancyMaxActiveBlocksPerMultiprocessor(&per_cu, (const void*)kern_of(1), NTHR, LDS_BYTES) != hipSuccess || per_cu < 1) { fprintf(stderr, "kernel_launch: occupancy query says %d blocks per CU\n", per_cu); (void)hipGetLastError(); }
        grid = cus < 256 ? cus : 256;
    }
    if (grid < 0) return;
    (void)in_sizes;
    (void)hipMemsetAsync((char*)d_ws + WS_CTL, 0, CTL_BYTES, stream);
    Args a{};
    for (int i = 0; i < N_IN; ++i) a.in[i] = (const float*)d_in[i];
    a.out = (float*)d_out; a.ws = (unsigned char*)d_ws;
#if MK_ONE_LAUNCH
    a.ph_lo = 0; a.ph_hi = NPH;
    hipLaunchKernelGGL(kern_of(0), dim3(grid), dim3(NTHR), LDS_BYTES, stream, a);
#else
    for (int p = 0; p < NPH; ++p) { a.ph_lo = p; a.ph_hi = p + 1; hipLaunchKernelGGL(kern_of(p), dim3(grid), dim3(NTHR), LDS_BYTES, stream, a); }
#endif
    const hipError_t le = hipPeekAtLastError();
    if (le != hipSuccess) fprintf(stderr, "kernel_launch: launch failed: %s\n", hipGetErrorName(le));
}
```

```cpp
#include <hip/hip_runtime.h>
#include <cstdio>
#include <cstdint>
#ifndef SCAN_CHUNKED
#define SCAN_CHUNKED 1
#endif
#ifndef CS_SERIAL
#define CS_SERIAL 0
#endif
#ifndef CS_BOTH
#define CS_BOTH 0
#endif
#ifndef CS_NOTILE
#define CS_NOTILE 0
#endif
#ifndef CS_OOP
#define CS_OOP 0
#endif
#ifndef CS_TOL
#define CS_TOL 0.05f
#endif

#ifndef MK_ONE_LAUNCH
#define MK_ONE_LAUNCH 1
#endif

#define LAS __attribute__((address_space(3)))
typedef unsigned short bf16_t;
typedef short bf16x8 __attribute__((ext_vector_type(8)));
typedef short s16x4 __attribute__((ext_vector_type(4)));
typedef float f32x2 __attribute__((ext_vector_type(2)));
typedef float f32x4 __attribute__((ext_vector_type(4)));
typedef float f32x16 __attribute__((ext_vector_type(16)));
typedef unsigned u32x2 __attribute__((ext_vector_type(2)));
typedef unsigned u32x4 __attribute__((ext_vector_type(4)));

constexpr int D = 1024, NB = 8, SEQ = 4096, CTX = 256, SEG = SEQ + CTX, R = NB * SEG;
constexpr int NPAN = R / 256;
constexpr int NTHR = 512, NWAVE = 8;
constexpr int QL = 384, KVL = 256, ROPE = 64, NOPE = 128, QKH = 192, VH = 128, NH = 8;
constexpr int DFF = 2816, NE = 8, DFE = 3584;
constexpr int MP_MAX = 71680;
constexpr float NORM_EPS = 1e-6f, LNX_EPS = 64e-5f;
constexpr float QSCALE = 0.07216878364870322f * 1.4426950408889634f;

enum { I_X = 0, I_C, I_CTX, I_CCTX, I_ADAW, I_ADAB, I_N1G, I_N2G, I_WQA, I_QAN, I_WQB, I_WKVA, I_KVAN, I_WKVB, I_QN, I_KN, I_MWO,
       I_MIX, I_WR, I_WK, I_WV, I_RWO, I_W0, I_W1, I_W2, I_A0, I_A1, I_A2, I_G1, I_G2, I_KK, I_KA, I_RK, I_LNW, I_LNB, I_V0, I_V1, I_V2,
       I_F1, I_F3, I_F2, I_ROUTER, I_M1, I_M3, I_M2, N_IN };

constexpr size_t U = (size_t)R * 1024 * 2;
constexpr size_t al256(size_t x) { return (x + 255) / 256 * 256; }
constexpr size_t WS_CTL = 0;
constexpr size_t CTL_BYTES = 65536;
constexpr size_t WS_MODS = WS_CTL + CTL_BYTES;
constexpr size_t WS_ROPE = WS_MODS + al256((size_t)4 * 9 * 6144 * 4);
constexpr size_t WS_CS = WS_ROPE + 8192;
constexpr size_t WS_RS = WS_CS + (size_t)NB * CTX * D * 4;
constexpr size_t WS_ROUTE = WS_RS + al256((size_t)R * 8);
constexpr size_t WS_RSLOT = WS_ROUTE + (size_t)R * 16;
constexpr size_t WS_HIST = WS_RSLOT + (size_t)R * 8;
constexpr size_t WS_META = WS_HIST + 2048 * 8 * 4;
constexpr size_t WS_WSM = WS_META + 256;
constexpr size_t E_QKVA = 768 * 1024, E_QB = 1536 * 384, E_KVB = 2048 * 384, E_MWO = 1024 * 1024, E_MLA = E_QKVA + E_QB + E_KVB + E_MWO;
constexpr size_t E_B1 = 1024 * 2048, E_B2 = 1024 * 2048, E_L1 = 512 * 2048, E_L2A = 4096 * 256, E_L2B = 2048 * 256, E_RWKV = E_B1 + E_B2 + E_L1 + E_L2A + E_L2B;
constexpr size_t E_F13 = 5632 * 1024, E_F2 = 1024 * 2816, E_FFN = E_F13 + E_F2;
constexpr size_t WS_WMLA = WS_WSM, WS_WRWKV = WS_WMLA + 2 * E_MLA * 2, WS_WFFN = WS_WRWKV + 2 * E_RWKV * 2;
constexpr size_t WS_VF = WS_WFFN + 2 * E_FFN * 2;
constexpr size_t WS_ARENA = WS_VF + U;
constexpr size_t A_H = 0;
constexpr size_t A_QKVA = U, A_Q = 2 * U, A_KV = 2 * U + U * 3 / 2, A_K = A_KV + 2 * U, A_O = A_K + U * 3 / 2;
constexpr size_t A_FHID = U;
constexpr size_t A_AX = 0, A_L1 = 5 * U, A_RR = A_L1 + U / 2, A_RK = A_RR + U, A_RV = A_RK + U, A_VL = A_RV + U, A_REND = A_VL + U;
constexpr size_t A_WL0 = 0, A_WL1 = U, A_AL0 = 2 * U, A_AL1 = 3 * U, A_G = 4 * U, A_RO = 0;
constexpr size_t A_YF = (SCAN_CHUNKED && CS_OOP && !CS_BOTH) ? A_REND : A_WL0, A_YR = (SCAN_CHUNKED && CS_OOP && !CS_BOTH) ? A_REND + U : A_WL1;
constexpr size_t A_YCF = CS_BOTH ? A_REND : A_YF, A_YCR = CS_BOTH ? A_REND + U : A_YR;
constexpr size_t A_HS = U, A_Y2 = U, A_MHID = A_HS + (size_t)MP_MAX * 1024 * 2, A_MEND = A_MHID + (size_t)MP_MAX * DFE * 2;
constexpr size_t E_M13 = (size_t)7168 * 1024, E_M2 = (size_t)1024 * 3584;
constexpr size_t A_WM13 = A_MEND, A_WM2 = A_WM13 + NE * E_M13 * 2, A_END = A_WM2 + NE * E_M2 * 2;
constexpr size_t WS_NEED = WS_ARENA + (A_END > A_REND ? A_END : A_REND);
static_assert(WS_NEED <= 1081188352ull, "workspace budget (sum of inputs)");
static_assert(CS_OOP || CS_BOTH || A_WM13 >= A_REND, "the MoE weight region must be free during the RWKV mixer (weights are converted inside the scan phase)");

struct Args { const float* in[N_IN]; float* out; unsigned char* ws; int ph_lo, ph_hi; };

__device__ __forceinline__ unsigned cvt_pk_bf16(float lo, float hi) { unsigned r; asm("v_cvt_pk_bf16_f32 %0, %1, %2" : "=v"(r) : "v"(lo), "v"(hi)); return r; }
__device__ __forceinline__ float bflo(unsigned w) { return __uint_as_float(w << 16); }
__device__ __forceinline__ float bfhi(unsigned w) { return __uint_as_float(w & 0xffff0000u); }
__device__ __forceinline__ void unpack8(const u32x4 w, float (&f)[8]) { f[0] = bflo(w.x); f[1] = bfhi(w.x); f[2] = bflo(w.y); f[3] = bfhi(w.y); f[4] = bflo(w.z); f[5] = bfhi(w.z); f[6] = bflo(w.w); f[7] = bfhi(w.w); }
__device__ __forceinline__ u32x4 pack8(const float (&f)[8]) { u32x4 w; w.x = cvt_pk_bf16(f[0], f[1]); w.y = cvt_pk_bf16(f[2], f[3]); w.z = cvt_pk_bf16(f[4], f[5]); w.w = cvt_pk_bf16(f[6], f[7]); return w; }
__device__ __forceinline__ float wave_sum(float v) {
#pragma unroll
    for (int o = 32; o >= 1; o >>= 1) v += __shfl_xor(v, o);
    return v;
}
template <int CTRL> __device__ __forceinline__ float dpp_f(float v) { return __int_as_float(__builtin_amdgcn_update_dpp(0, __float_as_int(v), CTRL, 0xF, 0xF, true)); }
__device__ __forceinline__ float red8(float v) { v += dpp_f<0xB1>(v); v += dpp_f<0x4E>(v); v += dpp_f<0x141>(v); return v; }
__device__ __forceinline__ int ltid() { int t = threadIdx.x; asm volatile("" : "+v"(t)); return t; }
template <class T> __device__ __forceinline__ T launder_s(T x) { asm volatile("" : "+s"(x)); return x; }
__device__ __forceinline__ Args launder_args(const Args& k) { Args a = k; a.ws = launder_s(k.ws); a.out = launder_s(k.out); return a; }
__device__ __forceinline__ float wave_sum_dpp(float v) {
    v += dpp_f<0xB1>(v); v += dpp_f<0x4E>(v); v += dpp_f<0x141>(v); v += dpp_f<0x140>(v);
    const int iv = __float_as_int(v);
    return (__int_as_float(__builtin_amdgcn_readlane(iv, 0)) + __int_as_float(__builtin_amdgcn_readlane(iv, 16))) + (__int_as_float(__builtin_amdgcn_readlane(iv, 32)) + __int_as_float(__builtin_amdgcn_readlane(iv, 48)));
}
__device__ __forceinline__ float sigmoidf_(float x) { return __builtin_amdgcn_rcpf(1.0f + __expf(-x)); }
__device__ __forceinline__ float* xrow(const Args& a, int row) {
    const int b = row / SEG, r = row - b * SEG;
    return r < CTX ? (float*)(a.ws + WS_CS) + (size_t)(b * CTX + r) * D : a.out + (size_t)(b * SEQ + r - CTX) * D;
}
__device__ __forceinline__ const float* xrow_in(const Args& a, int row) {
    const int b = row / SEG, r = row - b * SEG;
    return r < CTX ? a.in[I_CTX] + (size_t)(b * CTX + r) * D : a.in[I_X] + (size_t)(b * SEQ + r - CTX) * D;
}
__device__ __forceinline__ int mod_index(int row) { const int b = row / SEG, r = row - b * SEG; return r < CTX ? 8 : b; }
__device__ __forceinline__ const float* mods_ptr(const Args& a, int layer, int mi, int which) { return (const float*)(a.ws + WS_MODS) + ((size_t)(layer * 9 + mi) * 6 + which) * 1024; }

#define XB_TMO      128
#define XB_XCNT(j)  (256  + 64 * (j))
#define XB_XSUB(j)  (1280 + 64 * (j))
#define XB_XGEN(j)  (2304 + 64 * (j))
#define XB_TOP      3328
#define XB_TOPGEN   3392
#define XCD_BAR_WORDS 3456
#define XB_SPIN_CAP (1u << 22)
__device__ __forceinline__ unsigned xb_ld(unsigned* p)              { return __hip_atomic_load(p, __ATOMIC_RELAXED, __HIP_MEMORY_SCOPE_AGENT); }
__device__ __forceinline__ unsigned xb_add(unsigned* p, unsigned v) { return __hip_atomic_fetch_add(p, v, __ATOMIC_RELAXED, __HIP_MEMORY_SCOPE_AGENT); }
__device__ __forceinline__ unsigned xb_xcc_id() { return (unsigned)__builtin_amdgcn_s_getreg((3 << 11) | 20) & 0xFu; }
#define XB_SPIN(cond, bar) do { unsigned _sp = 0; while (cond) { __builtin_amdgcn_s_sleep(1); \
    if ((++_sp & 255u) == 0u) { if (xb_ld(&(bar)[XB_TMO])) break; if (_sp > XB_SPIN_CAP) { atomicAdd(&(bar)[XB_TMO], 1u); break; } } } } while (0)
struct XcdBarrier { unsigned* bar; unsigned x; volatile LAS unsigned* st; };
__device__ __forceinline__ XcdBarrier xcd_barrier_post(unsigned* bar, volatile LAS unsigned* st) {
    XcdBarrier b; b.bar = bar; b.x = xb_xcc_id(); b.st = st;
    if (threadIdx.x == 0) (void)xb_add(&bar[XB_XCNT(b.x)], 1u);
    return b;
}
__device__ __forceinline__ void xcd_barrier_complete(unsigned* bar, unsigned x, unsigned& nloc, unsigned& nx) {
    const unsigned G = gridDim.x * gridDim.y * gridDim.z;
    unsigned sum, cnt, mine, sp = 0u;
    for (;;) {
        sum = 0u; cnt = 0u; mine = 0u;
#pragma unroll
        for (unsigned j = 0; j < 16; ++j) { const unsigned c = xb_ld(&bar[XB_XCNT(j)]); sum += c; cnt += (c > 0u) ? 1u : 0u; mine = (j == x) ? c : mine; }
        if (sum == G) break;
        __builtin_amdgcn_s_sleep(1);
        if ((++sp & 255u) == 0u) { if (xb_ld(&bar[XB_TMO])) break; if (sp > XB_SPIN_CAP) { atomicAdd(&bar[XB_TMO], 1u); break; } }
    }
    nloc = mine > 0u ? mine : 1u; nx = cnt > 0u ? cnt : 1u;
}
__device__ __forceinline__ void xcd_barrier(const XcdBarrier& b) {
    asm volatile("s_waitcnt vmcnt(0)" ::: "memory");
    __syncthreads();
    if (threadIdx.x == 0) {
        unsigned* bar = b.bar;
        __builtin_amdgcn_s_waitcnt(0);
        unsigned nloc = b.st[0], nx = b.st[1];
        if (nloc == 0u) { xcd_barrier_complete(bar, b.x, nloc, nx); b.st[0] = nloc; b.st[1] = nx; }
        const unsigned old = xb_add(&bar[XB_XSUB(b.x)], 1u);
        const unsigned gen = old / nloc;
        if (old + 1u == (gen + 1u) * nloc) {
            __builtin_amdgcn_fence(__ATOMIC_RELEASE, "agent");
            asm volatile("s_waitcnt vmcnt(0)" ::: "memory");
            const unsigned og = xb_add(&bar[XB_TOP], 1u);
            const unsigned tg = og / nx;
            if (og + 1u == (tg + 1u) * nx) xb_add(&bar[XB_TOPGEN], 1u);
            else XB_SPIN(xb_ld(&bar[XB_TOPGEN]) == tg, bar);
            __builtin_amdgcn_fence(__ATOMIC_ACQUIRE, "agent");
            xb_add(&bar[XB_XGEN(b.x)], 1u);
            asm volatile("s_waitcnt vmcnt(0)" ::: "memory");
        } else {
            XB_SPIN(xb_ld(&bar[XB_XGEN(b.x)]) == gen, bar);
            __builtin_amdgcn_fence(__ATOMIC_ACQUIRE, "agent");
            asm volatile("s_waitcnt vmcnt(0)" ::: "memory");
        }
    }
    __syncthreads();
}

namespace pg8 {
constexpr int BM = 256, BK = 64, HALF = 128, HTB = HALF * BK * 2, STAGE_BYTES = 8 * HTB;
__device__ __forceinline__ int lds_byte(int r, int c) { const int st = (r >> 4) * 2 + (c >> 5), rr = r & 15, cc = c & 31, ob = rr * 64 + cc * 2; return st * 1024 + (ob ^ (((ob >> 9) & 1) << 5)); }
__device__ __forceinline__ void stage_rc(int b, int& Rr, int& C) { const int st = b / 1024, sb = b % 1024, swz = sb ^ (((sb >> 9) & 1) << 5); Rr = (st >> 1) * 16 + swz / 64; C = (st & 1) * 32 + (swz % 64) / 2; }
__device__ __forceinline__ int perm32(int rho) { const int n = rho >> 4, i = rho & 15; return 8 * (i >> 2) + 4 * n + (i & 3); }
struct GUnit { const char* A; const char* B; int nt, pm, pn, aux; };
__device__ __forceinline__ void tile_order(int L, int nM, int nN, int& pm, int& pn) {
    const int nwg = nM * nN; int wgid = L;
    { const int q = nwg / 8, r = nwg % 8, xcd = wgid % 8, off = wgid / 8; wgid = (xcd < r ? xcd * (q + 1) : r * (q + 1) + (xcd - r) * q) + off; }
    const int nig = 8 * nN, gid = wgid / nig, fm = gid * 8, gsz = (nM - fm) < 8 ? (nM - fm) : 8;
    pm = fm + ((wgid % nig) % gsz); pn = (wgid % nig) / gsz;
}
template <class Epi, class Map>
__device__ __forceinline__ void gemm_phase(LAS unsigned char* lds, const int lda, const int ldb, const Map& S, const Epi& E, const int G, const int c) {
    const int tid = ltid(), wid = __builtin_amdgcn_readfirstlane(tid >> 6), lane = tid & 63, wr = wid >> 2, wc = wid & 3, fr = lane & 15, fq = lane >> 4;
    unsigned voffA[2], voffB[2];
#pragma unroll
    for (int i = 0; i < 2; ++i) { int Rr, C; stage_rc(tid * 16 + i * 8192, Rr, C); const int Rb = Epi::PERM ? ((Rr & ~31) + perm32(Rr & 31)) : Rr;
        voffA[i] = (unsigned)(Rr * lda + C) * 2u; voffB[i] = (unsigned)(Rb * ldb + C) * 2u; }
    const size_t kstep = (size_t)(BK * 2);
    const size_t hA = (size_t)HALF * lda * 2, hB = (size_t)HALF * ldb * 2;
    const unsigned ldsw = (unsigned)wid * 1024u;
    const int aoff = lds_byte(wr * 64 + fr, fq * 8), boff = lds_byte(wc * 32 + fr, fq * 8);
#define PG8_SA(b, h) (((b) * 2 + (h)) * HTB)
#define PG8_SB(b, h) ((4 + (b) * 2 + (h)) * HTB)
#define PG8_STAGE(bufoff, gbase, voff) do { _Pragma("unroll") for (int _i = 0; _i < 2; ++_i) \
        __builtin_amdgcn_global_load_lds((const unsigned*)((const char*)(gbase) + (voff)[_i]), (LAS unsigned*)(lds + (bufoff) + ldsw + _i * 8192), 16, 0, 0); } while (0)
#define PG8_LDA(dst, b, h) do { _Pragma("unroll") for (int m = 0; m < 4; ++m) _Pragma("unroll") for (int k = 0; k < 2; ++k) dst[m][k] = *(const LAS bf16x8*)(lds + PG8_SA(b, h) + aoff + m * 2048 + k * 1024); } while (0)
#define PG8_LDB(dst, b, h) do { _Pragma("unroll") for (int n = 0; n < 2; ++n) _Pragma("unroll") for (int k = 0; k < 2; ++k) dst[n][k] = *(const LAS bf16x8*)(lds + PG8_SB(b, h) + boff + n * 2048 + k * 1024); } while (0)
#define PG8_MMA(ai, bj, At, Bt) do { __builtin_amdgcn_s_setprio(1); _Pragma("unroll") for (int m = 0; m < 4; ++m) _Pragma("unroll") for (int n = 0; n < 2; ++n) _Pragma("unroll") for (int k = 0; k < 2; ++k) \
        acc[ai][bj][m][n] = __builtin_amdgcn_mfma_f32_16x16x32_bf16(Bt[n][k], At[m][k], acc[ai][bj][m][n], 0, 0, 0); __builtin_amdgcn_s_setprio(0); } while (0)
#define PG8_WAIT_V(n) asm volatile("s_waitcnt vmcnt(" #n ")" ::: "memory")
#define PG8_WAIT_L(n) asm volatile("s_waitcnt lgkmcnt(" #n ")" ::: "memory")
#define PG8_BAR __builtin_amdgcn_s_barrier()
#define PG8_SCHED __builtin_amdgcn_sched_barrier(0)
    GUnit cur, nxt; int ui = 0;
    if (!S(c, cur)) return;
    f32x4 acc[2][2][4][2];
#pragma unroll
    for (int a = 0; a < 2; ++a)
#pragma unroll
        for (int b = 0; b < 2; ++b)
#pragma unroll
            for (int m = 0; m < 4; ++m)
#pragma unroll
                for (int n = 0; n < 2; ++n) acc[a][b][m][n] = (f32x4){0.f, 0.f, 0.f, 0.f};
    bf16x8 At[4][2], B0[2][2], B1[2][2];
    const char* cA = cur.A; const char* cB = cur.B;
    PG8_STAGE(PG8_SB(0, 0), cB, voffB); PG8_STAGE(PG8_SB(0, 1), cB + hB, voffB); PG8_STAGE(PG8_SA(0, 0), cA, voffA); PG8_STAGE(PG8_SA(0, 1), cA + hA, voffA);
    if (wr == 1) PG8_BAR;
    PG8_WAIT_V(2); PG8_BAR;
    PG8_STAGE(PG8_SB(1, 0), cB + kstep, voffB); PG8_STAGE(PG8_SA(1, 0), cA + kstep, voffA); PG8_STAGE(PG8_SB(1, 1), cB + hB + kstep, voffB);
    PG8_WAIT_V(6); PG8_BAR;
    for (;;) {
        const bool has_next = S((ui + 1) * G + c, nxt);
        const char* nA = has_next ? nxt.A : cA; const char* nB = has_next ? nxt.B : cB;
        const int nt = cur.nt;
        for (int t = 0; t < nt; t += 2) {
            const bool last = (t == nt - 2);
            const char* a1 = cA + (size_t)(t + 1) * kstep;
            const char* a2 = last ? nA : cA + (size_t)(t + 2) * kstep; const char* b2 = last ? nB : cB + (size_t)(t + 2) * kstep;
            const char* a3 = a2 + kstep; const char* b3 = b2 + kstep;
            PG8_LDB(B0, 0, 0); PG8_LDB(B1, 0, 1); PG8_SCHED; PG8_LDA(At, 0, 0); PG8_STAGE(PG8_SA(1, 1), a1 + hA, voffA);
            PG8_WAIT_V(8); PG8_WAIT_L(0); PG8_BAR; PG8_MMA(0, 0, At, B0); PG8_MMA(0, 1, At, B1); PG8_BAR; PG8_SCHED;
            PG8_LDA(At, 0, 1); PG8_STAGE(PG8_SB(0, 0), b2, voffB); PG8_STAGE(PG8_SB(0, 1), b2 + hB, voffB); PG8_STAGE(PG8_SA(0, 0), a2, voffA);
            PG8_WAIT_V(8); PG8_WAIT_L(0); PG8_BAR; PG8_MMA(1, 0, At, B0); PG8_MMA(1, 1, At, B1); PG8_BAR; PG8_SCHED;
            PG8_LDB(B0, 1, 0); PG8_LDB(B1, 1, 1); PG8_SCHED; PG8_LDA(At, 1, 0); PG8_STAGE(PG8_SA(0, 1), a2 + hA, voffA);
            PG8_WAIT_V(8); PG8_WAIT_L(0); PG8_BAR; PG8_MMA(0, 0, At, B0); PG8_MMA(0, 1, At, B1); PG8_BAR; PG8_SCHED;
            PG8_LDA(At, 1, 1); PG8_STAGE(PG8_SB(1, 0), b3, voffB); PG8_STAGE(PG8_SB(1, 1), b3 + hB, voffB); PG8_STAGE(PG8_SA(1, 0), a3, voffA);
            PG8_WAIT_V(8); PG8_WAIT_L(0); PG8_BAR; PG8_MMA(1, 0, At, B0); PG8_MMA(1, 1, At, B1); PG8_BAR; PG8_SCHED;
        }
        if (wr == 0) PG8_BAR;
        E(acc, cur, wr, wc, fr, fq);
        if (!has_next) break;
#pragma unroll
        for (int a = 0; a < 2; ++a)
#pragma unroll
            for (int b = 0; b < 2; ++b)
#pragma unroll
                for (int m = 0; m < 4; ++m)
#pragma unroll
                    for (int n = 0; n < 2; ++n) acc[a][b][m][n] = (f32x4){0.f, 0.f, 0.f, 0.f};
        cur = nxt; cA = nA; cB = nB; ++ui;
        if (wr == 1) PG8_BAR;
    }
    PG8_WAIT_V(0);
    PG8_BAR;
#undef PG8_SA
#undef PG8_SB
#undef PG8_STAGE
#undef PG8_LDA
#undef PG8_LDB
#undef PG8_MMA
#undef PG8_WAIT_V
#undef PG8_WAIT_L
#undef PG8_BAR
#undef PG8_SCHED
}
}

using pg8::GUnit;
typedef f32x4 Acc[2][2][4][2];
template <class F> struct EpiBf {
    static constexpr bool PERM = true;
    F f;
    __device__ __forceinline__ void operator()(const Acc& acc, const GUnit& u, int wr, int wc, int fr, int fq) const {
#pragma unroll
        for (int ai = 0; ai < 2; ++ai)
#pragma unroll
            for (int m = 0; m < 4; ++m) { const int trow = ai * 128 + wr * 64 + m * 16 + fr;
#pragma unroll
                for (int bj = 0; bj < 2; ++bj) f(acc[ai][bj][m][0], acc[ai][bj][m][1], u, trow, bj * 128 + wc * 32 + 8 * fq); }
    }
};
__device__ __forceinline__ void st8(bf16_t* p, f32x4 v0, f32x4 v1) { u32x4 w; w.x = cvt_pk_bf16(v0[0], v0[1]); w.y = cvt_pk_bf16(v0[2], v0[3]); w.z = cvt_pk_bf16(v1[0], v1[1]); w.w = cvt_pk_bf16(v1[2], v1[3]); *(u32x4*)p = w; }

struct FPlain { bf16_t* O; int ldc;
    __device__ __forceinline__ void operator()(f32x4 v0, f32x4 v1, const GUnit& u, int trow, int tcol) const { st8(O + (size_t)(u.pm * 256 + trow) * ldc + u.pn * 256 + tcol, v0, v1); } };
struct FQKV { bf16_t* Q; bf16_t* KV; const float* rsq; const float* rskv;
    __device__ __forceinline__ void operator()(f32x4 v0, f32x4 v1, const GUnit& u, int trow, int tcol) const {
        const int row = u.pm * 256 + trow;
        if (u.aux == 0) { const float s = rsq[row]; st8(Q + (size_t)row * 1536 + u.pn * 256 + tcol, v0 * s, v1 * s); }
        else { const float s = rskv[row]; st8(KV + (size_t)row * 2048 + u.pn * 256 + tcol, v0 * s, v1 * s); } } };
struct EpiQKV {
    static constexpr bool PERM = true;
    bf16_t* Q; bf16_t* KV; const float* rsq; const float* rskv;
    __device__ __forceinline__ void operator()(const Acc& acc, const GUnit& u, int wr, int wc, int fr, int fq) const {
        const float* rs = (u.aux == 0) ? rsq : rskv; bf16_t* O = (u.aux == 0) ? Q : KV; const int ldc = (u.aux == 0) ? 1536 : 2048;
        float sc[2][4];
#pragma unroll
        for (int ai = 0; ai < 2; ++ai)
#pragma unroll
            for (int m = 0; m < 4; ++m) sc[ai][m] = rs[u.pm * 256 + ai * 128 + wr * 64 + m * 16 + fr];
#pragma unroll
        for (int ai = 0; ai < 2; ++ai)
#pragma unroll
            for (int m = 0; m < 4; ++m) { const int row = u.pm * 256 + ai * 128 + wr * 64 + m * 16 + fr; const float s = sc[ai][m];
#pragma unroll
                for (int bj = 0; bj < 2; ++bj) st8(O + (size_t)row * ldc + u.pn * 256 + bj * 128 + wc * 32 + 8 * fq, acc[ai][bj][m][0] * s, acc[ai][bj][m][1] * s); }
    }
};
struct EpiRw2 {
    static constexpr bool PERM = true;
    bf16_t* base; bf16_t* vl; const float* w0; const float* a0;
    __device__ __forceinline__ void operator()(const Acc& acc, const GUnit& u, int wr, int wc, int fr, int fq) const {
        bf16_t* o = (u.aux < 5) ? base + (size_t)u.aux * ((size_t)R * 1024) : vl;
        const bool act = u.aux < 4; const float scl = (u.aux < 2) ? 0.6065306597126334f : 1.0f;
        f32x4 bv[2][2];
#pragma unroll
        for (int bj = 0; bj < 2; ++bj) { const int col = u.pn * 256 + bj * 128 + wc * 32 + 8 * fq; const float* bp = (u.aux < 2 ? w0 : a0) + (u.aux & 1) * 1024 + col;
            bv[bj][0] = act ? *(const f32x4*)bp : (f32x4){0.f, 0.f, 0.f, 0.f}; bv[bj][1] = act ? *(const f32x4*)(bp + 4) : (f32x4){0.f, 0.f, 0.f, 0.f}; }
#pragma unroll
        for (int ai = 0; ai < 2; ++ai)
#pragma unroll
            for (int m = 0; m < 4; ++m) { const int row = u.pm * 256 + ai * 128 + wr * 64 + m * 16 + fr;
#pragma unroll
                for (int bj = 0; bj < 2; ++bj) { f32x4 v0 = acc[ai][bj][m][0], v1 = acc[ai][bj][m][1];
                    if (act) {
#pragma unroll
                        for (int j = 0; j < 4; ++j) { v0[j] = scl * sigmoidf_(bv[bj][0][j] + v0[j]); v1[j] = scl * sigmoidf_(bv[bj][1][j] + v1[j]); } }
                    st8(o + (size_t)row * 1024 + u.pn * 256 + bj * 128 + wc * 32 + 8 * fq, v0, v1); } }
    }
};
struct FRw1 { bf16_t* L1; bf16_t* RR; bf16_t* RK; bf16_t* RV;
    __device__ __forceinline__ void operator()(f32x4 v0, f32x4 v1, const GUnit& u, int trow, int tcol) const {
        const int row = u.pm * 256 + trow;
        if (u.aux == 0) { const int col = u.pn * 256 + tcol;
            if (col < 128) {
#pragma unroll
                for (int j = 0; j < 4; ++j) { v0[j] = 1.0f - 2.0f * __builtin_amdgcn_rcpf(1.0f + __expf(2.0f * v0[j])); v1[j] = 1.0f - 2.0f * __builtin_amdgcn_rcpf(1.0f + __expf(2.0f * v1[j])); } }
            else if (col >= 320) {
#pragma unroll
                for (int j = 0; j < 4; ++j) { v0[j] = sigmoidf_(v0[j]); v1[j] = sigmoidf_(v1[j]); } }
            st8(L1 + (size_t)row * 512 + col, v0, v1); }
        else { bf16_t* o = u.aux == 1 ? RR : (u.aux == 2 ? RK : RV); st8(o + (size_t)row * 1024 + u.pn * 256 + tcol, v0, v1); } } };
struct FRw2 { bf16_t* base; bf16_t* vl; const float* w0; const float* a0;
    __device__ __forceinline__ void operator()(f32x4 v0, f32x4 v1, const GUnit& u, int trow, int tcol) const {
        const int col = u.pn * 256 + tcol;
        const unsigned off = (unsigned)(u.pm * 256 + trow) * 1024u + (unsigned)col + (u.aux < 5 ? (unsigned)u.aux * (unsigned)(R * 1024) : 0u);
        bf16_t* o = (u.aux < 5) ? base : vl;
        if (u.aux < 4) {
            const float* bp = (u.aux < 2 ? w0 : a0) + (u.aux & 1) * 1024 + col; const f32x4 b0 = *(const f32x4*)bp, b1 = *(const f32x4*)(bp + 4);
            const float sc = (u.aux < 2) ? 0.6065306597126334f : 1.0f;
#pragma unroll
            for (int j = 0; j < 4; ++j) { v0[j] = sc * sigmoidf_(b0[j] + v0[j]); v1[j] = sc * sigmoidf_(b1[j] + v1[j]); } }
        st8(o + off, v0, v1); } };
struct EpiSwiGLU {
    static constexpr bool PERM = true;
    bf16_t* O; int ldc;
    __device__ __forceinline__ void operator()(const Acc& acc, const GUnit& u, int wr, int wc, int fr, int fq) const {
#pragma unroll
        for (int ai = 0; ai < 2; ++ai)
#pragma unroll
            for (int m = 0; m < 4; ++m) { const int trow = ai * 128 + wr * 64 + m * 16 + fr; f32x4 h0, h1;
#pragma unroll
                for (int j = 0; j < 4; ++j) { const float g0 = acc[ai][0][m][0][j], g1 = acc[ai][0][m][1][j];
                    h0[j] = g0 * sigmoidf_(g0) * acc[ai][1][m][0][j]; h1[j] = g1 * sigmoidf_(g1) * acc[ai][1][m][1][j]; }
                st8(O + (size_t)(u.pm * 256 + trow) * ldc + u.pn * 128 + wc * 32 + 8 * fq, h0, h1); }
    }
};
struct EpiResid {
    static constexpr bool PERM = false;
    float* cs; float* out; const float* mods; int layer, which;
    const float* scs; const float* sout;
    __device__ __forceinline__ void operator()(const Acc& acc, const GUnit& u, int wr, int wc, int fr, int fq) const {
        const int b = u.pm / 17, isctx = (u.pm % 17 == 0);
        float* xp = isctx ? cs + (size_t)b * CTX * D : out + (size_t)(b * SEQ + (u.pm % 17 - 1) * 256) * D;
        const float* sp = isctx ? scs + (size_t)b * CTX * D : sout + (size_t)(b * SEQ + (u.pm % 17 - 1) * 256) * D;
        const float* gp = mods + ((size_t)(layer * 9 + (isctx ? 8 : b)) * 6 + which) * 1024;
        const int col0 = u.pn * 256 + wc * 32 + 4 * fq;
        f32x4 gv[2][2];
#pragma unroll
        for (int bj = 0; bj < 2; ++bj)
#pragma unroll
            for (int n = 0; n < 2; ++n) gv[bj][n] = *(const f32x4*)(gp + col0 + bj * 128 + n * 16);
#pragma unroll
        for (int ai = 0; ai < 2; ++ai)
#pragma unroll
            for (int mh = 0; mh < 2; ++mh) {
                f32x4 xv[2][2][2];
#pragma unroll
                for (int mm = 0; mm < 2; ++mm) { const float* srow = sp + (size_t)(ai * 128 + wr * 64 + (mh * 2 + mm) * 16 + fr) * D + col0;
#pragma unroll
                    for (int bj = 0; bj < 2; ++bj)
#pragma unroll
                        for (int n = 0; n < 2; ++n) xv[mm][bj][n] = *(const f32x4*)(srow + bj * 128 + n * 16); }
#pragma unroll
                for (int mm = 0; mm < 2; ++mm) { float* rowp = xp + (size_t)(ai * 128 + wr * 64 + (mh * 2 + mm) * 16 + fr) * D + col0;
#pragma unroll
                    for (int bj = 0; bj < 2; ++bj)
#pragma unroll
                        for (int n = 0; n < 2; ++n) *(f32x4*)(rowp + bj * 128 + n * 16) = xv[mm][bj][n] + gv[bj][n] * acc[ai][bj][mh * 2 + mm][n]; }
                asm volatile("" ::: "memory"); }
    }
};

struct MapSimple {
    const char* A; const char* B; size_t sa, sb; int nN, nt, lat;
    __device__ __forceinline__ bool operator()(int L, GUnit& u) const { const int nM = lat ? 128 : NPAN; if (L >= nM * nN) return false; int q; pg8::tile_order(L, nM, nN, q, u.pn);
        u.pm = lat ? (q / 16) * 17 + 1 + (q % 16) : q;
        u.A = A + (size_t)u.pm * sa; u.B = B + (size_t)u.pn * sb; u.nt = nt; u.aux = 0; return true; }
};
struct MapQKV {
    const char* QKVA; const char* QB; const char* KVB;
    __device__ __forceinline__ bool operator()(int L, GUnit& u) const { if (L >= NPAN * 14) return false; int pn; pg8::tile_order(L, NPAN, 14, u.pm, pn);
        const char* ap = QKVA + (size_t)u.pm * 256 * 768 * 2;
        if (pn < 6) { u.A = ap; u.B = QB + (size_t)pn * 256 * 384 * 2; u.nt = 6; u.pn = pn; u.aux = 0; }
        else { u.A = ap + 384 * 2; u.B = KVB + (size_t)(pn - 6) * 256 * 384 * 2; u.nt = 4; u.pn = pn - 6; u.aux = 1; }
        return true; }
};
struct MapRw1 {
    const char* AX; const char* B1; const char* B2; const char* L1;
    __device__ __forceinline__ bool operator()(int L, GUnit& u) const { if (L >= NPAN * 14) return false; int pn; pg8::tile_order(L, NPAN, 14, u.pm, pn);
        const char* ap = AX + (size_t)u.pm * 256 * 5120 * 2;
        if (pn < 2) { u.A = ap; u.B = L1 + (size_t)pn * 256 * 2048 * 2; u.nt = 32; u.pn = pn; u.aux = 0; }
        else if (pn < 6) { u.A = ap + 2048 * 2; u.B = B1 + (size_t)(pn - 2) * 256 * 2048 * 2; u.nt = 16; u.pn = pn - 2; u.aux = 1; }
        else if (pn < 10) { u.A = ap + 3072 * 2; u.B = B1 + (size_t)(pn - 6) * 256 * 2048 * 2 + 1024 * 2; u.nt = 16; u.pn = pn - 6; u.aux = 2; }
        else { u.A = ap + 4096 * 2; u.B = B2 + (size_t)(pn - 10) * 256 * 2048 * 2; u.nt = 16; u.pn = pn - 10; u.aux = 3; }
        return true; }
};
struct MapRw2 {
    const char* L1; const char* L2A; const char* L2B; int pn0, nN, nt;
    __device__ __forceinline__ bool operator()(int L, GUnit& u) const { if (L >= NPAN * nN) return false; int pn; pg8::tile_order(L, NPAN, nN, u.pm, pn); pn += pn0;
        const char* ap = L1 + (size_t)u.pm * 256 * 512 * 2; u.nt = nt; u.pn = pn & 3; u.aux = pn >> 2;
        if (pn < 16) { const int koff = (pn < 8) ? 0 : 128 * 2;
            u.A = ap + koff; u.B = L2A + (size_t)pn * 256 * 256 * 2 + koff; u.nt = nt >> 1; }
        else { u.A = ap + 256 * 2; u.B = L2B + (size_t)(pn - 16) * 256 * 256 * 2; if (pn >= 20) u.nt = nt >> 1; }
        return true; }
};
struct MapMoe {
    const char* A; const char* B; size_t sa, sbe, sb; int nN, nt; const int* base;
    __device__ __forceinline__ bool operator()(int L, GUnit& u) const { const int nM = base[8] >> 8; if (L >= nM * nN) return false; pg8::tile_order(L, nM, nN, u.pm, u.pn);
        int e = 0;
#pragma unroll
        for (int j = 1; j < 8; ++j) e += (u.pm * 256 >= base[j]) ? 1 : 0;
        u.A = A + (size_t)u.pm * sa; u.B = B + (size_t)e * sbe + (size_t)u.pn * sb; u.nt = nt; u.aux = e; return true; }
};

struct MoeSplit { int nMf, nT, S; };
__device__ __forceinline__ MoeSplit moe_split(int total_slots) { const int nM = total_slots >> 8; MoeSplit s; s.nMf = (nM >> 6) << 6; s.nT = nM - s.nMf; int S = s.nT > 0 ? 64 / s.nT : 1; S = S > 8 ? 8 : S; s.S = S < 1 ? 1 : S; return s; }
constexpr int XP0 = (int)((A_WM13 - A_Y2) / ((size_t)256 * 1024 * 2));
static_assert((A_WM13 - A_Y2) % ((size_t)256 * 1024 * 2) == 0, "partial-tile panels are addressed relative to Y2");
struct MapMoeDown {
    const char* A; const char* B; size_t sa, sbe, sb; const int* base;
    __device__ __forceinline__ bool operator()(int L, GUnit& u) const { const MoeSplit sp = moe_split(base[8]); const int nfull = sp.nMf * 4;
        int k0 = 0, nt = 56, opan;
        if (L < nfull) { pg8::tile_order(L, sp.nMf, 4, u.pm, u.pn); opan = u.pm; }
        else { const int i = L - nfull, ntu = sp.nT * 4; if (i >= ntu * sp.S) return false;
            const int sl = i / ntu, t = i - sl * ntu; pg8::tile_order(t, sp.nT, 4, u.pm, u.pn); u.pm += sp.nMf;
            const int q = 28 / sp.S, r = 28 - q * sp.S, p0 = sl * q + (sl < r ? sl : r), np = q + (sl < r ? 1 : 0); k0 = p0 * 2; nt = np * 2;
            opan = sl == 0 ? u.pm : XP0 + (sl - 1) * sp.nT + (u.pm - sp.nMf); }
        int e = 0;
#pragma unroll
        for (int j = 1; j < 8; ++j) e += (u.pm * 256 >= base[j]) ? 1 : 0;
        u.A = A + (size_t)u.pm * sa + (size_t)k0 * 128; u.B = B + (size_t)e * sbe + (size_t)u.pn * sb + (size_t)k0 * 128; u.nt = nt; u.aux = opan; return true; }
};
struct FPlainAux { bf16_t* O; int ldc;
    __device__ __forceinline__ void operator()(f32x4 v0, f32x4 v1, const GUnit& u, int trow, int tcol) const { st8(O + (size_t)(u.aux * 256 + trow) * ldc + u.pn * 256 + tcol, v0, v1); } };

struct Job { const float* src; const float* kscale; bf16_t* dst; int sld, srcK, srcN, ldd, Nd, Kd, koff, grp, gstride, tn, tile0, pad; };
constexpr int MAXJOB = 96;
#define NOGRP (1 << 30)
struct JobList { LAS Job* jobs; int n, tiles, z; };
__device__ __forceinline__ void addjob(JobList& L, const float* src, int sld, int srcK, int srcN, const float* kscale, bf16_t* dst, int ldd, int Nd, int Kd, int koff, int grp, int gstride) {
    LAS Job* j = L.jobs + L.n; j->src = src; j->kscale = kscale; j->dst = dst; j->sld = sld + L.z; j->srcK = srcK + L.z; j->srcN = srcN + L.z; j->ldd = ldd + L.z; j->Nd = Nd + L.z; j->Kd = Kd + L.z; j->koff = koff + L.z; j->grp = grp + L.z; j->gstride = gstride + L.z;
    const int tn = ((Nd + 63) >> 6) + L.z; j->tn = tn; j->tile0 = L.tiles; L.tiles += tn * (Kd >> 6); L.n += 1;
}
__device__ __forceinline__ bf16_t* wmla(const Args& a, int j) { return (bf16_t*)(a.ws + WS_WMLA) + (size_t)j * E_MLA; }
__device__ __forceinline__ bf16_t* wrwkv(const Args& a, int j) { return (bf16_t*)(a.ws + WS_WRWKV) + (size_t)j * E_RWKV; }
__device__ __forceinline__ bf16_t* wffn(const Args& a, int j) { return (bf16_t*)(a.ws + WS_WFFN) + (size_t)j * E_FFN; }
__device__ __forceinline__ void jobs_small(const Args& a, JobList& L) {
#pragma unroll 1
    for (int j = 0; j < 2; ++j) {
        {
            bf16_t* w = wmla(a, j); bf16_t* qkva = w; bf16_t* qb = w + E_QKVA; bf16_t* kvb = qb + E_QB; bf16_t* wo = kvb + E_KVB;
            addjob(L, a.in[I_WQA] + (size_t)j * D * QL, QL, D, QL, nullptr, qkva, 1024, 384, 1024, 0, NOGRP, 0);
            addjob(L, a.in[I_WKVA] + (size_t)j * D * 320, 320, D, 320, nullptr, qkva + (size_t)384 * 1024, 1024, 384, 1024, 0, NOGRP, 0);
            addjob(L, a.in[I_WQB] + (size_t)j * QL * 1536, 1536, QL, 1536, a.in[I_QAN] + j * QL, qb, 384, 1536, 384, 0, NOGRP, 0);
            addjob(L, a.in[I_WKVB] + (size_t)j * KVL * 2048, 2048, KVL, 2048, a.in[I_KVAN] + j * KVL, kvb, 384, 2048, 256, 0, NOGRP, 0);
            addjob(L, a.in[I_MWO] + (size_t)j * D * D, D, D, D, nullptr, wo, 1024, 1024, 1024, 0, NOGRP, 0);
        }
        {
            bf16_t* w = wrwkv(a, j); bf16_t* b1 = w; bf16_t* b2 = b1 + E_B1; bf16_t* l1 = b2 + E_B2; bf16_t* l2a = l1 + E_L1; bf16_t* l2b = l2a + E_L2A;
            const float* mix = a.in[I_MIX] + (size_t)j * 6 * D;
            addjob(L, a.in[I_WR] + (size_t)j * D * D, D, D, D, nullptr, b1, 2048, 1024, 1024, 0, NOGRP, 0);
            addjob(L, a.in[I_WK] + (size_t)j * D * D, D, D, D, nullptr, b1 + 1024, 2048, 1024, 1024, 0, NOGRP, 0);
            addjob(L, a.in[I_WV] + (size_t)j * D * D, D, D, D, nullptr, b2, 2048, 1024, 1024, 0, NOGRP, 0);
            addjob(L, a.in[I_RWO] + (size_t)j * D * D, D, D, D, nullptr, b2 + 1024, 2048, 1024, 1024, 0, NOGRP, 0);
            for (int d = 0; d < 2; ++d) {
                const float* w1 = a.in[I_W1] + (size_t)(j * 2 + d) * D * 64; const float* a1 = a.in[I_A1] + (size_t)(j * 2 + d) * D * 64;
                addjob(L, w1, 64, D, 64, nullptr, l1 + (size_t)(d * 64) * 2048, 2048, 64, 1024, 0, NOGRP, 0);
                addjob(L, w1, 64, D, 64, mix + 1 * D, l1 + (size_t)(d * 64) * 2048 + 1024, 2048, 64, 1024, 0, NOGRP, 0);
                addjob(L, a1, 64, D, 64, nullptr, l1 + (size_t)(128 + d * 64) * 2048, 2048, 64, 1024, 0, NOGRP, 0);
                addjob(L, a1, 64, D, 64, mix + 4 * D, l1 + (size_t)(128 + d * 64) * 2048 + 1024, 2048, 64, 1024, 0, NOGRP, 0);
            }
            const float* v1 = (j == 1) ? a.in[I_V1] : nullptr;
            addjob(L, v1, 32, D, 32, nullptr, l1 + (size_t)256 * 2048, 2048, 64, 1024, 0, NOGRP, 0);
            addjob(L, v1, 32, D, 32, mix + 3 * D, l1 + (size_t)256 * 2048 + 1024, 2048, 64, 1024, 0, NOGRP, 0);
            addjob(L, a.in[I_G1] + (size_t)j * D * 160, 160, D, 160, nullptr, l1 + (size_t)320 * 2048, 2048, 192, 1024, 0, NOGRP, 0);
            addjob(L, a.in[I_G1] + (size_t)j * D * 160, 160, D, 160, mix + 5 * D, l1 + (size_t)320 * 2048 + 1024, 2048, 192, 1024, 0, NOGRP, 0);
            for (int d = 0; d < 2; ++d) {
                addjob(L, a.in[I_W2] + (size_t)(j * 2 + d) * 64 * D, D, 64, D, nullptr, l2a + (size_t)(d * 1024) * 256, 256, 1024, 256, d * 64, NOGRP, 0);
                addjob(L, a.in[I_A2] + (size_t)(j * 2 + d) * 64 * D, D, 64, D, nullptr, l2a + (size_t)(2048 + d * 1024) * 256, 256, 1024, 256, 128 + d * 64, NOGRP, 0);
            }
            addjob(L, a.in[I_G2] + (size_t)j * 160 * D, D, 160, D, nullptr, l2b, 256, 1024, 256, 64, NOGRP, 0);
            addjob(L, (j == 1) ? a.in[I_V2] : nullptr, D, 32, D, nullptr, l2b + (size_t)1024 * 256, 256, 1024, 256, 0, NOGRP, 0);
        }
        {
            bf16_t* w = wffn(a, j);
            addjob(L, a.in[I_F1] + (size_t)j * D * DFF, DFF, D, DFF, nullptr, w, 1024, DFF, 1024, 0, 128, 256);
            addjob(L, a.in[I_F3] + (size_t)j * D * DFF, DFF, D, DFF, nullptr, w + (size_t)128 * 1024, 1024, DFF, 1024, 0, 128, 256);
            addjob(L, a.in[I_F2] + (size_t)j * DFF * D, D, DFF, D, nullptr, w + E_F13, DFF, 1024, DFF, 0, NOGRP, 0);
        }
    }
}
__device__ __forceinline__ void jobs_moe(const Args& a, JobList& L, int k) {
    bf16_t* w13 = (bf16_t*)(a.ws + WS_ARENA + A_WM13); bf16_t* w2 = (bf16_t*)(a.ws + WS_ARENA + A_WM2);
#pragma unroll 1
    for (int e = 0; e < NE; ++e) {
        const size_t so = (size_t)(k * NE + e) * D * DFE;
        addjob(L, a.in[I_M1] + so, DFE, D, DFE, nullptr, w13 + (size_t)e * E_M13, 1024, DFE, 1024, 0, 128, 256);
        addjob(L, a.in[I_M3] + so, DFE, D, DFE, nullptr, w13 + (size_t)e * E_M13 + (size_t)128 * 1024, 1024, DFE, 1024, 0, 128, 256);
        addjob(L, a.in[I_M2] + so, D, DFE, D, nullptr, w2 + (size_t)e * E_M2, DFE, 1024, DFE, 0, NOGRP, 0);
    }
}
__device__ __forceinline__ void run_prep(const Args& a, LAS unsigned char* jl, int which  , int j0  , int G, int c) {
    const int tid = ltid();
    LAS Job* jobs = (LAS Job*)jl; LAS int* hdr = (LAS int*)(jl + MAXJOB * sizeof(Job)); LAS float* tile = (LAS float*)(jl + MAXJOB * sizeof(Job) + 64);
    if (tid == 0) { JobList L{jobs, 0, 0, launder_s(0)}; if (which < 0) jobs_small(a, L); else jobs_moe(a, L, which); hdr[0] = L.n + L.z; hdr[1] = L.tiles + L.z; }
    __syncthreads();
    const int nj = hdr[0], ntile = hdr[1];
    const int kl = tid >> 4, nq = (tid & 15) * 4, sn = tid >> 3, sk = (tid & 7) * 8;
    int jcur = 0;
#define PREP_BAR() do { asm volatile("s_waitcnt lgkmcnt(0)" ::: "memory"); __builtin_amdgcn_s_barrier(); asm volatile("" ::: "memory"); } while (0)
    f32x4 vcur[2], vnxt[2];
#define PREP_FETCH(t_, dstv) do { while (jcur + 1 < nj && jobs[jcur + 1].tile0 <= (t_)) ++jcur; const LAS Job* J_ = jobs + jcur; \
        const float* src_ = J_->src; const float* ks_ = J_->kscale; const int sld_ = J_->sld, srcK_ = J_->srcK, srcN_ = J_->srcN, koff_ = J_->koff, tn_ = J_->tn, tl_ = (t_) - J_->tile0; \
        const int n0_ = (tl_ % tn_) * 64, k0_ = (tl_ / tn_) * 64; \
        _Pragma("unroll") for (int p = 0; p < 2; ++p) { const int kk = k0_ + kl + 32 * p, ksi = kk - koff_, n = n0_ + nq; f32x4 v = (f32x4){0.f, 0.f, 0.f, 0.f}; \
            if (src_ != nullptr && ksi >= 0 && ksi < srcK_ && n < srcN_) { v = *(const __attribute__((address_space(1))) f32x4*)(src_ + (size_t)ksi * sld_ + n); if (ks_) v = v * *(const __attribute__((address_space(1))) float*)(ks_ + ksi); } dstv[p] = v; } } while (0)
    int t = c + j0 * G;
    if (t < ntile) PREP_FETCH(t, vcur);
    for (; t < ntile; t += G) {
        const int jthis = jcur;
        if (t + G < ntile) PREP_FETCH(t + G, vnxt);
        const LAS Job* J = jobs + jthis;
        bf16_t* __restrict__ dst = J->dst;
        const int ldd = J->ldd, Nd = J->Nd, grp = J->grp, gstride = J->gstride, tn = J->tn, tl = t - J->tile0;
        const int n0 = (tl % tn) * 64, k0 = (tl / tn) * 64;
#pragma unroll
        for (int p = 0; p < 2; ++p) { LAS float* tp = tile + (kl + 32 * p) * 65 + nq; tp[0] = vcur[p][0]; tp[1] = vcur[p][1]; tp[2] = vcur[p][2]; tp[3] = vcur[p][3]; }
        PREP_BAR();
        { const int n = n0 + sn;
            if (n < Nd) { float f[8];
#pragma unroll
                for (int e = 0; e < 8; ++e) f[e] = tile[(sk + e) * 65 + sn];
                const int dr = (n / grp) * gstride + (n % grp);
                *(__attribute__((address_space(1))) u32x4*)(dst + (size_t)dr * ldd + k0 + sk) = pack8(f); } }
        PREP_BAR();
        vcur[0] = vnxt[0]; vcur[1] = vnxt[1];
    }
#undef PREP_FETCH
#undef PREP_BAR
    asm volatile("s_waitcnt vmcnt(0)" ::: "memory"); __syncthreads();
}

__device__ __forceinline__ void prologue_misc(const Args& a, LAS unsigned char* lds, int G, int c) {
    const int tid = ltid();
    if (c == 0) { float* rt = (float*)(a.ws + WS_ROPE);
      for (int i = tid; i < 1024; i += NTHR) { const int pos = i >> 4, j = i & 15; const double inv = 1.0 / pow(10000.0, (double)j / 16.0), ang = (double)pos * inv; rt[i] = (float)cos(ang); rt[1024 + i] = (float)sin(ang); } }
    LAS float* sc = (LAS float*)lds;
    LAS float* red = (LAS float*)(lds + 49152);
    for (int i = tid; i < 1024 * 12; i += NTHR) { const int k = i / 12, m = i % 12; float v = 0.f;
        if (m < 9) { const float x = (m < 8) ? a.in[I_C][m * D + k] : a.in[I_CCTX][k]; v = x / (1.0f + expf(-x)); } sc[i] = v; }
    __syncthreads();
    const int kq = tid >> 6, col = tid & 63;
    for (int u = c; u < 4 * 96; u += G) {
        const int layer = u / 96, n0 = (u % 96) * 64;
        const float* w = a.in[I_ADAW] + (size_t)layer * D * 6144 + n0 + col;
        float acc[9];
#pragma unroll
        for (int m = 0; m < 9; ++m) acc[m] = 0.f;
        for (int k8 = 0; k8 < 128; k8 += 8) {
            float wv[8];
#pragma unroll
            for (int e = 0; e < 8; ++e) wv[e] = w[(size_t)(kq * 128 + k8 + e) * 6144];
#pragma unroll
            for (int e = 0; e < 8; ++e) { const LAS f32x4* sp = (const LAS f32x4*)(sc + (kq * 128 + k8 + e) * 12); const f32x4 s0 = sp[0], s1 = sp[1], s2 = sp[2];
                acc[0] += s0[0] * wv[e]; acc[1] += s0[1] * wv[e]; acc[2] += s0[2] * wv[e]; acc[3] += s0[3] * wv[e];
                acc[4] += s1[0] * wv[e]; acc[5] += s1[1] * wv[e]; acc[6] += s1[2] * wv[e]; acc[7] += s1[3] * wv[e]; acc[8] += s2[0] * wv[e]; }
        }
#pragma unroll
        for (int m = 0; m < 9; ++m) red[(kq * 9 + m) * 64 + col] = acc[m];
        __syncthreads();
        for (int i = tid; i < 9 * 64; i += NTHR) { const int m = i >> 6, cc = i & 63; float s = 0.f;
#pragma unroll
            for (int q = 0; q < 8; ++q) s += red[(q * 9 + m) * 64 + cc];
            ((float*)(a.ws + WS_MODS))[(size_t)(layer * 9 + m) * 6144 + n0 + cc] = s + a.in[I_ADAB][layer * 6144 + n0 + cc]; }
        __syncthreads();
    }
}

struct RowParams { float A[16], Bv[16]; int mi; };
__device__ __forceinline__ void load_params(const Args& a, RowParams& P, int layer, int mi, const float* gain, int which, int lane) {
    const float* sh = mods_ptr(a, layer, mi, which); const float* scl = mods_ptr(a, layer, mi, which + 1);
#pragma unroll
    for (int j = 0; j < 2; ++j) { const int col = j * 512 + lane * 8;
#pragma unroll
        for (int q = 0; q < 2; ++q) { const f32x4 g = *(const f32x4*)(gain + col + 4 * q), s = *(const f32x4*)(scl + col + 4 * q), t = *(const f32x4*)(sh + col + 4 * q);
#pragma unroll
            for (int e = 0; e < 4; ++e) { P.A[j * 8 + q * 4 + e] = g[e] * (1.0f + s[e]); P.Bv[j * 8 + q * 4 + e] = t[e]; } } }
    P.mi = mi;
}
__device__ __forceinline__ void load_x16(const float* xp, int lane, float (&x)[16]) {
#pragma unroll
    for (int j = 0; j < 2; ++j)
#pragma unroll
        for (int q = 0; q < 2; ++q) { const f32x4 v = *(const f32x4*)(xp + j * 512 + lane * 8 + 4 * q); x[j * 8 + q * 4 + 0] = v[0]; x[j * 8 + q * 4 + 1] = v[1]; x[j * 8 + q * 4 + 2] = v[2]; x[j * 8 + q * 4 + 3] = v[3]; }
}
__device__ __forceinline__ void store_bf16_row(bf16_t* p, int lane, const float (&h)[16]) {
#pragma unroll
    for (int j = 0; j < 2; ++j) { u32x4 w; w.x = cvt_pk_bf16(h[j * 8 + 0], h[j * 8 + 1]); w.y = cvt_pk_bf16(h[j * 8 + 2], h[j * 8 + 3]); w.z = cvt_pk_bf16(h[j * 8 + 4], h[j * 8 + 5]); w.w = cvt_pk_bf16(h[j * 8 + 6], h[j * 8 + 7]);
        *(u32x4*)(p + j * 512 + lane * 8) = w; }
}
__device__ __forceinline__ void moe_combine16(const Args& a, int row, int layer_prev, int lane, float (&x)[16]) {
    const u32x4 rt = *(const u32x4*)(a.ws + WS_ROUTE + (size_t)row * 16);
    const int e0 = (int)rt[0];
    if (e0 < 0) return;
    const float p0 = __uint_as_float(rt[2]), p1 = __uint_as_float(rt[3]);
    const int* sl = (const int*)(a.ws + WS_RSLOT) + (size_t)row * 2; const int s0 = sl[0], s1 = sl[1];
    const bf16_t* y2 = (const bf16_t*)(a.ws + WS_ARENA + A_Y2);
    const float* g5 = mods_ptr(a, layer_prev, mod_index(row), 5);
    const MoeSplit sp = moe_split(((const int*)(a.ws + WS_META))[8]);
    const int x0 = (s0 >> 8) >= sp.nMf ? sp.S : 1, x1 = (s1 >> 8) >= sp.nMf ? sp.S : 1;
    const size_t o0 = ((size_t)(XP0 + (s0 >> 8) - sp.nMf) * 256 + (s0 & 255)) * 1024, o1 = ((size_t)(XP0 + (s1 >> 8) - sp.nMf) * 256 + (s1 & 255)) * 1024, ostep = (size_t)sp.nT * 256 * 1024;
#pragma unroll
    for (int j = 0; j < 2; ++j) { const int col = j * 512 + lane * 8; float ya[8], yb[8];
        unpack8(*(const u32x4*)(y2 + (size_t)s0 * 1024 + col), ya); unpack8(*(const u32x4*)(y2 + (size_t)s1 * 1024 + col), yb);
        for (int sl = 1; sl < x0; ++sl) { float t[8]; unpack8(*(const u32x4*)(y2 + o0 + (size_t)(sl - 1) * ostep + col), t);
#pragma unroll
            for (int e = 0; e < 8; ++e) ya[e] += t[e]; }
        for (int sl = 1; sl < x1; ++sl) { float t[8]; unpack8(*(const u32x4*)(y2 + o1 + (size_t)(sl - 1) * ostep + col), t);
#pragma unroll
            for (int e = 0; e < 8; ++e) yb[e] += t[e]; }
        const f32x4 g0 = *(const f32x4*)(g5 + col), g1 = *(const f32x4*)(g5 + col + 4);
#pragma unroll
        for (int e = 0; e < 8; ++e) x[j * 8 + e] += (e < 4 ? g0[e] : g1[e - 4]) * (p0 * ya[e] + p1 * yb[e]); }
}
__device__ __forceinline__ void store_x16(float* xp, int lane, const float (&x)[16]) {
#pragma unroll
    for (int j = 0; j < 2; ++j)
#pragma unroll
        for (int q = 0; q < 2; ++q) *(f32x4*)(xp + j * 512 + lane * 8 + 4 * q) = (f32x4){x[j * 8 + q * 4], x[j * 8 + q * 4 + 1], x[j * 8 + q * 4 + 2], x[j * 8 + q * 4 + 3]};
}
__device__ __forceinline__ void norm_row(const float (&x)[16], const RowParams& P, float (&h)[16]) {
    float ss = 0.f;
#pragma unroll
    for (int e = 0; e < 16; ++e) ss += x[e] * x[e];
    ss = wave_sum(ss);
    const float rstd = 1.0f / sqrtf(ss * (1.0f / 1024.0f) + NORM_EPS);
#pragma unroll
    for (int e = 0; e < 16; ++e) h[e] = x[e] * rstd * P.A[e] + P.Bv[e];
}
__device__ __forceinline__ void wave_rows(int G, int c, int& r0, int& r1) {
    const int nw = G * NWAVE, per = (R + nw - 1) / nw, gw = c * NWAVE + (ltid() >> 6);
    r0 = gw * per; r1 = r0 + per; if (r0 > R) r0 = R; if (r1 > R) r1 = R;
}
template <bool COMBINE, bool FIRST = false>
__device__ __forceinline__ void norm_plain(const Args& a, int layer, const float* gain, int which, bf16_t* Hout, int G, int c) {
    const int lane = ltid() & 63; int r0, r1; wave_rows(G, c, r0, r1);
    RowParams P; P.mi = -1;
    for (int row = r0; row < r1; ++row) {
        const int mi = mod_index(row); if (mi != P.mi) load_params(a, P, layer, mi, gain, which, lane);
        float* xp = xrow(a, row); float x[16], h[16]; load_x16(FIRST ? xrow_in(a, row) : xp, lane, x);
        if (COMBINE) { moe_combine16(a, row, layer - 1, lane, x); store_x16(xp, lane, x); }
        norm_row(x, P, h); store_bf16_row(Hout + (size_t)row * 1024, lane, h);
    }
}
__device__ __forceinline__ bool seg_first(int row) { const int r = row % SEG; return r == 0 || r == CTX; }
__device__ __forceinline__ bool seg_last(int row) { const int r = row % SEG; return r == CTX - 1 || r == SEG - 1; }
__device__ __forceinline__ void norm_mix(const Args& a, int layer, int j, int G, int c) {
    const int lane = ltid() & 63; int r0, r1; wave_rows(G, c, r0, r1); if (r0 >= r1) return;
    const float* gain = a.in[I_N1G] + layer * D; const float* mix = a.in[I_MIX] + (size_t)j * 6 * D;
    bf16_t* AX = (bf16_t*)(a.ws + WS_ARENA + A_AX);
    float mr[16], mk[16], mv[16];
#pragma unroll
    for (int jj = 0; jj < 2; ++jj)
#pragma unroll
        for (int e = 0; e < 8; ++e) { const int col = jj * 512 + lane * 8 + e; mr[jj * 8 + e] = mix[col]; mk[jj * 8 + e] = mix[2 * D + col]; mv[jj * 8 + e] = mix[3 * D + col]; }
    RowParams P; P.mi = -1;
    float hp[16], hc[16], hn[16], x[16];
    if (!seg_first(r0)) { const int mi = mod_index(r0 - 1); if (mi != P.mi) load_params(a, P, layer, mi, gain, 0, lane); load_x16(xrow(a, r0 - 1), lane, x); norm_row(x, P, hp); }
    else {
#pragma unroll
        for (int e = 0; e < 16; ++e) hp[e] = 0.f; }
    { const int mi = mod_index(r0); if (mi != P.mi) load_params(a, P, layer, mi, gain, 0, lane); load_x16(xrow(a, r0), lane, x); norm_row(x, P, hc); }
    if (r0 + 1 < R) load_x16(xrow(a, r0 + 1), lane, x);
    for (int row = r0; row < r1; ++row) {
        float xq[16];
        if (row + 2 < R && row + 1 < r1) load_x16(xrow(a, row + 2), lane, xq);
        if (row + 1 < R) { const int mi = mod_index(row + 1); if (mi != P.mi) load_params(a, P, layer, mi, gain, 0, lane); norm_row(x, P, hn); }
        else {
#pragma unroll
            for (int e = 0; e < 16; ++e) hn[e] = 0.f; }
#pragma unroll
        for (int e = 0; e < 16; ++e) x[e] = xq[e];
        const float fp = seg_first(row) ? 0.f : 0.5f, fn = seg_last(row) ? 0.f : 0.5f;
        float xx[16], t[16];
#pragma unroll
        for (int e = 0; e < 16; ++e) xx[e] = fp * hp[e] + fn * hn[e] - hc[e];
        bf16_t* o = AX + (size_t)row * 5120;
        store_bf16_row(o, lane, hc); store_bf16_row(o + 1024, lane, xx);
#pragma unroll
        for (int e = 0; e < 16; ++e) t[e] = hc[e] + xx[e] * mr[e];
        store_bf16_row(o + 2048, lane, t);
#pragma unroll
        for (int e = 0; e < 16; ++e) t[e] = hc[e] + xx[e] * mk[e];
        store_bf16_row(o + 3072, lane, t);
#pragma unroll
        for (int e = 0; e < 16; ++e) t[e] = hc[e] + xx[e] * mv[e];
        store_bf16_row(o + 4096, lane, t);
#pragma unroll
        for (int e = 0; e < 16; ++e) { hp[e] = hc[e]; hc[e] = hn[e]; }
    }
}
__device__ __forceinline__ void norm_router(const Args& a, int layer, int k, bool last, LAS unsigned char* lds, int G, int c) {
    const int tid = ltid(), lane = tid & 63; int r0, r1; wave_rows(G, c, r0, r1);
    LAS float* rw = (LAS float*)lds;
    { const float* rsrc = a.in[I_ROUTER] + (size_t)k * D * NE; for (int i = tid; i < D * NE; i += NTHR) rw[i] = rsrc[i]; }
    __syncthreads();
    const float* gain = a.in[I_N2G] + layer * D;
    bf16_t* Hout = (bf16_t*)(a.ws + WS_ARENA + A_H);
    RowParams P; P.mi = -1;
    int hist[8];
#pragma unroll
    for (int e = 0; e < 8; ++e) hist[e] = 0;
    for (int row = r0; row < r1; ++row) {
        const int mi = mod_index(row); if (mi != P.mi) load_params(a, P, layer, mi, gain, 3, lane);
        float x[16], h[16]; load_x16(xrow(a, row), lane, x); norm_row(x, P, h); store_bf16_row(Hout + (size_t)row * 1024, lane, h);
        const bool routed = !(last && mi == 8);
        float lg[8];
#pragma unroll
        for (int e = 0; e < 8; ++e) lg[e] = 0.f;
#pragma unroll
        for (int jj = 0; jj < 2; ++jj)
#pragma unroll
            for (int q = 0; q < 8; ++q) { const LAS f32x4* rp = (const LAS f32x4*)(rw + (jj * 512 + lane * 8 + q) * 8); const f32x4 w0 = rp[0], w1 = rp[1]; const float hv = h[jj * 8 + q];
                lg[0] += hv * w0[0]; lg[1] += hv * w0[1]; lg[2] += hv * w0[2]; lg[3] += hv * w0[3]; lg[4] += hv * w1[0]; lg[5] += hv * w1[1]; lg[6] += hv * w1[2]; lg[7] += hv * w1[3]; }
#pragma unroll
        for (int e = 0; e < 8; ++e) lg[e] = wave_sum(lg[e]);
        int e0 = 0; float v0 = lg[0];
#pragma unroll
        for (int e = 1; e < 8; ++e) if (lg[e] > v0) { v0 = lg[e]; e0 = e; }
        int e1 = -1; float v1 = -3.0e38f;
#pragma unroll
        for (int e = 0; e < 8; ++e) if (e != e0 && lg[e] > v1) { v1 = lg[e]; e1 = e; }
        const float p0 = 1.0f / (1.0f + expf(v1 - v0)), p1 = 1.0f - p0;
        if (routed) {
#pragma unroll
            for (int e = 0; e < 8; ++e) hist[e] += (e == e0 || e == e1) ? 1 : 0; }
        if (lane == 0) *(u32x4*)(a.ws + WS_ROUTE + (size_t)row * 16) = (u32x4){(unsigned)(routed ? e0 : -1), (unsigned)(routed ? e1 : -1), __float_as_uint(p0), __float_as_uint(p1)};
    }
    const int gw = c * NWAVE + (tid >> 6);
    if (lane == 0) { int* hp = (int*)(a.ws + WS_HIST) + (size_t)gw * 8;
#pragma unroll
        for (int e = 0; e < 8; ++e) hp[e] = hist[e]; }
}

__device__ __forceinline__ void mla_stats(const Args& a, int G, int c) {
    const int lane = ltid() & 63; int r0, r1; wave_rows(G, c, r0, r1);
    const bf16_t* QKVA = (const bf16_t*)(a.ws + WS_ARENA + A_QKVA); float* rs = (float*)(a.ws + WS_RS);
    for (int row = r0; row < r1; ++row) {
        float sq = 0.f, skv = 0.f; float f[8];
        if (lane < 48) { unpack8(*(const u32x4*)(QKVA + (size_t)row * 768 + lane * 8), f);
#pragma unroll
            for (int e = 0; e < 8; ++e) sq += f[e] * f[e]; }
        if (lane < 32) { unpack8(*(const u32x4*)(QKVA + (size_t)row * 768 + 384 + lane * 8), f);
#pragma unroll
            for (int e = 0; e < 8; ++e) skv += f[e] * f[e]; }
        sq = wave_sum(sq); skv = wave_sum(skv);
        if (lane == 0) { rs[row] = 1.0f / sqrtf(sq * (1.0f / 384.0f) + NORM_EPS); rs[R + row] = 1.0f / sqrtf(skv * (1.0f / 256.0f) + NORM_EPS); }
    }
}
__device__ __forceinline__ void mla_qkpost(const Args& a, int j, int G, int c) {
    const int lane = ltid() & 63, hd = lane >> 3, sub = lane & 7; int r0, r1; wave_rows(G, c, r0, r1);
    bf16_t* Q = (bf16_t*)(a.ws + WS_ARENA + A_Q); const bf16_t* KV = (const bf16_t*)(a.ws + WS_ARENA + A_KV); const bf16_t* QKVA = (const bf16_t*)(a.ws + WS_ARENA + A_QKVA);
    bf16_t* K = (bf16_t*)(a.ws + WS_ARENA + A_K); const float* rt = (const float*)(a.ws + WS_ROPE);
    float gq[3][8], gk[3][8];
#pragma unroll
    for (int cc = 0; cc < 3; ++cc)
#pragma unroll
        for (int e = 0; e < 8; ++e) { gq[cc][e] = a.in[I_QN][j * QKH + cc * 64 + sub * 8 + e]; gk[cc][e] = a.in[I_KN][j * QKH + cc * 64 + sub * 8 + e]; }
    const float sgn = (sub & 2) ? 1.0f : -1.0f;
    for (int row = r0; row < r1; ++row) {
        const int r = row % SEG; const bool lat = r >= CTX; const int t = r - CTX, pos = (sub & 4) ? (t & 63) : (t >> 6);
        float cs[8], sn[8];
        if (lat) {
#pragma unroll
            for (int q = 0; q < 2; ++q) { const f32x4 cv = *(const f32x4*)(rt + pos * 16 + (sub & 1) * 8 + 4 * q), sv = *(const f32x4*)(rt + 1024 + pos * 16 + (sub & 1) * 8 + 4 * q);
#pragma unroll
                for (int e = 0; e < 4; ++e) { cs[q * 4 + e] = cv[e]; sn[q * 4 + e] = sv[e]; } } }
        float v[3][8];
        bf16_t* qp = Q + (size_t)row * 1536 + hd * QKH + sub * 8;
#pragma unroll
        for (int cc = 0; cc < 3; ++cc) unpack8(*(const u32x4*)(qp + cc * 64), v[cc]);
        { float ss = 0.f;
#pragma unroll
          for (int cc = 0; cc < 3; ++cc)
#pragma unroll
              for (int e = 0; e < 8; ++e) ss += v[cc][e] * v[cc][e];
          ss = red8(ss); const float rstd = 1.0f / sqrtf(ss * (1.0f / 192.0f) + NORM_EPS);
#pragma unroll
          for (int cc = 0; cc < 3; ++cc)
#pragma unroll
              for (int e = 0; e < 8; ++e) v[cc][e] = v[cc][e] * rstd * gq[cc][e];
          if (lat) {
#pragma unroll
              for (int e = 0; e < 8; ++e) { const float pr = __shfl_xor(v[2][e], 2); v[2][e] = v[2][e] * cs[e] + sgn * pr * sn[e]; } }
#pragma unroll
          for (int cc = 0; cc < 3; ++cc) {
#pragma unroll
              for (int e = 0; e < 8; ++e) v[cc][e] *= QSCALE;
              *(u32x4*)(qp + cc * 64) = pack8(v[cc]); } }
        const bf16_t* kp = KV + (size_t)row * 2048 + hd * 256 + sub * 8;
        unpack8(*(const u32x4*)(kp), v[0]); unpack8(*(const u32x4*)(kp + 64), v[1]); unpack8(*(const u32x4*)(QKVA + (size_t)row * 768 + 640 + sub * 8), v[2]);
        { float ss = 0.f;
#pragma unroll
          for (int cc = 0; cc < 3; ++cc)
#pragma unroll
              for (int e = 0; e < 8; ++e) ss += v[cc][e] * v[cc][e];
          ss = red8(ss); const float rstd = 1.0f / sqrtf(ss * (1.0f / 192.0f) + NORM_EPS);
#pragma unroll
          for (int cc = 0; cc < 3; ++cc)
#pragma unroll
              for (int e = 0; e < 8; ++e) v[cc][e] = v[cc][e] * rstd * gk[cc][e];
          if (lat) {
#pragma unroll
              for (int e = 0; e < 8; ++e) { const float pr = __shfl_xor(v[2][e], 2); v[2][e] = v[2][e] * cs[e] + sgn * pr * sn[e]; } }
          bf16_t* ko = K + (size_t)row * 1536 + hd * QKH + sub * 8;
#pragma unroll
          for (int cc = 0; cc < 3; ++cc) *(u32x4*)(ko + cc * 64) = pack8(v[cc]); }
    }
}

namespace att {
constexpr int KVBLK = 64, KROWB = 384;
constexpr int SHM_V = KVBLK * 128 * 2, SHM_K = KVBLK * KROWB;
constexpr int SHM_ATTN = 2 * SHM_V + 2 * SHM_K + NWAVE * 64 * 4;
constexpr float THR = 11.5f;
#define KSWZ(row, colB) ((row) * att::KROWB + ((colB) ^ (((row) & 7) << 4)))
#define SBAR() __builtin_amdgcn_sched_barrier(0)
__device__ __forceinline__ int crow(int r, int hi) { return (r & 3) + 8 * (r >> 2) + 4 * hi; }
__device__ __forceinline__ void partialSM(f32x16& p0, f32x16& p1, float& m_reg, float& mn, float& alpha) {
    float pmax = p0[0];
#pragma unroll
    for (int r = 1; r < 16; ++r) pmax = fmaxf(pmax, p0[r]);
#pragma unroll
    for (int r = 0; r < 16; ++r) pmax = fmaxf(pmax, p1[r]);
    { auto rr = __builtin_amdgcn_permlane32_swap(__float_as_uint(pmax), __float_as_uint(pmax), false, false); pmax = fmaxf(__uint_as_float(rr[0]), __uint_as_float(rr[1])); }
    if (__builtin_expect(__all(pmax - m_reg <= THR), 1)) { mn = m_reg; alpha = 1.f; }
    else { mn = fmaxf(m_reg, pmax); alpha = __builtin_amdgcn_exp2f(m_reg - mn); m_reg = mn; }
#pragma unroll
    for (int r = 0; r < 16; ++r) { p0[r] -= mn; p1[r] -= mn; }
#pragma unroll
    for (int r = 0; r < 16; ++r) p0[r] = __builtin_amdgcn_exp2f(p0[r]);
}
__device__ __forceinline__ void finishSM(f32x16& p0, f32x16& p1, float alpha, float& l_reg, bf16x8& pa0, bf16x8& pa1, bf16x8& pa2, bf16x8& pa3) {
#pragma unroll
    for (int r = 0; r < 16; ++r) p1[r] = __builtin_amdgcn_exp2f(p1[r]);
    float ps = 0;
#pragma unroll
    for (int r = 0; r < 16; ++r) ps += p0[r];
#pragma unroll
    for (int r = 0; r < 16; ++r) ps += p1[r];
    { auto rr = __builtin_amdgcn_permlane32_swap(__float_as_uint(ps), __float_as_uint(ps), false, false); ps = __uint_as_float(rr[0]) + __uint_as_float(rr[1]); }
    l_reg = l_reg * alpha + ps;
#define PK4(P, BASE, OUT) do { unsigned a0 = cvt_pk_bf16(P[BASE + 0], P[BASE + 1]), a1 = cvt_pk_bf16(P[BASE + 2], P[BASE + 3]);   \
    unsigned b0 = cvt_pk_bf16(P[BASE + 4], P[BASE + 5]), b1 = cvt_pk_bf16(P[BASE + 6], P[BASE + 7]);                              \
    auto r0 = __builtin_amdgcn_permlane32_swap(a0, b0, false, false); auto r1 = __builtin_amdgcn_permlane32_swap(a1, b1, false, false); \
    u32x4 w = {r0[0], r1[0], r0[1], r1[1]}; OUT = *reinterpret_cast<bf16x8*>(&w); } while (0)
    PK4(p0, 0, pa0); PK4(p0, 8, pa1); PK4(p1, 0, pa2); PK4(p1, 8, pa3);
#undef PK4
}
__device__ __forceinline__ void qkt(f32x16& p0, f32x16& p1, const char* Ks, const bf16x8* qr, int r32, int hi) {
    p0 = f32x16{}; p1 = f32x16{};
    bf16x8 ka[4], kb[4];
#define QK_LD(buf, g) do { _Pragma("unroll") for (int q_ = 0; q_ < 2; ++q_) { const int cb_ = ((2 * (g) + q_) * 16 + hi * 8) * 2; \
        buf[2 * q_] = *reinterpret_cast<const bf16x8*>(Ks + KSWZ(r32, cb_)); buf[2 * q_ + 1] = *reinterpret_cast<const bf16x8*>(Ks + KSWZ(32 + r32, cb_)); } } while (0)
#define QK_MM(buf, g) do { _Pragma("unroll") for (int q_ = 0; q_ < 2; ++q_) { p0 = __builtin_amdgcn_mfma_f32_32x32x16_bf16(buf[2 * q_], qr[2 * (g) + q_], p0, 0, 0, 0); \
        p1 = __builtin_amdgcn_mfma_f32_32x32x16_bf16(buf[2 * q_ + 1], qr[2 * (g) + q_], p1, 0, 0, 0); } } while (0)
    QK_LD(ka, 0); SBAR();
    QK_LD(kb, 1); SBAR(); QK_MM(ka, 0); SBAR();
    QK_LD(ka, 2); SBAR(); QK_MM(kb, 1); SBAR();
    QK_LD(kb, 3); SBAR(); QK_MM(ka, 2); SBAR();
    QK_LD(ka, 4); SBAR(); QK_MM(kb, 3); SBAR();
    QK_LD(kb, 5); SBAR(); QK_MM(ka, 4); SBAR();
    QK_MM(kb, 5); SBAR();
#undef QK_LD
#undef QK_MM
}
__device__ __forceinline__ int v_st(int k, int c) { const int kk = (k & ~0xC) | ((k & 4) << 1) | ((k & 8) >> 1); return ((kk >> 3) * 4 + (c >> 5)) * 512 + ((kk & 7) * 32 + (c & 31)) * 2; }
__device__ __forceinline__ int v_rd_base(int lane) { return ((lane & 3) << 3) | (((lane >> 2) & 3) << 6) | (((lane >> 4) & 1) << 5) | (((lane >> 5) & 1) << 8); }
constexpr int v_rd_off(int d0, int ks, int half) { return d0 * 512 + ks * 4096 + half * 2048; }
template <int OFF> __device__ __forceinline__ s16x4 tr_read(int vb) { s16x4 r; asm volatile("ds_read_b64_tr_b16 %0, %1 offset:%2" : "=&v"(r) : "v"(vb), "i"(OFF) : "memory"); return r; }
struct VFrag { s16x4 l0, h0, l1, h1, l2, h2, l3, h3; };
template <int D0> __device__ __forceinline__ void pv_issue(VFrag& f, int vb) {
    f.l0 = tr_read<v_rd_off(D0, 0, 0)>(vb); f.h0 = tr_read<v_rd_off(D0, 0, 1)>(vb); f.l1 = tr_read<v_rd_off(D0, 1, 0)>(vb); f.h1 = tr_read<v_rd_off(D0, 1, 1)>(vb);
    f.l2 = tr_read<v_rd_off(D0, 2, 0)>(vb); f.h2 = tr_read<v_rd_off(D0, 2, 1)>(vb); f.l3 = tr_read<v_rd_off(D0, 3, 0)>(vb); f.h3 = tr_read<v_rd_off(D0, 3, 1)>(vb);
}
__device__ __forceinline__ void pv_mma(f32x16& od, const VFrag& f, bf16x8 pa0, bf16x8 pa1, bf16x8 pa2, bf16x8 pa3) {
#define PK(L, H) (bf16x8){L[0], L[1], L[2], L[3], H[0], H[1], H[2], H[3]}
    od = __builtin_amdgcn_mfma_f32_32x32x16_bf16(pa0, PK(f.l0, f.h0), od, 0, 0, 0);
    od = __builtin_amdgcn_mfma_f32_32x32x16_bf16(pa1, PK(f.l1, f.h1), od, 0, 0, 0);
    od = __builtin_amdgcn_mfma_f32_32x32x16_bf16(pa2, PK(f.l2, f.h2), od, 0, 0, 0);
    od = __builtin_amdgcn_mfma_f32_32x32x16_bf16(pa3, PK(f.l3, f.h3), od, 0, 0, 0);
#undef PK
}
__device__ __forceinline__ void pv_d0(f32x16* o, int vb, bf16x8 pa0, bf16x8 pa1, bf16x8 pa2, bf16x8 pa3) {
    VFrag fa, fb;
    pv_issue<0>(fa, vb); pv_issue<1>(fb, vb);
    asm volatile("s_waitcnt lgkmcnt(8)" ::: "memory"); SBAR(); pv_mma(o[0], fa, pa0, pa1, pa2, pa3); SBAR();
    pv_issue<2>(fa, vb);
    asm volatile("s_waitcnt lgkmcnt(8)" ::: "memory"); SBAR(); pv_mma(o[1], fb, pa0, pa1, pa2, pa3); SBAR();
    pv_issue<3>(fb, vb);
    asm volatile("s_waitcnt lgkmcnt(8)" ::: "memory"); SBAR(); pv_mma(o[2], fa, pa0, pa1, pa2, pa3); SBAR();
    asm volatile("s_waitcnt lgkmcnt(0)" ::: "memory"); SBAR(); pv_mma(o[3], fb, pa0, pa1, pa2, pa3);
}
__device__ __forceinline__ void attn_unit(const bf16_t* __restrict__ Qb, const bf16_t* __restrict__ Kh, const bf16_t* __restrict__ Vh, bf16_t* __restrict__ Ob, int seq, char* lds) {
    constexpr int LDQ = 1536, LDK = 1536, LDV = 2048, LDO = 1024;
    const int tid = ltid(), wid = tid >> 6, lane = tid & 63, r32 = lane & 31, hi = lane >> 5;
    char* V_lds = lds; char* K_lds = lds + 2 * SHM_V;
    float* wsp = (float*)(lds + 2 * SHM_V + 2 * SHM_K) + wid * 64; float* li_l = wsp; float* al_l = wsp + 32;
    float m_reg = -1e30f, l_reg = 0; f32x16 o[4] = {}; bf16x8 qr[12];
    const bf16_t* Qw = Qb + (long)(wid * 32 + r32) * LDQ + hi * 8;
#pragma unroll
    for (int d0 = 0; d0 < 12; ++d0) qr[d0] = *(const __attribute__((address_space(1))) bf16x8*)((const __attribute__((address_space(1))) bf16_t*)Qw + d0 * 16);
    const int sr = tid >> 4, sc = (tid & 15) * 8, vst0 = v_st(sr, sc), vst1 = v_st(32 + sr, sc);
    int kkey[3], kcb[3];
#pragma unroll
    for (int i = 0; i < 3; ++i) { const int ci = tid + i * 512; kkey[i] = ci / 24; kcb[i] = (ci % 24) * 16; }
    const int vb0 = (int)(uintptr_t)(LAS char*)V_lds + v_rd_base(lane);
    bf16x8 vs0, vs1, ks0, ks1, ks2;
#define GAS __attribute__((address_space(1)))
#define SLOAD(k0) do { vs0 = *(const GAS bf16x8*)((const GAS bf16_t*)Vh + (long)((k0) + sr) * LDV + sc); vs1 = *(const GAS bf16x8*)((const GAS bf16_t*)Vh + (long)((k0) + 32 + sr) * LDV + sc); \
    ks0 = *(const GAS bf16x8*)((const GAS char*)Kh + (long)((k0) + kkey[0]) * (LDK * 2) + kcb[0]); ks1 = *(const GAS bf16x8*)((const GAS char*)Kh + (long)((k0) + kkey[1]) * (LDK * 2) + kcb[1]); \
    ks2 = *(const GAS bf16x8*)((const GAS char*)Kh + (long)((k0) + kkey[2]) * (LDK * 2) + kcb[2]); } while (0)
#define SWRITE(b) do { *(bf16x8*)(V_lds + (b) * SHM_V + vst0) = vs0; *(bf16x8*)(V_lds + (b) * SHM_V + vst1) = vs1; \
    *(bf16x8*)(K_lds + (b) * SHM_K + KSWZ(kkey[0], kcb[0])) = ks0; *(bf16x8*)(K_lds + (b) * SHM_K + KSWZ(kkey[1], kcb[1])) = ks1; *(bf16x8*)(K_lds + (b) * SHM_K + KSWZ(kkey[2], kcb[2])) = ks2; } while (0)
#define SWAIT() asm volatile("s_waitcnt vmcnt(0)" ::: "memory")
#define RESC(al) do { if (__any((al) < 1.f)) { if (hi == 0) al_l[r32] = (al); asm volatile("s_waitcnt lgkmcnt(0)" ::: "memory"); \
    _Pragma("unroll") for (int d = 0; d < 4; ++d) _Pragma("unroll") for (int r = 0; r < 16; ++r) o[d][r] *= al_l[crow(r, hi)]; } } while (0)
    f32x16 p0, p1; float mn, al; bf16x8 pa0, pa1, pa2, pa3; const int NT = seq / KVBLK;
    SLOAD(0); SWAIT(); SWRITE(0); __syncthreads();
    for (int j = 0; j < NT; ++j) {
        const int bsel = j & 1;
        if (j + 1 < NT) SLOAD((j + 1) * KVBLK);
        SBAR(); qkt(p0, p1, K_lds + bsel * SHM_K, qr, r32, hi);
        partialSM(p0, p1, m_reg, mn, al);
        RESC(al);
        finishSM(p0, p1, al, l_reg, pa0, pa1, pa2, pa3); SBAR();
        pv_d0(o, vb0 + bsel * SHM_V, pa0, pa1, pa2, pa3);
        if (j + 1 < NT) { SWAIT(); SWRITE(bsel ^ 1); }
        __syncthreads();
    }
    if (hi == 0) li_l[r32] = l_reg; asm volatile("s_waitcnt lgkmcnt(0)" ::: "memory");
    float rli[16];
#pragma unroll
    for (int r = 0; r < 16; ++r) rli[r] = __builtin_amdgcn_rcpf(li_l[crow(r, hi)]);
    bf16_t* Ow = Ob + (long)(wid * 32) * LDO;
#pragma unroll
    for (int r = 0; r < 16; ++r) { const int orow = crow(r, hi);
#pragma unroll
        for (int d0 = 0; d0 < 4; ++d0) { const float val = o[d0][r] * rli[r]; ((__attribute__((address_space(1))) bf16_t*)Ow)[(long)orow * LDO + d0 * 32 + r32] = (bf16_t)(cvt_pk_bf16(val, val) & 0xffffu); } }
    __syncthreads();
#undef SLOAD
#undef SWRITE
#undef SWAIT
#undef RESC
}
}
__device__ __forceinline__ void attn_phase(const Args& a, LAS unsigned char* lds, int G, int c) {
    const bf16_t* Q = (const bf16_t*)(a.ws + WS_ARENA + A_Q); const bf16_t* K = (const bf16_t*)(a.ws + WS_ARENA + A_K); const bf16_t* KV = (const bf16_t*)(a.ws + WS_ARENA + A_KV);
    bf16_t* O = (bf16_t*)(a.ws + WS_ARENA + A_O);
    const int vcu = (G % 8 == 0) ? (c % 8) * (G / 8) + c / 8 : c;
    for (int L = vcu; L < 1024 + 64; L += G) {
        int b, h, q0, seq;
        if (L < 1024) { b = L >> 7; h = (L >> 4) & 7; q0 = CTX + (L & 15) * 256; seq = SEG; } else { const int l2 = L - 1024; b = l2 >> 3; h = l2 & 7; q0 = 0; seq = CTX; }
        const size_t rb = (size_t)b * SEG;
        att::attn_unit(Q + (rb + q0) * 1536 + h * QKH, K + rb * 1536 + h * QKH, KV + rb * 2048 + h * 256 + 128, O + (rb + q0) * 1024 + h * VH, seq, (char*)lds);
    }
}

namespace scan {
constexpr int CH = 32, STEP_B = 6 * 256, BUF_B = CH * STEP_B  , YB_B = CH * 64 * 4  , LDS_B = 2 * BUF_B + 2 * YB_B  , NCH = SEG / CH  ;
constexpr int TILE_B = 64 * 65 * 4, MT_TILES = 24 * 896;
struct MTile { const float* src; bf16_t* dst; int sld, ldd, n0, k0, grpd; };
__device__ __forceinline__ int step_row(int b, int dir, int gs) {
    const int base = b * SEG;
    if (dir == 0) return base + gs;
    return gs < CTX ? base + (CTX - 1 - gs) : base + CTX + (SEG - 1 - gs);
}
struct Raw { u32x4 k, r, v, wl, al, vf, vl; };
}
__device__ __forceinline__ bool moe_tile(const Args& a, int k, int t, scan::MTile& m) {
    if (CS_NOTILE || t >= scan::MT_TILES) return false;
    const int j = t / 896, tl = t - j * 896, e = j / 3, kind = j - e * 3; int tn;
    const size_t so = (size_t)(k * NE + e) * D * DFE;
    if (kind < 2) { m.src = a.in[kind == 0 ? I_M1 : I_M3] + so; m.sld = DFE; m.dst = (bf16_t*)(a.ws + WS_ARENA + A_WM13) + (size_t)e * E_M13 + (kind ? (size_t)128 * 1024 : 0); m.ldd = 1024; tn = 56; m.grpd = 1; }
    else { m.src = a.in[I_M2] + so; m.sld = D; m.dst = (bf16_t*)(a.ws + WS_ARENA + A_WM2) + (size_t)e * E_M2; m.ldd = DFE; tn = 16; m.grpd = 0; }
    m.n0 = (tl % tn) * 64; m.k0 = (tl / tn) * 64; return true;
}
__device__ __forceinline__ void scan_phase(const Args& a, int j, const bf16_t* Vsrc, const bool vres, LAS unsigned char* lds, int G, int c) {
    using namespace scan;
    int mt_round = 0;
    const int tid = ltid(), wave = tid >> 6, lane = tid & 63;
    const bf16_t* RR = (const bf16_t*)(a.ws + WS_ARENA + A_RR); const bf16_t* RK = (const bf16_t*)(a.ws + WS_ARENA + A_RK);
    for (int chain = c; chain < 256; chain += G) {
        const int b = chain >> 5, h = (chain >> 1) & 15, dir = chain & 1;
        const bf16_t* WL = (const bf16_t*)(a.ws + WS_ARENA + (dir ? A_WL1 : A_WL0)); const bf16_t* AL = (const bf16_t*)(a.ws + WS_ARENA + (dir ? A_AL1 : A_AL0));
        bf16_t* Y = (bf16_t*)(a.ws + WS_ARENA + (dir ? A_YR : A_YF));
        if (wave >= 4) {
            const int pt = tid - 256, s = pt >> 3, seg = pt & 7, ch0 = h * 64 + seg * 8;
            float kkp[8], kap[8], v0p[8];
            const bf16_t* VFp = (const bf16_t*)(a.ws + WS_VF); const bf16_t* VLp = (const bf16_t*)(a.ws + WS_ARENA + A_VL);
#pragma unroll
            for (int e = 0; e < 8; ++e) v0p[e] = vres ? a.in[I_V0][ch0 + e] : 0.f;
#pragma unroll
            for (int e = 0; e < 8; ++e) { kkp[e] = a.in[I_KK][(size_t)j * D + ch0 + e]; kap[e] = a.in[I_KA][(size_t)j * D + ch0 + e]; }
            Raw raw;
#define GLOAD(q) do { const size_t off_ = (size_t)step_row(b, dir, (q) * CH + s) * 1024 + ch0; \
                raw.k = *(const u32x4*)(RK + off_); raw.r = *(const u32x4*)(RR + off_); raw.v = *(const u32x4*)(Vsrc + off_); raw.wl = *(const u32x4*)(WL + off_); raw.al = *(const u32x4*)(AL + off_); \
                if (vres) { raw.vf = *(const u32x4*)(VFp + off_); raw.vl = *(const u32x4*)(VLp + off_); } } while (0)
#define PRODUCE(buf) do { \
                float k[8], r[8], v[8], wl[8], al[8]; unpack8(raw.k, k); unpack8(raw.r, r); unpack8(raw.v, v); unpack8(raw.wl, wl); unpack8(raw.al, al); \
                if (vres) { float vf[8], vl[8]; unpack8(raw.vf, vf); unpack8(raw.vl, vl); _Pragma("unroll") for (int e = 0; e < 8; ++e) v[e] = v[e] + (vf[e] - v[e]) * sigmoidf_(v0p[e] + vl[e]); } \
                float ad[8], kd[8], kk[8], ww[8], ss = 0.f; \
                _Pragma("unroll") for (int e = 0; e < 8; ++e) { ad[e] = al[e]; kd[e] = k[e] * (1.0f + (ad[e] - 1.0f) * kap[e]); kk[e] = k[e] * kkp[e]; ss += kk[e] * kk[e]; \
                    ww[e] = __expf(-wl[e]); } \
                ss = red8(ss); const float inv = 1.0f / fmaxf(sqrtf(ss), 1e-12f); \
                LAS f32x4* o = (LAS f32x4*)(lds + (buf) * BUF_B + s * STEP_B + seg * 32); \
                _Pragma("unroll") for (int e = 0; e < 8; ++e) kk[e] *= inv; \
                o[0] = (f32x4){ww[0], ww[1], ww[2], ww[3]}; o[1] = (f32x4){ww[4], ww[5], ww[6], ww[7]}; \
                o[16] = (f32x4){kd[0], kd[1], kd[2], kd[3]}; o[17] = (f32x4){kd[4], kd[5], kd[6], kd[7]}; \
                o[32] = (f32x4){-kk[0], -kk[1], -kk[2], -kk[3]}; o[33] = (f32x4){-kk[4], -kk[5], -kk[6], -kk[7]}; \
                o[48] = (f32x4){kk[0] * ad[0], kk[1] * ad[1], kk[2] * ad[2], kk[3] * ad[3]}; o[49] = (f32x4){kk[4] * ad[4], kk[5] * ad[5], kk[6] * ad[6], kk[7] * ad[7]}; \
                o[64] = (f32x4){r[0], r[1], r[2], r[3]}; o[65] = (f32x4){r[4], r[5], r[6], r[7]}; \
                o[80] = (f32x4){v[0], v[1], v[2], v[3]}; o[81] = (f32x4){v[4], v[5], v[6], v[7]}; } while (0)
#define YSTORE(q) do { const LAS f32x4* yp = (const LAS f32x4*)(lds + 2 * BUF_B + ((q) & 1) * YB_B + s * 256 + seg * 32); const f32x4 y0 = yp[0], y1 = yp[1]; \
                u32x4 w; w.x = cvt_pk_bf16(y0[0], y0[1]); w.y = cvt_pk_bf16(y0[2], y0[3]); w.z = cvt_pk_bf16(y1[0], y1[1]); w.w = cvt_pk_bf16(y1[2], y1[3]); \
                *(u32x4*)(Y + (size_t)step_row(b, dir, (q) * CH + s) * 1024 + ch0) = w; } while (0)
            GLOAD(0); PRODUCE(0); GLOAD(1);
            __syncthreads();
            f32x4 treg[4]; const int kl = pt >> 4, nq = (pt & 15) * 4, sn = pt >> 2, sk = (pt & 3) * 16;
            for (int q = 0; q < NCH; ++q) {
                if (q + 1 < NCH) { PRODUCE((q + 1) & 1); if (q + 2 < NCH) GLOAD(q + 2); }
                if (q >= 1) YSTORE(q - 1);
                MTile m;
                if (q >= 2 && moe_tile(a, j, c + (mt_round + q - 2) * G, m)) {
                    const LAS float* tl_ = (const LAS float*)(lds + LDS_B + (q & 1) * TILE_B); float f0[8], f1[8];
#pragma unroll
                    for (int e = 0; e < 8; ++e) { f0[e] = tl_[(sk + e) * 65 + sn]; f1[e] = tl_[(sk + 8 + e) * 65 + sn]; }
                    const int n = m.n0 + sn, dr = m.grpd ? ((n >> 7) * 256 + (n & 127)) : n; bf16_t* dp = m.dst + (size_t)dr * m.ldd + m.k0 + sk;
                    *(u32x4*)dp = pack8(f0); *(u32x4*)(dp + 8) = pack8(f1); }
                if (q >= 1 && q <= NCH - 2 && moe_tile(a, j, c + (mt_round + q - 1) * G, m)) {
                    LAS float* tl_ = (LAS float*)(lds + LDS_B + ((q - 1) & 1) * TILE_B);
#pragma unroll
                    for (int p = 0; p < 4; ++p) { LAS float* tp = tl_ + (kl + 16 * p) * 65 + nq; tp[0] = treg[p][0]; tp[1] = treg[p][1]; tp[2] = treg[p][2]; tp[3] = treg[p][3]; } }
                if (q <= NCH - 3 && moe_tile(a, j, c + (mt_round + q) * G, m)) {
#pragma unroll
                    for (int p = 0; p < 4; ++p) treg[p] = *(const f32x4*)(m.src + (size_t)(m.k0 + kl + 16 * p) * m.sld + m.n0 + nq); }
                __syncthreads();
            }
            YSTORE(NCH - 1);
#undef GLOAD
#undef PRODUCE
#undef YSTORE
        } else {
            const int rp = lane >> 3, ks = lane & 7, v0i = wave * 16 + rp * 2;
            f32x2 s0[4], s1[4];
#pragma unroll
            for (int i = 0; i < 4; ++i) { s0[i] = (f32x2){0.f, 0.f}; s1[i] = (f32x2){0.f, 0.f}; }
            __syncthreads();
            struct Vecs { f32x4 w0, w1, k0, k1, a0, a1, b0, b1, r0, r1; f32x2 vv; };
#define LOADV(V, t) do { const LAS f32x4* p_ = (const LAS f32x4*)(bp + (t) * STEP_B); V.w0 = p_[0]; V.w1 = p_[1]; V.k0 = p_[16]; V.k1 = p_[17]; V.a0 = p_[32]; V.a1 = p_[33]; \
                    V.b0 = p_[48]; V.b1 = p_[49]; V.r0 = p_[64]; V.r1 = p_[65]; V.vv = *(const LAS f32x2*)(vp + (t) * STEP_B); } while (0)
#define STEPV(V, t, HAVEPREV) do { \
                    const f32x2 wv[4] = {{V.w0[0], V.w0[1]}, {V.w0[2], V.w0[3]}, {V.w1[0], V.w1[1]}, {V.w1[2], V.w1[3]}}, kv[4] = {{V.k0[0], V.k0[1]}, {V.k0[2], V.k0[3]}, {V.k1[0], V.k1[1]}, {V.k1[2], V.k1[3]}}; \
                    const f32x2 av[4] = {{V.a0[0], V.a0[1]}, {V.a0[2], V.a0[3]}, {V.a1[0], V.a1[1]}, {V.a1[2], V.a1[3]}}, bv[4] = {{V.b0[0], V.b0[1]}, {V.b0[2], V.b0[3]}, {V.b1[0], V.b1[1]}, {V.b1[2], V.b1[3]}}; \
                    const f32x2 rv[4] = {{V.r0[0], V.r0[1]}, {V.r0[2], V.r0[3]}, {V.r1[0], V.r1[1]}, {V.r1[2], V.r1[3]}}; \
                    f32x2 d0 = s0[0] * av[0], d1 = s1[0] * av[0]; \
                    d0 += s0[1] * av[1]; d1 += s1[1] * av[1]; d0 += s0[2] * av[2]; d1 += s1[2] * av[2]; d0 += s0[3] * av[3]; d1 += s1[3] * av[3]; \
                    float h0 = d0.x + d0.y, h1 = d1.x + d1.y; \
                    h0 += dpp_f<0xB1>(h0); h1 += dpp_f<0xB1>(h1); yp0 += dpp_f<0xB1>(yp0); yp1 += dpp_f<0xB1>(yp1); \
                    h0 += dpp_f<0x4E>(h0); h1 += dpp_f<0x4E>(h1); yp0 += dpp_f<0x4E>(yp0); yp1 += dpp_f<0x4E>(yp1); \
                    h0 += dpp_f<0x141>(h0); h1 += dpp_f<0x141>(h1); yp0 += dpp_f<0x141>(yp0); yp1 += dpp_f<0x141>(yp1); \
                    if (HAVEPREV) yb[((t) - 1) * 64 + v0i + (ks & 1)] = (ks & 1) ? yp1 : yp0; \
                    const f32x2 sa0v = {h0, h0}, sa1v = {h1, h1}, v0v = {V.vv.x, V.vv.x}, v1v = {V.vv.y, V.vv.y}; \
                    _Pragma("unroll") for (int i = 0; i < 4; ++i) { s0[i] = s0[i] * wv[i] + sa0v * bv[i] + v0v * kv[i]; s1[i] = s1[i] * wv[i] + sa1v * bv[i] + v1v * kv[i]; } \
                    f32x2 y0 = s0[0] * rv[0], y1 = s1[0] * rv[0]; \
                    y0 += s0[1] * rv[1]; y1 += s1[1] * rv[1]; y0 += s0[2] * rv[2]; y1 += s1[2] * rv[2]; y0 += s0[3] * rv[3]; y1 += s1[3] * rv[3]; \
                    yp0 = y0.x + y0.y; yp1 = y1.x + y1.y; } while (0)
            for (int q = 0; q < NCH; ++q) {
                const LAS unsigned char* bp = lds + (q & 1) * BUF_B + ks * 32;
                const LAS unsigned char* vp = lds + (q & 1) * BUF_B + 5 * 256 + v0i * 4;
                LAS float* yb = (LAS float*)(lds + 2 * BUF_B + (q & 1) * YB_B);
                Vecs VA, VB; float yp0 = 0.f, yp1 = 0.f;
                LOADV(VA, 0); LOADV(VB, 1);
                STEPV(VA, 0, false);
                LOADV(VA, 2);
                STEPV(VB, 1, true);
#pragma unroll 1
                for (int t = 2; t < CH; t += 2) {
                    LOADV(VB, t + 1);
                    STEPV(VA, t, true);
                    LOADV(VA, t + 2);
                    STEPV(VB, t + 1, true);
                }
                yp0 = red8(yp0); yp1 = red8(yp1);
                yb[(CH - 1) * 64 + v0i + (ks & 1)] = (ks & 1) ? yp1 : yp0;
                __syncthreads();
            }
#undef LOADV
#undef STEPV
        }
        mt_round += NCH - 2;
        __syncthreads();
    }
}

namespace cs {
constexpr int C = 32, NCK = SEG / C;
constexpr int TM = 72, CM = 40, TMB = TM * 2, CMB = CM * 2;
constexpr int SZ_TM = 32 * TMB, SZ_CM = 64 * CMB, SZ_C32 = 32 * CMB;
constexpr int X_ATM = 0, X_RTM = SZ_TM, X_BHTM = 2 * SZ_TM, X_KHTM = 3 * SZ_TM, X_ACM = 4 * SZ_TM, X_RCM = X_ACM + SZ_CM, X_BBCM = X_RCM + SZ_CM, X_KBCM = X_BBCM + SZ_CM, X_B = X_KBCM + SZ_CM;
constexpr int Y_VCM = 0, Y_GC = SZ_CM, Y_B = SZ_CM + 256;
constexpr int OFF_X = 0, OFF_Y = 2 * X_B, OFF_MID = OFF_Y + 2 * Y_B;
constexpr int M_NL = 0, M_NR = SZ_C32, M_TT = 2 * SZ_C32, M_ARBT = 3 * SZ_C32, M_AAK = 4 * SZ_C32, M_UP = 5 * SZ_C32, M_W = 6 * SZ_C32, M_ARK = M_W + SZ_CM, MID_B = M_ARK + 4096;
constexpr int OFF_OUT = OFF_MID + MID_B;
constexpr int O_PST = 0, O_QST = 64 * TMB, O_PYT = O_QST + SZ_CM, O_QYT = O_PYT + SZ_TM, OUT_B = O_QYT + SZ_C32;
constexpr int OFF_YB = OFF_OUT + OUT_B, OFF_ES = OFF_YB + 8192, OFF_WT = OFF_ES + 2048, LDS_END = OFF_WT + 64 * 65 * 4;
__device__ __forceinline__ int rho(int r, int h) { return (r & 3) + 8 * (r >> 2) + 4 * h; }
__device__ __forceinline__ int perm16(int k) { return (k & ~0xC) | ((k & 4) << 1) | ((k & 8) >> 1); }
typedef __bf16 bf16v2 __attribute__((ext_vector_type(2)));
__device__ __forceinline__ unsigned cvt_pk_bf16_c(float lo, float hi) { const bf16v2 v = __builtin_convertvector((f32x2){lo, hi}, bf16v2); return __builtin_bit_cast(unsigned, v); }
__device__ __forceinline__ bf16_t f2bf(float x) { const __bf16 b = (__bf16)x; return __builtin_bit_cast(bf16_t, b); }
__device__ __forceinline__ float bf2f(bf16_t x) { return __uint_as_float((unsigned)x << 16); }
template <int KS> __device__ __forceinline__ void mma32t(f32x16& acc, const LAS unsigned char* A, int lda, const LAS unsigned char* B, int ldb, int r32, int h) {
    bf16x8 a[KS], b[KS];
#pragma unroll
    for (int s = 0; s < KS; ++s) { a[s] = *(const LAS bf16x8*)(A + r32 * lda + s * 32 + h * 16); b[s] = *(const LAS bf16x8*)(B + r32 * ldb + s * 32 + h * 16); }
#pragma unroll
    for (int s = 0; s < KS; ++s) acc = __builtin_amdgcn_mfma_f32_32x32x16_bf16(a[s], b[s], acc, 0, 0, 0);
}
__device__ __forceinline__ void mma32(f32x16& acc, const LAS unsigned char* A, int lda, const LAS unsigned char* B, int ldb, int ksteps, int r32, int h) {
    if (ksteps == 4) mma32t<4>(acc, A, lda, B, ldb, r32, h); else mma32t<2>(acc, A, lda, B, ldb, r32, h);
}
__device__ __forceinline__ void st_bf(const f32x16& acc, LAS unsigned char* dst, int sr, int sc, int r32, int h) {
#pragma unroll
    for (int r = 0; r < 16; ++r) *(LAS bf16_t*)(dst + rho(r, h) * sr + r32 * sc) = f2bf(acc[r]);
}
template <bool PERM> __device__ __forceinline__ void st_bf_T(const f32x16& acc, LAS unsigned char* dst, int sc, int r32, int h) {
#pragma unroll
    for (int m = 0; m < 4; ++m) { const int row0 = 8 * m + 4 * h, pos = PERM ? perm16(row0) : row0; u32x2 w; w.x = cvt_pk_bf16_c(acc[4 * m], acc[4 * m + 1]); w.y = cvt_pk_bf16_c(acc[4 * m + 2], acc[4 * m + 3]);
        *(LAS u32x2*)(dst + r32 * sc + pos * 2) = w; }
}
}
#define CS_BAR() do { asm volatile("s_waitcnt lgkmcnt(0)" ::: "memory"); __builtin_amdgcn_s_barrier(); asm volatile("" ::: "memory"); } while (0)
__device__ __forceinline__ void scan_chunked(const Args& a, int jl, const bf16_t* Vsrc, const bool vres, LAS unsigned char* lds, int G, int c) {
    using namespace cs;
    const int tid0 = ltid(), wave = __builtin_amdgcn_readfirstlane(tid0 >> 6);
    typedef const __attribute__((address_space(1))) bf16_t* gcp; typedef __attribute__((address_space(1))) bf16_t* gwp;
    gcp RR = (gcp)(a.ws + WS_ARENA + A_RR); gcp RK = (gcp)(a.ws + WS_ARENA + A_RK);
    gcp VFp = (gcp)(a.ws + WS_VF); gcp VLp = (gcp)(a.ws + WS_ARENA + A_VL); gcp Vg = (gcp)Vsrc;
    int mt0 = 0;
    for (int chain = c; chain < 256; chain += G) {
        const int b = chain >> 5, hd = (chain >> 1) & 15, dir = chain & 1;
        gcp WL = (gcp)(a.ws + WS_ARENA + (dir ? A_WL1 : A_WL0)); gcp AL = (gcp)(a.ws + WS_ARENA + (dir ? A_AL1 : A_AL0));
        gwp Y = (gwp)(a.ws + WS_ARENA + (dir ? A_YCR : A_YCF));
        const int gcol0 = hd * 64 + (tid0 & 63);
        const float kkp = a.in[I_KK][(size_t)jl * D + gcol0], kap = a.in[I_KA][(size_t)jl * D + gcol0], v0p = vres ? a.in[I_V0][gcol0] : 0.f;
        f32x16 S0 = {}, S1 = {};
        f32x4 wreg[8];
        constexpr int ntok = 4; const int tok0 = 4 * wave;
        bf16_t rk_[4], rr_[4], ra_[4], rv_[4], re_[4], rf_[4], rl_[4];
        bf16_t qk_[4], qr_[4], qa_[4], qv_[4], qe_[4], qf_[4], ql_[4];
#define CS_LOAD(q) do { _Pragma("unroll") for (int tk_ = 0; tk_ < 4; ++tk_) { const unsigned off_ = (unsigned)scan::step_row(b, dir, (q) * 32 + tok0 + tk_) * 1024u + (unsigned)gcol; \
                qk_[tk_] = RK[off_]; qr_[tk_] = RR[off_]; qa_[tk_] = AL[off_]; qe_[tk_] = WL[off_]; qv_[tk_] = Vg[off_]; if (vres) { qf_[tk_] = VFp[off_]; ql_[tk_] = VLp[off_]; } } } while (0)
#define CS_COPY() do { _Pragma("unroll") for (int tk_ = 0; tk_ < 4; ++tk_) { rk_[tk_] = qk_[tk_]; rr_[tk_] = qr_[tk_]; ra_[tk_] = qa_[tk_]; re_[tk_] = qe_[tk_]; rv_[tk_] = qv_[tk_]; rf_[tk_] = qf_[tk_]; rl_[tk_] = ql_[tk_]; } } while (0)
#define CS_ESUM() do { float es_ = 0.f; _Pragma("unroll") for (int tk_ = 0; tk_ < 4; ++tk_) es_ += bf2f(re_[tk_]); *(LAS float*)(lds + OFF_ES + wave * 256 + lane * 4) = es_; } while (0)
#define CS_MAIN(q) do { \
            LAS unsigned char* X_ = lds + OFF_X + ((q) & 1) * X_B; LAS unsigned char* Yb_ = lds + OFF_Y + ((q) & 1) * Y_B; \
            float before_ = 0.f, tot_ = 0.f; \
            _Pragma("unroll") for (int w_ = 0; w_ < 8; ++w_) { const float es_ = *(const LAS float*)(lds + OFF_ES + w_ * 256 + lane * 4); before_ += (w_ < wave) ? es_ : 0.f; tot_ += es_; } \
            float erun_ = __expf(-before_); const float gct_ = __expf(-tot_); \
            _Pragma("unroll") for (int p_ = 0; p_ < 2; ++p_) { const int t_ = tok0 + 2 * p_;            \
                const f32x2 kraw_ = {bf2f(rk_[2 * p_]), bf2f(rk_[2 * p_ + 1])}, rr2_ = {bf2f(rr_[2 * p_]), bf2f(rr_[2 * p_ + 1])}, ad_ = {bf2f(ra_[2 * p_]), bf2f(ra_[2 * p_ + 1])}; \
                f32x2 vv_ = {bf2f(rv_[2 * p_]), bf2f(rv_[2 * p_ + 1])}; \
                if (vres) { const f32x2 vf_ = {bf2f(rf_[2 * p_]), bf2f(rf_[2 * p_ + 1])}; const float s0_ = sigmoidf_(v0p + bf2f(rl_[2 * p_])), s1_ = sigmoidf_(v0p + bf2f(rl_[2 * p_ + 1])); \
                    vv_ = vv_ + (vf_ - vv_) * (f32x2){s0_, s1_}; } \
                const f32x2 kd_ = kraw_ * ((ad_ - 1.0f) * kap + 1.0f), kkr_ = kraw_ * kkp, sq_ = kkr_ * kkr_; \
                float s0 = sq_.x, s1 = sq_.y; \
                s0 += dpp_f<0xB1>(s0); s1 += dpp_f<0xB1>(s1); s0 += dpp_f<0x4E>(s0); s1 += dpp_f<0x4E>(s1); s0 += dpp_f<0x141>(s0); s1 += dpp_f<0x141>(s1); s0 += dpp_f<0x140>(s0); s1 += dpp_f<0x140>(s1); \
                const int i0_ = __float_as_int(s0), i1_ = __float_as_int(s1); \
                const float ss0_ = (__int_as_float(__builtin_amdgcn_readlane(i0_, 0)) + __int_as_float(__builtin_amdgcn_readlane(i0_, 16))) + (__int_as_float(__builtin_amdgcn_readlane(i0_, 32)) + __int_as_float(__builtin_amdgcn_readlane(i0_, 48))); \
                const float ss1_ = (__int_as_float(__builtin_amdgcn_readlane(i1_, 0)) + __int_as_float(__builtin_amdgcn_readlane(i1_, 16))) + (__int_as_float(__builtin_amdgcn_readlane(i1_, 32)) + __int_as_float(__builtin_amdgcn_readlane(i1_, 48))); \
                const f32x2 kk_ = kkr_ * (f32x2){__builtin_amdgcn_rsqf(fmaxf(ss0_, 1e-24f)), __builtin_amdgcn_rsqf(fmaxf(ss1_, 1e-24f))}; \
                const float w0_ = __expf(-bf2f(re_[2 * p_])), w1_ = __expf(-bf2f(re_[2 * p_ + 1])); \
                f32x2 E1_, E2_; E1_.x = erun_; E2_.x = erun_ * w0_; E1_.y = E2_.x; E2_.y = E2_.x * w1_; erun_ = E2_.y; \
                const f32x2 Ei_ = {__builtin_amdgcn_rcpf(E2_.x), __builtin_amdgcn_rcpf(E2_.y)}, E3_ = Ei_ * gct_, bv_ = kk_ * ad_; \
                const f32x2 at2_ = -(kk_ * E1_), rt2_ = rr2_ * E2_, bh2_ = bv_ * Ei_, kh2_ = kd_ * Ei_, kb2_ = kd_ * E3_, bb2_ = bv_ * E3_; \
                const unsigned pa_ = cvt_pk_bf16_c(at2_.x, at2_.y), pr_ = cvt_pk_bf16_c(rt2_.x, rt2_.y), pbh_ = cvt_pk_bf16_c(bh2_.x, bh2_.y), pkh_ = cvt_pk_bf16_c(kh2_.x, kh2_.y); \
                *(LAS unsigned*)(X_ + X_ACM + lane * CMB + t_ * 2) = pa_; *(LAS unsigned*)(X_ + X_RCM + lane * CMB + t_ * 2) = pr_; \
                *(LAS unsigned*)(X_ + X_KBCM + lane * CMB + t_ * 2) = cvt_pk_bf16_c(kb2_.x, kb2_.y); *(LAS unsigned*)(X_ + X_BBCM + lane * CMB + t_ * 2) = cvt_pk_bf16_c(bb2_.x, bb2_.y); \
                *(LAS unsigned*)(Yb_ + Y_VCM + lane * CMB + t_ * 2) = cvt_pk_bf16_c(vv_.x, vv_.y); \
                *(LAS bf16_t*)(X_ + X_ATM + t_ * TMB + lane * 2) = (bf16_t)pa_; *(LAS bf16_t*)(X_ + X_ATM + (t_ + 1) * TMB + lane * 2) = (bf16_t)(pa_ >> 16); \
                *(LAS bf16_t*)(X_ + X_RTM + t_ * TMB + lane * 2) = (bf16_t)pr_; *(LAS bf16_t*)(X_ + X_RTM + (t_ + 1) * TMB + lane * 2) = (bf16_t)(pr_ >> 16); \
                *(LAS bf16_t*)(X_ + X_BHTM + t_ * TMB + lane * 2) = (bf16_t)pbh_; *(LAS bf16_t*)(X_ + X_BHTM + (t_ + 1) * TMB + lane * 2) = (bf16_t)(pbh_ >> 16); \
                *(LAS bf16_t*)(X_ + X_KHTM + t_ * TMB + lane * 2) = (bf16_t)pkh_; *(LAS bf16_t*)(X_ + X_KHTM + (t_ + 1) * TMB + lane * 2) = (bf16_t)(pkh_ >> 16); } \
            if (wave == 7) *(LAS float*)(Yb_ + Y_GC + lane * 4) = gct_; } while (0)
        { const int tid = ltid(), lane = tid & 63, gcol = hd * 64 + lane;
          { CS_LOAD(0); CS_COPY(); CS_ESUM(); }
          CS_BAR();
          { CS_LOAD(1); CS_MAIN(0); } }
        CS_BAR();
        for (int it = -1; it < NCK; ++it) {
            const bool have_next = (it + 1 < NCK);
            const int tid = ltid(), lane = tid & 63, r32 = lane & 31, h = lane >> 5, gcol = hd * 64 + lane;
            LAS unsigned char* X = lds + OFF_X + ((it + 1) & 1) * X_B; LAS unsigned char* M = lds + OFF_MID; LAS unsigned char* O = lds + OFF_OUT;
            f32x16 acc = {}, accT = {};
            if (have_next && wave < 4) {
                if (wave == 0) {
                    bf16x8 fb[4], fa[4];
#pragma unroll
                    for (int s4 = 0; s4 < 4; ++s4) { fb[s4] = *(const LAS bf16x8*)(X + X_BHTM + r32 * TMB + s4 * 32 + h * 16); fa[s4] = *(const LAS bf16x8*)(X + X_ATM + r32 * TMB + s4 * 32 + h * 16); }
#pragma unroll
                    for (int s4 = 0; s4 < 4; ++s4) { acc = __builtin_amdgcn_mfma_f32_32x32x16_bf16(fb[s4], fa[s4], acc, 0, 0, 0); accT = __builtin_amdgcn_mfma_f32_32x32x16_bf16(fa[s4], fb[s4], accT, 0, 0, 0); }
#pragma unroll
                    for (int r = 0; r < 16; ++r) accT[r] = (r32 < rho(r, h)) ? accT[r] : 0.f; }
                else if (wave == 2) mma32(acc, X + X_ATM, TMB, X + X_KHTM, TMB, 4, r32, h);
                else mma32(acc, X + ((wave & 2) ? X_KHTM : X_BHTM), TMB, X + ((wave & 1) ? X_RTM : X_ATM), TMB, 4, r32, h);
#pragma unroll
                for (int r = 0; r < 16; ++r) { const int i = rho(r, h); const bool keep = (wave == 2) ? (r32 < i) : ((wave & 1) ? (i <= r32) : (i < r32)); acc[r] = keep ? acc[r] : 0.f; }
                if (wave == 0) { }
                else if (wave == 1) st_bf_T<false>(acc, M + M_ARBT, CMB, r32, h);
                else if (wave == 2) st_bf_T<false>(acc, M + M_AAK, CMB, r32, h);
                else {
#pragma unroll
                    for (int m = 0; m < 4; ++m) *(LAS f32x4*)(M + M_ARK + r32 * 128 + (8 * m + 4 * h) * 4) = (f32x4){acc[4 * m], acc[4 * m + 1], acc[4 * m + 2], acc[4 * m + 3]}; }
            }
            if (CS_SERIAL) CS_BAR();
            if (it >= 0 && wave >= 6) {
                const int vb = wave - 6; const LAS unsigned char* Yb = lds + OFF_Y + (it & 1) * Y_B;
                bf16x8 bs[4];
#pragma unroll
                for (int s = 0; s < 2; ++s) { u32x4 w0, w1;
                    w0.x = cvt_pk_bf16_c(S0[8 * s + 0], S0[8 * s + 1]); w0.y = cvt_pk_bf16_c(S0[8 * s + 2], S0[8 * s + 3]); w0.z = cvt_pk_bf16_c(S0[8 * s + 4], S0[8 * s + 5]); w0.w = cvt_pk_bf16_c(S0[8 * s + 6], S0[8 * s + 7]);
                    w1.x = cvt_pk_bf16_c(S1[8 * s + 0], S1[8 * s + 1]); w1.y = cvt_pk_bf16_c(S1[8 * s + 2], S1[8 * s + 3]); w1.z = cvt_pk_bf16_c(S1[8 * s + 4], S1[8 * s + 5]); w1.w = cvt_pk_bf16_c(S1[8 * s + 6], S1[8 * s + 7]);
                    bs[s] = *reinterpret_cast<bf16x8*>(&w0); bs[2 + s] = *reinterpret_cast<bf16x8*>(&w1); }
                const LAS unsigned char* Vr = Yb + Y_VCM + (vb * 32 + r32) * CMB + h * 16;
                const bf16x8 bv0 = *(const LAS bf16x8*)Vr, bv1 = *(const LAS bf16x8*)(Vr + 32);
                bf16x8 fy[6], fs[6];
#pragma unroll
                for (int s = 0; s < 4; ++s) { fy[s] = *(const LAS bf16x8*)(O + O_PYT + r32 * TMB + s * 32 + h * 16); fs[s] = *(const LAS bf16x8*)(O + O_PST + r32 * TMB + s * 32 + h * 16); }
#pragma unroll
                for (int s = 0; s < 2; ++s) { fy[4 + s] = *(const LAS bf16x8*)(O + O_QYT + r32 * CMB + s * 32 + h * 16); fs[4 + s] = *(const LAS bf16x8*)(O + O_QST + r32 * CMB + s * 32 + h * 16); }
                f32x16 n0, n1;
#pragma unroll
                for (int m = 0; m < 4; ++m) { const f32x4 g0 = *(const LAS f32x4*)(Yb + Y_GC + (8 * m + 4 * h) * 4), g1 = *(const LAS f32x4*)(Yb + Y_GC + (32 + 8 * m + 4 * h) * 4);
#pragma unroll
                    for (int i = 0; i < 4; ++i) { n0[4 * m + i] = S0[4 * m + i] * g0[i]; n1[4 * m + i] = S1[4 * m + i] * g1[i]; } }
                f32x16 ya = {};
#pragma unroll
                for (int s = 0; s < 4; ++s) { ya = __builtin_amdgcn_mfma_f32_32x32x16_bf16(fy[s], bs[s], ya, 0, 0, 0); n0 = __builtin_amdgcn_mfma_f32_32x32x16_bf16(fs[s], bs[s], n0, 0, 0, 0); }
                ya = __builtin_amdgcn_mfma_f32_32x32x16_bf16(fy[4], bv0, ya, 0, 0, 0); n0 = __builtin_amdgcn_mfma_f32_32x32x16_bf16(fs[4], bv0, n0, 0, 0, 0);
                ya = __builtin_amdgcn_mfma_f32_32x32x16_bf16(fy[5], bv1, ya, 0, 0, 0); n0 = __builtin_amdgcn_mfma_f32_32x32x16_bf16(fs[5], bv1, n0, 0, 0, 0);
#pragma unroll
                for (int s = 0; s < 4; ++s) fs[s] = *(const LAS bf16x8*)(O + O_PST + (32 + r32) * TMB + s * 32 + h * 16);
#pragma unroll
                for (int s = 0; s < 2; ++s) fs[4 + s] = *(const LAS bf16x8*)(O + O_QST + (32 + r32) * CMB + s * 32 + h * 16);
#pragma unroll
                for (int r = 0; r < 16; ++r) *(LAS float*)(lds + OFF_YB + rho(r, h) * 256 + (vb * 32 + r32) * 4) = ya[r];
#pragma unroll
                for (int s = 0; s < 4; ++s) n1 = __builtin_amdgcn_mfma_f32_32x32x16_bf16(fs[s], bs[s], n1, 0, 0, 0);
                n1 = __builtin_amdgcn_mfma_f32_32x32x16_bf16(fs[4], bv0, n1, 0, 0, 0); n1 = __builtin_amdgcn_mfma_f32_32x32x16_bf16(fs[5], bv1, n1, 0, 0, 0);
                S0 = n0; S1 = n1;
            }
            if (it + 2 < NCK) { CS_COPY(); CS_ESUM(); }
            if (wave == 4 || wave == 5) {
                const int pt = tid - 256; scan::MTile m;
                if (it >= 0 && it <= NCK - 2 && moe_tile(a, jl, c + (mt0 + it) * G, m)) {
                    const LAS float* tl_ = (const LAS float*)(lds + OFF_WT); const int sn = pt >> 1, sk = (pt & 1) * 32;
                    const int n = m.n0 + sn, dr = m.grpd ? ((n >> 7) * 256 + (n & 127)) : n; bf16_t* dp = m.dst + (size_t)dr * m.ldd + m.k0 + sk;
#pragma unroll
                    for (int q8 = 0; q8 < 4; ++q8) { float f[8];
#pragma unroll
                        for (int e = 0; e < 8; ++e) f[e] = tl_[(sk + q8 * 8 + e) * 65 + sn];
                        *(__attribute__((address_space(1))) u32x4*)(dp + q8 * 8) = pack8(f); } }
                if (it + 1 < NCK - 1 && moe_tile(a, jl, c + (mt0 + it + 1) * G, m)) { const int kl = pt >> 4, nq = (pt & 15) * 4;
#pragma unroll
                    for (int p8 = 0; p8 < 8; ++p8) wreg[p8] = *(const __attribute__((address_space(1))) f32x4*)(m.src + (size_t)(m.k0 + kl + 8 * p8) * m.sld + m.n0 + nq); }
            }
            CS_BAR();
            if (have_next && wave == 0) {
                f32x16 Tm = acc, Mm = acc, Mt = accT;
#pragma unroll
                for (int r = 0; r < 16; ++r) Tm[r] += (rho(r, h) == r32) ? 1.0f : 0.f;
#define CS_SLAB(tile, s) ({ u32x4 w_; w_.x = cvt_pk_bf16_c(tile[8 * (s) + 0], tile[8 * (s) + 1]); w_.y = cvt_pk_bf16_c(tile[8 * (s) + 2], tile[8 * (s) + 3]); \
                    w_.z = cvt_pk_bf16_c(tile[8 * (s) + 4], tile[8 * (s) + 5]); w_.w = cvt_pk_bf16_c(tile[8 * (s) + 6], tile[8 * (s) + 7]); *reinterpret_cast<bf16x8*>(&w_); })
                for (int lvl = 0; lvl < 4; ++lvl) {
                    const bf16x8 m0 = CS_SLAB(Mm, 0), m1 = CS_SLAB(Mm, 1), t0_ = CS_SLAB(Mt, 0), t1_ = CS_SLAB(Mt, 1);
                    f32x16 m2 = {}, m2t = {};
                    m2 = __builtin_amdgcn_mfma_f32_32x32x16_bf16(t0_, m0, m2, 0, 0, 0); m2t = __builtin_amdgcn_mfma_f32_32x32x16_bf16(m0, t0_, m2t, 0, 0, 0);
                    m2 = __builtin_amdgcn_mfma_f32_32x32x16_bf16(t1_, m1, m2, 0, 0, 0); m2t = __builtin_amdgcn_mfma_f32_32x32x16_bf16(m1, t1_, m2t, 0, 0, 0);
                    Mm = m2; Mt = m2t;
                    { const bf16x8 a0 = CS_SLAB(Mt, 0), a1 = CS_SLAB(Mt, 1), bt0 = CS_SLAB(Tm, 0), bt1 = CS_SLAB(Tm, 1);
                      Tm = __builtin_amdgcn_mfma_f32_32x32x16_bf16(a0, bt0, Tm, 0, 0, 0); Tm = __builtin_amdgcn_mfma_f32_32x32x16_bf16(a1, bt1, Tm, 0, 0, 0); }
                }
                st_bf_T<false>(Tm, M + M_TT, CMB, r32, h);
            }
            if (CS_SERIAL) CS_BAR();
            if (it + 3 < NCK) CS_LOAD(it + 3);
            if (it + 2 < NCK) CS_MAIN(it + 2);
            if (CS_SERIAL) CS_BAR();
            if (it >= 0 && wave >= 5) {
                for (int item = tid - 320; item < 256; item += 192) { const int t = item >> 3, seg = item & 7;
                    const LAS f32x4* yp = (const LAS f32x4*)(lds + OFF_YB + t * 256 + seg * 32); const f32x4 y0 = yp[0], y1 = yp[1];
                    u32x4 w; w.x = cvt_pk_bf16(y0[0], y0[1]); w.y = cvt_pk_bf16(y0[2], y0[3]); w.z = cvt_pk_bf16(y1[0], y1[1]); w.w = cvt_pk_bf16(y1[2], y1[3]);
                    *(__attribute__((address_space(1))) u32x4*)(Y + (size_t)scan::step_row(b, dir, it * 32 + t) * 1024 + hd * 64 + seg * 8) = w; }
            }
            CS_BAR();
            if (have_next && wave < 3) {
                f32x16 d = {};
                if (wave < 2) { mma32(d, M + M_TT, CMB, X + X_ACM + wave * 32 * CMB, CMB, 2, r32, h); st_bf_T<false>(d, M + M_W + wave * 32 * CMB, CMB, r32, h); }
                else { mma32(d, M + M_TT, CMB, M + M_AAK, CMB, 2, r32, h); st_bf_T<false>(d, M + M_UP, CMB, r32, h); }
            }
            if (wave == 4 || wave == 5) { const int pt = tid - 256, kl = pt >> 4, nq = (pt & 15) * 4; scan::MTile m;
                if (it + 1 < NCK - 1 && moe_tile(a, jl, c + (mt0 + it + 1) * G, m)) { LAS float* tl_ = (LAS float*)(lds + OFF_WT);
#pragma unroll
                    for (int p8 = 0; p8 < 8; ++p8) { LAS float* tp = tl_ + (kl + 8 * p8) * 65 + nq; tp[0] = wreg[p8][0]; tp[1] = wreg[p8][1]; tp[2] = wreg[p8][2]; tp[3] = wreg[p8][3]; } } }
            CS_BAR();
            if (have_next) {
                f32x16 d = {};
                if (wave < 4) { const int kt = wave & 1, kpt = wave >> 1;
                    mma32(d, M + M_W + kt * 32 * CMB, CMB, X + X_BBCM + kpt * 32 * CMB, CMB, 2, r32, h);
                    st_bf_T<true>(d, O + O_PST + kpt * 32 * TMB + kt * 64, TMB, r32, h); }
                else if (wave < 6) { const int kt = wave - 4;
                    u32x2 ra[4];
#pragma unroll
                    for (int m = 0; m < 4; ++m) ra[m] = *(const LAS u32x2*)(X + X_RTM + r32 * TMB + (kt * 32 + 8 * m + 4 * h) * 2);
                    mma32(d, M + M_W + kt * 32 * CMB, CMB, M + M_ARBT, CMB, 2, r32, h);
#pragma unroll
                    for (int m = 0; m < 4; ++m) { d[4 * m] += bflo(ra[m].x); d[4 * m + 1] += bfhi(ra[m].x); d[4 * m + 2] += bflo(ra[m].y); d[4 * m + 3] += bfhi(ra[m].y); }
                    st_bf_T<true>(d, O + O_PYT + kt * 64, TMB, r32, h); }
                else { const int kpt = wave - 6;
                    u32x2 ka[4];
#pragma unroll
                    for (int m = 0; m < 4; ++m) ka[m] = *(const LAS u32x2*)(X + X_KBCM + (kpt * 32 + r32) * CMB + (8 * m + 4 * h) * 2);
                    mma32(d, M + M_UP, CMB, X + X_BBCM + kpt * 32 * CMB, CMB, 2, r32, h);
#pragma unroll
                    for (int m = 0; m < 4; ++m) { d[4 * m] += bflo(ka[m].x); d[4 * m + 1] += bfhi(ka[m].x); d[4 * m + 2] += bflo(ka[m].y); d[4 * m + 3] += bfhi(ka[m].y); }
                    st_bf_T<false>(d, O + O_QST + kpt * 32 * CMB, CMB, r32, h);
                    if (wave == 7) { f32x16 e = {}; f32x4 aa[4];
#pragma unroll
                        for (int m = 0; m < 4; ++m) aa[m] = *(const LAS f32x4*)(M + M_ARK + r32 * 128 + (8 * m + 4 * h) * 4);
                        mma32(e, M + M_UP, CMB, M + M_ARBT, CMB, 2, r32, h);
#pragma unroll
                        for (int m = 0; m < 4; ++m) { e[4 * m] += aa[m][0]; e[4 * m + 1] += aa[m][1]; e[4 * m + 2] += aa[m][2]; e[4 * m + 3] += aa[m][3]; }
                        st_bf_T<false>(e, O + O_QYT, CMB, r32, h); } }
            }
            CS_BAR();
        }
#undef CS_LOAD
#undef CS_COPY
#undef CS_ESUM
#undef CS_MAIN
        mt0 += NCK - 1;
    }
}


__device__ __forceinline__ void scan_compare(const Args& a, LAS unsigned char* lds, int G, int c) {
    const int tid = ltid();
    asm volatile("s_waitcnt vmcnt(0)" ::: "memory"); __syncthreads();
    for (int chain = c; chain < 256; chain += G) {
        const int b = chain >> 5, hd = (chain >> 1) & 15, dir = chain & 1;
        const bf16_t* Yo = (const bf16_t*)(a.ws + WS_ARENA + (dir ? A_YR : A_YF)); const bf16_t* Yc = (const bf16_t*)(a.ws + WS_ARENA + (dir ? A_YCR : A_YCF));
        float md = 0.f, mo = 0.f;
        for (int i = tid; i < SEG * 8; i += NTHR) { const int r = i >> 3, seg = i & 7; const size_t off = (size_t)(b * SEG + r) * 1024 + hd * 64 + seg * 8;
            u32x4 wo, wc; const unsigned* po = (const unsigned*)(Yo + off); const unsigned* pc = (const unsigned*)(Yc + off);
#pragma unroll
            for (int q = 0; q < 4; ++q) { wo[q] = __hip_atomic_load(po + q, __ATOMIC_RELAXED, __HIP_MEMORY_SCOPE_AGENT); wc[q] = __hip_atomic_load(pc + q, __ATOMIC_RELAXED, __HIP_MEMORY_SCOPE_AGENT); }
            float yo[8], yc[8]; unpack8(wo, yo); unpack8(wc, yc);
#pragma unroll
            for (int e = 0; e < 8; ++e) { md = fmaxf(md, fabsf(yo[e] - yc[e])); mo = fmaxf(mo, fabsf(yo[e])); } }
#pragma unroll
        for (int o = 32; o >= 1; o >>= 1) { md = fmaxf(md, __shfl_xor(md, o)); mo = fmaxf(mo, __shfl_xor(mo, o)); }
        LAS float* red = (LAS float*)lds;
        if ((tid & 63) == 0) { red[(tid >> 6) * 2] = md; red[(tid >> 6) * 2 + 1] = mo; }
        __syncthreads();
        if (tid == 0) { float d = 0.f, o = 0.f; for (int w = 0; w < 8; ++w) { d = fmaxf(d, red[w * 2]); o = fmaxf(o, red[w * 2 + 1]); }
            if (!(d <= CS_TOL * o)) { bf16_t* Yw = (bf16_t*)(a.ws + WS_ARENA + (dir ? A_YR : A_YF)); Yw[(size_t)(b * SEG + CTX) * 1024 + hd * 64] = (bf16_t)0x7fc0u; } }
        __syncthreads();
    }
}

__device__ __forceinline__ void rwkv_outprep(const Args& a, int j, const bf16_t* Vsrc, const bool vres, int G, int c) {
    const int lane = ltid() & 63; int r0, r1; wave_rows(G, c, r0, r1);
    const bf16_t* YF = (const bf16_t*)(a.ws + WS_ARENA + A_YF); const bf16_t* YR = (const bf16_t*)(a.ws + WS_ARENA + A_YR);
    const bf16_t* RR = (const bf16_t*)(a.ws + WS_ARENA + A_RR); const bf16_t* RK = (const bf16_t*)(a.ws + WS_ARENA + A_RK);
    const bf16_t* AL0 = (const bf16_t*)(a.ws + WS_ARENA + A_AL0); const bf16_t* AL1 = (const bf16_t*)(a.ws + WS_ARENA + A_AL1); const bf16_t* GG = (const bf16_t*)(a.ws + WS_ARENA + A_G);
    bf16_t* O = (bf16_t*)(a.ws + WS_ARENA + A_RO);
    float lnw[16], lnb[16], rk[16], ka[16];
#pragma unroll
    for (int jj = 0; jj < 2; ++jj)
#pragma unroll
        for (int e = 0; e < 8; ++e) { const int col = jj * 512 + lane * 8 + e, i = jj * 8 + e; lnw[i] = a.in[I_LNW][j * D + col]; lnb[i] = a.in[I_LNB][j * D + col]; rk[i] = a.in[I_RK][j * D + col];
            ka[i] = a.in[I_KA][j * D + col]; }
    for (int row = r0; row < r1; ++row) {
        u32x4 out[2];
#pragma unroll
        for (int jj = 0; jj < 2; ++jj) { const size_t off = (size_t)row * 1024 + jj * 512 + lane * 8;
            float yf[8], yr[8], r[8], k[8], v[8], l0[8], l1[8], g[8], y[8];
            unpack8(*(const u32x4*)(YF + off), yf); unpack8(*(const u32x4*)(YR + off), yr); unpack8(*(const u32x4*)(RR + off), r); unpack8(*(const u32x4*)(RK + off), k);
            unpack8(*(const u32x4*)(Vsrc + off), v);
            if (vres) { float vf[8], vl[8]; unpack8(*(const u32x4*)((const bf16_t*)(a.ws + WS_VF) + off), vf); unpack8(*(const u32x4*)((const bf16_t*)(a.ws + WS_ARENA + A_VL) + off), vl);
#pragma unroll
                for (int e = 0; e < 8; ++e) v[e] = v[e] + (vf[e] - v[e]) * sigmoidf_(a.in[I_V0][jj * 512 + lane * 8 + e] + vl[e]); }
            unpack8(*(const u32x4*)(AL0 + off), l0); unpack8(*(const u32x4*)(AL1 + off), l1); unpack8(*(const u32x4*)(GG + off), g);
            float sm = 0.f, dot = 0.f;
#pragma unroll
            for (int e = 0; e < 8; ++e) { const int i = jj * 8 + e; y[e] = yf[e] + yr[e]; sm += y[e];
                const float adm = 0.5f * (l0[e] + l1[e]); const float kb = k[e] * (1.0f + (adm - 1.0f) * ka[i]); dot += r[e] * kb * rk[i]; }
            sm = red8(sm); dot = red8(dot); const float mu = sm * (1.0f / 64.0f); float var = 0.f;
#pragma unroll
            for (int e = 0; e < 8; ++e) { const float d = y[e] - mu; var += d * d; }
            var = red8(var) * (1.0f / 64.0f); const float rstd = 1.0f / sqrtf(var + LNX_EPS);
            float o[8];
#pragma unroll
            for (int e = 0; e < 8; ++e) { const int i = jj * 8 + e; o[e] = ((y[e] - mu) * rstd * lnw[i] + lnb[i] + dot * v[e]) * g[e]; }
            out[jj] = pack8(o); }
        *(u32x4*)(O + (size_t)row * 1024 + lane * 8) = out[0]; *(u32x4*)(O + (size_t)row * 1024 + 512 + lane * 8) = out[1];
    }
}

__device__ __forceinline__ void moe_gather(const Args& a, LAS unsigned char* lds, int G, int c) {
    const int tid = ltid(), wave = tid >> 6, lane = tid & 63; int r0, r1; wave_rows(G, c, r0, r1);
    LAS int* cnt = (LAS int*)lds;
    if (tid < 16) cnt[tid] = 0;
    __syncthreads();
    const int* hist = (const int*)(a.ws + WS_HIST); const int nchunk = G * NWAVE, first = c * NWAVE;
    int pre[8], tot[8];
#pragma unroll
    for (int e = 0; e < 8; ++e) { pre[e] = 0; tot[e] = 0; }
    for (int ch = tid; ch < nchunk; ch += NTHR) { const u32x4 h0 = *(const u32x4*)(hist + (size_t)ch * 8), h1 = *(const u32x4*)(hist + (size_t)ch * 8 + 4); const int m = ch < first ? 1 : 0;
        tot[0] += h0[0]; tot[1] += h0[1]; tot[2] += h0[2]; tot[3] += h0[3]; tot[4] += h1[0]; tot[5] += h1[1]; tot[6] += h1[2]; tot[7] += h1[3];
        pre[0] += m * h0[0]; pre[1] += m * h0[1]; pre[2] += m * h0[2]; pre[3] += m * h0[3]; pre[4] += m * h1[0]; pre[5] += m * h1[1]; pre[6] += m * h1[2]; pre[7] += m * h1[3]; }
#pragma unroll
    for (int e = 0; e < 8; ++e) { int p = pre[e], t = tot[e];
#pragma unroll
        for (int o = 32; o >= 1; o >>= 1) { p += __shfl_xor(p, o); t += __shfl_xor(t, o); }
        if (lane == 0) { __hip_atomic_fetch_add(&cnt[e], p, __ATOMIC_RELAXED, __HIP_MEMORY_SCOPE_WORKGROUP); __hip_atomic_fetch_add(&cnt[8 + e], t, __ATOMIC_RELAXED, __HIP_MEMORY_SCOPE_WORKGROUP); } }
    __syncthreads();
    int base[9], run[8]; base[0] = 0;
#pragma unroll
    for (int e = 0; e < 8; ++e) base[e + 1] = base[e] + ((cnt[8 + e] + 255) & ~255);
    if (c == 0 && tid < 9) { int v = 0;
#pragma unroll
        for (int e = 0; e < 9; ++e) v = (tid == e) ? base[e] : v;
        ((int*)(a.ws + WS_META))[tid] = v; }
#pragma unroll
    for (int e = 0; e < 8; ++e) { int p = cnt[e];
        for (int w = 0; w < wave; ++w) p += hist[(size_t)(first + w) * 8 + e];
        run[e] = base[e] + p; }
    const bf16_t* H = (const bf16_t*)(a.ws + WS_ARENA + A_H); bf16_t* HS = (bf16_t*)(a.ws + WS_ARENA + A_HS);
    for (int row = r0; row < r1; ++row) {
        const u32x4 rt = *(const u32x4*)(a.ws + WS_ROUTE + (size_t)row * 16); const int e0 = (int)rt[0], e1 = (int)rt[1];
        if (e0 < 0) continue;
        int s0 = 0, s1 = 0;
#pragma unroll
        for (int e = 0; e < 8; ++e) { if (e == e0) { s0 = run[e]; run[e] += 1; } if (e == e1) { s1 = run[e]; run[e] += 1; } }
        const u32x4 h0 = *(const u32x4*)(H + (size_t)row * 1024 + lane * 8), h1 = *(const u32x4*)(H + (size_t)row * 1024 + 512 + lane * 8);
        *(u32x4*)(HS + (size_t)s0 * 1024 + lane * 8) = h0; *(u32x4*)(HS + (size_t)s0 * 1024 + 512 + lane * 8) = h1;
        *(u32x4*)(HS + (size_t)s1 * 1024 + lane * 8) = h0; *(u32x4*)(HS + (size_t)s1 * 1024 + 512 + lane * 8) = h1;
        if (lane == 0) { int* sl = (int*)(a.ws + WS_RSLOT) + (size_t)row * 2; sl[0] = s0; sl[1] = s1; }
    }
}
__device__ __forceinline__ void final_combine(const Args& a, int layer, int G, int c) {
    const int lane = ltid() & 63; int r0, r1; wave_rows(G, c, r0, r1);
    for (int row = r0; row < r1; ++row) { if (row % SEG < CTX) continue;
        float* xp = xrow(a, row); float x[16]; load_x16(xp, lane, x); moe_combine16(a, row, layer, lane, x); store_x16(xp, lane, x); }
}

constexpr int NPH = 42;
#define CT(k) (((PSEL) >> (k)) & 1u)
#ifndef PROBE_MASK
#define PROBE_MASK 0u
#endif
#define REPS(k) for (int rep_ = 0; rep_ <= (int)(((PROBE_MASK) >> (k)) & 1u); ++rep_)
constexpr int LDS_ST_OFF = 161792;
constexpr int LDS_BYTES = LDS_ST_OFF + 64;
constexpr int TILE_OFF = 73728;
#define WSP(off) (a.ws + WS_ARENA + (off))
template <unsigned PSEL>
__global__ void __launch_bounds__(NTHR, 2) fwd(Args ka) {
    extern __shared__ __attribute__((aligned(16))) unsigned char lds_raw[];
    LAS unsigned char* lds = (LAS unsigned char*)lds_raw;
    const int Gk = gridDim.x, ck = blockIdx.x, tid = ltid();
    volatile LAS unsigned* st = (volatile LAS unsigned*)(lds + LDS_ST_OFF);
    if (tid < 4) st[tid] = 0u;
    __syncthreads();
    XcdBarrier bar; bar.bar = (unsigned*)(ka.ws + WS_CTL); bar.x = 0; bar.st = st;
    if (ka.ph_hi - ka.ph_lo > 1) bar = xcd_barrier_post((unsigned*)(ka.ws + WS_CTL), st);
#define IN(p) (ka.ph_lo <= (p) && (p) < ka.ph_hi)
#define PHB const Args a = launder_args(ka); const int G = launder_s(Gk), c = launder_s(ck); (void)G; (void)c;
#define SEAM(p) do { if (IN(p) && IN((p) + 1)) xcd_barrier(bar); } while (0)
    const size_t P1K = (size_t)256 * 1024 * 2;

    { const int jj_ = 0; const bool last_ = false;
    if (CT(20) && IN(0)) REPS(20) { PHB const bf16_t* wm = wmla(a, jj_); const bf16_t* wr_ = wrwkv(a, jj_); const bf16_t* wf = wffn(a, jj_); bf16_t* Vb = last_ ? (bf16_t*)WSP(A_RV) : (bf16_t*)(a.ws + WS_VF); (void)wm; (void)wr_; (void)wf; (void)Vb;
            { prologue_misc(a, lds, G, c); run_prep(a, lds + TILE_OFF, -1, 0, G, c); } }
    }
    SEAM(0);

    for (int jj = 0; jj < 2; ++jj) {
        const int pb = 1 + jj * 20, lm = 2 * jj, lr = 2 * jj + 1, jj_ = jj; const bool last = (jj == 1), last_ = last;

        if (CT(0) && IN(pb + 0)) REPS(0) { PHB const bf16_t* wm = wmla(a, jj_); const bf16_t* wr_ = wrwkv(a, jj_); const bf16_t* wf = wffn(a, jj_); bf16_t* Vb = last_ ? (bf16_t*)WSP(A_RV) : (bf16_t*)(a.ws + WS_VF); (void)wm; (void)wr_; (void)wf; (void)Vb;
            { if (jj == 0) norm_plain<false, true>(a, lm, a.in[I_N1G] + lm * D, 0, (bf16_t*)WSP(A_H), G, c); else norm_plain<true>(a, lm, a.in[I_N1G] + lm * D, 0, (bf16_t*)WSP(A_H), G, c); } }
        SEAM(pb + 0);
        if (CT(1) && IN(pb + 1)) REPS(1) { PHB const bf16_t* wm = wmla(a, jj_); const bf16_t* wr_ = wrwkv(a, jj_); const bf16_t* wf = wffn(a, jj_); bf16_t* Vb = last_ ? (bf16_t*)WSP(A_RV) : (bf16_t*)(a.ws + WS_VF); (void)wm; (void)wr_; (void)wf; (void)Vb;
            { MapSimple S{(const char*)WSP(A_H), (const char*)wm, P1K, P1K, 3, 16, 0}; EpiBf<FPlain> E{{(bf16_t*)WSP(A_QKVA), 768}};
            pg8::gemm_phase(lds, 1024, 1024, S, E, G, c); } }
        SEAM(pb + 1);
        if (CT(2) && IN(pb + 2)) REPS(2) { PHB const bf16_t* wm = wmla(a, jj_); const bf16_t* wr_ = wrwkv(a, jj_); const bf16_t* wf = wffn(a, jj_); bf16_t* Vb = last_ ? (bf16_t*)WSP(A_RV) : (bf16_t*)(a.ws + WS_VF); (void)wm; (void)wr_; (void)wf; (void)Vb;
            mla_stats(a, G, c); }
        SEAM(pb + 2);
        if (CT(3) && IN(pb + 3)) REPS(3) { PHB const bf16_t* wm = wmla(a, jj_); const bf16_t* wr_ = wrwkv(a, jj_); const bf16_t* wf = wffn(a, jj_); bf16_t* Vb = last_ ? (bf16_t*)WSP(A_RV) : (bf16_t*)(a.ws + WS_VF); (void)wm; (void)wr_; (void)wf; (void)Vb;
            { MapQKV S{(const char*)WSP(A_QKVA), (const char*)(wm + E_QKVA), (const char*)(wm + E_QKVA + E_QB)};
            EpiQKV E{(bf16_t*)WSP(A_Q), (bf16_t*)WSP(A_KV), (const float*)(a.ws + WS_RS), (const float*)(a.ws + WS_RS) + R};
            pg8::gemm_phase(lds, 768, 384, S, E, G, c); } }
        SEAM(pb + 3);
        if (CT(4) && IN(pb + 4)) REPS(4) { PHB const bf16_t* wm = wmla(a, jj_); const bf16_t* wr_ = wrwkv(a, jj_); const bf16_t* wf = wffn(a, jj_); bf16_t* Vb = last_ ? (bf16_t*)WSP(A_RV) : (bf16_t*)(a.ws + WS_VF); (void)wm; (void)wr_; (void)wf; (void)Vb;
            mla_qkpost(a, jj, G, c); }
        SEAM(pb + 4);
        if (CT(5) && IN(pb + 5)) REPS(5) { PHB const bf16_t* wm = wmla(a, jj_); const bf16_t* wr_ = wrwkv(a, jj_); const bf16_t* wf = wffn(a, jj_); bf16_t* Vb = last_ ? (bf16_t*)WSP(A_RV) : (bf16_t*)(a.ws + WS_VF); (void)wm; (void)wr_; (void)wf; (void)Vb;
            attn_phase(a, lds, G, c); }
        SEAM(pb + 5);
        if (CT(6) && IN(pb + 6)) REPS(6) { PHB const bf16_t* wm = wmla(a, jj_); const bf16_t* wr_ = wrwkv(a, jj_); const bf16_t* wf = wffn(a, jj_); bf16_t* Vb = last_ ? (bf16_t*)WSP(A_RV) : (bf16_t*)(a.ws + WS_VF); (void)wm; (void)wr_; (void)wf; (void)Vb;
            { MapSimple S{(const char*)WSP(A_O), (const char*)(wm + E_QKVA + E_QB + E_KVB), P1K, P1K, 4, 16, 0}; EpiResid E{(float*)(a.ws + WS_CS), a.out, (const float*)(a.ws + WS_MODS), lm, 2, jj == 0 ? a.in[I_CTX] : (const float*)(a.ws + WS_CS), jj == 0 ? a.in[I_X] : (const float*)a.out};
            pg8::gemm_phase(lds, 1024, 1024, S, E, G, c); } }
        SEAM(pb + 6);
        if (CT(7) && IN(pb + 7)) REPS(7) { PHB const bf16_t* wm = wmla(a, jj_); const bf16_t* wr_ = wrwkv(a, jj_); const bf16_t* wf = wffn(a, jj_); bf16_t* Vb = last_ ? (bf16_t*)WSP(A_RV) : (bf16_t*)(a.ws + WS_VF); (void)wm; (void)wr_; (void)wf; (void)Vb;
            norm_plain<false>(a, lm, a.in[I_N2G] + lm * D, 3, (bf16_t*)WSP(A_H), G, c); }
        SEAM(pb + 7);
        if (CT(8) && IN(pb + 8)) REPS(8) { PHB const bf16_t* wm = wmla(a, jj_); const bf16_t* wr_ = wrwkv(a, jj_); const bf16_t* wf = wffn(a, jj_); bf16_t* Vb = last_ ? (bf16_t*)WSP(A_RV) : (bf16_t*)(a.ws + WS_VF); (void)wm; (void)wr_; (void)wf; (void)Vb;
            { MapSimple S{(const char*)WSP(A_H), (const char*)wf, P1K, P1K, 22, 16, 0}; EpiSwiGLU E{(bf16_t*)WSP(A_FHID), DFF};
            pg8::gemm_phase(lds, 1024, 1024, S, E, G, c); } }
        SEAM(pb + 8);
        if (CT(9) && IN(pb + 9)) REPS(9) { PHB const bf16_t* wm = wmla(a, jj_); const bf16_t* wr_ = wrwkv(a, jj_); const bf16_t* wf = wffn(a, jj_); bf16_t* Vb = last_ ? (bf16_t*)WSP(A_RV) : (bf16_t*)(a.ws + WS_VF); (void)wm; (void)wr_; (void)wf; (void)Vb;
            { MapSimple S{(const char*)WSP(A_FHID), (const char*)(wf + E_F13), (size_t)256 * DFF * 2, (size_t)256 * DFF * 2, 4, 44, 0}; EpiResid E{(float*)(a.ws + WS_CS), a.out, (const float*)(a.ws + WS_MODS), lm, 5, (const float*)(a.ws + WS_CS), (const float*)a.out};
            pg8::gemm_phase(lds, DFF, DFF, S, E, G, c); } }
        SEAM(pb + 9);
        if (CT(10) && IN(pb + 10)) REPS(10) { PHB const bf16_t* wm = wmla(a, jj_); const bf16_t* wr_ = wrwkv(a, jj_); const bf16_t* wf = wffn(a, jj_); bf16_t* Vb = last_ ? (bf16_t*)WSP(A_RV) : (bf16_t*)(a.ws + WS_VF); (void)wm; (void)wr_; (void)wf; (void)Vb;
            norm_mix(a, lr, jj, G, c); }
        SEAM(pb + 10);
        if (CT(11) && IN(pb + 11)) REPS(11) { PHB const bf16_t* wm = wmla(a, jj_); const bf16_t* wr_ = wrwkv(a, jj_); const bf16_t* wf = wffn(a, jj_); bf16_t* Vb = last_ ? (bf16_t*)WSP(A_RV) : (bf16_t*)(a.ws + WS_VF); (void)wm; (void)wr_; (void)wf; (void)Vb;
            { MapRw1 S{(const char*)WSP(A_AX), (const char*)wr_, (const char*)(wr_ + E_B1), (const char*)(wr_ + E_B1 + E_B2)};
            EpiBf<FRw1> E{{(bf16_t*)WSP(A_L1), (bf16_t*)WSP(A_RR), (bf16_t*)WSP(A_RK), Vb}};
            pg8::gemm_phase(lds, 5120, 2048, S, E, G, c); } }
        SEAM(pb + 11);
        if (CT(12) && IN(pb + 12)) REPS(12) { PHB const bf16_t* wm = wmla(a, jj_); const bf16_t* wr_ = wrwkv(a, jj_); const bf16_t* wf = wffn(a, jj_); bf16_t* Vb = last_ ? (bf16_t*)WSP(A_RV) : (bf16_t*)(a.ws + WS_VF); (void)wm; (void)wr_; (void)wf; (void)Vb;
            { int nt4 = 4; asm volatile("" : "+s"(nt4));
            MapRw2 S{(const char*)WSP(A_L1), (const char*)(wr_ + E_B1 + E_B2 + E_L1), (const char*)(wr_ + E_B1 + E_B2 + E_L1 + E_L2A), 0, last ? 24 : 20, nt4};
            EpiRw2 E{(bf16_t*)WSP(A_WL0), (bf16_t*)WSP(A_VL), a.in[I_W0] + (size_t)jj * 2 * D, a.in[I_A0] + (size_t)jj * 2 * D}; pg8::gemm_phase(lds, 512, 256, S, E, G, c); } }
        SEAM(pb + 12);
        if (CT(13) && IN(pb + 13)) REPS(13) { PHB const bf16_t* wm = wmla(a, jj_); const bf16_t* wr_ = wrwkv(a, jj_); const bf16_t* wf = wffn(a, jj_); bf16_t* Vb = last_ ? (bf16_t*)WSP(A_RV) : (bf16_t*)(a.ws + WS_VF); (void)wm; (void)wr_; (void)wf; (void)Vb;
            { if (SCAN_CHUNKED) scan_chunked(a, jj, Vb, last, lds, G, c); if (!SCAN_CHUNKED || CS_BOTH) { __syncthreads(); scan_phase(a, jj, Vb, last, lds, G, c); }
              if (SCAN_CHUNKED && CS_BOTH) scan_compare(a, lds, G, c); } }
        SEAM(pb + 13);
        if (CT(14) && IN(pb + 14)) REPS(14) { PHB const bf16_t* wm = wmla(a, jj_); const bf16_t* wr_ = wrwkv(a, jj_); const bf16_t* wf = wffn(a, jj_); bf16_t* Vb = last_ ? (bf16_t*)WSP(A_RV) : (bf16_t*)(a.ws + WS_VF); (void)wm; (void)wr_; (void)wf; (void)Vb;
            rwkv_outprep(a, jj, Vb, last, G, c); }
        SEAM(pb + 14);
        if (CT(15) && IN(pb + 15)) REPS(15) { PHB const bf16_t* wm = wmla(a, jj_); const bf16_t* wr_ = wrwkv(a, jj_); const bf16_t* wf = wffn(a, jj_); bf16_t* Vb = last_ ? (bf16_t*)WSP(A_RV) : (bf16_t*)(a.ws + WS_VF); (void)wm; (void)wr_; (void)wf; (void)Vb;
            { MapSimple S{(const char*)WSP(A_RO), (const char*)(wr_ + E_B1 + 1024), P1K, (size_t)256 * 2048 * 2, 4, 16, last ? 1 : 0}; EpiResid E{(float*)(a.ws + WS_CS), a.out, (const float*)(a.ws + WS_MODS), lr, 2, (const float*)(a.ws + WS_CS), (const float*)a.out};
            pg8::gemm_phase(lds, 1024, 2048, S, E, G, c); } }
        SEAM(pb + 15);
        if (CT(16) && IN(pb + 16)) REPS(16) { PHB const bf16_t* wm = wmla(a, jj_); const bf16_t* wr_ = wrwkv(a, jj_); const bf16_t* wf = wffn(a, jj_); bf16_t* Vb = last_ ? (bf16_t*)WSP(A_RV) : (bf16_t*)(a.ws + WS_VF); (void)wm; (void)wr_; (void)wf; (void)Vb;
            { norm_router(a, lr, jj, last, lds, G, c); run_prep(a, lds + TILE_OFF, jj, CS_NOTILE ? 0 : (SCAN_CHUNKED ? cs::NCK - 1 : scan::NCH - 2), G, c);   } }
        SEAM(pb + 16);
        if (CT(17) && IN(pb + 17)) REPS(17) { PHB const bf16_t* wm = wmla(a, jj_); const bf16_t* wr_ = wrwkv(a, jj_); const bf16_t* wf = wffn(a, jj_); bf16_t* Vb = last_ ? (bf16_t*)WSP(A_RV) : (bf16_t*)(a.ws + WS_VF); (void)wm; (void)wr_; (void)wf; (void)Vb;
            moe_gather(a, lds, G, c); }
        SEAM(pb + 17);
        if (CT(18) && IN(pb + 18)) REPS(18) { PHB const bf16_t* wm = wmla(a, jj_); const bf16_t* wr_ = wrwkv(a, jj_); const bf16_t* wf = wffn(a, jj_); bf16_t* Vb = last_ ? (bf16_t*)WSP(A_RV) : (bf16_t*)(a.ws + WS_VF); (void)wm; (void)wr_; (void)wf; (void)Vb;
            { MapMoe S{(const char*)WSP(A_HS), (const char*)WSP(A_WM13), P1K, E_M13 * 2, P1K, 28, 16, (const int*)(a.ws + WS_META)}; EpiSwiGLU E{(bf16_t*)WSP(A_MHID), DFE};
            pg8::gemm_phase(lds, 1024, 1024, S, E, G, c); } }
        SEAM(pb + 18);
        if (CT(19) && IN(pb + 19)) REPS(19) { PHB const bf16_t* wm = wmla(a, jj_); const bf16_t* wr_ = wrwkv(a, jj_); const bf16_t* wf = wffn(a, jj_); bf16_t* Vb = last_ ? (bf16_t*)WSP(A_RV) : (bf16_t*)(a.ws + WS_VF); (void)wm; (void)wr_; (void)wf; (void)Vb;
            { MapMoeDown S{(const char*)WSP(A_MHID), (const char*)WSP(A_WM2), (size_t)256 * DFE * 2, E_M2 * 2, (size_t)256 * DFE * 2, (const int*)(a.ws + WS_META)}; EpiBf<FPlainAux> E{{(bf16_t*)WSP(A_Y2), 1024}};
            pg8::gemm_phase(lds, DFE, DFE, S, E, G, c); } }
        SEAM(pb + 19);
    }
    { const int jj_ = 1; const bool last_ = true;
    if (CT(21) && IN(41)) REPS(21) { PHB const bf16_t* wm = wmla(a, jj_); const bf16_t* wr_ = wrwkv(a, jj_); const bf16_t* wf = wffn(a, jj_); bf16_t* Vb = last_ ? (bf16_t*)WSP(A_RV) : (bf16_t*)(a.ws + WS_VF); (void)wm; (void)wr_; (void)wf; (void)Vb;
            final_combine(a, 3, G, c); }
    }
#undef IN
#undef SEAM
}

typedef void (*KernFn)(Args);
#if MK_ONE_LAUNCH
#ifndef PMASK
#define PMASK 0x3fffffu
#endif
static KernFn kern_of(int) { return fwd<PMASK>; }
#else
static KernFn kern_of(int p) {
    static const KernFn tab[22] = { fwd<1u << 0>, fwd<1u << 1>, fwd<1u << 2>, fwd<1u << 3>, fwd<1u << 4>, fwd<1u << 5>, fwd<1u << 6>, fwd<1u << 7>, fwd<1u << 8>, fwd<1u << 9>, fwd<1u << 10>, fwd<1u << 11>, fwd<1u << 12>, fwd<1u << 13>, fwd<1u << 14>, fwd<1u << 15>, fwd<1u << 16>, fwd<1u << 17>, fwd<1u << 18>, fwd<1u << 19>, fwd<1u << 20>, fwd<1u << 21> };
    return tab[p == 0 ? 20 : (p == NPH - 1 ? 21 : (p - 1) % 20)];
}
#endif
extern "C" void kernel_launch(void* const* d_in, const int* in_sizes, int n_in, void* d_out, int out_size, void* d_ws, size_t ws_size, hipStream_t stream) {
    static int grid = 0;
    if (grid == 0) {
        if (n_in != N_IN || out_size != NB * SEQ * D || ws_size < WS_NEED) { fprintf(stderr, "kernel_launch: unexpected shapes: n_in %d out %d ws %zu (need %zu)\n", n_in, out_size, ws_size, (size_t)WS_NEED); grid = -1; return; }
        int dev = 0, cus = 0;
        if (hipGetDevice(&dev) != hipSuccess || hipDeviceGetAttribute(&cus, hipDeviceAttributeMultiprocessorCount, dev) != hipSuccess) { grid = -1; return; }
        for (int p = 0; p < NPH; ++p)
            if (hipFuncSetAttribute((const void*)kern_of(p), hipFuncAttributeMaxDynamicSharedMemorySize, LDS_BYTES) != hipSuccess) { fprintf(stderr, "kernel_launch: hipFuncSetAttribute failed\n"); grid = -1; return; }
        int per_cu = 0;
        if (hipOccupancyMaxActiveBlocksPerMultiprocessor(&per_cu, (const void*)kern_of(1), NTHR, LDS_BYTES) != hipSuccess || per_cu < 1) { fprintf(stderr, "kernel_launch: occupancy query says %d blocks per CU\n", per_cu); (void)hipGetLastError(); }
        grid = cus < 256 ? cus : 256;
    }
    if (grid < 0) return;
    (void)in_sizes;
    (void)hipMemsetAsync((char*)d_ws + WS_CTL, 0, CTL_BYTES, stream);
    Args a{};
    for (int i = 0; i < N_IN; ++i) a.in[i] = (const float*)d_in[i];
    a.out = (float*)d_out; a.ws = (unsigned char*)d_ws;
#if MK_ONE_LAUNCH
    a.ph_lo = 0; a.ph_hi = NPH;
    hipLaunchKernelGGL(kern_of(0), dim3(grid), dim3(NTHR), LDS_BYTES, stream, a);
#else
    for (int p = 0; p < NPH; ++p) { a.ph_lo = p; a.ph_hi = p + 1; hipLaunchKernelGGL(kern_of(p), dim3(grid), dim3(NTHR), LDS_BYTES, stream, a); }
#endif
    const hipError_t le = hipPeekAtLastError();
    if (le != hipSuccess) fprintf(stderr, "kernel_launch: launch failed: %s\n", hipGetErrorName(le));
}
```

```cpp
#include <hip/hip_runtime.h>
#include <cstdio>
#include <cstdint>
#ifndef SCAN_CHUNKED
#define SCAN_CHUNKED 1
#endif
#ifndef CS_SERIAL
#define CS_SERIAL 0
#endif
#ifndef CS_BOTH
#define CS_BOTH 0
#endif
#ifndef CS_NOTILE
#define CS_NOTILE 0
#endif
#ifndef CS_OOP
#define CS_OOP 0
#endif
#ifndef CS_TOL
#define CS_TOL 0.05f
#endif

#ifndef MK_ONE_LAUNCH
#define MK_ONE_LAUNCH 1
#endif

#define LAS __attribute__((address_space(3)))
typedef unsigned short bf16_t;
typedef short bf16x8 __attribute__((ext_vector_type(8)));
typedef short s16x4 __attribute__((ext_vector_type(4)));
typedef float f32x2 __attribute__((ext_vector_type(2)));
typedef float f32x4 __attribute__((ext_vector_type(4)));
typedef float f32x16 __attribute__((ext_vector_type(16)));
typedef unsigned u32x2 __attribute__((ext_vector_type(2)));
typedef unsigned u32x4 __attribute__((ext_vector_type(4)));

constexpr int D = 1024, NB = 8, SEQ = 4096, CTX = 256, SEG = SEQ + CTX, R = NB * SEG;
constexpr int NPAN = R / 256;
constexpr int NTHR = 512, NWAVE = 8;
constexpr int QL = 384, KVL = 256, ROPE = 64, NOPE = 128, QKH = 192, VH = 128, NH = 8;
constexpr int DFF = 2816, NE = 8, DFE = 3584;
constexpr int MP_MAX = 71680;
constexpr float NORM_EPS = 1e-6f, LNX_EPS = 64e-5f;
constexpr float QSCALE = 0.07216878364870322f * 1.4426950408889634f;

enum { I_X = 0, I_C, I_CTX, I_CCTX, I_ADAW, I_ADAB, I_N1G, I_N2G, I_WQA, I_QAN, I_WQB, I_WKVA, I_KVAN, I_WKVB, I_QN, I_KN, I_MWO,
       I_MIX, I_WR, I_WK, I_WV, I_RWO, I_W0, I_W1, I_W2, I_A0, I_A1, I_A2, I_G1, I_G2, I_KK, I_KA, I_RK, I_LNW, I_LNB, I_V0, I_V1, I_V2,
       I_F1, I_F3, I_F2, I_ROUTER, I_M1, I_M3, I_M2, N_IN };

constexpr size_t U = (size_t)R * 1024 * 2;
constexpr size_t al256(size_t x) { return (x + 255) / 256 * 256; }
constexpr size_t WS_CTL = 0;
constexpr size_t CTL_BYTES = 65536;
constexpr size_t WS_MODS = WS_CTL + CTL_BYTES;
constexpr size_t WS_ROPE = WS_MODS + al256((size_t)4 * 9 * 6144 * 4);
constexpr size_t WS_CS = WS_ROPE + 8192;
constexpr size_t WS_RS = WS_CS + (size_t)NB * CTX * D * 4;
constexpr size_t WS_ROUTE = WS_RS + al256((size_t)R * 8);
constexpr size_t WS_RSLOT = WS_ROUTE + (size_t)R * 16;
constexpr size_t WS_HIST = WS_RSLOT + (size_t)R * 8;
constexpr size_t WS_META = WS_HIST + 2048 * 8 * 4;
constexpr size_t WS_DOT = WS_META + 256;
constexpr size_t WS_WSM = WS_DOT + (size_t)2 * R * 16 * 4;
constexpr size_t E_QKVA = 768 * 1024, E_QB = 1536 * 384, E_KVB = 2048 * 384, E_MWO = 1024 * 1024, E_MLA = E_QKVA + E_QB + E_KVB + E_MWO;
constexpr int LDB1 = 2048 + 64;
constexpr size_t E_B1 = 1024 * LDB1, E_B2 = 1024 * LDB1, E_L1 = 512 * LDB1, E_L2A = 4096 * 256, E_L2B = 2048 * 256, E_RWO = 1024 * 1024, E_RWKV = E_B1 + E_B2 + E_L1 + E_L2A + E_L2B + E_RWO;
constexpr size_t E_F13 = 5632 * 1024, E_F2 = 1024 * 2816, E_FFN = E_F13 + E_F2;
constexpr size_t WS_WMLA = WS_WSM, WS_WRWKV = WS_WMLA + 2 * E_MLA * 2, WS_WFFN = WS_WRWKV + 2 * E_RWKV * 2;
constexpr size_t WS_VF = WS_WFFN + 2 * E_FFN * 2;
constexpr size_t WS_ARENA = WS_VF + U;
constexpr size_t A_H = 0;
constexpr int LDKV = 2048 + 64;
constexpr size_t A_QKVA = U, A_Q = 2 * U, A_KV = 2 * U + U * 3 / 2, A_K = A_KV + al256((size_t)R * LDKV * 2), A_O = A_K + U * 3 / 2;
constexpr size_t A_FHID = U;
constexpr size_t A_AX = 0, A_L1 = 5 * U, A_RR = A_L1 + U / 2, A_RK = A_RR + U, A_RV = A_RK + U, A_VL = A_RV + U, A_REND = A_VL + U;
constexpr size_t A_WL0 = 0, A_WL1 = U, A_AL0 = 2 * U, A_AL1 = 3 * U, A_G = 4 * U, A_RO = 0;
constexpr size_t A_YF = (SCAN_CHUNKED && CS_OOP && !CS_BOTH) ? A_REND : A_WL0, A_YR = (SCAN_CHUNKED && CS_OOP && !CS_BOTH) ? A_REND + U : A_WL1;
constexpr size_t A_YCF = CS_BOTH ? A_REND : A_YF, A_YCR = CS_BOTH ? A_REND + U : A_YR;
constexpr size_t A_HS = U, A_Y2 = U, A_MHID = A_HS + (size_t)MP_MAX * 1024 * 2, A_MEND = A_MHID + (size_t)MP_MAX * DFE * 2;
constexpr size_t E_M13 = (size_t)7168 * 1024, E_M2 = (size_t)1024 * 3584;
constexpr size_t A_WM13 = A_MEND, A_WM2 = A_WM13 + NE * E_M13 * 2, A_END = A_WM2 + NE * E_M2 * 2;
constexpr size_t WS_NEED = WS_ARENA + (A_END > A_REND ? A_END : A_REND);
static_assert(WS_NEED <= 1081188352ull, "workspace budget (sum of inputs)");
static_assert(CS_OOP || CS_BOTH || A_WM13 >= A_REND, "the MoE weight region must be free during the RWKV mixer (weights are converted inside the scan phase)");

struct Args { const float* in[N_IN]; float* out; unsigned char* ws; int ph_lo, ph_hi; };

__device__ __forceinline__ unsigned cvt_pk_bf16(float lo, float hi) { unsigned r; asm("v_cvt_pk_bf16_f32 %0, %1, %2" : "=v"(r) : "v"(lo), "v"(hi)); return r; }
__device__ __forceinline__ float bflo(unsigned w) { return __uint_as_float(w << 16); }
__device__ __forceinline__ float bfhi(unsigned w) { return __uint_as_float(w & 0xffff0000u); }
__device__ __forceinline__ void unpack8(const u32x4 w, float (&f)[8]) { f[0] = bflo(w.x); f[1] = bfhi(w.x); f[2] = bflo(w.y); f[3] = bfhi(w.y); f[4] = bflo(w.z); f[5] = bfhi(w.z); f[6] = bflo(w.w); f[7] = bfhi(w.w); }
__device__ __forceinline__ u32x4 pack8(const float (&f)[8]) { u32x4 w; w.x = cvt_pk_bf16(f[0], f[1]); w.y = cvt_pk_bf16(f[2], f[3]); w.z = cvt_pk_bf16(f[4], f[5]); w.w = cvt_pk_bf16(f[6], f[7]); return w; }
__device__ __forceinline__ float wave_sum(float v) {
#pragma unroll
    for (int o = 32; o >= 1; o >>= 1) v += __shfl_xor(v, o);
    return v;
}
template <int CTRL> __device__ __forceinline__ float dpp_f(float v) { return __int_as_float(__builtin_amdgcn_update_dpp(0, __float_as_int(v), CTRL, 0xF, 0xF, true)); }
__device__ __forceinline__ float red8(float v) { v += dpp_f<0xB1>(v); v += dpp_f<0x4E>(v); v += dpp_f<0x141>(v); return v; }
__device__ __forceinline__ int ltid() { int t = threadIdx.x; asm volatile("" : "+v"(t)); return t; }
template <class T> __device__ __forceinline__ T launder_s(T x) { asm volatile("" : "+s"(x)); return x; }
__device__ __forceinline__ Args launder_args(const Args& k) { Args a = k; a.ws = launder_s(k.ws); a.out = launder_s(k.out); return a; }
__device__ __forceinline__ float wave_sum_dpp(float v) {
    v += dpp_f<0xB1>(v); v += dpp_f<0x4E>(v); v += dpp_f<0x141>(v); v += dpp_f<0x140>(v);
    const int iv = __float_as_int(v);
    return (__int_as_float(__builtin_amdgcn_readlane(iv, 0)) + __int_as_float(__builtin_amdgcn_readlane(iv, 16))) + (__int_as_float(__builtin_amdgcn_readlane(iv, 32)) + __int_as_float(__builtin_amdgcn_readlane(iv, 48)));
}
__device__ __forceinline__ float sigmoidf_(float x) { return __builtin_amdgcn_rcpf(1.0f + __expf(-x)); }
__device__ __forceinline__ float* xrow(const Args& a, int row) {
    const int b = row / SEG, r = row - b * SEG;
    return r < CTX ? (float*)(a.ws + WS_CS) + (size_t)(b * CTX + r) * D : a.out + (size_t)(b * SEQ + r - CTX) * D;
}
__device__ __forceinline__ const float* xrow_in(const Args& a, int row) {
    const int b = row / SEG, r = row - b * SEG;
    return r < CTX ? a.in[I_CTX] + (size_t)(b * CTX + r) * D : a.in[I_X] + (size_t)(b * SEQ + r - CTX) * D;
}
__device__ __forceinline__ int mod_index(int row) { const int b = row / SEG, r = row - b * SEG; return r < CTX ? 8 : b; }
__device__ __forceinline__ const float* mods_ptr(const Args& a, int layer, int mi, int which) { return (const float*)(a.ws + WS_MODS) + ((size_t)(layer * 9 + mi) * 6 + which) * 1024; }

#define XB_TMO      128
#define XB_XCNT(j)  (256  + 64 * (j))
#define XB_XSUB(j)  (1280 + 64 * (j))
#define XB_XGEN(j)  (2304 + 64 * (j))
#define XB_TOP      3328
#define XB_TOPGEN   3392
#define XCD_BAR_WORDS 3456
#define XB_SPIN_CAP (1u << 22)
__device__ __forceinline__ unsigned xb_ld(unsigned* p)              { return __hip_atomic_load(p, __ATOMIC_RELAXED, __HIP_MEMORY_SCOPE_AGENT); }
__device__ __forceinline__ unsigned xb_add(unsigned* p, unsigned v) { return __hip_atomic_fetch_add(p, v, __ATOMIC_RELAXED, __HIP_MEMORY_SCOPE_AGENT); }
__device__ __forceinline__ unsigned xb_xcc_id() { return (unsigned)__builtin_amdgcn_s_getreg((3 << 11) | 20) & 0xFu; }
#define XB_SPIN(cond, bar) do { unsigned _sp = 0; while (cond) { __builtin_amdgcn_s_sleep(1); \
    if ((++_sp & 255u) == 0u) { if (xb_ld(&(bar)[XB_TMO])) break; if (_sp > XB_SPIN_CAP) { atomicAdd(&(bar)[XB_TMO], 1u); break; } } } } while (0)
struct XcdBarrier { unsigned* bar; unsigned x; volatile LAS unsigned* st; };
__device__ __forceinline__ XcdBarrier xcd_barrier_post(unsigned* bar, volatile LAS unsigned* st) {
    XcdBarrier b; b.bar = bar; b.x = xb_xcc_id(); b.st = st;
    if (threadIdx.x == 0) (void)xb_add(&bar[XB_XCNT(b.x)], 1u);
    return b;
}
__device__ __forceinline__ void xcd_barrier_complete(unsigned* bar, unsigned x, unsigned& nloc, unsigned& nx) {
    const unsigned G = gridDim.x * gridDim.y * gridDim.z;
    unsigned sum, cnt, mine, sp = 0u;
    for (;;) {
        sum = 0u; cnt = 0u; mine = 0u;
#pragma unroll
        for (unsigned j = 0; j < 16; ++j) { const unsigned c = xb_ld(&bar[XB_XCNT(j)]); sum += c; cnt += (c > 0u) ? 1u : 0u; mine = (j == x) ? c : mine; }
        if (sum == G) break;
        __builtin_amdgcn_s_sleep(1);
        if ((++sp & 255u) == 0u) { if (xb_ld(&bar[XB_TMO])) break; if (sp > XB_SPIN_CAP) { atomicAdd(&bar[XB_TMO], 1u); break; } }
    }
    nloc = mine > 0u ? mine : 1u; nx = cnt > 0u ? cnt : 1u;
}
__device__ __forceinline__ void xcd_barrier(const XcdBarrier& b) {
    asm volatile("s_waitcnt vmcnt(0)" ::: "memory");
    __syncthreads();
    if (threadIdx.x == 0) {
        unsigned* bar = b.bar;
        __builtin_amdgcn_s_waitcnt(0);
        unsigned nloc = b.st[0], nx = b.st[1];
        if (nloc == 0u) { xcd_barrier_complete(bar, b.x, nloc, nx); b.st[0] = nloc; b.st[1] = nx; }
        const unsigned old = xb_add(&bar[XB_XSUB(b.x)], 1u);
        const unsigned gen = old / nloc;
        if (old + 1u == (gen + 1u) * nloc) {
            __builtin_amdgcn_fence(__ATOMIC_RELEASE, "agent");
            asm volatile("s_waitcnt vmcnt(0)" ::: "memory");
            const unsigned og = xb_add(&bar[XB_TOP], 1u);
            const unsigned tg = og / nx;
            if (og + 1u == (tg + 1u) * nx) xb_add(&bar[XB_TOPGEN], 1u);
            else XB_SPIN(xb_ld(&bar[XB_TOPGEN]) == tg, bar);
            __builtin_amdgcn_fence(__ATOMIC_ACQUIRE, "agent");
            xb_add(&bar[XB_XGEN(b.x)], 1u);
            asm volatile("s_waitcnt vmcnt(0)" ::: "memory");
        } else {
            XB_SPIN(xb_ld(&bar[XB_XGEN(b.x)]) == gen, bar);
            __builtin_amdgcn_fence(__ATOMIC_ACQUIRE, "agent");
            asm volatile("s_waitcnt vmcnt(0)" ::: "memory");
        }
    }
    __syncthreads();
}

namespace pg8 {
constexpr int BM = 256, BK = 64, HALF = 128, HTB = HALF * BK * 2, STAGE_BYTES = 8 * HTB;
__device__ __forceinline__ int lds_byte(int r, int c) { const int st = (r >> 4) * 2 + (c >> 5), rr = r & 15, cc = c & 31, ob = rr * 64 + cc * 2; return st * 1024 + (ob ^ (((ob >> 9) & 1) << 5)); }
__device__ __forceinline__ void stage_rc(int b, int& Rr, int& C) { const int st = b / 1024, sb = b % 1024, swz = sb ^ (((sb >> 9) & 1) << 5); Rr = (st >> 1) * 16 + swz / 64; C = (st & 1) * 32 + (swz % 64) / 2; }
__device__ __forceinline__ int perm32(int rho) { const int n = rho >> 4, i = rho & 15; return 8 * (i >> 2) + 4 * n + (i & 3); }
struct GUnit { const char* A; const char* B; int nt, pm, pn, aux; };
__device__ __forceinline__ void tile_order(int L, int nM, int nN, int& pm, int& pn) {
    const int nwg = nM * nN; int wgid = L;
    { const int q = nwg / 8, r = nwg % 8, xcd = wgid % 8, off = wgid / 8; wgid = (xcd < r ? xcd * (q + 1) : r * (q + 1) + (xcd - r) * q) + off; }
    const int nig = 8 * nN, gid = wgid / nig, fm = gid * 8, gsz = (nM - fm) < 8 ? (nM - fm) : 8;
    pm = fm + ((wgid % nig) % gsz); pn = (wgid % nig) / gsz;
}
template <class Epi, class Map>
__device__ __forceinline__ void gemm_phase(LAS unsigned char* lds, const int lda, const int ldb, const Map& S, const Epi& E, const int G, const int c) {
    const int tid = ltid(), wid = __builtin_amdgcn_readfirstlane(tid >> 6), lane = tid & 63, wr = wid >> 2, wc = wid & 3, fr = lane & 15, fq = lane >> 4;
    unsigned voffA[2], voffB[2];
#pragma unroll
    for (int i = 0; i < 2; ++i) { int Rr, C; stage_rc(tid * 16 + i * 8192, Rr, C); const int Rb = Epi::PERM ? ((Rr & ~31) + perm32(Rr & 31)) : Rr;
        voffA[i] = (unsigned)(Rr * lda + C) * 2u; voffB[i] = (unsigned)(Rb * ldb + C) * 2u; }
    const size_t kstep = (size_t)(BK * 2);
    const size_t hA = (size_t)HALF * lda * 2, hB = (size_t)HALF * ldb * 2;
    const unsigned ldsw = (unsigned)wid * 1024u;
    const int aoff = lds_byte(wr * 64 + fr, fq * 8), boff = lds_byte(wc * 32 + fr, fq * 8);
#define PG8_SA(b, h) (((b) * 2 + (h)) * HTB)
#define PG8_SB(b, h) ((4 + (b) * 2 + (h)) * HTB)
#define PG8_STAGE(bufoff, gbase, voff) do { _Pragma("unroll") for (int _i = 0; _i < 2; ++_i) \
        __builtin_amdgcn_global_load_lds((const unsigned*)((const char*)(gbase) + (voff)[_i]), (LAS unsigned*)(lds + (bufoff) + ldsw + _i * 8192), 16, 0, 0); } while (0)
#define PG8_LDA(dst, b, h) do { _Pragma("unroll") for (int m = 0; m < 4; ++m) _Pragma("unroll") for (int k = 0; k < 2; ++k) dst[m][k] = *(const LAS bf16x8*)(lds + PG8_SA(b, h) + aoff + m * 2048 + k * 1024); } while (0)
#define PG8_LDB(dst, b, h) do { _Pragma("unroll") for (int n = 0; n < 2; ++n) _Pragma("unroll") for (int k = 0; k < 2; ++k) dst[n][k] = *(const LAS bf16x8*)(lds + PG8_SB(b, h) + boff + n * 2048 + k * 1024); } while (0)
#define PG8_MMA(ai, bj, At, Bt) do { __builtin_amdgcn_s_setprio(1); _Pragma("unroll") for (int m = 0; m < 4; ++m) _Pragma("unroll") for (int n = 0; n < 2; ++n) _Pragma("unroll") for (int k = 0; k < 2; ++k) \
        acc[ai][bj][m][n] = __builtin_amdgcn_mfma_f32_16x16x32_bf16(Bt[n][k], At[m][k], acc[ai][bj][m][n], 0, 0, 0); __builtin_amdgcn_s_setprio(0); } while (0)
#define PG8_WAIT_V(n) asm volatile("s_waitcnt vmcnt(" #n ")" ::: "memory")
#define PG8_WAIT_L(n) asm volatile("s_waitcnt lgkmcnt(" #n ")" ::: "memory")
#define PG8_BAR __builtin_amdgcn_s_barrier()
#define PG8_SCHED __builtin_amdgcn_sched_barrier(0)
    GUnit cur, nxt; int ui = 0;
    if (!S(c, cur)) return;
    f32x4 acc[2][2][4][2];
#pragma unroll
    for (int a = 0; a < 2; ++a)
#pragma unroll
        for (int b = 0; b < 2; ++b)
#pragma unroll
            for (int m = 0; m < 4; ++m)
#pragma unroll
                for (int n = 0; n < 2; ++n) acc[a][b][m][n] = (f32x4){0.f, 0.f, 0.f, 0.f};
    bf16x8 At[4][2], B0[2][2], B1[2][2];
    const char* cA = cur.A; const char* cB = cur.B;
    PG8_STAGE(PG8_SB(0, 0), cB, voffB); PG8_STAGE(PG8_SB(0, 1), cB + hB, voffB); PG8_STAGE(PG8_SA(0, 0), cA, voffA); PG8_STAGE(PG8_SA(0, 1), cA + hA, voffA);
    if (wr == 1) PG8_BAR;
    PG8_WAIT_V(2); PG8_BAR;
    PG8_STAGE(PG8_SB(1, 0), cB + kstep, voffB); PG8_STAGE(PG8_SA(1, 0), cA + kstep, voffA); PG8_STAGE(PG8_SB(1, 1), cB + hB + kstep, voffB);
    PG8_WAIT_V(6); PG8_BAR;
    for (;;) {
        const bool has_next = S((ui + 1) * G + c, nxt);
        const char* nA = has_next ? nxt.A : cA; const char* nB = has_next ? nxt.B : cB;
        const int nt = cur.nt;
        for (int t = 0; t < nt; t += 2) {
            const bool last = (t == nt - 2);
            const char* a1 = cA + (size_t)(t + 1) * kstep;
            const char* a2 = last ? nA : cA + (size_t)(t + 2) * kstep; const char* b2 = last ? nB : cB + (size_t)(t + 2) * kstep;
            const char* a3 = a2 + kstep; const char* b3 = b2 + kstep;
            PG8_LDB(B0, 0, 0); PG8_LDB(B1, 0, 1); PG8_SCHED; PG8_LDA(At, 0, 0); PG8_STAGE(PG8_SA(1, 1), a1 + hA, voffA);
            PG8_WAIT_V(8); PG8_WAIT_L(0); PG8_BAR; PG8_MMA(0, 0, At, B0); PG8_MMA(0, 1, At, B1); PG8_BAR; PG8_SCHED;
            PG8_LDA(At, 0, 1); PG8_STAGE(PG8_SB(0, 0), b2, voffB); PG8_STAGE(PG8_SB(0, 1), b2 + hB, voffB); PG8_STAGE(PG8_SA(0, 0), a2, voffA);
            PG8_WAIT_V(8); PG8_WAIT_L(0); PG8_BAR; PG8_MMA(1, 0, At, B0); PG8_MMA(1, 1, At, B1); PG8_BAR; PG8_SCHED;
            PG8_LDB(B0, 1, 0); PG8_LDB(B1, 1, 1); PG8_SCHED; PG8_LDA(At, 1, 0); PG8_STAGE(PG8_SA(0, 1), a2 + hA, voffA);
            PG8_WAIT_V(8); PG8_WAIT_L(0); PG8_BAR; PG8_MMA(0, 0, At, B0); PG8_MMA(0, 1, At, B1); PG8_BAR; PG8_SCHED;
            PG8_LDA(At, 1, 1); PG8_STAGE(PG8_SB(1, 0), b3, voffB); PG8_STAGE(PG8_SB(1, 1), b3 + hB, voffB); PG8_STAGE(PG8_SA(1, 0), a3, voffA);
            PG8_WAIT_V(8); PG8_WAIT_L(0); PG8_BAR; PG8_MMA(1, 0, At, B0); PG8_MMA(1, 1, At, B1); PG8_BAR; PG8_SCHED;
        }
        if (wr == 0) PG8_BAR;
        E(acc, cur, wr, wc, fr, fq);
        if (!has_next) break;
#pragma unroll
        for (int a = 0; a < 2; ++a)
#pragma unroll
            for (int b = 0; b < 2; ++b)
#pragma unroll
                for (int m = 0; m < 4; ++m)
#pragma unroll
                    for (int n = 0; n < 2; ++n) acc[a][b][m][n] = (f32x4){0.f, 0.f, 0.f, 0.f};
        cur = nxt; cA = nA; cB = nB; ++ui;
        if (wr == 1) PG8_BAR;
    }
    PG8_WAIT_V(0);
    PG8_BAR;
#undef PG8_SA
#undef PG8_SB
#undef PG8_STAGE
#undef PG8_LDA
#undef PG8_LDB
#undef PG8_MMA
#undef PG8_WAIT_V
#undef PG8_WAIT_L
#undef PG8_BAR
#undef PG8_SCHED
}
}

using pg8::GUnit;
typedef f32x4 Acc[2][2][4][2];
template <class F> struct EpiBf {
    static constexpr bool PERM = true;
    F f;
    __device__ __forceinline__ void operator()(const Acc& acc, const GUnit& u, int wr, int wc, int fr, int fq) const {
#pragma unroll
        for (int ai = 0; ai < 2; ++ai)
#pragma unroll
            for (int m = 0; m < 4; ++m) { const int trow = ai * 128 + wr * 64 + m * 16 + fr;
#pragma unroll
                for (int bj = 0; bj < 2; ++bj) f(acc[ai][bj][m][0], acc[ai][bj][m][1], u, trow, bj * 128 + wc * 32 + 8 * fq); }
    }
};
__device__ __forceinline__ void st8(bf16_t* p, f32x4 v0, f32x4 v1) { u32x4 w; w.x = cvt_pk_bf16(v0[0], v0[1]); w.y = cvt_pk_bf16(v0[2], v0[3]); w.z = cvt_pk_bf16(v1[0], v1[1]); w.w = cvt_pk_bf16(v1[2], v1[3]); *(u32x4*)p = w; }

struct FPlain { bf16_t* O; int ldc;
    __device__ __forceinline__ void operator()(f32x4 v0, f32x4 v1, const GUnit& u, int trow, int tcol) const { st8(O + (size_t)(u.pm * 256 + trow) * ldc + u.pn * 256 + tcol, v0, v1); } };
struct FQKV { bf16_t* Q; bf16_t* KV; const float* rsq; const float* rskv;
    __device__ __forceinline__ void operator()(f32x4 v0, f32x4 v1, const GUnit& u, int trow, int tcol) const {
        const int row = u.pm * 256 + trow;
        if (u.aux == 0) { const float s = rsq[row]; st8(Q + (size_t)row * 1536 + u.pn * 256 + tcol, v0 * s, v1 * s); }
        else { const float s = rskv[row]; st8(KV + (size_t)row * LDKV + u.pn * 256 + tcol, v0 * s, v1 * s); } } };
struct EpiQKV {
    static constexpr bool PERM = true;
    bf16_t* Q; bf16_t* KV; const float* rsq; const float* rskv;
    __device__ __forceinline__ void operator()(const Acc& acc, const GUnit& u, int wr, int wc, int fr, int fq) const {
        const float* rs = (u.aux == 0) ? rsq : rskv; bf16_t* O = (u.aux == 0) ? Q : KV; const int ldc = (u.aux == 0) ? 1536 : LDKV;
        float sc[2][4];
#pragma unroll
        for (int ai = 0; ai < 2; ++ai)
#pragma unroll
            for (int m = 0; m < 4; ++m) sc[ai][m] = rs[u.pm * 256 + ai * 128 + wr * 64 + m * 16 + fr];
#pragma unroll
        for (int ai = 0; ai < 2; ++ai)
#pragma unroll
            for (int m = 0; m < 4; ++m) { const int row = u.pm * 256 + ai * 128 + wr * 64 + m * 16 + fr; const float s = sc[ai][m];
#pragma unroll
                for (int bj = 0; bj < 2; ++bj) st8(O + (size_t)row * ldc + u.pn * 256 + bj * 128 + wc * 32 + 8 * fq, acc[ai][bj][m][0] * s, acc[ai][bj][m][1] * s); }
    }
};
struct EpiRw2 {
    static constexpr bool PERM = true;
    bf16_t* base; bf16_t* vl; const float* w0; const float* a0;
    __device__ __forceinline__ void operator()(const Acc& acc, const GUnit& u, int wr, int wc, int fr, int fq) const {
        bf16_t* o = (u.aux < 5) ? base + (size_t)u.aux * ((size_t)R * 1024) : vl;
        const bool act = u.aux < 4; const float scl = (u.aux < 2) ? 0.6065306597126334f : 1.0f;
        f32x4 bv[2][2];
#pragma unroll
        for (int bj = 0; bj < 2; ++bj) { const int col = u.pn * 256 + bj * 128 + wc * 32 + 8 * fq; const float* bp = (u.aux < 2 ? w0 : a0) + (u.aux & 1) * 1024 + col;
            bv[bj][0] = act ? *(const f32x4*)bp : (f32x4){0.f, 0.f, 0.f, 0.f}; bv[bj][1] = act ? *(const f32x4*)(bp + 4) : (f32x4){0.f, 0.f, 0.f, 0.f}; }
#pragma unroll
        for (int ai = 0; ai < 2; ++ai)
#pragma unroll
            for (int m = 0; m < 4; ++m) { const int row = u.pm * 256 + ai * 128 + wr * 64 + m * 16 + fr;
#pragma unroll
                for (int bj = 0; bj < 2; ++bj) { f32x4 v0 = acc[ai][bj][m][0], v1 = acc[ai][bj][m][1];
                    if (act) {
#pragma unroll
                        for (int j = 0; j < 4; ++j) { v0[j] = scl * sigmoidf_(bv[bj][0][j] + v0[j]); v1[j] = scl * sigmoidf_(bv[bj][1][j] + v1[j]); } }
                    st8(o + (size_t)row * 1024 + u.pn * 256 + bj * 128 + wc * 32 + 8 * fq, v0, v1); } }
    }
};
struct FRw1 { bf16_t* L1; bf16_t* RR; bf16_t* RK; bf16_t* RV;
    __device__ __forceinline__ void operator()(f32x4 v0, f32x4 v1, const GUnit& u, int trow, int tcol) const {
        const int row = u.pm * 256 + trow;
        if (u.aux == 0) { const int col = u.pn * 256 + tcol;
            if (col < 128) {
#pragma unroll
                for (int j = 0; j < 4; ++j) { v0[j] = 1.0f - 2.0f * __builtin_amdgcn_rcpf(1.0f + __expf(2.0f * v0[j])); v1[j] = 1.0f - 2.0f * __builtin_amdgcn_rcpf(1.0f + __expf(2.0f * v1[j])); } }
            else if (col >= 320) {
#pragma unroll
                for (int j = 0; j < 4; ++j) { v0[j] = sigmoidf_(v0[j]); v1[j] = sigmoidf_(v1[j]); } }
            st8(L1 + (size_t)row * 512 + col, v0, v1); }
        else { bf16_t* o = u.aux == 1 ? RR : (u.aux == 2 ? RK : RV); st8(o + (size_t)row * 1024 + u.pn * 256 + tcol, v0, v1); } } };
struct FRw2 { bf16_t* base; bf16_t* vl; const float* w0; const float* a0;
    __device__ __forceinline__ void operator()(f32x4 v0, f32x4 v1, const GUnit& u, int trow, int tcol) const {
        const int col = u.pn * 256 + tcol;
        const unsigned off = (unsigned)(u.pm * 256 + trow) * 1024u + (unsigned)col + (u.aux < 5 ? (unsigned)u.aux * (unsigned)(R * 1024) : 0u);
        bf16_t* o = (u.aux < 5) ? base : vl;
        if (u.aux < 4) {
            const float* bp = (u.aux < 2 ? w0 : a0) + (u.aux & 1) * 1024 + col; const f32x4 b0 = *(const f32x4*)bp, b1 = *(const f32x4*)(bp + 4);
            const float sc = (u.aux < 2) ? 0.6065306597126334f : 1.0f;
#pragma unroll
            for (int j = 0; j < 4; ++j) { v0[j] = sc * sigmoidf_(b0[j] + v0[j]); v1[j] = sc * sigmoidf_(b1[j] + v1[j]); } }
        st8(o + off, v0, v1); } };
struct EpiSwiGLU {
    static constexpr bool PERM = true;
    bf16_t* O; int ldc;
    __device__ __forceinline__ void operator()(const Acc& acc, const GUnit& u, int wr, int wc, int fr, int fq) const {
#pragma unroll
        for (int ai = 0; ai < 2; ++ai)
#pragma unroll
            for (int m = 0; m < 4; ++m) { const int trow = ai * 128 + wr * 64 + m * 16 + fr; f32x4 h0, h1;
#pragma unroll
                for (int j = 0; j < 4; ++j) { const float g0 = acc[ai][0][m][0][j], g1 = acc[ai][0][m][1][j];
                    h0[j] = g0 * sigmoidf_(g0) * acc[ai][1][m][0][j]; h1[j] = g1 * sigmoidf_(g1) * acc[ai][1][m][1][j]; }
                st8(O + (size_t)(u.pm * 256 + trow) * ldc + u.pn * 128 + wc * 32 + 8 * fq, h0, h1); }
    }
};
struct EpiResid {
    static constexpr bool PERM = false;
    float* cs; float* out; const float* mods; int layer, which;
    const float* scs; const float* sout;
    __device__ __forceinline__ void operator()(const Acc& acc, const GUnit& u, int wr, int wc, int fr, int fq) const {
        const int b = u.pm / 17, isctx = (u.pm % 17 == 0);
        float* xp = isctx ? cs + (size_t)b * CTX * D : out + (size_t)(b * SEQ + (u.pm % 17 - 1) * 256) * D;
        const float* sp = isctx ? scs + (size_t)b * CTX * D : sout + (size_t)(b * SEQ + (u.pm % 17 - 1) * 256) * D;
        const float* gp = mods + ((size_t)(layer * 9 + (isctx ? 8 : b)) * 6 + which) * 1024;
        const int col0 = u.pn * 256 + wc * 32 + 4 * fq;
        f32x4 gv[2][2];
#pragma unroll
        for (int bj = 0; bj < 2; ++bj)
#pragma unroll
            for (int n = 0; n < 2; ++n) gv[bj][n] = *(const f32x4*)(gp + col0 + bj * 128 + n * 16);
#pragma unroll
        for (int ai = 0; ai < 2; ++ai)
#pragma unroll
            for (int mh = 0; mh < 2; ++mh) {
                f32x4 xv[2][2][2];
#pragma unroll
                for (int mm = 0; mm < 2; ++mm) { const float* srow = sp + (size_t)(ai * 128 + wr * 64 + (mh * 2 + mm) * 16 + fr) * D + col0;
#pragma unroll
                    for (int bj = 0; bj < 2; ++bj)
#pragma unroll
                        for (int n = 0; n < 2; ++n) xv[mm][bj][n] = *(const f32x4*)(srow + bj * 128 + n * 16); }
#pragma unroll
                for (int mm = 0; mm < 2; ++mm) { float* rowp = xp + (size_t)(ai * 128 + wr * 64 + (mh * 2 + mm) * 16 + fr) * D + col0;
#pragma unroll
                    for (int bj = 0; bj < 2; ++bj)
#pragma unroll
                        for (int n = 0; n < 2; ++n) *(f32x4*)(rowp + bj * 128 + n * 16) = xv[mm][bj][n] + gv[bj][n] * acc[ai][bj][mh * 2 + mm][n]; }
                asm volatile("" ::: "memory"); }
    }
};

struct MapSimple {
    const char* A; const char* B; size_t sa, sb; int nN, nt, lat;
    __device__ __forceinline__ bool operator()(int L, GUnit& u) const { const int nM = lat ? 128 : NPAN; if (L >= nM * nN) return false; int q; pg8::tile_order(L, nM, nN, q, u.pn);
        u.pm = lat ? (q / 16) * 17 + 1 + (q % 16) : q;
        u.A = A + (size_t)u.pm * sa; u.B = B + (size_t)u.pn * sb; u.nt = nt; u.aux = 0; return true; }
};
struct MapQKV {
    const char* QKVA; const char* QB; const char* KVB;
    __device__ __forceinline__ bool operator()(int L, GUnit& u) const { if (L >= NPAN * 14) return false; int pn; pg8::tile_order(L, NPAN, 14, u.pm, pn);
        const char* ap = QKVA + (size_t)u.pm * 256 * 768 * 2;
        if (pn < 6) { u.A = ap; u.B = QB + (size_t)pn * 256 * 384 * 2; u.nt = 6; u.pn = pn; u.aux = 0; }
        else { u.A = ap + 384 * 2; u.B = KVB + (size_t)(pn - 6) * 256 * 384 * 2; u.nt = 4; u.pn = pn - 6; u.aux = 1; }
        return true; }
};
struct MapRw1 {
    static constexpr bool KCAT = false;
    const char* AX; const char* B1; const char* B2; const char* L1; int G;
    __device__ __forceinline__ void fill(GUnit& u, int pn) const {
        const char* ap = AX + (size_t)u.pm * 256 * 5120 * 2;
        if (pn < 2) { u.A = ap; u.B = L1 + (size_t)pn * 256 * LDB1 * 2; u.nt = 32; u.pn = pn; u.aux = 0; }
        else if (pn < 6) { u.A = ap + 2048 * 2; u.B = B1 + (size_t)(pn - 2) * 256 * LDB1 * 2; u.nt = 16; u.pn = pn - 2; u.aux = 1; }
        else if (pn < 10) { u.A = ap + 3072 * 2; u.B = B1 + (size_t)(pn - 6) * 256 * LDB1 * 2 + 1024 * 2; u.nt = 16; u.pn = pn - 6; u.aux = 2; }
        else { u.A = ap + 4096 * 2; u.B = B2 + (size_t)(pn - 10) * 256 * LDB1 * 2; u.nt = 16; u.pn = pn - 10; u.aux = 3; } }
    __device__ __forceinline__ bool operator()(int L, GUnit& u) const {
        int pn;
        if (G != 256) { if (L >= NPAN * 14) return false; pg8::tile_order(L, NPAN, 14, u.pm, pn); fill(u, pn); return true; }
        const int c = L & 255, i = L >> 8, nl = (c < 16) ? 2 : 1;
        if (i < nl) { pg8::tile_order(c + i * 256, NPAN, 2, u.pm, pn); fill(u, pn); return true; }
        const int k = i - nl; int Ln;
        if (c >= 16) { const int v = c - 16; if (k < 6) Ln = v + k * 240; else if (k == 6 && v < 112) Ln = 1440 + v; else return false; }
        else { if (k < 5) Ln = 1552 + c * 5 + k; else return false; }
        pg8::tile_order(Ln, NPAN, 12, u.pm, pn); fill(u, pn + 2); return true; }
};
struct MapRw2 {
    const char* L1; const char* L2A; const char* L2B; int pn0, nN, nt;
    __device__ __forceinline__ bool operator()(int L, GUnit& u) const { if (L >= NPAN * nN) return false; int pn; pg8::tile_order(L, NPAN, nN, u.pm, pn); pn += pn0;
        const char* ap = L1 + (size_t)u.pm * 256 * 512 * 2; u.nt = nt; u.pn = pn & 3; u.aux = pn >> 2;
        if (pn < 16) { const int koff = (pn < 8) ? 0 : 128 * 2;
            u.A = ap + koff; u.B = L2A + (size_t)pn * 256 * 256 * 2 + koff; u.nt = nt >> 1; }
        else { u.A = ap + 256 * 2; u.B = L2B + (size_t)(pn - 16) * 256 * 256 * 2; if (pn >= 20) u.nt = nt >> 1; }
        return true; }
};
struct MapMoe {
    const char* A; const char* B; size_t sa, sbe, sb; int nN, nt; const int* base;
    __device__ __forceinline__ bool operator()(int L, GUnit& u) const { const int nM = base[8] >> 8; if (L >= nM * nN) return false; pg8::tile_order(L, nM, nN, u.pm, u.pn);
        int e = 0;
#pragma unroll
        for (int j = 1; j < 8; ++j) e += (u.pm * 256 >= base[j]) ? 1 : 0;
        u.A = A + (size_t)u.pm * sa; u.B = B + (size_t)e * sbe + (size_t)u.pn * sb; u.nt = nt; u.aux = e; return true; }
};

struct MoeSplit { int nMf, nT, S; };
__device__ __forceinline__ MoeSplit moe_split(int total_slots) { const int nM = total_slots >> 8; MoeSplit s; s.nMf = (nM >> 6) << 6; s.nT = nM - s.nMf; int S = s.nT > 0 ? 64 / s.nT : 1; S = S > 8 ? 8 : S; s.S = S < 1 ? 1 : S; return s; }
constexpr int XP0 = (int)((A_WM13 - A_Y2) / ((size_t)256 * 1024 * 2));
static_assert((A_WM13 - A_Y2) % ((size_t)256 * 1024 * 2) == 0, "partial-tile panels are addressed relative to Y2");
struct MapMoeDown {
    const char* A; const char* B; size_t sa, sbe, sb; const int* base;
    __device__ __forceinline__ bool operator()(int L, GUnit& u) const { const MoeSplit sp = moe_split(base[8]); const int nfull = sp.nMf * 4;
        int k0 = 0, nt = 56, opan;
        if (L < nfull) { pg8::tile_order(L, sp.nMf, 4, u.pm, u.pn); opan = u.pm; }
        else { const int i = L - nfull, ntu = sp.nT * 4; if (i >= ntu * sp.S) return false;
            const int sl = i / ntu, t = i - sl * ntu; pg8::tile_order(t, sp.nT, 4, u.pm, u.pn); u.pm += sp.nMf;
            const int q = 28 / sp.S, r = 28 - q * sp.S, p0 = sl * q + (sl < r ? sl : r), np = q + (sl < r ? 1 : 0); k0 = p0 * 2; nt = np * 2;
            opan = sl == 0 ? u.pm : XP0 + (sl - 1) * sp.nT + (u.pm - sp.nMf); }
        int e = 0;
#pragma unroll
        for (int j = 1; j < 8; ++j) e += (u.pm * 256 >= base[j]) ? 1 : 0;
        u.A = A + (size_t)u.pm * sa + (size_t)k0 * 128; u.B = B + (size_t)e * sbe + (size_t)u.pn * sb + (size_t)k0 * 128; u.nt = nt; u.aux = opan; return true; }
};
struct FPlainAux { bf16_t* O; int ldc;
    __device__ __forceinline__ void operator()(f32x4 v0, f32x4 v1, const GUnit& u, int trow, int tcol) const { st8(O + (size_t)(u.aux * 256 + trow) * ldc + u.pn * 256 + tcol, v0, v1); } };

struct Job { const float* src; const float* kscale; bf16_t* dst; int sld, srcK, srcN, ldd, Nd, Kd, koff, grp, gstride, tn, tile0, pad; };
constexpr int MAXJOB = 96;
#define NOGRP (1 << 30)
struct JobList { LAS Job* jobs; int n, tiles, z; };
__device__ __forceinline__ void addjob(JobList& L, const float* src, int sld, int srcK, int srcN, const float* kscale, bf16_t* dst, int ldd, int Nd, int Kd, int koff, int grp, int gstride) {
    LAS Job* j = L.jobs + L.n; j->src = src; j->kscale = kscale; j->dst = dst; j->sld = sld + L.z; j->srcK = srcK + L.z; j->srcN = srcN + L.z; j->ldd = ldd + L.z; j->Nd = Nd + L.z; j->Kd = Kd + L.z; j->koff = koff + L.z; j->grp = grp + L.z; j->gstride = gstride + L.z;
    const int tn = ((Nd + 63) >> 6) + L.z; j->tn = tn; j->tile0 = L.tiles; L.tiles += tn * (Kd >> 6); L.n += 1;
}
__device__ __forceinline__ bf16_t* wmla(const Args& a, int j) { return (bf16_t*)(a.ws + WS_WMLA) + (size_t)j * E_MLA; }
__device__ __forceinline__ bf16_t* wrwkv(const Args& a, int j) { return (bf16_t*)(a.ws + WS_WRWKV) + (size_t)j * E_RWKV; }
__device__ __forceinline__ bf16_t* wffn(const Args& a, int j) { return (bf16_t*)(a.ws + WS_WFFN) + (size_t)j * E_FFN; }
__device__ __forceinline__ void jobs_small(const Args& a, JobList& L) {
#pragma unroll 1
    for (int j = 0; j < 2; ++j) {
        {
            bf16_t* w = wmla(a, j); bf16_t* qkva = w; bf16_t* qb = w + E_QKVA; bf16_t* kvb = qb + E_QB; bf16_t* wo = kvb + E_KVB;
            addjob(L, a.in[I_WQA] + (size_t)j * D * QL, QL, D, QL, nullptr, qkva, 1024, 384, 1024, 0, NOGRP, 0);
            addjob(L, a.in[I_WKVA] + (size_t)j * D * 320, 320, D, 320, nullptr, qkva + (size_t)384 * 1024, 1024, 384, 1024, 0, NOGRP, 0);
            addjob(L, a.in[I_WQB] + (size_t)j * QL * 1536, 1536, QL, 1536, a.in[I_QAN] + j * QL, qb, 384, 1536, 384, 0, NOGRP, 0);
            addjob(L, a.in[I_WKVB] + (size_t)j * KVL * 2048, 2048, KVL, 2048, a.in[I_KVAN] + j * KVL, kvb, 384, 2048, 256, 0, NOGRP, 0);
            addjob(L, a.in[I_MWO] + (size_t)j * D * D, D, D, D, nullptr, wo, 1024, 1024, 1024, 0, NOGRP, 0);
        }
        {
            bf16_t* w = wrwkv(a, j); bf16_t* b1 = w; bf16_t* b2 = b1 + E_B1; bf16_t* l1 = b2 + E_B2; bf16_t* l2a = l1 + E_L1; bf16_t* l2b = l2a + E_L2A;
            const float* mix = a.in[I_MIX] + (size_t)j * 6 * D;
            addjob(L, a.in[I_WR] + (size_t)j * D * D, D, D, D, nullptr, b1, LDB1, 1024, 1024, 0, NOGRP, 0);
            addjob(L, a.in[I_WK] + (size_t)j * D * D, D, D, D, nullptr, b1 + 1024, LDB1, 1024, 1024, 0, NOGRP, 0);
            addjob(L, a.in[I_WV] + (size_t)j * D * D, D, D, D, nullptr, b2, LDB1, 1024, 1024, 0, NOGRP, 0);
            addjob(L, a.in[I_RWO] + (size_t)j * D * D, D, D, D, nullptr, b2 + E_B2 + E_L1 + E_L2A + E_L2B, 1024, 1024, 1024, 0, NOGRP, 0);
            for (int d = 0; d < 2; ++d) {
                const float* w1 = a.in[I_W1] + (size_t)(j * 2 + d) * D * 64; const float* a1 = a.in[I_A1] + (size_t)(j * 2 + d) * D * 64;
                addjob(L, w1, 64, D, 64, nullptr, l1 + (size_t)(d * 64) * LDB1, LDB1, 64, 1024, 0, NOGRP, 0);
                addjob(L, w1, 64, D, 64, mix + 1 * D, l1 + (size_t)(d * 64) * LDB1 + 1024, LDB1, 64, 1024, 0, NOGRP, 0);
                addjob(L, a1, 64, D, 64, nullptr, l1 + (size_t)(128 + d * 64) * LDB1, LDB1, 64, 1024, 0, NOGRP, 0);
                addjob(L, a1, 64, D, 64, mix + 4 * D, l1 + (size_t)(128 + d * 64) * LDB1 + 1024, LDB1, 64, 1024, 0, NOGRP, 0);
            }
            const float* v1 = (j == 1) ? a.in[I_V1] : nullptr;
            addjob(L, v1, 32, D, 32, nullptr, l1 + (size_t)256 * LDB1, LDB1, 64, 1024, 0, NOGRP, 0);
            addjob(L, v1, 32, D, 32, mix + 3 * D, l1 + (size_t)256 * LDB1 + 1024, LDB1, 64, 1024, 0, NOGRP, 0);
            addjob(L, a.in[I_G1] + (size_t)j * D * 160, 160, D, 160, nullptr, l1 + (size_t)320 * LDB1, LDB1, 192, 1024, 0, NOGRP, 0);
            addjob(L, a.in[I_G1] + (size_t)j * D * 160, 160, D, 160, mix + 5 * D, l1 + (size_t)320 * LDB1 + 1024, LDB1, 192, 1024, 0, NOGRP, 0);
            for (int d = 0; d < 2; ++d) {
                addjob(L, a.in[I_W2] + (size_t)(j * 2 + d) * 64 * D, D, 64, D, nullptr, l2a + (size_t)(d * 1024) * 256, 256, 1024, 256, d * 64, NOGRP, 0);
                addjob(L, a.in[I_A2] + (size_t)(j * 2 + d) * 64 * D, D, 64, D, nullptr, l2a + (size_t)(2048 + d * 1024) * 256, 256, 1024, 256, 128 + d * 64, NOGRP, 0);
            }
            addjob(L, a.in[I_G2] + (size_t)j * 160 * D, D, 160, D, nullptr, l2b, 256, 1024, 256, 64, NOGRP, 0);
            addjob(L, (j == 1) ? a.in[I_V2] : nullptr, D, 32, D, nullptr, l2b + (size_t)1024 * 256, 256, 1024, 256, 0, NOGRP, 0);
        }
        {
            bf16_t* w = wffn(a, j);
            addjob(L, a.in[I_F1] + (size_t)j * D * DFF, DFF, D, DFF, nullptr, w, 1024, DFF, 1024, 0, 128, 256);
            addjob(L, a.in[I_F3] + (size_t)j * D * DFF, DFF, D, DFF, nullptr, w + (size_t)128 * 1024, 1024, DFF, 1024, 0, 128, 256);
            addjob(L, a.in[I_F2] + (size_t)j * DFF * D, D, DFF, D, nullptr, w + E_F13, DFF, 1024, DFF, 0, NOGRP, 0);
        }
    }
}
__device__ __forceinline__ void jobs_moe(const Args& a, JobList& L, int k) {
    bf16_t* w13 = (bf16_t*)(a.ws + WS_ARENA + A_WM13); bf16_t* w2 = (bf16_t*)(a.ws + WS_ARENA + A_WM2);
#pragma unroll 1
    for (int e = 0; e < NE; ++e) {
        const size_t so = (size_t)(k * NE + e) * D * DFE;
        addjob(L, a.in[I_M1] + so, DFE, D, DFE, nullptr, w13 + (size_t)e * E_M13, 1024, DFE, 1024, 0, 128, 256);
        addjob(L, a.in[I_M3] + so, DFE, D, DFE, nullptr, w13 + (size_t)e * E_M13 + (size_t)128 * 1024, 1024, DFE, 1024, 0, 128, 256);
        addjob(L, a.in[I_M2] + so, D, DFE, D, nullptr, w2 + (size_t)e * E_M2, DFE, 1024, DFE, 0, NOGRP, 0);
    }
}
__device__ __forceinline__ void run_prep(const Args& a, LAS unsigned char* jl, int which  , int j0  , int G, int c) {
    const int tid = ltid();
    LAS Job* jobs = (LAS Job*)jl; LAS int* hdr = (LAS int*)(jl + MAXJOB * sizeof(Job)); LAS float* tile = (LAS float*)(jl + MAXJOB * sizeof(Job) + 64);
    if (tid == 0) { JobList L{jobs, 0, 0, launder_s(0)}; if (which < 0) jobs_small(a, L); else jobs_moe(a, L, which); hdr[0] = L.n + L.z; hdr[1] = L.tiles + L.z; }
    __syncthreads();
    const int nj = hdr[0], ntile = hdr[1];
    const int kl = tid >> 4, nq = (tid & 15) * 4, sn = tid >> 3, sk = (tid & 7) * 8;
    int jcur = 0;
#define PREP_BAR() do { asm volatile("s_waitcnt lgkmcnt(0)" ::: "memory"); __builtin_amdgcn_s_barrier(); asm volatile("" ::: "memory"); } while (0)
    f32x4 vcur[2], vnxt[2];
#define PREP_FETCH(t_, dstv) do { while (jcur + 1 < nj && jobs[jcur + 1].tile0 <= (t_)) ++jcur; const LAS Job* J_ = jobs + jcur; \
        const float* src_ = J_->src; const float* ks_ = J_->kscale; const int sld_ = J_->sld, srcK_ = J_->srcK, srcN_ = J_->srcN, koff_ = J_->koff, tn_ = J_->tn, tl_ = (t_) - J_->tile0; \
        const int n0_ = (tl_ % tn_) * 64, k0_ = (tl_ / tn_) * 64; \
        _Pragma("unroll") for (int p = 0; p < 2; ++p) { const int kk = k0_ + kl + 32 * p, ksi = kk - koff_, n = n0_ + nq; f32x4 v = (f32x4){0.f, 0.f, 0.f, 0.f}; \
            if (src_ != nullptr && ksi >= 0 && ksi < srcK_ && n < srcN_) { v = *(const __attribute__((address_space(1))) f32x4*)(src_ + (size_t)ksi * sld_ + n); if (ks_) v = v * *(const __attribute__((address_space(1))) float*)(ks_ + ksi); } dstv[p] = v; } } while (0)
    int t = c + j0 * G;
    if (t < ntile) PREP_FETCH(t, vcur);
    for (; t < ntile; t += G) {
        const int jthis = jcur;
        if (t + G < ntile) PREP_FETCH(t + G, vnxt);
        const LAS Job* J = jobs + jthis;
        bf16_t* __restrict__ dst = J->dst;
        const int ldd = J->ldd, Nd = J->Nd, grp = J->grp, gstride = J->gstride, tn = J->tn, tl = t - J->tile0;
        const int n0 = (tl % tn) * 64, k0 = (tl / tn) * 64;
#pragma unroll
        for (int p = 0; p < 2; ++p) { LAS float* tp = tile + (kl + 32 * p) * 65 + nq; tp[0] = vcur[p][0]; tp[1] = vcur[p][1]; tp[2] = vcur[p][2]; tp[3] = vcur[p][3]; }
        PREP_BAR();
        { const int n = n0 + sn;
            if (n < Nd) { float f[8];
#pragma unroll
                for (int e = 0; e < 8; ++e) f[e] = tile[(sk + e) * 65 + sn];
                const int dr = (n / grp) * gstride + (n % grp);
                *(__attribute__((address_space(1))) u32x4*)(dst + (size_t)dr * ldd + k0 + sk) = pack8(f); } }
        PREP_BAR();
        vcur[0] = vnxt[0]; vcur[1] = vnxt[1];
    }
#undef PREP_FETCH
#undef PREP_BAR
    asm volatile("s_waitcnt vmcnt(0)" ::: "memory"); __syncthreads();
}

__device__ __forceinline__ void prologue_misc(const Args& a, LAS unsigned char* lds, int G, int c) {
    const int tid = ltid();
    if (c == 0) { float* rt = (float*)(a.ws + WS_ROPE);
      for (int i = tid; i < 1024; i += NTHR) { const int pos = i >> 4, j = i & 15; const double inv = 1.0 / pow(10000.0, (double)j / 16.0), ang = (double)pos * inv; rt[i] = (float)cos(ang); rt[1024 + i] = (float)sin(ang); } }
    LAS float* sc = (LAS float*)lds;
    LAS float* red = (LAS float*)(lds + 49152);
    for (int i = tid; i < 1024 * 12; i += NTHR) { const int k = i / 12, m = i % 12; float v = 0.f;
        if (m < 9) { const float x = (m < 8) ? a.in[I_C][m * D + k] : a.in[I_CCTX][k]; v = x / (1.0f + expf(-x)); } sc[i] = v; }
    __syncthreads();
    const int kq = tid >> 6, col = tid & 63;
    for (int u = c; u < 4 * 96; u += G) {
        const int layer = u / 96, n0 = (u % 96) * 64;
        const float* w = a.in[I_ADAW] + (size_t)layer * D * 6144 + n0 + col;
        float acc[9];
#pragma unroll
        for (int m = 0; m < 9; ++m) acc[m] = 0.f;
        for (int k8 = 0; k8 < 128; k8 += 8) {
            float wv[8];
#pragma unroll
            for (int e = 0; e < 8; ++e) wv[e] = w[(size_t)(kq * 128 + k8 + e) * 6144];
#pragma unroll
            for (int e = 0; e < 8; ++e) { const LAS f32x4* sp = (const LAS f32x4*)(sc + (kq * 128 + k8 + e) * 12); const f32x4 s0 = sp[0], s1 = sp[1], s2 = sp[2];
                acc[0] += s0[0] * wv[e]; acc[1] += s0[1] * wv[e]; acc[2] += s0[2] * wv[e]; acc[3] += s0[3] * wv[e];
                acc[4] += s1[0] * wv[e]; acc[5] += s1[1] * wv[e]; acc[6] += s1[2] * wv[e]; acc[7] += s1[3] * wv[e]; acc[8] += s2[0] * wv[e]; }
        }
#pragma unroll
        for (int m = 0; m < 9; ++m) red[(kq * 9 + m) * 64 + col] = acc[m];
        __syncthreads();
        for (int i = tid; i < 9 * 64; i += NTHR) { const int m = i >> 6, cc = i & 63; float s = 0.f;
#pragma unroll
            for (int q = 0; q < 8; ++q) s += red[(q * 9 + m) * 64 + cc];
            ((float*)(a.ws + WS_MODS))[(size_t)(layer * 9 + m) * 6144 + n0 + cc] = s + a.in[I_ADAB][layer * 6144 + n0 + cc]; }
        __syncthreads();
    }
}

struct RowParams { float A[16], Bv[16]; int mi; };
__device__ __forceinline__ void load_params(const Args& a, RowParams& P, int layer, int mi, const float* gain, int which, int lane) {
    const float* sh = mods_ptr(a, layer, mi, which); const float* scl = mods_ptr(a, layer, mi, which + 1);
#pragma unroll
    for (int j = 0; j < 2; ++j) { const int col = j * 512 + lane * 8;
#pragma unroll
        for (int q = 0; q < 2; ++q) { const f32x4 g = *(const f32x4*)(gain + col + 4 * q), s = *(const f32x4*)(scl + col + 4 * q), t = *(const f32x4*)(sh + col + 4 * q);
#pragma unroll
            for (int e = 0; e < 4; ++e) { P.A[j * 8 + q * 4 + e] = g[e] * (1.0f + s[e]); P.Bv[j * 8 + q * 4 + e] = t[e]; } } }
    P.mi = mi;
}
__device__ __forceinline__ void load_x16(const float* xp, int lane, float (&x)[16]) {
#pragma unroll
    for (int j = 0; j < 2; ++j)
#pragma unroll
        for (int q = 0; q < 2; ++q) { const f32x4 v = *(const f32x4*)(xp + j * 512 + lane * 8 + 4 * q); x[j * 8 + q * 4 + 0] = v[0]; x[j * 8 + q * 4 + 1] = v[1]; x[j * 8 + q * 4 + 2] = v[2]; x[j * 8 + q * 4 + 3] = v[3]; }
}
__device__ __forceinline__ void store_bf16_row(bf16_t* p, int lane, const float (&h)[16]) {
#pragma unroll
    for (int j = 0; j < 2; ++j) { u32x4 w; w.x = cvt_pk_bf16(h[j * 8 + 0], h[j * 8 + 1]); w.y = cvt_pk_bf16(h[j * 8 + 2], h[j * 8 + 3]); w.z = cvt_pk_bf16(h[j * 8 + 4], h[j * 8 + 5]); w.w = cvt_pk_bf16(h[j * 8 + 6], h[j * 8 + 7]);
        *(u32x4*)(p + j * 512 + lane * 8) = w; }
}
__device__ __forceinline__ void moe_combine16(const Args& a, int row, int layer_prev, int lane, float (&x)[16]) {
    const u32x4 rt = *(const u32x4*)(a.ws + WS_ROUTE + (size_t)row * 16);
    const int e0 = (int)rt[0];
    if (e0 < 0) return;
    const float p0 = __uint_as_float(rt[2]), p1 = __uint_as_float(rt[3]);
    const int* sl = (const int*)(a.ws + WS_RSLOT) + (size_t)row * 2; const int s0 = sl[0], s1 = sl[1];
    const bf16_t* y2 = (const bf16_t*)(a.ws + WS_ARENA + A_Y2);
    const float* g5 = mods_ptr(a, layer_prev, mod_index(row), 5);
    const MoeSplit sp = moe_split(((const int*)(a.ws + WS_META))[8]);
    const int x0 = (s0 >> 8) >= sp.nMf ? sp.S : 1, x1 = (s1 >> 8) >= sp.nMf ? sp.S : 1;
    const size_t o0 = ((size_t)(XP0 + (s0 >> 8) - sp.nMf) * 256 + (s0 & 255)) * 1024, o1 = ((size_t)(XP0 + (s1 >> 8) - sp.nMf) * 256 + (s1 & 255)) * 1024, ostep = (size_t)sp.nT * 256 * 1024;
#pragma unroll
    for (int j = 0; j < 2; ++j) { const int col = j * 512 + lane * 8; float ya[8], yb[8];
        unpack8(*(const u32x4*)(y2 + (size_t)s0 * 1024 + col), ya); unpack8(*(const u32x4*)(y2 + (size_t)s1 * 1024 + col), yb);
        for (int sl = 1; sl < x0; ++sl) { float t[8]; unpack8(*(const u32x4*)(y2 + o0 + (size_t)(sl - 1) * ostep + col), t);
#pragma unroll
            for (int e = 0; e < 8; ++e) ya[e] += t[e]; }
        for (int sl = 1; sl < x1; ++sl) { float t[8]; unpack8(*(const u32x4*)(y2 + o1 + (size_t)(sl - 1) * ostep + col), t);
#pragma unroll
            for (int e = 0; e < 8; ++e) yb[e] += t[e]; }
        const f32x4 g0 = *(const f32x4*)(g5 + col), g1 = *(const f32x4*)(g5 + col + 4);
#pragma unroll
        for (int e = 0; e < 8; ++e) x[j * 8 + e] += (e < 4 ? g0[e] : g1[e - 4]) * (p0 * ya[e] + p1 * yb[e]); }
}
__device__ __forceinline__ void store_x16(float* xp, int lane, const float (&x)[16]) {
#pragma unroll
    for (int j = 0; j < 2; ++j)
#pragma unroll
        for (int q = 0; q < 2; ++q) *(f32x4*)(xp + j * 512 + lane * 8 + 4 * q) = (f32x4){x[j * 8 + q * 4], x[j * 8 + q * 4 + 1], x[j * 8 + q * 4 + 2], x[j * 8 + q * 4 + 3]};
}
__device__ __forceinline__ void norm_row(const float (&x)[16], const RowParams& P, float (&h)[16]) {
    float ss = 0.f;
#pragma unroll
    for (int e = 0; e < 16; ++e) ss += x[e] * x[e];
    ss = wave_sum_dpp(ss);
    const float rstd = __builtin_amdgcn_rsqf(ss * (1.0f / 1024.0f) + NORM_EPS);
#pragma unroll
    for (int e = 0; e < 16; ++e) h[e] = x[e] * rstd * P.A[e] + P.Bv[e];
}
__device__ __forceinline__ void wave_rows(int G, int c, int& r0, int& r1) {
    const int nw = G * NWAVE, per = (R + nw - 1) / nw, gw = c * NWAVE + (ltid() >> 6);
    r0 = gw * per; r1 = r0 + per; if (r0 > R) r0 = R; if (r1 > R) r1 = R;
}
template <bool COMBINE, bool FIRST = false>
__device__ __forceinline__ void norm_plain(const Args& a, int layer, const float* gain, int which, bf16_t* Hout, int G, int c) {
    const int lane = ltid() & 63; int r0, r1; wave_rows(G, c, r0, r1);
    RowParams P; P.mi = -1;
    for (int row = r0; row < r1; ++row) {
        const int mi = mod_index(row); if (mi != P.mi) load_params(a, P, layer, mi, gain, which, lane);
        float* xp = xrow(a, row); float x[16], h[16]; load_x16(FIRST ? xrow_in(a, row) : xp, lane, x);
        if (COMBINE) { moe_combine16(a, row, layer - 1, lane, x); store_x16(xp, lane, x); }
        norm_row(x, P, h); store_bf16_row(Hout + (size_t)row * 1024, lane, h);
    }
}
struct CMeta { u32x4 rt; int s0, s1; };
struct CData { f32x4 x[4]; u32x4 y[4]; };
__device__ __forceinline__ void cm_load(const Args& a, int row, CMeta& m) {
    m.rt = *(const u32x4*)(a.ws + WS_ROUTE + (size_t)row * 16);
    const int* sl = (const int*)(a.ws + WS_RSLOT) + (size_t)row * 2; m.s0 = sl[0]; m.s1 = sl[1];
}
__device__ __forceinline__ void cd_load(const Args& a, int row, const CMeta& m, int lane, CData& d) {
    const float* xp = xrow(a, row);
#pragma unroll
    for (int j = 0; j < 2; ++j)
#pragma unroll
        for (int q = 0; q < 2; ++q) d.x[j * 2 + q] = *(const f32x4*)(xp + j * 512 + lane * 8 + 4 * q);
    if ((int)m.rt[0] >= 0) { const bf16_t* y2 = (const bf16_t*)(a.ws + WS_ARENA + A_Y2);
#pragma unroll
        for (int j = 0; j < 2; ++j) { d.y[j * 2] = *(const u32x4*)(y2 + (size_t)m.s0 * 1024 + j * 512 + lane * 8); d.y[j * 2 + 1] = *(const u32x4*)(y2 + (size_t)m.s1 * 1024 + j * 512 + lane * 8); } }
}
template <bool NORM>
__device__ __forceinline__ void combine_rows(const Args& a, int layer_prev, int layer, const float* gain, int which, bf16_t* Hout, int G, int c) {
    const int lane = ltid() & 63; int r0, r1; wave_rows(G, c, r0, r1); if (r0 >= r1) return;
    const bf16_t* y2 = (const bf16_t*)(a.ws + WS_ARENA + A_Y2);
    const MoeSplit sp = moe_split(((const int*)(a.ws + WS_META))[8]);
    const size_t ostep = (size_t)sp.nT * 256 * 1024;
    RowParams P; P.mi = -1; float g5[16]; int gmi = -1;
    CMeta m0, m1, m2; CData d0, dn;
    cm_load(a, r0, m0); m1 = m0; if (r0 + 1 < r1) cm_load(a, r0 + 1, m1);
    cd_load(a, r0, m0, lane, d0);
    for (int row = r0; row < r1; ++row) {
        m2 = m1; if (row + 2 < r1) cm_load(a, row + 2, m2);
        dn = d0; if (row + 1 < r1) cd_load(a, row + 1, m1, lane, dn);
        const int mi = mod_index(row);
        if (mi != gmi) { const float* gp = mods_ptr(a, layer_prev, mi, 5); gmi = mi;
#pragma unroll
            for (int j = 0; j < 2; ++j)
#pragma unroll
                for (int q = 0; q < 2; ++q) { const f32x4 v = *(const f32x4*)(gp + j * 512 + lane * 8 + 4 * q); g5[j * 8 + q * 4] = v[0]; g5[j * 8 + q * 4 + 1] = v[1]; g5[j * 8 + q * 4 + 2] = v[2]; g5[j * 8 + q * 4 + 3] = v[3]; } }
        float x[16];
#pragma unroll
        for (int i = 0; i < 4; ++i) { x[i * 4] = d0.x[i][0]; x[i * 4 + 1] = d0.x[i][1]; x[i * 4 + 2] = d0.x[i][2]; x[i * 4 + 3] = d0.x[i][3]; }
        const bool routed = (int)m0.rt[0] >= 0;
        if (routed) { const float p0 = __uint_as_float(m0.rt[2]), p1 = __uint_as_float(m0.rt[3]); const int s0 = m0.s0, s1 = m0.s1;
            const int x0 = (s0 >> 8) >= sp.nMf ? sp.S : 1, x1 = (s1 >> 8) >= sp.nMf ? sp.S : 1;
            const size_t o0 = ((size_t)(XP0 + (s0 >> 8) - sp.nMf) * 256 + (s0 & 255)) * 1024, o1 = ((size_t)(XP0 + (s1 >> 8) - sp.nMf) * 256 + (s1 & 255)) * 1024;
#pragma unroll
            for (int j = 0; j < 2; ++j) { const int col = j * 512 + lane * 8; float ya[8], yb[8]; unpack8(d0.y[j * 2], ya); unpack8(d0.y[j * 2 + 1], yb);
                for (int sl = 1; sl < x0; ++sl) { float t[8]; unpack8(*(const u32x4*)(y2 + o0 + (size_t)(sl - 1) * ostep + col), t);
#pragma unroll
                    for (int e = 0; e < 8; ++e) ya[e] += t[e]; }
                for (int sl = 1; sl < x1; ++sl) { float t[8]; unpack8(*(const u32x4*)(y2 + o1 + (size_t)(sl - 1) * ostep + col), t);
#pragma unroll
                    for (int e = 0; e < 8; ++e) yb[e] += t[e]; }
#pragma unroll
                for (int e = 0; e < 8; ++e) x[j * 8 + e] += g5[j * 8 + e] * (p0 * ya[e] + p1 * yb[e]); } }
        if (NORM || routed) store_x16(xrow(a, row), lane, x);
        if (NORM) { if (mi != P.mi) load_params(a, P, layer, mi, gain, which, lane); float h[16]; norm_row(x, P, h); store_bf16_row(Hout + (size_t)row * 1024, lane, h); }
        d0 = dn; m0 = m1; m1 = m2;
    }
}
__device__ __forceinline__ bool seg_first(int row) { const int r = row % SEG; return r == 0 || r == CTX; }
__device__ __forceinline__ bool seg_last(int row) { const int r = row % SEG; return r == CTX - 1 || r == SEG - 1; }
__device__ __forceinline__ void norm_mix(const Args& a, int layer, int j, int G, int c) {
    const int lane = ltid() & 63; int r0, r1; wave_rows(G, c, r0, r1); if (r0 >= r1) return;
    const float* gain = a.in[I_N1G] + layer * D; const float* mix = a.in[I_MIX] + (size_t)j * 6 * D;
    bf16_t* AX = (bf16_t*)(a.ws + WS_ARENA + A_AX);
    float mr[16], mk[16], mv[16];
#pragma unroll
    for (int jj = 0; jj < 2; ++jj)
#pragma unroll
        for (int e = 0; e < 8; ++e) { const int col = jj * 512 + lane * 8 + e; mr[jj * 8 + e] = mix[col]; mk[jj * 8 + e] = mix[2 * D + col]; mv[jj * 8 + e] = mix[3 * D + col]; }
    RowParams P; P.mi = -1;
    float hp[16], hc[16], hn[16], x[16];
    if (!seg_first(r0)) { const int mi = mod_index(r0 - 1); if (mi != P.mi) load_params(a, P, layer, mi, gain, 0, lane); load_x16(xrow(a, r0 - 1), lane, x); norm_row(x, P, hp); }
    else {
#pragma unroll
        for (int e = 0; e < 16; ++e) hp[e] = 0.f; }
    { const int mi = mod_index(r0); if (mi != P.mi) load_params(a, P, layer, mi, gain, 0, lane); load_x16(xrow(a, r0), lane, x); norm_row(x, P, hc); }
    if (r0 + 1 < R) load_x16(xrow(a, r0 + 1), lane, x);
    for (int row = r0; row < r1; ++row) {
        float xq[16];
        if (row + 2 < R && row + 1 < r1) load_x16(xrow(a, row + 2), lane, xq);
        if (row + 1 < R) { const int mi = mod_index(row + 1); if (mi != P.mi) load_params(a, P, layer, mi, gain, 0, lane); norm_row(x, P, hn); }
        else {
#pragma unroll
            for (int e = 0; e < 16; ++e) hn[e] = 0.f; }
#pragma unroll
        for (int e = 0; e < 16; ++e) x[e] = xq[e];
        const float fp = seg_first(row) ? 0.f : 0.5f, fn = seg_last(row) ? 0.f : 0.5f;
        float xx[16], t[16];
#pragma unroll
        for (int e = 0; e < 16; ++e) xx[e] = fp * hp[e] + fn * hn[e] - hc[e];
        bf16_t* o = AX + (size_t)row * 5120;
        store_bf16_row(o, lane, hc); store_bf16_row(o + 1024, lane, xx);
#pragma unroll
        for (int e = 0; e < 16; ++e) t[e] = hc[e] + xx[e] * mr[e];
        store_bf16_row(o + 2048, lane, t);
#pragma unroll
        for (int e = 0; e < 16; ++e) t[e] = hc[e] + xx[e] * mk[e];
        store_bf16_row(o + 3072, lane, t);
#pragma unroll
        for (int e = 0; e < 16; ++e) t[e] = hc[e] + xx[e] * mv[e];
        store_bf16_row(o + 4096, lane, t);
#pragma unroll
        for (int e = 0; e < 16; ++e) { hp[e] = hc[e]; hc[e] = hn[e]; }
    }
}
__device__ __forceinline__ void norm_router(const Args& a, int layer, int k, bool last, LAS unsigned char* lds, int G, int c) {
    const int tid = ltid(), lane = tid & 63; int r0, r1; wave_rows(G, c, r0, r1);
    LAS float* rw = (LAS float*)lds;
    { const float* rsrc = a.in[I_ROUTER] + (size_t)k * D * NE; for (int i = tid; i < D * NE; i += NTHR) rw[(i >> 6) * 68 + (i & 63)] = rsrc[i]; }
    __syncthreads();
    const float* gain = a.in[I_N2G] + layer * D;
    bf16_t* Hout = (bf16_t*)(a.ws + WS_ARENA + A_H);
    RowParams P; P.mi = -1;
    int hist[8];
#pragma unroll
    for (int e = 0; e < 8; ++e) hist[e] = 0;
    float xn[16];
    if (r0 < r1) load_x16(xrow(a, r0), lane, xn);
    for (int row = r0; row < r1; ++row) {
        const int mi = mod_index(row); if (mi != P.mi) load_params(a, P, layer, mi, gain, 3, lane);
        float x[16], h[16];
#pragma unroll
        for (int e = 0; e < 16; ++e) x[e] = xn[e];
        if (row + 1 < r1) load_x16(xrow(a, row + 1), lane, xn);
        { float ss = 0.f;
#pragma unroll
          for (int e = 0; e < 16; ++e) ss += x[e] * x[e];
          ss = wave_sum_dpp(ss);
          const float rstd = __builtin_amdgcn_rsqf(ss * (1.0f / 1024.0f) + NORM_EPS);
#pragma unroll
          for (int e = 0; e < 16; ++e) h[e] = x[e] * rstd * P.A[e] + P.Bv[e]; }
        store_bf16_row(Hout + (size_t)row * 1024, lane, h);
        const bool routed = !(last && mi == 8);
        float lg[8];
#pragma unroll
        for (int e = 0; e < 8; ++e) lg[e] = 0.f;
#pragma unroll
        for (int jj = 0; jj < 2; ++jj)
#pragma unroll
            for (int q = 0; q < 8; ++q) { const LAS f32x4* rp = (const LAS f32x4*)(rw + (jj * 64 + lane) * 68 + q * 8); const f32x4 w0 = rp[0], w1 = rp[1]; const float hv = h[jj * 8 + q];
                lg[0] += hv * w0[0]; lg[1] += hv * w0[1]; lg[2] += hv * w0[2]; lg[3] += hv * w0[3]; lg[4] += hv * w1[0]; lg[5] += hv * w1[1]; lg[6] += hv * w1[2]; lg[7] += hv * w1[3]; }
#pragma unroll
        for (int e = 0; e < 8; ++e) lg[e] = wave_sum_dpp(lg[e]);
        int e0 = 0; float v0 = lg[0];
#pragma unroll
        for (int e = 1; e < 8; ++e) if (lg[e] > v0) { v0 = lg[e]; e0 = e; }
        int e1 = -1; float v1 = -3.0e38f;
#pragma unroll
        for (int e = 0; e < 8; ++e) if (e != e0 && lg[e] > v1) { v1 = lg[e]; e1 = e; }
        const float p0 = __builtin_amdgcn_rcpf(1.0f + __expf(v1 - v0)), p1 = 1.0f - p0;
        if (routed) {
#pragma unroll
            for (int e = 0; e < 8; ++e) hist[e] += (e == e0 || e == e1) ? 1 : 0; }
        if (lane == 0) *(u32x4*)(a.ws + WS_ROUTE + (size_t)row * 16) = (u32x4){(unsigned)(routed ? e0 : -1), (unsigned)(routed ? e1 : -1), __float_as_uint(p0), __float_as_uint(p1)};
    }
    const int gw = c * NWAVE + (tid >> 6);
    if (lane == 0) { int* hp = (int*)(a.ws + WS_HIST) + (size_t)gw * 8;
#pragma unroll
        for (int e = 0; e < 8; ++e) hp[e] = hist[e]; }
}

__device__ __forceinline__ void mla_stats(const Args& a, int G, int c) {
    const int lane = ltid() & 63; int r0, r1; wave_rows(G, c, r0, r1);
    const bf16_t* QKVA = (const bf16_t*)(a.ws + WS_ARENA + A_QKVA); float* rs = (float*)(a.ws + WS_RS);
    for (int row = r0; row < r1; ++row) {
        float sq = 0.f, skv = 0.f; float f[8];
        if (lane < 48) { unpack8(*(const u32x4*)(QKVA + (size_t)row * 768 + lane * 8), f);
#pragma unroll
            for (int e = 0; e < 8; ++e) sq += f[e] * f[e]; }
        if (lane < 32) { unpack8(*(const u32x4*)(QKVA + (size_t)row * 768 + 384 + lane * 8), f);
#pragma unroll
            for (int e = 0; e < 8; ++e) skv += f[e] * f[e]; }
        sq = wave_sum_dpp(sq); skv = wave_sum_dpp(skv);
        if (lane == 0) { rs[row] = 1.0f / sqrtf(sq * (1.0f / 384.0f) + NORM_EPS); rs[R + row] = 1.0f / sqrtf(skv * (1.0f / 256.0f) + NORM_EPS); }
    }
}
__device__ __forceinline__ void mla_qkpost(const Args& a, int j, int G, int c) {
    const int lane = ltid() & 63, hd = lane >> 3, sub = lane & 7; int r0, r1; wave_rows(G, c, r0, r1);
    bf16_t* Q = (bf16_t*)(a.ws + WS_ARENA + A_Q); const bf16_t* KV = (const bf16_t*)(a.ws + WS_ARENA + A_KV); const bf16_t* QKVA = (const bf16_t*)(a.ws + WS_ARENA + A_QKVA);
    bf16_t* K = (bf16_t*)(a.ws + WS_ARENA + A_K); const float* rt = (const float*)(a.ws + WS_ROPE);
    float gq[3][8], gk[3][8];
#pragma unroll
    for (int cc = 0; cc < 3; ++cc)
#pragma unroll
        for (int e = 0; e < 8; ++e) { gq[cc][e] = a.in[I_QN][j * QKH + cc * 64 + sub * 8 + e]; gk[cc][e] = a.in[I_KN][j * QKH + cc * 64 + sub * 8 + e]; }
    const float sgn = (sub & 2) ? 1.0f : -1.0f;
    for (int row = r0; row < r1; ++row) {
        const int r = row % SEG; const bool lat = r >= CTX; const int t = r - CTX, pos = (sub & 4) ? (t & 63) : (t >> 6);
        float cs[8], sn[8];
        if (lat) {
#pragma unroll
            for (int q = 0; q < 2; ++q) { const f32x4 cv = *(const f32x4*)(rt + pos * 16 + (sub & 1) * 8 + 4 * q), sv = *(const f32x4*)(rt + 1024 + pos * 16 + (sub & 1) * 8 + 4 * q);
#pragma unroll
                for (int e = 0; e < 4; ++e) { cs[q * 4 + e] = cv[e]; sn[q * 4 + e] = sv[e]; } } }
        float v[3][8];
        bf16_t* qp = Q + (size_t)row * 1536 + hd * QKH + sub * 8;
#pragma unroll
        for (int cc = 0; cc < 3; ++cc) unpack8(*(const u32x4*)(qp + cc * 64), v[cc]);
        { float ss = 0.f;
#pragma unroll
          for (int cc = 0; cc < 3; ++cc)
#pragma unroll
              for (int e = 0; e < 8; ++e) ss += v[cc][e] * v[cc][e];
          ss = red8(ss); const float rstd = 1.0f / sqrtf(ss * (1.0f / 192.0f) + NORM_EPS);
#pragma unroll
          for (int cc = 0; cc < 3; ++cc)
#pragma unroll
              for (int e = 0; e < 8; ++e) v[cc][e] = v[cc][e] * rstd * gq[cc][e];
          if (lat) {
#pragma unroll
              for (int e = 0; e < 8; ++e) { const float pr = __shfl_xor(v[2][e], 2); v[2][e] = v[2][e] * cs[e] + sgn * pr * sn[e]; } }
#pragma unroll
          for (int cc = 0; cc < 3; ++cc) {
#pragma unroll
              for (int e = 0; e < 8; ++e) v[cc][e] *= QSCALE;
              *(u32x4*)(qp + cc * 64) = pack8(v[cc]); } }
        const bf16_t* kp = KV + (size_t)row * LDKV + hd * 256 + sub * 8;
        unpack8(*(const u32x4*)(kp), v[0]); unpack8(*(const u32x4*)(kp + 64), v[1]); unpack8(*(const u32x4*)(QKVA + (size_t)row * 768 + 640 + sub * 8), v[2]);
        { float ss = 0.f;
#pragma unroll
          for (int cc = 0; cc < 3; ++cc)
#pragma unroll
              for (int e = 0; e < 8; ++e) ss += v[cc][e] * v[cc][e];
          ss = red8(ss); const float rstd = 1.0f / sqrtf(ss * (1.0f / 192.0f) + NORM_EPS);
#pragma unroll
          for (int cc = 0; cc < 3; ++cc)
#pragma unroll
              for (int e = 0; e < 8; ++e) v[cc][e] = v[cc][e] * rstd * gk[cc][e];
          if (lat) {
#pragma unroll
              for (int e = 0; e < 8; ++e) { const float pr = __shfl_xor(v[2][e], 2); v[2][e] = v[2][e] * cs[e] + sgn * pr * sn[e]; } }
          bf16_t* ko = K + (size_t)row * 1536 + hd * QKH + sub * 8;
#pragma unroll
          for (int cc = 0; cc < 3; ++cc) *(u32x4*)(ko + cc * 64) = pack8(v[cc]); }
    }
}

namespace att {
constexpr int KVBLK = 64, KROWB = 384;
constexpr int SHM_V = KVBLK * 128 * 2, SHM_K = KVBLK * KROWB;
constexpr int SHM_ATTN = 2 * SHM_V + 2 * SHM_K + NWAVE * 64 * 4;
constexpr float THR = 11.5f;
#define KSWZ(row, colB) ((row) * att::KROWB + ((colB) ^ (((row) & 7) << 4)))
#define SBAR() __builtin_amdgcn_sched_barrier(0)
__device__ __forceinline__ int crow(int r, int hi) { return (r & 3) + 8 * (r >> 2) + 4 * hi; }
__device__ __forceinline__ void partialSM(f32x16& p0, f32x16& p1, float& m_reg, float& mn, float& alpha) {
    float pmax = p0[0];
#pragma unroll
    for (int r = 1; r < 16; ++r) pmax = fmaxf(pmax, p0[r]);
#pragma unroll
    for (int r = 0; r < 16; ++r) pmax = fmaxf(pmax, p1[r]);
    { auto rr = __builtin_amdgcn_permlane32_swap(__float_as_uint(pmax), __float_as_uint(pmax), false, false); pmax = fmaxf(__uint_as_float(rr[0]), __uint_as_float(rr[1])); }
    if (__builtin_expect(__all(pmax - m_reg <= THR), 1)) { mn = m_reg; alpha = 1.f; }
    else { mn = fmaxf(m_reg, pmax); alpha = __builtin_amdgcn_exp2f(m_reg - mn); m_reg = mn; }
#pragma unroll
    for (int r = 0; r < 16; ++r) { p0[r] -= mn; p1[r] -= mn; }
#pragma unroll
    for (int r = 0; r < 16; ++r) p0[r] = __builtin_amdgcn_exp2f(p0[r]);
}
__device__ __forceinline__ void finishSM(f32x16& p0, f32x16& p1, float alpha, float& l_reg, bf16x8& pa0, bf16x8& pa1, bf16x8& pa2, bf16x8& pa3) {
#pragma unroll
    for (int r = 0; r < 16; ++r) p1[r] = __builtin_amdgcn_exp2f(p1[r]);
    float ps = 0;
#pragma unroll
    for (int r = 0; r < 16; ++r) ps += p0[r];
#pragma unroll
    for (int r = 0; r < 16; ++r) ps += p1[r];
    { auto rr = __builtin_amdgcn_permlane32_swap(__float_as_uint(ps), __float_as_uint(ps), false, false); ps = __uint_as_float(rr[0]) + __uint_as_float(rr[1]); }
    l_reg = l_reg * alpha + ps;
#define PK4(P, BASE, OUT) do { unsigned a0 = cvt_pk_bf16(P[BASE + 0], P[BASE + 1]), a1 = cvt_pk_bf16(P[BASE + 2], P[BASE + 3]);   \
    unsigned b0 = cvt_pk_bf16(P[BASE + 4], P[BASE + 5]), b1 = cvt_pk_bf16(P[BASE + 6], P[BASE + 7]);                              \
    auto r0 = __builtin_amdgcn_permlane32_swap(a0, b0, false, false); auto r1 = __builtin_amdgcn_permlane32_swap(a1, b1, false, false); \
    u32x4 w = {r0[0], r1[0], r0[1], r1[1]}; OUT = *reinterpret_cast<bf16x8*>(&w); } while (0)
    PK4(p0, 0, pa0); PK4(p0, 8, pa1); PK4(p1, 0, pa2); PK4(p1, 8, pa3);
#undef PK4
}
__device__ __forceinline__ void qkt(f32x16& p0, f32x16& p1, const char* Ks, const bf16x8* qr, int r32, int hi) {
    p0 = f32x16{}; p1 = f32x16{};
    bf16x8 ka[4], kb[4];
#define QK_LD(buf, g) do { _Pragma("unroll") for (int q_ = 0; q_ < 2; ++q_) { const int cb_ = ((2 * (g) + q_) * 16 + hi * 8) * 2; \
        buf[2 * q_] = *reinterpret_cast<const bf16x8*>(Ks + KSWZ(r32, cb_)); buf[2 * q_ + 1] = *reinterpret_cast<const bf16x8*>(Ks + KSWZ(32 + r32, cb_)); } } while (0)
#define QK_MM(buf, g) do { _Pragma("unroll") for (int q_ = 0; q_ < 2; ++q_) { p0 = __builtin_amdgcn_mfma_f32_32x32x16_bf16(buf[2 * q_], qr[2 * (g) + q_], p0, 0, 0, 0); \
        p1 = __builtin_amdgcn_mfma_f32_32x32x16_bf16(buf[2 * q_ + 1], qr[2 * (g) + q_], p1, 0, 0, 0); } } while (0)
    QK_LD(ka, 0); SBAR();
    QK_LD(kb, 1); SBAR(); QK_MM(ka, 0); SBAR();
    QK_LD(ka, 2); SBAR(); QK_MM(kb, 1); SBAR();
    QK_LD(kb, 3); SBAR(); QK_MM(ka, 2); SBAR();
    QK_LD(ka, 4); SBAR(); QK_MM(kb, 3); SBAR();
    QK_LD(kb, 5); SBAR(); QK_MM(ka, 4); SBAR();
    QK_MM(kb, 5); SBAR();
#undef QK_LD
#undef QK_MM
}
__device__ __forceinline__ int v_st(int k, int c) { const int kk = (k & ~0xC) | ((k & 4) << 1) | ((k & 8) >> 1); return ((kk >> 3) * 4 + (c >> 5)) * 512 + ((kk & 7) * 32 + (c & 31)) * 2; }
__device__ __forceinline__ int v_rd_base(int lane) { return ((lane & 3) << 3) | (((lane >> 2) & 3) << 6) | (((lane >> 4) & 1) << 5) | (((lane >> 5) & 1) << 8); }
constexpr int v_rd_off(int d0, int ks, int half) { return d0 * 512 + ks * 4096 + half * 2048; }
template <int OFF> __device__ __forceinline__ s16x4 tr_read(int vb) { s16x4 r; asm volatile("ds_read_b64_tr_b16 %0, %1 offset:%2" : "=&v"(r) : "v"(vb), "i"(OFF) : "memory"); return r; }
struct VFrag { s16x4 l0, h0, l1, h1, l2, h2, l3, h3; };
template <int D0> __device__ __forceinline__ void pv_issue(VFrag& f, int vb) {
    f.l0 = tr_read<v_rd_off(D0, 0, 0)>(vb); f.h0 = tr_read<v_rd_off(D0, 0, 1)>(vb); f.l1 = tr_read<v_rd_off(D0, 1, 0)>(vb); f.h1 = tr_read<v_rd_off(D0, 1, 1)>(vb);
    f.l2 = tr_read<v_rd_off(D0, 2, 0)>(vb); f.h2 = tr_read<v_rd_off(D0, 2, 1)>(vb); f.l3 = tr_read<v_rd_off(D0, 3, 0)>(vb); f.h3 = tr_read<v_rd_off(D0, 3, 1)>(vb);
}
__device__ __forceinline__ void pv_mma(f32x16& od, const VFrag& f, bf16x8 pa0, bf16x8 pa1, bf16x8 pa2, bf16x8 pa3) {
#define PK(L, H) (bf16x8){L[0], L[1], L[2], L[3], H[0], H[1], H[2], H[3]}
    od = __builtin_amdgcn_mfma_f32_32x32x16_bf16(pa0, PK(f.l0, f.h0), od, 0, 0, 0);
    od = __builtin_amdgcn_mfma_f32_32x32x16_bf16(pa1, PK(f.l1, f.h1), od, 0, 0, 0);
    od = __builtin_amdgcn_mfma_f32_32x32x16_bf16(pa2, PK(f.l2, f.h2), od, 0, 0, 0);
    od = __builtin_amdgcn_mfma_f32_32x32x16_bf16(pa3, PK(f.l3, f.h3), od, 0, 0, 0);
#undef PK
}
__device__ __forceinline__ void pv_d0(f32x16* o, int vb, bf16x8 pa0, bf16x8 pa1, bf16x8 pa2, bf16x8 pa3) {
    VFrag fa, fb;
    pv_issue<0>(fa, vb); pv_issue<1>(fb, vb);
    asm volatile("s_waitcnt lgkmcnt(8)" ::: "memory"); SBAR(); pv_mma(o[0], fa, pa0, pa1, pa2, pa3); SBAR();
    pv_issue<2>(fa, vb);
    asm volatile("s_waitcnt lgkmcnt(8)" ::: "memory"); SBAR(); pv_mma(o[1], fb, pa0, pa1, pa2, pa3); SBAR();
    pv_issue<3>(fb, vb);
    asm volatile("s_waitcnt lgkmcnt(8)" ::: "memory"); SBAR(); pv_mma(o[2], fa, pa0, pa1, pa2, pa3); SBAR();
    asm volatile("s_waitcnt lgkmcnt(0)" ::: "memory"); SBAR(); pv_mma(o[3], fb, pa0, pa1, pa2, pa3);
}
__device__ __forceinline__ void attn_unit(const bf16_t* __restrict__ Qb, const bf16_t* __restrict__ Kh, const bf16_t* __restrict__ Vh, bf16_t* __restrict__ Ob, int seq, char* lds) {
    constexpr int LDQ = 1536, LDK = 1536, LDV = LDKV, LDO = 1024;
    const int tid = ltid(), wid = tid >> 6, lane = tid & 63, r32 = lane & 31, hi = lane >> 5;
    char* V_lds = lds; char* K_lds = lds + 2 * SHM_V;
    float* wsp = (float*)(lds + 2 * SHM_V + 2 * SHM_K) + wid * 64; float* li_l = wsp; float* al_l = wsp + 32;
    float m_reg = -1e30f, l_reg = 0; f32x16 o[4] = {}; bf16x8 qr[12];
    const bf16_t* Qw = Qb + (long)(wid * 32 + r32) * LDQ + hi * 8;
#pragma unroll
    for (int d0 = 0; d0 < 12; ++d0) qr[d0] = *(const __attribute__((address_space(1))) bf16x8*)((const __attribute__((address_space(1))) bf16_t*)Qw + d0 * 16);
    const int sr = tid >> 4, sc = (tid & 15) * 8, vst0 = v_st(sr, sc), vst1 = v_st(32 + sr, sc);
    int kkey[3], kcb[3];
#pragma unroll
    for (int i = 0; i < 3; ++i) { const int ci = tid + i * 512; kkey[i] = ci / 24; kcb[i] = (ci % 24) * 16; }
    const int vb0 = (int)(uintptr_t)(LAS char*)V_lds + v_rd_base(lane);
    bf16x8 vs0, vs1, ks0, ks1, ks2;
#define GAS __attribute__((address_space(1)))
#define SLOAD(k0) do { vs0 = *(const GAS bf16x8*)((const GAS bf16_t*)Vh + (long)((k0) + sr) * LDV + sc); vs1 = *(const GAS bf16x8*)((const GAS bf16_t*)Vh + (long)((k0) + 32 + sr) * LDV + sc); \
    ks0 = *(const GAS bf16x8*)((const GAS char*)Kh + (long)((k0) + kkey[0]) * (LDK * 2) + kcb[0]); ks1 = *(const GAS bf16x8*)((const GAS char*)Kh + (long)((k0) + kkey[1]) * (LDK * 2) + kcb[1]); \
    ks2 = *(const GAS bf16x8*)((const GAS char*)Kh + (long)((k0) + kkey[2]) * (LDK * 2) + kcb[2]); } while (0)
#define SWRITE(b) do { *(bf16x8*)(V_lds + (b) * SHM_V + vst0) = vs0; *(bf16x8*)(V_lds + (b) * SHM_V + vst1) = vs1; \
    *(bf16x8*)(K_lds + (b) * SHM_K + KSWZ(kkey[0], kcb[0])) = ks0; *(bf16x8*)(K_lds + (b) * SHM_K + KSWZ(kkey[1], kcb[1])) = ks1; *(bf16x8*)(K_lds + (b) * SHM_K + KSWZ(kkey[2], kcb[2])) = ks2; } while (0)
#define SWAIT() asm volatile("s_waitcnt vmcnt(0)" ::: "memory")
#define RESC(al) do { if (__any((al) < 1.f)) { if (hi == 0) al_l[r32] = (al); asm volatile("s_waitcnt lgkmcnt(0)" ::: "memory"); \
    _Pragma("unroll") for (int d = 0; d < 4; ++d) _Pragma("unroll") for (int r = 0; r < 16; ++r) o[d][r] *= al_l[crow(r, hi)]; } } while (0)
    f32x16 p0, p1; float mn, al; bf16x8 pa0, pa1, pa2, pa3; const int NT = seq / KVBLK;
    SLOAD(0); SWAIT(); SWRITE(0); __syncthreads();
    for (int j = 0; j < NT; ++j) {
        const int bsel = j & 1;
        if (j + 1 < NT) SLOAD((j + 1) * KVBLK);
        SBAR(); qkt(p0, p1, K_lds + bsel * SHM_K, qr, r32, hi);
        partialSM(p0, p1, m_reg, mn, al);
        RESC(al);
        finishSM(p0, p1, al, l_reg, pa0, pa1, pa2, pa3); SBAR();
        pv_d0(o, vb0 + bsel * SHM_V, pa0, pa1, pa2, pa3);
        if (j + 1 < NT) { SWAIT(); SWRITE(bsel ^ 1); }
        __syncthreads();
    }
    if (hi == 0) li_l[r32] = l_reg; asm volatile("s_waitcnt lgkmcnt(0)" ::: "memory");
    float rli[16];
#pragma unroll
    for (int r = 0; r < 16; ++r) rli[r] = __builtin_amdgcn_rcpf(li_l[crow(r, hi)]);
    bf16_t* Ow = Ob + (long)(wid * 32) * LDO;
#pragma unroll
    for (int r = 0; r < 16; ++r) { const int orow = crow(r, hi);
#pragma unroll
        for (int d0 = 0; d0 < 4; ++d0) { const float val = o[d0][r] * rli[r]; ((__attribute__((address_space(1))) bf16_t*)Ow)[(long)orow * LDO + d0 * 32 + r32] = (bf16_t)(cvt_pk_bf16(val, val) & 0xffffu); } }
    __syncthreads();
#undef SLOAD
#undef SWRITE
#undef SWAIT
#undef RESC
}
}
__device__ __forceinline__ void attn_phase(const Args& a, LAS unsigned char* lds, int G, int c) {
    const bf16_t* Q = (const bf16_t*)(a.ws + WS_ARENA + A_Q); const bf16_t* K = (const bf16_t*)(a.ws + WS_ARENA + A_K); const bf16_t* KV = (const bf16_t*)(a.ws + WS_ARENA + A_KV);
    bf16_t* O = (bf16_t*)(a.ws + WS_ARENA + A_O);
    const int vcu = (G % 8 == 0) ? (c % 8) * (G / 8) + c / 8 : c;
    for (int L = vcu; L < 1024 + 64; L += G) {
        int b, h, q0, seq;
        if (L < 1024) { b = L >> 7; h = (L >> 4) & 7; q0 = CTX + (L & 15) * 256; seq = SEG; } else { const int l2 = L - 1024; b = l2 >> 3; h = l2 & 7; q0 = 0; seq = CTX; }
        const size_t rb = (size_t)b * SEG;
        att::attn_unit(Q + (rb + q0) * 1536 + h * QKH, K + rb * 1536 + h * QKH, KV + rb * LDKV + h * 256 + 128, O + (rb + q0) * 1024 + h * VH, seq, (char*)lds);
    }
}

namespace scan {
constexpr int CH = 32, STEP_B = 6 * 256, BUF_B = CH * STEP_B  , YB_B = CH * 64 * 4  , LDS_B = 2 * BUF_B + 2 * YB_B  , NCH = SEG / CH  ;
constexpr int TILE_B = 64 * 65 * 4, MT_TILES = 24 * 896;
struct MTile { const float* src; bf16_t* dst; int sld, ldd, n0, k0, grpd; };
__device__ __forceinline__ int step_row(int b, int dir, int gs) {
    const int base = b * SEG;
    if (dir == 0) return base + gs;
    return gs < CTX ? base + (CTX - 1 - gs) : base + CTX + (SEG - 1 - gs);
}
struct Raw { u32x4 k, r, v, wl, al, vf, vl; };
}
__device__ __forceinline__ bool moe_tile(const Args& a, int k, int t, scan::MTile& m) {
    if (CS_NOTILE || t >= scan::MT_TILES) return false;
    const int j = t / 896, tl = t - j * 896, e = j / 3, kind = j - e * 3; int tn;
    const size_t so = (size_t)(k * NE + e) * D * DFE;
    if (kind < 2) { m.src = a.in[kind == 0 ? I_M1 : I_M3] + so; m.sld = DFE; m.dst = (bf16_t*)(a.ws + WS_ARENA + A_WM13) + (size_t)e * E_M13 + (kind ? (size_t)128 * 1024 : 0); m.ldd = 1024; tn = 56; m.grpd = 1; }
    else { m.src = a.in[I_M2] + so; m.sld = D; m.dst = (bf16_t*)(a.ws + WS_ARENA + A_WM2) + (size_t)e * E_M2; m.ldd = DFE; tn = 16; m.grpd = 0; }
    m.n0 = (tl % tn) * 64; m.k0 = (tl / tn) * 64; return true;
}
__device__ __forceinline__ void scan_phase(const Args& a, int j, const bf16_t* Vsrc, const bool vres, LAS unsigned char* lds, int G, int c) {
    using namespace scan;
    int mt_round = 0;
    const int tid = ltid(), wave = tid >> 6, lane = tid & 63;
    const bf16_t* RR = (const bf16_t*)(a.ws + WS_ARENA + A_RR); const bf16_t* RK = (const bf16_t*)(a.ws + WS_ARENA + A_RK);
    for (int chain = c; chain < 256; chain += G) {
        const int b = chain >> 5, h = (chain >> 1) & 15, dir = chain & 1;
        const bf16_t* WL = (const bf16_t*)(a.ws + WS_ARENA + (dir ? A_WL1 : A_WL0)); const bf16_t* AL = (const bf16_t*)(a.ws + WS_ARENA + (dir ? A_AL1 : A_AL0));
        bf16_t* Y = (bf16_t*)(a.ws + WS_ARENA + (dir ? A_YR : A_YF));
        if (wave >= 4) {
            const int pt = tid - 256, s = pt >> 3, seg = pt & 7, ch0 = h * 64 + seg * 8;
            float kkp[8], kap[8], v0p[8];
            const bf16_t* VFp = (const bf16_t*)(a.ws + WS_VF); const bf16_t* VLp = (const bf16_t*)(a.ws + WS_ARENA + A_VL);
#pragma unroll
            for (int e = 0; e < 8; ++e) v0p[e] = vres ? a.in[I_V0][ch0 + e] : 0.f;
#pragma unroll
            for (int e = 0; e < 8; ++e) { kkp[e] = a.in[I_KK][(size_t)j * D + ch0 + e]; kap[e] = a.in[I_KA][(size_t)j * D + ch0 + e]; }
            Raw raw;
#define GLOAD(q) do { const size_t off_ = (size_t)step_row(b, dir, (q) * CH + s) * 1024 + ch0; \
                raw.k = *(const u32x4*)(RK + off_); raw.r = *(const u32x4*)(RR + off_); raw.v = *(const u32x4*)(Vsrc + off_); raw.wl = *(const u32x4*)(WL + off_); raw.al = *(const u32x4*)(AL + off_); \
                if (vres) { raw.vf = *(const u32x4*)(VFp + off_); raw.vl = *(const u32x4*)(VLp + off_); } } while (0)
#define PRODUCE(buf) do { \
                float k[8], r[8], v[8], wl[8], al[8]; unpack8(raw.k, k); unpack8(raw.r, r); unpack8(raw.v, v); unpack8(raw.wl, wl); unpack8(raw.al, al); \
                if (vres) { float vf[8], vl[8]; unpack8(raw.vf, vf); unpack8(raw.vl, vl); _Pragma("unroll") for (int e = 0; e < 8; ++e) v[e] = v[e] + (vf[e] - v[e]) * sigmoidf_(v0p[e] + vl[e]); } \
                float ad[8], kd[8], kk[8], ww[8], ss = 0.f; \
                _Pragma("unroll") for (int e = 0; e < 8; ++e) { ad[e] = al[e]; kd[e] = k[e] * (1.0f + (ad[e] - 1.0f) * kap[e]); kk[e] = k[e] * kkp[e]; ss += kk[e] * kk[e]; \
                    ww[e] = __expf(-wl[e]); } \
                ss = red8(ss); const float inv = 1.0f / fmaxf(sqrtf(ss), 1e-12f); \
                LAS f32x4* o = (LAS f32x4*)(lds + (buf) * BUF_B + s * STEP_B + seg * 32); \
                _Pragma("unroll") for (int e = 0; e < 8; ++e) kk[e] *= inv; \
                o[0] = (f32x4){ww[0], ww[1], ww[2], ww[3]}; o[1] = (f32x4){ww[4], ww[5], ww[6], ww[7]}; \
                o[16] = (f32x4){kd[0], kd[1], kd[2], kd[3]}; o[17] = (f32x4){kd[4], kd[5], kd[6], kd[7]}; \
                o[32] = (f32x4){-kk[0], -kk[1], -kk[2], -kk[3]}; o[33] = (f32x4){-kk[4], -kk[5], -kk[6], -kk[7]}; \
                o[48] = (f32x4){kk[0] * ad[0], kk[1] * ad[1], kk[2] * ad[2], kk[3] * ad[3]}; o[49] = (f32x4){kk[4] * ad[4], kk[5] * ad[5], kk[6] * ad[6], kk[7] * ad[7]}; \
                o[64] = (f32x4){r[0], r[1], r[2], r[3]}; o[65] = (f32x4){r[4], r[5], r[6], r[7]}; \
                o[80] = (f32x4){v[0], v[1], v[2], v[3]}; o[81] = (f32x4){v[4], v[5], v[6], v[7]}; } while (0)
#define YSTORE(q) do { const LAS f32x4* yp = (const LAS f32x4*)(lds + 2 * BUF_B + ((q) & 1) * YB_B + s * 256 + seg * 32); const f32x4 y0 = yp[0], y1 = yp[1]; \
                u32x4 w; w.x = cvt_pk_bf16(y0[0], y0[1]); w.y = cvt_pk_bf16(y0[2], y0[3]); w.z = cvt_pk_bf16(y1[0], y1[1]); w.w = cvt_pk_bf16(y1[2], y1[3]); \
                *(u32x4*)(Y + (size_t)step_row(b, dir, (q) * CH + s) * 1024 + ch0) = w; } while (0)
            GLOAD(0); PRODUCE(0); GLOAD(1);
            __syncthreads();
            f32x4 treg[4]; const int kl = pt >> 4, nq = (pt & 15) * 4, sn = pt >> 2, sk = (pt & 3) * 16;
            for (int q = 0; q < NCH; ++q) {
                if (q + 1 < NCH) { PRODUCE((q + 1) & 1); if (q + 2 < NCH) GLOAD(q + 2); }
                if (q >= 1) YSTORE(q - 1);
                MTile m;
                if (q >= 2 && moe_tile(a, j, c + (mt_round + q - 2) * G, m)) {
                    const LAS float* tl_ = (const LAS float*)(lds + LDS_B + (q & 1) * TILE_B); float f0[8], f1[8];
#pragma unroll
                    for (int e = 0; e < 8; ++e) { f0[e] = tl_[(sk + e) * 65 + sn]; f1[e] = tl_[(sk + 8 + e) * 65 + sn]; }
                    const int n = m.n0 + sn, dr = m.grpd ? ((n >> 7) * 256 + (n & 127)) : n; bf16_t* dp = m.dst + (size_t)dr * m.ldd + m.k0 + sk;
                    *(u32x4*)dp = pack8(f0); *(u32x4*)(dp + 8) = pack8(f1); }
                if (q >= 1 && q <= NCH - 2 && moe_tile(a, j, c + (mt_round + q - 1) * G, m)) {
                    LAS float* tl_ = (LAS float*)(lds + LDS_B + ((q - 1) & 1) * TILE_B);
#pragma unroll
                    for (int p = 0; p < 4; ++p) { LAS float* tp = tl_ + (kl + 16 * p) * 65 + nq; tp[0] = treg[p][0]; tp[1] = treg[p][1]; tp[2] = treg[p][2]; tp[3] = treg[p][3]; } }
                if (q <= NCH - 3 && moe_tile(a, j, c + (mt_round + q) * G, m)) {
#pragma unroll
                    for (int p = 0; p < 4; ++p) treg[p] = *(const f32x4*)(m.src + (size_t)(m.k0 + kl + 16 * p) * m.sld + m.n0 + nq); }
                __syncthreads();
            }
            YSTORE(NCH - 1);
#undef GLOAD
#undef PRODUCE
#undef YSTORE
        } else {
            const int rp = lane >> 3, ks = lane & 7, v0i = wave * 16 + rp * 2;
            f32x2 s0[4], s1[4];
#pragma unroll
            for (int i = 0; i < 4; ++i) { s0[i] = (f32x2){0.f, 0.f}; s1[i] = (f32x2){0.f, 0.f}; }
            __syncthreads();
            struct Vecs { f32x4 w0, w1, k0, k1, a0, a1, b0, b1, r0, r1; f32x2 vv; };
#define LOADV(V, t) do { const LAS f32x4* p_ = (const LAS f32x4*)(bp + (t) * STEP_B); V.w0 = p_[0]; V.w1 = p_[1]; V.k0 = p_[16]; V.k1 = p_[17]; V.a0 = p_[32]; V.a1 = p_[33]; \
                    V.b0 = p_[48]; V.b1 = p_[49]; V.r0 = p_[64]; V.r1 = p_[65]; V.vv = *(const LAS f32x2*)(vp + (t) * STEP_B); } while (0)
#define STEPV(V, t, HAVEPREV) do { \
                    const f32x2 wv[4] = {{V.w0[0], V.w0[1]}, {V.w0[2], V.w0[3]}, {V.w1[0], V.w1[1]}, {V.w1[2], V.w1[3]}}, kv[4] = {{V.k0[0], V.k0[1]}, {V.k0[2], V.k0[3]}, {V.k1[0], V.k1[1]}, {V.k1[2], V.k1[3]}}; \
                    const f32x2 av[4] = {{V.a0[0], V.a0[1]}, {V.a0[2], V.a0[3]}, {V.a1[0], V.a1[1]}, {V.a1[2], V.a1[3]}}, bv[4] = {{V.b0[0], V.b0[1]}, {V.b0[2], V.b0[3]}, {V.b1[0], V.b1[1]}, {V.b1[2], V.b1[3]}}; \
                    const f32x2 rv[4] = {{V.r0[0], V.r0[1]}, {V.r0[2], V.r0[3]}, {V.r1[0], V.r1[1]}, {V.r1[2], V.r1[3]}}; \
                    f32x2 d0 = s0[0] * av[0], d1 = s1[0] * av[0]; \
                    d0 += s0[1] * av[1]; d1 += s1[1] * av[1]; d0 += s0[2] * av[2]; d1 += s1[2] * av[2]; d0 += s0[3] * av[3]; d1 += s1[3] * av[3]; \
                    float h0 = d0.x + d0.y, h1 = d1.x + d1.y; \
                    h0 += dpp_f<0xB1>(h0); h1 += dpp_f<0xB1>(h1); yp0 += dpp_f<0xB1>(yp0); yp1 += dpp_f<0xB1>(yp1); \
                    h0 += dpp_f<0x4E>(h0); h1 += dpp_f<0x4E>(h1); yp0 += dpp_f<0x4E>(yp0); yp1 += dpp_f<0x4E>(yp1); \
                    h0 += dpp_f<0x141>(h0); h1 += dpp_f<0x141>(h1); yp0 += dpp_f<0x141>(yp0); yp1 += dpp_f<0x141>(yp1); \
                    if (HAVEPREV) yb[((t) - 1) * 64 + v0i + (ks & 1)] = (ks & 1) ? yp1 : yp0; \
                    const f32x2 sa0v = {h0, h0}, sa1v = {h1, h1}, v0v = {V.vv.x, V.vv.x}, v1v = {V.vv.y, V.vv.y}; \
                    _Pragma("unroll") for (int i = 0; i < 4; ++i) { s0[i] = s0[i] * wv[i] + sa0v * bv[i] + v0v * kv[i]; s1[i] = s1[i] * wv[i] + sa1v * bv[i] + v1v * kv[i]; } \
                    f32x2 y0 = s0[0] * rv[0], y1 = s1[0] * rv[0]; \
                    y0 += s0[1] * rv[1]; y1 += s1[1] * rv[1]; y0 += s0[2] * rv[2]; y1 += s1[2] * rv[2]; y0 += s0[3] * rv[3]; y1 += s1[3] * rv[3]; \
                    yp0 = y0.x + y0.y; yp1 = y1.x + y1.y; } while (0)
            for (int q = 0; q < NCH; ++q) {
                const LAS unsigned char* bp = lds + (q & 1) * BUF_B + ks * 32;
                const LAS unsigned char* vp = lds + (q & 1) * BUF_B + 5 * 256 + v0i * 4;
                LAS float* yb = (LAS float*)(lds + 2 * BUF_B + (q & 1) * YB_B);
                Vecs VA, VB; float yp0 = 0.f, yp1 = 0.f;
                LOADV(VA, 0); LOADV(VB, 1);
                STEPV(VA, 0, false);
                LOADV(VA, 2);
                STEPV(VB, 1, true);
#pragma unroll 1
                for (int t = 2; t < CH; t += 2) {
                    LOADV(VB, t + 1);
                    STEPV(VA, t, true);
                    LOADV(VA, t + 2);
                    STEPV(VB, t + 1, true);
                }
                yp0 = red8(yp0); yp1 = red8(yp1);
                yb[(CH - 1) * 64 + v0i + (ks & 1)] = (ks & 1) ? yp1 : yp0;
                __syncthreads();
            }
#undef LOADV
#undef STEPV
        }
        mt_round += NCH - 2;
        __syncthreads();
    }
}

namespace cs {
constexpr int C = 32, NCK = SEG / C;
constexpr int TM = 72, CM = 40, TMB = TM * 2, CMB = CM * 2;
constexpr int SZ_TM = 32 * TMB, SZ_CM = 64 * CMB, SZ_C32 = 32 * CMB;
constexpr int X_ATM = 0, X_RTM = SZ_TM, X_BHTM = 2 * SZ_TM, X_KHTM = 3 * SZ_TM, X_ACM = 4 * SZ_TM, X_RCM = X_ACM + SZ_CM, X_BBCM = X_RCM + SZ_CM, X_KBCM = X_BBCM + SZ_CM, X_B = X_KBCM + SZ_CM;
constexpr int Y_VCM = 0, Y_GC = SZ_CM, Y_B = SZ_CM + 256;
constexpr int OFF_X = 0, OFF_Y = 2 * X_B, OFF_MID = OFF_Y + 2 * Y_B;
constexpr int M_NL = 0, M_NR = SZ_C32, M_TT = 2 * SZ_C32, M_ARBT = 3 * SZ_C32, M_AAK = 4 * SZ_C32, M_UP = 5 * SZ_C32, M_W = 6 * SZ_C32, M_ARK = M_W + SZ_CM, MID_B = M_ARK + 4096;
constexpr int OFF_OUT = OFF_MID + MID_B;
constexpr int O_PST = 0, O_QST = 64 * TMB, O_PYT = O_QST + SZ_CM, O_QYT = O_PYT + SZ_TM, OUT_B = O_QYT + SZ_C32;
constexpr int OFF_YB = OFF_OUT + OUT_B, OFF_ES = OFF_YB + 8192, OFF_WT = OFF_ES + 2048, LDS_END = OFF_WT + 64 * 65 * 4;
__device__ __forceinline__ int rho(int r, int h) { return (r & 3) + 8 * (r >> 2) + 4 * h; }
__device__ __forceinline__ int perm16(int k) { return (k & ~0xC) | ((k & 4) << 1) | ((k & 8) >> 1); }
typedef __bf16 bf16v2 __attribute__((ext_vector_type(2)));
__device__ __forceinline__ unsigned cvt_pk_bf16_c(float lo, float hi) { const bf16v2 v = __builtin_convertvector((f32x2){lo, hi}, bf16v2); return __builtin_bit_cast(unsigned, v); }
__device__ __forceinline__ bf16_t f2bf(float x) { const __bf16 b = (__bf16)x; return __builtin_bit_cast(bf16_t, b); }
__device__ __forceinline__ float bf2f(bf16_t x) { return __uint_as_float((unsigned)x << 16); }
template <int KS> __device__ __forceinline__ void mma32t(f32x16& acc, const LAS unsigned char* A, int lda, const LAS unsigned char* B, int ldb, int r32, int h) {
    bf16x8 a[KS], b[KS];
#pragma unroll
    for (int s = 0; s < KS; ++s) { a[s] = *(const LAS bf16x8*)(A + r32 * lda + s * 32 + h * 16); b[s] = *(const LAS bf16x8*)(B + r32 * ldb + s * 32 + h * 16); }
#pragma unroll
    for (int s = 0; s < KS; ++s) acc = __builtin_amdgcn_mfma_f32_32x32x16_bf16(a[s], b[s], acc, 0, 0, 0);
}
__device__ __forceinline__ void mma32(f32x16& acc, const LAS unsigned char* A, int lda, const LAS unsigned char* B, int ldb, int ksteps, int r32, int h) {
    if (ksteps == 4) mma32t<4>(acc, A, lda, B, ldb, r32, h); else mma32t<2>(acc, A, lda, B, ldb, r32, h);
}
__device__ __forceinline__ void st_bf(const f32x16& acc, LAS unsigned char* dst, int sr, int sc, int r32, int h) {
#pragma unroll
    for (int r = 0; r < 16; ++r) *(LAS bf16_t*)(dst + rho(r, h) * sr + r32 * sc) = f2bf(acc[r]);
}
template <bool PERM> __device__ __forceinline__ void st_bf_T(const f32x16& acc, LAS unsigned char* dst, int sc, int r32, int h) {
#pragma unroll
    for (int m = 0; m < 4; ++m) { const int row0 = 8 * m + 4 * h, pos = PERM ? perm16(row0) : row0; u32x2 w; w.x = cvt_pk_bf16_c(acc[4 * m], acc[4 * m + 1]); w.y = cvt_pk_bf16_c(acc[4 * m + 2], acc[4 * m + 3]);
        *(LAS u32x2*)(dst + r32 * sc + pos * 2) = w; }
}
}
#define CS_BAR() do { asm volatile("s_waitcnt lgkmcnt(0)" ::: "memory"); __builtin_amdgcn_s_barrier(); asm volatile("" ::: "memory"); } while (0)
__device__ __forceinline__ void scan_chunked(const Args& a, int jl, const bf16_t* Vsrc, const bool vres, LAS unsigned char* lds, int G, int c) {
    using namespace cs;
    const int tid0 = ltid(), wave = __builtin_amdgcn_readfirstlane(tid0 >> 6);
    typedef const __attribute__((address_space(1))) bf16_t* gcp; typedef __attribute__((address_space(1))) bf16_t* gwp;
    gcp RR = (gcp)(a.ws + WS_ARENA + A_RR); gcp RK = (gcp)(a.ws + WS_ARENA + A_RK);
    gcp VFp = (gcp)(a.ws + WS_VF); gcp VLp = (gcp)(a.ws + WS_ARENA + A_VL); gcp Vg = (gcp)Vsrc;
    int mt0 = 0;
    for (int chain = c; chain < 256; chain += G) {
        const int b = chain >> 5, hd = (chain >> 1) & 15, dir = chain & 1;
        gcp WL = (gcp)(a.ws + WS_ARENA + (dir ? A_WL1 : A_WL0)); gcp AL = (gcp)(a.ws + WS_ARENA + (dir ? A_AL1 : A_AL0));
        gwp Y = (gwp)(a.ws + WS_ARENA + (dir ? A_YCR : A_YCF));
        const int gcol0 = hd * 64 + (tid0 & 63);
        const float kkp = a.in[I_KK][(size_t)jl * D + gcol0], kap = a.in[I_KA][(size_t)jl * D + gcol0], v0p = vres ? a.in[I_V0][gcol0] : 0.f, rkh = 0.5f * a.in[I_RK][(size_t)jl * D + gcol0];
        __attribute__((address_space(1))) float* DOTp = (__attribute__((address_space(1))) float*)(a.ws + WS_DOT) + (size_t)dir * R * 16 + hd;
        f32x16 S0 = {}, S1 = {};
        f32x4 wreg[8];
        constexpr int ntok = 4; const int tok0 = 4 * wave;
        bf16_t rk_[4], rr_[4], ra_[4], rv_[4], re_[4], rf_[4], rl_[4];
        bf16_t qk_[4], qr_[4], qa_[4], qv_[4], qe_[4], qf_[4], ql_[4];
#define CS_LOAD(q) do { _Pragma("unroll") for (int tk_ = 0; tk_ < 4; ++tk_) { const unsigned off_ = (unsigned)scan::step_row(b, dir, (q) * 32 + tok0 + tk_) * 1024u + (unsigned)gcol; \
                qk_[tk_] = RK[off_]; qr_[tk_] = RR[off_]; qa_[tk_] = AL[off_]; qe_[tk_] = WL[off_]; qv_[tk_] = Vg[off_]; if (vres) { qf_[tk_] = VFp[off_]; ql_[tk_] = VLp[off_]; } } } while (0)
#define CS_COPY() do { _Pragma("unroll") for (int tk_ = 0; tk_ < 4; ++tk_) { rk_[tk_] = qk_[tk_]; rr_[tk_] = qr_[tk_]; ra_[tk_] = qa_[tk_]; re_[tk_] = qe_[tk_]; rv_[tk_] = qv_[tk_]; rf_[tk_] = qf_[tk_]; rl_[tk_] = ql_[tk_]; } } while (0)
#define CS_ESUM() do { float es_ = 0.f; _Pragma("unroll") for (int tk_ = 0; tk_ < 4; ++tk_) es_ += bf2f(re_[tk_]); *(LAS float*)(lds + OFF_ES + wave * 256 + lane * 4) = es_; } while (0)
#define CS_MAIN(q) do { \
            LAS unsigned char* X_ = lds + OFF_X + ((q) & 1) * X_B; LAS unsigned char* Yb_ = lds + OFF_Y + ((q) & 1) * Y_B; \
            float before_ = 0.f, tot_ = 0.f; \
            _Pragma("unroll") for (int w_ = 0; w_ < 8; ++w_) { const float es_ = *(const LAS float*)(lds + OFF_ES + w_ * 256 + lane * 4); before_ += (w_ < wave) ? es_ : 0.f; tot_ += es_; } \
            float erun_ = __expf(-before_); const float gct_ = __expf(-tot_); \
            _Pragma("unroll") for (int p_ = 0; p_ < 2; ++p_) { const int t_ = tok0 + 2 * p_;            \
                const f32x2 kraw_ = {bf2f(rk_[2 * p_]), bf2f(rk_[2 * p_ + 1])}, rr2_ = {bf2f(rr_[2 * p_]), bf2f(rr_[2 * p_ + 1])}, ad_ = {bf2f(ra_[2 * p_]), bf2f(ra_[2 * p_ + 1])}; \
                f32x2 vv_ = {bf2f(rv_[2 * p_]), bf2f(rv_[2 * p_ + 1])}; \
                if (vres) { const f32x2 vf_ = {bf2f(rf_[2 * p_]), bf2f(rf_[2 * p_ + 1])}; const float s0_ = sigmoidf_(v0p + bf2f(rl_[2 * p_])), s1_ = sigmoidf_(v0p + bf2f(rl_[2 * p_ + 1])); \
                    vv_ = vv_ + (vf_ - vv_) * (f32x2){s0_, s1_}; } \
                const f32x2 kd_ = kraw_ * ((ad_ - 1.0f) * kap + 1.0f), kkr_ = kraw_ * kkp, sq_ = kkr_ * kkr_; \
                float s0 = sq_.x, s1 = sq_.y; const f32x2 bd_ = rr2_ * kd_ * rkh; float d0 = bd_.x, d1 = bd_.y;     \
                s0 += dpp_f<0xB1>(s0); s1 += dpp_f<0xB1>(s1); s0 += dpp_f<0x4E>(s0); s1 += dpp_f<0x4E>(s1); s0 += dpp_f<0x141>(s0); s1 += dpp_f<0x141>(s1); s0 += dpp_f<0x140>(s0); s1 += dpp_f<0x140>(s1); \
                d0 += dpp_f<0xB1>(d0); d1 += dpp_f<0xB1>(d1); d0 += dpp_f<0x4E>(d0); d1 += dpp_f<0x4E>(d1); d0 += dpp_f<0x141>(d0); d1 += dpp_f<0x141>(d1); d0 += dpp_f<0x140>(d0); d1 += dpp_f<0x140>(d1); \
                { const int j0_ = __float_as_int(d0), j1_ = __float_as_int(d1); \
                  const float dd0_ = (__int_as_float(__builtin_amdgcn_readlane(j0_, 0)) + __int_as_float(__builtin_amdgcn_readlane(j0_, 16))) + (__int_as_float(__builtin_amdgcn_readlane(j0_, 32)) + __int_as_float(__builtin_amdgcn_readlane(j0_, 48))); \
                  const float dd1_ = (__int_as_float(__builtin_amdgcn_readlane(j1_, 0)) + __int_as_float(__builtin_amdgcn_readlane(j1_, 16))) + (__int_as_float(__builtin_amdgcn_readlane(j1_, 32)) + __int_as_float(__builtin_amdgcn_readlane(j1_, 48))); \
                  if (lane == 0) { DOTp[(size_t)scan::step_row(b, dir, (q) * 32 + t_) * 16] = dd0_; DOTp[(size_t)scan::step_row(b, dir, (q) * 32 + t_ + 1) * 16] = dd1_; } } \
                const int i0_ = __float_as_int(s0), i1_ = __float_as_int(s1); \
                const float ss0_ = (__int_as_float(__builtin_amdgcn_readlane(i0_, 0)) + __int_as_float(__builtin_amdgcn_readlane(i0_, 16))) + (__int_as_float(__builtin_amdgcn_readlane(i0_, 32)) + __int_as_float(__builtin_amdgcn_readlane(i0_, 48))); \
                const float ss1_ = (__int_as_float(__builtin_amdgcn_readlane(i1_, 0)) + __int_as_float(__builtin_amdgcn_readlane(i1_, 16))) + (__int_as_float(__builtin_amdgcn_readlane(i1_, 32)) + __int_as_float(__builtin_amdgcn_readlane(i1_, 48))); \
                const f32x2 kk_ = kkr_ * (f32x2){__builtin_amdgcn_rsqf(fmaxf(ss0_, 1e-24f)), __builtin_amdgcn_rsqf(fmaxf(ss1_, 1e-24f))}; \
                const float w0_ = __expf(-bf2f(re_[2 * p_])), w1_ = __expf(-bf2f(re_[2 * p_ + 1])); \
                f32x2 E1_, E2_; E1_.x = erun_; E2_.x = erun_ * w0_; E1_.y = E2_.x; E2_.y = E2_.x * w1_; erun_ = E2_.y; \
                const f32x2 Ei_ = {__builtin_amdgcn_rcpf(E2_.x), __builtin_amdgcn_rcpf(E2_.y)}, E3_ = Ei_ * gct_, bv_ = kk_ * ad_; \
                const f32x2 at2_ = -(kk_ * E1_), rt2_ = rr2_ * E2_, bh2_ = bv_ * Ei_, kh2_ = kd_ * Ei_, kb2_ = kd_ * E3_, bb2_ = bv_ * E3_; \
                const unsigned pa_ = cvt_pk_bf16_c(at2_.x, at2_.y), pr_ = cvt_pk_bf16_c(rt2_.x, rt2_.y), pbh_ = cvt_pk_bf16_c(bh2_.x, bh2_.y), pkh_ = cvt_pk_bf16_c(kh2_.x, kh2_.y); \
                *(LAS unsigned*)(X_ + X_ACM + lane * CMB + t_ * 2) = pa_; *(LAS unsigned*)(X_ + X_RCM + lane * CMB + t_ * 2) = pr_; \
                *(LAS unsigned*)(X_ + X_KBCM + lane * CMB + t_ * 2) = cvt_pk_bf16_c(kb2_.x, kb2_.y); *(LAS unsigned*)(X_ + X_BBCM + lane * CMB + t_ * 2) = cvt_pk_bf16_c(bb2_.x, bb2_.y); \
                *(LAS unsigned*)(Yb_ + Y_VCM + lane * CMB + t_ * 2) = cvt_pk_bf16_c(vv_.x, vv_.y); \
                *(LAS bf16_t*)(X_ + X_ATM + t_ * TMB + lane * 2) = (bf16_t)pa_; *(LAS bf16_t*)(X_ + X_ATM + (t_ + 1) * TMB + lane * 2) = (bf16_t)(pa_ >> 16); \
                *(LAS bf16_t*)(X_ + X_RTM + t_ * TMB + lane * 2) = (bf16_t)pr_; *(LAS bf16_t*)(X_ + X_RTM + (t_ + 1) * TMB + lane * 2) = (bf16_t)(pr_ >> 16); \
                *(LAS bf16_t*)(X_ + X_BHTM + t_ * TMB + lane * 2) = (bf16_t)pbh_; *(LAS bf16_t*)(X_ + X_BHTM + (t_ + 1) * TMB + lane * 2) = (bf16_t)(pbh_ >> 16); \
                *(LAS bf16_t*)(X_ + X_KHTM + t_ * TMB + lane * 2) = (bf16_t)pkh_; *(LAS bf16_t*)(X_ + X_KHTM + (t_ + 1) * TMB + lane * 2) = (bf16_t)(pkh_ >> 16); } \
            if (wave == 7) *(LAS float*)(Yb_ + Y_GC + lane * 4) = gct_; } while (0)
        { const int tid = ltid(), lane = tid & 63, gcol = hd * 64 + lane;
          { CS_LOAD(0); CS_COPY(); CS_ESUM(); }
          CS_BAR();
          { CS_LOAD(1); CS_MAIN(0); } }
        CS_BAR();
        for (int it = -1; it < NCK; ++it) {
            const bool have_next = (it + 1 < NCK);
            const int tid = ltid(), lane = tid & 63, r32 = lane & 31, h = lane >> 5, gcol = hd * 64 + lane;
            LAS unsigned char* X = lds + OFF_X + ((it + 1) & 1) * X_B; LAS unsigned char* M = lds + OFF_MID; LAS unsigned char* O = lds + OFF_OUT;
            f32x16 acc = {}, accT = {};
            if (have_next && wave < 4) {
                if (wave == 0) {
                    bf16x8 fb[4], fa[4];
#pragma unroll
                    for (int s4 = 0; s4 < 4; ++s4) { fb[s4] = *(const LAS bf16x8*)(X + X_BHTM + r32 * TMB + s4 * 32 + h * 16); fa[s4] = *(const LAS bf16x8*)(X + X_ATM + r32 * TMB + s4 * 32 + h * 16); }
#pragma unroll
                    for (int s4 = 0; s4 < 4; ++s4) { acc = __builtin_amdgcn_mfma_f32_32x32x16_bf16(fb[s4], fa[s4], acc, 0, 0, 0); accT = __builtin_amdgcn_mfma_f32_32x32x16_bf16(fa[s4], fb[s4], accT, 0, 0, 0); }
#pragma unroll
                    for (int r = 0; r < 16; ++r) accT[r] = (r32 < rho(r, h)) ? accT[r] : 0.f; }
                else if (wave == 2) mma32(acc, X + X_ATM, TMB, X + X_KHTM, TMB, 4, r32, h);
                else mma32(acc, X + ((wave & 2) ? X_KHTM : X_BHTM), TMB, X + ((wave & 1) ? X_RTM : X_ATM), TMB, 4, r32, h);
#pragma unroll
                for (int r = 0; r < 16; ++r) { const int i = rho(r, h); const bool keep = (wave == 2) ? (r32 < i) : ((wave & 1) ? (i <= r32) : (i < r32)); acc[r] = keep ? acc[r] : 0.f; }
                if (wave == 0) { }
                else if (wave == 1) st_bf_T<false>(acc, M + M_ARBT, CMB, r32, h);
                else if (wave == 2) st_bf_T<false>(acc, M + M_AAK, CMB, r32, h);
                else {
#pragma unroll
                    for (int m = 0; m < 4; ++m) *(LAS f32x4*)(M + M_ARK + r32 * 128 + (8 * m + 4 * h) * 4) = (f32x4){acc[4 * m], acc[4 * m + 1], acc[4 * m + 2], acc[4 * m + 3]}; }
            }
            if (CS_SERIAL) CS_BAR();
            if (it >= 0 && wave >= 6) {
                const int vb = wave - 6; const LAS unsigned char* Yb = lds + OFF_Y + (it & 1) * Y_B;
                bf16x8 bs[4];
#pragma unroll
                for (int s = 0; s < 2; ++s) { u32x4 w0, w1;
                    w0.x = cvt_pk_bf16_c(S0[8 * s + 0], S0[8 * s + 1]); w0.y = cvt_pk_bf16_c(S0[8 * s + 2], S0[8 * s + 3]); w0.z = cvt_pk_bf16_c(S0[8 * s + 4], S0[8 * s + 5]); w0.w = cvt_pk_bf16_c(S0[8 * s + 6], S0[8 * s + 7]);
                    w1.x = cvt_pk_bf16_c(S1[8 * s + 0], S1[8 * s + 1]); w1.y = cvt_pk_bf16_c(S1[8 * s + 2], S1[8 * s + 3]); w1.z = cvt_pk_bf16_c(S1[8 * s + 4], S1[8 * s + 5]); w1.w = cvt_pk_bf16_c(S1[8 * s + 6], S1[8 * s + 7]);
                    bs[s] = *reinterpret_cast<bf16x8*>(&w0); bs[2 + s] = *reinterpret_cast<bf16x8*>(&w1); }
                const LAS unsigned char* Vr = Yb + Y_VCM + (vb * 32 + r32) * CMB + h * 16;
                const bf16x8 bv0 = *(const LAS bf16x8*)Vr, bv1 = *(const LAS bf16x8*)(Vr + 32);
                bf16x8 fy[6], fs[6];
#pragma unroll
                for (int s = 0; s < 4; ++s) { fy[s] = *(const LAS bf16x8*)(O + O_PYT + r32 * TMB + s * 32 + h * 16); fs[s] = *(const LAS bf16x8*)(O + O_PST + r32 * TMB + s * 32 + h * 16); }
#pragma unroll
                for (int s = 0; s < 2; ++s) { fy[4 + s] = *(const LAS bf16x8*)(O + O_QYT + r32 * CMB + s * 32 + h * 16); fs[4 + s] = *(const LAS bf16x8*)(O + O_QST + r32 * CMB + s * 32 + h * 16); }
                f32x16 n0, n1;
#pragma unroll
                for (int m = 0; m < 4; ++m) { const f32x4 g0 = *(const LAS f32x4*)(Yb + Y_GC + (8 * m + 4 * h) * 4), g1 = *(const LAS f32x4*)(Yb + Y_GC + (32 + 8 * m + 4 * h) * 4);
#pragma unroll
                    for (int i = 0; i < 4; ++i) { n0[4 * m + i] = S0[4 * m + i] * g0[i]; n1[4 * m + i] = S1[4 * m + i] * g1[i]; } }
                f32x16 ya = {};
#pragma unroll
                for (int s = 0; s < 4; ++s) { ya = __builtin_amdgcn_mfma_f32_32x32x16_bf16(fy[s], bs[s], ya, 0, 0, 0); n0 = __builtin_amdgcn_mfma_f32_32x32x16_bf16(fs[s], bs[s], n0, 0, 0, 0); }
                ya = __builtin_amdgcn_mfma_f32_32x32x16_bf16(fy[4], bv0, ya, 0, 0, 0); n0 = __builtin_amdgcn_mfma_f32_32x32x16_bf16(fs[4], bv0, n0, 0, 0, 0);
                ya = __builtin_amdgcn_mfma_f32_32x32x16_bf16(fy[5], bv1, ya, 0, 0, 0); n0 = __builtin_amdgcn_mfma_f32_32x32x16_bf16(fs[5], bv1, n0, 0, 0, 0);
#pragma unroll
                for (int s = 0; s < 4; ++s) fs[s] = *(const LAS bf16x8*)(O + O_PST + (32 + r32) * TMB + s * 32 + h * 16);
#pragma unroll
                for (int s = 0; s < 2; ++s) fs[4 + s] = *(const LAS bf16x8*)(O + O_QST + (32 + r32) * CMB + s * 32 + h * 16);
#pragma unroll
                for (int r = 0; r < 16; ++r) *(LAS float*)(lds + OFF_YB + rho(r, h) * 256 + (vb * 32 + r32) * 4) = ya[r];
#pragma unroll
                for (int s = 0; s < 4; ++s) n1 = __builtin_amdgcn_mfma_f32_32x32x16_bf16(fs[s], bs[s], n1, 0, 0, 0);
                n1 = __builtin_amdgcn_mfma_f32_32x32x16_bf16(fs[4], bv0, n1, 0, 0, 0); n1 = __builtin_amdgcn_mfma_f32_32x32x16_bf16(fs[5], bv1, n1, 0, 0, 0);
                S0 = n0; S1 = n1;
            }
            if (it + 2 < NCK) { CS_COPY(); CS_ESUM(); }
            if (wave == 4 || wave == 5) {
                const int pt = tid - 256; scan::MTile m;
                if (it >= 0 && it <= NCK - 2 && moe_tile(a, jl, c + (mt0 + it) * G, m)) {
                    const LAS float* tl_ = (const LAS float*)(lds + OFF_WT); const int sn = pt >> 1, sk = (pt & 1) * 32;
                    const int n = m.n0 + sn, dr = m.grpd ? ((n >> 7) * 256 + (n & 127)) : n; bf16_t* dp = m.dst + (size_t)dr * m.ldd + m.k0 + sk;
#pragma unroll
                    for (int q8 = 0; q8 < 4; ++q8) { float f[8];
#pragma unroll
                        for (int e = 0; e < 8; ++e) f[e] = tl_[(sk + q8 * 8 + e) * 65 + sn];
                        *(__attribute__((address_space(1))) u32x4*)(dp + q8 * 8) = pack8(f); } }
                if (it + 1 < NCK - 1 && moe_tile(a, jl, c + (mt0 + it + 1) * G, m)) { const int kl = pt >> 4, nq = (pt & 15) * 4;
#pragma unroll
                    for (int p8 = 0; p8 < 8; ++p8) wreg[p8] = *(const __attribute__((address_space(1))) f32x4*)(m.src + (size_t)(m.k0 + kl + 8 * p8) * m.sld + m.n0 + nq); }
            }
            CS_BAR();
            if (have_next && wave == 0) {
                f32x16 Tm = acc, Mm = acc, Mt = accT;
#pragma unroll
                for (int r = 0; r < 16; ++r) Tm[r] += (rho(r, h) == r32) ? 1.0f : 0.f;
#define CS_SLAB(tile, s) ({ u32x4 w_; w_.x = cvt_pk_bf16_c(tile[8 * (s) + 0], tile[8 * (s) + 1]); w_.y = cvt_pk_bf16_c(tile[8 * (s) + 2], tile[8 * (s) + 3]); \
                    w_.z = cvt_pk_bf16_c(tile[8 * (s) + 4], tile[8 * (s) + 5]); w_.w = cvt_pk_bf16_c(tile[8 * (s) + 6], tile[8 * (s) + 7]); *reinterpret_cast<bf16x8*>(&w_); })
                for (int lvl = 0; lvl < 4; ++lvl) {
                    const bf16x8 m0 = CS_SLAB(Mm, 0), m1 = CS_SLAB(Mm, 1), t0_ = CS_SLAB(Mt, 0), t1_ = CS_SLAB(Mt, 1);
                    f32x16 m2 = {}, m2t = {};
                    m2 = __builtin_amdgcn_mfma_f32_32x32x16_bf16(t0_, m0, m2, 0, 0, 0); m2t = __builtin_amdgcn_mfma_f32_32x32x16_bf16(m0, t0_, m2t, 0, 0, 0);
                    m2 = __builtin_amdgcn_mfma_f32_32x32x16_bf16(t1_, m1, m2, 0, 0, 0); m2t = __builtin_amdgcn_mfma_f32_32x32x16_bf16(m1, t1_, m2t, 0, 0, 0);
                    Mm = m2; Mt = m2t;
                    { const bf16x8 a0 = CS_SLAB(Mt, 0), a1 = CS_SLAB(Mt, 1), bt0 = CS_SLAB(Tm, 0), bt1 = CS_SLAB(Tm, 1);
                      Tm = __builtin_amdgcn_mfma_f32_32x32x16_bf16(a0, bt0, Tm, 0, 0, 0); Tm = __builtin_amdgcn_mfma_f32_32x32x16_bf16(a1, bt1, Tm, 0, 0, 0); }
                }
                st_bf_T<false>(Tm, M + M_TT, CMB, r32, h);
            }
            if (CS_SERIAL) CS_BAR();
            if (it + 3 < NCK) CS_LOAD(it + 3);
            if (it + 2 < NCK) CS_MAIN(it + 2);
            if (CS_SERIAL) CS_BAR();
            if (it >= 0 && wave >= 5) {
                for (int item = tid - 320; item < 256; item += 192) { const int t = item >> 3, seg = item & 7;
                    const LAS f32x4* yp = (const LAS f32x4*)(lds + OFF_YB + t * 256 + seg * 32); const f32x4 y0 = yp[0], y1 = yp[1];
                    u32x4 w; w.x = cvt_pk_bf16(y0[0], y0[1]); w.y = cvt_pk_bf16(y0[2], y0[3]); w.z = cvt_pk_bf16(y1[0], y1[1]); w.w = cvt_pk_bf16(y1[2], y1[3]);
                    *(__attribute__((address_space(1))) u32x4*)(Y + (size_t)scan::step_row(b, dir, it * 32 + t) * 1024 + hd * 64 + seg * 8) = w; }
            }
            CS_BAR();
            if (have_next && wave < 3) {
                f32x16 d = {};
                if (wave < 2) { mma32(d, M + M_TT, CMB, X + X_ACM + wave * 32 * CMB, CMB, 2, r32, h); st_bf_T<false>(d, M + M_W + wave * 32 * CMB, CMB, r32, h); }
                else { mma32(d, M + M_TT, CMB, M + M_AAK, CMB, 2, r32, h); st_bf_T<false>(d, M + M_UP, CMB, r32, h); }
            }
            if (wave == 4 || wave == 5) { const int pt = tid - 256, kl = pt >> 4, nq = (pt & 15) * 4; scan::MTile m;
                if (it + 1 < NCK - 1 && moe_tile(a, jl, c + (mt0 + it + 1) * G, m)) { LAS float* tl_ = (LAS float*)(lds + OFF_WT);
#pragma unroll
                    for (int p8 = 0; p8 < 8; ++p8) { LAS float* tp = tl_ + (kl + 8 * p8) * 65 + nq; tp[0] = wreg[p8][0]; tp[1] = wreg[p8][1]; tp[2] = wreg[p8][2]; tp[3] = wreg[p8][3]; } } }
            CS_BAR();
            if (have_next) {
                f32x16 d = {};
                if (wave < 4) { const int kt = wave & 1, kpt = wave >> 1;
                    mma32(d, M + M_W + kt * 32 * CMB, CMB, X + X_BBCM + kpt * 32 * CMB, CMB, 2, r32, h);
                    st_bf_T<true>(d, O + O_PST + kpt * 32 * TMB + kt * 64, TMB, r32, h); }
                else if (wave < 6) { const int kt = wave - 4;
                    u32x2 ra[4];
#pragma unroll
                    for (int m = 0; m < 4; ++m) ra[m] = *(const LAS u32x2*)(X + X_RTM + r32 * TMB + (kt * 32 + 8 * m + 4 * h) * 2);
                    mma32(d, M + M_W + kt * 32 * CMB, CMB, M + M_ARBT, CMB, 2, r32, h);
#pragma unroll
                    for (int m = 0; m < 4; ++m) { d[4 * m] += bflo(ra[m].x); d[4 * m + 1] += bfhi(ra[m].x); d[4 * m + 2] += bflo(ra[m].y); d[4 * m + 3] += bfhi(ra[m].y); }
                    st_bf_T<true>(d, O + O_PYT + kt * 64, TMB, r32, h); }
                else { const int kpt = wave - 6;
                    u32x2 ka[4];
#pragma unroll
                    for (int m = 0; m < 4; ++m) ka[m] = *(const LAS u32x2*)(X + X_KBCM + (kpt * 32 + r32) * CMB + (8 * m + 4 * h) * 2);
                    mma32(d, M + M_UP, CMB, X + X_BBCM + kpt * 32 * CMB, CMB, 2, r32, h);
#pragma unroll
                    for (int m = 0; m < 4; ++m) { d[4 * m] += bflo(ka[m].x); d[4 * m + 1] += bfhi(ka[m].x); d[4 * m + 2] += bflo(ka[m].y); d[4 * m + 3] += bfhi(ka[m].y); }
                    st_bf_T<false>(d, O + O_QST + kpt * 32 * CMB, CMB, r32, h);
                    if (wave == 7) { f32x16 e = {}; f32x4 aa[4];
#pragma unroll
                        for (int m = 0; m < 4; ++m) aa[m] = *(const LAS f32x4*)(M + M_ARK + r32 * 128 + (8 * m + 4 * h) * 4);
                        mma32(e, M + M_UP, CMB, M + M_ARBT, CMB, 2, r32, h);
#pragma unroll
                        for (int m = 0; m < 4; ++m) { e[4 * m] += aa[m][0]; e[4 * m + 1] += aa[m][1]; e[4 * m + 2] += aa[m][2]; e[4 * m + 3] += aa[m][3]; }
                        st_bf_T<false>(e, O + O_QYT, CMB, r32, h); } }
            }
            CS_BAR();
        }
#undef CS_LOAD
#undef CS_COPY
#undef CS_ESUM
#undef CS_MAIN
        mt0 += NCK - 1;
    }
}


__device__ __forceinline__ void scan_compare(const Args& a, LAS unsigned char* lds, int G, int c) {
    const int tid = ltid();
    asm volatile("s_waitcnt vmcnt(0)" ::: "memory"); __syncthreads();
    for (int chain = c; chain < 256; chain += G) {
        const int b = chain >> 5, hd = (chain >> 1) & 15, dir = chain & 1;
        const bf16_t* Yo = (const bf16_t*)(a.ws + WS_ARENA + (dir ? A_YR : A_YF)); const bf16_t* Yc = (const bf16_t*)(a.ws + WS_ARENA + (dir ? A_YCR : A_YCF));
        float md = 0.f, mo = 0.f;
        for (int i = tid; i < SEG * 8; i += NTHR) { const int r = i >> 3, seg = i & 7; const size_t off = (size_t)(b * SEG + r) * 1024 + hd * 64 + seg * 8;
            u32x4 wo, wc; const unsigned* po = (const unsigned*)(Yo + off); const unsigned* pc = (const unsigned*)(Yc + off);
#pragma unroll
            for (int q = 0; q < 4; ++q) { wo[q] = __hip_atomic_load(po + q, __ATOMIC_RELAXED, __HIP_MEMORY_SCOPE_AGENT); wc[q] = __hip_atomic_load(pc + q, __ATOMIC_RELAXED, __HIP_MEMORY_SCOPE_AGENT); }
            float yo[8], yc[8]; unpack8(wo, yo); unpack8(wc, yc);
#pragma unroll
            for (int e = 0; e < 8; ++e) { md = fmaxf(md, fabsf(yo[e] - yc[e])); mo = fmaxf(mo, fabsf(yo[e])); } }
#pragma unroll
        for (int o = 32; o >= 1; o >>= 1) { md = fmaxf(md, __shfl_xor(md, o)); mo = fmaxf(mo, __shfl_xor(mo, o)); }
        LAS float* red = (LAS float*)lds;
        if ((tid & 63) == 0) { red[(tid >> 6) * 2] = md; red[(tid >> 6) * 2 + 1] = mo; }
        __syncthreads();
        if (tid == 0) { float d = 0.f, o = 0.f; for (int w = 0; w < 8; ++w) { d = fmaxf(d, red[w * 2]); o = fmaxf(o, red[w * 2 + 1]); }
            if (!(d <= CS_TOL * o)) { bf16_t* Yw = (bf16_t*)(a.ws + WS_ARENA + (dir ? A_YR : A_YF)); Yw[(size_t)(b * SEG + CTX) * 1024 + hd * 64] = (bf16_t)0x7fc0u; } }
        __syncthreads();
    }
}

__device__ __forceinline__ void rwkv_outprep(const Args& a, int j, const bf16_t* Vsrc, const bool vres, int G, int c) {
    const int lane = ltid() & 63; int r0, r1; wave_rows(G, c, r0, r1);
    const bf16_t* YF = (const bf16_t*)(a.ws + WS_ARENA + A_YF); const bf16_t* YR = (const bf16_t*)(a.ws + WS_ARENA + A_YR);
    const bf16_t* RR = (const bf16_t*)(a.ws + WS_ARENA + A_RR); const bf16_t* RK = (const bf16_t*)(a.ws + WS_ARENA + A_RK);
    const bf16_t* AL0 = (const bf16_t*)(a.ws + WS_ARENA + A_AL0); const bf16_t* AL1 = (const bf16_t*)(a.ws + WS_ARENA + A_AL1); const bf16_t* GG = (const bf16_t*)(a.ws + WS_ARENA + A_G);
    bf16_t* O = (bf16_t*)(a.ws + WS_ARENA + A_RO);
    float lnw[16], lnb[16];
    const float* DOT0 = (const float*)(a.ws + WS_DOT); const float* DOT1 = DOT0 + (size_t)R * 16;
#pragma unroll
    for (int jj = 0; jj < 2; ++jj)
#pragma unroll
        for (int e = 0; e < 8; ++e) { const int col = jj * 512 + lane * 8 + e, i = jj * 8 + e; lnw[i] = a.in[I_LNW][j * D + col]; lnb[i] = a.in[I_LNB][j * D + col]; }
    for (int row = r0; row < r1; ++row) {
        u32x4 out[2];
#pragma unroll
        for (int jj = 0; jj < 2; ++jj) { const size_t off = (size_t)row * 1024 + jj * 512 + lane * 8;
            float yf[8], yr[8], v[8], g[8], y[8];
            unpack8(*(const u32x4*)(YF + off), yf); unpack8(*(const u32x4*)(YR + off), yr);
            unpack8(*(const u32x4*)(Vsrc + off), v);
            const float dot = DOT0[(size_t)row * 16 + jj * 8 + (lane >> 3)] + DOT1[(size_t)row * 16 + jj * 8 + (lane >> 3)];
            if (vres) { float vf[8], vl[8]; unpack8(*(const u32x4*)((const bf16_t*)(a.ws + WS_VF) + off), vf); unpack8(*(const u32x4*)((const bf16_t*)(a.ws + WS_ARENA + A_VL) + off), vl);
#pragma unroll
                for (int e = 0; e < 8; ++e) v[e] = v[e] + (vf[e] - v[e]) * sigmoidf_(a.in[I_V0][jj * 512 + lane * 8 + e] + vl[e]); }
            unpack8(*(const u32x4*)(GG + off), g);
            float sm = 0.f;
#pragma unroll
            for (int e = 0; e < 8; ++e) { y[e] = yf[e] + yr[e]; sm += y[e]; }
            sm = red8(sm); const float mu = sm * (1.0f / 64.0f); float var = 0.f;
#pragma unroll
            for (int e = 0; e < 8; ++e) { const float d = y[e] - mu; var += d * d; }
            var = red8(var) * (1.0f / 64.0f); const float rstd = 1.0f / sqrtf(var + LNX_EPS);
            float o[8];
#pragma unroll
            for (int e = 0; e < 8; ++e) { const int i = jj * 8 + e; o[e] = ((y[e] - mu) * rstd * lnw[i] + lnb[i] + dot * v[e]) * g[e]; }
            out[jj] = pack8(o); }
        *(u32x4*)(O + (size_t)row * 1024 + lane * 8) = out[0]; *(u32x4*)(O + (size_t)row * 1024 + 512 + lane * 8) = out[1];
    }
}

__device__ __forceinline__ void moe_gather(const Args& a, LAS unsigned char* lds, int G, int c) {
    const int tid = ltid(), wave = tid >> 6, lane = tid & 63; int r0, r1; wave_rows(G, c, r0, r1);
    LAS int* cnt = (LAS int*)lds;
    if (tid < 16) cnt[tid] = 0;
    __syncthreads();
    const int* hist = (const int*)(a.ws + WS_HIST); const int nchunk = G * NWAVE, first = c * NWAVE;
    int pre[8], tot[8];
#pragma unroll
    for (int e = 0; e < 8; ++e) { pre[e] = 0; tot[e] = 0; }
    for (int ch = tid; ch < nchunk; ch += NTHR) { const u32x4 h0 = *(const u32x4*)(hist + (size_t)ch * 8), h1 = *(const u32x4*)(hist + (size_t)ch * 8 + 4); const int m = ch < first ? 1 : 0;
        tot[0] += h0[0]; tot[1] += h0[1]; tot[2] += h0[2]; tot[3] += h0[3]; tot[4] += h1[0]; tot[5] += h1[1]; tot[6] += h1[2]; tot[7] += h1[3];
        pre[0] += m * h0[0]; pre[1] += m * h0[1]; pre[2] += m * h0[2]; pre[3] += m * h0[3]; pre[4] += m * h1[0]; pre[5] += m * h1[1]; pre[6] += m * h1[2]; pre[7] += m * h1[3]; }
#pragma unroll
    for (int e = 0; e < 8; ++e) { int p = pre[e], t = tot[e];
#pragma unroll
        for (int o = 32; o >= 1; o >>= 1) { p += __shfl_xor(p, o); t += __shfl_xor(t, o); }
        if (lane == 0) { __hip_atomic_fetch_add(&cnt[e], p, __ATOMIC_RELAXED, __HIP_MEMORY_SCOPE_WORKGROUP); __hip_atomic_fetch_add(&cnt[8 + e], t, __ATOMIC_RELAXED, __HIP_MEMORY_SCOPE_WORKGROUP); } }
    __syncthreads();
    int base[9], run[8]; base[0] = 0;
#pragma unroll
    for (int e = 0; e < 8; ++e) base[e + 1] = base[e] + ((cnt[8 + e] + 255) & ~255);
    if (c == 0 && tid < 9) { int v = 0;
#pragma unroll
        for (int e = 0; e < 9; ++e) v = (tid == e) ? base[e] : v;
        ((int*)(a.ws + WS_META))[tid] = v; }
#pragma unroll
    for (int e = 0; e < 8; ++e) { int p = cnt[e];
        for (int w = 0; w < wave; ++w) p += hist[(size_t)(first + w) * 8 + e];
        run[e] = base[e] + p; }
    const bf16_t* H = (const bf16_t*)(a.ws + WS_ARENA + A_H); bf16_t* HS = (bf16_t*)(a.ws + WS_ARENA + A_HS);
    for (int row = r0; row < r1; ++row) {
        const u32x4 rt = *(const u32x4*)(a.ws + WS_ROUTE + (size_t)row * 16); const int e0 = (int)rt[0], e1 = (int)rt[1];
        if (e0 < 0) continue;
        int s0 = 0, s1 = 0;
#pragma unroll
        for (int e = 0; e < 8; ++e) { if (e == e0) { s0 = run[e]; run[e] += 1; } if (e == e1) { s1 = run[e]; run[e] += 1; } }
        const u32x4 h0 = *(const u32x4*)(H + (size_t)row * 1024 + lane * 8), h1 = *(const u32x4*)(H + (size_t)row * 1024 + 512 + lane * 8);
        *(u32x4*)(HS + (size_t)s0 * 1024 + lane * 8) = h0; *(u32x4*)(HS + (size_t)s0 * 1024 + 512 + lane * 8) = h1;
        *(u32x4*)(HS + (size_t)s1 * 1024 + lane * 8) = h0; *(u32x4*)(HS + (size_t)s1 * 1024 + 512 + lane * 8) = h1;
        if (lane == 0) { int* sl = (int*)(a.ws + WS_RSLOT) + (size_t)row * 2; sl[0] = s0; sl[1] = s1; }
    }
}
__device__ __forceinline__ void final_combine(const Args& a, int layer, int G, int c) {
    const int lane = ltid() & 63; int r0, r1; wave_rows(G, c, r0, r1);
    for (int row = r0; row < r1; ++row) { if (row % SEG < CTX) continue;
        float* xp = xrow(a, row); float x[16]; load_x16(xp, lane, x); moe_combine16(a, row, layer, lane, x); store_x16(xp, lane, x); }
}

constexpr int NPH = 42;
#define CT(k) (((PSEL) >> (k)) & 1u)
#ifndef PROBE_MASK
#define PROBE_MASK 0u
#endif
#ifndef TPROBE_MASK
#define TPROBE_MASK 0u
#endif
struct TimeProbe { int n; bool on; unsigned long long t0;
    __device__ __forceinline__ TimeProbe(bool twice, bool on_) : n(twice ? 2 : 1), on(on_), t0(0) { if (on) t0 = wall_clock64(); }
    __device__ __forceinline__ void step() { --n; if (on && n == 0) { __syncthreads(); const unsigned long long t1 = wall_clock64(), dt = t1 - t0; while (wall_clock64() - t1 < dt) __builtin_amdgcn_s_sleep(8); } } };
#define REPS(k) for (TimeProbe tp_((((PROBE_MASK) >> (k)) & 1u) != 0u, (((TPROBE_MASK) >> (k)) & 1u) != 0u); tp_.n > 0; tp_.step())
constexpr int LDS_ST_OFF = 161792;
constexpr int LDS_BYTES = LDS_ST_OFF + 64;
constexpr int TILE_OFF = 73728;
#define WSP(off) (a.ws + WS_ARENA + (off))
template <unsigned PSEL>
__global__ void __launch_bounds__(NTHR, 2) fwd(Args ka) {
    extern __shared__ __attribute__((aligned(16))) unsigned char lds_raw[];
    LAS unsigned char* lds = (LAS unsigned char*)lds_raw;
    const int Gk = gridDim.x, ck = blockIdx.x, tid = ltid();
    volatile LAS unsigned* st = (volatile LAS unsigned*)(lds + LDS_ST_OFF);
    if (tid < 4) st[tid] = 0u;
    __syncthreads();
    XcdBarrier bar; bar.bar = (unsigned*)(ka.ws + WS_CTL); bar.x = 0; bar.st = st;
    if (ka.ph_hi - ka.ph_lo > 1) bar = xcd_barrier_post((unsigned*)(ka.ws + WS_CTL), st);
#define IN(p) (ka.ph_lo <= (p) && (p) < ka.ph_hi)
#define PHB const Args a = launder_args(ka); const int G = launder_s(Gk), c = launder_s(ck); (void)G; (void)c;
#define SEAM(p) do { if (IN(p) && IN((p) + 1)) xcd_barrier(bar); } while (0)
    const size_t P1K = (size_t)256 * 1024 * 2;

    { const int jj_ = 0; const bool last_ = false;
    if (CT(20) && IN(0)) REPS(20) { PHB const bf16_t* wm = wmla(a, jj_); const bf16_t* wr_ = wrwkv(a, jj_); const bf16_t* wf = wffn(a, jj_); bf16_t* Vb = last_ ? (bf16_t*)WSP(A_RV) : (bf16_t*)(a.ws + WS_VF); (void)wm; (void)wr_; (void)wf; (void)Vb;
            { prologue_misc(a, lds, G, c); run_prep(a, lds + TILE_OFF, -1, 0, G, c); } }
    }
    SEAM(0);

    for (int jj = 0; jj < 2; ++jj) {
        const int pb = 1 + jj * 20, lm = 2 * jj, lr = 2 * jj + 1, jj_ = jj; const bool last = (jj == 1), last_ = last;

        if (CT(0) && IN(pb + 0)) REPS(0) { PHB const bf16_t* wm = wmla(a, jj_); const bf16_t* wr_ = wrwkv(a, jj_); const bf16_t* wf = wffn(a, jj_); bf16_t* Vb = last_ ? (bf16_t*)WSP(A_RV) : (bf16_t*)(a.ws + WS_VF); (void)wm; (void)wr_; (void)wf; (void)Vb;
            { if (jj == 0) norm_plain<false, true>(a, lm, a.in[I_N1G] + lm * D, 0, (bf16_t*)WSP(A_H), G, c); else combine_rows<true>(a, lm - 1, lm, a.in[I_N1G] + lm * D, 0, (bf16_t*)WSP(A_H), G, c); } }
        SEAM(pb + 0);
        if (CT(1) && IN(pb + 1)) REPS(1) { PHB const bf16_t* wm = wmla(a, jj_); const bf16_t* wr_ = wrwkv(a, jj_); const bf16_t* wf = wffn(a, jj_); bf16_t* Vb = last_ ? (bf16_t*)WSP(A_RV) : (bf16_t*)(a.ws + WS_VF); (void)wm; (void)wr_; (void)wf; (void)Vb;
            { MapSimple S{(const char*)WSP(A_H), (const char*)wm, P1K, P1K, 3, 16, 0}; EpiBf<FPlain> E{{(bf16_t*)WSP(A_QKVA), 768}};
            pg8::gemm_phase(lds, 1024, 1024, S, E, G, c); } }
        SEAM(pb + 1);
        if (CT(2) && IN(pb + 2)) REPS(2) { PHB const bf16_t* wm = wmla(a, jj_); const bf16_t* wr_ = wrwkv(a, jj_); const bf16_t* wf = wffn(a, jj_); bf16_t* Vb = last_ ? (bf16_t*)WSP(A_RV) : (bf16_t*)(a.ws + WS_VF); (void)wm; (void)wr_; (void)wf; (void)Vb;
            mla_stats(a, G, c); }
        SEAM(pb + 2);
        if (CT(3) && IN(pb + 3)) REPS(3) { PHB const bf16_t* wm = wmla(a, jj_); const bf16_t* wr_ = wrwkv(a, jj_); const bf16_t* wf = wffn(a, jj_); bf16_t* Vb = last_ ? (bf16_t*)WSP(A_RV) : (bf16_t*)(a.ws + WS_VF); (void)wm; (void)wr_; (void)wf; (void)Vb;
            { MapQKV S{(const char*)WSP(A_QKVA), (const char*)(wm + E_QKVA), (const char*)(wm + E_QKVA + E_QB)};
            EpiQKV E{(bf16_t*)WSP(A_Q), (bf16_t*)WSP(A_KV), (const float*)(a.ws + WS_RS), (const float*)(a.ws + WS_RS) + R};
            pg8::gemm_phase(lds, 768, 384, S, E, G, c); } }
        SEAM(pb + 3);
        if (CT(4) && IN(pb + 4)) REPS(4) { PHB const bf16_t* wm = wmla(a, jj_); const bf16_t* wr_ = wrwkv(a, jj_); const bf16_t* wf = wffn(a, jj_); bf16_t* Vb = last_ ? (bf16_t*)WSP(A_RV) : (bf16_t*)(a.ws + WS_VF); (void)wm; (void)wr_; (void)wf; (void)Vb;
            mla_qkpost(a, jj, G, c); }
        SEAM(pb + 4);
        if (CT(5) && IN(pb + 5)) REPS(5) { PHB const bf16_t* wm = wmla(a, jj_); const bf16_t* wr_ = wrwkv(a, jj_); const bf16_t* wf = wffn(a, jj_); bf16_t* Vb = last_ ? (bf16_t*)WSP(A_RV) : (bf16_t*)(a.ws + WS_VF); (void)wm; (void)wr_; (void)wf; (void)Vb;
            attn_phase(a, lds, G, c); }
        SEAM(pb + 5);
        if (CT(6) && IN(pb + 6)) REPS(6) { PHB const bf16_t* wm = wmla(a, jj_); const bf16_t* wr_ = wrwkv(a, jj_); const bf16_t* wf = wffn(a, jj_); bf16_t* Vb = last_ ? (bf16_t*)WSP(A_RV) : (bf16_t*)(a.ws + WS_VF); (void)wm; (void)wr_; (void)wf; (void)Vb;
            { MapSimple S{(const char*)WSP(A_O), (const char*)(wm + E_QKVA + E_QB + E_KVB), P1K, P1K, 4, 16, 0}; EpiResid E{(float*)(a.ws + WS_CS), a.out, (const float*)(a.ws + WS_MODS), lm, 2, jj == 0 ? a.in[I_CTX] : (const float*)(a.ws + WS_CS), jj == 0 ? a.in[I_X] : (const float*)a.out};
            pg8::gemm_phase(lds, 1024, 1024, S, E, G, c); } }
        SEAM(pb + 6);
        if (CT(7) && IN(pb + 7)) REPS(7) { PHB const bf16_t* wm = wmla(a, jj_); const bf16_t* wr_ = wrwkv(a, jj_); const bf16_t* wf = wffn(a, jj_); bf16_t* Vb = last_ ? (bf16_t*)WSP(A_RV) : (bf16_t*)(a.ws + WS_VF); (void)wm; (void)wr_; (void)wf; (void)Vb;
            norm_plain<false>(a, lm, a.in[I_N2G] + lm * D, 3, (bf16_t*)WSP(A_H), G, c); }
        SEAM(pb + 7);
        if (CT(8) && IN(pb + 8)) REPS(8) { PHB const bf16_t* wm = wmla(a, jj_); const bf16_t* wr_ = wrwkv(a, jj_); const bf16_t* wf = wffn(a, jj_); bf16_t* Vb = last_ ? (bf16_t*)WSP(A_RV) : (bf16_t*)(a.ws + WS_VF); (void)wm; (void)wr_; (void)wf; (void)Vb;
            { MapSimple S{(const char*)WSP(A_H), (const char*)wf, P1K, P1K, 22, 16, 0}; EpiSwiGLU E{(bf16_t*)WSP(A_FHID), DFF};
            pg8::gemm_phase(lds, 1024, 1024, S, E, G, c); } }
        SEAM(pb + 8);
        if (CT(9) && IN(pb + 9)) REPS(9) { PHB const bf16_t* wm = wmla(a, jj_); const bf16_t* wr_ = wrwkv(a, jj_); const bf16_t* wf = wffn(a, jj_); bf16_t* Vb = last_ ? (bf16_t*)WSP(A_RV) : (bf16_t*)(a.ws + WS_VF); (void)wm; (void)wr_; (void)wf; (void)Vb;
            { MapSimple S{(const char*)WSP(A_FHID), (const char*)(wf + E_F13), (size_t)256 * DFF * 2, (size_t)256 * DFF * 2, 4, 44, 0}; EpiResid E{(float*)(a.ws + WS_CS), a.out, (const float*)(a.ws + WS_MODS), lm, 5, (const float*)(a.ws + WS_CS), (const float*)a.out};
            pg8::gemm_phase(lds, DFF, DFF, S, E, G, c); } }
        SEAM(pb + 9);
        if (CT(10) && IN(pb + 10)) REPS(10) { PHB const bf16_t* wm = wmla(a, jj_); const bf16_t* wr_ = wrwkv(a, jj_); const bf16_t* wf = wffn(a, jj_); bf16_t* Vb = last_ ? (bf16_t*)WSP(A_RV) : (bf16_t*)(a.ws + WS_VF); (void)wm; (void)wr_; (void)wf; (void)Vb;
            norm_mix(a, lr, jj, G, c); }
        SEAM(pb + 10);
        if (CT(11) && IN(pb + 11)) REPS(11) { PHB const bf16_t* wm = wmla(a, jj_); const bf16_t* wr_ = wrwkv(a, jj_); const bf16_t* wf = wffn(a, jj_); bf16_t* Vb = last_ ? (bf16_t*)WSP(A_RV) : (bf16_t*)(a.ws + WS_VF); (void)wm; (void)wr_; (void)wf; (void)Vb;
            { MapRw1 S{(const char*)WSP(A_AX), (const char*)wr_, (const char*)(wr_ + E_B1), (const char*)(wr_ + E_B1 + E_B2), G};
            EpiBf<FRw1> E{{(bf16_t*)WSP(A_L1), (bf16_t*)WSP(A_RR), (bf16_t*)WSP(A_RK), Vb}};
            pg8::gemm_phase(lds, 5120, LDB1, S, E, G, c); } }
        SEAM(pb + 11);
        if (CT(12) && IN(pb + 12)) REPS(12) { PHB const bf16_t* wm = wmla(a, jj_); const bf16_t* wr_ = wrwkv(a, jj_); const bf16_t* wf = wffn(a, jj_); bf16_t* Vb = last_ ? (bf16_t*)WSP(A_RV) : (bf16_t*)(a.ws + WS_VF); (void)wm; (void)wr_; (void)wf; (void)Vb;
            { int nt4 = 4; asm volatile("" : "+s"(nt4));
            MapRw2 S{(const char*)WSP(A_L1), (const char*)(wr_ + E_B1 + E_B2 + E_L1), (const char*)(wr_ + E_B1 + E_B2 + E_L1 + E_L2A), 0, last ? 24 : 20, nt4};
            EpiRw2 E{(bf16_t*)WSP(A_WL0), (bf16_t*)WSP(A_VL), a.in[I_W0] + (size_t)jj * 2 * D, a.in[I_A0] + (size_t)jj * 2 * D}; pg8::gemm_phase(lds, 512, 256, S, E, G, c); } }
        SEAM(pb + 12);
        if (CT(13) && IN(pb + 13)) REPS(13) { PHB const bf16_t* wm = wmla(a, jj_); const bf16_t* wr_ = wrwkv(a, jj_); const bf16_t* wf = wffn(a, jj_); bf16_t* Vb = last_ ? (bf16_t*)WSP(A_RV) : (bf16_t*)(a.ws + WS_VF); (void)wm; (void)wr_; (void)wf; (void)Vb;
            { if (SCAN_CHUNKED) scan_chunked(a, jj, Vb, last, lds, G, c); if (!SCAN_CHUNKED || CS_BOTH) { __syncthreads(); scan_phase(a, jj, Vb, last, lds, G, c); }
              if (SCAN_CHUNKED && CS_BOTH) scan_compare(a, lds, G, c); } }
        SEAM(pb + 13);
        if (CT(14) && IN(pb + 14)) REPS(14) { PHB const bf16_t* wm = wmla(a, jj_); const bf16_t* wr_ = wrwkv(a, jj_); const bf16_t* wf = wffn(a, jj_); bf16_t* Vb = last_ ? (bf16_t*)WSP(A_RV) : (bf16_t*)(a.ws + WS_VF); (void)wm; (void)wr_; (void)wf; (void)Vb;
            rwkv_outprep(a, jj, Vb, last, G, c); }
        SEAM(pb + 14);
        if (CT(15) && IN(pb + 15)) REPS(15) { PHB const bf16_t* wm = wmla(a, jj_); const bf16_t* wr_ = wrwkv(a, jj_); const bf16_t* wf = wffn(a, jj_); bf16_t* Vb = last_ ? (bf16_t*)WSP(A_RV) : (bf16_t*)(a.ws + WS_VF); (void)wm; (void)wr_; (void)wf; (void)Vb;
            { MapSimple S{(const char*)WSP(A_RO), (const char*)(wr_ + E_B1 + E_B2 + E_L1 + E_L2A + E_L2B), P1K, P1K, 4, 16, last ? 1 : 0}; EpiResid E{(float*)(a.ws + WS_CS), a.out, (const float*)(a.ws + WS_MODS), lr, 2, (const float*)(a.ws + WS_CS), (const float*)a.out};
            pg8::gemm_phase(lds, 1024, 1024, S, E, G, c); } }
        SEAM(pb + 15);
        if (CT(16) && IN(pb + 16)) REPS(16) { PHB const bf16_t* wm = wmla(a, jj_); const bf16_t* wr_ = wrwkv(a, jj_); const bf16_t* wf = wffn(a, jj_); bf16_t* Vb = last_ ? (bf16_t*)WSP(A_RV) : (bf16_t*)(a.ws + WS_VF); (void)wm; (void)wr_; (void)wf; (void)Vb;
            { norm_router(a, lr, jj, last, lds, G, c); run_prep(a, lds + TILE_OFF, jj, CS_NOTILE ? 0 : (SCAN_CHUNKED ? cs::NCK - 1 : scan::NCH - 2), G, c);   } }
        SEAM(pb + 16);
        if (CT(17) && IN(pb + 17)) REPS(17) { PHB const bf16_t* wm = wmla(a, jj_); const bf16_t* wr_ = wrwkv(a, jj_); const bf16_t* wf = wffn(a, jj_); bf16_t* Vb = last_ ? (bf16_t*)WSP(A_RV) : (bf16_t*)(a.ws + WS_VF); (void)wm; (void)wr_; (void)wf; (void)Vb;
            moe_gather(a, lds, G, c); }
        SEAM(pb + 17);
        if (CT(18) && IN(pb + 18)) REPS(18) { PHB const bf16_t* wm = wmla(a, jj_); const bf16_t* wr_ = wrwkv(a, jj_); const bf16_t* wf = wffn(a, jj_); bf16_t* Vb = last_ ? (bf16_t*)WSP(A_RV) : (bf16_t*)(a.ws + WS_VF); (void)wm; (void)wr_; (void)wf; (void)Vb;
            { MapMoe S{(const char*)WSP(A_HS), (const char*)WSP(A_WM13), P1K, E_M13 * 2, P1K, 28, 16, (const int*)(a.ws + WS_META)}; EpiSwiGLU E{(bf16_t*)WSP(A_MHID), DFE};
            pg8::gemm_phase(lds, 1024, 1024, S, E, G, c); } }
        SEAM(pb + 18);
        if (CT(19) && IN(pb + 19)) REPS(19) { PHB const bf16_t* wm = wmla(a, jj_); const bf16_t* wr_ = wrwkv(a, jj_); const bf16_t* wf = wffn(a, jj_); bf16_t* Vb = last_ ? (bf16_t*)WSP(A_RV) : (bf16_t*)(a.ws + WS_VF); (void)wm; (void)wr_; (void)wf; (void)Vb;
            { MapMoeDown S{(const char*)WSP(A_MHID), (const char*)WSP(A_WM2), (size_t)256 * DFE * 2, E_M2 * 2, (size_t)256 * DFE * 2, (const int*)(a.ws + WS_META)}; EpiBf<FPlainAux> E{{(bf16_t*)WSP(A_Y2), 1024}};
            pg8::gemm_phase(lds, DFE, DFE, S, E, G, c); } }
        SEAM(pb + 19);
    }
    { const int jj_ = 1; const bool last_ = true;
    if (CT(21) && IN(41)) REPS(21) { PHB const bf16_t* wm = wmla(a, jj_); const bf16_t* wr_ = wrwkv(a, jj_); const bf16_t* wf = wffn(a, jj_); bf16_t* Vb = last_ ? (bf16_t*)WSP(A_RV) : (bf16_t*)(a.ws + WS_VF); (void)wm; (void)wr_; (void)wf; (void)Vb;
            combine_rows<false>(a, 3, 0, nullptr, 0, nullptr, G, c); }
    }
#undef IN
#undef SEAM
}

typedef void (*KernFn)(Args);
#if MK_ONE_LAUNCH
#ifndef PMASK
#define PMASK 0x3fffffu
#endif
static KernFn kern_of(int) { return fwd<PMASK>; }
#else
static KernFn kern_of(int p) {
    static const KernFn tab[22] = { fwd<1u << 0>, fwd<1u << 1>, fwd<1u << 2>, fwd<1u << 3>, fwd<1u << 4>, fwd<1u << 5>, fwd<1u << 6>, fwd<1u << 7>, fwd<1u << 8>, fwd<1u << 9>, fwd<1u << 10>, fwd<1u << 11>, fwd<1u << 12>, fwd<1u << 13>, fwd<1u << 14>, fwd<1u << 15>, fwd<1u << 16>, fwd<1u << 17>, fwd<1u << 18>, fwd<1u << 19>, fwd<1u << 20>, fwd<1u << 21> };
    return tab[p == 0 ? 20 : (p == NPH - 1 ? 21 : (p - 1) % 20)];
}
#endif
extern "C" void kernel_launch(void* const* d_in, const int* in_sizes, int n_in, void* d_out, int out_size, void* d_ws, size_t ws_size, hipStream_t stream) {
    static int grid = 0;
    if (grid == 0) {
        if (n_in != N_IN || out_size != NB * SEQ * D || ws_size < WS_NEED) { fprintf(stderr, "kernel_launch: unexpected shapes: n_in %d out %d ws %zu (need %zu)\n", n_in, out_size, ws_size, (size_t)WS_NEED); grid = -1; return; }
        int dev = 0, cus = 0;
        if (hipGetDevice(&dev) != hipSuccess || hipDeviceGetAttribute(&cus, hipDeviceAttributeMultiprocessorCount, dev) != hipSuccess) { grid = -1; return; }
        for (int p = 0; p < NPH; ++p)
            if (hipFuncSetAttribute((const void*)kern_of(p), hipFuncAttributeMaxDynamicSharedMemorySize, LDS_BYTES) != hipSuccess) { fprintf(stderr, "kernel_launch: hipFuncSetAttribute failed\n"); grid = -1; return; }
        int per_cu = 0;
        if (hipOccupancyMaxActiveBlocksPerMultiprocessor(&per_cu, (const void*)kern_of(1), NTHR, LDS_BYTES) != hipSuccess || per_cu < 1) { fprintf(stderr, "kernel_launch: occupancy query says %d blocks per CU\n", per_cu); (void)hipGetLastError(); }
        grid = cus < 256 ? cus : 256;
    }
    if (grid < 0) return;
    (void)in_sizes;
    (void)hipMemsetAsync((char*)d_ws + WS_CTL, 0, CTL_BYTES, stream);
    Args a{};
    for (int i = 0; i < N_IN; ++i) a.in[i] = (const float*)d_in[i];
    a.out = (float*)d_out; a.ws = (unsigned char*)d_ws;
#if MK_ONE_LAUNCH
    a.ph_lo = 0; a.ph_hi = NPH;
    hipLaunchKernelGGL(kern_of(0), dim3(grid), dim3(NTHR), LDS_BYTES, stream, a);
#else
    for (int p = 0; p < NPH; ++p) { a.ph_lo = p; a.ph_hi = p + 1; hipLaunchKernelGGL(kern_of(p), dim3(grid), dim3(NTHR), LDS_BYTES, stream, a); }
#endif
    const hipError_t le = hipPeekAtLastError();
    if (le != hipSuccess) fprintf(stderr, "kernel_launch: launch failed: %s\n", hipGetErrorName(le));
}
```

```cpp
#include <hip/hip_runtime.h>
#include <cstdio>
#include <cstdint>
#ifndef SCAN_CHUNKED
#define SCAN_CHUNKED 1
#endif
#ifndef CS_SERIAL
#define CS_SERIAL 0
#endif
#ifndef CS_BOTH
#define CS_BOTH 0
#endif
#ifndef CS_NOTILE
#define CS_NOTILE 0
#endif
#ifndef CS_OOP
#define CS_OOP 0
#endif
#ifndef CS_TOL
#define CS_TOL 0.05f
#endif

#ifndef MK_ONE_LAUNCH
#define MK_ONE_LAUNCH 1
#endif

#define LAS __attribute__((address_space(3)))
typedef unsigned short bf16_t;
typedef short bf16x8 __attribute__((ext_vector_type(8)));
typedef short s16x4 __attribute__((ext_vector_type(4)));
typedef float f32x2 __attribute__((ext_vector_type(2)));
typedef float f32x4 __attribute__((ext_vector_type(4)));
typedef float f32x16 __attribute__((ext_vector_type(16)));
typedef unsigned u32x2 __attribute__((ext_vector_type(2)));
typedef unsigned u32x4 __attribute__((ext_vector_type(4)));

constexpr int D = 1024, NB = 8, SEQ = 4096, CTX = 256, SEG = SEQ + CTX, R = NB * SEG;
constexpr int NPAN = R / 256;
constexpr int NTHR = 512, NWAVE = 8;
constexpr int QL = 384, KVL = 256, ROPE = 64, NOPE = 128, QKH = 192, VH = 128, NH = 8;
constexpr int DFF = 2816, NE = 8, DFE = 3584;
constexpr int MP_MAX = 71680;
constexpr float NORM_EPS = 1e-6f, LNX_EPS = 64e-5f;
constexpr float QSCALE = 0.07216878364870322f * 1.4426950408889634f;

enum { I_X = 0, I_C, I_CTX, I_CCTX, I_ADAW, I_ADAB, I_N1G, I_N2G, I_WQA, I_QAN, I_WQB, I_WKVA, I_KVAN, I_WKVB, I_QN, I_KN, I_MWO,
       I_MIX, I_WR, I_WK, I_WV, I_RWO, I_W0, I_W1, I_W2, I_A0, I_A1, I_A2, I_G1, I_G2, I_KK, I_KA, I_RK, I_LNW, I_LNB, I_V0, I_V1, I_V2,
       I_F1, I_F3, I_F2, I_ROUTER, I_M1, I_M3, I_M2, N_IN };

constexpr size_t U = (size_t)R * 1024 * 2;
constexpr size_t al256(size_t x) { return (x + 255) / 256 * 256; }
constexpr size_t WS_CTL = 0;
constexpr size_t CTL_BYTES = 65536;
constexpr size_t WS_MODS = WS_CTL + CTL_BYTES;
constexpr size_t WS_ROPE = WS_MODS + al256((size_t)4 * 9 * 6144 * 4);
constexpr size_t WS_CS = WS_ROPE + 8192;
constexpr size_t WS_RS = WS_CS + (size_t)NB * CTX * D * 4;
constexpr size_t WS_ROUTE = WS_RS + al256((size_t)R * 8);
constexpr size_t WS_RSLOT = WS_ROUTE + (size_t)R * 16;
constexpr size_t WS_HIST = WS_RSLOT + (size_t)R * 8;
constexpr size_t WS_META = WS_HIST + 2048 * 8 * 4;
constexpr size_t WS_DOT = WS_META + 256;
constexpr size_t WS_WSM = WS_DOT + (size_t)2 * R * 16 * 4;
constexpr size_t E_QKVA = 768 * 1024, E_QB = 1536 * 384, E_KVB = 2048 * 384, E_MWO = 1024 * 1024, E_MLA = E_QKVA + E_QB + E_KVB + E_MWO;
constexpr int LDB1 = 2048 + 64;
constexpr size_t E_B1 = 1024 * LDB1, E_B2 = 1024 * LDB1, E_L1 = 512 * LDB1, E_L2A = 4096 * 256, E_L2B = 2048 * 256, E_RWO = 1024 * 1024, E_RWKV = E_B1 + E_B2 + E_L1 + E_L2A + E_L2B + E_RWO;
constexpr size_t E_F13 = 5632 * 1024, E_F2 = 1024 * 2816, E_FFN = E_F13 + E_F2;
constexpr size_t WS_WMLA = WS_WSM, WS_WRWKV = WS_WMLA + 2 * E_MLA * 2, WS_WFFN = WS_WRWKV + 2 * E_RWKV * 2;
constexpr size_t WS_VF = WS_WFFN + 2 * E_FFN * 2;
constexpr size_t WS_ARENA = WS_VF + U;
constexpr size_t A_H = 0;
constexpr int LDKV = 2048 + 64;
constexpr size_t A_QKVA = U, A_Q = 2 * U, A_KV = 2 * U + U * 3 / 2, A_K = A_KV + al256((size_t)R * LDKV * 2), A_O = A_K + U * 3 / 2;
constexpr size_t A_FHID = U;
constexpr size_t A_AX = 0, A_L1 = 5 * U, A_RR = A_L1 + U / 2, A_RK = A_RR + U, A_RV = A_RK + U, A_VL = A_RV + U, A_REND = A_VL + U;
constexpr size_t A_WL0 = 0, A_WL1 = U, A_AL0 = 2 * U, A_AL1 = 3 * U, A_G = 4 * U, A_RO = 0;
constexpr size_t A_YF = (SCAN_CHUNKED && CS_OOP && !CS_BOTH) ? A_REND : A_WL0, A_YR = (SCAN_CHUNKED && CS_OOP && !CS_BOTH) ? A_REND + U : A_WL1;
constexpr size_t A_YCF = CS_BOTH ? A_REND : A_YF, A_YCR = CS_BOTH ? A_REND + U : A_YR;
constexpr size_t A_HS = U, A_Y2 = U, A_MHID = A_HS + (size_t)MP_MAX * 1024 * 2, A_MEND = A_MHID + (size_t)MP_MAX * DFE * 2;
constexpr size_t E_M13 = (size_t)7168 * 1024, E_M2 = (size_t)1024 * 3584;
constexpr size_t A_WM13 = A_MEND, A_WM2 = A_WM13 + NE * E_M13 * 2, A_END = A_WM2 + NE * E_M2 * 2;
constexpr size_t WS_NEED = WS_ARENA + (A_END > A_REND ? A_END : A_REND);
static_assert(WS_NEED <= 1081188352ull, "workspace budget (sum of inputs)");
static_assert(CS_OOP || CS_BOTH || A_WM13 >= A_REND, "the MoE weight region must be free during the RWKV mixer (weights are converted inside the scan phase)");

struct Args { const float* in[N_IN]; float* out; unsigned char* ws; int ph_lo, ph_hi; };

__device__ __forceinline__ unsigned cvt_pk_bf16(float lo, float hi) { unsigned r; asm("v_cvt_pk_bf16_f32 %0, %1, %2" : "=v"(r) : "v"(lo), "v"(hi)); return r; }
__device__ __forceinline__ float bflo(unsigned w) { return __uint_as_float(w << 16); }
__device__ __forceinline__ float bfhi(unsigned w) { return __uint_as_float(w & 0xffff0000u); }
__device__ __forceinline__ void unpack8(const u32x4 w, float (&f)[8]) { f[0] = bflo(w.x); f[1] = bfhi(w.x); f[2] = bflo(w.y); f[3] = bfhi(w.y); f[4] = bflo(w.z); f[5] = bfhi(w.z); f[6] = bflo(w.w); f[7] = bfhi(w.w); }
__device__ __forceinline__ u32x4 pack8(const float (&f)[8]) { u32x4 w; w.x = cvt_pk_bf16(f[0], f[1]); w.y = cvt_pk_bf16(f[2], f[3]); w.z = cvt_pk_bf16(f[4], f[5]); w.w = cvt_pk_bf16(f[6], f[7]); return w; }
__device__ __forceinline__ float wave_sum(float v) {
#pragma unroll
    for (int o = 32; o >= 1; o >>= 1) v += __shfl_xor(v, o);
    return v;
}
template <int CTRL> __device__ __forceinline__ float dpp_f(float v) { return __int_as_float(__builtin_amdgcn_update_dpp(0, __float_as_int(v), CTRL, 0xF, 0xF, true)); }
__device__ __forceinline__ float red8(float v) { v += dpp_f<0xB1>(v); v += dpp_f<0x4E>(v); v += dpp_f<0x141>(v); return v; }
__device__ __forceinline__ int ltid() { int t = threadIdx.x; asm volatile("" : "+v"(t)); return t; }
template <class T> __device__ __forceinline__ T launder_s(T x) { asm volatile("" : "+s"(x)); return x; }
__device__ __forceinline__ Args launder_args(const Args& k) { Args a = k; a.ws = launder_s(k.ws); a.out = launder_s(k.out); return a; }
__device__ __forceinline__ float wave_sum_dpp(float v) {
    v += dpp_f<0xB1>(v); v += dpp_f<0x4E>(v); v += dpp_f<0x141>(v); v += dpp_f<0x140>(v);
    const int iv = __float_as_int(v);
    return (__int_as_float(__builtin_amdgcn_readlane(iv, 0)) + __int_as_float(__builtin_amdgcn_readlane(iv, 16))) + (__int_as_float(__builtin_amdgcn_readlane(iv, 32)) + __int_as_float(__builtin_amdgcn_readlane(iv, 48)));
}
__device__ __forceinline__ float sigmoidf_(float x) { return __builtin_amdgcn_rcpf(1.0f + __expf(-x)); }
__device__ __forceinline__ float* xrow(const Args& a, int row) {
    const int b = row / SEG, r = row - b * SEG;
    return r < CTX ? (float*)(a.ws + WS_CS) + (size_t)(b * CTX + r) * D : a.out + (size_t)(b * SEQ + r - CTX) * D;
}
__device__ __forceinline__ const float* xrow_in(const Args& a, int row) {
    const int b = row / SEG, r = row - b * SEG;
    return r < CTX ? a.in[I_CTX] + (size_t)(b * CTX + r) * D : a.in[I_X] + (size_t)(b * SEQ + r - CTX) * D;
}
__device__ __forceinline__ int mod_index(int row) { const int b = row / SEG, r = row - b * SEG; return r < CTX ? 8 : b; }
__device__ __forceinline__ const float* mods_ptr(const Args& a, int layer, int mi, int which) { return (const float*)(a.ws + WS_MODS) + ((size_t)(layer * 9 + mi) * 6 + which) * 1024; }

#define XB_TMO      128
#define XB_XCNT(j)  (256  + 64 * (j))
#define XB_XSUB(j)  (1280 + 64 * (j))
#define XB_XGEN(j)  (2304 + 64 * (j))
#define XB_TOP      3328
#define XB_TOPGEN   3392
#define XCD_BAR_WORDS 3456
#define XB_SPIN_CAP (1u << 22)
__device__ __forceinline__ unsigned xb_ld(unsigned* p)              { return __hip_atomic_load(p, __ATOMIC_RELAXED, __HIP_MEMORY_SCOPE_AGENT); }
__device__ __forceinline__ unsigned xb_add(unsigned* p, unsigned v) { return __hip_atomic_fetch_add(p, v, __ATOMIC_RELAXED, __HIP_MEMORY_SCOPE_AGENT); }
__device__ __forceinline__ unsigned xb_xcc_id() { return (unsigned)__builtin_amdgcn_s_getreg((3 << 11) | 20) & 0xFu; }
#define XB_SPIN(cond, bar) do { unsigned _sp = 0; while (cond) { __builtin_amdgcn_s_sleep(1); \
    if ((++_sp & 255u) == 0u) { if (xb_ld(&(bar)[XB_TMO])) break; if (_sp > XB_SPIN_CAP) { atomicAdd(&(bar)[XB_TMO], 1u); break; } } } } while (0)
struct XcdBarrier { unsigned* bar; unsigned x; volatile LAS unsigned* st; };
__device__ __forceinline__ XcdBarrier xcd_barrier_post(unsigned* bar, volatile LAS unsigned* st) {
    XcdBarrier b; b.bar = bar; b.x = xb_xcc_id(); b.st = st;
    if (threadIdx.x == 0) (void)xb_add(&bar[XB_XCNT(b.x)], 1u);
    return b;
}
__device__ __forceinline__ void xcd_barrier_complete(unsigned* bar, unsigned x, unsigned& nloc, unsigned& nx) {
    const unsigned G = gridDim.x * gridDim.y * gridDim.z;
    unsigned sum, cnt, mine, sp = 0u;
    for (;;) {
        sum = 0u; cnt = 0u; mine = 0u;
#pragma unroll
        for (unsigned j = 0; j < 16; ++j) { const unsigned c = xb_ld(&bar[XB_XCNT(j)]); sum += c; cnt += (c > 0u) ? 1u : 0u; mine = (j == x) ? c : mine; }
        if (sum == G) break;
        __builtin_amdgcn_s_sleep(1);
        if ((++sp & 255u) == 0u) { if (xb_ld(&bar[XB_TMO])) break; if (sp > XB_SPIN_CAP) { atomicAdd(&bar[XB_TMO], 1u); break; } }
    }
    nloc = mine > 0u ? mine : 1u; nx = cnt > 0u ? cnt : 1u;
}
__device__ __forceinline__ void xcd_barrier(const XcdBarrier& b) {
    asm volatile("s_waitcnt vmcnt(0)" ::: "memory");
    __syncthreads();
    if (threadIdx.x == 0) {
        unsigned* bar = b.bar;
        __builtin_amdgcn_s_waitcnt(0);
        unsigned nloc = b.st[0], nx = b.st[1];
        if (nloc == 0u) { xcd_barrier_complete(bar, b.x, nloc, nx); b.st[0] = nloc; b.st[1] = nx; }
        const unsigned old = xb_add(&bar[XB_XSUB(b.x)], 1u);
        const unsigned gen = old / nloc;
        if (old + 1u == (gen + 1u) * nloc) {
            __builtin_amdgcn_fence(__ATOMIC_RELEASE, "agent");
            asm volatile("s_waitcnt vmcnt(0)" ::: "memory");
            const unsigned og = xb_add(&bar[XB_TOP], 1u);
            const unsigned tg = og / nx;
            if (og + 1u == (tg + 1u) * nx) xb_add(&bar[XB_TOPGEN], 1u);
            else XB_SPIN(xb_ld(&bar[XB_TOPGEN]) == tg, bar);
            __builtin_amdgcn_fence(__ATOMIC_ACQUIRE, "agent");
            xb_add(&bar[XB_XGEN(b.x)], 1u);
            asm volatile("s_waitcnt vmcnt(0)" ::: "memory");
        } else {
            XB_SPIN(xb_ld(&bar[XB_XGEN(b.x)]) == gen, bar);
            __builtin_amdgcn_fence(__ATOMIC_ACQUIRE, "agent");
            asm volatile("s_waitcnt vmcnt(0)" ::: "memory");
        }
    }
    __syncthreads();
}

namespace pg8 {
constexpr int BM = 256, BK = 64, HALF = 128, HTB = HALF * BK * 2, STAGE_BYTES = 8 * HTB;
__device__ __forceinline__ int lds_byte(int r, int c) { const int st = (r >> 4) * 2 + (c >> 5), rr = r & 15, cc = c & 31, ob = rr * 64 + cc * 2; return st * 1024 + (ob ^ (((ob >> 9) & 1) << 5)); }
__device__ __forceinline__ void stage_rc(int b, int& Rr, int& C) { const int st = b / 1024, sb = b % 1024, swz = sb ^ (((sb >> 9) & 1) << 5); Rr = (st >> 1) * 16 + swz / 64; C = (st & 1) * 32 + (swz % 64) / 2; }
__device__ __forceinline__ int perm32(int rho) { const int n = rho >> 4, i = rho & 15; return 8 * (i >> 2) + 4 * n + (i & 3); }
struct GUnit { const char* A; const char* B; int nt, pm, pn, aux; };
__device__ __forceinline__ void tile_order(int L, int nM, int nN, int& pm, int& pn) {
    const int nwg = nM * nN; int wgid = L;
    { const int q = nwg / 8, r = nwg % 8, xcd = wgid % 8, off = wgid / 8; wgid = (xcd < r ? xcd * (q + 1) : r * (q + 1) + (xcd - r) * q) + off; }
    const int nig = 8 * nN, gid = wgid / nig, fm = gid * 8, gsz = (nM - fm) < 8 ? (nM - fm) : 8;
    pm = fm + ((wgid % nig) % gsz); pn = (wgid % nig) / gsz;
}
template <class Epi, class Map>
__device__ __forceinline__ void gemm_phase(LAS unsigned char* lds, const int lda, const int ldb, const Map& S, const Epi& E, const int G, const int c) {
    const int tid = ltid(), wid = __builtin_amdgcn_readfirstlane(tid >> 6), lane = tid & 63, wr = wid >> 2, wc = wid & 3, fr = lane & 15, fq = lane >> 4;
    unsigned voffA[2], voffB[2];
#pragma unroll
    for (int i = 0; i < 2; ++i) { int Rr, C; stage_rc(tid * 16 + i * 8192, Rr, C); const int Rb = Epi::PERM ? ((Rr & ~31) + perm32(Rr & 31)) : Rr;
        voffA[i] = (unsigned)(Rr * lda + C) * 2u; voffB[i] = (unsigned)(Rb * ldb + C) * 2u; }
    const size_t kstep = (size_t)(BK * 2);
    const size_t hA = (size_t)HALF * lda * 2, hB = (size_t)HALF * ldb * 2;
    const unsigned ldsw = (unsigned)wid * 1024u;
    const int aoff = lds_byte(wr * 64 + fr, fq * 8), boff = lds_byte(wc * 32 + fr, fq * 8);
#define PG8_SA(b, h) (((b) * 2 + (h)) * HTB)
#define PG8_SB(b, h) ((4 + (b) * 2 + (h)) * HTB)
#define PG8_STAGE(bufoff, gbase, voff) do { _Pragma("unroll") for (int _i = 0; _i < 2; ++_i) \
        __builtin_amdgcn_global_load_lds((const unsigned*)((const char*)(gbase) + (voff)[_i]), (LAS unsigned*)(lds + (bufoff) + ldsw + _i * 8192), 16, 0, 0); } while (0)
#define PG8_LDA(dst, b, h) do { _Pragma("unroll") for (int m = 0; m < 4; ++m) _Pragma("unroll") for (int k = 0; k < 2; ++k) dst[m][k] = *(const LAS bf16x8*)(lds + PG8_SA(b, h) + aoff + m * 2048 + k * 1024); } while (0)
#define PG8_LDB(dst, b, h) do { _Pragma("unroll") for (int n = 0; n < 2; ++n) _Pragma("unroll") for (int k = 0; k < 2; ++k) dst[n][k] = *(const LAS bf16x8*)(lds + PG8_SB(b, h) + boff + n * 2048 + k * 1024); } while (0)
#define PG8_MMA(ai, bj, At, Bt) do { __builtin_amdgcn_s_setprio(1); _Pragma("unroll") for (int m = 0; m < 4; ++m) _Pragma("unroll") for (int n = 0; n < 2; ++n) _Pragma("unroll") for (int k = 0; k < 2; ++k) \
        acc[ai][bj][m][n] = __builtin_amdgcn_mfma_f32_16x16x32_bf16(Bt[n][k], At[m][k], acc[ai][bj][m][n], 0, 0, 0); __builtin_amdgcn_s_setprio(0); } while (0)
#define PG8_WAIT_V(n) asm volatile("s_waitcnt vmcnt(" #n ")" ::: "memory")
#define PG8_WAIT_L(n) asm volatile("s_waitcnt lgkmcnt(" #n ")" ::: "memory")
#define PG8_BAR __builtin_amdgcn_s_barrier()
#define PG8_SCHED __builtin_amdgcn_sched_barrier(0)
    GUnit cur, nxt; int ui = 0;
    if (!S(c, cur)) return;
    f32x4 acc[2][2][4][2];
#pragma unroll
    for (int a = 0; a < 2; ++a)
#pragma unroll
        for (int b = 0; b < 2; ++b)
#pragma unroll
            for (int m = 0; m < 4; ++m)
#pragma unroll
                for (int n = 0; n < 2; ++n) acc[a][b][m][n] = (f32x4){0.f, 0.f, 0.f, 0.f};
    bf16x8 At[4][2], B0[2][2], B1[2][2];
    const char* cA = cur.A; const char* cB = cur.B;
    PG8_STAGE(PG8_SB(0, 0), cB, voffB); PG8_STAGE(PG8_SB(0, 1), cB + hB, voffB); PG8_STAGE(PG8_SA(0, 0), cA, voffA); PG8_STAGE(PG8_SA(0, 1), cA + hA, voffA);
    if (wr == 1) PG8_BAR;
    PG8_WAIT_V(2); PG8_BAR;
    PG8_STAGE(PG8_SB(1, 0), cB + kstep, voffB); PG8_STAGE(PG8_SA(1, 0), cA + kstep, voffA); PG8_STAGE(PG8_SB(1, 1), cB + hB + kstep, voffB);
    PG8_WAIT_V(6); PG8_BAR;
    for (;;) {
        const bool has_next = S((ui + 1) * G + c, nxt);
        const char* nA = has_next ? nxt.A : cA; const char* nB = has_next ? nxt.B : cB;
        const int nt = cur.nt;
        for (int t = 0; t < nt; t += 2) {
            const bool last = (t == nt - 2);
            const char* a1 = cA + (size_t)(t + 1) * kstep;
            const char* a2 = last ? nA : cA + (size_t)(t + 2) * kstep; const char* b2 = last ? nB : cB + (size_t)(t + 2) * kstep;
            const char* a3 = a2 + kstep; const char* b3 = b2 + kstep;
            PG8_LDB(B0, 0, 0); PG8_LDB(B1, 0, 1); PG8_SCHED; PG8_LDA(At, 0, 0); PG8_STAGE(PG8_SA(1, 1), a1 + hA, voffA);
            PG8_WAIT_V(8); PG8_WAIT_L(0); PG8_BAR; PG8_MMA(0, 0, At, B0); PG8_MMA(0, 1, At, B1); PG8_BAR; PG8_SCHED;
            PG8_LDA(At, 0, 1); PG8_STAGE(PG8_SB(0, 0), b2, voffB); PG8_STAGE(PG8_SB(0, 1), b2 + hB, voffB); PG8_STAGE(PG8_SA(0, 0), a2, voffA);
            PG8_WAIT_V(8); PG8_WAIT_L(0); PG8_BAR; PG8_MMA(1, 0, At, B0); PG8_MMA(1, 1, At, B1); PG8_BAR; PG8_SCHED;
            PG8_LDB(B0, 1, 0); PG8_LDB(B1, 1, 1); PG8_SCHED; PG8_LDA(At, 1, 0); PG8_STAGE(PG8_SA(0, 1), a2 + hA, voffA);
            PG8_WAIT_V(8); PG8_WAIT_L(0); PG8_BAR; PG8_MMA(0, 0, At, B0); PG8_MMA(0, 1, At, B1); PG8_BAR; PG8_SCHED;
            PG8_LDA(At, 1, 1); PG8_STAGE(PG8_SB(1, 0), b3, voffB); PG8_STAGE(PG8_SB(1, 1), b3 + hB, voffB); PG8_STAGE(PG8_SA(1, 0), a3, voffA);
            PG8_WAIT_V(8); PG8_WAIT_L(0); PG8_BAR; PG8_MMA(1, 0, At, B0); PG8_MMA(1, 1, At, B1); PG8_BAR; PG8_SCHED;
        }
        if (wr == 0) PG8_BAR;
        E(acc, cur, wr, wc, fr, fq);
        if (!has_next) break;
#pragma unroll
        for (int a = 0; a < 2; ++a)
#pragma unroll
            for (int b = 0; b < 2; ++b)
#pragma unroll
                for (int m = 0; m < 4; ++m)
#pragma unroll
                    for (int n = 0; n < 2; ++n) acc[a][b][m][n] = (f32x4){0.f, 0.f, 0.f, 0.f};
        cur = nxt; cA = nA; cB = nB; ++ui;
        if (wr == 1) PG8_BAR;
    }
    PG8_WAIT_V(0);
    PG8_BAR;
#undef PG8_SA
#undef PG8_SB
#undef PG8_STAGE
#undef PG8_LDA
#undef PG8_LDB
#undef PG8_MMA
#undef PG8_WAIT_V
#undef PG8_WAIT_L
#undef PG8_BAR
#undef PG8_SCHED
}
}

using pg8::GUnit;
typedef f32x4 Acc[2][2][4][2];
template <class F> struct EpiBf {
    static constexpr bool PERM = true;
    F f;
    __device__ __forceinline__ void operator()(const Acc& acc, const GUnit& u, int wr, int wc, int fr, int fq) const {
#pragma unroll
        for (int ai = 0; ai < 2; ++ai)
#pragma unroll
            for (int m = 0; m < 4; ++m) { const int trow = ai * 128 + wr * 64 + m * 16 + fr;
#pragma unroll
                for (int bj = 0; bj < 2; ++bj) f(acc[ai][bj][m][0], acc[ai][bj][m][1], u, trow, bj * 128 + wc * 32 + 8 * fq); }
    }
};
__device__ __forceinline__ void st8(bf16_t* p, f32x4 v0, f32x4 v1) { u32x4 w; w.x = cvt_pk_bf16(v0[0], v0[1]); w.y = cvt_pk_bf16(v0[2], v0[3]); w.z = cvt_pk_bf16(v1[0], v1[1]); w.w = cvt_pk_bf16(v1[2], v1[3]); *(u32x4*)p = w; }

struct FPlain { bf16_t* O; int ldc;
    __device__ __forceinline__ void operator()(f32x4 v0, f32x4 v1, const GUnit& u, int trow, int tcol) const { st8(O + (size_t)(u.pm * 256 + trow) * ldc + u.pn * 256 + tcol, v0, v1); } };
struct FQKV { bf16_t* Q; bf16_t* KV; const float* rsq; const float* rskv;
    __device__ __forceinline__ void operator()(f32x4 v0, f32x4 v1, const GUnit& u, int trow, int tcol) const {
        const int row = u.pm * 256 + trow;
        if (u.aux == 0) { const float s = rsq[row]; st8(Q + (size_t)row * 1536 + u.pn * 256 + tcol, v0 * s, v1 * s); }
        else { const float s = rskv[row]; st8(KV + (size_t)row * LDKV + u.pn * 256 + tcol, v0 * s, v1 * s); } } };
struct EpiQKV {
    static constexpr bool PERM = true;
    bf16_t* Q; bf16_t* KV; const float* rsq; const float* rskv;
    __device__ __forceinline__ void operator()(const Acc& acc, const GUnit& u, int wr, int wc, int fr, int fq) const {
        const float* rs = (u.aux == 0) ? rsq : rskv; bf16_t* O = (u.aux == 0) ? Q : KV; const int ldc = (u.aux == 0) ? 1536 : LDKV;
        float sc[2][4];
#pragma unroll
        for (int ai = 0; ai < 2; ++ai)
#pragma unroll
            for (int m = 0; m < 4; ++m) sc[ai][m] = rs[u.pm * 256 + ai * 128 + wr * 64 + m * 16 + fr];
#pragma unroll
        for (int ai = 0; ai < 2; ++ai)
#pragma unroll
            for (int m = 0; m < 4; ++m) { const int row = u.pm * 256 + ai * 128 + wr * 64 + m * 16 + fr; const float s = sc[ai][m];
#pragma unroll
                for (int bj = 0; bj < 2; ++bj) st8(O + (size_t)row * ldc + u.pn * 256 + bj * 128 + wc * 32 + 8 * fq, acc[ai][bj][m][0] * s, acc[ai][bj][m][1] * s); }
    }
};
struct EpiRw2 {
    static constexpr bool PERM = true;
    bf16_t* base; bf16_t* vl; const float* w0; const float* a0;
    __device__ __forceinline__ void operator()(const Acc& acc, const GUnit& u, int wr, int wc, int fr, int fq) const {
        bf16_t* o = (u.aux < 5) ? base + (size_t)u.aux * ((size_t)R * 1024) : vl;
        const bool act = u.aux < 4; const float scl = (u.aux < 2) ? 0.6065306597126334f : 1.0f;
        f32x4 bv[2][2];
#pragma unroll
        for (int bj = 0; bj < 2; ++bj) { const int col = u.pn * 256 + bj * 128 + wc * 32 + 8 * fq; const float* bp = (u.aux < 2 ? w0 : a0) + (u.aux & 1) * 1024 + col;
            bv[bj][0] = act ? *(const f32x4*)bp : (f32x4){0.f, 0.f, 0.f, 0.f}; bv[bj][1] = act ? *(const f32x4*)(bp + 4) : (f32x4){0.f, 0.f, 0.f, 0.f}; }
#pragma unroll
        for (int ai = 0; ai < 2; ++ai)
#pragma unroll
            for (int m = 0; m < 4; ++m) { const int row = u.pm * 256 + ai * 128 + wr * 64 + m * 16 + fr;
#pragma unroll
                for (int bj = 0; bj < 2; ++bj) { f32x4 v0 = acc[ai][bj][m][0], v1 = acc[ai][bj][m][1];
                    if (act) {
#pragma unroll
                        for (int j = 0; j < 4; ++j) { v0[j] = scl * sigmoidf_(bv[bj][0][j] + v0[j]); v1[j] = scl * sigmoidf_(bv[bj][1][j] + v1[j]); } }
                    st8(o + (size_t)row * 1024 + u.pn * 256 + bj * 128 + wc * 32 + 8 * fq, v0, v1); } }
    }
};
struct FRw1 { bf16_t* L1; bf16_t* RR; bf16_t* RK; bf16_t* RV;
    __device__ __forceinline__ void operator()(f32x4 v0, f32x4 v1, const GUnit& u, int trow, int tcol) const {
        const int row = u.pm * 256 + trow;
        if (u.aux == 0) { const int col = u.pn * 256 + tcol;
            if (col < 128) {
#pragma unroll
                for (int j = 0; j < 4; ++j) { v0[j] = 1.0f - 2.0f * __builtin_amdgcn_rcpf(1.0f + __expf(2.0f * v0[j])); v1[j] = 1.0f - 2.0f * __builtin_amdgcn_rcpf(1.0f + __expf(2.0f * v1[j])); } }
            else if (col >= 320) {
#pragma unroll
                for (int j = 0; j < 4; ++j) { v0[j] = sigmoidf_(v0[j]); v1[j] = sigmoidf_(v1[j]); } }
            st8(L1 + (size_t)row * 512 + col, v0, v1); }
        else { bf16_t* o = u.aux == 1 ? RR : (u.aux == 2 ? RK : RV); st8(o + (size_t)row * 1024 + u.pn * 256 + tcol, v0, v1); } } };
struct FRw2 { bf16_t* base; bf16_t* vl; const float* w0; const float* a0;
    __device__ __forceinline__ void operator()(f32x4 v0, f32x4 v1, const GUnit& u, int trow, int tcol) const {
        const int col = u.pn * 256 + tcol;
        const unsigned off = (unsigned)(u.pm * 256 + trow) * 1024u + (unsigned)col + (u.aux < 5 ? (unsigned)u.aux * (unsigned)(R * 1024) : 0u);
        bf16_t* o = (u.aux < 5) ? base : vl;
        if (u.aux < 4) {
            const float* bp = (u.aux < 2 ? w0 : a0) + (u.aux & 1) * 1024 + col; const f32x4 b0 = *(const f32x4*)bp, b1 = *(const f32x4*)(bp + 4);
            const float sc = (u.aux < 2) ? 0.6065306597126334f : 1.0f;
#pragma unroll
            for (int j = 0; j < 4; ++j) { v0[j] = sc * sigmoidf_(b0[j] + v0[j]); v1[j] = sc * sigmoidf_(b1[j] + v1[j]); } }
        st8(o + off, v0, v1); } };
struct EpiSwiGLU {
    static constexpr bool PERM = true;
    bf16_t* O; int ldc;
    __device__ __forceinline__ void operator()(const Acc& acc, const GUnit& u, int wr, int wc, int fr, int fq) const {
#pragma unroll
        for (int ai = 0; ai < 2; ++ai)
#pragma unroll
            for (int m = 0; m < 4; ++m) { const int trow = ai * 128 + wr * 64 + m * 16 + fr; f32x4 h0, h1;
#pragma unroll
                for (int j = 0; j < 4; ++j) { const float g0 = acc[ai][0][m][0][j], g1 = acc[ai][0][m][1][j];
                    h0[j] = g0 * sigmoidf_(g0) * acc[ai][1][m][0][j]; h1[j] = g1 * sigmoidf_(g1) * acc[ai][1][m][1][j]; }
                st8(O + (size_t)(u.pm * 256 + trow) * ldc + u.pn * 128 + wc * 32 + 8 * fq, h0, h1); }
    }
};
struct EpiResid {
    static constexpr bool PERM = false;
    float* cs; float* out; const float* mods; int layer, which;
    const float* scs; const float* sout;
    __device__ __forceinline__ void operator()(const Acc& acc, const GUnit& u, int wr, int wc, int fr, int fq) const {
        const int b = u.pm / 17, isctx = (u.pm % 17 == 0);
        float* xp = isctx ? cs + (size_t)b * CTX * D : out + (size_t)(b * SEQ + (u.pm % 17 - 1) * 256) * D;
        const float* sp = isctx ? scs + (size_t)b * CTX * D : sout + (size_t)(b * SEQ + (u.pm % 17 - 1) * 256) * D;
        const float* gp = mods + ((size_t)(layer * 9 + (isctx ? 8 : b)) * 6 + which) * 1024;
        const int col0 = u.pn * 256 + wc * 32 + 4 * fq;
        f32x4 gv[2][2];
#pragma unroll
        for (int bj = 0; bj < 2; ++bj)
#pragma unroll
            for (int n = 0; n < 2; ++n) gv[bj][n] = *(const f32x4*)(gp + col0 + bj * 128 + n * 16);
#pragma unroll
        for (int ai = 0; ai < 2; ++ai)
#pragma unroll
            for (int mh = 0; mh < 2; ++mh) {
                f32x4 xv[2][2][2];
#pragma unroll
                for (int mm = 0; mm < 2; ++mm) { const float* srow = sp + (size_t)(ai * 128 + wr * 64 + (mh * 2 + mm) * 16 + fr) * D + col0;
#pragma unroll
                    for (int bj = 0; bj < 2; ++bj)
#pragma unroll
                        for (int n = 0; n < 2; ++n) xv[mm][bj][n] = *(const f32x4*)(srow + bj * 128 + n * 16); }
#pragma unroll
                for (int mm = 0; mm < 2; ++mm) { float* rowp = xp + (size_t)(ai * 128 + wr * 64 + (mh * 2 + mm) * 16 + fr) * D + col0;
#pragma unroll
                    for (int bj = 0; bj < 2; ++bj)
#pragma unroll
                        for (int n = 0; n < 2; ++n) *(f32x4*)(rowp + bj * 128 + n * 16) = xv[mm][bj][n] + gv[bj][n] * acc[ai][bj][mh * 2 + mm][n]; }
                asm volatile("" ::: "memory"); }
    }
};

struct MapSimple {
    const char* A; const char* B; size_t sa, sb; int nN, nt, lat;
    __device__ __forceinline__ bool operator()(int L, GUnit& u) const { const int nM = lat ? 128 : NPAN; if (L >= nM * nN) return false; int q; pg8::tile_order(L, nM, nN, q, u.pn);
        u.pm = lat ? (q / 16) * 17 + 1 + (q % 16) : q;
        u.A = A + (size_t)u.pm * sa; u.B = B + (size_t)u.pn * sb; u.nt = nt; u.aux = 0; return true; }
};
struct MapQKV {
    const char* QKVA; const char* QB; const char* KVB;
    __device__ __forceinline__ bool operator()(int L, GUnit& u) const { if (L >= NPAN * 14) return false; int pn; pg8::tile_order(L, NPAN, 14, u.pm, pn);
        const char* ap = QKVA + (size_t)u.pm * 256 * 768 * 2;
        if (pn < 6) { u.A = ap; u.B = QB + (size_t)pn * 256 * 384 * 2; u.nt = 6; u.pn = pn; u.aux = 0; }
        else { u.A = ap + 384 * 2; u.B = KVB + (size_t)(pn - 6) * 256 * 384 * 2; u.nt = 4; u.pn = pn - 6; u.aux = 1; }
        return true; }
};
struct MapRw1 {
    static constexpr bool KCAT = false;
    const char* AX; const char* B1; const char* B2; const char* L1; int G;
    __device__ __forceinline__ void fill(GUnit& u, int pn) const {
        const char* ap = AX + (size_t)u.pm * 256 * 5120 * 2;
        if (pn < 2) { u.A = ap; u.B = L1 + (size_t)pn * 256 * LDB1 * 2; u.nt = 32; u.pn = pn; u.aux = 0; }
        else if (pn < 6) { u.A = ap + 2048 * 2; u.B = B1 + (size_t)(pn - 2) * 256 * LDB1 * 2; u.nt = 16; u.pn = pn - 2; u.aux = 1; }
        else if (pn < 10) { u.A = ap + 3072 * 2; u.B = B1 + (size_t)(pn - 6) * 256 * LDB1 * 2 + 1024 * 2; u.nt = 16; u.pn = pn - 6; u.aux = 2; }
        else { u.A = ap + 4096 * 2; u.B = B2 + (size_t)(pn - 10) * 256 * LDB1 * 2; u.nt = 16; u.pn = pn - 10; u.aux = 3; } }
    __device__ __forceinline__ bool operator()(int L, GUnit& u) const {
        int pn;
        if (G != 256) { if (L >= NPAN * 14) return false; pg8::tile_order(L, NPAN, 14, u.pm, pn); fill(u, pn); return true; }
        const int c = L & 255, i = L >> 8, nl = (c < 16) ? 2 : 1;
        if (i < nl) { pg8::tile_order(c + i * 256, NPAN, 2, u.pm, pn); fill(u, pn); return true; }
        const int k = i - nl; int Ln;
        if (c >= 16) { const int v = c - 16; if (k < 6) Ln = v + k * 240; else if (k == 6 && v < 112) Ln = 1440 + v; else return false; }
        else { if (k < 5) Ln = 1552 + c * 5 + k; else return false; }
        pg8::tile_order(Ln, NPAN, 12, u.pm, pn); fill(u, pn + 2); return true; }
};
struct MapRw2 {
    const char* L1; const char* L2A; const char* L2B; int pn0, nN, nt;
    __device__ __forceinline__ bool operator()(int L, GUnit& u) const { if (L >= NPAN * nN) return false; int pn; pg8::tile_order(L, NPAN, nN, u.pm, pn); pn += pn0;
        const char* ap = L1 + (size_t)u.pm * 256 * 512 * 2; u.nt = nt; u.pn = pn & 3; u.aux = pn >> 2;
        if (pn < 16) { const int koff = (pn < 8) ? 0 : 128 * 2;
            u.A = ap + koff; u.B = L2A + (size_t)pn * 256 * 256 * 2 + koff; u.nt = nt >> 1; }
        else { u.A = ap + 256 * 2; u.B = L2B + (size_t)(pn - 16) * 256 * 256 * 2; if (pn >= 20) u.nt = nt >> 1; }
        return true; }
};
struct MapMoe {
    const char* A; const char* B; size_t sa, sbe, sb; int nN, nt; const int* base;
    __device__ __forceinline__ bool operator()(int L, GUnit& u) const { const int nM = base[8] >> 8; if (L >= nM * nN) return false; pg8::tile_order(L, nM, nN, u.pm, u.pn);
        int e = 0;
#pragma unroll
        for (int j = 1; j < 8; ++j) e += (u.pm * 256 >= base[j]) ? 1 : 0;
        u.A = A + (size_t)u.pm * sa; u.B = B + (size_t)e * sbe + (size_t)u.pn * sb; u.nt = nt; u.aux = e; return true; }
};

struct MoeSplit { int nMf, nT, S; };
__device__ __forceinline__ MoeSplit moe_split(int total_slots) { const int nM = total_slots >> 8; MoeSplit s; s.nMf = (nM >> 6) << 6; s.nT = nM - s.nMf; int S = s.nT > 0 ? 64 / s.nT : 1; S = S > 8 ? 8 : S; s.S = S < 1 ? 1 : S; return s; }
constexpr int XP0 = (int)((A_WM13 - A_Y2) / ((size_t)256 * 1024 * 2));
static_assert((A_WM13 - A_Y2) % ((size_t)256 * 1024 * 2) == 0, "partial-tile panels are addressed relative to Y2");
struct MapMoeDown {
    const char* A; const char* B; size_t sa, sbe, sb; const int* base;
    __device__ __forceinline__ bool operator()(int L, GUnit& u) const { const MoeSplit sp = moe_split(base[8]); const int nfull = sp.nMf * 4;
        int k0 = 0, nt = 56, opan;
        if (L < nfull) { pg8::tile_order(L, sp.nMf, 4, u.pm, u.pn); opan = u.pm; }
        else { const int i = L - nfull, ntu = sp.nT * 4; if (i >= ntu * sp.S) return false;
            const int sl = i / ntu, t = i - sl * ntu; pg8::tile_order(t, sp.nT, 4, u.pm, u.pn); u.pm += sp.nMf;
            const int q = 28 / sp.S, r = 28 - q * sp.S, p0 = sl * q + (sl < r ? sl : r), np = q + (sl < r ? 1 : 0); k0 = p0 * 2; nt = np * 2;
            opan = sl == 0 ? u.pm : XP0 + (sl - 1) * sp.nT + (u.pm - sp.nMf); }
        int e = 0;
#pragma unroll
        for (int j = 1; j < 8; ++j) e += (u.pm * 256 >= base[j]) ? 1 : 0;
        u.A = A + (size_t)u.pm * sa + (size_t)k0 * 128; u.B = B + (size_t)e * sbe + (size_t)u.pn * sb + (size_t)k0 * 128; u.nt = nt; u.aux = opan; return true; }
};
struct FPlainAux { bf16_t* O; int ldc;
    __device__ __forceinline__ void operator()(f32x4 v0, f32x4 v1, const GUnit& u, int trow, int tcol) const { st8(O + (size_t)(u.aux * 256 + trow) * ldc + u.pn * 256 + tcol, v0, v1); } };

struct Job { const float* src; const float* kscale; bf16_t* dst; int sld, srcK, srcN, ldd, Nd, Kd, koff, grp, gstride, tn, tile0, pad; };
constexpr int MAXJOB = 96;
#define NOGRP (1 << 30)
struct JobList { LAS Job* jobs; int n, tiles, z; };
__device__ __forceinline__ void addjob(JobList& L, const float* src, int sld, int srcK, int srcN, const float* kscale, bf16_t* dst, int ldd, int Nd, int Kd, int koff, int grp, int gstride) {
    LAS Job* j = L.jobs + L.n; j->src = src; j->kscale = kscale; j->dst = dst; j->sld = sld + L.z; j->srcK = srcK + L.z; j->srcN = srcN + L.z; j->ldd = ldd + L.z; j->Nd = Nd + L.z; j->Kd = Kd + L.z; j->koff = koff + L.z; j->grp = grp + L.z; j->gstride = gstride + L.z;
    const int tn = ((Nd + 63) >> 6) + L.z; j->tn = tn; j->tile0 = L.tiles; L.tiles += tn * (Kd >> 6); L.n += 1;
}
__device__ __forceinline__ bf16_t* wmla(const Args& a, int j) { return (bf16_t*)(a.ws + WS_WMLA) + (size_t)j * E_MLA; }
__device__ __forceinline__ bf16_t* wrwkv(const Args& a, int j) { return (bf16_t*)(a.ws + WS_WRWKV) + (size_t)j * E_RWKV; }
__device__ __forceinline__ bf16_t* wffn(const Args& a, int j) { return (bf16_t*)(a.ws + WS_WFFN) + (size_t)j * E_FFN; }
__device__ __forceinline__ void jobs_small(const Args& a, JobList& L) {
#pragma unroll 1
    for (int j = 0; j < 2; ++j) {
        {
            bf16_t* w = wmla(a, j); bf16_t* qkva = w; bf16_t* qb = w + E_QKVA; bf16_t* kvb = qb + E_QB; bf16_t* wo = kvb + E_KVB;
            addjob(L, a.in[I_WQA] + (size_t)j * D * QL, QL, D, QL, nullptr, qkva, 1024, 384, 1024, 0, NOGRP, 0);
            addjob(L, a.in[I_WKVA] + (size_t)j * D * 320, 320, D, 320, nullptr, qkva + (size_t)384 * 1024, 1024, 384, 1024, 0, NOGRP, 0);
            addjob(L, a.in[I_WQB] + (size_t)j * QL * 1536, 1536, QL, 1536, a.in[I_QAN] + j * QL, qb, 384, 1536, 384, 0, NOGRP, 0);
            addjob(L, a.in[I_WKVB] + (size_t)j * KVL * 2048, 2048, KVL, 2048, a.in[I_KVAN] + j * KVL, kvb, 384, 2048, 256, 0, NOGRP, 0);
            addjob(L, a.in[I_MWO] + (size_t)j * D * D, D, D, D, nullptr, wo, 1024, 1024, 1024, 0, NOGRP, 0);
        }
        {
            bf16_t* w = wrwkv(a, j); bf16_t* b1 = w; bf16_t* b2 = b1 + E_B1; bf16_t* l1 = b2 + E_B2; bf16_t* l2a = l1 + E_L1; bf16_t* l2b = l2a + E_L2A;
            const float* mix = a.in[I_MIX] + (size_t)j * 6 * D;
            addjob(L, a.in[I_WR] + (size_t)j * D * D, D, D, D, nullptr, b1, LDB1, 1024, 1024, 0, NOGRP, 0);
            addjob(L, a.in[I_WK] + (size_t)j * D * D, D, D, D, nullptr, b1 + 1024, LDB1, 1024, 1024, 0, NOGRP, 0);
            addjob(L, a.in[I_WV] + (size_t)j * D * D, D, D, D, nullptr, b2, LDB1, 1024, 1024, 0, NOGRP, 0);
            addjob(L, a.in[I_RWO] + (size_t)j * D * D, D, D, D, nullptr, b2 + E_B2 + E_L1 + E_L2A + E_L2B, 1024, 1024, 1024, 0, NOGRP, 0);
            for (int d = 0; d < 2; ++d) {
                const float* w1 = a.in[I_W1] + (size_t)(j * 2 + d) * D * 64; const float* a1 = a.in[I_A1] + (size_t)(j * 2 + d) * D * 64;
                addjob(L, w1, 64, D, 64, nullptr, l1 + (size_t)(d * 64) * LDB1, LDB1, 64, 1024, 0, NOGRP, 0);
                addjob(L, w1, 64, D, 64, mix + 1 * D, l1 + (size_t)(d * 64) * LDB1 + 1024, LDB1, 64, 1024, 0, NOGRP, 0);
                addjob(L, a1, 64, D, 64, nullptr, l1 + (size_t)(128 + d * 64) * LDB1, LDB1, 64, 1024, 0, NOGRP, 0);
                addjob(L, a1, 64, D, 64, mix + 4 * D, l1 + (size_t)(128 + d * 64) * LDB1 + 1024, LDB1, 64, 1024, 0, NOGRP, 0);
            }
            const float* v1 = (j == 1) ? a.in[I_V1] : nullptr;
            addjob(L, v1, 32, D, 32, nullptr, l1 + (size_t)256 * LDB1, LDB1, 64, 1024, 0, NOGRP, 0);
            addjob(L, v1, 32, D, 32, mix + 3 * D, l1 + (size_t)256 * LDB1 + 1024, LDB1, 64, 1024, 0, NOGRP, 0);
            addjob(L, a.in[I_G1] + (size_t)j * D * 160, 160, D, 160, nullptr, l1 + (size_t)320 * LDB1, LDB1, 192, 1024, 0, NOGRP, 0);
            addjob(L, a.in[I_G1] + (size_t)j * D * 160, 160, D, 160, mix + 5 * D, l1 + (size_t)320 * LDB1 + 1024, LDB1, 192, 1024, 0, NOGRP, 0);
            for (int d = 0; d < 2; ++d) {
                addjob(L, a.in[I_W2] + (size_t)(j * 2 + d) * 64 * D, D, 64, D, nullptr, l2a + (size_t)(d * 1024) * 256, 256, 1024, 256, d * 64, NOGRP, 0);
                addjob(L, a.in[I_A2] + (size_t)(j * 2 + d) * 64 * D, D, 64, D, nullptr, l2a + (size_t)(2048 + d * 1024) * 256, 256, 1024, 256, 128 + d * 64, NOGRP, 0);
            }
            addjob(L, a.in[I_G2] + (size_t)j * 160 * D, D, 160, D, nullptr, l2b, 256, 1024, 256, 64, NOGRP, 0);
            addjob(L, (j == 1) ? a.in[I_V2] : nullptr, D, 32, D, nullptr, l2b + (size_t)1024 * 256, 256, 1024, 256, 0, NOGRP, 0);
        }
        {
            bf16_t* w = wffn(a, j);
            addjob(L, a.in[I_F1] + (size_t)j * D * DFF, DFF, D, DFF, nullptr, w, 1024, DFF, 1024, 0, 128, 256);
            addjob(L, a.in[I_F3] + (size_t)j * D * DFF, DFF, D, DFF, nullptr, w + (size_t)128 * 1024, 1024, DFF, 1024, 0, 128, 256);
            addjob(L, a.in[I_F2] + (size_t)j * DFF * D, D, DFF, D, nullptr, w + E_F13, DFF, 1024, DFF, 0, NOGRP, 0);
        }
    }
}
__device__ __forceinline__ void jobs_moe(const Args& a, JobList& L, int k) {
    bf16_t* w13 = (bf16_t*)(a.ws + WS_ARENA + A_WM13); bf16_t* w2 = (bf16_t*)(a.ws + WS_ARENA + A_WM2);
#pragma unroll 1
    for (int e = 0; e < NE; ++e) {
        const size_t so = (size_t)(k * NE + e) * D * DFE;
        addjob(L, a.in[I_M1] + so, DFE, D, DFE, nullptr, w13 + (size_t)e * E_M13, 1024, DFE, 1024, 0, 128, 256);
        addjob(L, a.in[I_M3] + so, DFE, D, DFE, nullptr, w13 + (size_t)e * E_M13 + (size_t)128 * 1024, 1024, DFE, 1024, 0, 128, 256);
        addjob(L, a.in[I_M2] + so, D, DFE, D, nullptr, w2 + (size_t)e * E_M2, DFE, 1024, DFE, 0, NOGRP, 0);
    }
}
__device__ __forceinline__ void run_prep(const Args& a, LAS unsigned char* jl, int which  , int j0  , int G, int c) {
    const int tid = ltid();
    LAS Job* jobs = (LAS Job*)jl; LAS int* hdr = (LAS int*)(jl + MAXJOB * sizeof(Job)); LAS float* tile = (LAS float*)(jl + MAXJOB * sizeof(Job) + 64);
    if (tid == 0) { JobList L{jobs, 0, 0, launder_s(0)}; if (which < 0) jobs_small(a, L); else jobs_moe(a, L, which); hdr[0] = L.n + L.z; hdr[1] = L.tiles + L.z; }
    __syncthreads();
    const int nj = hdr[0], ntile = hdr[1];
    const int kl = tid >> 4, nq = (tid & 15) * 4, sn = tid >> 3, sk = (tid & 7) * 8;
    int jcur = 0;
#define PREP_BAR() do { asm volatile("s_waitcnt lgkmcnt(0)" ::: "memory"); __builtin_amdgcn_s_barrier(); asm volatile("" ::: "memory"); } while (0)
    f32x4 vcur[2], vnxt[2];
#define PREP_FETCH(t_, dstv) do { while (jcur + 1 < nj && jobs[jcur + 1].tile0 <= (t_)) ++jcur; const LAS Job* J_ = jobs + jcur; \
        const float* src_ = J_->src; const float* ks_ = J_->kscale; const int sld_ = J_->sld, srcK_ = J_->srcK, srcN_ = J_->srcN, koff_ = J_->koff, tn_ = J_->tn, tl_ = (t_) - J_->tile0; \
        const int n0_ = (tl_ % tn_) * 64, k0_ = (tl_ / tn_) * 64; \
        _Pragma("unroll") for (int p = 0; p < 2; ++p) { const int kk = k0_ + kl + 32 * p, ksi = kk - koff_, n = n0_ + nq; f32x4 v = (f32x4){0.f, 0.f, 0.f, 0.f}; \
            if (src_ != nullptr && ksi >= 0 && ksi < srcK_ && n < srcN_) { v = *(const __attribute__((address_space(1))) f32x4*)(src_ + (size_t)ksi * sld_ + n); if (ks_) v = v * *(const __attribute__((address_space(1))) float*)(ks_ + ksi); } dstv[p] = v; } } while (0)
    int t = c + j0 * G;
    if (t < ntile) PREP_FETCH(t, vcur);
    for (; t < ntile; t += G) {
        const int jthis = jcur;
        if (t + G < ntile) PREP_FETCH(t + G, vnxt);
        const LAS Job* J = jobs + jthis;
        bf16_t* __restrict__ dst = J->dst;
        const int ldd = J->ldd, Nd = J->Nd, grp = J->grp, gstride = J->gstride, tn = J->tn, tl = t - J->tile0;
        const int n0 = (tl % tn) * 64, k0 = (tl / tn) * 64;
#pragma unroll
        for (int p = 0; p < 2; ++p) { LAS float* tp = tile + (kl + 32 * p) * 65 + nq; tp[0] = vcur[p][0]; tp[1] = vcur[p][1]; tp[2] = vcur[p][2]; tp[3] = vcur[p][3]; }
        PREP_BAR();
        { const int n = n0 + sn;
            if (n < Nd) { float f[8];
#pragma unroll
                for (int e = 0; e < 8; ++e) f[e] = tile[(sk + e) * 65 + sn];
                const int dr = (n / grp) * gstride + (n % grp);
                *(__attribute__((address_space(1))) u32x4*)(dst + (size_t)dr * ldd + k0 + sk) = pack8(f); } }
        PREP_BAR();
        vcur[0] = vnxt[0]; vcur[1] = vnxt[1];
    }
#undef PREP_FETCH
#undef PREP_BAR
    asm volatile("s_waitcnt vmcnt(0)" ::: "memory"); __syncthreads();
}

__device__ __forceinline__ void prologue_misc(const Args& a, LAS unsigned char* lds, int G, int c) {
    const int tid = ltid();
    if (c == 0) { float* rt = (float*)(a.ws + WS_ROPE);
      for (int i = tid; i < 1024; i += NTHR) { const int pos = i >> 4, j = i & 15; const double inv = 1.0 / pow(10000.0, (double)j / 16.0), ang = (double)pos * inv; rt[i] = (float)cos(ang); rt[1024 + i] = (float)sin(ang); } }
    LAS float* sc = (LAS float*)lds;
    LAS float* red = (LAS float*)(lds + 49152);
    for (int i = tid; i < 1024 * 12; i += NTHR) { const int k = i / 12, m = i % 12; float v = 0.f;
        if (m < 9) { const float x = (m < 8) ? a.in[I_C][m * D + k] : a.in[I_CCTX][k]; v = x / (1.0f + expf(-x)); } sc[i] = v; }
    __syncthreads();
    const int kq = tid >> 6, col = tid & 63;
    for (int u = c; u < 4 * 96; u += G) {
        const int layer = u / 96, n0 = (u % 96) * 64;
        const float* w = a.in[I_ADAW] + (size_t)layer * D * 6144 + n0 + col;
        float acc[9];
#pragma unroll
        for (int m = 0; m < 9; ++m) acc[m] = 0.f;
        for (int k8 = 0; k8 < 128; k8 += 8) {
            float wv[8];
#pragma unroll
            for (int e = 0; e < 8; ++e) wv[e] = w[(size_t)(kq * 128 + k8 + e) * 6144];
#pragma unroll
            for (int e = 0; e < 8; ++e) { const LAS f32x4* sp = (const LAS f32x4*)(sc + (kq * 128 + k8 + e) * 12); const f32x4 s0 = sp[0], s1 = sp[1], s2 = sp[2];
                acc[0] += s0[0] * wv[e]; acc[1] += s0[1] * wv[e]; acc[2] += s0[2] * wv[e]; acc[3] += s0[3] * wv[e];
                acc[4] += s1[0] * wv[e]; acc[5] += s1[1] * wv[e]; acc[6] += s1[2] * wv[e]; acc[7] += s1[3] * wv[e]; acc[8] += s2[0] * wv[e]; }
        }
#pragma unroll
        for (int m = 0; m < 9; ++m) red[(kq * 9 + m) * 64 + col] = acc[m];
        __syncthreads();
        for (int i = tid; i < 9 * 64; i += NTHR) { const int m = i >> 6, cc = i & 63; float s = 0.f;
#pragma unroll
            for (int q = 0; q < 8; ++q) s += red[(q * 9 + m) * 64 + cc];
            ((float*)(a.ws + WS_MODS))[(size_t)(layer * 9 + m) * 6144 + n0 + cc] = s + a.in[I_ADAB][layer * 6144 + n0 + cc]; }
        __syncthreads();
    }
}

struct RowParams { float A[16], Bv[16]; int mi; };
__device__ __forceinline__ void load_params(const Args& a, RowParams& P, int layer, int mi, const float* gain, int which, int lane) {
    const float* sh = mods_ptr(a, layer, mi, which); const float* scl = mods_ptr(a, layer, mi, which + 1);
#pragma unroll
    for (int j = 0; j < 2; ++j) { const int col = j * 512 + lane * 8;
#pragma unroll
        for (int q = 0; q < 2; ++q) { const f32x4 g = *(const f32x4*)(gain + col + 4 * q), s = *(const f32x4*)(scl + col + 4 * q), t = *(const f32x4*)(sh + col + 4 * q);
#pragma unroll
            for (int e = 0; e < 4; ++e) { P.A[j * 8 + q * 4 + e] = g[e] * (1.0f + s[e]); P.Bv[j * 8 + q * 4 + e] = t[e]; } } }
    P.mi = mi;
}
__device__ __forceinline__ void load_x16(const float* xp, int lane, float (&x)[16]) {
#pragma unroll
    for (int j = 0; j < 2; ++j)
#pragma unroll
        for (int q = 0; q < 2; ++q) { const f32x4 v = *(const f32x4*)(xp + j * 512 + lane * 8 + 4 * q); x[j * 8 + q * 4 + 0] = v[0]; x[j * 8 + q * 4 + 1] = v[1]; x[j * 8 + q * 4 + 2] = v[2]; x[j * 8 + q * 4 + 3] = v[3]; }
}
__device__ __forceinline__ void store_bf16_row(bf16_t* p, int lane, const float (&h)[16]) {
#pragma unroll
    for (int j = 0; j < 2; ++j) { u32x4 w; w.x = cvt_pk_bf16(h[j * 8 + 0], h[j * 8 + 1]); w.y = cvt_pk_bf16(h[j * 8 + 2], h[j * 8 + 3]); w.z = cvt_pk_bf16(h[j * 8 + 4], h[j * 8 + 5]); w.w = cvt_pk_bf16(h[j * 8 + 6], h[j * 8 + 7]);
        *(u32x4*)(p + j * 512 + lane * 8) = w; }
}
__device__ __forceinline__ void moe_combine16(const Args& a, int row, int layer_prev, int lane, float (&x)[16]) {
    const u32x4 rt = *(const u32x4*)(a.ws + WS_ROUTE + (size_t)row * 16);
    const int e0 = (int)rt[0];
    if (e0 < 0) return;
    const float p0 = __uint_as_float(rt[2]), p1 = __uint_as_float(rt[3]);
    const int* sl = (const int*)(a.ws + WS_RSLOT) + (size_t)row * 2; const int s0 = sl[0], s1 = sl[1];
    const bf16_t* y2 = (const bf16_t*)(a.ws + WS_ARENA + A_Y2);
    const float* g5 = mods_ptr(a, layer_prev, mod_index(row), 5);
    const MoeSplit sp = moe_split(((const int*)(a.ws + WS_META))[8]);
    const int x0 = (s0 >> 8) >= sp.nMf ? sp.S : 1, x1 = (s1 >> 8) >= sp.nMf ? sp.S : 1;
    const size_t o0 = ((size_t)(XP0 + (s0 >> 8) - sp.nMf) * 256 + (s0 & 255)) * 1024, o1 = ((size_t)(XP0 + (s1 >> 8) - sp.nMf) * 256 + (s1 & 255)) * 1024, ostep = (size_t)sp.nT * 256 * 1024;
#pragma unroll
    for (int j = 0; j < 2; ++j) { const int col = j * 512 + lane * 8; float ya[8], yb[8];
        unpack8(*(const u32x4*)(y2 + (size_t)s0 * 1024 + col), ya); unpack8(*(const u32x4*)(y2 + (size_t)s1 * 1024 + col), yb);
        for (int sl = 1; sl < x0; ++sl) { float t[8]; unpack8(*(const u32x4*)(y2 + o0 + (size_t)(sl - 1) * ostep + col), t);
#pragma unroll
            for (int e = 0; e < 8; ++e) ya[e] += t[e]; }
        for (int sl = 1; sl < x1; ++sl) { float t[8]; unpack8(*(const u32x4*)(y2 + o1 + (size_t)(sl - 1) * ostep + col), t);
#pragma unroll
            for (int e = 0; e < 8; ++e) yb[e] += t[e]; }
        const f32x4 g0 = *(const f32x4*)(g5 + col), g1 = *(const f32x4*)(g5 + col + 4);
#pragma unroll
        for (int e = 0; e < 8; ++e) x[j * 8 + e] += (e < 4 ? g0[e] : g1[e - 4]) * (p0 * ya[e] + p1 * yb[e]); }
}
__device__ __forceinline__ void store_x16(float* xp, int lane, const float (&x)[16]) {
#pragma unroll
    for (int j = 0; j < 2; ++j)
#pragma unroll
        for (int q = 0; q < 2; ++q) *(f32x4*)(xp + j * 512 + lane * 8 + 4 * q) = (f32x4){x[j * 8 + q * 4], x[j * 8 + q * 4 + 1], x[j * 8 + q * 4 + 2], x[j * 8 + q * 4 + 3]};
}
__device__ __forceinline__ void norm_row(const float (&x)[16], const RowParams& P, float (&h)[16]) {
    float ss = 0.f;
#pragma unroll
    for (int e = 0; e < 16; ++e) ss += x[e] * x[e];
    ss = wave_sum_dpp(ss);
    const float rstd = __builtin_amdgcn_rsqf(ss * (1.0f / 1024.0f) + NORM_EPS);
#pragma unroll
    for (int e = 0; e < 16; ++e) h[e] = x[e] * rstd * P.A[e] + P.Bv[e];
}
__device__ __forceinline__ void wave_rows(int G, int c, int& r0, int& r1) {
    const int nw = G * NWAVE, per = (R + nw - 1) / nw, gw = c * NWAVE + (ltid() >> 6);
    r0 = gw * per; r1 = r0 + per; if (r0 > R) r0 = R; if (r1 > R) r1 = R;
}
template <bool COMBINE, bool FIRST = false>
__device__ __forceinline__ void norm_plain(const Args& a, int layer, const float* gain, int which, bf16_t* Hout, int G, int c) {
    const int lane = ltid() & 63; int r0, r1; wave_rows(G, c, r0, r1);
    RowParams P; P.mi = -1;
    for (int row = r0; row < r1; ++row) {
        const int mi = mod_index(row); if (mi != P.mi) load_params(a, P, layer, mi, gain, which, lane);
        float* xp = xrow(a, row); float x[16], h[16]; load_x16(FIRST ? xrow_in(a, row) : xp, lane, x);
        if (COMBINE) { moe_combine16(a, row, layer - 1, lane, x); store_x16(xp, lane, x); }
        norm_row(x, P, h); store_bf16_row(Hout + (size_t)row * 1024, lane, h);
    }
}
struct CMeta { u32x4 rt; int s0, s1; };
struct CData { f32x4 x[4]; u32x4 y[4]; };
__device__ __forceinline__ void cm_load(const Args& a, int row, CMeta& m) {
    m.rt = *(const u32x4*)(a.ws + WS_ROUTE + (size_t)row * 16);
    const int* sl = (const int*)(a.ws + WS_RSLOT) + (size_t)row * 2; m.s0 = sl[0]; m.s1 = sl[1];
}
__device__ __forceinline__ void cd_load(const Args& a, int row, const CMeta& m, int lane, CData& d) {
    const float* xp = xrow(a, row);
#pragma unroll
    for (int j = 0; j < 2; ++j)
#pragma unroll
        for (int q = 0; q < 2; ++q) d.x[j * 2 + q] = *(const f32x4*)(xp + j * 512 + lane * 8 + 4 * q);
    if ((int)m.rt[0] >= 0) { const bf16_t* y2 = (const bf16_t*)(a.ws + WS_ARENA + A_Y2);
#pragma unroll
        for (int j = 0; j < 2; ++j) { d.y[j * 2] = *(const u32x4*)(y2 + (size_t)m.s0 * 1024 + j * 512 + lane * 8); d.y[j * 2 + 1] = *(const u32x4*)(y2 + (size_t)m.s1 * 1024 + j * 512 + lane * 8); } }
}
template <bool NORM>
__device__ __forceinline__ void combine_rows(const Args& a, int layer_prev, int layer, const float* gain, int which, bf16_t* Hout, int G, int c) {
    const int lane = ltid() & 63; int r0, r1; wave_rows(G, c, r0, r1); if (r0 >= r1) return;
    const bf16_t* y2 = (const bf16_t*)(a.ws + WS_ARENA + A_Y2);
    const MoeSplit sp = moe_split(((const int*)(a.ws + WS_META))[8]);
    const size_t ostep = (size_t)sp.nT * 256 * 1024;
    RowParams P; P.mi = -1; float g5[16]; int gmi = -1;
    CMeta m0, m1, m2; CData d0, dn;
    cm_load(a, r0, m0); m1 = m0; if (r0 + 1 < r1) cm_load(a, r0 + 1, m1);
    cd_load(a, r0, m0, lane, d0);
    for (int row = r0; row < r1; ++row) {
        m2 = m1; if (row + 2 < r1) cm_load(a, row + 2, m2);
        dn = d0; if (row + 1 < r1) cd_load(a, row + 1, m1, lane, dn);
        const int mi = mod_index(row);
        if (mi != gmi) { const float* gp = mods_ptr(a, layer_prev, mi, 5); gmi = mi;
#pragma unroll
            for (int j = 0; j < 2; ++j)
#pragma unroll
                for (int q = 0; q < 2; ++q) { const f32x4 v = *(const f32x4*)(gp + j * 512 + lane * 8 + 4 * q); g5[j * 8 + q * 4] = v[0]; g5[j * 8 + q * 4 + 1] = v[1]; g5[j * 8 + q * 4 + 2] = v[2]; g5[j * 8 + q * 4 + 3] = v[3]; } }
        float x[16];
#pragma unroll
        for (int i = 0; i < 4; ++i) { x[i * 4] = d0.x[i][0]; x[i * 4 + 1] = d0.x[i][1]; x[i * 4 + 2] = d0.x[i][2]; x[i * 4 + 3] = d0.x[i][3]; }
        const bool routed = (int)m0.rt[0] >= 0;
        if (routed) { const float p0 = __uint_as_float(m0.rt[2]), p1 = __uint_as_float(m0.rt[3]); const int s0 = m0.s0, s1 = m0.s1;
            const int x0 = (s0 >> 8) >= sp.nMf ? sp.S : 1, x1 = (s1 >> 8) >= sp.nMf ? sp.S : 1;
            const size_t o0 = ((size_t)(XP0 + (s0 >> 8) - sp.nMf) * 256 + (s0 & 255)) * 1024, o1 = ((size_t)(XP0 + (s1 >> 8) - sp.nMf) * 256 + (s1 & 255)) * 1024;
#pragma unroll
            for (int j = 0; j < 2; ++j) { const int col = j * 512 + lane * 8; float ya[8], yb[8]; unpack8(d0.y[j * 2], ya); unpack8(d0.y[j * 2 + 1], yb);
                for (int sl = 1; sl < x0; ++sl) { float t[8]; unpack8(*(const u32x4*)(y2 + o0 + (size_t)(sl - 1) * ostep + col), t);
#pragma unroll
                    for (int e = 0; e < 8; ++e) ya[e] += t[e]; }
                for (int sl = 1; sl < x1; ++sl) { float t[8]; unpack8(*(const u32x4*)(y2 + o1 + (size_t)(sl - 1) * ostep + col), t);
#pragma unroll
                    for (int e = 0; e < 8; ++e) yb[e] += t[e]; }
#pragma unroll
                for (int e = 0; e < 8; ++e) x[j * 8 + e] += g5[j * 8 + e] * (p0 * ya[e] + p1 * yb[e]); } }
        if (NORM || routed) store_x16(xrow(a, row), lane, x);
        if (NORM) { if (mi != P.mi) load_params(a, P, layer, mi, gain, which, lane); float h[16]; norm_row(x, P, h); store_bf16_row(Hout + (size_t)row * 1024, lane, h); }
        d0 = dn; m0 = m1; m1 = m2;
    }
}
__device__ __forceinline__ bool seg_first(int row) { const int r = row % SEG; return r == 0 || r == CTX; }
__device__ __forceinline__ bool seg_last(int row) { const int r = row % SEG; return r == CTX - 1 || r == SEG - 1; }
__device__ __forceinline__ void norm_mix(const Args& a, int layer, int j, int G, int c) {
    const int lane = ltid() & 63; int r0, r1; wave_rows(G, c, r0, r1); if (r0 >= r1) return;
    const float* gain = a.in[I_N1G] + layer * D; const float* mix = a.in[I_MIX] + (size_t)j * 6 * D;
    bf16_t* AX = (bf16_t*)(a.ws + WS_ARENA + A_AX);
    float mr[16], mk[16], mv[16];
#pragma unroll
    for (int jj = 0; jj < 2; ++jj)
#pragma unroll
        for (int e = 0; e < 8; ++e) { const int col = jj * 512 + lane * 8 + e; mr[jj * 8 + e] = mix[col]; mk[jj * 8 + e] = mix[2 * D + col]; mv[jj * 8 + e] = mix[3 * D + col]; }
    RowParams P; P.mi = -1;
    float hp[16], hc[16], hn[16], x[16];
    if (!seg_first(r0)) { const int mi = mod_index(r0 - 1); if (mi != P.mi) load_params(a, P, layer, mi, gain, 0, lane); load_x16(xrow(a, r0 - 1), lane, x); norm_row(x, P, hp); }
    else {
#pragma unroll
        for (int e = 0; e < 16; ++e) hp[e] = 0.f; }
    { const int mi = mod_index(r0); if (mi != P.mi) load_params(a, P, layer, mi, gain, 0, lane); load_x16(xrow(a, r0), lane, x); norm_row(x, P, hc); }
    if (r0 + 1 < R) load_x16(xrow(a, r0 + 1), lane, x);
    for (int row = r0; row < r1; ++row) {
        float xq[16];
        if (row + 2 < R && row + 1 < r1) load_x16(xrow(a, row + 2), lane, xq);
        if (row + 1 < R) { const int mi = mod_index(row + 1); if (mi != P.mi) load_params(a, P, layer, mi, gain, 0, lane); norm_row(x, P, hn); }
        else {
#pragma unroll
            for (int e = 0; e < 16; ++e) hn[e] = 0.f; }
#pragma unroll
        for (int e = 0; e < 16; ++e) x[e] = xq[e];
        const float fp = seg_first(row) ? 0.f : 0.5f, fn = seg_last(row) ? 0.f : 0.5f;
        float xx[16], t[16];
#pragma unroll
        for (int e = 0; e < 16; ++e) xx[e] = fp * hp[e] + fn * hn[e] - hc[e];
        bf16_t* o = AX + (size_t)row * 5120;
        store_bf16_row(o, lane, hc); store_bf16_row(o + 1024, lane, xx);
#pragma unroll
        for (int e = 0; e < 16; ++e) t[e] = hc[e] + xx[e] * mr[e];
        store_bf16_row(o + 2048, lane, t);
#pragma unroll
        for (int e = 0; e < 16; ++e) t[e] = hc[e] + xx[e] * mk[e];
        store_bf16_row(o + 3072, lane, t);
#pragma unroll
        for (int e = 0; e < 16; ++e) t[e] = hc[e] + xx[e] * mv[e];
        store_bf16_row(o + 4096, lane, t);
#pragma unroll
        for (int e = 0; e < 16; ++e) { hp[e] = hc[e]; hc[e] = hn[e]; }
    }
}
__device__ __forceinline__ void norm_router(const Args& a, int layer, int k, bool last, LAS unsigned char* lds, int G, int c) {
    const int tid = ltid(), lane = tid & 63; int r0, r1; wave_rows(G, c, r0, r1);
    LAS float* rw = (LAS float*)lds;
    { const float* rsrc = a.in[I_ROUTER] + (size_t)k * D * NE; for (int i = tid; i < D * NE; i += NTHR) rw[(i >> 6) * 68 + (i & 63)] = rsrc[i]; }
    __syncthreads();
    const float* gain = a.in[I_N2G] + layer * D;
    bf16_t* Hout = (bf16_t*)(a.ws + WS_ARENA + A_H);
    RowParams P; P.mi = -1;
    int hist[8];
#pragma unroll
    for (int e = 0; e < 8; ++e) hist[e] = 0;
    float xn[16];
    if (r0 < r1) load_x16(xrow(a, r0), lane, xn);
    for (int row = r0; row < r1; ++row) {
        const int mi = mod_index(row); if (mi != P.mi) load_params(a, P, layer, mi, gain, 3, lane);
        float x[16], h[16];
#pragma unroll
        for (int e = 0; e < 16; ++e) x[e] = xn[e];
        if (row + 1 < r1) load_x16(xrow(a, row + 1), lane, xn);
        { float ss = 0.f;
#pragma unroll
          for (int e = 0; e < 16; ++e) ss += x[e] * x[e];
          ss = wave_sum_dpp(ss);
          const float rstd = __builtin_amdgcn_rsqf(ss * (1.0f / 1024.0f) + NORM_EPS);
#pragma unroll
          for (int e = 0; e < 16; ++e) h[e] = x[e] * rstd * P.A[e] + P.Bv[e]; }
        store_bf16_row(Hout + (size_t)row * 1024, lane, h);
        const bool routed = !(last && mi == 8);
        float lg[8];
#pragma unroll
        for (int e = 0; e < 8; ++e) lg[e] = 0.f;
#pragma unroll
        for (int jj = 0; jj < 2; ++jj)
#pragma unroll
            for (int q = 0; q < 8; ++q) { const LAS f32x4* rp = (const LAS f32x4*)(rw + (jj * 64 + lane) * 68 + q * 8); const f32x4 w0 = rp[0], w1 = rp[1]; const float hv = h[jj * 8 + q];
                lg[0] += hv * w0[0]; lg[1] += hv * w0[1]; lg[2] += hv * w0[2]; lg[3] += hv * w0[3]; lg[4] += hv * w1[0]; lg[5] += hv * w1[1]; lg[6] += hv * w1[2]; lg[7] += hv * w1[3]; }
#pragma unroll
        for (int e = 0; e < 8; ++e) lg[e] = wave_sum_dpp(lg[e]);
        int e0 = 0; float v0 = lg[0];
#pragma unroll
        for (int e = 1; e < 8; ++e) if (lg[e] > v0) { v0 = lg[e]; e0 = e; }
        int e1 = -1; float v1 = -3.0e38f;
#pragma unroll
        for (int e = 0; e < 8; ++e) if (e != e0 && lg[e] > v1) { v1 = lg[e]; e1 = e; }
        const float p0 = __builtin_amdgcn_rcpf(1.0f + __expf(v1 - v0)), p1 = 1.0f - p0;
        if (routed) {
#pragma unroll
            for (int e = 0; e < 8; ++e) hist[e] += (e == e0 || e == e1) ? 1 : 0; }
        if (lane == 0) *(u32x4*)(a.ws + WS_ROUTE + (size_t)row * 16) = (u32x4){(unsigned)(routed ? e0 : -1), (unsigned)(routed ? e1 : -1), __float_as_uint(p0), __float_as_uint(p1)};
    }
    const int gw = c * NWAVE + (tid >> 6);
    if (lane == 0) { int* hp = (int*)(a.ws + WS_HIST) + (size_t)gw * 8;
#pragma unroll
        for (int e = 0; e < 8; ++e) hp[e] = hist[e]; }
}

__device__ __forceinline__ void mla_stats(const Args& a, int G, int c) {
    const int lane = ltid() & 63; int r0, r1; wave_rows(G, c, r0, r1);
    const bf16_t* QKVA = (const bf16_t*)(a.ws + WS_ARENA + A_QKVA); float* rs = (float*)(a.ws + WS_RS);
    for (int row = r0; row < r1; ++row) {
        float sq = 0.f, skv = 0.f; float f[8];
        if (lane < 48) { unpack8(*(const u32x4*)(QKVA + (size_t)row * 768 + lane * 8), f);
#pragma unroll
            for (int e = 0; e < 8; ++e) sq += f[e] * f[e]; }
        if (lane < 32) { unpack8(*(const u32x4*)(QKVA + (size_t)row * 768 + 384 + lane * 8), f);
#pragma unroll
            for (int e = 0; e < 8; ++e) skv += f[e] * f[e]; }
        sq = wave_sum_dpp(sq); skv = wave_sum_dpp(skv);
        if (lane == 0) { rs[row] = 1.0f / sqrtf(sq * (1.0f / 384.0f) + NORM_EPS); rs[R + row] = 1.0f / sqrtf(skv * (1.0f / 256.0f) + NORM_EPS); }
    }
}
__device__ __forceinline__ void mla_qkpost(const Args& a, int j, int G, int c) {
    const int lane = ltid() & 63, hd = lane >> 3, sub = lane & 7; int r0, r1; wave_rows(G, c, r0, r1);
    bf16_t* Q = (bf16_t*)(a.ws + WS_ARENA + A_Q); const bf16_t* KV = (const bf16_t*)(a.ws + WS_ARENA + A_KV); const bf16_t* QKVA = (const bf16_t*)(a.ws + WS_ARENA + A_QKVA);
    bf16_t* K = (bf16_t*)(a.ws + WS_ARENA + A_K); const float* rt = (const float*)(a.ws + WS_ROPE);
    float gq[3][8], gk[3][8];
#pragma unroll
    for (int cc = 0; cc < 3; ++cc)
#pragma unroll
        for (int e = 0; e < 8; ++e) { gq[cc][e] = a.in[I_QN][j * QKH + cc * 64 + sub * 8 + e]; gk[cc][e] = a.in[I_KN][j * QKH + cc * 64 + sub * 8 + e]; }
    const float sgn = (sub & 2) ? 1.0f : -1.0f;
    for (int row = r0; row < r1; ++row) {
        const int r = row % SEG; const bool lat = r >= CTX; const int t = r - CTX, pos = (sub & 4) ? (t & 63) : (t >> 6);
        float cs[8], sn[8];
        if (lat) {
#pragma unroll
            for (int q = 0; q < 2; ++q) { const f32x4 cv = *(const f32x4*)(rt + pos * 16 + (sub & 1) * 8 + 4 * q), sv = *(const f32x4*)(rt + 1024 + pos * 16 + (sub & 1) * 8 + 4 * q);
#pragma unroll
                for (int e = 0; e < 4; ++e) { cs[q * 4 + e] = cv[e]; sn[q * 4 + e] = sv[e]; } } }
        float v[3][8];
        bf16_t* qp = Q + (size_t)row * 1536 + hd * QKH + sub * 8;
#pragma unroll
        for (int cc = 0; cc < 3; ++cc) unpack8(*(const u32x4*)(qp + cc * 64), v[cc]);
        { float ss = 0.f;
#pragma unroll
          for (int cc = 0; cc < 3; ++cc)
#pragma unroll
              for (int e = 0; e < 8; ++e) ss += v[cc][e] * v[cc][e];
          ss = red8(ss); const float rstd = 1.0f / sqrtf(ss * (1.0f / 192.0f) + NORM_EPS);
#pragma unroll
          for (int cc = 0; cc < 3; ++cc)
#pragma unroll
              for (int e = 0; e < 8; ++e) v[cc][e] = v[cc][e] * rstd * gq[cc][e];
          if (lat) {
#pragma unroll
              for (int e = 0; e < 8; ++e) { const float pr = __shfl_xor(v[2][e], 2); v[2][e] = v[2][e] * cs[e] + sgn * pr * sn[e]; } }
#pragma unroll
          for (int cc = 0; cc < 3; ++cc) {
#pragma unroll
              for (int e = 0; e < 8; ++e) v[cc][e] *= QSCALE;
              *(u32x4*)(qp + cc * 64) = pack8(v[cc]); } }
        const bf16_t* kp = KV + (size_t)row * LDKV + hd * 256 + sub * 8;
        unpack8(*(const u32x4*)(kp), v[0]); unpack8(*(const u32x4*)(kp + 64), v[1]); unpack8(*(const u32x4*)(QKVA + (size_t)row * 768 + 640 + sub * 8), v[2]);
        { float ss = 0.f;
#pragma unroll
          for (int cc = 0; cc < 3; ++cc)
#pragma unroll
              for (int e = 0; e < 8; ++e) ss += v[cc][e] * v[cc][e];
          ss = red8(ss); const float rstd = 1.0f / sqrtf(ss * (1.0f / 192.0f) + NORM_EPS);
#pragma unroll
          for (int cc = 0; cc < 3; ++cc)
#pragma unroll
              for (int e = 0; e < 8; ++e) v[cc][e] = v[cc][e] * rstd * gk[cc][e];
          if (lat) {
#pragma unroll
              for (int e = 0; e < 8; ++e) { const float pr = __shfl_xor(v[2][e], 2); v[2][e] = v[2][e] * cs[e] + sgn * pr * sn[e]; } }
          bf16_t* ko = K + (size_t)row * 1536 + hd * QKH + sub * 8;
#pragma unroll
          for (int cc = 0; cc < 3; ++cc) *(u32x4*)(ko + cc * 64) = pack8(v[cc]); }
    }
}

namespace att {
constexpr int KVBLK = 64, KROWB = 384;
constexpr int SHM_V = KVBLK * 128 * 2, SHM_K = KVBLK * KROWB;
constexpr int SHM_ATTN = 2 * SHM_V + 2 * SHM_K + NWAVE * 64 * 4;
constexpr float THR = 11.5f;
#define KSWZ(row, colB) ((row) * att::KROWB + ((colB) ^ (((row) & 7) << 4)))
#define SBAR() __builtin_amdgcn_sched_barrier(0)
__device__ __forceinline__ int crow(int r, int hi) { return (r & 3) + 8 * (r >> 2) + 4 * hi; }
__device__ __forceinline__ void partialSM(f32x16& p0, f32x16& p1, float& m_reg, float& mn, float& alpha) {
    float pmax = p0[0];
#pragma unroll
    for (int r = 1; r < 16; ++r) pmax = fmaxf(pmax, p0[r]);
#pragma unroll
    for (int r = 0; r < 16; ++r) pmax = fmaxf(pmax, p1[r]);
    { auto rr = __builtin_amdgcn_permlane32_swap(__float_as_uint(pmax), __float_as_uint(pmax), false, false); pmax = fmaxf(__uint_as_float(rr[0]), __uint_as_float(rr[1])); }
    if (__builtin_expect(__all(pmax - m_reg <= THR), 1)) { mn = m_reg; alpha = 1.f; }
    else { mn = fmaxf(m_reg, pmax); alpha = __builtin_amdgcn_exp2f(m_reg - mn); m_reg = mn; }
#pragma unroll
    for (int r = 0; r < 16; ++r) { p0[r] -= mn; p1[r] -= mn; }
#pragma unroll
    for (int r = 0; r < 16; ++r) p0[r] = __builtin_amdgcn_exp2f(p0[r]);
}
__device__ __forceinline__ void finishSM(f32x16& p0, f32x16& p1, float alpha, float& l_reg, bf16x8& pa0, bf16x8& pa1, bf16x8& pa2, bf16x8& pa3) {
#pragma unroll
    for (int r = 0; r < 16; ++r) p1[r] = __builtin_amdgcn_exp2f(p1[r]);
    float ps = 0;
#pragma unroll
    for (int r = 0; r < 16; ++r) ps += p0[r];
#pragma unroll
    for (int r = 0; r < 16; ++r) ps += p1[r];
    { auto rr = __builtin_amdgcn_permlane32_swap(__float_as_uint(ps), __float_as_uint(ps), false, false); ps = __uint_as_float(rr[0]) + __uint_as_float(rr[1]); }
    l_reg = l_reg * alpha + ps;
#define PK4(P, BASE, OUT) do { unsigned a0 = cvt_pk_bf16(P[BASE + 0], P[BASE + 1]), a1 = cvt_pk_bf16(P[BASE + 2], P[BASE + 3]);   \
    unsigned b0 = cvt_pk_bf16(P[BASE + 4], P[BASE + 5]), b1 = cvt_pk_bf16(P[BASE + 6], P[BASE + 7]);                              \
    auto r0 = __builtin_amdgcn_permlane32_swap(a0, b0, false, false); auto r1 = __builtin_amdgcn_permlane32_swap(a1, b1, false, false); \
    u32x4 w = {r0[0], r1[0], r0[1], r1[1]}; OUT = *reinterpret_cast<bf16x8*>(&w); } while (0)
    PK4(p0, 0, pa0); PK4(p0, 8, pa1); PK4(p1, 0, pa2); PK4(p1, 8, pa3);
#undef PK4
}
__device__ __forceinline__ void qkt(f32x16& p0, f32x16& p1, const char* Ks, const bf16x8* qr, int r32, int hi) {
    p0 = f32x16{}; p1 = f32x16{};
    bf16x8 ka[4], kb[4];
#define QK_LD(buf, g) do { _Pragma("unroll") for (int q_ = 0; q_ < 2; ++q_) { const int cb_ = ((2 * (g) + q_) * 16 + hi * 8) * 2; \
        buf[2 * q_] = *reinterpret_cast<const bf16x8*>(Ks + KSWZ(r32, cb_)); buf[2 * q_ + 1] = *reinterpret_cast<const bf16x8*>(Ks + KSWZ(32 + r32, cb_)); } } while (0)
#define QK_MM(buf, g) do { _Pragma("unroll") for (int q_ = 0; q_ < 2; ++q_) { p0 = __builtin_amdgcn_mfma_f32_32x32x16_bf16(buf[2 * q_], qr[2 * (g) + q_], p0, 0, 0, 0); \
        p1 = __builtin_amdgcn_mfma_f32_32x32x16_bf16(buf[2 * q_ + 1], qr[2 * (g) + q_], p1, 0, 0, 0); } } while (0)
    QK_LD(ka, 0); SBAR();
    QK_LD(kb, 1); SBAR(); QK_MM(ka, 0); SBAR();
    QK_LD(ka, 2); SBAR(); QK_MM(kb, 1); SBAR();
    QK_LD(kb, 3); SBAR(); QK_MM(ka, 2); SBAR();
    QK_LD(ka, 4); SBAR(); QK_MM(kb, 3); SBAR();
    QK_LD(kb, 5); SBAR(); QK_MM(ka, 4); SBAR();
    QK_MM(kb, 5); SBAR();
#undef QK_LD
#undef QK_MM
}
__device__ __forceinline__ int v_st(int k, int c) { const int kk = (k & ~0xC) | ((k & 4) << 1) | ((k & 8) >> 1); return ((kk >> 3) * 4 + (c >> 5)) * 512 + ((kk & 7) * 32 + (c & 31)) * 2; }
__device__ __forceinline__ int v_rd_base(int lane) { return ((lane & 3) << 3) | (((lane >> 2) & 3) << 6) | (((lane >> 4) & 1) << 5) | (((lane >> 5) & 1) << 8); }
constexpr int v_rd_off(int d0, int ks, int half) { return d0 * 512 + ks * 4096 + half * 2048; }
template <int OFF> __device__ __forceinline__ s16x4 tr_read(int vb) { s16x4 r; asm volatile("ds_read_b64_tr_b16 %0, %1 offset:%2" : "=&v"(r) : "v"(vb), "i"(OFF) : "memory"); return r; }
struct VFrag { s16x4 l0, h0, l1, h1, l2, h2, l3, h3; };
template <int D0> __device__ __forceinline__ void pv_issue(VFrag& f, int vb) {
    f.l0 = tr_read<v_rd_off(D0, 0, 0)>(vb); f.h0 = tr_read<v_rd_off(D0, 0, 1)>(vb); f.l1 = tr_read<v_rd_off(D0, 1, 0)>(vb); f.h1 = tr_read<v_rd_off(D0, 1, 1)>(vb);
    f.l2 = tr_read<v_rd_off(D0, 2, 0)>(vb); f.h2 = tr_read<v_rd_off(D0, 2, 1)>(vb); f.l3 = tr_read<v_rd_off(D0, 3, 0)>(vb); f.h3 = tr_read<v_rd_off(D0, 3, 1)>(vb);
}
__device__ __forceinline__ void pv_mma(f32x16& od, const VFrag& f, bf16x8 pa0, bf16x8 pa1, bf16x8 pa2, bf16x8 pa3) {
#define PK(L, H) (bf16x8){L[0], L[1], L[2], L[3], H[0], H[1], H[2], H[3]}
    od = __builtin_amdgcn_mfma_f32_32x32x16_bf16(pa0, PK(f.l0, f.h0), od, 0, 0, 0);
    od = __builtin_amdgcn_mfma_f32_32x32x16_bf16(pa1, PK(f.l1, f.h1), od, 0, 0, 0);
    od = __builtin_amdgcn_mfma_f32_32x32x16_bf16(pa2, PK(f.l2, f.h2), od, 0, 0, 0);
    od = __builtin_amdgcn_mfma_f32_32x32x16_bf16(pa3, PK(f.l3, f.h3), od, 0, 0, 0);
#undef PK
}
__device__ __forceinline__ void pv_d0(f32x16* o, int vb, bf16x8 pa0, bf16x8 pa1, bf16x8 pa2, bf16x8 pa3) {
    VFrag fa, fb;
    pv_issue<0>(fa, vb); pv_issue<1>(fb, vb);
    asm volatile("s_waitcnt lgkmcnt(8)" ::: "memory"); SBAR(); pv_mma(o[0], fa, pa0, pa1, pa2, pa3); SBAR();
    pv_issue<2>(fa, vb);
    asm volatile("s_waitcnt lgkmcnt(8)" ::: "memory"); SBAR(); pv_mma(o[1], fb, pa0, pa1, pa2, pa3); SBAR();
    pv_issue<3>(fb, vb);
    asm volatile("s_waitcnt lgkmcnt(8)" ::: "memory"); SBAR(); pv_mma(o[2], fa, pa0, pa1, pa2, pa3); SBAR();
    asm volatile("s_waitcnt lgkmcnt(0)" ::: "memory"); SBAR(); pv_mma(o[3], fb, pa0, pa1, pa2, pa3);
}
__device__ __forceinline__ void attn_unit(const bf16_t* __restrict__ Qb, const bf16_t* __restrict__ Kh, const bf16_t* __restrict__ Vh, bf16_t* __restrict__ Ob, int seq, char* lds) {
    constexpr int LDQ = 1536, LDK = 1536, LDV = LDKV, LDO = 1024;
    const int tid = ltid(), wid = tid >> 6, lane = tid & 63, r32 = lane & 31, hi = lane >> 5;
    char* V_lds = lds; char* K_lds = lds + 2 * SHM_V;
    float* wsp = (float*)(lds + 2 * SHM_V + 2 * SHM_K) + wid * 64; float* li_l = wsp; float* al_l = wsp + 32;
    float m_reg = -1e30f, l_reg = 0; f32x16 o[4] = {}; bf16x8 qr[12];
    const bf16_t* Qw = Qb + (long)(wid * 32 + r32) * LDQ + hi * 8;
#pragma unroll
    for (int d0 = 0; d0 < 12; ++d0) qr[d0] = *(const __attribute__((address_space(1))) bf16x8*)((const __attribute__((address_space(1))) bf16_t*)Qw + d0 * 16);
    const int sr = tid >> 4, sc = (tid & 15) * 8, vst0 = v_st(sr, sc), vst1 = v_st(32 + sr, sc);
    int kkey[3], kcb[3];
#pragma unroll
    for (int i = 0; i < 3; ++i) { const int ci = tid + i * 512; kkey[i] = ci / 24; kcb[i] = (ci % 24) * 16; }
    const int vb0 = (int)(uintptr_t)(LAS char*)V_lds + v_rd_base(lane);
    bf16x8 vs0, vs1, ks0, ks1, ks2;
#define GAS __attribute__((address_space(1)))
#define SLOAD(k0) do { vs0 = *(const GAS bf16x8*)((const GAS bf16_t*)Vh + (long)((k0) + sr) * LDV + sc); vs1 = *(const GAS bf16x8*)((const GAS bf16_t*)Vh + (long)((k0) + 32 + sr) * LDV + sc); \
    ks0 = *(const GAS bf16x8*)((const GAS char*)Kh + (long)((k0) + kkey[0]) * (LDK * 2) + kcb[0]); ks1 = *(const GAS bf16x8*)((const GAS char*)Kh + (long)((k0) + kkey[1]) * (LDK * 2) + kcb[1]); \
    ks2 = *(const GAS bf16x8*)((const GAS char*)Kh + (long)((k0) + kkey[2]) * (LDK * 2) + kcb[2]); } while (0)
#define SWRITE(b) do { *(bf16x8*)(V_lds + (b) * SHM_V + vst0) = vs0; *(bf16x8*)(V_lds + (b) * SHM_V + vst1) = vs1; \
    *(bf16x8*)(K_lds + (b) * SHM_K + KSWZ(kkey[0], kcb[0])) = ks0; *(bf16x8*)(K_lds + (b) * SHM_K + KSWZ(kkey[1], kcb[1])) = ks1; *(bf16x8*)(K_lds + (b) * SHM_K + KSWZ(kkey[2], kcb[2])) = ks2; } while (0)
#define SWAIT() asm volatile("s_waitcnt vmcnt(0)" ::: "memory")
#define RESC(al) do { if (__any((al) < 1.f)) { if (hi == 0) al_l[r32] = (al); asm volatile("s_waitcnt lgkmcnt(0)" ::: "memory"); \
    _Pragma("unroll") for (int d = 0; d < 4; ++d) _Pragma("unroll") for (int r = 0; r < 16; ++r) o[d][r] *= al_l[crow(r, hi)]; } } while (0)
    f32x16 p0, p1; float mn, al; bf16x8 pa0, pa1, pa2, pa3; const int NT = seq / KVBLK;
    SLOAD(0); SWAIT(); SWRITE(0); __syncthreads();
    for (int j = 0; j < NT; ++j) {
        const int bsel = j & 1;
        if (j + 1 < NT) SLOAD((j + 1) * KVBLK);
        SBAR(); qkt(p0, p1, K_lds + bsel * SHM_K, qr, r32, hi);
        partialSM(p0, p1, m_reg, mn, al);
        RESC(al);
        finishSM(p0, p1, al, l_reg, pa0, pa1, pa2, pa3); SBAR();
        pv_d0(o, vb0 + bsel * SHM_V, pa0, pa1, pa2, pa3);
        if (j + 1 < NT) { SWAIT(); SWRITE(bsel ^ 1); }
        __syncthreads();
    }
    if (hi == 0) li_l[r32] = l_reg; asm volatile("s_waitcnt lgkmcnt(0)" ::: "memory");
    float rli[16];
#pragma unroll
    for (int r = 0; r < 16; ++r) rli[r] = __builtin_amdgcn_rcpf(li_l[crow(r, hi)]);
    bf16_t* Ow = Ob + (long)(wid * 32) * LDO;
#pragma unroll
    for (int r = 0; r < 16; ++r) { const int orow = crow(r, hi);
#pragma unroll
        for (int d0 = 0; d0 < 4; ++d0) { const float val = o[d0][r] * rli[r]; ((__attribute__((address_space(1))) bf16_t*)Ow)[(long)orow * LDO + d0 * 32 + r32] = (bf16_t)(cvt_pk_bf16(val, val) & 0xffffu); } }
    __syncthreads();
#undef SLOAD
#undef SWRITE
#undef SWAIT
#undef RESC
}
}
__device__ __forceinline__ void attn_phase(const Args& a, LAS unsigned char* lds, int G, int c) {
    const bf16_t* Q = (const bf16_t*)(a.ws + WS_ARENA + A_Q); const bf16_t* K = (const bf16_t*)(a.ws + WS_ARENA + A_K); const bf16_t* KV = (const bf16_t*)(a.ws + WS_ARENA + A_KV);
    bf16_t* O = (bf16_t*)(a.ws + WS_ARENA + A_O);
    const int vcu = (G % 8 == 0) ? (c % 8) * (G / 8) + c / 8 : c;
    for (int L = vcu; L < 1024 + 64; L += G) {
        int b, h, q0, seq;
        if (L < 1024) { b = L >> 7; h = (L >> 4) & 7; q0 = CTX + (L & 15) * 256; seq = SEG; } else { const int l2 = L - 1024; b = l2 >> 3; h = l2 & 7; q0 = 0; seq = CTX; }
        const size_t rb = (size_t)b * SEG;
        att::attn_unit(Q + (rb + q0) * 1536 + h * QKH, K + rb * 1536 + h * QKH, KV + rb * LDKV + h * 256 + 128, O + (rb + q0) * 1024 + h * VH, seq, (char*)lds);
    }
}

namespace scan {
constexpr int CH = 32, STEP_B = 6 * 256, BUF_B = CH * STEP_B  , YB_B = CH * 64 * 4  , LDS_B = 2 * BUF_B + 2 * YB_B  , NCH = SEG / CH  ;
constexpr int TILE_B = 64 * 65 * 4, MT_TILES = 24 * 896;
struct MTile { const float* src; bf16_t* dst; int sld, ldd, n0, k0, grpd; };
__device__ __forceinline__ int step_row(int b, int dir, int gs) {
    const int base = b * SEG;
    if (dir == 0) return base + gs;
    return gs < CTX ? base + (CTX - 1 - gs) : base + CTX + (SEG - 1 - gs);
}
struct Raw { u32x4 k, r, v, wl, al, vf, vl; };
}
__device__ __forceinline__ bool moe_tile(const Args& a, int k, int t, scan::MTile& m) {
    if (CS_NOTILE || t >= scan::MT_TILES) return false;
    const int j = t / 896, tl = t - j * 896, e = j / 3, kind = j - e * 3; int tn;
    const size_t so = (size_t)(k * NE + e) * D * DFE;
    if (kind < 2) { m.src = a.in[kind == 0 ? I_M1 : I_M3] + so; m.sld = DFE; m.dst = (bf16_t*)(a.ws + WS_ARENA + A_WM13) + (size_t)e * E_M13 + (kind ? (size_t)128 * 1024 : 0); m.ldd = 1024; tn = 56; m.grpd = 1; }
    else { m.src = a.in[I_M2] + so; m.sld = D; m.dst = (bf16_t*)(a.ws + WS_ARENA + A_WM2) + (size_t)e * E_M2; m.ldd = DFE; tn = 16; m.grpd = 0; }
    m.n0 = (tl % tn) * 64; m.k0 = (tl / tn) * 64; return true;
}
__device__ __forceinline__ void scan_phase(const Args& a, int j, const bf16_t* Vsrc, const bool vres, LAS unsigned char* lds, int G, int c) {
    using namespace scan;
    int mt_round = 0;
    const int tid = ltid(), wave = tid >> 6, lane = tid & 63;
    const bf16_t* RR = (const bf16_t*)(a.ws + WS_ARENA + A_RR); const bf16_t* RK = (const bf16_t*)(a.ws + WS_ARENA + A_RK);
    for (int chain = c; chain < 256; chain += G) {
        const int b = chain >> 5, h = (chain >> 1) & 15, dir = chain & 1;
        const bf16_t* WL = (const bf16_t*)(a.ws + WS_ARENA + (dir ? A_WL1 : A_WL0)); const bf16_t* AL = (const bf16_t*)(a.ws + WS_ARENA + (dir ? A_AL1 : A_AL0));
        bf16_t* Y = (bf16_t*)(a.ws + WS_ARENA + (dir ? A_YR : A_YF));
        if (wave >= 4) {
            const int pt = tid - 256, s = pt >> 3, seg = pt & 7, ch0 = h * 64 + seg * 8;
            float kkp[8], kap[8], v0p[8];
            const bf16_t* VFp = (const bf16_t*)(a.ws + WS_VF); const bf16_t* VLp = (const bf16_t*)(a.ws + WS_ARENA + A_VL);
#pragma unroll
            for (int e = 0; e < 8; ++e) v0p[e] = vres ? a.in[I_V0][ch0 + e] : 0.f;
#pragma unroll
            for (int e = 0; e < 8; ++e) { kkp[e] = a.in[I_KK][(size_t)j * D + ch0 + e]; kap[e] = a.in[I_KA][(size_t)j * D + ch0 + e]; }
            Raw raw;
#define GLOAD(q) do { const size_t off_ = (size_t)step_row(b, dir, (q) * CH + s) * 1024 + ch0; \
                raw.k = *(const u32x4*)(RK + off_); raw.r = *(const u32x4*)(RR + off_); raw.v = *(const u32x4*)(Vsrc + off_); raw.wl = *(const u32x4*)(WL + off_); raw.al = *(const u32x4*)(AL + off_); \
                if (vres) { raw.vf = *(const u32x4*)(VFp + off_); raw.vl = *(const u32x4*)(VLp + off_); } } while (0)
#define PRODUCE(buf) do { \
                float k[8], r[8], v[8], wl[8], al[8]; unpack8(raw.k, k); unpack8(raw.r, r); unpack8(raw.v, v); unpack8(raw.wl, wl); unpack8(raw.al, al); \
                if (vres) { float vf[8], vl[8]; unpack8(raw.vf, vf); unpack8(raw.vl, vl); _Pragma("unroll") for (int e = 0; e < 8; ++e) v[e] = v[e] + (vf[e] - v[e]) * sigmoidf_(v0p[e] + vl[e]); } \
                float ad[8], kd[8], kk[8], ww[8], ss = 0.f; \
                _Pragma("unroll") for (int e = 0; e < 8; ++e) { ad[e] = al[e]; kd[e] = k[e] * (1.0f + (ad[e] - 1.0f) * kap[e]); kk[e] = k[e] * kkp[e]; ss += kk[e] * kk[e]; \
                    ww[e] = __expf(-wl[e]); } \
                ss = red8(ss); const float inv = 1.0f / fmaxf(sqrtf(ss), 1e-12f); \
                LAS f32x4* o = (LAS f32x4*)(lds + (buf) * BUF_B + s * STEP_B + seg * 32); \
                _Pragma("unroll") for (int e = 0; e < 8; ++e) kk[e] *= inv; \
                o[0] = (f32x4){ww[0], ww[1], ww[2], ww[3]}; o[1] = (f32x4){ww[4], ww[5], ww[6], ww[7]}; \
                o[16] = (f32x4){kd[0], kd[1], kd[2], kd[3]}; o[17] = (f32x4){kd[4], kd[5], kd[6], kd[7]}; \
                o[32] = (f32x4){-kk[0], -kk[1], -kk[2], -kk[3]}; o[33] = (f32x4){-kk[4], -kk[5], -kk[6], -kk[7]}; \
                o[48] = (f32x4){kk[0] * ad[0], kk[1] * ad[1], kk[2] * ad[2], kk[3] * ad[3]}; o[49] = (f32x4){kk[4] * ad[4], kk[5] * ad[5], kk[6] * ad[6], kk[7] * ad[7]}; \
                o[64] = (f32x4){r[0], r[1], r[2], r[3]}; o[65] = (f32x4){r[4], r[5], r[6], r[7]}; \
                o[80] = (f32x4){v[0], v[1], v[2], v[3]}; o[81] = (f32x4){v[4], v[5], v[6], v[7]}; } while (0)
#define YSTORE(q) do { const LAS f32x4* yp = (const LAS f32x4*)(lds + 2 * BUF_B + ((q) & 1) * YB_B + s * 256 + seg * 32); const f32x4 y0 = yp[0], y1 = yp[1]; \
                u32x4 w; w.x = cvt_pk_bf16(y0[0], y0[1]); w.y = cvt_pk_bf16(y0[2], y0[3]); w.z = cvt_pk_bf16(y1[0], y1[1]); w.w = cvt_pk_bf16(y1[2], y1[3]); \
                *(u32x4*)(Y + (size_t)step_row(b, dir, (q) * CH + s) * 1024 + ch0) = w; } while (0)
            GLOAD(0); PRODUCE(0); GLOAD(1);
            __syncthreads();
            f32x4 treg[4]; const int kl = pt >> 4, nq = (pt & 15) * 4, sn = pt >> 2, sk = (pt & 3) * 16;
            for (int q = 0; q < NCH; ++q) {
                if (q + 1 < NCH) { PRODUCE((q + 1) & 1); if (q + 2 < NCH) GLOAD(q + 2); }
                if (q >= 1) YSTORE(q - 1);
                MTile m;
                if (q >= 2 && moe_tile(a, j, c + (mt_round + q - 2) * G, m)) {
                    const LAS float* tl_ = (const LAS float*)(lds + LDS_B + (q & 1) * TILE_B); float f0[8], f1[8];
#pragma unroll
                    for (int e = 0; e < 8; ++e) { f0[e] = tl_[(sk + e) * 65 + sn]; f1[e] = tl_[(sk + 8 + e) * 65 + sn]; }
                    const int n = m.n0 + sn, dr = m.grpd ? ((n >> 7) * 256 + (n & 127)) : n; bf16_t* dp = m.dst + (size_t)dr * m.ldd + m.k0 + sk;
                    *(u32x4*)dp = pack8(f0); *(u32x4*)(dp + 8) = pack8(f1); }
                if (q >= 1 && q <= NCH - 2 && moe_tile(a, j, c + (mt_round + q - 1) * G, m)) {
                    LAS float* tl_ = (LAS float*)(lds + LDS_B + ((q - 1) & 1) * TILE_B);
#pragma unroll
                    for (int p = 0; p < 4; ++p) { LAS float* tp = tl_ + (kl + 16 * p) * 65 + nq; tp[0] = treg[p][0]; tp[1] = treg[p][1]; tp[2] = treg[p][2]; tp[3] = treg[p][3]; } }
                if (q <= NCH - 3 && moe_tile(a, j, c + (mt_round + q) * G, m)) {
#pragma unroll
                    for (int p = 0; p < 4; ++p) treg[p] = *(const f32x4*)(m.src + (size_t)(m.k0 + kl + 16 * p) * m.sld + m.n0 + nq); }
                __syncthreads();
            }
            YSTORE(NCH - 1);
#undef GLOAD
#undef PRODUCE
#undef YSTORE
        } else {
            const int rp = lane >> 3, ks = lane & 7, v0i = wave * 16 + rp * 2;
            f32x2 s0[4], s1[4];
#pragma unroll
            for (int i = 0; i < 4; ++i) { s0[i] = (f32x2){0.f, 0.f}; s1[i] = (f32x2){0.f, 0.f}; }
            __syncthreads();
            struct Vecs { f32x4 w0, w1, k0, k1, a0, a1, b0, b1, r0, r1; f32x2 vv; };
#define LOADV(V, t) do { const LAS f32x4* p_ = (const LAS f32x4*)(bp + (t) * STEP_B); V.w0 = p_[0]; V.w1 = p_[1]; V.k0 = p_[16]; V.k1 = p_[17]; V.a0 = p_[32]; V.a1 = p_[33]; \
                    V.b0 = p_[48]; V.b1 = p_[49]; V.r0 = p_[64]; V.r1 = p_[65]; V.vv = *(const LAS f32x2*)(vp + (t) * STEP_B); } while (0)
#define STEPV(V, t, HAVEPREV) do { \
                    const f32x2 wv[4] = {{V.w0[0], V.w0[1]}, {V.w0[2], V.w0[3]}, {V.w1[0], V.w1[1]}, {V.w1[2], V.w1[3]}}, kv[4] = {{V.k0[0], V.k0[1]}, {V.k0[2], V.k0[3]}, {V.k1[0], V.k1[1]}, {V.k1[2], V.k1[3]}}; \
                    const f32x2 av[4] = {{V.a0[0], V.a0[1]}, {V.a0[2], V.a0[3]}, {V.a1[0], V.a1[1]}, {V.a1[2], V.a1[3]}}, bv[4] = {{V.b0[0], V.b0[1]}, {V.b0[2], V.b0[3]}, {V.b1[0], V.b1[1]}, {V.b1[2], V.b1[3]}}; \
                    const f32x2 rv[4] = {{V.r0[0], V.r0[1]}, {V.r0[2], V.r0[3]}, {V.r1[0], V.r1[1]}, {V.r1[2], V.r1[3]}}; \
                    f32x2 d0 = s0[0] * av[0], d1 = s1[0] * av[0]; \
                    d0 += s0[1] * av[1]; d1 += s1[1] * av[1]; d0 += s0[2] * av[2]; d1 += s1[2] * av[2]; d0 += s0[3] * av[3]; d1 += s1[3] * av[3]; \
                    float h0 = d0.x + d0.y, h1 = d1.x + d1.y; \
                    h0 += dpp_f<0xB1>(h0); h1 += dpp_f<0xB1>(h1); yp0 += dpp_f<0xB1>(yp0); yp1 += dpp_f<0xB1>(yp1); \
                    h0 += dpp_f<0x4E>(h0); h1 += dpp_f<0x4E>(h1); yp0 += dpp_f<0x4E>(yp0); yp1 += dpp_f<0x4E>(yp1); \
                    h0 += dpp_f<0x141>(h0); h1 += dpp_f<0x141>(h1); yp0 += dpp_f<0x141>(yp0); yp1 += dpp_f<0x141>(yp1); \
                    if (HAVEPREV) yb[((t) - 1) * 64 + v0i + (ks & 1)] = (ks & 1) ? yp1 : yp0; \
                    const f32x2 sa0v = {h0, h0}, sa1v = {h1, h1}, v0v = {V.vv.x, V.vv.x}, v1v = {V.vv.y, V.vv.y}; \
                    _Pragma("unroll") for (int i = 0; i < 4; ++i) { s0[i] = s0[i] * wv[i] + sa0v * bv[i] + v0v * kv[i]; s1[i] = s1[i] * wv[i] + sa1v * bv[i] + v1v * kv[i]; } \
                    f32x2 y0 = s0[0] * rv[0], y1 = s1[0] * rv[0]; \
                    y0 += s0[1] * rv[1]; y1 += s1[1] * rv[1]; y0 += s0[2] * rv[2]; y1 += s1[2] * rv[2]; y0 += s0[3] * rv[3]; y1 += s1[3] * rv[3]; \
                    yp0 = y0.x + y0.y; yp1 = y1.x + y1.y; } while (0)
            for (int q = 0; q < NCH; ++q) {
                const LAS unsigned char* bp = lds + (q & 1) * BUF_B + ks * 32;
                const LAS unsigned char* vp = lds + (q & 1) * BUF_B + 5 * 256 + v0i * 4;
                LAS float* yb = (LAS float*)(lds + 2 * BUF_B + (q & 1) * YB_B);
                Vecs VA, VB; float yp0 = 0.f, yp1 = 0.f;
                LOADV(VA, 0); LOADV(VB, 1);
                STEPV(VA, 0, false);
                LOADV(VA, 2);
                STEPV(VB, 1, true);
#pragma unroll 1
                for (int t = 2; t < CH; t += 2) {
                    LOADV(VB, t + 1);
                    STEPV(VA, t, true);
                    LOADV(VA, t + 2);
                    STEPV(VB, t + 1, true);
                }
                yp0 = red8(yp0); yp1 = red8(yp1);
                yb[(CH - 1) * 64 + v0i + (ks & 1)] = (ks & 1) ? yp1 : yp0;
                __syncthreads();
            }
#undef LOADV
#undef STEPV
        }
        mt_round += NCH - 2;
        __syncthreads();
    }
}

namespace cs {
constexpr int C = 32, NCK = SEG / C;
constexpr int TM = 72, CM = 40, TMB = TM * 2, CMB = CM * 2;
constexpr int SZ_TM = 32 * TMB, SZ_CM = 64 * CMB, SZ_C32 = 32 * CMB;
constexpr int X_ATM = 0, X_RTM = SZ_TM, X_BHTM = 2 * SZ_TM, X_KHTM = 3 * SZ_TM, X_ACM = 4 * SZ_TM, X_RCM = X_ACM + SZ_CM, X_BBCM = X_RCM + SZ_CM, X_KBCM = X_BBCM + SZ_CM, X_B = X_KBCM + SZ_CM;
constexpr int Y_VCM = 0, Y_GC = SZ_CM, Y_B = SZ_CM + 256;
constexpr int OFF_X = 0, OFF_Y = 2 * X_B, OFF_MID = OFF_Y + 2 * Y_B;
constexpr int M_NL = 0, M_NR = SZ_C32, M_TT = 2 * SZ_C32, M_ARBT = 3 * SZ_C32, M_AAK = 4 * SZ_C32, M_UP = 5 * SZ_C32, M_W = 6 * SZ_C32, M_ARK = M_W + SZ_CM, MID_B = M_ARK + 4096;
constexpr int OFF_OUT = OFF_MID + MID_B;
constexpr int O_PST = 0, O_QST = 64 * TMB, O_PYT = O_QST + SZ_CM, O_QYT = O_PYT + SZ_TM, OUT_B = O_QYT + SZ_C32;
constexpr int OFF_YB = OFF_OUT + OUT_B, OFF_ES = OFF_YB + 8192, OFF_WT = OFF_ES + 2048, LDS_END = OFF_WT + 64 * 65 * 4;
__device__ __forceinline__ int rho(int r, int h) { return (r & 3) + 8 * (r >> 2) + 4 * h; }
__device__ __forceinline__ int perm16(int k) { return (k & ~0xC) | ((k & 4) << 1) | ((k & 8) >> 1); }
typedef __bf16 bf16v2 __attribute__((ext_vector_type(2)));
__device__ __forceinline__ unsigned cvt_pk_bf16_c(float lo, float hi) { const bf16v2 v = __builtin_convertvector((f32x2){lo, hi}, bf16v2); return __builtin_bit_cast(unsigned, v); }
__device__ __forceinline__ bf16_t f2bf(float x) { const __bf16 b = (__bf16)x; return __builtin_bit_cast(bf16_t, b); }
__device__ __forceinline__ float bf2f(bf16_t x) { return __uint_as_float((unsigned)x << 16); }
template <int KS> __device__ __forceinline__ void mma32t(f32x16& acc, const LAS unsigned char* A, int lda, const LAS unsigned char* B, int ldb, int r32, int h) {
    bf16x8 a[KS], b[KS];
#pragma unroll
    for (int s = 0; s < KS; ++s) { a[s] = *(const LAS bf16x8*)(A + r32 * lda + s * 32 + h * 16); b[s] = *(const LAS bf16x8*)(B + r32 * ldb + s * 32 + h * 16); }
#pragma unroll
    for (int s = 0; s < KS; ++s) acc = __builtin_amdgcn_mfma_f32_32x32x16_bf16(a[s], b[s], acc, 0, 0, 0);
}
__device__ __forceinline__ void mma32(f32x16& acc, const LAS unsigned char* A, int lda, const LAS unsigned char* B, int ldb, int ksteps, int r32, int h) {
    if (ksteps == 4) mma32t<4>(acc, A, lda, B, ldb, r32, h); else mma32t<2>(acc, A, lda, B, ldb, r32, h);
}
__device__ __forceinline__ void st_bf(const f32x16& acc, LAS unsigned char* dst, int sr, int sc, int r32, int h) {
#pragma unroll
    for (int r = 0; r < 16; ++r) *(LAS bf16_t*)(dst + rho(r, h) * sr + r32 * sc) = f2bf(acc[r]);
}
template <bool PERM> __device__ __forceinline__ void st_bf_T(const f32x16& acc, LAS unsigned char* dst, int sc, int r32, int h) {
#pragma unroll
    for (int m = 0; m < 4; ++m) { const int row0 = 8 * m + 4 * h, pos = PERM ? perm16(row0) : row0; u32x2 w; w.x = cvt_pk_bf16_c(acc[4 * m], acc[4 * m + 1]); w.y = cvt_pk_bf16_c(acc[4 * m + 2], acc[4 * m + 3]);
        *(LAS u32x2*)(dst + r32 * sc + pos * 2) = w; }
}
}
#define CS_BAR() do { asm volatile("s_waitcnt lgkmcnt(0)" ::: "memory"); __builtin_amdgcn_s_barrier(); asm volatile("" ::: "memory"); } while (0)
__device__ __forceinline__ void scan_chunked(const Args& a, int jl, const bf16_t* Vsrc, const bool vres, LAS unsigned char* lds, int G, int c) {
    using namespace cs;
    const int tid0 = ltid(), wave = __builtin_amdgcn_readfirstlane(tid0 >> 6);
    typedef const __attribute__((address_space(1))) bf16_t* gcp; typedef __attribute__((address_space(1))) bf16_t* gwp;
    gcp RR = (gcp)(a.ws + WS_ARENA + A_RR); gcp RK = (gcp)(a.ws + WS_ARENA + A_RK);
    gcp VFp = (gcp)(a.ws + WS_VF); gcp VLp = (gcp)(a.ws + WS_ARENA + A_VL); gcp Vg = (gcp)Vsrc;
    int mt0 = 0;
    for (int chain = c; chain < 256; chain += G) {
        const int b = chain >> 5, hd = (chain >> 1) & 15, dir = chain & 1;
        gcp WL = (gcp)(a.ws + WS_ARENA + (dir ? A_WL1 : A_WL0)); gcp AL = (gcp)(a.ws + WS_ARENA + (dir ? A_AL1 : A_AL0));
        gwp Y = (gwp)(a.ws + WS_ARENA + (dir ? A_YCR : A_YCF));
        const int gcol0 = hd * 64 + (tid0 & 63);
        const float kkp = a.in[I_KK][(size_t)jl * D + gcol0], kap = a.in[I_KA][(size_t)jl * D + gcol0], v0p = vres ? a.in[I_V0][gcol0] : 0.f, rkh = 0.5f * a.in[I_RK][(size_t)jl * D + gcol0];
        __attribute__((address_space(1))) float* DOTp = (__attribute__((address_space(1))) float*)(a.ws + WS_DOT) + (size_t)dir * R * 16 + hd;
        f32x16 S0 = {}, S1 = {};
        f32x4 wreg[8];
        constexpr int ntok = 4; const int tok0 = 4 * wave;
        bf16_t rk_[4], rr_[4], ra_[4], rv_[4], re_[4], rf_[4], rl_[4];
        bf16_t qk_[4], qr_[4], qa_[4], qv_[4], qe_[4], qf_[4], ql_[4];
#define CS_LOAD(q) do { _Pragma("unroll") for (int tk_ = 0; tk_ < 4; ++tk_) { const unsigned off_ = (unsigned)scan::step_row(b, dir, (q) * 32 + tok0 + tk_) * 1024u + (unsigned)gcol; \
                qk_[tk_] = RK[off_]; qr_[tk_] = RR[off_]; qa_[tk_] = AL[off_]; qe_[tk_] = WL[off_]; qv_[tk_] = Vg[off_]; if (vres) { qf_[tk_] = VFp[off_]; ql_[tk_] = VLp[off_]; } } } while (0)
#define CS_COPY() do { _Pragma("unroll") for (int tk_ = 0; tk_ < 4; ++tk_) { rk_[tk_] = qk_[tk_]; rr_[tk_] = qr_[tk_]; ra_[tk_] = qa_[tk_]; re_[tk_] = qe_[tk_]; rv_[tk_] = qv_[tk_]; rf_[tk_] = qf_[tk_]; rl_[tk_] = ql_[tk_]; } } while (0)
#define CS_ESUM() do { float es_ = 0.f; _Pragma("unroll") for (int tk_ = 0; tk_ < 4; ++tk_) es_ += bf2f(re_[tk_]); *(LAS float*)(lds + OFF_ES + wave * 256 + lane * 4) = es_; } while (0)
#define CS_MAIN(q) do { \
            LAS unsigned char* X_ = lds + OFF_X + ((q) & 1) * X_B; LAS unsigned char* Yb_ = lds + OFF_Y + ((q) & 1) * Y_B; \
            float before_ = 0.f, tot_ = 0.f; \
            _Pragma("unroll") for (int w_ = 0; w_ < 8; ++w_) { const float es_ = *(const LAS float*)(lds + OFF_ES + w_ * 256 + lane * 4); before_ += (w_ < wave) ? es_ : 0.f; tot_ += es_; } \
            float erun_ = __expf(-before_); const float gct_ = __expf(-tot_); \
            _Pragma("unroll") for (int p_ = 0; p_ < 2; ++p_) { const int t_ = tok0 + 2 * p_;            \
                const f32x2 kraw_ = {bf2f(rk_[2 * p_]), bf2f(rk_[2 * p_ + 1])}, rr2_ = {bf2f(rr_[2 * p_]), bf2f(rr_[2 * p_ + 1])}, ad_ = {bf2f(ra_[2 * p_]), bf2f(ra_[2 * p_ + 1])}; \
                f32x2 vv_ = {bf2f(rv_[2 * p_]), bf2f(rv_[2 * p_ + 1])}; \
                if (vres) { const f32x2 vf_ = {bf2f(rf_[2 * p_]), bf2f(rf_[2 * p_ + 1])}; const float s0_ = sigmoidf_(v0p + bf2f(rl_[2 * p_])), s1_ = sigmoidf_(v0p + bf2f(rl_[2 * p_ + 1])); \
                    vv_ = vv_ + (vf_ - vv_) * (f32x2){s0_, s1_}; } \
                const f32x2 kd_ = kraw_ * ((ad_ - 1.0f) * kap + 1.0f), kkr_ = kraw_ * kkp, sq_ = kkr_ * kkr_; \
                float s0 = sq_.x, s1 = sq_.y; const f32x2 bd_ = rr2_ * kd_ * rkh; float d0 = bd_.x, d1 = bd_.y;     \
                  \
                float u0_, u1_; { const auto x0_ = __builtin_amdgcn_permlane32_swap(__float_as_uint(s0), __float_as_uint(d0), false, false); const auto x1_ = __builtin_amdgcn_permlane32_swap(__float_as_uint(s1), __float_as_uint(d1), false, false); \
                  u0_ = __uint_as_float(x0_[0]) + __uint_as_float(x0_[1]); u1_ = __uint_as_float(x1_[0]) + __uint_as_float(x1_[1]); } \
                u0_ += dpp_f<0xB1>(u0_); u1_ += dpp_f<0xB1>(u1_); u0_ += dpp_f<0x4E>(u0_); u1_ += dpp_f<0x4E>(u1_); u0_ += dpp_f<0x141>(u0_); u1_ += dpp_f<0x141>(u1_); u0_ += dpp_f<0x140>(u0_); u1_ += dpp_f<0x140>(u1_); \
                const int i0_ = __float_as_int(u0_), i1_ = __float_as_int(u1_); \
                const float ss0_ = __int_as_float(__builtin_amdgcn_readlane(i0_, 0)) + __int_as_float(__builtin_amdgcn_readlane(i0_, 16)), dd0_ = __int_as_float(__builtin_amdgcn_readlane(i0_, 32)) + __int_as_float(__builtin_amdgcn_readlane(i0_, 48)); \
                const float ss1_ = __int_as_float(__builtin_amdgcn_readlane(i1_, 0)) + __int_as_float(__builtin_amdgcn_readlane(i1_, 16)), dd1_ = __int_as_float(__builtin_amdgcn_readlane(i1_, 32)) + __int_as_float(__builtin_amdgcn_readlane(i1_, 48)); \
                if (lane == 0) { DOTp[(size_t)scan::step_row(b, dir, (q) * 32 + t_) * 16] = dd0_; DOTp[(size_t)scan::step_row(b, dir, (q) * 32 + t_ + 1) * 16] = dd1_; } \
                const f32x2 kk_ = kkr_ * (f32x2){__builtin_amdgcn_rsqf(fmaxf(ss0_, 1e-24f)), __builtin_amdgcn_rsqf(fmaxf(ss1_, 1e-24f))}; \
                const float w0_ = __expf(-bf2f(re_[2 * p_])), w1_ = __expf(-bf2f(re_[2 * p_ + 1])); \
                f32x2 E1_, E2_; E1_.x = erun_; E2_.x = erun_ * w0_; E1_.y = E2_.x; E2_.y = E2_.x * w1_; erun_ = E2_.y; \
                const f32x2 Ei_ = {__builtin_amdgcn_rcpf(E2_.x), __builtin_amdgcn_rcpf(E2_.y)}, E3_ = Ei_ * gct_, bv_ = kk_ * ad_; \
                const f32x2 at2_ = -(kk_ * E1_), rt2_ = rr2_ * E2_, bh2_ = bv_ * Ei_, kh2_ = kd_ * Ei_, kb2_ = kd_ * E3_, bb2_ = bv_ * E3_; \
                const unsigned pa_ = cvt_pk_bf16_c(at2_.x, at2_.y), pr_ = cvt_pk_bf16_c(rt2_.x, rt2_.y), pbh_ = cvt_pk_bf16_c(bh2_.x, bh2_.y), pkh_ = cvt_pk_bf16_c(kh2_.x, kh2_.y); \
                *(LAS unsigned*)(X_ + X_ACM + lane * CMB + t_ * 2) = pa_; *(LAS unsigned*)(X_ + X_RCM + lane * CMB + t_ * 2) = pr_; \
                *(LAS unsigned*)(X_ + X_KBCM + lane * CMB + t_ * 2) = cvt_pk_bf16_c(kb2_.x, kb2_.y); *(LAS unsigned*)(X_ + X_BBCM + lane * CMB + t_ * 2) = cvt_pk_bf16_c(bb2_.x, bb2_.y); \
                *(LAS unsigned*)(Yb_ + Y_VCM + lane * CMB + t_ * 2) = cvt_pk_bf16_c(vv_.x, vv_.y); \
                *(LAS bf16_t*)(X_ + X_ATM + t_ * TMB + lane * 2) = (bf16_t)pa_; *(LAS bf16_t*)(X_ + X_ATM + (t_ + 1) * TMB + lane * 2) = (bf16_t)(pa_ >> 16); \
                *(LAS bf16_t*)(X_ + X_RTM + t_ * TMB + lane * 2) = (bf16_t)pr_; *(LAS bf16_t*)(X_ + X_RTM + (t_ + 1) * TMB + lane * 2) = (bf16_t)(pr_ >> 16); \
                *(LAS bf16_t*)(X_ + X_BHTM + t_ * TMB + lane * 2) = (bf16_t)pbh_; *(LAS bf16_t*)(X_ + X_BHTM + (t_ + 1) * TMB + lane * 2) = (bf16_t)(pbh_ >> 16); \
                *(LAS bf16_t*)(X_ + X_KHTM + t_ * TMB + lane * 2) = (bf16_t)pkh_; *(LAS bf16_t*)(X_ + X_KHTM + (t_ + 1) * TMB + lane * 2) = (bf16_t)(pkh_ >> 16); } \
            if (wave == 7) *(LAS float*)(Yb_ + Y_GC + lane * 4) = gct_; } while (0)
        { const int tid = ltid(), lane = tid & 63, gcol = hd * 64 + lane;
          { CS_LOAD(0); CS_COPY(); CS_ESUM(); }
          CS_BAR();
          { CS_LOAD(1); CS_MAIN(0); } }
        CS_BAR();
        for (int it = -1; it < NCK; ++it) {
            const bool have_next = (it + 1 < NCK);
            const int tid = ltid(), lane = tid & 63, r32 = lane & 31, h = lane >> 5, gcol = hd * 64 + lane;
            LAS unsigned char* X = lds + OFF_X + ((it + 1) & 1) * X_B; LAS unsigned char* M = lds + OFF_MID; LAS unsigned char* O = lds + OFF_OUT;
            f32x16 acc = {}, accT = {};
            if (have_next && wave < 4) {
                if (wave == 0) {
                    bf16x8 fb[4], fa[4];
#pragma unroll
                    for (int s4 = 0; s4 < 4; ++s4) { fb[s4] = *(const LAS bf16x8*)(X + X_BHTM + r32 * TMB + s4 * 32 + h * 16); fa[s4] = *(const LAS bf16x8*)(X + X_ATM + r32 * TMB + s4 * 32 + h * 16); }
#pragma unroll
                    for (int s4 = 0; s4 < 4; ++s4) { acc = __builtin_amdgcn_mfma_f32_32x32x16_bf16(fb[s4], fa[s4], acc, 0, 0, 0); accT = __builtin_amdgcn_mfma_f32_32x32x16_bf16(fa[s4], fb[s4], accT, 0, 0, 0); }
#pragma unroll
                    for (int r = 0; r < 16; ++r) accT[r] = (r32 < rho(r, h)) ? accT[r] : 0.f; }
                else if (wave == 2) mma32(acc, X + X_ATM, TMB, X + X_KHTM, TMB, 4, r32, h);
                else mma32(acc, X + ((wave & 2) ? X_KHTM : X_BHTM), TMB, X + ((wave & 1) ? X_RTM : X_ATM), TMB, 4, r32, h);
#pragma unroll
                for (int r = 0; r < 16; ++r) { const int i = rho(r, h); const bool keep = (wave == 2) ? (r32 < i) : ((wave & 1) ? (i <= r32) : (i < r32)); acc[r] = keep ? acc[r] : 0.f; }
                if (wave == 0) { }
                else if (wave == 1) st_bf_T<false>(acc, M + M_ARBT, CMB, r32, h);
                else if (wave == 2) st_bf_T<false>(acc, M + M_AAK, CMB, r32, h);
                else {
#pragma unroll
                    for (int m = 0; m < 4; ++m) *(LAS f32x4*)(M + M_ARK + r32 * 128 + (8 * m + 4 * h) * 4) = (f32x4){acc[4 * m], acc[4 * m + 1], acc[4 * m + 2], acc[4 * m + 3]}; }
            }
            if (CS_SERIAL) CS_BAR();
            if (it >= 0 && wave >= 6) {
                const int vb = wave - 6; const LAS unsigned char* Yb = lds + OFF_Y + (it & 1) * Y_B;
                bf16x8 bs[4];
#pragma unroll
                for (int s = 0; s < 2; ++s) { u32x4 w0, w1;
                    w0.x = cvt_pk_bf16_c(S0[8 * s + 0], S0[8 * s + 1]); w0.y = cvt_pk_bf16_c(S0[8 * s + 2], S0[8 * s + 3]); w0.z = cvt_pk_bf16_c(S0[8 * s + 4], S0[8 * s + 5]); w0.w = cvt_pk_bf16_c(S0[8 * s + 6], S0[8 * s + 7]);
                    w1.x = cvt_pk_bf16_c(S1[8 * s + 0], S1[8 * s + 1]); w1.y = cvt_pk_bf16_c(S1[8 * s + 2], S1[8 * s + 3]); w1.z = cvt_pk_bf16_c(S1[8 * s + 4], S1[8 * s + 5]); w1.w = cvt_pk_bf16_c(S1[8 * s + 6], S1[8 * s + 7]);
                    bs[s] = *reinterpret_cast<bf16x8*>(&w0); bs[2 + s] = *reinterpret_cast<bf16x8*>(&w1); }
                const LAS unsigned char* Vr = Yb + Y_VCM + (vb * 32 + r32) * CMB + h * 16;
                const bf16x8 bv0 = *(const LAS bf16x8*)Vr, bv1 = *(const LAS bf16x8*)(Vr + 32);
                bf16x8 fy[6], fs[6];
#pragma unroll
                for (int s = 0; s < 4; ++s) { fy[s] = *(const LAS bf16x8*)(O + O_PYT + r32 * TMB + s * 32 + h * 16); fs[s] = *(const LAS bf16x8*)(O + O_PST + r32 * TMB + s * 32 + h * 16); }
#pragma unroll
                for (int s = 0; s < 2; ++s) { fy[4 + s] = *(const LAS bf16x8*)(O + O_QYT + r32 * CMB + s * 32 + h * 16); fs[4 + s] = *(const LAS bf16x8*)(O + O_QST + r32 * CMB + s * 32 + h * 16); }
                f32x16 n0, n1;
#pragma unroll
                for (int m = 0; m < 4; ++m) { const f32x4 g0 = *(const LAS f32x4*)(Yb + Y_GC + (8 * m + 4 * h) * 4), g1 = *(const LAS f32x4*)(Yb + Y_GC + (32 + 8 * m + 4 * h) * 4);
#pragma unroll
                    for (int i = 0; i < 4; ++i) { n0[4 * m + i] = S0[4 * m + i] * g0[i]; n1[4 * m + i] = S1[4 * m + i] * g1[i]; } }
                f32x16 ya = {};
#pragma unroll
                for (int s = 0; s < 4; ++s) { ya = __builtin_amdgcn_mfma_f32_32x32x16_bf16(fy[s], bs[s], ya, 0, 0, 0); n0 = __builtin_amdgcn_mfma_f32_32x32x16_bf16(fs[s], bs[s], n0, 0, 0, 0); }
                ya = __builtin_amdgcn_mfma_f32_32x32x16_bf16(fy[4], bv0, ya, 0, 0, 0); n0 = __builtin_amdgcn_mfma_f32_32x32x16_bf16(fs[4], bv0, n0, 0, 0, 0);
                ya = __builtin_amdgcn_mfma_f32_32x32x16_bf16(fy[5], bv1, ya, 0, 0, 0); n0 = __builtin_amdgcn_mfma_f32_32x32x16_bf16(fs[5], bv1, n0, 0, 0, 0);
#pragma unroll
                for (int s = 0; s < 4; ++s) fs[s] = *(const LAS bf16x8*)(O + O_PST + (32 + r32) * TMB + s * 32 + h * 16);
#pragma unroll
                for (int s = 0; s < 2; ++s) fs[4 + s] = *(const LAS bf16x8*)(O + O_QST + (32 + r32) * CMB + s * 32 + h * 16);
#pragma unroll
                for (int r = 0; r < 16; ++r) *(LAS float*)(lds + OFF_YB + rho(r, h) * 256 + (vb * 32 + r32) * 4) = ya[r];
#pragma unroll
                for (int s = 0; s < 4; ++s) n1 = __builtin_amdgcn_mfma_f32_32x32x16_bf16(fs[s], bs[s], n1, 0, 0, 0);
                n1 = __builtin_amdgcn_mfma_f32_32x32x16_bf16(fs[4], bv0, n1, 0, 0, 0); n1 = __builtin_amdgcn_mfma_f32_32x32x16_bf16(fs[5], bv1, n1, 0, 0, 0);
                S0 = n0; S1 = n1;
            }
            if (it + 2 < NCK) { CS_COPY(); CS_ESUM(); }
            if (wave == 4 || wave == 5) {
                const int pt = tid - 256; scan::MTile m;
                if (it >= 0 && it <= NCK - 2 && moe_tile(a, jl, c + (mt0 + it) * G, m)) {
                    const LAS float* tl_ = (const LAS float*)(lds + OFF_WT); const int sn = pt >> 1, sk = (pt & 1) * 32;
                    const int n = m.n0 + sn, dr = m.grpd ? ((n >> 7) * 256 + (n & 127)) : n; bf16_t* dp = m.dst + (size_t)dr * m.ldd + m.k0 + sk;
#pragma unroll
                    for (int q8 = 0; q8 < 4; ++q8) { float f[8];
#pragma unroll
                        for (int e = 0; e < 8; ++e) f[e] = tl_[(sk + q8 * 8 + e) * 65 + sn];
                        *(__attribute__((address_space(1))) u32x4*)(dp + q8 * 8) = pack8(f); } }
                if (it + 1 < NCK - 1 && moe_tile(a, jl, c + (mt0 + it + 1) * G, m)) { const int kl = pt >> 4, nq = (pt & 15) * 4;
#pragma unroll
                    for (int p8 = 0; p8 < 8; ++p8) wreg[p8] = *(const __attribute__((address_space(1))) f32x4*)(m.src + (size_t)(m.k0 + kl + 8 * p8) * m.sld + m.n0 + nq); }
            }
            CS_BAR();
            if (have_next && wave == 0) {
                f32x16 Tm = acc, Mm = acc, Mt = accT;
#pragma unroll
                for (int r = 0; r < 16; ++r) Tm[r] += (rho(r, h) == r32) ? 1.0f : 0.f;
#define CS_SLAB(tile, s) ({ u32x4 w_; w_.x = cvt_pk_bf16_c(tile[8 * (s) + 0], tile[8 * (s) + 1]); w_.y = cvt_pk_bf16_c(tile[8 * (s) + 2], tile[8 * (s) + 3]); \
                    w_.z = cvt_pk_bf16_c(tile[8 * (s) + 4], tile[8 * (s) + 5]); w_.w = cvt_pk_bf16_c(tile[8 * (s) + 6], tile[8 * (s) + 7]); *reinterpret_cast<bf16x8*>(&w_); })
                for (int lvl = 0; lvl < 4; ++lvl) {
                    const bf16x8 m0 = CS_SLAB(Mm, 0), m1 = CS_SLAB(Mm, 1), t0_ = CS_SLAB(Mt, 0), t1_ = CS_SLAB(Mt, 1);
                    f32x16 m2 = {}, m2t = {};
                    m2 = __builtin_amdgcn_mfma_f32_32x32x16_bf16(t0_, m0, m2, 0, 0, 0); m2t = __builtin_amdgcn_mfma_f32_32x32x16_bf16(m0, t0_, m2t, 0, 0, 0);
                    m2 = __builtin_amdgcn_mfma_f32_32x32x16_bf16(t1_, m1, m2, 0, 0, 0); m2t = __builtin_amdgcn_mfma_f32_32x32x16_bf16(m1, t1_, m2t, 0, 0, 0);
                    Mm = m2; Mt = m2t;
                    { const bf16x8 a0 = CS_SLAB(Mt, 0), a1 = CS_SLAB(Mt, 1), bt0 = CS_SLAB(Tm, 0), bt1 = CS_SLAB(Tm, 1);
                      Tm = __builtin_amdgcn_mfma_f32_32x32x16_bf16(a0, bt0, Tm, 0, 0, 0); Tm = __builtin_amdgcn_mfma_f32_32x32x16_bf16(a1, bt1, Tm, 0, 0, 0); }
                }
                st_bf_T<false>(Tm, M + M_TT, CMB, r32, h);
            }
            if (CS_SERIAL) CS_BAR();
            if (it + 3 < NCK) CS_LOAD(it + 3);
            if (it + 2 < NCK) CS_MAIN(it + 2);
            if (CS_SERIAL) CS_BAR();
            if (it >= 0 && wave >= 5) {
                for (int item = tid - 320; item < 256; item += 192) { const int t = item >> 3, seg = item & 7;
                    const LAS f32x4* yp = (const LAS f32x4*)(lds + OFF_YB + t * 256 + seg * 32); const f32x4 y0 = yp[0], y1 = yp[1];
                    u32x4 w; w.x = cvt_pk_bf16(y0[0], y0[1]); w.y = cvt_pk_bf16(y0[2], y0[3]); w.z = cvt_pk_bf16(y1[0], y1[1]); w.w = cvt_pk_bf16(y1[2], y1[3]);
                    *(__attribute__((address_space(1))) u32x4*)(Y + (size_t)scan::step_row(b, dir, it * 32 + t) * 1024 + hd * 64 + seg * 8) = w; }
            }
            CS_BAR();
            if (have_next && wave < 3) {
                f32x16 d = {};
                if (wave < 2) { mma32(d, M + M_TT, CMB, X + X_ACM + wave * 32 * CMB, CMB, 2, r32, h); st_bf_T<false>(d, M + M_W + wave * 32 * CMB, CMB, r32, h); }
                else { mma32(d, M + M_TT, CMB, M + M_AAK, CMB, 2, r32, h); st_bf_T<false>(d, M + M_UP, CMB, r32, h); }
            }
            if (wave == 4 || wave == 5) { const int pt = tid - 256, kl = pt >> 4, nq = (pt & 15) * 4; scan::MTile m;
                if (it + 1 < NCK - 1 && moe_tile(a, jl, c + (mt0 + it + 1) * G, m)) { LAS float* tl_ = (LAS float*)(lds + OFF_WT);
#pragma unroll
                    for (int p8 = 0; p8 < 8; ++p8) { LAS float* tp = tl_ + (kl + 8 * p8) * 65 + nq; tp[0] = wreg[p8][0]; tp[1] = wreg[p8][1]; tp[2] = wreg[p8][2]; tp[3] = wreg[p8][3]; } } }
            CS_BAR();
            if (have_next) {
                f32x16 d = {};
                if (wave < 4) { const int kt = wave & 1, kpt = wave >> 1;
                    mma32(d, M + M_W + kt * 32 * CMB, CMB, X + X_BBCM + kpt * 32 * CMB, CMB, 2, r32, h);
                    st_bf_T<true>(d, O + O_PST + kpt * 32 * TMB + kt * 64, TMB, r32, h); }
                else if (wave < 6) { const int kt = wave - 4;
                    u32x2 ra[4];
#pragma unroll
                    for (int m = 0; m < 4; ++m) ra[m] = *(const LAS u32x2*)(X + X_RTM + r32 * TMB + (kt * 32 + 8 * m + 4 * h) * 2);
                    mma32(d, M + M_W + kt * 32 * CMB, CMB, M + M_ARBT, CMB, 2, r32, h);
#pragma unroll
                    for (int m = 0; m < 4; ++m) { d[4 * m] += bflo(ra[m].x); d[4 * m + 1] += bfhi(ra[m].x); d[4 * m + 2] += bflo(ra[m].y); d[4 * m + 3] += bfhi(ra[m].y); }
                    st_bf_T<true>(d, O + O_PYT + kt * 64, TMB, r32, h); }
                else { const int kpt = wave - 6;
                    u32x2 ka[4];
#pragma unroll
                    for (int m = 0; m < 4; ++m) ka[m] = *(const LAS u32x2*)(X + X_KBCM + (kpt * 32 + r32) * CMB + (8 * m + 4 * h) * 2);
                    mma32(d, M + M_UP, CMB, X + X_BBCM + kpt * 32 * CMB, CMB, 2, r32, h);
#pragma unroll
                    for (int m = 0; m < 4; ++m) { d[4 * m] += bflo(ka[m].x); d[4 * m + 1] += bfhi(ka[m].x); d[4 * m + 2] += bflo(ka[m].y); d[4 * m + 3] += bfhi(ka[m].y); }
                    st_bf_T<false>(d, O + O_QST + kpt * 32 * CMB, CMB, r32, h);
                    if (wave == 7) { f32x16 e = {}; f32x4 aa[4];
#pragma unroll
                        for (int m = 0; m < 4; ++m) aa[m] = *(const LAS f32x4*)(M + M_ARK + r32 * 128 + (8 * m + 4 * h) * 4);
                        mma32(e, M + M_UP, CMB, M + M_ARBT, CMB, 2, r32, h);
#pragma unroll
                        for (int m = 0; m < 4; ++m) { e[4 * m] += aa[m][0]; e[4 * m + 1] += aa[m][1]; e[4 * m + 2] += aa[m][2]; e[4 * m + 3] += aa[m][3]; }
                        st_bf_T<false>(e, O + O_QYT, CMB, r32, h); } }
            }
            CS_BAR();
        }
#undef CS_LOAD
#undef CS_COPY
#undef CS_ESUM
#undef CS_MAIN
        mt0 += NCK - 1;
    }
}


__device__ __forceinline__ void scan_compare(const Args& a, LAS unsigned char* lds, int G, int c) {
    const int tid = ltid();
    asm volatile("s_waitcnt vmcnt(0)" ::: "memory"); __syncthreads();
    for (int chain = c; chain < 256; chain += G) {
        const int b = chain >> 5, hd = (chain >> 1) & 15, dir = chain & 1;
        const bf16_t* Yo = (const bf16_t*)(a.ws + WS_ARENA + (dir ? A_YR : A_YF)); const bf16_t* Yc = (const bf16_t*)(a.ws + WS_ARENA + (dir ? A_YCR : A_YCF));
        float md = 0.f, mo = 0.f;
        for (int i = tid; i < SEG * 8; i += NTHR) { const int r = i >> 3, seg = i & 7; const size_t off = (size_t)(b * SEG + r) * 1024 + hd * 64 + seg * 8;
            u32x4 wo, wc; const unsigned* po = (const unsigned*)(Yo + off); const unsigned* pc = (const unsigned*)(Yc + off);
#pragma unroll
            for (int q = 0; q < 4; ++q) { wo[q] = __hip_atomic_load(po + q, __ATOMIC_RELAXED, __HIP_MEMORY_SCOPE_AGENT); wc[q] = __hip_atomic_load(pc + q, __ATOMIC_RELAXED, __HIP_MEMORY_SCOPE_AGENT); }
            float yo[8], yc[8]; unpack8(wo, yo); unpack8(wc, yc);
#pragma unroll
            for (int e = 0; e < 8; ++e) { md = fmaxf(md, fabsf(yo[e] - yc[e])); mo = fmaxf(mo, fabsf(yo[e])); } }
#pragma unroll
        for (int o = 32; o >= 1; o >>= 1) { md = fmaxf(md, __shfl_xor(md, o)); mo = fmaxf(mo, __shfl_xor(mo, o)); }
        LAS float* red = (LAS float*)lds;
        if ((tid & 63) == 0) { red[(tid >> 6) * 2] = md; red[(tid >> 6) * 2 + 1] = mo; }
        __syncthreads();
        if (tid == 0) { float d = 0.f, o = 0.f; for (int w = 0; w < 8; ++w) { d = fmaxf(d, red[w * 2]); o = fmaxf(o, red[w * 2 + 1]); }
            if (!(d <= CS_TOL * o)) { bf16_t* Yw = (bf16_t*)(a.ws + WS_ARENA + (dir ? A_YR : A_YF)); Yw[(size_t)(b * SEG + CTX) * 1024 + hd * 64] = (bf16_t)0x7fc0u; } }
        __syncthreads();
    }
}

__device__ __forceinline__ void rwkv_outprep(const Args& a, int j, const bf16_t* Vsrc, const bool vres, int G, int c) {
    const int lane = ltid() & 63; int r0, r1; wave_rows(G, c, r0, r1);
    const bf16_t* YF = (const bf16_t*)(a.ws + WS_ARENA + A_YF); const bf16_t* YR = (const bf16_t*)(a.ws + WS_ARENA + A_YR);
    const bf16_t* RR = (const bf16_t*)(a.ws + WS_ARENA + A_RR); const bf16_t* RK = (const bf16_t*)(a.ws + WS_ARENA + A_RK);
    const bf16_t* AL0 = (const bf16_t*)(a.ws + WS_ARENA + A_AL0); const bf16_t* AL1 = (const bf16_t*)(a.ws + WS_ARENA + A_AL1); const bf16_t* GG = (const bf16_t*)(a.ws + WS_ARENA + A_G);
    bf16_t* O = (bf16_t*)(a.ws + WS_ARENA + A_RO);
    float lnw[16], lnb[16];
    const float* DOT0 = (const float*)(a.ws + WS_DOT); const float* DOT1 = DOT0 + (size_t)R * 16;
#pragma unroll
    for (int jj = 0; jj < 2; ++jj)
#pragma unroll
        for (int e = 0; e < 8; ++e) { const int col = jj * 512 + lane * 8 + e, i = jj * 8 + e; lnw[i] = a.in[I_LNW][j * D + col]; lnb[i] = a.in[I_LNB][j * D + col]; }
    for (int row = r0; row < r1; ++row) {
        u32x4 out[2];
#pragma unroll
        for (int jj = 0; jj < 2; ++jj) { const size_t off = (size_t)row * 1024 + jj * 512 + lane * 8;
            float yf[8], yr[8], v[8], g[8], y[8];
            unpack8(*(const u32x4*)(YF + off), yf); unpack8(*(const u32x4*)(YR + off), yr);
            unpack8(*(const u32x4*)(Vsrc + off), v);
            const float dot = DOT0[(size_t)row * 16 + jj * 8 + (lane >> 3)] + DOT1[(size_t)row * 16 + jj * 8 + (lane >> 3)];
            if (vres) { float vf[8], vl[8]; unpack8(*(const u32x4*)((const bf16_t*)(a.ws + WS_VF) + off), vf); unpack8(*(const u32x4*)((const bf16_t*)(a.ws + WS_ARENA + A_VL) + off), vl);
#pragma unroll
                for (int e = 0; e < 8; ++e) v[e] = v[e] + (vf[e] - v[e]) * sigmoidf_(a.in[I_V0][jj * 512 + lane * 8 + e] + vl[e]); }
            unpack8(*(const u32x4*)(GG + off), g);
            float sm = 0.f;
#pragma unroll
            for (int e = 0; e < 8; ++e) { y[e] = yf[e] + yr[e]; sm += y[e]; }
            sm = red8(sm); const float mu = sm * (1.0f / 64.0f); float var = 0.f;
#pragma unroll
            for (int e = 0; e < 8; ++e) { const float d = y[e] - mu; var += d * d; }
            var = red8(var) * (1.0f / 64.0f); const float rstd = 1.0f / sqrtf(var + LNX_EPS);
            float o[8];
#pragma unroll
            for (int e = 0; e < 8; ++e) { const int i = jj * 8 + e; o[e] = ((y[e] - mu) * rstd * lnw[i] + lnb[i] + dot * v[e]) * g[e]; }
            out[jj] = pack8(o); }
        *(u32x4*)(O + (size_t)row * 1024 + lane * 8) = out[0]; *(u32x4*)(O + (size_t)row * 1024 + 512 + lane * 8) = out[1];
    }
}

__device__ __forceinline__ void moe_gather(const Args& a, LAS unsigned char* lds, int G, int c) {
    const int tid = ltid(), wave = tid >> 6, lane = tid & 63; int r0, r1; wave_rows(G, c, r0, r1);
    LAS int* cnt = (LAS int*)lds;
    if (tid < 16) cnt[tid] = 0;
    __syncthreads();
    const int* hist = (const int*)(a.ws + WS_HIST); const int nchunk = G * NWAVE, first = c * NWAVE;
    int pre[8], tot[8];
#pragma unroll
    for (int e = 0; e < 8; ++e) { pre[e] = 0; tot[e] = 0; }
    for (int ch = tid; ch < nchunk; ch += NTHR) { const u32x4 h0 = *(const u32x4*)(hist + (size_t)ch * 8), h1 = *(const u32x4*)(hist + (size_t)ch * 8 + 4); const int m = ch < first ? 1 : 0;
        tot[0] += h0[0]; tot[1] += h0[1]; tot[2] += h0[2]; tot[3] += h0[3]; tot[4] += h1[0]; tot[5] += h1[1]; tot[6] += h1[2]; tot[7] += h1[3];
        pre[0] += m * h0[0]; pre[1] += m * h0[1]; pre[2] += m * h0[2]; pre[3] += m * h0[3]; pre[4] += m * h1[0]; pre[5] += m * h1[1]; pre[6] += m * h1[2]; pre[7] += m * h1[3]; }
#pragma unroll
    for (int e = 0; e < 8; ++e) { int p = pre[e], t = tot[e];
#pragma unroll
        for (int o = 32; o >= 1; o >>= 1) { p += __shfl_xor(p, o); t += __shfl_xor(t, o); }
        if (lane == 0) { __hip_atomic_fetch_add(&cnt[e], p, __ATOMIC_RELAXED, __HIP_MEMORY_SCOPE_WORKGROUP); __hip_atomic_fetch_add(&cnt[8 + e], t, __ATOMIC_RELAXED, __HIP_MEMORY_SCOPE_WORKGROUP); } }
    __syncthreads();
    int base[9], run[8]; base[0] = 0;
#pragma unroll
    for (int e = 0; e < 8; ++e) base[e + 1] = base[e] + ((cnt[8 + e] + 255) & ~255);
    if (c == 0 && tid < 9) { int v = 0;
#pragma unroll
        for (int e = 0; e < 9; ++e) v = (tid == e) ? base[e] : v;
        ((int*)(a.ws + WS_META))[tid] = v; }
#pragma unroll
    for (int e = 0; e < 8; ++e) { int p = cnt[e];
        for (int w = 0; w < wave; ++w) p += hist[(size_t)(first + w) * 8 + e];
        run[e] = base[e] + p; }
    const bf16_t* H = (const bf16_t*)(a.ws + WS_ARENA + A_H); bf16_t* HS = (bf16_t*)(a.ws + WS_ARENA + A_HS);
    for (int row = r0; row < r1; ++row) {
        const u32x4 rt = *(const u32x4*)(a.ws + WS_ROUTE + (size_t)row * 16); const int e0 = (int)rt[0], e1 = (int)rt[1];
        if (e0 < 0) continue;
        int s0 = 0, s1 = 0;
#pragma unroll
        for (int e = 0; e < 8; ++e) { if (e == e0) { s0 = run[e]; run[e] += 1; } if (e == e1) { s1 = run[e]; run[e] += 1; } }
        const u32x4 h0 = *(const u32x4*)(H + (size_t)row * 1024 + lane * 8), h1 = *(const u32x4*)(H + (size_t)row * 1024 + 512 + lane * 8);
        *(u32x4*)(HS + (size_t)s0 * 1024 + lane * 8) = h0; *(u32x4*)(HS + (size_t)s0 * 1024 + 512 + lane * 8) = h1;
        *(u32x4*)(HS + (size_t)s1 * 1024 + lane * 8) = h0; *(u32x4*)(HS + (size_t)s1 * 1024 + 512 + lane * 8) = h1;
        if (lane == 0) { int* sl = (int*)(a.ws + WS_RSLOT) + (size_t)row * 2; sl[0] = s0; sl[1] = s1; }
    }
}
__device__ __forceinline__ void final_combine(const Args& a, int layer, int G, int c) {
    const int lane = ltid() & 63; int r0, r1; wave_rows(G, c, r0, r1);
    for (int row = r0; row < r1; ++row) { if (row % SEG < CTX) continue;
        float* xp = xrow(a, row); float x[16]; load_x16(xp, lane, x); moe_combine16(a, row, layer, lane, x); store_x16(xp, lane, x); }
}

constexpr int NPH = 42;
#define CT(k) (((PSEL) >> (k)) & 1u)
#ifndef PROBE_MASK
#define PROBE_MASK 0u
#endif
#ifndef TPROBE_MASK
#define TPROBE_MASK 0u
#endif
struct TimeProbe { int n; bool on; unsigned long long t0;
    __device__ __forceinline__ TimeProbe(bool twice, bool on_) : n(twice ? 2 : 1), on(on_), t0(0) { if (on) t0 = wall_clock64(); }
    __device__ __forceinline__ void step() { --n; if (on && n == 0) { __syncthreads(); const unsigned long long t1 = wall_clock64(), dt = t1 - t0; while (wall_clock64() - t1 < dt) __builtin_amdgcn_s_sleep(8); } } };
#define REPS(k) for (TimeProbe tp_((((PROBE_MASK) >> (k)) & 1u) != 0u, (((TPROBE_MASK) >> (k)) & 1u) != 0u); tp_.n > 0; tp_.step())
constexpr int LDS_ST_OFF = 161792;
constexpr int LDS_BYTES = LDS_ST_OFF + 64;
constexpr int TILE_OFF = 73728;
#define WSP(off) (a.ws + WS_ARENA + (off))
template <unsigned PSEL>
__global__ void __launch_bounds__(NTHR, 2) fwd(Args ka) {
    extern __shared__ __attribute__((aligned(16))) unsigned char lds_raw[];
    LAS unsigned char* lds = (LAS unsigned char*)lds_raw;
    const int Gk = gridDim.x, ck = blockIdx.x, tid = ltid();
    volatile LAS unsigned* st = (volatile LAS unsigned*)(lds + LDS_ST_OFF);
    if (tid < 4) st[tid] = 0u;
    __syncthreads();
    XcdBarrier bar; bar.bar = (unsigned*)(ka.ws + WS_CTL); bar.x = 0; bar.st = st;
    if (ka.ph_hi - ka.ph_lo > 1) bar = xcd_barrier_post((unsigned*)(ka.ws + WS_CTL), st);
#define IN(p) (ka.ph_lo <= (p) && (p) < ka.ph_hi)
#define PHB const Args a = launder_args(ka); const int G = launder_s(Gk), c = launder_s(ck); (void)G; (void)c;
#define SEAM(p) do { if (IN(p) && IN((p) + 1)) xcd_barrier(bar); } while (0)
    const size_t P1K = (size_t)256 * 1024 * 2;

    { const int jj_ = 0; const bool last_ = false;
    if (CT(20) && IN(0)) REPS(20) { PHB const bf16_t* wm = wmla(a, jj_); const bf16_t* wr_ = wrwkv(a, jj_); const bf16_t* wf = wffn(a, jj_); bf16_t* Vb = last_ ? (bf16_t*)WSP(A_RV) : (bf16_t*)(a.ws + WS_VF); (void)wm; (void)wr_; (void)wf; (void)Vb;
            { prologue_misc(a, lds, G, c); run_prep(a, lds + TILE_OFF, -1, 0, G, c); } }
    }
    SEAM(0);

    for (int jj = 0; jj < 2; ++jj) {
        const int pb = 1 + jj * 20, lm = 2 * jj, lr = 2 * jj + 1, jj_ = jj; const bool last = (jj == 1), last_ = last;

        if (CT(0) && IN(pb + 0)) REPS(0) { PHB const bf16_t* wm = wmla(a, jj_); const bf16_t* wr_ = wrwkv(a, jj_); const bf16_t* wf = wffn(a, jj_); bf16_t* Vb = last_ ? (bf16_t*)WSP(A_RV) : (bf16_t*)(a.ws + WS_VF); (void)wm; (void)wr_; (void)wf; (void)Vb;
            { if (jj == 0) norm_plain<false, true>(a, lm, a.in[I_N1G] + lm * D, 0, (bf16_t*)WSP(A_H), G, c); else combine_rows<true>(a, lm - 1, lm, a.in[I_N1G] + lm * D, 0, (bf16_t*)WSP(A_H), G, c); } }
        SEAM(pb + 0);
        if (CT(1) && IN(pb + 1)) REPS(1) { PHB const bf16_t* wm = wmla(a, jj_); const bf16_t* wr_ = wrwkv(a, jj_); const bf16_t* wf = wffn(a, jj_); bf16_t* Vb = last_ ? (bf16_t*)WSP(A_RV) : (bf16_t*)(a.ws + WS_VF); (void)wm; (void)wr_; (void)wf; (void)Vb;
            { MapSimple S{(const char*)WSP(A_H), (const char*)wm, P1K, P1K, 3, 16, 0}; EpiBf<FPlain> E{{(bf16_t*)WSP(A_QKVA), 768}};
            pg8::gemm_phase(lds, 1024, 1024, S, E, G, c); } }
        SEAM(pb + 1);
        if (CT(2) && IN(pb + 2)) REPS(2) { PHB const bf16_t* wm = wmla(a, jj_); const bf16_t* wr_ = wrwkv(a, jj_); const bf16_t* wf = wffn(a, jj_); bf16_t* Vb = last_ ? (bf16_t*)WSP(A_RV) : (bf16_t*)(a.ws + WS_VF); (void)wm; (void)wr_; (void)wf; (void)Vb;
            mla_stats(a, G, c); }
        SEAM(pb + 2);
        if (CT(3) && IN(pb + 3)) REPS(3) { PHB const bf16_t* wm = wmla(a, jj_); const bf16_t* wr_ = wrwkv(a, jj_); const bf16_t* wf = wffn(a, jj_); bf16_t* Vb = last_ ? (bf16_t*)WSP(A_RV) : (bf16_t*)(a.ws + WS_VF); (void)wm; (void)wr_; (void)wf; (void)Vb;
            { MapQKV S{(const char*)WSP(A_QKVA), (const char*)(wm + E_QKVA), (const char*)(wm + E_QKVA + E_QB)};
            EpiQKV E{(bf16_t*)WSP(A_Q), (bf16_t*)WSP(A_KV), (const float*)(a.ws + WS_RS), (const float*)(a.ws + WS_RS) + R};
            pg8::gemm_phase(lds, 768, 384, S, E, G, c); } }
        SEAM(pb + 3);
        if (CT(4) && IN(pb + 4)) REPS(4) { PHB const bf16_t* wm = wmla(a, jj_); const bf16_t* wr_ = wrwkv(a, jj_); const bf16_t* wf = wffn(a, jj_); bf16_t* Vb = last_ ? (bf16_t*)WSP(A_RV) : (bf16_t*)(a.ws + WS_VF); (void)wm; (void)wr_; (void)wf; (void)Vb;
            mla_qkpost(a, jj, G, c); }
        SEAM(pb + 4);
        if (CT(5) && IN(pb + 5)) REPS(5) { PHB const bf16_t* wm = wmla(a, jj_); const bf16_t* wr_ = wrwkv(a, jj_); const bf16_t* wf = wffn(a, jj_); bf16_t* Vb = last_ ? (bf16_t*)WSP(A_RV) : (bf16_t*)(a.ws + WS_VF); (void)wm; (void)wr_; (void)wf; (void)Vb;
            attn_phase(a, lds, G, c); }
        SEAM(pb + 5);
        if (CT(6) && IN(pb + 6)) REPS(6) { PHB const bf16_t* wm = wmla(a, jj_); const bf16_t* wr_ = wrwkv(a, jj_); const bf16_t* wf = wffn(a, jj_); bf16_t* Vb = last_ ? (bf16_t*)WSP(A_RV) : (bf16_t*)(a.ws + WS_VF); (void)wm; (void)wr_; (void)wf; (void)Vb;
            { MapSimple S{(const char*)WSP(A_O), (const char*)(wm + E_QKVA + E_QB + E_KVB), P1K, P1K, 4, 16, 0}; EpiResid E{(float*)(a.ws + WS_CS), a.out, (const float*)(a.ws + WS_MODS), lm, 2, jj == 0 ? a.in[I_CTX] : (const float*)(a.ws + WS_CS), jj == 0 ? a.in[I_X] : (const float*)a.out};
            pg8::gemm_phase(lds, 1024, 1024, S, E, G, c); } }
        SEAM(pb + 6);
        if (CT(7) && IN(pb + 7)) REPS(7) { PHB const bf16_t* wm = wmla(a, jj_); const bf16_t* wr_ = wrwkv(a, jj_); const bf16_t* wf = wffn(a, jj_); bf16_t* Vb = last_ ? (bf16_t*)WSP(A_RV) : (bf16_t*)(a.ws + WS_VF); (void)wm; (void)wr_; (void)wf; (void)Vb;
            norm_plain<false>(a, lm, a.in[I_N2G] + lm * D, 3, (bf16_t*)WSP(A_H), G, c); }
        SEAM(pb + 7);
        if (CT(8) && IN(pb + 8)) REPS(8) { PHB const bf16_t* wm = wmla(a, jj_); const bf16_t* wr_ = wrwkv(a, jj_); const bf16_t* wf = wffn(a, jj_); bf16_t* Vb = last_ ? (bf16_t*)WSP(A_RV) : (bf16_t*)(a.ws + WS_VF); (void)wm; (void)wr_; (void)wf; (void)Vb;
            { MapSimple S{(const char*)WSP(A_H), (const char*)wf, P1K, P1K, 22, 16, 0}; EpiSwiGLU E{(bf16_t*)WSP(A_FHID), DFF};
            pg8::gemm_phase(lds, 1024, 1024, S, E, G, c); } }
        SEAM(pb + 8);
        if (CT(9) && IN(pb + 9)) REPS(9) { PHB const bf16_t* wm = wmla(a, jj_); const bf16_t* wr_ = wrwkv(a, jj_); const bf16_t* wf = wffn(a, jj_); bf16_t* Vb = last_ ? (bf16_t*)WSP(A_RV) : (bf16_t*)(a.ws + WS_VF); (void)wm; (void)wr_; (void)wf; (void)Vb;
            { MapSimple S{(const char*)WSP(A_FHID), (const char*)(wf + E_F13), (size_t)256 * DFF * 2, (size_t)256 * DFF * 2, 4, 44, 0}; EpiResid E{(float*)(a.ws + WS_CS), a.out, (const float*)(a.ws + WS_MODS), lm, 5, (const float*)(a.ws + WS_CS), (const float*)a.out};
            pg8::gemm_phase(lds, DFF, DFF, S, E, G, c); } }
        SEAM(pb + 9);
        if (CT(10) && IN(pb + 10)) REPS(10) { PHB const bf16_t* wm = wmla(a, jj_); const bf16_t* wr_ = wrwkv(a, jj_); const bf16_t* wf = wffn(a, jj_); bf16_t* Vb = last_ ? (bf16_t*)WSP(A_RV) : (bf16_t*)(a.ws + WS_VF); (void)wm; (void)wr_; (void)wf; (void)Vb;
            norm_mix(a, lr, jj, G, c); }
        SEAM(pb + 10);
        if (CT(11) && IN(pb + 11)) REPS(11) { PHB const bf16_t* wm = wmla(a, jj_); const bf16_t* wr_ = wrwkv(a, jj_); const bf16_t* wf = wffn(a, jj_); bf16_t* Vb = last_ ? (bf16_t*)WSP(A_RV) : (bf16_t*)(a.ws + WS_VF); (void)wm; (void)wr_; (void)wf; (void)Vb;
            { MapRw1 S{(const char*)WSP(A_AX), (const char*)wr_, (const char*)(wr_ + E_B1), (const char*)(wr_ + E_B1 + E_B2), G};
            EpiBf<FRw1> E{{(bf16_t*)WSP(A_L1), (bf16_t*)WSP(A_RR), (bf16_t*)WSP(A_RK), Vb}};
            pg8::gemm_phase(lds, 5120, LDB1, S, E, G, c); } }
        SEAM(pb + 11);
        if (CT(12) && IN(pb + 12)) REPS(12) { PHB const bf16_t* wm = wmla(a, jj_); const bf16_t* wr_ = wrwkv(a, jj_); const bf16_t* wf = wffn(a, jj_); bf16_t* Vb = last_ ? (bf16_t*)WSP(A_RV) : (bf16_t*)(a.ws + WS_VF); (void)wm; (void)wr_; (void)wf; (void)Vb;
            { int nt4 = 4; asm volatile("" : "+s"(nt4));
            MapRw2 S{(const char*)WSP(A_L1), (const char*)(wr_ + E_B1 + E_B2 + E_L1), (const char*)(wr_ + E_B1 + E_B2 + E_L1 + E_L2A), 0, last ? 24 : 20, nt4};
            EpiRw2 E{(bf16_t*)WSP(A_WL0), (bf16_t*)WSP(A_VL), a.in[I_W0] + (size_t)jj * 2 * D, a.in[I_A0] + (size_t)jj * 2 * D}; pg8::gemm_phase(lds, 512, 256, S, E, G, c); } }
        SEAM(pb + 12);
        if (CT(13) && IN(pb + 13)) REPS(13) { PHB const bf16_t* wm = wmla(a, jj_); const bf16_t* wr_ = wrwkv(a, jj_); const bf16_t* wf = wffn(a, jj_); bf16_t* Vb = last_ ? (bf16_t*)WSP(A_RV) : (bf16_t*)(a.ws + WS_VF); (void)wm; (void)wr_; (void)wf; (void)Vb;
            { if (SCAN_CHUNKED) scan_chunked(a, jj, Vb, last, lds, G, c); if (!SCAN_CHUNKED || CS_BOTH) { __syncthreads(); scan_phase(a, jj, Vb, last, lds, G, c); }
              if (SCAN_CHUNKED && CS_BOTH) scan_compare(a, lds, G, c); } }
        SEAM(pb + 13);
        if (CT(14) && IN(pb + 14)) REPS(14) { PHB const bf16_t* wm = wmla(a, jj_); const bf16_t* wr_ = wrwkv(a, jj_); const bf16_t* wf = wffn(a, jj_); bf16_t* Vb = last_ ? (bf16_t*)WSP(A_RV) : (bf16_t*)(a.ws + WS_VF); (void)wm; (void)wr_; (void)wf; (void)Vb;
            rwkv_outprep(a, jj, Vb, last, G, c); }
        SEAM(pb + 14);
        if (CT(15) && IN(pb + 15)) REPS(15) { PHB const bf16_t* wm = wmla(a, jj_); const bf16_t* wr_ = wrwkv(a, jj_); const bf16_t* wf = wffn(a, jj_); bf16_t* Vb = last_ ? (bf16_t*)WSP(A_RV) : (bf16_t*)(a.ws + WS_VF); (void)wm; (void)wr_; (void)wf; (void)Vb;
            { MapSimple S{(const char*)WSP(A_RO), (const char*)(wr_ + E_B1 + E_B2 + E_L1 + E_L2A + E_L2B), P1K, P1K, 4, 16, last ? 1 : 0}; EpiResid E{(float*)(a.ws + WS_CS), a.out, (const float*)(a.ws + WS_MODS), lr, 2, (const float*)(a.ws + WS_CS), (const float*)a.out};
            pg8::gemm_phase(lds, 1024, 1024, S, E, G, c); } }
        SEAM(pb + 15);
        if (CT(16) && IN(pb + 16)) REPS(16) { PHB const bf16_t* wm = wmla(a, jj_); const bf16_t* wr_ = wrwkv(a, jj_); const bf16_t* wf = wffn(a, jj_); bf16_t* Vb = last_ ? (bf16_t*)WSP(A_RV) : (bf16_t*)(a.ws + WS_VF); (void)wm; (void)wr_; (void)wf; (void)Vb;
            { norm_router(a, lr, jj, last, lds, G, c); run_prep(a, lds + TILE_OFF, jj, CS_NOTILE ? 0 : (SCAN_CHUNKED ? cs::NCK - 1 : scan::NCH - 2), G, c);   } }
        SEAM(pb + 16);
        if (CT(17) && IN(pb + 17)) REPS(17) { PHB const bf16_t* wm = wmla(a, jj_); const bf16_t* wr_ = wrwkv(a, jj_); const bf16_t* wf = wffn(a, jj_); bf16_t* Vb = last_ ? (bf16_t*)WSP(A_RV) : (bf16_t*)(a.ws + WS_VF); (void)wm; (void)wr_; (void)wf; (void)Vb;
            moe_gather(a, lds, G, c); }
        SEAM(pb + 17);
        if (CT(18) && IN(pb + 18)) REPS(18) { PHB const bf16_t* wm = wmla(a, jj_); const bf16_t* wr_ = wrwkv(a, jj_); const bf16_t* wf = wffn(a, jj_); bf16_t* Vb = last_ ? (bf16_t*)WSP(A_RV) : (bf16_t*)(a.ws + WS_VF); (void)wm; (void)wr_; (void)wf; (void)Vb;
            { MapMoe S{(const char*)WSP(A_HS), (const char*)WSP(A_WM13), P1K, E_M13 * 2, P1K, 28, 16, (const int*)(a.ws + WS_META)}; EpiSwiGLU E{(bf16_t*)WSP(A_MHID), DFE};
            pg8::gemm_phase(lds, 1024, 1024, S, E, G, c); } }
        SEAM(pb + 18);
        if (CT(19) && IN(pb + 19)) REPS(19) { PHB const bf16_t* wm = wmla(a, jj_); const bf16_t* wr_ = wrwkv(a, jj_); const bf16_t* wf = wffn(a, jj_); bf16_t* Vb = last_ ? (bf16_t*)WSP(A_RV) : (bf16_t*)(a.ws + WS_VF); (void)wm; (void)wr_; (void)wf; (void)Vb;
            { MapMoeDown S{(const char*)WSP(A_MHID), (const char*)WSP(A_WM2), (size_t)256 * DFE * 2, E_M2 * 2, (size_t)256 * DFE * 2, (const int*)(a.ws + WS_META)}; EpiBf<FPlainAux> E{{(bf16_t*)WSP(A_Y2), 1024}};
            pg8::gemm_phase(lds, DFE, DFE, S, E, G, c); } }
        SEAM(pb + 19);
    }
    { const int jj_ = 1; const bool last_ = true;
    if (CT(21) && IN(41)) REPS(21) { PHB const bf16_t* wm = wmla(a, jj_); const bf16_t* wr_ = wrwkv(a, jj_); const bf16_t* wf = wffn(a, jj_); bf16_t* Vb = last_ ? (bf16_t*)WSP(A_RV) : (bf16_t*)(a.ws + WS_VF); (void)wm; (void)wr_; (void)wf; (void)Vb;
            combine_rows<false>(a, 3, 0, nullptr, 0, nullptr, G, c); }
    }
#undef IN
#undef SEAM
}

typedef void (*KernFn)(Args);
#if MK_ONE_LAUNCH
#ifndef PMASK
#define PMASK 0x3fffffu
#endif
static KernFn kern_of(int) { return fwd<PMASK>; }
#else
static KernFn kern_of(int p) {
    static const KernFn tab[22] = { fwd<1u << 0>, fwd<1u << 1>, fwd<1u << 2>, fwd<1u << 3>, fwd<1u << 4>, fwd<1u << 5>, fwd<1u << 6>, fwd<1u << 7>, fwd<1u << 8>, fwd<1u << 9>, fwd<1u << 10>, fwd<1u << 11>, fwd<1u << 12>, fwd<1u << 13>, fwd<1u << 14>, fwd<1u << 15>, fwd<1u << 16>, fwd<1u << 17>, fwd<1u << 18>, fwd<1u << 19>, fwd<1u << 20>, fwd<1u << 21> };
    return tab[p == 0 ? 20 : (p == NPH - 1 ? 21 : (p - 1) % 20)];
}
#endif
extern "C" void kernel_launch(void* const* d_in, const int* in_sizes, int n_in, void* d_out, int out_size, void* d_ws, size_t ws_size, hipStream_t stream) {
    static int grid = 0;
    if (grid == 0) {
        if (n_in != N_IN || out_size != NB * SEQ * D || ws_size < WS_NEED) { fprintf(stderr, "kernel_launch: unexpected shapes: n_in %d out %d ws %zu (need %zu)\n", n_in, out_size, ws_size, (size_t)WS_NEED); grid = -1; return; }
        int dev = 0, cus = 0;
        if (hipGetDevice(&dev) != hipSuccess || hipDeviceGetAttribute(&cus, hipDeviceAttributeMultiprocessorCount, dev) != hipSuccess) { grid = -1; return; }
        for (int p = 0; p < NPH; ++p)
            if (hipFuncSetAttribute((const void*)kern_of(p), hipFuncAttributeMaxDynamicSharedMemorySize, LDS_BYTES) != hipSuccess) { fprintf(stderr, "kernel_launch: hipFuncSetAttribute failed\n"); grid = -1; return; }
        int per_cu = 0;
        if (hipOccupancyMaxActiveBlocksPerMultiprocessor(&per_cu, (const void*)kern_of(1), NTHR, LDS_BYTES) != hipSuccess || per_cu < 1) { fprintf(stderr, "kernel_launch: occupancy query says %d blocks per CU\n", per_cu); (void)hipGetLastError(); }
        grid = cus < 256 ? cus : 256;
    }
    if (grid < 0) return;
    (void)in_sizes;
    (void)hipMemsetAsync((char*)d_ws + WS_CTL, 0, CTL_BYTES, stream);
    Args a{};
    for (int i = 0; i < N_IN; ++i) a.in[i] = (const float*)d_in[i];
    a.out = (float*)d_out; a.ws = (unsigned char*)d_ws;
#if MK_ONE_LAUNCH
    a.ph_lo = 0; a.ph_hi = NPH;
    hipLaunchKernelGGL(kern_of(0), dim3(grid), dim3(NTHR), LDS_BYTES, stream, a);
#else
    for (int p = 0; p < NPH; ++p) { a.ph_lo = p; a.ph_hi = p + 1; hipLaunchKernelGGL(kern_of(p), dim3(grid), dim3(NTHR), LDS_BYTES, stream, a); }
#endif
    const hipError_t le = hipPeekAtLastError();
    if (le != hipSuccess) fprintf(stderr, "kernel_launch: launch failed: %s\n", hipGetErrorName(le));
}
```

```cpp
#include <hip/hip_runtime.h>
#include <cstdio>
#include <cstdint>
#ifndef SCAN_CHUNKED
#define SCAN_CHUNKED 1
#endif
#ifndef CS_SERIAL
#define CS_SERIAL 0
#endif
#ifndef CS_BOTH
#define CS_BOTH 0
#endif
#ifndef CS_NOTILE
#define CS_NOTILE 0
#endif
#ifndef CS_OOP
#define CS_OOP 0
#endif
#ifndef CS_TOL
#define CS_TOL 0.05f
#endif

#ifndef MK_ONE_LAUNCH
#define MK_ONE_LAUNCH 1
#endif

#define LAS __attribute__((address_space(3)))
typedef unsigned short bf16_t;
typedef short bf16x8 __attribute__((ext_vector_type(8)));
typedef short s16x4 __attribute__((ext_vector_type(4)));
typedef float f32x2 __attribute__((ext_vector_type(2)));
typedef float f32x4 __attribute__((ext_vector_type(4)));
typedef float f32x16 __attribute__((ext_vector_type(16)));
typedef unsigned u32x2 __attribute__((ext_vector_type(2)));
typedef unsigned u32x4 __attribute__((ext_vector_type(4)));

constexpr int D = 1024, NB = 8, SEQ = 4096, CTX = 256, SEG = SEQ + CTX, R = NB * SEG;
constexpr int NPAN = R / 256;
constexpr int NTHR = 512, NWAVE = 8;
constexpr int QL = 384, KVL = 256, ROPE = 64, NOPE = 128, QKH = 192, VH = 128, NH = 8;
constexpr int DFF = 2816, NE = 8, DFE = 3584;
constexpr int MP_MAX = 71680;
constexpr float NORM_EPS = 1e-6f, LNX_EPS = 64e-5f;
constexpr float QSCALE = 0.07216878364870322f * 1.4426950408889634f;

enum { I_X = 0, I_C, I_CTX, I_CCTX, I_ADAW, I_ADAB, I_N1G, I_N2G, I_WQA, I_QAN, I_WQB, I_WKVA, I_KVAN, I_WKVB, I_QN, I_KN, I_MWO,
       I_MIX, I_WR, I_WK, I_WV, I_RWO, I_W0, I_W1, I_W2, I_A0, I_A1, I_A2, I_G1, I_G2, I_KK, I_KA, I_RK, I_LNW, I_LNB, I_V0, I_V1, I_V2,
       I_F1, I_F3, I_F2, I_ROUTER, I_M1, I_M3, I_M2, N_IN };

constexpr size_t U = (size_t)R * 1024 * 2;
constexpr size_t al256(size_t x) { return (x + 255) / 256 * 256; }
constexpr size_t WS_CTL = 0;
constexpr size_t CTL_BYTES = 65536;
constexpr size_t WS_MODS = WS_CTL + CTL_BYTES;
constexpr size_t WS_ROPE = WS_MODS + al256((size_t)4 * 9 * 6144 * 4);
constexpr size_t WS_CS = WS_ROPE + 8192;
constexpr size_t WS_RS = WS_CS + (size_t)NB * CTX * D * 4;
constexpr size_t WS_ROUTE = WS_RS + al256((size_t)R * 8);
constexpr size_t WS_RSLOT = WS_ROUTE + (size_t)R * 16;
constexpr size_t WS_HIST = WS_RSLOT + (size_t)R * 8;
constexpr size_t WS_META = WS_HIST + 2048 * 8 * 4;
constexpr size_t WS_WSM = WS_META + 256;
constexpr size_t E_QKVA = 768 * 1024, E_QB = 1536 * 384, E_KVB = 2048 * 384, E_MWO = 1024 * 1024, E_MLA = E_QKVA + E_QB + E_KVB + E_MWO;
constexpr int LDB1 = 2048 + 64;
constexpr size_t E_B1 = 1024 * LDB1, E_B2 = 1024 * LDB1, E_L1 = 512 * LDB1, E_L2A = 4096 * 256, E_L2B = 2048 * 256, E_RWO = 1024 * 1024, E_RWKV = E_B1 + E_B2 + E_L1 + E_L2A + E_L2B + E_RWO;
constexpr size_t E_F13 = 5632 * 1024, E_F2 = 1024 * 2816, E_FFN = E_F13 + E_F2;
constexpr size_t WS_WMLA = WS_WSM, WS_WRWKV = WS_WMLA + 2 * E_MLA * 2, WS_WFFN = WS_WRWKV + 2 * E_RWKV * 2;
constexpr size_t WS_VF = WS_WFFN + 2 * E_FFN * 2;
constexpr size_t WS_ARENA = WS_VF + U;
constexpr size_t A_H = 0;
constexpr int LDKV = 2048 + 64;
constexpr size_t A_QKVA = U, A_Q = 2 * U, A_KV = 2 * U + U * 3 / 2, A_K = A_KV + al256((size_t)R * LDKV * 2), A_O = A_K + U * 3 / 2;
constexpr size_t A_FHID = U;
constexpr size_t A_AX = 0, A_L1 = 5 * U, A_RR = A_L1 + U / 2, A_RK = A_RR + U, A_RV = A_RK + U, A_VL = A_RV + U, A_REND = A_VL + U;
constexpr size_t A_WL0 = 0, A_WL1 = U, A_AL0 = 2 * U, A_AL1 = 3 * U, A_G = 4 * U, A_RO = 0;
constexpr size_t A_YF = (SCAN_CHUNKED && CS_OOP && !CS_BOTH) ? A_REND : A_WL0, A_YR = (SCAN_CHUNKED && CS_OOP && !CS_BOTH) ? A_REND + U : A_WL1;
constexpr size_t A_YCF = CS_BOTH ? A_REND : A_YF, A_YCR = CS_BOTH ? A_REND + U : A_YR;
constexpr size_t A_HS = U, A_Y2 = U, A_MHID = A_HS + (size_t)MP_MAX * 1024 * 2, A_MEND = A_MHID + (size_t)MP_MAX * DFE * 2;
constexpr size_t E_M13 = (size_t)7168 * 1024, E_M2 = (size_t)1024 * 3584;
constexpr size_t A_WM13 = A_MEND, A_WM2 = A_WM13 + NE * E_M13 * 2, A_END = A_WM2 + NE * E_M2 * 2;
constexpr size_t WS_NEED = WS_ARENA + (A_END > A_REND ? A_END : A_REND);
static_assert(WS_NEED <= 1081188352ull, "workspace budget (sum of inputs)");
static_assert(CS_OOP || CS_BOTH || A_WM13 >= A_REND, "the MoE weight region must be free during the RWKV mixer (weights are converted inside the scan phase)");

struct Args { const float* in[N_IN]; float* out; unsigned char* ws; int ph_lo, ph_hi; };

__device__ __forceinline__ unsigned cvt_pk_bf16(float lo, float hi) { unsigned r; asm("v_cvt_pk_bf16_f32 %0, %1, %2" : "=v"(r) : "v"(lo), "v"(hi)); return r; }
__device__ __forceinline__ float bflo(unsigned w) { return __uint_as_float(w << 16); }
__device__ __forceinline__ float bfhi(unsigned w) { return __uint_as_float(w & 0xffff0000u); }
__device__ __forceinline__ void unpack8(const u32x4 w, float (&f)[8]) { f[0] = bflo(w.x); f[1] = bfhi(w.x); f[2] = bflo(w.y); f[3] = bfhi(w.y); f[4] = bflo(w.z); f[5] = bfhi(w.z); f[6] = bflo(w.w); f[7] = bfhi(w.w); }
__device__ __forceinline__ u32x4 pack8(const float (&f)[8]) { u32x4 w; w.x = cvt_pk_bf16(f[0], f[1]); w.y = cvt_pk_bf16(f[2], f[3]); w.z = cvt_pk_bf16(f[4], f[5]); w.w = cvt_pk_bf16(f[6], f[7]); return w; }
__device__ __forceinline__ float wave_sum(float v) {
#pragma unroll
    for (int o = 32; o >= 1; o >>= 1) v += __shfl_xor(v, o);
    return v;
}
template <int CTRL> __device__ __forceinline__ float dpp_f(float v) { return __int_as_float(__builtin_amdgcn_update_dpp(0, __float_as_int(v), CTRL, 0xF, 0xF, true)); }
__device__ __forceinline__ float red8(float v) { v += dpp_f<0xB1>(v); v += dpp_f<0x4E>(v); v += dpp_f<0x141>(v); return v; }
__device__ __forceinline__ int ltid() { int t = threadIdx.x; asm volatile("" : "+v"(t)); return t; }
template <class T> __device__ __forceinline__ T launder_s(T x) { asm volatile("" : "+s"(x)); return x; }
__device__ __forceinline__ Args launder_args(const Args& k) { Args a = k; a.ws = launder_s(k.ws); a.out = launder_s(k.out); return a; }
__device__ __forceinline__ float wave_sum_dpp(float v) {
    v += dpp_f<0xB1>(v); v += dpp_f<0x4E>(v); v += dpp_f<0x141>(v); v += dpp_f<0x140>(v);
    const int iv = __float_as_int(v);
    return (__int_as_float(__builtin_amdgcn_readlane(iv, 0)) + __int_as_float(__builtin_amdgcn_readlane(iv, 16))) + (__int_as_float(__builtin_amdgcn_readlane(iv, 32)) + __int_as_float(__builtin_amdgcn_readlane(iv, 48)));
}
__device__ __forceinline__ float sigmoidf_(float x) { return __builtin_amdgcn_rcpf(1.0f + __expf(-x)); }
__device__ __forceinline__ float* xrow(const Args& a, int row) {
    const int b = row / SEG, r = row - b * SEG;
    return r < CTX ? (float*)(a.ws + WS_CS) + (size_t)(b * CTX + r) * D : a.out + (size_t)(b * SEQ + r - CTX) * D;
}
__device__ __forceinline__ const float* xrow_in(const Args& a, int row) {
    const int b = row / SEG, r = row - b * SEG;
    return r < CTX ? a.in[I_CTX] + (size_t)(b * CTX + r) * D : a.in[I_X] + (size_t)(b * SEQ + r - CTX) * D;
}
__device__ __forceinline__ int mod_index(int row) { const int b = row / SEG, r = row - b * SEG; return r < CTX ? 8 : b; }
__device__ __forceinline__ const float* mods_ptr(const Args& a, int layer, int mi, int which) { return (const float*)(a.ws + WS_MODS) + ((size_t)(layer * 9 + mi) * 6 + which) * 1024; }

#define XB_TMO      128
#define XB_XCNT(j)  (256  + 64 * (j))
#define XB_XSUB(j)  (1280 + 64 * (j))
#define XB_XGEN(j)  (2304 + 64 * (j))
#define XB_TOP      3328
#define XB_TOPGEN   3392
#define XCD_BAR_WORDS 3456
#define XB_SPIN_CAP (1u << 22)
__device__ __forceinline__ unsigned xb_ld(unsigned* p)              { return __hip_atomic_load(p, __ATOMIC_RELAXED, __HIP_MEMORY_SCOPE_AGENT); }
__device__ __forceinline__ unsigned xb_add(unsigned* p, unsigned v) { return __hip_atomic_fetch_add(p, v, __ATOMIC_RELAXED, __HIP_MEMORY_SCOPE_AGENT); }
__device__ __forceinline__ unsigned xb_xcc_id() { return (unsigned)__builtin_amdgcn_s_getreg((3 << 11) | 20) & 0xFu; }
#define XB_SPIN(cond, bar) do { unsigned _sp = 0; while (cond) { __builtin_amdgcn_s_sleep(1); \
    if ((++_sp & 255u) == 0u) { if (xb_ld(&(bar)[XB_TMO])) break; if (_sp > XB_SPIN_CAP) { atomicAdd(&(bar)[XB_TMO], 1u); break; } } } } while (0)
struct XcdBarrier { unsigned* bar; unsigned x; volatile LAS unsigned* st; };
__device__ __forceinline__ XcdBarrier xcd_barrier_post(unsigned* bar, volatile LAS unsigned* st) {
    XcdBarrier b; b.bar = bar; b.x = xb_xcc_id(); b.st = st;
    if (threadIdx.x == 0) (void)xb_add(&bar[XB_XCNT(b.x)], 1u);
    return b;
}
__device__ __forceinline__ void xcd_barrier_complete(unsigned* bar, unsigned x, unsigned& nloc, unsigned& nx) {
    const unsigned G = gridDim.x * gridDim.y * gridDim.z;
    unsigned sum, cnt, mine, sp = 0u;
    for (;;) {
        sum = 0u; cnt = 0u; mine = 0u;
#pragma unroll
        for (unsigned j = 0; j < 16; ++j) { const unsigned c = xb_ld(&bar[XB_XCNT(j)]); sum += c; cnt += (c > 0u) ? 1u : 0u; mine = (j == x) ? c : mine; }
        if (sum == G) break;
        __builtin_amdgcn_s_sleep(1);
        if ((++sp & 255u) == 0u) { if (xb_ld(&bar[XB_TMO])) break; if (sp > XB_SPIN_CAP) { atomicAdd(&bar[XB_TMO], 1u); break; } }
    }
    nloc = mine > 0u ? mine : 1u; nx = cnt > 0u ? cnt : 1u;
}
__device__ __forceinline__ void xcd_barrier(const XcdBarrier& b) {
    asm volatile("s_waitcnt vmcnt(0)" ::: "memory");
    __syncthreads();
    if (threadIdx.x == 0) {
        unsigned* bar = b.bar;
        __builtin_amdgcn_s_waitcnt(0);
        unsigned nloc = b.st[0], nx = b.st[1];
        if (nloc == 0u) { xcd_barrier_complete(bar, b.x, nloc, nx); b.st[0] = nloc; b.st[1] = nx; }
        const unsigned old = xb_add(&bar[XB_XSUB(b.x)], 1u);
        const unsigned gen = old / nloc;
        if (old + 1u == (gen + 1u) * nloc) {
            __builtin_amdgcn_fence(__ATOMIC_RELEASE, "agent");
            asm volatile("s_waitcnt vmcnt(0)" ::: "memory");
            const unsigned og = xb_add(&bar[XB_TOP], 1u);
            const unsigned tg = og / nx;
            if (og + 1u == (tg + 1u) * nx) xb_add(&bar[XB_TOPGEN], 1u);
            else XB_SPIN(xb_ld(&bar[XB_TOPGEN]) == tg, bar);
            __builtin_amdgcn_fence(__ATOMIC_ACQUIRE, "agent");
            xb_add(&bar[XB_XGEN(b.x)], 1u);
            asm volatile("s_waitcnt vmcnt(0)" ::: "memory");
        } else {
            XB_SPIN(xb_ld(&bar[XB_XGEN(b.x)]) == gen, bar);
            __builtin_amdgcn_fence(__ATOMIC_ACQUIRE, "agent");
            asm volatile("s_waitcnt vmcnt(0)" ::: "memory");
        }
    }
    __syncthreads();
}

namespace pg8 {
constexpr int BM = 256, BK = 64, HALF = 128, HTB = HALF * BK * 2, STAGE_BYTES = 8 * HTB;
__device__ __forceinline__ int lds_byte(int r, int c) { const int st = (r >> 4) * 2 + (c >> 5), rr = r & 15, cc = c & 31, ob = rr * 64 + cc * 2; return st * 1024 + (ob ^ (((ob >> 9) & 1) << 5)); }
__device__ __forceinline__ void stage_rc(int b, int& Rr, int& C) { const int st = b / 1024, sb = b % 1024, swz = sb ^ (((sb >> 9) & 1) << 5); Rr = (st >> 1) * 16 + swz / 64; C = (st & 1) * 32 + (swz % 64) / 2; }
__device__ __forceinline__ int perm32(int rho) { const int n = rho >> 4, i = rho & 15; return 8 * (i >> 2) + 4 * n + (i & 3); }
struct GUnit { const char* A; const char* B; int nt, pm, pn, aux; };
__device__ __forceinline__ void tile_order(int L, int nM, int nN, int& pm, int& pn) {
    const int nwg = nM * nN; int wgid = L;
    { const int q = nwg / 8, r = nwg % 8, xcd = wgid % 8, off = wgid / 8; wgid = (xcd < r ? xcd * (q + 1) : r * (q + 1) + (xcd - r) * q) + off; }
    const int nig = 8 * nN, gid = wgid / nig, fm = gid * 8, gsz = (nM - fm) < 8 ? (nM - fm) : 8;
    pm = fm + ((wgid % nig) % gsz); pn = (wgid % nig) / gsz;
}
template <class Epi, class Map>
__device__ __forceinline__ void gemm_phase(LAS unsigned char* lds, const int lda, const int ldb, const Map& S, const Epi& E, const int G, const int c) {
    const int tid = ltid(), wid = __builtin_amdgcn_readfirstlane(tid >> 6), lane = tid & 63, wr = wid >> 2, wc = wid & 3, fr = lane & 15, fq = lane >> 4;
    unsigned voffA[2], voffB[2];
#pragma unroll
    for (int i = 0; i < 2; ++i) { int Rr, C; stage_rc(tid * 16 + i * 8192, Rr, C); const int Rb = Epi::PERM ? ((Rr & ~31) + perm32(Rr & 31)) : Rr;
        voffA[i] = (unsigned)(Rr * lda + C) * 2u; voffB[i] = (unsigned)(Rb * ldb + C) * 2u; }
    const size_t kstep = (size_t)(BK * 2);
    const size_t hA = (size_t)HALF * lda * 2, hB = (size_t)HALF * ldb * 2;
    const unsigned ldsw = (unsigned)wid * 1024u;
    const int aoff = lds_byte(wr * 64 + fr, fq * 8), boff = lds_byte(wc * 32 + fr, fq * 8);
#define PG8_SA(b, h) (((b) * 2 + (h)) * HTB)
#define PG8_SB(b, h) ((4 + (b) * 2 + (h)) * HTB)
#define PG8_STAGE(bufoff, gbase, voff) do { _Pragma("unroll") for (int _i = 0; _i < 2; ++_i) \
        __builtin_amdgcn_global_load_lds((const unsigned*)((const char*)(gbase) + (voff)[_i]), (LAS unsigned*)(lds + (bufoff) + ldsw + _i * 8192), 16, 0, 0); } while (0)
#define PG8_LDA(dst, b, h) do { _Pragma("unroll") for (int m = 0; m < 4; ++m) _Pragma("unroll") for (int k = 0; k < 2; ++k) dst[m][k] = *(const LAS bf16x8*)(lds + PG8_SA(b, h) + aoff + m * 2048 + k * 1024); } while (0)
#define PG8_LDB(dst, b, h) do { _Pragma("unroll") for (int n = 0; n < 2; ++n) _Pragma("unroll") for (int k = 0; k < 2; ++k) dst[n][k] = *(const LAS bf16x8*)(lds + PG8_SB(b, h) + boff + n * 2048 + k * 1024); } while (0)
#define PG8_MMA(ai, bj, At, Bt) do { __builtin_amdgcn_s_setprio(1); _Pragma("unroll") for (int m = 0; m < 4; ++m) _Pragma("unroll") for (int n = 0; n < 2; ++n) _Pragma("unroll") for (int k = 0; k < 2; ++k) \
        acc[ai][bj][m][n] = __builtin_amdgcn_mfma_f32_16x16x32_bf16(Bt[n][k], At[m][k], acc[ai][bj][m][n], 0, 0, 0); __builtin_amdgcn_s_setprio(0); } while (0)
#define PG8_WAIT_V(n) asm volatile("s_waitcnt vmcnt(" #n ")" ::: "memory")
#define PG8_WAIT_L(n) asm volatile("s_waitcnt lgkmcnt(" #n ")" ::: "memory")
#define PG8_BAR __builtin_amdgcn_s_barrier()
#define PG8_SCHED __builtin_amdgcn_sched_barrier(0)
    GUnit cur, nxt; int ui = 0;
    if (!S(c, cur)) return;
    f32x4 acc[2][2][4][2];
#pragma unroll
    for (int a = 0; a < 2; ++a)
#pragma unroll
        for (int b = 0; b < 2; ++b)
#pragma unroll
            for (int m = 0; m < 4; ++m)
#pragma unroll
                for (int n = 0; n < 2; ++n) acc[a][b][m][n] = (f32x4){0.f, 0.f, 0.f, 0.f};
    bf16x8 At[4][2], B0[2][2], B1[2][2];
    const char* cA = cur.A; const char* cB = cur.B;
    PG8_STAGE(PG8_SB(0, 0), cB, voffB); PG8_STAGE(PG8_SB(0, 1), cB + hB, voffB); PG8_STAGE(PG8_SA(0, 0), cA, voffA); PG8_STAGE(PG8_SA(0, 1), cA + hA, voffA);
    if (wr == 1) PG8_BAR;
    PG8_WAIT_V(2); PG8_BAR;
    PG8_STAGE(PG8_SB(1, 0), cB + kstep, voffB); PG8_STAGE(PG8_SA(1, 0), cA + kstep, voffA); PG8_STAGE(PG8_SB(1, 1), cB + hB + kstep, voffB);
    PG8_WAIT_V(6); PG8_BAR;
    for (;;) {
        const bool has_next = S((ui + 1) * G + c, nxt);
        const char* nA = has_next ? nxt.A : cA; const char* nB = has_next ? nxt.B : cB;
        const int nt = cur.nt;
        for (int t = 0; t < nt; t += 2) {
            const bool last = (t == nt - 2);
            const char* a1 = cA + (size_t)(t + 1) * kstep;
            const char* a2 = last ? nA : cA + (size_t)(t + 2) * kstep; const char* b2 = last ? nB : cB + (size_t)(t + 2) * kstep;
            const char* a3 = a2 + kstep; const char* b3 = b2 + kstep;
            PG8_LDB(B0, 0, 0); PG8_LDB(B1, 0, 1); PG8_SCHED; PG8_LDA(At, 0, 0); PG8_STAGE(PG8_SA(1, 1), a1 + hA, voffA);
            PG8_WAIT_V(8); PG8_WAIT_L(0); PG8_BAR; PG8_MMA(0, 0, At, B0); PG8_MMA(0, 1, At, B1); PG8_BAR; PG8_SCHED;
            PG8_LDA(At, 0, 1); PG8_STAGE(PG8_SB(0, 0), b2, voffB); PG8_STAGE(PG8_SB(0, 1), b2 + hB, voffB); PG8_STAGE(PG8_SA(0, 0), a2, voffA);
            PG8_WAIT_V(8); PG8_WAIT_L(0); PG8_BAR; PG8_MMA(1, 0, At, B0); PG8_MMA(1, 1, At, B1); PG8_BAR; PG8_SCHED;
            PG8_LDB(B0, 1, 0); PG8_LDB(B1, 1, 1); PG8_SCHED; PG8_LDA(At, 1, 0); PG8_STAGE(PG8_SA(0, 1), a2 + hA, voffA);
            PG8_WAIT_V(8); PG8_WAIT_L(0); PG8_BAR; PG8_MMA(0, 0, At, B0); PG8_MMA(0, 1, At, B1); PG8_BAR; PG8_SCHED;
            PG8_LDA(At, 1, 1); PG8_STAGE(PG8_SB(1, 0), b3, voffB); PG8_STAGE(PG8_SB(1, 1), b3 + hB, voffB); PG8_STAGE(PG8_SA(1, 0), a3, voffA);
            PG8_WAIT_V(8); PG8_WAIT_L(0); PG8_BAR; PG8_MMA(1, 0, At, B0); PG8_MMA(1, 1, At, B1); PG8_BAR; PG8_SCHED;
        }
        if (wr == 0) PG8_BAR;
        E(acc, cur, wr, wc, fr, fq);
        if (!has_next) break;
#pragma unroll
        for (int a = 0; a < 2; ++a)
#pragma unroll
            for (int b = 0; b < 2; ++b)
#pragma unroll
                for (int m = 0; m < 4; ++m)
#pragma unroll
                    for (int n = 0; n < 2; ++n) acc[a][b][m][n] = (f32x4){0.f, 0.f, 0.f, 0.f};
        cur = nxt; cA = nA; cB = nB; ++ui;
        if (wr == 1) PG8_BAR;
    }
    PG8_WAIT_V(0);
    PG8_BAR;
#undef PG8_SA
#undef PG8_SB
#undef PG8_STAGE
#undef PG8_LDA
#undef PG8_LDB
#undef PG8_MMA
#undef PG8_WAIT_V
#undef PG8_WAIT_L
#undef PG8_BAR
#undef PG8_SCHED
}
}

using pg8::GUnit;
typedef f32x4 Acc[2][2][4][2];
template <class F> struct EpiBf {
    static constexpr bool PERM = true;
    F f;
    __device__ __forceinline__ void operator()(const Acc& acc, const GUnit& u, int wr, int wc, int fr, int fq) const {
#pragma unroll
        for (int ai = 0; ai < 2; ++ai)
#pragma unroll
            for (int m = 0; m < 4; ++m) { const int trow = ai * 128 + wr * 64 + m * 16 + fr;
#pragma unroll
                for (int bj = 0; bj < 2; ++bj) f(acc[ai][bj][m][0], acc[ai][bj][m][1], u, trow, bj * 128 + wc * 32 + 8 * fq); }
    }
};
__device__ __forceinline__ void st8(bf16_t* p, f32x4 v0, f32x4 v1) { u32x4 w; w.x = cvt_pk_bf16(v0[0], v0[1]); w.y = cvt_pk_bf16(v0[2], v0[3]); w.z = cvt_pk_bf16(v1[0], v1[1]); w.w = cvt_pk_bf16(v1[2], v1[3]); *(u32x4*)p = w; }

struct FPlain { bf16_t* O; int ldc;
    __device__ __forceinline__ void operator()(f32x4 v0, f32x4 v1, const GUnit& u, int trow, int tcol) const { st8(O + (size_t)(u.pm * 256 + trow) * ldc + u.pn * 256 + tcol, v0, v1); } };
struct FQKV { bf16_t* Q; bf16_t* KV; const float* rsq; const float* rskv;
    __device__ __forceinline__ void operator()(f32x4 v0, f32x4 v1, const GUnit& u, int trow, int tcol) const {
        const int row = u.pm * 256 + trow;
        if (u.aux == 0) { const float s = rsq[row]; st8(Q + (size_t)row * 1536 + u.pn * 256 + tcol, v0 * s, v1 * s); }
        else { const float s = rskv[row]; st8(KV + (size_t)row * LDKV + u.pn * 256 + tcol, v0 * s, v1 * s); } } };
struct EpiQKV {
    static constexpr bool PERM = true;
    bf16_t* Q; bf16_t* KV; const float* rsq; const float* rskv;
    __device__ __forceinline__ void operator()(const Acc& acc, const GUnit& u, int wr, int wc, int fr, int fq) const {
        const float* rs = (u.aux == 0) ? rsq : rskv; bf16_t* O = (u.aux == 0) ? Q : KV; const int ldc = (u.aux == 0) ? 1536 : LDKV;
        float sc[2][4];
#pragma unroll
        for (int ai = 0; ai < 2; ++ai)
#pragma unroll
            for (int m = 0; m < 4; ++m) sc[ai][m] = rs[u.pm * 256 + ai * 128 + wr * 64 + m * 16 + fr];
#pragma unroll
        for (int ai = 0; ai < 2; ++ai)
#pragma unroll
            for (int m = 0; m < 4; ++m) { const int row = u.pm * 256 + ai * 128 + wr * 64 + m * 16 + fr; const float s = sc[ai][m];
#pragma unroll
                for (int bj = 0; bj < 2; ++bj) st8(O + (size_t)row * ldc + u.pn * 256 + bj * 128 + wc * 32 + 8 * fq, acc[ai][bj][m][0] * s, acc[ai][bj][m][1] * s); }
    }
};
struct EpiRw2 {
    static constexpr bool PERM = true;
    bf16_t* base; bf16_t* vl; const float* w0; const float* a0;
    __device__ __forceinline__ void operator()(const Acc& acc, const GUnit& u, int wr, int wc, int fr, int fq) const {
        bf16_t* o = (u.aux < 5) ? base + (size_t)u.aux * ((size_t)R * 1024) : vl;
        const bool act = u.aux < 4; const float scl = (u.aux < 2) ? 0.6065306597126334f : 1.0f;
        f32x4 bv[2][2];
#pragma unroll
        for (int bj = 0; bj < 2; ++bj) { const int col = u.pn * 256 + bj * 128 + wc * 32 + 8 * fq; const float* bp = (u.aux < 2 ? w0 : a0) + (u.aux & 1) * 1024 + col;
            bv[bj][0] = act ? *(const f32x4*)bp : (f32x4){0.f, 0.f, 0.f, 0.f}; bv[bj][1] = act ? *(const f32x4*)(bp + 4) : (f32x4){0.f, 0.f, 0.f, 0.f}; }
#pragma unroll
        for (int ai = 0; ai < 2; ++ai)
#pragma unroll
            for (int m = 0; m < 4; ++m) { const int row = u.pm * 256 + ai * 128 + wr * 64 + m * 16 + fr;
#pragma unroll
                for (int bj = 0; bj < 2; ++bj) { f32x4 v0 = acc[ai][bj][m][0], v1 = acc[ai][bj][m][1];
                    if (act) {
#pragma unroll
                        for (int j = 0; j < 4; ++j) { v0[j] = scl * sigmoidf_(bv[bj][0][j] + v0[j]); v1[j] = scl * sigmoidf_(bv[bj][1][j] + v1[j]); } }
                    st8(o + (size_t)row * 1024 + u.pn * 256 + bj * 128 + wc * 32 + 8 * fq, v0, v1); } }
    }
};
struct FRw1 { bf16_t* L1; bf16_t* RR; bf16_t* RK; bf16_t* RV;
    __device__ __forceinline__ void operator()(f32x4 v0, f32x4 v1, const GUnit& u, int trow, int tcol) const {
        const int row = u.pm * 256 + trow;
        if (u.aux == 0) { const int col = u.pn * 256 + tcol;
            if (col < 128) {
#pragma unroll
                for (int j = 0; j < 4; ++j) { v0[j] = 1.0f - 2.0f * __builtin_amdgcn_rcpf(1.0f + __expf(2.0f * v0[j])); v1[j] = 1.0f - 2.0f * __builtin_amdgcn_rcpf(1.0f + __expf(2.0f * v1[j])); } }
            else if (col >= 320) {
#pragma unroll
                for (int j = 0; j < 4; ++j) { v0[j] = sigmoidf_(v0[j]); v1[j] = sigmoidf_(v1[j]); } }
            st8(L1 + (size_t)row * 512 + col, v0, v1); }
        else { bf16_t* o = u.aux == 1 ? RR : (u.aux == 2 ? RK : RV); st8(o + (size_t)row * 1024 + u.pn * 256 + tcol, v0, v1); } } };
struct FRw2 { bf16_t* base; bf16_t* vl; const float* w0; const float* a0;
    __device__ __forceinline__ void operator()(f32x4 v0, f32x4 v1, const GUnit& u, int trow, int tcol) const {
        const int col = u.pn * 256 + tcol;
        const unsigned off = (unsigned)(u.pm * 256 + trow) * 1024u + (unsigned)col + (u.aux < 5 ? (unsigned)u.aux * (unsigned)(R * 1024) : 0u);
        bf16_t* o = (u.aux < 5) ? base : vl;
        if (u.aux < 4) {
            const float* bp = (u.aux < 2 ? w0 : a0) + (u.aux & 1) * 1024 + col; const f32x4 b0 = *(const f32x4*)bp, b1 = *(const f32x4*)(bp + 4);
            const float sc = (u.aux < 2) ? 0.6065306597126334f : 1.0f;
#pragma unroll
            for (int j = 0; j < 4; ++j) { v0[j] = sc * sigmoidf_(b0[j] + v0[j]); v1[j] = sc * sigmoidf_(b1[j] + v1[j]); } }
        st8(o + off, v0, v1); } };
struct EpiSwiGLU {
    static constexpr bool PERM = true;
    bf16_t* O; int ldc;
    __device__ __forceinline__ void operator()(const Acc& acc, const GUnit& u, int wr, int wc, int fr, int fq) const {
#pragma unroll
        for (int ai = 0; ai < 2; ++ai)
#pragma unroll
            for (int m = 0; m < 4; ++m) { const int trow = ai * 128 + wr * 64 + m * 16 + fr; f32x4 h0, h1;
#pragma unroll
                for (int j = 0; j < 4; ++j) { const float g0 = acc[ai][0][m][0][j], g1 = acc[ai][0][m][1][j];
                    h0[j] = g0 * sigmoidf_(g0) * acc[ai][1][m][0][j]; h1[j] = g1 * sigmoidf_(g1) * acc[ai][1][m][1][j]; }
                st8(O + (size_t)(u.pm * 256 + trow) * ldc + u.pn * 128 + wc * 32 + 8 * fq, h0, h1); }
    }
};
struct EpiResid {
    static constexpr bool PERM = false;
    float* cs; float* out; const float* mods; int layer, which;
    const float* scs; const float* sout;
    __device__ __forceinline__ void operator()(const Acc& acc, const GUnit& u, int wr, int wc, int fr, int fq) const {
        const int b = u.pm / 17, isctx = (u.pm % 17 == 0);
        float* xp = isctx ? cs + (size_t)b * CTX * D : out + (size_t)(b * SEQ + (u.pm % 17 - 1) * 256) * D;
        const float* sp = isctx ? scs + (size_t)b * CTX * D : sout + (size_t)(b * SEQ + (u.pm % 17 - 1) * 256) * D;
        const float* gp = mods + ((size_t)(layer * 9 + (isctx ? 8 : b)) * 6 + which) * 1024;
        const int col0 = u.pn * 256 + wc * 32 + 4 * fq;
        f32x4 gv[2][2];
#pragma unroll
        for (int bj = 0; bj < 2; ++bj)
#pragma unroll
            for (int n = 0; n < 2; ++n) gv[bj][n] = *(const f32x4*)(gp + col0 + bj * 128 + n * 16);
#pragma unroll
        for (int ai = 0; ai < 2; ++ai)
#pragma unroll
            for (int mh = 0; mh < 2; ++mh) {
                f32x4 xv[2][2][2];
#pragma unroll
                for (int mm = 0; mm < 2; ++mm) { const float* srow = sp + (size_t)(ai * 128 + wr * 64 + (mh * 2 + mm) * 16 + fr) * D + col0;
#pragma unroll
                    for (int bj = 0; bj < 2; ++bj)
#pragma unroll
                        for (int n = 0; n < 2; ++n) xv[mm][bj][n] = *(const f32x4*)(srow + bj * 128 + n * 16); }
#pragma unroll
                for (int mm = 0; mm < 2; ++mm) { float* rowp = xp + (size_t)(ai * 128 + wr * 64 + (mh * 2 + mm) * 16 + fr) * D + col0;
#pragma unroll
                    for (int bj = 0; bj < 2; ++bj)
#pragma unroll
                        for (int n = 0; n < 2; ++n) *(f32x4*)(rowp + bj * 128 + n * 16) = xv[mm][bj][n] + gv[bj][n] * acc[ai][bj][mh * 2 + mm][n]; }
                asm volatile("" ::: "memory"); }
    }
};

struct MapSimple {
    const char* A; const char* B; size_t sa, sb; int nN, nt, lat;
    __device__ __forceinline__ bool operator()(int L, GUnit& u) const { const int nM = lat ? 128 : NPAN; if (L >= nM * nN) return false; int q; pg8::tile_order(L, nM, nN, q, u.pn);
        u.pm = lat ? (q / 16) * 17 + 1 + (q % 16) : q;
        u.A = A + (size_t)u.pm * sa; u.B = B + (size_t)u.pn * sb; u.nt = nt; u.aux = 0; return true; }
};
struct MapQKV {
    const char* QKVA; const char* QB; const char* KVB;
    __device__ __forceinline__ bool operator()(int L, GUnit& u) const { if (L >= NPAN * 14) return false; int pn; pg8::tile_order(L, NPAN, 14, u.pm, pn);
        const char* ap = QKVA + (size_t)u.pm * 256 * 768 * 2;
        if (pn < 6) { u.A = ap; u.B = QB + (size_t)pn * 256 * 384 * 2; u.nt = 6; u.pn = pn; u.aux = 0; }
        else { u.A = ap + 384 * 2; u.B = KVB + (size_t)(pn - 6) * 256 * 384 * 2; u.nt = 4; u.pn = pn - 6; u.aux = 1; }
        return true; }
};
struct MapRw1 {
    static constexpr bool KCAT = false;
    const char* AX; const char* B1; const char* B2; const char* L1; int G;
    __device__ __forceinline__ void fill(GUnit& u, int pn) const {
        const char* ap = AX + (size_t)u.pm * 256 * 5120 * 2;
        if (pn < 2) { u.A = ap; u.B = L1 + (size_t)pn * 256 * LDB1 * 2; u.nt = 32; u.pn = pn; u.aux = 0; }
        else if (pn < 6) { u.A = ap + 2048 * 2; u.B = B1 + (size_t)(pn - 2) * 256 * LDB1 * 2; u.nt = 16; u.pn = pn - 2; u.aux = 1; }
        else if (pn < 10) { u.A = ap + 3072 * 2; u.B = B1 + (size_t)(pn - 6) * 256 * LDB1 * 2 + 1024 * 2; u.nt = 16; u.pn = pn - 6; u.aux = 2; }
        else { u.A = ap; u.B = B2 + (size_t)(pn - 10) * 256 * LDB1 * 2; u.nt = 16; u.pn = pn - 10; u.aux = 3; } }
    __device__ __forceinline__ bool operator()(int L, GUnit& u) const {
        int pn;
        if (G != 256) { if (L >= NPAN * 14) return false; pg8::tile_order(L, NPAN, 14, u.pm, pn); fill(u, pn); return true; }
        const int c = L & 255, i = L >> 8, nl = (c < 16) ? 2 : 1;
        if (i < nl) { pg8::tile_order(c + i * 256, NPAN, 2, u.pm, pn); fill(u, pn); return true; }
        const int k = i - nl; int Ln;
        if (c >= 16) { const int v = c - 16; if (k < 6) Ln = v + k * 240; else if (k == 6 && v < 112) Ln = 1440 + v; else return false; }
        else { if (k < 5) Ln = 1552 + c * 5 + k; else return false; }
        pg8::tile_order(Ln, NPAN, 12, u.pm, pn); fill(u, pn + 2); return true; }
};
struct MapRw2 {
    const char* L1; const char* L2A; const char* L2B; int pn0, nN, nt;
    __device__ __forceinline__ bool operator()(int L, GUnit& u) const { if (L >= NPAN * nN) return false; int pn; pg8::tile_order(L, NPAN, nN, u.pm, pn); pn += pn0;
        const char* ap = L1 + (size_t)u.pm * 256 * 512 * 2; u.nt = nt; u.pn = pn & 3; u.aux = pn >> 2;
        if (pn < 16) { const int koff = (pn < 8) ? 0 : 128 * 2;
            u.A = ap + koff; u.B = L2A + (size_t)pn * 256 * 256 * 2 + koff; u.nt = nt >> 1; }
        else { u.A = ap + 256 * 2; u.B = L2B + (size_t)(pn - 16) * 256 * 256 * 2; if (pn >= 20) u.nt = nt >> 1; }
        return true; }
};
struct MapMoe {
    const char* A; const char* B; size_t sa, sbe, sb; int nN, nt; const int* base;
    __device__ __forceinline__ bool operator()(int L, GUnit& u) const { const int nM = base[8] >> 8; if (L >= nM * nN) return false; pg8::tile_order(L, nM, nN, u.pm, u.pn);
        int e = 0;
#pragma unroll
        for (int j = 1; j < 8; ++j) e += (u.pm * 256 >= base[j]) ? 1 : 0;
        u.A = A + (size_t)u.pm * sa; u.B = B + (size_t)e * sbe + (size_t)u.pn * sb; u.nt = nt; u.aux = e; return true; }
};

struct MoeSplit { int nMf, nT, S; };
__device__ __forceinline__ MoeSplit moe_split(int total_slots) { const int nM = total_slots >> 8; MoeSplit s; s.nMf = (nM >> 6) << 6; s.nT = nM - s.nMf; int S = s.nT > 0 ? 64 / s.nT : 1; S = S > 8 ? 8 : S; s.S = S < 1 ? 1 : S; return s; }
constexpr int XP0 = (int)((A_WM13 - A_Y2) / ((size_t)256 * 1024 * 2));
static_assert((A_WM13 - A_Y2) % ((size_t)256 * 1024 * 2) == 0, "partial-tile panels are addressed relative to Y2");
struct MapMoeDown {
    const char* A; const char* B; size_t sa, sbe, sb; const int* base;
    __device__ __forceinline__ bool operator()(int L, GUnit& u) const { const MoeSplit sp = moe_split(base[8]); const int nfull = sp.nMf * 4;
        int k0 = 0, nt = 56, opan;
        if (L < nfull) { pg8::tile_order(L, sp.nMf, 4, u.pm, u.pn); opan = u.pm; }
        else { const int i = L - nfull, ntu = sp.nT * 4; if (i >= ntu * sp.S) return false;
            const int sl = i / ntu, t = i - sl * ntu; pg8::tile_order(t, sp.nT, 4, u.pm, u.pn); u.pm += sp.nMf;
            const int q = 28 / sp.S, r = 28 - q * sp.S, p0 = sl * q + (sl < r ? sl : r), np = q + (sl < r ? 1 : 0); k0 = p0 * 2; nt = np * 2;
            opan = sl == 0 ? u.pm : XP0 + (sl - 1) * sp.nT + (u.pm - sp.nMf); }
        int e = 0;
#pragma unroll
        for (int j = 1; j < 8; ++j) e += (u.pm * 256 >= base[j]) ? 1 : 0;
        u.A = A + (size_t)u.pm * sa + (size_t)k0 * 128; u.B = B + (size_t)e * sbe + (size_t)u.pn * sb + (size_t)k0 * 128; u.nt = nt; u.aux = opan; return true; }
};
struct FPlainAux { bf16_t* O; int ldc;
    __device__ __forceinline__ void operator()(f32x4 v0, f32x4 v1, const GUnit& u, int trow, int tcol) const { st8(O + (size_t)(u.aux * 256 + trow) * ldc + u.pn * 256 + tcol, v0, v1); } };

struct Job { const float* src; const float* kscale; const float* kscale2; bf16_t* dst; int sld, srcK, srcN, ldd, Nd, Kd, koff, grp, gstride, tn, tile0, pad; };
constexpr int MAXJOB = 96;
#define NOGRP (1 << 30)
struct JobList { LAS Job* jobs; int n, tiles, z; };
__device__ __forceinline__ void addjob(JobList& L, const float* src, int sld, int srcK, int srcN, const float* kscale, bf16_t* dst, int ldd, int Nd, int Kd, int koff, int grp, int gstride, const float* kscale2 = nullptr) {
    LAS Job* j = L.jobs + L.n; j->src = src; j->kscale = kscale; j->kscale2 = kscale2; j->dst = dst; j->sld = sld + L.z; j->srcK = srcK + L.z; j->srcN = srcN + L.z; j->ldd = ldd + L.z; j->Nd = Nd + L.z; j->Kd = Kd + L.z; j->koff = koff + L.z; j->grp = grp + L.z; j->gstride = gstride + L.z;
    const int tn = ((Nd + 63) >> 6) + L.z; j->tn = tn; j->tile0 = L.tiles; L.tiles += tn * (Kd >> 6); L.n += 1;
}
__device__ __forceinline__ bf16_t* wmla(const Args& a, int j) { return (bf16_t*)(a.ws + WS_WMLA) + (size_t)j * E_MLA; }
__device__ __forceinline__ bf16_t* wrwkv(const Args& a, int j) { return (bf16_t*)(a.ws + WS_WRWKV) + (size_t)j * E_RWKV; }
__device__ __forceinline__ bf16_t* wffn(const Args& a, int j) { return (bf16_t*)(a.ws + WS_WFFN) + (size_t)j * E_FFN; }
__device__ __forceinline__ void jobs_small(const Args& a, JobList& L) {
#pragma unroll 1
    for (int j = 0; j < 2; ++j) {
        {
            bf16_t* w = wmla(a, j); bf16_t* qkva = w; bf16_t* qb = w + E_QKVA; bf16_t* kvb = qb + E_QB; bf16_t* wo = kvb + E_KVB;
            addjob(L, a.in[I_WQA] + (size_t)j * D * QL, QL, D, QL, nullptr, qkva, 1024, 384, 1024, 0, NOGRP, 0);
            addjob(L, a.in[I_WKVA] + (size_t)j * D * 320, 320, D, 320, nullptr, qkva + (size_t)384 * 1024, 1024, 384, 1024, 0, NOGRP, 0);
            addjob(L, a.in[I_WQB] + (size_t)j * QL * 1536, 1536, QL, 1536, a.in[I_QAN] + j * QL, qb, 384, 1536, 384, 0, NOGRP, 0);
            addjob(L, a.in[I_WKVB] + (size_t)j * KVL * 2048, 2048, KVL, 2048, a.in[I_KVAN] + j * KVL, kvb, 384, 2048, 256, 0, NOGRP, 0);
            addjob(L, a.in[I_MWO] + (size_t)j * D * D, D, D, D, nullptr, wo, 1024, 1024, 1024, 0, NOGRP, 0);
        }
        {
            bf16_t* w = wrwkv(a, j); bf16_t* b1 = w; bf16_t* b2 = b1 + E_B1; bf16_t* l1 = b2 + E_B2; bf16_t* l2a = l1 + E_L1; bf16_t* l2b = l2a + E_L2A;
            const float* mix = a.in[I_MIX] + (size_t)j * 6 * D;
            addjob(L, a.in[I_WR] + (size_t)j * D * D, D, D, D, nullptr, b1, LDB1, 1024, 1024, 0, NOGRP, 0);
            addjob(L, a.in[I_WK] + (size_t)j * D * D, D, D, D, nullptr, b1 + 1024, LDB1, 1024, 1024, 0, NOGRP, 0);
            addjob(L, a.in[I_WV] + (size_t)j * D * D, D, D, D, nullptr, b2, LDB1, 1024, 1024, 0, NOGRP, 0);
            addjob(L, a.in[I_RWO] + (size_t)j * D * D, D, D, D, nullptr, b2 + E_B2 + E_L1 + E_L2A + E_L2B, 1024, 1024, 1024, 0, NOGRP, 0);
            for (int d = 0; d < 2; ++d) {
                const float* w1 = a.in[I_W1] + (size_t)(j * 2 + d) * D * 64; const float* a1 = a.in[I_A1] + (size_t)(j * 2 + d) * D * 64;
                addjob(L, w1, 64, D, 64, nullptr, l1 + (size_t)(d * 64) * LDB1, LDB1, 64, 1024, 0, NOGRP, 0);
                addjob(L, w1, 64, D, 64, mix + 1 * D, l1 + (size_t)(d * 64) * LDB1 + 1024, LDB1, 64, 1024, 0, NOGRP, 0, mix + 3 * D);
                addjob(L, a1, 64, D, 64, nullptr, l1 + (size_t)(128 + d * 64) * LDB1, LDB1, 64, 1024, 0, NOGRP, 0);
                addjob(L, a1, 64, D, 64, mix + 4 * D, l1 + (size_t)(128 + d * 64) * LDB1 + 1024, LDB1, 64, 1024, 0, NOGRP, 0, mix + 3 * D);
            }
            const float* v1 = (j == 1) ? a.in[I_V1] : nullptr;
            addjob(L, v1, 32, D, 32, nullptr, l1 + (size_t)256 * LDB1, LDB1, 64, 1024, 0, NOGRP, 0);
            addjob(L, nullptr, 32, D, 32, nullptr, l1 + (size_t)256 * LDB1 + 1024, LDB1, 64, 1024, 0, NOGRP, 0);
            addjob(L, a.in[I_G1] + (size_t)j * D * 160, 160, D, 160, nullptr, l1 + (size_t)320 * LDB1, LDB1, 192, 1024, 0, NOGRP, 0);
            addjob(L, a.in[I_G1] + (size_t)j * D * 160, 160, D, 160, mix + 5 * D, l1 + (size_t)320 * LDB1 + 1024, LDB1, 192, 1024, 0, NOGRP, 0, mix + 3 * D);
            for (int d = 0; d < 2; ++d) {
                addjob(L, a.in[I_W2] + (size_t)(j * 2 + d) * 64 * D, D, 64, D, nullptr, l2a + (size_t)(d * 1024) * 256, 256, 1024, 256, d * 64, NOGRP, 0);
                addjob(L, a.in[I_A2] + (size_t)(j * 2 + d) * 64 * D, D, 64, D, nullptr, l2a + (size_t)(2048 + d * 1024) * 256, 256, 1024, 256, 128 + d * 64, NOGRP, 0);
            }
            addjob(L, a.in[I_G2] + (size_t)j * 160 * D, D, 160, D, nullptr, l2b, 256, 1024, 256, 64, NOGRP, 0);
            addjob(L, (j == 1) ? a.in[I_V2] : nullptr, D, 32, D, nullptr, l2b + (size_t)1024 * 256, 256, 1024, 256, 0, NOGRP, 0);
        }
        {
            bf16_t* w = wffn(a, j);
            addjob(L, a.in[I_F1] + (size_t)j * D * DFF, DFF, D, DFF, nullptr, w, 1024, DFF, 1024, 0, 128, 256);
            addjob(L, a.in[I_F3] + (size_t)j * D * DFF, DFF, D, DFF, nullptr, w + (size_t)128 * 1024, 1024, DFF, 1024, 0, 128, 256);
            addjob(L, a.in[I_F2] + (size_t)j * DFF * D, D, DFF, D, nullptr, w + E_F13, DFF, 1024, DFF, 0, NOGRP, 0);
        }
    }
}
__device__ __forceinline__ void jobs_moe(const Args& a, JobList& L, int k) {
    bf16_t* w13 = (bf16_t*)(a.ws + WS_ARENA + A_WM13); bf16_t* w2 = (bf16_t*)(a.ws + WS_ARENA + A_WM2);
#pragma unroll 1
    for (int e = 0; e < NE; ++e) {
        const size_t so = (size_t)(k * NE + e) * D * DFE;
        addjob(L, a.in[I_M1] + so, DFE, D, DFE, nullptr, w13 + (size_t)e * E_M13, 1024, DFE, 1024, 0, 128, 256);
        addjob(L, a.in[I_M3] + so, DFE, D, DFE, nullptr, w13 + (size_t)e * E_M13 + (size_t)128 * 1024, 1024, DFE, 1024, 0, 128, 256);
        addjob(L, a.in[I_M2] + so, D, DFE, D, nullptr, w2 + (size_t)e * E_M2, DFE, 1024, DFE, 0, NOGRP, 0);
    }
}
__device__ __forceinline__ void run_prep(const Args& a, LAS unsigned char* jl, int which  , int j0  , int G, int c) {
    const int tid = ltid();
    LAS Job* jobs = (LAS Job*)jl; LAS int* hdr = (LAS int*)(jl + MAXJOB * sizeof(Job)); LAS float* tile = (LAS float*)(jl + MAXJOB * sizeof(Job) + 64);
    if (tid == 0) { JobList L{jobs, 0, 0, launder_s(0)}; if (which < 0) jobs_small(a, L); else jobs_moe(a, L, which); hdr[0] = L.n + L.z; hdr[1] = L.tiles + L.z; }
    __syncthreads();
    const int nj = hdr[0], ntile = hdr[1];
    const int kl = tid >> 4, nq = (tid & 15) * 4, sn = tid >> 3, sk = (tid & 7) * 8;
    int jcur = 0;
#define PREP_BAR() do { asm volatile("s_waitcnt lgkmcnt(0)" ::: "memory"); __builtin_amdgcn_s_barrier(); asm volatile("" ::: "memory"); } while (0)
    f32x4 vcur[2], vnxt[2];
#define PREP_FETCH(t_, dstv) do { while (jcur + 1 < nj && jobs[jcur + 1].tile0 <= (t_)) ++jcur; const LAS Job* J_ = jobs + jcur; \
        const float* src_ = J_->src; const float* ks_ = J_->kscale; const float* ks2_ = J_->kscale2; const int sld_ = J_->sld, srcK_ = J_->srcK, srcN_ = J_->srcN, koff_ = J_->koff, tn_ = J_->tn, tl_ = (t_) - J_->tile0; \
        const int n0_ = (tl_ % tn_) * 64, k0_ = (tl_ / tn_) * 64; \
        _Pragma("unroll") for (int p = 0; p < 2; ++p) { const int kk = k0_ + kl + 32 * p, ksi = kk - koff_, n = n0_ + nq; f32x4 v = (f32x4){0.f, 0.f, 0.f, 0.f}; \
            if (src_ != nullptr && ksi >= 0 && ksi < srcK_ && n < srcN_) { v = *(const __attribute__((address_space(1))) f32x4*)(src_ + (size_t)ksi * sld_ + n); if (ks_) { float sc_ = *(const __attribute__((address_space(1))) float*)(ks_ + ksi); if (ks2_) sc_ -= *(const __attribute__((address_space(1))) float*)(ks2_ + ksi); v = v * sc_; } } dstv[p] = v; } } while (0)
    int t = c + j0 * G;
    if (t < ntile) PREP_FETCH(t, vcur);
    for (; t < ntile; t += G) {
        const int jthis = jcur;
        if (t + G < ntile) PREP_FETCH(t + G, vnxt);
        const LAS Job* J = jobs + jthis;
        bf16_t* __restrict__ dst = J->dst;
        const int ldd = J->ldd, Nd = J->Nd, grp = J->grp, gstride = J->gstride, tn = J->tn, tl = t - J->tile0;
        const int n0 = (tl % tn) * 64, k0 = (tl / tn) * 64;
#pragma unroll
        for (int p = 0; p < 2; ++p) { LAS float* tp = tile + (kl + 32 * p) * 65 + nq; tp[0] = vcur[p][0]; tp[1] = vcur[p][1]; tp[2] = vcur[p][2]; tp[3] = vcur[p][3]; }
        PREP_BAR();
        { const int n = n0 + sn;
            if (n < Nd) { float f[8];
#pragma unroll
                for (int e = 0; e < 8; ++e) f[e] = tile[(sk + e) * 65 + sn];
                const int dr = (n / grp) * gstride + (n % grp);
                *(__attribute__((address_space(1))) u32x4*)(dst + (size_t)dr * ldd + k0 + sk) = pack8(f); } }
        PREP_BAR();
        vcur[0] = vnxt[0]; vcur[1] = vnxt[1];
    }
#undef PREP_FETCH
#undef PREP_BAR
    asm volatile("s_waitcnt vmcnt(0)" ::: "memory"); __syncthreads();
}

__device__ __forceinline__ void prologue_misc(const Args& a, LAS unsigned char* lds, int G, int c) {
    const int tid = ltid();
    if (c == 0) { float* rt = (float*)(a.ws + WS_ROPE);
      for (int i = tid; i < 1024; i += NTHR) { const int pos = i >> 4, j = i & 15; const double inv = 1.0 / pow(10000.0, (double)j / 16.0), ang = (double)pos * inv; rt[i] = (float)cos(ang); rt[1024 + i] = (float)sin(ang); } }
    LAS float* sc = (LAS float*)lds;
    LAS float* red = (LAS float*)(lds + 49152);
    for (int i = tid; i < 1024 * 12; i += NTHR) { const int k = i / 12, m = i % 12; float v = 0.f;
        if (m < 9) { const float x = (m < 8) ? a.in[I_C][m * D + k] : a.in[I_CCTX][k]; v = x / (1.0f + expf(-x)); } sc[i] = v; }
    __syncthreads();
    const int kq = tid >> 6, col = tid & 63;
    for (int u = c; u < 4 * 96; u += G) {
        const int layer = u / 96, n0 = (u % 96) * 64;
        const float* w = a.in[I_ADAW] + (size_t)layer * D * 6144 + n0 + col;
        float acc[9];
#pragma unroll
        for (int m = 0; m < 9; ++m) acc[m] = 0.f;
        for (int k8 = 0; k8 < 128; k8 += 8) {
            float wv[8];
#pragma unroll
            for (int e = 0; e < 8; ++e) wv[e] = w[(size_t)(kq * 128 + k8 + e) * 6144];
#pragma unroll
            for (int e = 0; e < 8; ++e) { const LAS f32x4* sp = (const LAS f32x4*)(sc + (kq * 128 + k8 + e) * 12); const f32x4 s0 = sp[0], s1 = sp[1], s2 = sp[2];
                acc[0] += s0[0] * wv[e]; acc[1] += s0[1] * wv[e]; acc[2] += s0[2] * wv[e]; acc[3] += s0[3] * wv[e];
                acc[4] += s1[0] * wv[e]; acc[5] += s1[1] * wv[e]; acc[6] += s1[2] * wv[e]; acc[7] += s1[3] * wv[e]; acc[8] += s2[0] * wv[e]; }
        }
#pragma unroll
        for (int m = 0; m < 9; ++m) red[(kq * 9 + m) * 64 + col] = acc[m];
        __syncthreads();
        for (int i = tid; i < 9 * 64; i += NTHR) { const int m = i >> 6, cc = i & 63; float s = 0.f;
#pragma unroll
            for (int q = 0; q < 8; ++q) s += red[(q * 9 + m) * 64 + cc];
            ((float*)(a.ws + WS_MODS))[(size_t)(layer * 9 + m) * 6144 + n0 + cc] = s + a.in[I_ADAB][layer * 6144 + n0 + cc]; }
        __syncthreads();
    }
}

struct RowParams { float A[16], Bv[16]; int mi; };
__device__ __forceinline__ void load_params(const Args& a, RowParams& P, int layer, int mi, const float* gain, int which, int lane) {
    const float* sh = mods_ptr(a, layer, mi, which); const float* scl = mods_ptr(a, layer, mi, which + 1);
#pragma unroll
    for (int j = 0; j < 2; ++j) { const int col = j * 512 + lane * 8;
#pragma unroll
        for (int q = 0; q < 2; ++q) { const f32x4 g = *(const f32x4*)(gain + col + 4 * q), s = *(const f32x4*)(scl + col + 4 * q), t = *(const f32x4*)(sh + col + 4 * q);
#pragma unroll
            for (int e = 0; e < 4; ++e) { P.A[j * 8 + q * 4 + e] = g[e] * (1.0f + s[e]); P.Bv[j * 8 + q * 4 + e] = t[e]; } } }
    P.mi = mi;
}
__device__ __forceinline__ void load_x16(const float* xp, int lane, float (&x)[16]) {
#pragma unroll
    for (int j = 0; j < 2; ++j)
#pragma unroll
        for (int q = 0; q < 2; ++q) { const f32x4 v = *(const f32x4*)(xp + j * 512 + lane * 8 + 4 * q); x[j * 8 + q * 4 + 0] = v[0]; x[j * 8 + q * 4 + 1] = v[1]; x[j * 8 + q * 4 + 2] = v[2]; x[j * 8 + q * 4 + 3] = v[3]; }
}
__device__ __forceinline__ void store_bf16_row(bf16_t* p, int lane, const float (&h)[16]) {
#pragma unroll
    for (int j = 0; j < 2; ++j) { u32x4 w; w.x = cvt_pk_bf16(h[j * 8 + 0], h[j * 8 + 1]); w.y = cvt_pk_bf16(h[j * 8 + 2], h[j * 8 + 3]); w.z = cvt_pk_bf16(h[j * 8 + 4], h[j * 8 + 5]); w.w = cvt_pk_bf16(h[j * 8 + 6], h[j * 8 + 7]);
        *(u32x4*)(p + j * 512 + lane * 8) = w; }
}
__device__ __forceinline__ void moe_combine16(const Args& a, int row, int layer_prev, int lane, float (&x)[16]) {
    const u32x4 rt = *(const u32x4*)(a.ws + WS_ROUTE + (size_t)row * 16);
    const int e0 = (int)rt[0];
    if (e0 < 0) return;
    const float p0 = __uint_as_float(rt[2]), p1 = __uint_as_float(rt[3]);
    const int* sl = (const int*)(a.ws + WS_RSLOT) + (size_t)row * 2; const int s0 = sl[0], s1 = sl[1];
    const bf16_t* y2 = (const bf16_t*)(a.ws + WS_ARENA + A_Y2);
    const float* g5 = mods_ptr(a, layer_prev, mod_index(row), 5);
    const MoeSplit sp = moe_split(((const int*)(a.ws + WS_META))[8]);
    const int x0 = (s0 >> 8) >= sp.nMf ? sp.S : 1, x1 = (s1 >> 8) >= sp.nMf ? sp.S : 1;
    const size_t o0 = ((size_t)(XP0 + (s0 >> 8) - sp.nMf) * 256 + (s0 & 255)) * 1024, o1 = ((size_t)(XP0 + (s1 >> 8) - sp.nMf) * 256 + (s1 & 255)) * 1024, ostep = (size_t)sp.nT * 256 * 1024;
#pragma unroll
    for (int j = 0; j < 2; ++j) { const int col = j * 512 + lane * 8; float ya[8], yb[8];
        unpack8(*(const u32x4*)(y2 + (size_t)s0 * 1024 + col), ya); unpack8(*(const u32x4*)(y2 + (size_t)s1 * 1024 + col), yb);
        for (int sl = 1; sl < x0; ++sl) { float t[8]; unpack8(*(const u32x4*)(y2 + o0 + (size_t)(sl - 1) * ostep + col), t);
#pragma unroll
            for (int e = 0; e < 8; ++e) ya[e] += t[e]; }
        for (int sl = 1; sl < x1; ++sl) { float t[8]; unpack8(*(const u32x4*)(y2 + o1 + (size_t)(sl - 1) * ostep + col), t);
#pragma unroll
            for (int e = 0; e < 8; ++e) yb[e] += t[e]; }
        const f32x4 g0 = *(const f32x4*)(g5 + col), g1 = *(const f32x4*)(g5 + col + 4);
#pragma unroll
        for (int e = 0; e < 8; ++e) x[j * 8 + e] += (e < 4 ? g0[e] : g1[e - 4]) * (p0 * ya[e] + p1 * yb[e]); }
}
__device__ __forceinline__ void store_x16(float* xp, int lane, const float (&x)[16]) {
#pragma unroll
    for (int j = 0; j < 2; ++j)
#pragma unroll
        for (int q = 0; q < 2; ++q) *(f32x4*)(xp + j * 512 + lane * 8 + 4 * q) = (f32x4){x[j * 8 + q * 4], x[j * 8 + q * 4 + 1], x[j * 8 + q * 4 + 2], x[j * 8 + q * 4 + 3]};
}
__device__ __forceinline__ void norm_row(const float (&x)[16], const RowParams& P, float (&h)[16]) {
    float ss = 0.f;
#pragma unroll
    for (int e = 0; e < 16; ++e) ss += x[e] * x[e];
    ss = wave_sum_dpp(ss);
    const float rstd = __builtin_amdgcn_rsqf(ss * (1.0f / 1024.0f) + NORM_EPS);
#pragma unroll
    for (int e = 0; e < 16; ++e) h[e] = x[e] * rstd * P.A[e] + P.Bv[e];
}
__device__ __forceinline__ void wave_rows(int G, int c, int& r0, int& r1) {
    const int nw = G * NWAVE, per = (R + nw - 1) / nw, gw = c * NWAVE + (ltid() >> 6);
    r0 = gw * per; r1 = r0 + per; if (r0 > R) r0 = R; if (r1 > R) r1 = R;
}
template <bool COMBINE, bool FIRST = false>
__device__ __forceinline__ void norm_plain(const Args& a, int layer, const float* gain, int which, bf16_t* Hout, int G, int c) {
    const int lane = ltid() & 63; int r0, r1; wave_rows(G, c, r0, r1);
    RowParams P; P.mi = -1;
    for (int row = r0; row < r1; ++row) {
        const int mi = mod_index(row); if (mi != P.mi) load_params(a, P, layer, mi, gain, which, lane);
        float* xp = xrow(a, row); float x[16], h[16]; load_x16(FIRST ? xrow_in(a, row) : xp, lane, x);
        if (COMBINE) { moe_combine16(a, row, layer - 1, lane, x); store_x16(xp, lane, x); }
        norm_row(x, P, h); store_bf16_row(Hout + (size_t)row * 1024, lane, h);
    }
}
struct CMeta { u32x4 rt; int s0, s1; };
struct CData { f32x4 x[4]; u32x4 y[4]; };
__device__ __forceinline__ void cm_load(const Args& a, int row, CMeta& m) {
    m.rt = *(const u32x4*)(a.ws + WS_ROUTE + (size_t)row * 16);
    const int* sl = (const int*)(a.ws + WS_RSLOT) + (size_t)row * 2; m.s0 = sl[0]; m.s1 = sl[1];
}
__device__ __forceinline__ void cd_load(const Args& a, int row, const CMeta& m, int lane, CData& d) {
    const float* xp = xrow(a, row);
#pragma unroll
    for (int j = 0; j < 2; ++j)
#pragma unroll
        for (int q = 0; q < 2; ++q) d.x[j * 2 + q] = *(const f32x4*)(xp + j * 512 + lane * 8 + 4 * q);
    if ((int)m.rt[0] >= 0) { const bf16_t* y2 = (const bf16_t*)(a.ws + WS_ARENA + A_Y2);
#pragma unroll
        for (int j = 0; j < 2; ++j) { d.y[j * 2] = *(const u32x4*)(y2 + (size_t)m.s0 * 1024 + j * 512 + lane * 8); d.y[j * 2 + 1] = *(const u32x4*)(y2 + (size_t)m.s1 * 1024 + j * 512 + lane * 8); } }
}
template <bool NORM>
__device__ __forceinline__ void combine_rows(const Args& a, int layer_prev, int layer, const float* gain, int which, bf16_t* Hout, int G, int c) {
    const int lane = ltid() & 63; int r0, r1; wave_rows(G, c, r0, r1); if (r0 >= r1) return;
    const bf16_t* y2 = (const bf16_t*)(a.ws + WS_ARENA + A_Y2);
    const MoeSplit sp = moe_split(((const int*)(a.ws + WS_META))[8]);
    const size_t ostep = (size_t)sp.nT * 256 * 1024;
    RowParams P; P.mi = -1; float g5[16]; int gmi = -1;
    CMeta m0, m1, m2; CData d0, dn;
    cm_load(a, r0, m0); m1 = m0; if (r0 + 1 < r1) cm_load(a, r0 + 1, m1);
    cd_load(a, r0, m0, lane, d0);
    for (int row = r0; row < r1; ++row) {
        m2 = m1; if (row + 2 < r1) cm_load(a, row + 2, m2);
        dn = d0; if (row + 1 < r1) cd_load(a, row + 1, m1, lane, dn);
        const int mi = mod_index(row);
        if (mi != gmi) { const float* gp = mods_ptr(a, layer_prev, mi, 5); gmi = mi;
#pragma unroll
            for (int j = 0; j < 2; ++j)
#pragma unroll
                for (int q = 0; q < 2; ++q) { const f32x4 v = *(const f32x4*)(gp + j * 512 + lane * 8 + 4 * q); g5[j * 8 + q * 4] = v[0]; g5[j * 8 + q * 4 + 1] = v[1]; g5[j * 8 + q * 4 + 2] = v[2]; g5[j * 8 + q * 4 + 3] = v[3]; } }
        float x[16];
#pragma unroll
        for (int i = 0; i < 4; ++i) { x[i * 4] = d0.x[i][0]; x[i * 4 + 1] = d0.x[i][1]; x[i * 4 + 2] = d0.x[i][2]; x[i * 4 + 3] = d0.x[i][3]; }
        const bool routed = (int)m0.rt[0] >= 0;
        if (routed) { const float p0 = __uint_as_float(m0.rt[2]), p1 = __uint_as_float(m0.rt[3]); const int s0 = m0.s0, s1 = m0.s1;
            const int x0 = (s0 >> 8) >= sp.nMf ? sp.S : 1, x1 = (s1 >> 8) >= sp.nMf ? sp.S : 1;
            const size_t o0 = ((size_t)(XP0 + (s0 >> 8) - sp.nMf) * 256 + (s0 & 255)) * 1024, o1 = ((size_t)(XP0 + (s1 >> 8) - sp.nMf) * 256 + (s1 & 255)) * 1024;
#pragma unroll
            for (int j = 0; j < 2; ++j) { const int col = j * 512 + lane * 8; float ya[8], yb[8]; unpack8(d0.y[j * 2], ya); unpack8(d0.y[j * 2 + 1], yb);
                for (int sl = 1; sl < x0; ++sl) { float t[8]; unpack8(*(const u32x4*)(y2 + o0 + (size_t)(sl - 1) * ostep + col), t);
#pragma unroll
                    for (int e = 0; e < 8; ++e) ya[e] += t[e]; }
                for (int sl = 1; sl < x1; ++sl) { float t[8]; unpack8(*(const u32x4*)(y2 + o1 + (size_t)(sl - 1) * ostep + col), t);
#pragma unroll
                    for (int e = 0; e < 8; ++e) yb[e] += t[e]; }
#pragma unroll
                for (int e = 0; e < 8; ++e) x[j * 8 + e] += g5[j * 8 + e] * (p0 * ya[e] + p1 * yb[e]); } }
        if (NORM || routed) store_x16(xrow(a, row), lane, x);
        if (NORM) { if (mi != P.mi) load_params(a, P, layer, mi, gain, which, lane); float h[16]; norm_row(x, P, h); store_bf16_row(Hout + (size_t)row * 1024, lane, h); }
        d0 = dn; m0 = m1; m1 = m2;
    }
}
__device__ __forceinline__ bool seg_first(int row) { const int r = row % SEG; return r == 0 || r == CTX; }
__device__ __forceinline__ bool seg_last(int row) { const int r = row % SEG; return r == CTX - 1 || r == SEG - 1; }
__device__ __forceinline__ void norm_mix(const Args& a, int layer, int j, int G, int c) {
    const int lane = ltid() & 63; int r0, r1; wave_rows(G, c, r0, r1); if (r0 >= r1) return;
    const float* gain = a.in[I_N1G] + layer * D; const float* mix = a.in[I_MIX] + (size_t)j * 6 * D;
    bf16_t* AX = (bf16_t*)(a.ws + WS_ARENA + A_AX);
    float mr[16], mk[16], mv[16];
#pragma unroll
    for (int jj = 0; jj < 2; ++jj)
#pragma unroll
        for (int e = 0; e < 8; ++e) { const int col = jj * 512 + lane * 8 + e; mr[jj * 8 + e] = mix[col]; mk[jj * 8 + e] = mix[2 * D + col]; mv[jj * 8 + e] = mix[3 * D + col]; }
    RowParams P; P.mi = -1;
    float hp[16], hc[16], hn[16], x[16];
    if (!seg_first(r0)) { const int mi = mod_index(r0 - 1); if (mi != P.mi) load_params(a, P, layer, mi, gain, 0, lane); load_x16(xrow(a, r0 - 1), lane, x); norm_row(x, P, hp); }
    else {
#pragma unroll
        for (int e = 0; e < 16; ++e) hp[e] = 0.f; }
    { const int mi = mod_index(r0); if (mi != P.mi) load_params(a, P, layer, mi, gain, 0, lane); load_x16(xrow(a, r0), lane, x); norm_row(x, P, hc); }
    if (r0 + 1 < R) load_x16(xrow(a, r0 + 1), lane, x);
    for (int row = r0; row < r1; ++row) {
        float xq[16];
        if (row + 2 < R && row + 1 < r1) load_x16(xrow(a, row + 2), lane, xq);
        if (row + 1 < R) { const int mi = mod_index(row + 1); if (mi != P.mi) load_params(a, P, layer, mi, gain, 0, lane); norm_row(x, P, hn); }
        else {
#pragma unroll
            for (int e = 0; e < 16; ++e) hn[e] = 0.f; }
#pragma unroll
        for (int e = 0; e < 16; ++e) x[e] = xq[e];
        const float fp = seg_first(row) ? 0.f : 0.5f, fn = seg_last(row) ? 0.f : 0.5f;
        float xx[16], t[16];
#pragma unroll
        for (int e = 0; e < 16; ++e) xx[e] = fp * hp[e] + fn * hn[e] - hc[e];
        bf16_t* o = AX + (size_t)row * 5120;
        store_bf16_row(o + 1024, lane, xx);
#pragma unroll
        for (int e = 0; e < 16; ++e) t[e] = hc[e] + xx[e] * mv[e];
        store_bf16_row(o, lane, t);
#pragma unroll
        for (int e = 0; e < 16; ++e) t[e] = hc[e] + xx[e] * mr[e];
        store_bf16_row(o + 2048, lane, t);
#pragma unroll
        for (int e = 0; e < 16; ++e) t[e] = hc[e] + xx[e] * mk[e];
        store_bf16_row(o + 3072, lane, t);
#pragma unroll
        for (int e = 0; e < 16; ++e) { hp[e] = hc[e]; hc[e] = hn[e]; }
    }
}
__device__ __forceinline__ void norm_router(const Args& a, int layer, int k, bool last, LAS unsigned char* lds, int G, int c) {
    const int tid = ltid(), lane = tid & 63; int r0, r1; wave_rows(G, c, r0, r1);
    LAS float* rw = (LAS float*)lds;
    { const float* rsrc = a.in[I_ROUTER] + (size_t)k * D * NE; for (int i = tid; i < D * NE; i += NTHR) rw[(i >> 6) * 68 + (i & 63)] = rsrc[i]; }
    __syncthreads();
    const float* gain = a.in[I_N2G] + layer * D;
    bf16_t* Hout = (bf16_t*)(a.ws + WS_ARENA + A_H);
    RowParams P; P.mi = -1;
    int hist[8];
#pragma unroll
    for (int e = 0; e < 8; ++e) hist[e] = 0;
    float xn[16];
    if (r0 < r1) load_x16(xrow(a, r0), lane, xn);
    for (int row = r0; row < r1; ++row) {
        const int mi = mod_index(row); if (mi != P.mi) load_params(a, P, layer, mi, gain, 3, lane);
        float x[16], h[16];
#pragma unroll
        for (int e = 0; e < 16; ++e) x[e] = xn[e];
        if (row + 1 < r1) load_x16(xrow(a, row + 1), lane, xn);
        { float ss = 0.f;
#pragma unroll
          for (int e = 0; e < 16; ++e) ss += x[e] * x[e];
          ss = wave_sum_dpp(ss);
          const float rstd = __builtin_amdgcn_rsqf(ss * (1.0f / 1024.0f) + NORM_EPS);
#pragma unroll
          for (int e = 0; e < 16; ++e) h[e] = x[e] * rstd * P.A[e] + P.Bv[e]; }
        store_bf16_row(Hout + (size_t)row * 1024, lane, h);
        const bool routed = !(last && mi == 8);
        float lg[8];
#pragma unroll
        for (int e = 0; e < 8; ++e) lg[e] = 0.f;
#pragma unroll
        for (int jj = 0; jj < 2; ++jj)
#pragma unroll
            for (int q = 0; q < 8; ++q) { const LAS f32x4* rp = (const LAS f32x4*)(rw + (jj * 64 + lane) * 68 + q * 8); const f32x4 w0 = rp[0], w1 = rp[1]; const float hv = h[jj * 8 + q];
                lg[0] += hv * w0[0]; lg[1] += hv * w0[1]; lg[2] += hv * w0[2]; lg[3] += hv * w0[3]; lg[4] += hv * w1[0]; lg[5] += hv * w1[1]; lg[6] += hv * w1[2]; lg[7] += hv * w1[3]; }
#pragma unroll
        for (int e = 0; e < 8; ++e) lg[e] = wave_sum_dpp(lg[e]);
        int e0 = 0; float v0 = lg[0];
#pragma unroll
        for (int e = 1; e < 8; ++e) if (lg[e] > v0) { v0 = lg[e]; e0 = e; }
        int e1 = -1; float v1 = -3.0e38f;
#pragma unroll
        for (int e = 0; e < 8; ++e) if (e != e0 && lg[e] > v1) { v1 = lg[e]; e1 = e; }
        const float p0 = __builtin_amdgcn_rcpf(1.0f + __expf(v1 - v0)), p1 = 1.0f - p0;
        if (routed) {
#pragma unroll
            for (int e = 0; e < 8; ++e) hist[e] += (e == e0 || e == e1) ? 1 : 0; }
        if (lane == 0) *(u32x4*)(a.ws + WS_ROUTE + (size_t)row * 16) = (u32x4){(unsigned)(routed ? e0 : -1), (unsigned)(routed ? e1 : -1), __float_as_uint(p0), __float_as_uint(p1)};
    }
    const int gw = c * NWAVE + (tid >> 6);
    if (lane == 0) { int* hp = (int*)(a.ws + WS_HIST) + (size_t)gw * 8;
#pragma unroll
        for (int e = 0; e < 8; ++e) hp[e] = hist[e]; }
}

__device__ __forceinline__ void mla_stats(const Args& a, int G, int c) {
    const int lane = ltid() & 63; int r0, r1; wave_rows(G, c, r0, r1);
    const bf16_t* QKVA = (const bf16_t*)(a.ws + WS_ARENA + A_QKVA); float* rs = (float*)(a.ws + WS_RS);
    for (int row = r0; row < r1; ++row) {
        float sq = 0.f, skv = 0.f; float f[8];
        if (lane < 48) { unpack8(*(const u32x4*)(QKVA + (size_t)row * 768 + lane * 8), f);
#pragma unroll
            for (int e = 0; e < 8; ++e) sq += f[e] * f[e]; }
        if (lane < 32) { unpack8(*(const u32x4*)(QKVA + (size_t)row * 768 + 384 + lane * 8), f);
#pragma unroll
            for (int e = 0; e < 8; ++e) skv += f[e] * f[e]; }
        sq = wave_sum_dpp(sq); skv = wave_sum_dpp(skv);
        if (lane == 0) { rs[row] = 1.0f / sqrtf(sq * (1.0f / 384.0f) + NORM_EPS); rs[R + row] = 1.0f / sqrtf(skv * (1.0f / 256.0f) + NORM_EPS); }
    }
}
__device__ __forceinline__ void mla_qkpost(const Args& a, int j, int G, int c) {
    const int lane = ltid() & 63, hd = lane >> 3, sub = lane & 7; int r0, r1; wave_rows(G, c, r0, r1);
    bf16_t* Q = (bf16_t*)(a.ws + WS_ARENA + A_Q); const bf16_t* KV = (const bf16_t*)(a.ws + WS_ARENA + A_KV); const bf16_t* QKVA = (const bf16_t*)(a.ws + WS_ARENA + A_QKVA);
    bf16_t* K = (bf16_t*)(a.ws + WS_ARENA + A_K); const float* rt = (const float*)(a.ws + WS_ROPE);
    float gq[3][8], gk[3][8];
#pragma unroll
    for (int cc = 0; cc < 3; ++cc)
#pragma unroll
        for (int e = 0; e < 8; ++e) { gq[cc][e] = a.in[I_QN][j * QKH + cc * 64 + sub * 8 + e]; gk[cc][e] = a.in[I_KN][j * QKH + cc * 64 + sub * 8 + e]; }
    const float sgn = (sub & 2) ? 1.0f : -1.0f;
    for (int row = r0; row < r1; ++row) {
        const int r = row % SEG; const bool lat = r >= CTX; const int t = r - CTX, pos = (sub & 4) ? (t & 63) : (t >> 6);
        float cs[8], sn[8];
        if (lat) {
#pragma unroll
            for (int q = 0; q < 2; ++q) { const f32x4 cv = *(const f32x4*)(rt + pos * 16 + (sub & 1) * 8 + 4 * q), sv = *(const f32x4*)(rt + 1024 + pos * 16 + (sub & 1) * 8 + 4 * q);
#pragma unroll
                for (int e = 0; e < 4; ++e) { cs[q * 4 + e] = cv[e]; sn[q * 4 + e] = sv[e]; } } }
        float v[3][8];
        bf16_t* qp = Q + (size_t)row * 1536 + hd * QKH + sub * 8;
#pragma unroll
        for (int cc = 0; cc < 3; ++cc) unpack8(*(const u32x4*)(qp + cc * 64), v[cc]);
        { float ss = 0.f;
#pragma unroll
          for (int cc = 0; cc < 3; ++cc)
#pragma unroll
              for (int e = 0; e < 8; ++e) ss += v[cc][e] * v[cc][e];
          ss = red8(ss); const float rstd = 1.0f / sqrtf(ss * (1.0f / 192.0f) + NORM_EPS);
#pragma unroll
          for (int cc = 0; cc < 3; ++cc)
#pragma unroll
              for (int e = 0; e < 8; ++e) v[cc][e] = v[cc][e] * rstd * gq[cc][e];
          if (lat) {
#pragma unroll
              for (int e = 0; e < 8; ++e) { const float pr = __shfl_xor(v[2][e], 2); v[2][e] = v[2][e] * cs[e] + sgn * pr * sn[e]; } }
#pragma unroll
          for (int cc = 0; cc < 3; ++cc) {
#pragma unroll
              for (int e = 0; e < 8; ++e) v[cc][e] *= QSCALE;
              *(u32x4*)(qp + cc * 64) = pack8(v[cc]); } }
        const bf16_t* kp = KV + (size_t)row * LDKV + hd * 256 + sub * 8;
        unpack8(*(const u32x4*)(kp), v[0]); unpack8(*(const u32x4*)(kp + 64), v[1]); unpack8(*(const u32x4*)(QKVA + (size_t)row * 768 + 640 + sub * 8), v[2]);
        { float ss = 0.f;
#pragma unroll
          for (int cc = 0; cc < 3; ++cc)
#pragma unroll
              for (int e = 0; e < 8; ++e) ss += v[cc][e] * v[cc][e];
          ss = red8(ss); const float rstd = 1.0f / sqrtf(ss * (1.0f / 192.0f) + NORM_EPS);
#pragma unroll
          for (int cc = 0; cc < 3; ++cc)
#pragma unroll
              for (int e = 0; e < 8; ++e) v[cc][e] = v[cc][e] * rstd * gk[cc][e];
          if (lat) {
#pragma unroll
              for (int e = 0; e < 8; ++e) { const float pr = __shfl_xor(v[2][e], 2); v[2][e] = v[2][e] * cs[e] + sgn * pr * sn[e]; } }
          bf16_t* ko = K + (size_t)row * 1536 + hd * QKH + sub * 8;
#pragma unroll
          for (int cc = 0; cc < 3; ++cc) *(u32x4*)(ko + cc * 64) = pack8(v[cc]); }
    }
}

namespace att {
constexpr int KVBLK = 64, KROWB = 384;
constexpr int SHM_V = KVBLK * 128 * 2, SHM_K = KVBLK * KROWB;
constexpr int SHM_ATTN = 2 * SHM_V + 2 * SHM_K + NWAVE * 64 * 4;
constexpr float THR = 11.5f;
#define KSWZ(row, colB) ((row) * att::KROWB + ((colB) ^ (((row) & 7) << 4)))
#define SBAR() __builtin_amdgcn_sched_barrier(0)
__device__ __forceinline__ int crow(int r, int hi) { return (r & 3) + 8 * (r >> 2) + 4 * hi; }
__device__ __forceinline__ void partialSM(f32x16& p0, f32x16& p1, float& m_reg, float& mn, float& alpha) {
    float pmax = p0[0];
#pragma unroll
    for (int r = 1; r < 16; ++r) pmax = fmaxf(pmax, p0[r]);
#pragma unroll
    for (int r = 0; r < 16; ++r) pmax = fmaxf(pmax, p1[r]);
    { auto rr = __builtin_amdgcn_permlane32_swap(__float_as_uint(pmax), __float_as_uint(pmax), false, false); pmax = fmaxf(__uint_as_float(rr[0]), __uint_as_float(rr[1])); }
    if (__builtin_expect(__all(pmax - m_reg <= THR), 1)) { mn = m_reg; alpha = 1.f; }
    else { mn = fmaxf(m_reg, pmax); alpha = __builtin_amdgcn_exp2f(m_reg - mn); m_reg = mn; }
#pragma unroll
    for (int r = 0; r < 16; ++r) { p0[r] -= mn; p1[r] -= mn; }
#pragma unroll
    for (int r = 0; r < 16; ++r) p0[r] = __builtin_amdgcn_exp2f(p0[r]);
}
__device__ __forceinline__ void finishSM(f32x16& p0, f32x16& p1, float alpha, float& l_reg, bf16x8& pa0, bf16x8& pa1, bf16x8& pa2, bf16x8& pa3) {
#pragma unroll
    for (int r = 0; r < 16; ++r) p1[r] = __builtin_amdgcn_exp2f(p1[r]);
    float ps = 0;
#pragma unroll
    for (int r = 0; r < 16; ++r) ps += p0[r];
#pragma unroll
    for (int r = 0; r < 16; ++r) ps += p1[r];
    { auto rr = __builtin_amdgcn_permlane32_swap(__float_as_uint(ps), __float_as_uint(ps), false, false); ps = __uint_as_float(rr[0]) + __uint_as_float(rr[1]); }
    l_reg = l_reg * alpha + ps;
#define PK4(P, BASE, OUT) do { unsigned a0 = cvt_pk_bf16(P[BASE + 0], P[BASE + 1]), a1 = cvt_pk_bf16(P[BASE + 2], P[BASE + 3]);   \
    unsigned b0 = cvt_pk_bf16(P[BASE + 4], P[BASE + 5]), b1 = cvt_pk_bf16(P[BASE + 6], P[BASE + 7]);                              \
    auto r0 = __builtin_amdgcn_permlane32_swap(a0, b0, false, false); auto r1 = __builtin_amdgcn_permlane32_swap(a1, b1, false, false); \
    u32x4 w = {r0[0], r1[0], r0[1], r1[1]}; OUT = *reinterpret_cast<bf16x8*>(&w); } while (0)
    PK4(p0, 0, pa0); PK4(p0, 8, pa1); PK4(p1, 0, pa2); PK4(p1, 8, pa3);
#undef PK4
}
__device__ __forceinline__ void qkt(f32x16& p0, f32x16& p1, const char* Ks, const bf16x8* qr, int r32, int hi) {
    p0 = f32x16{}; p1 = f32x16{};
    bf16x8 ka[4], kb[4];
#define QK_LD(buf, g) do { _Pragma("unroll") for (int q_ = 0; q_ < 2; ++q_) { const int cb_ = ((2 * (g) + q_) * 16 + hi * 8) * 2; \
        buf[2 * q_] = *reinterpret_cast<const bf16x8*>(Ks + KSWZ(r32, cb_)); buf[2 * q_ + 1] = *reinterpret_cast<const bf16x8*>(Ks + KSWZ(32 + r32, cb_)); } } while (0)
#define QK_MM(buf, g) do { _Pragma("unroll") for (int q_ = 0; q_ < 2; ++q_) { p0 = __builtin_amdgcn_mfma_f32_32x32x16_bf16(buf[2 * q_], qr[2 * (g) + q_], p0, 0, 0, 0); \
        p1 = __builtin_amdgcn_mfma_f32_32x32x16_bf16(buf[2 * q_ + 1], qr[2 * (g) + q_], p1, 0, 0, 0); } } while (0)
    QK_LD(ka, 0); SBAR();
    QK_LD(kb, 1); SBAR(); QK_MM(ka, 0); SBAR();
    QK_LD(ka, 2); SBAR(); QK_MM(kb, 1); SBAR();
    QK_LD(kb, 3); SBAR(); QK_MM(ka, 2); SBAR();
    QK_LD(ka, 4); SBAR(); QK_MM(kb, 3); SBAR();
    QK_LD(kb, 5); SBAR(); QK_MM(ka, 4); SBAR();
    QK_MM(kb, 5); SBAR();
#undef QK_LD
#undef QK_MM
}
__device__ __forceinline__ int v_st(int k, int c) { const int kk = (k & ~0xC) | ((k & 4) << 1) | ((k & 8) >> 1); return ((kk >> 3) * 4 + (c >> 5)) * 512 + ((kk & 7) * 32 + (c & 31)) * 2; }
__device__ __forceinline__ int v_rd_base(int lane) { return ((lane & 3) << 3) | (((lane >> 2) & 3) << 6) | (((lane >> 4) & 1) << 5) | (((lane >> 5) & 1) << 8); }
constexpr int v_rd_off(int d0, int ks, int half) { return d0 * 512 + ks * 4096 + half * 2048; }
template <int OFF> __device__ __forceinline__ s16x4 tr_read(int vb) { s16x4 r; asm volatile("ds_read_b64_tr_b16 %0, %1 offset:%2" : "=&v"(r) : "v"(vb), "i"(OFF) : "memory"); return r; }
struct VFrag { s16x4 l0, h0, l1, h1, l2, h2, l3, h3; };
template <int D0> __device__ __forceinline__ void pv_issue(VFrag& f, int vb) {
    f.l0 = tr_read<v_rd_off(D0, 0, 0)>(vb); f.h0 = tr_read<v_rd_off(D0, 0, 1)>(vb); f.l1 = tr_read<v_rd_off(D0, 1, 0)>(vb); f.h1 = tr_read<v_rd_off(D0, 1, 1)>(vb);
    f.l2 = tr_read<v_rd_off(D0, 2, 0)>(vb); f.h2 = tr_read<v_rd_off(D0, 2, 1)>(vb); f.l3 = tr_read<v_rd_off(D0, 3, 0)>(vb); f.h3 = tr_read<v_rd_off(D0, 3, 1)>(vb);
}
__device__ __forceinline__ void pv_mma(f32x16& od, const VFrag& f, bf16x8 pa0, bf16x8 pa1, bf16x8 pa2, bf16x8 pa3) {
#define PK(L, H) (bf16x8){L[0], L[1], L[2], L[3], H[0], H[1], H[2], H[3]}
    od = __builtin_amdgcn_mfma_f32_32x32x16_bf16(pa0, PK(f.l0, f.h0), od, 0, 0, 0);
    od = __builtin_amdgcn_mfma_f32_32x32x16_bf16(pa1, PK(f.l1, f.h1), od, 0, 0, 0);
    od = __builtin_amdgcn_mfma_f32_32x32x16_bf16(pa2, PK(f.l2, f.h2), od, 0, 0, 0);
    od = __builtin_amdgcn_mfma_f32_32x32x16_bf16(pa3, PK(f.l3, f.h3), od, 0, 0, 0);
#undef PK
}
__device__ __forceinline__ void pv_d0(f32x16* o, int vb, bf16x8 pa0, bf16x8 pa1, bf16x8 pa2, bf16x8 pa3) {
    VFrag fa, fb;
    pv_issue<0>(fa, vb); pv_issue<1>(fb, vb);
    asm volatile("s_waitcnt lgkmcnt(8)" ::: "memory"); SBAR(); pv_mma(o[0], fa, pa0, pa1, pa2, pa3); SBAR();
    pv_issue<2>(fa, vb);
    asm volatile("s_waitcnt lgkmcnt(8)" ::: "memory"); SBAR(); pv_mma(o[1], fb, pa0, pa1, pa2, pa3); SBAR();
    pv_issue<3>(fb, vb);
    asm volatile("s_waitcnt lgkmcnt(8)" ::: "memory"); SBAR(); pv_mma(o[2], fa, pa0, pa1, pa2, pa3); SBAR();
    asm volatile("s_waitcnt lgkmcnt(0)" ::: "memory"); SBAR(); pv_mma(o[3], fb, pa0, pa1, pa2, pa3);
}
__device__ __forceinline__ void attn_unit(const bf16_t* __restrict__ Qb, const bf16_t* __restrict__ Kh, const bf16_t* __restrict__ Vh, bf16_t* __restrict__ Ob, int seq, char* lds) {
    constexpr int LDQ = 1536, LDK = 1536, LDV = LDKV, LDO = 1024;
    const int tid = ltid(), wid = tid >> 6, lane = tid & 63, r32 = lane & 31, hi = lane >> 5;
    char* V_lds = lds; char* K_lds = lds + 2 * SHM_V;
    float* wsp = (float*)(lds + 2 * SHM_V + 2 * SHM_K) + wid * 64; float* li_l = wsp; float* al_l = wsp + 32;
    float m_reg = -1e30f, l_reg = 0; f32x16 o[4] = {}; bf16x8 qr[12];
    const bf16_t* Qw = Qb + (long)(wid * 32 + r32) * LDQ + hi * 8;
#pragma unroll
    for (int d0 = 0; d0 < 12; ++d0) qr[d0] = *(const __attribute__((address_space(1))) bf16x8*)((const __attribute__((address_space(1))) bf16_t*)Qw + d0 * 16);
    const int sr = tid >> 4, sc = (tid & 15) * 8, vst0 = v_st(sr, sc), vst1 = v_st(32 + sr, sc);
    int kkey[3], kcb[3];
#pragma unroll
    for (int i = 0; i < 3; ++i) { const int ci = tid + i * 512; kkey[i] = ci / 24; kcb[i] = (ci % 24) * 16; }
    const int vb0 = (int)(uintptr_t)(LAS char*)V_lds + v_rd_base(lane);
    bf16x8 vs0, vs1, ks0, ks1, ks2;
#define GAS __attribute__((address_space(1)))
#define SLOAD(k0) do { vs0 = *(const GAS bf16x8*)((const GAS bf16_t*)Vh + (long)((k0) + sr) * LDV + sc); vs1 = *(const GAS bf16x8*)((const GAS bf16_t*)Vh + (long)((k0) + 32 + sr) * LDV + sc); \
    ks0 = *(const GAS bf16x8*)((const GAS char*)Kh + (long)((k0) + kkey[0]) * (LDK * 2) + kcb[0]); ks1 = *(const GAS bf16x8*)((const GAS char*)Kh + (long)((k0) + kkey[1]) * (LDK * 2) + kcb[1]); \
    ks2 = *(const GAS bf16x8*)((const GAS char*)Kh + (long)((k0) + kkey[2]) * (LDK * 2) + kcb[2]); } while (0)
#define SWRITE(b) do { *(bf16x8*)(V_lds + (b) * SHM_V + vst0) = vs0; *(bf16x8*)(V_lds + (b) * SHM_V + vst1) = vs1; \
    *(bf16x8*)(K_lds + (b) * SHM_K + KSWZ(kkey[0], kcb[0])) = ks0; *(bf16x8*)(K_lds + (b) * SHM_K + KSWZ(kkey[1], kcb[1])) = ks1; *(bf16x8*)(K_lds + (b) * SHM_K + KSWZ(kkey[2], kcb[2])) = ks2; } while (0)
#define SWAIT() asm volatile("s_waitcnt vmcnt(0)" ::: "memory")
#define RESC(al) do { if (__any((al) < 1.f)) { if (hi == 0) al_l[r32] = (al); asm volatile("s_waitcnt lgkmcnt(0)" ::: "memory"); \
    _Pragma("unroll") for (int d = 0; d < 4; ++d) _Pragma("unroll") for (int r = 0; r < 16; ++r) o[d][r] *= al_l[crow(r, hi)]; } } while (0)
    f32x16 p0, p1; float mn, al; bf16x8 pa0, pa1, pa2, pa3; const int NT = seq / KVBLK;
    SLOAD(0); SWAIT(); SWRITE(0); __syncthreads();
    for (int j = 0; j < NT; ++j) {
        const int bsel = j & 1;
        if (j + 1 < NT) SLOAD((j + 1) * KVBLK);
        SBAR(); qkt(p0, p1, K_lds + bsel * SHM_K, qr, r32, hi);
        partialSM(p0, p1, m_reg, mn, al);
        RESC(al);
        finishSM(p0, p1, al, l_reg, pa0, pa1, pa2, pa3); SBAR();
        pv_d0(o, vb0 + bsel * SHM_V, pa0, pa1, pa2, pa3);
        if (j + 1 < NT) { SWAIT(); SWRITE(bsel ^ 1); }
        __syncthreads();
    }
    if (hi == 0) li_l[r32] = l_reg; asm volatile("s_waitcnt lgkmcnt(0)" ::: "memory");
    float rli[16];
#pragma unroll
    for (int r = 0; r < 16; ++r) rli[r] = __builtin_amdgcn_rcpf(li_l[crow(r, hi)]);
    bf16_t* Ow = Ob + (long)(wid * 32) * LDO;
#pragma unroll
    for (int r = 0; r < 16; ++r) { const int orow = crow(r, hi);
#pragma unroll
        for (int d0 = 0; d0 < 4; ++d0) { const float val = o[d0][r] * rli[r]; ((__attribute__((address_space(1))) bf16_t*)Ow)[(long)orow * LDO + d0 * 32 + r32] = (bf16_t)(cvt_pk_bf16(val, val) & 0xffffu); } }
    __syncthreads();
#undef SLOAD
#undef SWRITE
#undef SWAIT
#undef RESC
}
}
__device__ __forceinline__ void attn_phase(const Args& a, LAS unsigned char* lds, int G, int c) {
    const bf16_t* Q = (const bf16_t*)(a.ws + WS_ARENA + A_Q); const bf16_t* K = (const bf16_t*)(a.ws + WS_ARENA + A_K); const bf16_t* KV = (const bf16_t*)(a.ws + WS_ARENA + A_KV);
    bf16_t* O = (bf16_t*)(a.ws + WS_ARENA + A_O);
    const int vcu = (G % 8 == 0) ? (c % 8) * (G / 8) + c / 8 : c;
    for (int L = vcu; L < 1024 + 64; L += G) {
        int b, h, q0, seq;
        if (L < 1024) { b = L >> 7; h = (L >> 4) & 7; q0 = CTX + (L & 15) * 256; seq = SEG; } else { const int l2 = L - 1024; b = l2 >> 3; h = l2 & 7; q0 = 0; seq = CTX; }
        const size_t rb = (size_t)b * SEG;
        att::attn_unit(Q + (rb + q0) * 1536 + h * QKH, K + rb * 1536 + h * QKH, KV + rb * LDKV + h * 256 + 128, O + (rb + q0) * 1024 + h * VH, seq, (char*)lds);
    }
}

namespace scan {
constexpr int CH = 32, STEP_B = 6 * 256, BUF_B = CH * STEP_B  , YB_B = CH * 64 * 4  , LDS_B = 2 * BUF_B + 2 * YB_B  , NCH = SEG / CH  ;
constexpr int TILE_B = 64 * 65 * 4, MT_TILES = 24 * 896;
struct MTile { const float* src; bf16_t* dst; int sld, ldd, n0, k0, grpd; };
__device__ __forceinline__ int step_row(int b, int dir, int gs) {
    const int base = b * SEG;
    if (dir == 0) return base + gs;
    return gs < CTX ? base + (CTX - 1 - gs) : base + CTX + (SEG - 1 - gs);
}
struct Raw { u32x4 k, r, v, wl, al, vf, vl; };
}
__device__ __forceinline__ bool moe_tile(const Args& a, int k, int t, scan::MTile& m) {
    if (CS_NOTILE || t >= scan::MT_TILES) return false;
    const int j = t / 896, tl = t - j * 896, e = j / 3, kind = j - e * 3; int tn;
    const size_t so = (size_t)(k * NE + e) * D * DFE;
    if (kind < 2) { m.src = a.in[kind == 0 ? I_M1 : I_M3] + so; m.sld = DFE; m.dst = (bf16_t*)(a.ws + WS_ARENA + A_WM13) + (size_t)e * E_M13 + (kind ? (size_t)128 * 1024 : 0); m.ldd = 1024; tn = 56; m.grpd = 1; }
    else { m.src = a.in[I_M2] + so; m.sld = D; m.dst = (bf16_t*)(a.ws + WS_ARENA + A_WM2) + (size_t)e * E_M2; m.ldd = DFE; tn = 16; m.grpd = 0; }
    m.n0 = (tl % tn) * 64; m.k0 = (tl / tn) * 64; return true;
}
__device__ __forceinline__ void scan_phase(const Args& a, int j, const bf16_t* Vsrc, const bool vres, LAS unsigned char* lds, int G, int c) {
    using namespace scan;
    int mt_round = 0;
    const int tid = ltid(), wave = tid >> 6, lane = tid & 63;
    const bf16_t* RR = (const bf16_t*)(a.ws + WS_ARENA + A_RR); const bf16_t* RK = (const bf16_t*)(a.ws + WS_ARENA + A_RK);
    for (int chain = c; chain < 256; chain += G) {
        const int b = chain >> 5, h = (chain >> 1) & 15, dir = chain & 1;
        const bf16_t* WL = (const bf16_t*)(a.ws + WS_ARENA + (dir ? A_WL1 : A_WL0)); const bf16_t* AL = (const bf16_t*)(a.ws + WS_ARENA + (dir ? A_AL1 : A_AL0));
        bf16_t* Y = (bf16_t*)(a.ws + WS_ARENA + (dir ? A_YR : A_YF));
        if (wave >= 4) {
            const int pt = tid - 256, s = pt >> 3, seg = pt & 7, ch0 = h * 64 + seg * 8;
            float kkp[8], kap[8], v0p[8];
            const bf16_t* VFp = (const bf16_t*)(a.ws + WS_VF); const bf16_t* VLp = (const bf16_t*)(a.ws + WS_ARENA + A_VL);
#pragma unroll
            for (int e = 0; e < 8; ++e) v0p[e] = vres ? a.in[I_V0][ch0 + e] : 0.f;
#pragma unroll
            for (int e = 0; e < 8; ++e) { kkp[e] = a.in[I_KK][(size_t)j * D + ch0 + e]; kap[e] = a.in[I_KA][(size_t)j * D + ch0 + e]; }
            Raw raw;
#define GLOAD(q) do { const size_t off_ = (size_t)step_row(b, dir, (q) * CH + s) * 1024 + ch0; \
                raw.k = *(const u32x4*)(RK + off_); raw.r = *(const u32x4*)(RR + off_); raw.v = *(const u32x4*)(Vsrc + off_); raw.wl = *(const u32x4*)(WL + off_); raw.al = *(const u32x4*)(AL + off_); \
                if (vres) { raw.vf = *(const u32x4*)(VFp + off_); raw.vl = *(const u32x4*)(VLp + off_); } } while (0)
#define PRODUCE(buf) do { \
                float k[8], r[8], v[8], wl[8], al[8]; unpack8(raw.k, k); unpack8(raw.r, r); unpack8(raw.v, v); unpack8(raw.wl, wl); unpack8(raw.al, al); \
                if (vres) { float vf[8], vl[8]; unpack8(raw.vf, vf); unpack8(raw.vl, vl); _Pragma("unroll") for (int e = 0; e < 8; ++e) v[e] = v[e] + (vf[e] - v[e]) * sigmoidf_(v0p[e] + vl[e]); } \
                float ad[8], kd[8], kk[8], ww[8], ss = 0.f; \
                _Pragma("unroll") for (int e = 0; e < 8; ++e) { ad[e] = al[e]; kd[e] = k[e] * (1.0f + (ad[e] - 1.0f) * kap[e]); kk[e] = k[e] * kkp[e]; ss += kk[e] * kk[e]; \
                    ww[e] = __expf(-wl[e]); } \
                ss = red8(ss); const float inv = 1.0f / fmaxf(sqrtf(ss), 1e-12f); \
                LAS f32x4* o = (LAS f32x4*)(lds + (buf) * BUF_B + s * STEP_B + seg * 32); \
                _Pragma("unroll") for (int e = 0; e < 8; ++e) kk[e] *= inv; \
                o[0] = (f32x4){ww[0], ww[1], ww[2], ww[3]}; o[1] = (f32x4){ww[4], ww[5], ww[6], ww[7]}; \
                o[16] = (f32x4){kd[0], kd[1], kd[2], kd[3]}; o[17] = (f32x4){kd[4], kd[5], kd[6], kd[7]}; \
                o[32] = (f32x4){-kk[0], -kk[1], -kk[2], -kk[3]}; o[33] = (f32x4){-kk[4], -kk[5], -kk[6], -kk[7]}; \
                o[48] = (f32x4){kk[0] * ad[0], kk[1] * ad[1], kk[2] * ad[2], kk[3] * ad[3]}; o[49] = (f32x4){kk[4] * ad[4], kk[5] * ad[5], kk[6] * ad[6], kk[7] * ad[7]}; \
                o[64] = (f32x4){r[0], r[1], r[2], r[3]}; o[65] = (f32x4){r[4], r[5], r[6], r[7]}; \
                o[80] = (f32x4){v[0], v[1], v[2], v[3]}; o[81] = (f32x4){v[4], v[5], v[6], v[7]}; } while (0)
#define YSTORE(q) do { const LAS f32x4* yp = (const LAS f32x4*)(lds + 2 * BUF_B + ((q) & 1) * YB_B + s * 256 + seg * 32); const f32x4 y0 = yp[0], y1 = yp[1]; \
                u32x4 w; w.x = cvt_pk_bf16(y0[0], y0[1]); w.y = cvt_pk_bf16(y0[2], y0[3]); w.z = cvt_pk_bf16(y1[0], y1[1]); w.w = cvt_pk_bf16(y1[2], y1[3]); \
                *(u32x4*)(Y + (size_t)step_row(b, dir, (q) * CH + s) * 1024 + ch0) = w; } while (0)
            GLOAD(0); PRODUCE(0); GLOAD(1);
            __syncthreads();
            f32x4 treg[4]; const int kl = pt >> 4, nq = (pt & 15) * 4, sn = pt >> 2, sk = (pt & 3) * 16;
            for (int q = 0; q < NCH; ++q) {
                if (q + 1 < NCH) { PRODUCE((q + 1) & 1); if (q + 2 < NCH) GLOAD(q + 2); }
                if (q >= 1) YSTORE(q - 1);
                MTile m;
                if (q >= 2 && moe_tile(a, j, c + (mt_round + q - 2) * G, m)) {
                    const LAS float* tl_ = (const LAS float*)(lds + LDS_B + (q & 1) * TILE_B); float f0[8], f1[8];
#pragma unroll
                    for (int e = 0; e < 8; ++e) { f0[e] = tl_[(sk + e) * 65 + sn]; f1[e] = tl_[(sk + 8 + e) * 65 + sn]; }
                    const int n = m.n0 + sn, dr = m.grpd ? ((n >> 7) * 256 + (n & 127)) : n; bf16_t* dp = m.dst + (size_t)dr * m.ldd + m.k0 + sk;
                    *(u32x4*)dp = pack8(f0); *(u32x4*)(dp + 8) = pack8(f1); }
                if (q >= 1 && q <= NCH - 2 && moe_tile(a, j, c + (mt_round + q - 1) * G, m)) {
                    LAS float* tl_ = (LAS float*)(lds + LDS_B + ((q - 1) & 1) * TILE_B);
#pragma unroll
                    for (int p = 0; p < 4; ++p) { LAS float* tp = tl_ + (kl + 16 * p) * 65 + nq; tp[0] = treg[p][0]; tp[1] = treg[p][1]; tp[2] = treg[p][2]; tp[3] = treg[p][3]; } }
                if (q <= NCH - 3 && moe_tile(a, j, c + (mt_round + q) * G, m)) {
#pragma unroll
                    for (int p = 0; p < 4; ++p) treg[p] = *(const f32x4*)(m.src + (size_t)(m.k0 + kl + 16 * p) * m.sld + m.n0 + nq); }
                __syncthreads();
            }
            YSTORE(NCH - 1);
#undef GLOAD
#undef PRODUCE
#undef YSTORE
        } else {
            const int rp = lane >> 3, ks = lane & 7, v0i = wave * 16 + rp * 2;
            f32x2 s0[4], s1[4];
#pragma unroll
            for (int i = 0; i < 4; ++i) { s0[i] = (f32x2){0.f, 0.f}; s1[i] = (f32x2){0.f, 0.f}; }
            __syncthreads();
            struct Vecs { f32x4 w0, w1, k0, k1, a0, a1, b0, b1, r0, r1; f32x2 vv; };
#define LOADV(V, t) do { const LAS f32x4* p_ = (const LAS f32x4*)(bp + (t) * STEP_B); V.w0 = p_[0]; V.w1 = p_[1]; V.k0 = p_[16]; V.k1 = p_[17]; V.a0 = p_[32]; V.a1 = p_[33]; \
                    V.b0 = p_[48]; V.b1 = p_[49]; V.r0 = p_[64]; V.r1 = p_[65]; V.vv = *(const LAS f32x2*)(vp + (t) * STEP_B); } while (0)
#define STEPV(V, t, HAVEPREV) do { \
                    const f32x2 wv[4] = {{V.w0[0], V.w0[1]}, {V.w0[2], V.w0[3]}, {V.w1[0], V.w1[1]}, {V.w1[2], V.w1[3]}}, kv[4] = {{V.k0[0], V.k0[1]}, {V.k0[2], V.k0[3]}, {V.k1[0], V.k1[1]}, {V.k1[2], V.k1[3]}}; \
                    const f32x2 av[4] = {{V.a0[0], V.a0[1]}, {V.a0[2], V.a0[3]}, {V.a1[0], V.a1[1]}, {V.a1[2], V.a1[3]}}, bv[4] = {{V.b0[0], V.b0[1]}, {V.b0[2], V.b0[3]}, {V.b1[0], V.b1[1]}, {V.b1[2], V.b1[3]}}; \
                    const f32x2 rv[4] = {{V.r0[0], V.r0[1]}, {V.r0[2], V.r0[3]}, {V.r1[0], V.r1[1]}, {V.r1[2], V.r1[3]}}; \
                    f32x2 d0 = s0[0] * av[0], d1 = s1[0] * av[0]; \
                    d0 += s0[1] * av[1]; d1 += s1[1] * av[1]; d0 += s0[2] * av[2]; d1 += s1[2] * av[2]; d0 += s0[3] * av[3]; d1 += s1[3] * av[3]; \
                    float h0 = d0.x + d0.y, h1 = d1.x + d1.y; \
                    h0 += dpp_f<0xB1>(h0); h1 += dpp_f<0xB1>(h1); yp0 += dpp_f<0xB1>(yp0); yp1 += dpp_f<0xB1>(yp1); \
                    h0 += dpp_f<0x4E>(h0); h1 += dpp_f<0x4E>(h1); yp0 += dpp_f<0x4E>(yp0); yp1 += dpp_f<0x4E>(yp1); \
                    h0 += dpp_f<0x141>(h0); h1 += dpp_f<0x141>(h1); yp0 += dpp_f<0x141>(yp0); yp1 += dpp_f<0x141>(yp1); \
                    if (HAVEPREV) yb[((t) - 1) * 64 + v0i + (ks & 1)] = (ks & 1) ? yp1 : yp0; \
                    const f32x2 sa0v = {h0, h0}, sa1v = {h1, h1}, v0v = {V.vv.x, V.vv.x}, v1v = {V.vv.y, V.vv.y}; \
                    _Pragma("unroll") for (int i = 0; i < 4; ++i) { s0[i] = s0[i] * wv[i] + sa0v * bv[i] + v0v * kv[i]; s1[i] = s1[i] * wv[i] + sa1v * bv[i] + v1v * kv[i]; } \
                    f32x2 y0 = s0[0] * rv[0], y1 = s1[0] * rv[0]; \
                    y0 += s0[1] * rv[1]; y1 += s1[1] * rv[1]; y0 += s0[2] * rv[2]; y1 += s1[2] * rv[2]; y0 += s0[3] * rv[3]; y1 += s1[3] * rv[3]; \
                    yp0 = y0.x + y0.y; yp1 = y1.x + y1.y; } while (0)
            for (int q = 0; q < NCH; ++q) {
                const LAS unsigned char* bp = lds + (q & 1) * BUF_B + ks * 32;
                const LAS unsigned char* vp = lds + (q & 1) * BUF_B + 5 * 256 + v0i * 4;
                LAS float* yb = (LAS float*)(lds + 2 * BUF_B + (q & 1) * YB_B);
                Vecs VA, VB; float yp0 = 0.f, yp1 = 0.f;
                LOADV(VA, 0); LOADV(VB, 1);
                STEPV(VA, 0, false);
                LOADV(VA, 2);
                STEPV(VB, 1, true);
#pragma unroll 1
                for (int t = 2; t < CH; t += 2) {
                    LOADV(VB, t + 1);
                    STEPV(VA, t, true);
                    LOADV(VA, t + 2);
                    STEPV(VB, t + 1, true);
                }
                yp0 = red8(yp0); yp1 = red8(yp1);
                yb[(CH - 1) * 64 + v0i + (ks & 1)] = (ks & 1) ? yp1 : yp0;
                __syncthreads();
            }
#undef LOADV
#undef STEPV
        }
        mt_round += NCH - 2;
        __syncthreads();
    }
}

namespace cs {
constexpr int C = 32, NCK = SEG / C;
constexpr int TM = 72, CM = 40, TMB = TM * 2, CMB = CM * 2;
constexpr int SZ_TM = 32 * TMB, SZ_CM = 64 * CMB, SZ_C32 = 32 * CMB;
constexpr int X_ATM = 0, X_RTM = SZ_TM, X_BHTM = 2 * SZ_TM, X_KHTM = 3 * SZ_TM, X_ACM = 4 * SZ_TM, X_RCM = X_ACM + SZ_CM, X_BBCM = X_RCM + SZ_CM, X_KBCM = X_BBCM + SZ_CM, X_B = X_KBCM + SZ_CM;
constexpr int Y_VCM = 0, Y_GC = SZ_CM, Y_B = SZ_CM + 256;
constexpr int OFF_X = 0, OFF_Y = 2 * X_B, OFF_MID = OFF_Y + 2 * Y_B;
constexpr int M_NL = 0, M_NR = SZ_C32, M_TT = 2 * SZ_C32, M_ARBT = 3 * SZ_C32, M_AAK = 4 * SZ_C32, M_UP = 5 * SZ_C32, M_W = 6 * SZ_C32, M_ARK = M_W + SZ_CM, MID_B = M_ARK + 4096;
constexpr int OFF_OUT = OFF_MID + MID_B;
constexpr int O_PST = 0, O_QST = 64 * TMB, O_PYT = O_QST + SZ_CM, O_QYT = O_PYT + SZ_TM, OUT_B = O_QYT + SZ_C32;
constexpr int OFF_YB = OFF_OUT + OUT_B, OFF_ES = OFF_YB + 8192, OFF_WT = OFF_ES + 2048, LDS_END = OFF_WT + 64 * 65 * 4;
__device__ __forceinline__ int rho(int r, int h) { return (r & 3) + 8 * (r >> 2) + 4 * h; }
__device__ __forceinline__ int perm16(int k) { return (k & ~0xC) | ((k & 4) << 1) | ((k & 8) >> 1); }
typedef __bf16 bf16v2 __attribute__((ext_vector_type(2)));
__device__ __forceinline__ unsigned cvt_pk_bf16_c(float lo, float hi) { const bf16v2 v = __builtin_convertvector((f32x2){lo, hi}, bf16v2); return __builtin_bit_cast(unsigned, v); }
__device__ __forceinline__ bf16_t f2bf(float x) { const __bf16 b = (__bf16)x; return __builtin_bit_cast(bf16_t, b); }
__device__ __forceinline__ float bf2f(bf16_t x) { return __uint_as_float((unsigned)x << 16); }
template <int KS> __device__ __forceinline__ void mma32t(f32x16& acc, const LAS unsigned char* A, int lda, const LAS unsigned char* B, int ldb, int r32, int h) {
    bf16x8 a[KS], b[KS];
#pragma unroll
    for (int s = 0; s < KS; ++s) { a[s] = *(const LAS bf16x8*)(A + r32 * lda + s * 32 + h * 16); b[s] = *(const LAS bf16x8*)(B + r32 * ldb + s * 32 + h * 16); }
#pragma unroll
    for (int s = 0; s < KS; ++s) acc = __builtin_amdgcn_mfma_f32_32x32x16_bf16(a[s], b[s], acc, 0, 0, 0);
}
__device__ __forceinline__ void mma32(f32x16& acc, const LAS unsigned char* A, int lda, const LAS unsigned char* B, int ldb, int ksteps, int r32, int h) {
    if (ksteps == 4) mma32t<4>(acc, A, lda, B, ldb, r32, h); else mma32t<2>(acc, A, lda, B, ldb, r32, h);
}
__device__ __forceinline__ void st_bf(const f32x16& acc, LAS unsigned char* dst, int sr, int sc, int r32, int h) {
#pragma unroll
    for (int r = 0; r < 16; ++r) *(LAS bf16_t*)(dst + rho(r, h) * sr + r32 * sc) = f2bf(acc[r]);
}
template <bool PERM> __device__ __forceinline__ void st_bf_T(const f32x16& acc, LAS unsigned char* dst, int sc, int r32, int h) {
#pragma unroll
    for (int m = 0; m < 4; ++m) { const int row0 = 8 * m + 4 * h, pos = PERM ? perm16(row0) : row0; u32x2 w; w.x = cvt_pk_bf16_c(acc[4 * m], acc[4 * m + 1]); w.y = cvt_pk_bf16_c(acc[4 * m + 2], acc[4 * m + 3]);
        *(LAS u32x2*)(dst + r32 * sc + pos * 2) = w; }
}
}
#define CS_BAR() do { asm volatile("s_waitcnt lgkmcnt(0)" ::: "memory"); __builtin_amdgcn_s_barrier(); asm volatile("" ::: "memory"); } while (0)
__device__ __forceinline__ void scan_chunked(const Args& a, int jl, const bf16_t* Vsrc, const bool vres, LAS unsigned char* lds, int G, int c) {
    using namespace cs;
    const int tid0 = ltid(), wave = __builtin_amdgcn_readfirstlane(tid0 >> 6);
    typedef const __attribute__((address_space(1))) bf16_t* gcp; typedef __attribute__((address_space(1))) bf16_t* gwp;
    gcp RR = (gcp)(a.ws + WS_ARENA + A_RR); gcp RK = (gcp)(a.ws + WS_ARENA + A_RK);
    gcp VFp = (gcp)(a.ws + WS_VF); gcp VLp = (gcp)(a.ws + WS_ARENA + A_VL); gcp Vg = (gcp)Vsrc;
    int mt0 = 0;
    for (int chain = c; chain < 256; chain += G) {
        const int b = chain >> 5, hd = (chain >> 1) & 15, dir = chain & 1;
        gcp WL = (gcp)(a.ws + WS_ARENA + (dir ? A_WL1 : A_WL0)); gcp AL = (gcp)(a.ws + WS_ARENA + (dir ? A_AL1 : A_AL0));
        gwp Y = (gwp)(a.ws + WS_ARENA + (dir ? A_YCR : A_YCF));
        const int gcol0 = hd * 64 + (tid0 & 63);
        const float kkp = a.in[I_KK][(size_t)jl * D + gcol0], kap = a.in[I_KA][(size_t)jl * D + gcol0], v0p = vres ? a.in[I_V0][gcol0] : 0.f;
        f32x16 S0 = {}, S1 = {};
        f32x4 wreg[8];
        constexpr int ntok = 4; const int tok0 = 4 * wave;
        bf16_t rk_[4], rr_[4], ra_[4], rv_[4], re_[4], rf_[4], rl_[4];
        bf16_t qk_[4], qr_[4], qa_[4], qv_[4], qe_[4], qf_[4], ql_[4];
#define CS_LOAD(q) do { _Pragma("unroll") for (int tk_ = 0; tk_ < 4; ++tk_) { const unsigned off_ = (unsigned)scan::step_row(b, dir, (q) * 32 + tok0 + tk_) * 1024u + (unsigned)gcol; \
                qk_[tk_] = RK[off_]; qr_[tk_] = RR[off_]; qa_[tk_] = AL[off_]; qe_[tk_] = WL[off_]; qv_[tk_] = Vg[off_]; if (vres) { qf_[tk_] = VFp[off_]; ql_[tk_] = VLp[off_]; } } } while (0)
#define CS_COPY() do { _Pragma("unroll") for (int tk_ = 0; tk_ < 4; ++tk_) { rk_[tk_] = qk_[tk_]; rr_[tk_] = qr_[tk_]; ra_[tk_] = qa_[tk_]; re_[tk_] = qe_[tk_]; rv_[tk_] = qv_[tk_]; rf_[tk_] = qf_[tk_]; rl_[tk_] = ql_[tk_]; } } while (0)
#define CS_ESUM() do { float es_ = 0.f; _Pragma("unroll") for (int tk_ = 0; tk_ < 4; ++tk_) es_ += bf2f(re_[tk_]); *(LAS float*)(lds + OFF_ES + wave * 256 + lane * 4) = es_; } while (0)
#define CS_MAIN(q) do { \
            LAS unsigned char* X_ = lds + OFF_X + ((q) & 1) * X_B; LAS unsigned char* Yb_ = lds + OFF_Y + ((q) & 1) * Y_B; \
            float before_ = 0.f, tot_ = 0.f; \
            _Pragma("unroll") for (int w_ = 0; w_ < 8; ++w_) { const float es_ = *(const LAS float*)(lds + OFF_ES + w_ * 256 + lane * 4); before_ += (w_ < wave) ? es_ : 0.f; tot_ += es_; } \
            float erun_ = __expf(-before_); const float gct_ = __expf(-tot_); \
            _Pragma("unroll") for (int p_ = 0; p_ < 2; ++p_) { const int t_ = tok0 + 2 * p_;            \
                const f32x2 kraw_ = {bf2f(rk_[2 * p_]), bf2f(rk_[2 * p_ + 1])}, rr2_ = {bf2f(rr_[2 * p_]), bf2f(rr_[2 * p_ + 1])}, ad_ = {bf2f(ra_[2 * p_]), bf2f(ra_[2 * p_ + 1])}; \
                f32x2 vv_ = {bf2f(rv_[2 * p_]), bf2f(rv_[2 * p_ + 1])}; \
                if (vres) { const f32x2 vf_ = {bf2f(rf_[2 * p_]), bf2f(rf_[2 * p_ + 1])}; const float s0_ = sigmoidf_(v0p + bf2f(rl_[2 * p_])), s1_ = sigmoidf_(v0p + bf2f(rl_[2 * p_ + 1])); \
                    vv_ = vv_ + (vf_ - vv_) * (f32x2){s0_, s1_}; } \
                const f32x2 kd_ = kraw_ * ((ad_ - 1.0f) * kap + 1.0f), kkr_ = kraw_ * kkp, sq_ = kkr_ * kkr_; \
                float s0 = sq_.x, s1 = sq_.y; \
                s0 += dpp_f<0xB1>(s0); s1 += dpp_f<0xB1>(s1); s0 += dpp_f<0x4E>(s0); s1 += dpp_f<0x4E>(s1); s0 += dpp_f<0x141>(s0); s1 += dpp_f<0x141>(s1); s0 += dpp_f<0x140>(s0); s1 += dpp_f<0x140>(s1); \
                const int i0_ = __float_as_int(s0), i1_ = __float_as_int(s1); \
                const float ss0_ = (__int_as_float(__builtin_amdgcn_readlane(i0_, 0)) + __int_as_float(__builtin_amdgcn_readlane(i0_, 16))) + (__int_as_float(__builtin_amdgcn_readlane(i0_, 32)) + __int_as_float(__builtin_amdgcn_readlane(i0_, 48))); \
                const float ss1_ = (__int_as_float(__builtin_amdgcn_readlane(i1_, 0)) + __int_as_float(__builtin_amdgcn_readlane(i1_, 16))) + (__int_as_float(__builtin_amdgcn_readlane(i1_, 32)) + __int_as_float(__builtin_amdgcn_readlane(i1_, 48))); \
                const f32x2 kk_ = kkr_ * (f32x2){__builtin_amdgcn_rsqf(fmaxf(ss0_, 1e-24f)), __builtin_amdgcn_rsqf(fmaxf(ss1_, 1e-24f))}; \
                const float w0_ = __expf(-bf2f(re_[2 * p_])), w1_ = __expf(-bf2f(re_[2 * p_ + 1])); \
                f32x2 E1_, E2_; E1_.x = erun_; E2_.x = erun_ * w0_; E1_.y = E2_.x; E2_.y = E2_.x * w1_; erun_ = E2_.y; \
                const f32x2 Ei_ = {__builtin_amdgcn_rcpf(E2_.x), __builtin_amdgcn_rcpf(E2_.y)}, E3_ = Ei_ * gct_, bv_ = kk_ * ad_; \
                const f32x2 at2_ = -(kk_ * E1_), rt2_ = rr2_ * E2_, bh2_ = bv_ * Ei_, kh2_ = kd_ * Ei_, kb2_ = kd_ * E3_, bb2_ = bv_ * E3_; \
                const unsigned pa_ = cvt_pk_bf16_c(at2_.x, at2_.y), pr_ = cvt_pk_bf16_c(rt2_.x, rt2_.y), pbh_ = cvt_pk_bf16_c(bh2_.x, bh2_.y), pkh_ = cvt_pk_bf16_c(kh2_.x, kh2_.y); \
                *(LAS unsigned*)(X_ + X_ACM + lane * CMB + t_ * 2) = pa_; *(LAS unsigned*)(X_ + X_RCM + lane * CMB + t_ * 2) = pr_; \
                *(LAS unsigned*)(X_ + X_KBCM + lane * CMB + t_ * 2) = cvt_pk_bf16_c(kb2_.x, kb2_.y); *(LAS unsigned*)(X_ + X_BBCM + lane * CMB + t_ * 2) = cvt_pk_bf16_c(bb2_.x, bb2_.y); \
                *(LAS unsigned*)(Yb_ + Y_VCM + lane * CMB + t_ * 2) = cvt_pk_bf16_c(vv_.x, vv_.y); \
                *(LAS bf16_t*)(X_ + X_ATM + t_ * TMB + lane * 2) = (bf16_t)pa_; *(LAS bf16_t*)(X_ + X_ATM + (t_ + 1) * TMB + lane * 2) = (bf16_t)(pa_ >> 16); \
                *(LAS bf16_t*)(X_ + X_RTM + t_ * TMB + lane * 2) = (bf16_t)pr_; *(LAS bf16_t*)(X_ + X_RTM + (t_ + 1) * TMB + lane * 2) = (bf16_t)(pr_ >> 16); \
                *(LAS bf16_t*)(X_ + X_BHTM + t_ * TMB + lane * 2) = (bf16_t)pbh_; *(LAS bf16_t*)(X_ + X_BHTM + (t_ + 1) * TMB + lane * 2) = (bf16_t)(pbh_ >> 16); \
                *(LAS bf16_t*)(X_ + X_KHTM + t_ * TMB + lane * 2) = (bf16_t)pkh_; *(LAS bf16_t*)(X_ + X_KHTM + (t_ + 1) * TMB + lane * 2) = (bf16_t)(pkh_ >> 16); } \
            if (wave == 7) *(LAS float*)(Yb_ + Y_GC + lane * 4) = gct_; } while (0)
        { const int tid = ltid(), lane = tid & 63, gcol = hd * 64 + lane;
          { CS_LOAD(0); CS_COPY(); CS_ESUM(); }
          CS_BAR();
          { CS_LOAD(1); CS_MAIN(0); } }
        CS_BAR();
        for (int it = -1; it < NCK; ++it) {
            const bool have_next = (it + 1 < NCK);
            const int tid = ltid(), lane = tid & 63, r32 = lane & 31, h = lane >> 5, gcol = hd * 64 + lane;
            LAS unsigned char* X = lds + OFF_X + ((it + 1) & 1) * X_B; LAS unsigned char* M = lds + OFF_MID; LAS unsigned char* O = lds + OFF_OUT;
            f32x16 acc = {}, accT = {};
            if (have_next && wave < 4) {
                if (wave == 0) {
                    bf16x8 fb[4], fa[4];
#pragma unroll
                    for (int s4 = 0; s4 < 4; ++s4) { fb[s4] = *(const LAS bf16x8*)(X + X_BHTM + r32 * TMB + s4 * 32 + h * 16); fa[s4] = *(const LAS bf16x8*)(X + X_ATM + r32 * TMB + s4 * 32 + h * 16); }
#pragma unroll
                    for (int s4 = 0; s4 < 4; ++s4) { acc = __builtin_amdgcn_mfma_f32_32x32x16_bf16(fb[s4], fa[s4], acc, 0, 0, 0); accT = __builtin_amdgcn_mfma_f32_32x32x16_bf16(fa[s4], fb[s4], accT, 0, 0, 0); }
#pragma unroll
                    for (int r = 0; r < 16; ++r) accT[r] = (r32 < rho(r, h)) ? accT[r] : 0.f; }
                else if (wave == 2) mma32(acc, X + X_ATM, TMB, X + X_KHTM, TMB, 4, r32, h);
                else mma32(acc, X + ((wave & 2) ? X_KHTM : X_BHTM), TMB, X + ((wave & 1) ? X_RTM : X_ATM), TMB, 4, r32, h);
#pragma unroll
                for (int r = 0; r < 16; ++r) { const int i = rho(r, h); const bool keep = (wave == 2) ? (r32 < i) : ((wave & 1) ? (i <= r32) : (i < r32)); acc[r] = keep ? acc[r] : 0.f; }
                if (wave == 0) { }
                else if (wave == 1) st_bf_T<false>(acc, M + M_ARBT, CMB, r32, h);
                else if (wave == 2) st_bf_T<false>(acc, M + M_AAK, CMB, r32, h);
                else {
#pragma unroll
                    for (int m = 0; m < 4; ++m) *(LAS f32x4*)(M + M_ARK + r32 * 128 + (8 * m + 4 * h) * 4) = (f32x4){acc[4 * m], acc[4 * m + 1], acc[4 * m + 2], acc[4 * m + 3]}; }
            }
            if (CS_SERIAL) CS_BAR();
            if (it >= 0 && wave >= 6) {
                const int vb = wave - 6; const LAS unsigned char* Yb = lds + OFF_Y + (it & 1) * Y_B;
                bf16x8 bs[4];
#pragma unroll
                for (int s = 0; s < 2; ++s) { u32x4 w0, w1;
                    w0.x = cvt_pk_bf16_c(S0[8 * s + 0], S0[8 * s + 1]); w0.y = cvt_pk_bf16_c(S0[8 * s + 2], S0[8 * s + 3]); w0.z = cvt_pk_bf16_c(S0[8 * s + 4], S0[8 * s + 5]); w0.w = cvt_pk_bf16_c(S0[8 * s + 6], S0[8 * s + 7]);
                    w1.x = cvt_pk_bf16_c(S1[8 * s + 0], S1[8 * s + 1]); w1.y = cvt_pk_bf16_c(S1[8 * s + 2], S1[8 * s + 3]); w1.z = cvt_pk_bf16_c(S1[8 * s + 4], S1[8 * s + 5]); w1.w = cvt_pk_bf16_c(S1[8 * s + 6], S1[8 * s + 7]);
                    bs[s] = *reinterpret_cast<bf16x8*>(&w0); bs[2 + s] = *reinterpret_cast<bf16x8*>(&w1); }
                const LAS unsigned char* Vr = Yb + Y_VCM + (vb * 32 + r32) * CMB + h * 16;
                const bf16x8 bv0 = *(const LAS bf16x8*)Vr, bv1 = *(const LAS bf16x8*)(Vr + 32);
                bf16x8 fy[6], fs[6];
#pragma unroll
                for (int s = 0; s < 4; ++s) { fy[s] = *(const LAS bf16x8*)(O + O_PYT + r32 * TMB + s * 32 + h * 16); fs[s] = *(const LAS bf16x8*)(O + O_PST + r32 * TMB + s * 32 + h * 16); }
#pragma unroll
                for (int s = 0; s < 2; ++s) { fy[4 + s] = *(const LAS bf16x8*)(O + O_QYT + r32 * CMB + s * 32 + h * 16); fs[4 + s] = *(const LAS bf16x8*)(O + O_QST + r32 * CMB + s * 32 + h * 16); }
                f32x16 n0, n1;
#pragma unroll
                for (int m = 0; m < 4; ++m) { const f32x4 g0 = *(const LAS f32x4*)(Yb + Y_GC + (8 * m + 4 * h) * 4), g1 = *(const LAS f32x4*)(Yb + Y_GC + (32 + 8 * m + 4 * h) * 4);
#pragma unroll
                    for (int i = 0; i < 4; ++i) { n0[4 * m + i] = S0[4 * m + i] * g0[i]; n1[4 * m + i] = S1[4 * m + i] * g1[i]; } }
                f32x16 ya = {};
#pragma unroll
                for (int s = 0; s < 4; ++s) { ya = __builtin_amdgcn_mfma_f32_32x32x16_bf16(fy[s], bs[s], ya, 0, 0, 0); n0 = __builtin_amdgcn_mfma_f32_32x32x16_bf16(fs[s], bs[s], n0, 0, 0, 0); }
                ya = __builtin_amdgcn_mfma_f32_32x32x16_bf16(fy[4], bv0, ya, 0, 0, 0); n0 = __builtin_amdgcn_mfma_f32_32x32x16_bf16(fs[4], bv0, n0, 0, 0, 0);
                ya = __builtin_amdgcn_mfma_f32_32x32x16_bf16(fy[5], bv1, ya, 0, 0, 0); n0 = __builtin_amdgcn_mfma_f32_32x32x16_bf16(fs[5], bv1, n0, 0, 0, 0);
#pragma unroll
                for (int s = 0; s < 4; ++s) fs[s] = *(const LAS bf16x8*)(O + O_PST + (32 + r32) * TMB + s * 32 + h * 16);
#pragma unroll
                for (int s = 0; s < 2; ++s) fs[4 + s] = *(const LAS bf16x8*)(O + O_QST + (32 + r32) * CMB + s * 32 + h * 16);
#pragma unroll
                for (int r = 0; r < 16; ++r) *(LAS float*)(lds + OFF_YB + rho(r, h) * 256 + (vb * 32 + r32) * 4) = ya[r];
#pragma unroll
                for (int s = 0; s < 4; ++s) n1 = __builtin_amdgcn_mfma_f32_32x32x16_bf16(fs[s], bs[s], n1, 0, 0, 0);
                n1 = __builtin_amdgcn_mfma_f32_32x32x16_bf16(fs[4], bv0, n1, 0, 0, 0); n1 = __builtin_amdgcn_mfma_f32_32x32x16_bf16(fs[5], bv1, n1, 0, 0, 0);
                S0 = n0; S1 = n1;
            }
            if (it + 2 < NCK) { CS_COPY(); CS_ESUM(); }
            if (wave == 4 || wave == 5) {
                const int pt = tid - 256; scan::MTile m;
                if (it >= 0 && it <= NCK - 2 && moe_tile(a, jl, c + (mt0 + it) * G, m)) {
                    const LAS float* tl_ = (const LAS float*)(lds + OFF_WT); const int sn = pt >> 1, sk = (pt & 1) * 32;
                    const int n = m.n0 + sn, dr = m.grpd ? ((n >> 7) * 256 + (n & 127)) : n; bf16_t* dp = m.dst + (size_t)dr * m.ldd + m.k0 + sk;
#pragma unroll
                    for (int q8 = 0; q8 < 4; ++q8) { float f[8];
#pragma unroll
                        for (int e = 0; e < 8; ++e) f[e] = tl_[(sk + q8 * 8 + e) * 65 + sn];
                        *(__attribute__((address_space(1))) u32x4*)(dp + q8 * 8) = pack8(f); } }
                if (it + 1 < NCK - 1 && moe_tile(a, jl, c + (mt0 + it + 1) * G, m)) { const int kl = pt >> 4, nq = (pt & 15) * 4;
#pragma unroll
                    for (int p8 = 0; p8 < 8; ++p8) wreg[p8] = *(const __attribute__((address_space(1))) f32x4*)(m.src + (size_t)(m.k0 + kl + 8 * p8) * m.sld + m.n0 + nq); }
            }
            CS_BAR();
            if (have_next && wave == 0) {
                f32x16 Tm = acc, Mm = acc, Mt = accT;
#pragma unroll
                for (int r = 0; r < 16; ++r) Tm[r] += (rho(r, h) == r32) ? 1.0f : 0.f;
#define CS_SLAB(tile, s) ({ u32x4 w_; w_.x = cvt_pk_bf16_c(tile[8 * (s) + 0], tile[8 * (s) + 1]); w_.y = cvt_pk_bf16_c(tile[8 * (s) + 2], tile[8 * (s) + 3]); \
                    w_.z = cvt_pk_bf16_c(tile[8 * (s) + 4], tile[8 * (s) + 5]); w_.w = cvt_pk_bf16_c(tile[8 * (s) + 6], tile[8 * (s) + 7]); *reinterpret_cast<bf16x8*>(&w_); })
                for (int lvl = 0; lvl < 4; ++lvl) {
                    const bf16x8 m0 = CS_SLAB(Mm, 0), m1 = CS_SLAB(Mm, 1), t0_ = CS_SLAB(Mt, 0), t1_ = CS_SLAB(Mt, 1);
                    f32x16 m2 = {}, m2t = {};
                    m2 = __builtin_amdgcn_mfma_f32_32x32x16_bf16(t0_, m0, m2, 0, 0, 0); m2t = __builtin_amdgcn_mfma_f32_32x32x16_bf16(m0, t0_, m2t, 0, 0, 0);
                    m2 = __builtin_amdgcn_mfma_f32_32x32x16_bf16(t1_, m1, m2, 0, 0, 0); m2t = __builtin_amdgcn_mfma_f32_32x32x16_bf16(m1, t1_, m2t, 0, 0, 0);
                    Mm = m2; Mt = m2t;
                    { const bf16x8 a0 = CS_SLAB(Mt, 0), a1 = CS_SLAB(Mt, 1), bt0 = CS_SLAB(Tm, 0), bt1 = CS_SLAB(Tm, 1);
                      Tm = __builtin_amdgcn_mfma_f32_32x32x16_bf16(a0, bt0, Tm, 0, 0, 0); Tm = __builtin_amdgcn_mfma_f32_32x32x16_bf16(a1, bt1, Tm, 0, 0, 0); }
                }
                st_bf_T<false>(Tm, M + M_TT, CMB, r32, h);
            }
            if (CS_SERIAL) CS_BAR();
            if (it + 3 < NCK) CS_LOAD(it + 3);
            if (it + 2 < NCK) CS_MAIN(it + 2);
            if (CS_SERIAL) CS_BAR();
            if (it >= 0 && wave >= 5) {
                for (int item = tid - 320; item < 256; item += 192) { const int t = item >> 3, seg = item & 7;
                    const LAS f32x4* yp = (const LAS f32x4*)(lds + OFF_YB + t * 256 + seg * 32); const f32x4 y0 = yp[0], y1 = yp[1];
                    u32x4 w; w.x = cvt_pk_bf16(y0[0], y0[1]); w.y = cvt_pk_bf16(y0[2], y0[3]); w.z = cvt_pk_bf16(y1[0], y1[1]); w.w = cvt_pk_bf16(y1[2], y1[3]);
                    *(__attribute__((address_space(1))) u32x4*)(Y + (size_t)scan::step_row(b, dir, it * 32 + t) * 1024 + hd * 64 + seg * 8) = w; }
            }
            CS_BAR();
            if (have_next && wave < 3) {
                f32x16 d = {};
                if (wave < 2) { mma32(d, M + M_TT, CMB, X + X_ACM + wave * 32 * CMB, CMB, 2, r32, h); st_bf_T<false>(d, M + M_W + wave * 32 * CMB, CMB, r32, h); }
                else { mma32(d, M + M_TT, CMB, M + M_AAK, CMB, 2, r32, h); st_bf_T<false>(d, M + M_UP, CMB, r32, h); }
            }
            if (wave == 4 || wave == 5) { const int pt = tid - 256, kl = pt >> 4, nq = (pt & 15) * 4; scan::MTile m;
                if (it + 1 < NCK - 1 && moe_tile(a, jl, c + (mt0 + it + 1) * G, m)) { LAS float* tl_ = (LAS float*)(lds + OFF_WT);
#pragma unroll
                    for (int p8 = 0; p8 < 8; ++p8) { LAS float* tp = tl_ + (kl + 8 * p8) * 65 + nq; tp[0] = wreg[p8][0]; tp[1] = wreg[p8][1]; tp[2] = wreg[p8][2]; tp[3] = wreg[p8][3]; } } }
            CS_BAR();
            if (have_next) {
                f32x16 d = {};
                if (wave < 4) { const int kt = wave & 1, kpt = wave >> 1;
                    mma32(d, M + M_W + kt * 32 * CMB, CMB, X + X_BBCM + kpt * 32 * CMB, CMB, 2, r32, h);
                    st_bf_T<true>(d, O + O_PST + kpt * 32 * TMB + kt * 64, TMB, r32, h); }
                else if (wave < 6) { const int kt = wave - 4;
                    u32x2 ra[4];
#pragma unroll
                    for (int m = 0; m < 4; ++m) ra[m] = *(const LAS u32x2*)(X + X_RTM + r32 * TMB + (kt * 32 + 8 * m + 4 * h) * 2);
                    mma32(d, M + M_W + kt * 32 * CMB, CMB, M + M_ARBT, CMB, 2, r32, h);
#pragma unroll
                    for (int m = 0; m < 4; ++m) { d[4 * m] += bflo(ra[m].x); d[4 * m + 1] += bfhi(ra[m].x); d[4 * m + 2] += bflo(ra[m].y); d[4 * m + 3] += bfhi(ra[m].y); }
                    st_bf_T<true>(d, O + O_PYT + kt * 64, TMB, r32, h); }
                else { const int kpt = wave - 6;
                    u32x2 ka[4];
#pragma unroll
                    for (int m = 0; m < 4; ++m) ka[m] = *(const LAS u32x2*)(X + X_KBCM + (kpt * 32 + r32) * CMB + (8 * m + 4 * h) * 2);
                    mma32(d, M + M_UP, CMB, X + X_BBCM + kpt * 32 * CMB, CMB, 2, r32, h);
#pragma unroll
                    for (int m = 0; m < 4; ++m) { d[4 * m] += bflo(ka[m].x); d[4 * m + 1] += bfhi(ka[m].x); d[4 * m + 2] += bflo(ka[m].y); d[4 * m + 3] += bfhi(ka[m].y); }
                    st_bf_T<false>(d, O + O_QST + kpt * 32 * CMB, CMB, r32, h);
                    if (wave == 7) { f32x16 e = {}; f32x4 aa[4];
#pragma unroll
                        for (int m = 0; m < 4; ++m) aa[m] = *(const LAS f32x4*)(M + M_ARK + r32 * 128 + (8 * m + 4 * h) * 4);
                        mma32(e, M + M_UP, CMB, M + M_ARBT, CMB, 2, r32, h);
#pragma unroll
                        for (int m = 0; m < 4; ++m) { e[4 * m] += aa[m][0]; e[4 * m + 1] += aa[m][1]; e[4 * m + 2] += aa[m][2]; e[4 * m + 3] += aa[m][3]; }
                        st_bf_T<false>(e, O + O_QYT, CMB, r32, h); } }
            }
            CS_BAR();
        }
#undef CS_LOAD
#undef CS_COPY
#undef CS_ESUM
#undef CS_MAIN
        mt0 += NCK - 1;
    }
}


__device__ __forceinline__ void scan_compare(const Args& a, LAS unsigned char* lds, int G, int c) {
    const int tid = ltid();
    asm volatile("s_waitcnt vmcnt(0)" ::: "memory"); __syncthreads();
    for (int chain = c; chain < 256; chain += G) {
        const int b = chain >> 5, hd = (chain >> 1) & 15, dir = chain & 1;
        const bf16_t* Yo = (const bf16_t*)(a.ws + WS_ARENA + (dir ? A_YR : A_YF)); const bf16_t* Yc = (const bf16_t*)(a.ws + WS_ARENA + (dir ? A_YCR : A_YCF));
        float md = 0.f, mo = 0.f;
        for (int i = tid; i < SEG * 8; i += NTHR) { const int r = i >> 3, seg = i & 7; const size_t off = (size_t)(b * SEG + r) * 1024 + hd * 64 + seg * 8;
            u32x4 wo, wc; const unsigned* po = (const unsigned*)(Yo + off); const unsigned* pc = (const unsigned*)(Yc + off);
#pragma unroll
            for (int q = 0; q < 4; ++q) { wo[q] = __hip_atomic_load(po + q, __ATOMIC_RELAXED, __HIP_MEMORY_SCOPE_AGENT); wc[q] = __hip_atomic_load(pc + q, __ATOMIC_RELAXED, __HIP_MEMORY_SCOPE_AGENT); }
            float yo[8], yc[8]; unpack8(wo, yo); unpack8(wc, yc);
#pragma unroll
            for (int e = 0; e < 8; ++e) { md = fmaxf(md, fabsf(yo[e] - yc[e])); mo = fmaxf(mo, fabsf(yo[e])); } }
#pragma unroll
        for (int o = 32; o >= 1; o >>= 1) { md = fmaxf(md, __shfl_xor(md, o)); mo = fmaxf(mo, __shfl_xor(mo, o)); }
        LAS float* red = (LAS float*)lds;
        if ((tid & 63) == 0) { red[(tid >> 6) * 2] = md; red[(tid >> 6) * 2 + 1] = mo; }
        __syncthreads();
        if (tid == 0) { float d = 0.f, o = 0.f; for (int w = 0; w < 8; ++w) { d = fmaxf(d, red[w * 2]); o = fmaxf(o, red[w * 2 + 1]); }
            if (!(d <= CS_TOL * o)) { bf16_t* Yw = (bf16_t*)(a.ws + WS_ARENA + (dir ? A_YR : A_YF)); Yw[(size_t)(b * SEG + CTX) * 1024 + hd * 64] = (bf16_t)0x7fc0u; } }
        __syncthreads();
    }
}

__device__ __forceinline__ void rwkv_outprep(const Args& a, int j, const bf16_t* Vsrc, const bool vres, int G, int c) {
    const int lane = ltid() & 63; int r0, r1; wave_rows(G, c, r0, r1);
    const bf16_t* YF = (const bf16_t*)(a.ws + WS_ARENA + A_YF); const bf16_t* YR = (const bf16_t*)(a.ws + WS_ARENA + A_YR);
    const bf16_t* RR = (const bf16_t*)(a.ws + WS_ARENA + A_RR); const bf16_t* RK = (const bf16_t*)(a.ws + WS_ARENA + A_RK);
    const bf16_t* AL0 = (const bf16_t*)(a.ws + WS_ARENA + A_AL0); const bf16_t* AL1 = (const bf16_t*)(a.ws + WS_ARENA + A_AL1); const bf16_t* GG = (const bf16_t*)(a.ws + WS_ARENA + A_G);
    bf16_t* O = (bf16_t*)(a.ws + WS_ARENA + A_RO);
    float lnw[16], lnb[16], rk[16], ka[16];
#pragma unroll
    for (int jj = 0; jj < 2; ++jj)
#pragma unroll
        for (int e = 0; e < 8; ++e) { const int col = jj * 512 + lane * 8 + e, i = jj * 8 + e; lnw[i] = a.in[I_LNW][j * D + col]; lnb[i] = a.in[I_LNB][j * D + col]; rk[i] = a.in[I_RK][j * D + col];
            ka[i] = a.in[I_KA][j * D + col]; }
    for (int row = r0; row < r1; ++row) {
        u32x4 out[2];
#pragma unroll
        for (int jj = 0; jj < 2; ++jj) { const size_t off = (size_t)row * 1024 + jj * 512 + lane * 8;
            float yf[8], yr[8], r[8], k[8], v[8], l0[8], l1[8], g[8], y[8];
            unpack8(*(const u32x4*)(YF + off), yf); unpack8(*(const u32x4*)(YR + off), yr); unpack8(*(const u32x4*)(RR + off), r); unpack8(*(const u32x4*)(RK + off), k);
            unpack8(*(const u32x4*)(Vsrc + off), v);
            if (vres) { float vf[8], vl[8]; unpack8(*(const u32x4*)((const bf16_t*)(a.ws + WS_VF) + off), vf); unpack8(*(const u32x4*)((const bf16_t*)(a.ws + WS_ARENA + A_VL) + off), vl);
#pragma unroll
                for (int e = 0; e < 8; ++e) v[e] = v[e] + (vf[e] - v[e]) * sigmoidf_(a.in[I_V0][jj * 512 + lane * 8 + e] + vl[e]); }
            unpack8(*(const u32x4*)(AL0 + off), l0); unpack8(*(const u32x4*)(AL1 + off), l1); unpack8(*(const u32x4*)(GG + off), g);
            float sm = 0.f, dot = 0.f;
#pragma unroll
            for (int e = 0; e < 8; ++e) { const int i = jj * 8 + e; y[e] = yf[e] + yr[e]; sm += y[e];
                const float adm = 0.5f * (l0[e] + l1[e]); const float kb = k[e] * (1.0f + (adm - 1.0f) * ka[i]); dot += r[e] * kb * rk[i]; }
            sm = red8(sm); dot = red8(dot); const float mu = sm * (1.0f / 64.0f); float var = 0.f;
#pragma unroll
            for (int e = 0; e < 8; ++e) { const float d = y[e] - mu; var += d * d; }
            var = red8(var) * (1.0f / 64.0f); const float rstd = 1.0f / sqrtf(var + LNX_EPS);
            float o[8];
#pragma unroll
            for (int e = 0; e < 8; ++e) { const int i = jj * 8 + e; o[e] = ((y[e] - mu) * rstd * lnw[i] + lnb[i] + dot * v[e]) * g[e]; }
            out[jj] = pack8(o); }
        *(u32x4*)(O + (size_t)row * 1024 + lane * 8) = out[0]; *(u32x4*)(O + (size_t)row * 1024 + 512 + lane * 8) = out[1];
    }
}

__device__ __forceinline__ void moe_gather(const Args& a, LAS unsigned char* lds, int G, int c) {
    const int tid = ltid(), wave = tid >> 6, lane = tid & 63; int r0, r1; wave_rows(G, c, r0, r1);
    LAS int* cnt = (LAS int*)lds;
    if (tid < 16) cnt[tid] = 0;
    __syncthreads();
    const int* hist = (const int*)(a.ws + WS_HIST); const int nchunk = G * NWAVE, first = c * NWAVE;
    int pre[8], tot[8];
#pragma unroll
    for (int e = 0; e < 8; ++e) { pre[e] = 0; tot[e] = 0; }
    for (int ch = tid; ch < nchunk; ch += NTHR) { const u32x4 h0 = *(const u32x4*)(hist + (size_t)ch * 8), h1 = *(const u32x4*)(hist + (size_t)ch * 8 + 4); const int m = ch < first ? 1 : 0;
        tot[0] += h0[0]; tot[1] += h0[1]; tot[2] += h0[2]; tot[3] += h0[3]; tot[4] += h1[0]; tot[5] += h1[1]; tot[6] += h1[2]; tot[7] += h1[3];
        pre[0] += m * h0[0]; pre[1] += m * h0[1]; pre[2] += m * h0[2]; pre[3] += m * h0[3]; pre[4] += m * h1[0]; pre[5] += m * h1[1]; pre[6] += m * h1[2]; pre[7] += m * h1[3]; }
#pragma unroll
    for (int e = 0; e < 8; ++e) { int p = pre[e], t = tot[e];
#pragma unroll
        for (int o = 32; o >= 1; o >>= 1) { p += __shfl_xor(p, o); t += __shfl_xor(t, o); }
        if (lane == 0) { __hip_atomic_fetch_add(&cnt[e], p, __ATOMIC_RELAXED, __HIP_MEMORY_SCOPE_WORKGROUP); __hip_atomic_fetch_add(&cnt[8 + e], t, __ATOMIC_RELAXED, __HIP_MEMORY_SCOPE_WORKGROUP); } }
    __syncthreads();
    int base[9], run[8]; base[0] = 0;
#pragma unroll
    for (int e = 0; e < 8; ++e) base[e + 1] = base[e] + ((cnt[8 + e] + 255) & ~255);
    if (c == 0 && tid < 9) { int v = 0;
#pragma unroll
        for (int e = 0; e < 9; ++e) v = (tid == e) ? base[e] : v;
        ((int*)(a.ws + WS_META))[tid] = v; }
#pragma unroll
    for (int e = 0; e < 8; ++e) { int p = cnt[e];
        for (int w = 0; w < wave; ++w) p += hist[(size_t)(first + w) * 8 + e];
        run[e] = base[e] + p; }
    const bf16_t* H = (const bf16_t*)(a.ws + WS_ARENA + A_H); bf16_t* HS = (bf16_t*)(a.ws + WS_ARENA + A_HS);
    for (int row = r0; row < r1; ++row) {
        const u32x4 rt = *(const u32x4*)(a.ws + WS_ROUTE + (size_t)row * 16); const int e0 = (int)rt[0], e1 = (int)rt[1];
        if (e0 < 0) continue;
        int s0 = 0, s1 = 0;
#pragma unroll
        for (int e = 0; e < 8; ++e) { if (e == e0) { s0 = run[e]; run[e] += 1; } if (e == e1) { s1 = run[e]; run[e] += 1; } }
        const u32x4 h0 = *(const u32x4*)(H + (size_t)row * 1024 + lane * 8), h1 = *(const u32x4*)(H + (size_t)row * 1024 + 512 + lane * 8);
        *(u32x4*)(HS + (size_t)s0 * 1024 + lane * 8) = h0; *(u32x4*)(HS + (size_t)s0 * 1024 + 512 + lane * 8) = h1;
        *(u32x4*)(HS + (size_t)s1 * 1024 + lane * 8) = h0; *(u32x4*)(HS + (size_t)s1 * 1024 + 512 + lane * 8) = h1;
        if (lane == 0) { int* sl = (int*)(a.ws + WS_RSLOT) + (size_t)row * 2; sl[0] = s0; sl[1] = s1; }
    }
}
__device__ __forceinline__ void final_combine(const Args& a, int layer, int G, int c) {
    const int lane = ltid() & 63; int r0, r1; wave_rows(G, c, r0, r1);
    for (int row = r0; row < r1; ++row) { if (row % SEG < CTX) continue;
        float* xp = xrow(a, row); float x[16]; load_x16(xp, lane, x); moe_combine16(a, row, layer, lane, x); store_x16(xp, lane, x); }
}

constexpr int NPH = 42;
#define CT(k) (((PSEL) >> (k)) & 1u)
#ifndef PROBE_MASK
#define PROBE_MASK 0u
#endif
#ifndef TPROBE_MASK
#define TPROBE_MASK 0u
#endif
struct TimeProbe { int n; bool on; unsigned long long t0;
    __device__ __forceinline__ TimeProbe(bool twice, bool on_) : n(twice ? 2 : 1), on(on_), t0(0) { if (on) t0 = wall_clock64(); }
    __device__ __forceinline__ void step() { --n; if (on && n == 0) { __syncthreads(); const unsigned long long t1 = wall_clock64(), dt = t1 - t0; while (wall_clock64() - t1 < dt) __builtin_amdgcn_s_sleep(8); } } };
#define REPS(k) for (TimeProbe tp_((((PROBE_MASK) >> (k)) & 1u) != 0u, (((TPROBE_MASK) >> (k)) & 1u) != 0u); tp_.n > 0; tp_.step())
constexpr int LDS_ST_OFF = 161792;
constexpr int LDS_BYTES = LDS_ST_OFF + 64;
constexpr int TILE_OFF = 73728;
#define WSP(off) (a.ws + WS_ARENA + (off))
template <unsigned PSEL>
__global__ void __launch_bounds__(NTHR, 2) fwd(Args ka) {
    extern __shared__ __attribute__((aligned(16))) unsigned char lds_raw[];
    LAS unsigned char* lds = (LAS unsigned char*)lds_raw;
    const int Gk = gridDim.x, ck = blockIdx.x, tid = ltid();
    volatile LAS unsigned* st = (volatile LAS unsigned*)(lds + LDS_ST_OFF);
    if (tid < 4) st[tid] = 0u;
    __syncthreads();
    XcdBarrier bar; bar.bar = (unsigned*)(ka.ws + WS_CTL); bar.x = 0; bar.st = st;
    if (ka.ph_hi - ka.ph_lo > 1) bar = xcd_barrier_post((unsigned*)(ka.ws + WS_CTL), st);
#define IN(p) (ka.ph_lo <= (p) && (p) < ka.ph_hi)
#define PHB const Args a = launder_args(ka); const int G = launder_s(Gk), c = launder_s(ck); (void)G; (void)c;
#define SEAM(p) do { if (IN(p) && IN((p) + 1)) xcd_barrier(bar); } while (0)
    const size_t P1K = (size_t)256 * 1024 * 2;

    { const int jj_ = 0; const bool last_ = false;
    if (CT(20) && IN(0)) REPS(20) { PHB const bf16_t* wm = wmla(a, jj_); const bf16_t* wr_ = wrwkv(a, jj_); const bf16_t* wf = wffn(a, jj_); bf16_t* Vb = last_ ? (bf16_t*)WSP(A_RV) : (bf16_t*)(a.ws + WS_VF); (void)wm; (void)wr_; (void)wf; (void)Vb;
            { prologue_misc(a, lds, G, c); run_prep(a, lds + TILE_OFF, -1, 0, G, c); } }
    }
    SEAM(0);

    for (int jj = 0; jj < 2; ++jj) {
        const int pb = 1 + jj * 20, lm = 2 * jj, lr = 2 * jj + 1, jj_ = jj; const bool last = (jj == 1), last_ = last;

        if (CT(0) && IN(pb + 0)) REPS(0) { PHB const bf16_t* wm = wmla(a, jj_); const bf16_t* wr_ = wrwkv(a, jj_); const bf16_t* wf = wffn(a, jj_); bf16_t* Vb = last_ ? (bf16_t*)WSP(A_RV) : (bf16_t*)(a.ws + WS_VF); (void)wm; (void)wr_; (void)wf; (void)Vb;
            { if (jj == 0) norm_plain<false, true>(a, lm, a.in[I_N1G] + lm * D, 0, (bf16_t*)WSP(A_H), G, c); else combine_rows<true>(a, lm - 1, lm, a.in[I_N1G] + lm * D, 0, (bf16_t*)WSP(A_H), G, c); } }
        SEAM(pb + 0);
        if (CT(1) && IN(pb + 1)) REPS(1) { PHB const bf16_t* wm = wmla(a, jj_); const bf16_t* wr_ = wrwkv(a, jj_); const bf16_t* wf = wffn(a, jj_); bf16_t* Vb = last_ ? (bf16_t*)WSP(A_RV) : (bf16_t*)(a.ws + WS_VF); (void)wm; (void)wr_; (void)wf; (void)Vb;
            { MapSimple S{(const char*)WSP(A_H), (const char*)wm, P1K, P1K, 3, 16, 0}; EpiBf<FPlain> E{{(bf16_t*)WSP(A_QKVA), 768}};
            pg8::gemm_phase(lds, 1024, 1024, S, E, G, c); } }
        SEAM(pb + 1);
        if (CT(2) && IN(pb + 2)) REPS(2) { PHB const bf16_t* wm = wmla(a, jj_); const bf16_t* wr_ = wrwkv(a, jj_); const bf16_t* wf = wffn(a, jj_); bf16_t* Vb = last_ ? (bf16_t*)WSP(A_RV) : (bf16_t*)(a.ws + WS_VF); (void)wm; (void)wr_; (void)wf; (void)Vb;
            mla_stats(a, G, c); }
        SEAM(pb + 2);
        if (CT(3) && IN(pb + 3)) REPS(3) { PHB const bf16_t* wm = wmla(a, jj_); const bf16_t* wr_ = wrwkv(a, jj_); const bf16_t* wf = wffn(a, jj_); bf16_t* Vb = last_ ? (bf16_t*)WSP(A_RV) : (bf16_t*)(a.ws + WS_VF); (void)wm; (void)wr_; (void)wf; (void)Vb;
            { MapQKV S{(const char*)WSP(A_QKVA), (const char*)(wm + E_QKVA), (const char*)(wm + E_QKVA + E_QB)};
            EpiQKV E{(bf16_t*)WSP(A_Q), (bf16_t*)WSP(A_KV), (const float*)(a.ws + WS_RS), (const float*)(a.ws + WS_RS) + R};
            pg8::gemm_phase(lds, 768, 384, S, E, G, c); } }
        SEAM(pb + 3);
        if (CT(4) && IN(pb + 4)) REPS(4) { PHB const bf16_t* wm = wmla(a, jj_); const bf16_t* wr_ = wrwkv(a, jj_); const bf16_t* wf = wffn(a, jj_); bf16_t* Vb = last_ ? (bf16_t*)WSP(A_RV) : (bf16_t*)(a.ws + WS_VF); (void)wm; (void)wr_; (void)wf; (void)Vb;
            mla_qkpost(a, jj, G, c); }
        SEAM(pb + 4);
        if (CT(5) && IN(pb + 5)) REPS(5) { PHB const bf16_t* wm = wmla(a, jj_); const bf16_t* wr_ = wrwkv(a, jj_); const bf16_t* wf = wffn(a, jj_); bf16_t* Vb = last_ ? (bf16_t*)WSP(A_RV) : (bf16_t*)(a.ws + WS_VF); (void)wm; (void)wr_; (void)wf; (void)Vb;
            attn_phase(a, lds, G, c); }
        SEAM(pb + 5);
        if (CT(6) && IN(pb + 6)) REPS(6) { PHB const bf16_t* wm = wmla(a, jj_); const bf16_t* wr_ = wrwkv(a, jj_); const bf16_t* wf = wffn(a, jj_); bf16_t* Vb = last_ ? (bf16_t*)WSP(A_RV) : (bf16_t*)(a.ws + WS_VF); (void)wm; (void)wr_; (void)wf; (void)Vb;
            { MapSimple S{(const char*)WSP(A_O), (const char*)(wm + E_QKVA + E_QB + E_KVB), P1K, P1K, 4, 16, 0}; EpiResid E{(float*)(a.ws + WS_CS), a.out, (const float*)(a.ws + WS_MODS), lm, 2, jj == 0 ? a.in[I_CTX] : (const float*)(a.ws + WS_CS), jj == 0 ? a.in[I_X] : (const float*)a.out};
            pg8::gemm_phase(lds, 1024, 1024, S, E, G, c); } }
        SEAM(pb + 6);
        if (CT(7) && IN(pb + 7)) REPS(7) { PHB const bf16_t* wm = wmla(a, jj_); const bf16_t* wr_ = wrwkv(a, jj_); const bf16_t* wf = wffn(a, jj_); bf16_t* Vb = last_ ? (bf16_t*)WSP(A_RV) : (bf16_t*)(a.ws + WS_VF); (void)wm; (void)wr_; (void)wf; (void)Vb;
            norm_plain<false>(a, lm, a.in[I_N2G] + lm * D, 3, (bf16_t*)WSP(A_H), G, c); }
        SEAM(pb + 7);
        if (CT(8) && IN(pb + 8)) REPS(8) { PHB const bf16_t* wm = wmla(a, jj_); const bf16_t* wr_ = wrwkv(a, jj_); const bf16_t* wf = wffn(a, jj_); bf16_t* Vb = last_ ? (bf16_t*)WSP(A_RV) : (bf16_t*)(a.ws + WS_VF); (void)wm; (void)wr_; (void)wf; (void)Vb;
            { MapSimple S{(const char*)WSP(A_H), (const char*)wf, P1K, P1K, 22, 16, 0}; EpiSwiGLU E{(bf16_t*)WSP(A_FHID), DFF};
            pg8::gemm_phase(lds, 1024, 1024, S, E, G, c); } }
        SEAM(pb + 8);
        if (CT(9) && IN(pb + 9)) REPS(9) { PHB const bf16_t* wm = wmla(a, jj_); const bf16_t* wr_ = wrwkv(a, jj_); const bf16_t* wf = wffn(a, jj_); bf16_t* Vb = last_ ? (bf16_t*)WSP(A_RV) : (bf16_t*)(a.ws + WS_VF); (void)wm; (void)wr_; (void)wf; (void)Vb;
            { MapSimple S{(const char*)WSP(A_FHID), (const char*)(wf + E_F13), (size_t)256 * DFF * 2, (size_t)256 * DFF * 2, 4, 44, 0}; EpiResid E{(float*)(a.ws + WS_CS), a.out, (const float*)(a.ws + WS_MODS), lm, 5, (const float*)(a.ws + WS_CS), (const float*)a.out};
            pg8::gemm_phase(lds, DFF, DFF, S, E, G, c); } }
        SEAM(pb + 9);
        if (CT(10) && IN(pb + 10)) REPS(10) { PHB const bf16_t* wm = wmla(a, jj_); const bf16_t* wr_ = wrwkv(a, jj_); const bf16_t* wf = wffn(a, jj_); bf16_t* Vb = last_ ? (bf16_t*)WSP(A_RV) : (bf16_t*)(a.ws + WS_VF); (void)wm; (void)wr_; (void)wf; (void)Vb;
            norm_mix(a, lr, jj, G, c); }
        SEAM(pb + 10);
        if (CT(11) && IN(pb + 11)) REPS(11) { PHB const bf16_t* wm = wmla(a, jj_); const bf16_t* wr_ = wrwkv(a, jj_); const bf16_t* wf = wffn(a, jj_); bf16_t* Vb = last_ ? (bf16_t*)WSP(A_RV) : (bf16_t*)(a.ws + WS_VF); (void)wm; (void)wr_; (void)wf; (void)Vb;
            { MapRw1 S{(const char*)WSP(A_AX), (const char*)wr_, (const char*)(wr_ + E_B1), (const char*)(wr_ + E_B1 + E_B2), G};
            EpiBf<FRw1> E{{(bf16_t*)WSP(A_L1), (bf16_t*)WSP(A_RR), (bf16_t*)WSP(A_RK), Vb}};
            pg8::gemm_phase(lds, 5120, LDB1, S, E, G, c); } }
        SEAM(pb + 11);
        if (CT(12) && IN(pb + 12)) REPS(12) { PHB const bf16_t* wm = wmla(a, jj_); const bf16_t* wr_ = wrwkv(a, jj_); const bf16_t* wf = wffn(a, jj_); bf16_t* Vb = last_ ? (bf16_t*)WSP(A_RV) : (bf16_t*)(a.ws + WS_VF); (void)wm; (void)wr_; (void)wf; (void)Vb;
            { int nt4 = 4; asm volatile("" : "+s"(nt4));
            MapRw2 S{(const char*)WSP(A_L1), (const char*)(wr_ + E_B1 + E_B2 + E_L1), (const char*)(wr_ + E_B1 + E_B2 + E_L1 + E_L2A), 0, last ? 24 : 20, nt4};
            EpiRw2 E{(bf16_t*)WSP(A_WL0), (bf16_t*)WSP(A_VL), a.in[I_W0] + (size_t)jj * 2 * D, a.in[I_A0] + (size_t)jj * 2 * D}; pg8::gemm_phase(lds, 512, 256, S, E, G, c); } }
        SEAM(pb + 12);
        if (CT(13) && IN(pb + 13)) REPS(13) { PHB const bf16_t* wm = wmla(a, jj_); const bf16_t* wr_ = wrwkv(a, jj_); const bf16_t* wf = wffn(a, jj_); bf16_t* Vb = last_ ? (bf16_t*)WSP(A_RV) : (bf16_t*)(a.ws + WS_VF); (void)wm; (void)wr_; (void)wf; (void)Vb;
            { if (SCAN_CHUNKED) scan_chunked(a, jj, Vb, last, lds, G, c); if (!SCAN_CHUNKED || CS_BOTH) { __syncthreads(); scan_phase(a, jj, Vb, last, lds, G, c); }
              if (SCAN_CHUNKED && CS_BOTH) scan_compare(a, lds, G, c); } }
        SEAM(pb + 13);
        if (CT(14) && IN(pb + 14)) REPS(14) { PHB const bf16_t* wm = wmla(a, jj_); const bf16_t* wr_ = wrwkv(a, jj_); const bf16_t* wf = wffn(a, jj_); bf16_t* Vb = last_ ? (bf16_t*)WSP(A_RV) : (bf16_t*)(a.ws + WS_VF); (void)wm; (void)wr_; (void)wf; (void)Vb;
            rwkv_outprep(a, jj, Vb, last, G, c); }
        SEAM(pb + 14);
        if (CT(15) && IN(pb + 15)) REPS(15) { PHB const bf16_t* wm = wmla(a, jj_); const bf16_t* wr_ = wrwkv(a, jj_); const bf16_t* wf = wffn(a, jj_); bf16_t* Vb = last_ ? (bf16_t*)WSP(A_RV) : (bf16_t*)(a.ws + WS_VF); (void)wm; (void)wr_; (void)wf; (void)Vb;
            { MapSimple S{(const char*)WSP(A_RO), (const char*)(wr_ + E_B1 + E_B2 + E_L1 + E_L2A + E_L2B), P1K, P1K, 4, 16, last ? 1 : 0}; EpiResid E{(float*)(a.ws + WS_CS), a.out, (const float*)(a.ws + WS_MODS), lr, 2, (const float*)(a.ws + WS_CS), (const float*)a.out};
            pg8::gemm_phase(lds, 1024, 1024, S, E, G, c); } }
        SEAM(pb + 15);
        if (CT(16) && IN(pb + 16)) REPS(16) { PHB const bf16_t* wm = wmla(a, jj_); const bf16_t* wr_ = wrwkv(a, jj_); const bf16_t* wf = wffn(a, jj_); bf16_t* Vb = last_ ? (bf16_t*)WSP(A_RV) : (bf16_t*)(a.ws + WS_VF); (void)wm; (void)wr_; (void)wf; (void)Vb;
            { norm_router(a, lr, jj, last, lds, G, c); run_prep(a, lds + TILE_OFF, jj, CS_NOTILE ? 0 : (SCAN_CHUNKED ? cs::NCK - 1 : scan::NCH - 2), G, c);   } }
        SEAM(pb + 16);
        if (CT(17) && IN(pb + 17)) REPS(17) { PHB const bf16_t* wm = wmla(a, jj_); const bf16_t* wr_ = wrwkv(a, jj_); const bf16_t* wf = wffn(a, jj_); bf16_t* Vb = last_ ? (bf16_t*)WSP(A_RV) : (bf16_t*)(a.ws + WS_VF); (void)wm; (void)wr_; (void)wf; (void)Vb;
            moe_gather(a, lds, G, c); }
        SEAM(pb + 17);
        if (CT(18) && IN(pb + 18)) REPS(18) { PHB const bf16_t* wm = wmla(a, jj_); const bf16_t* wr_ = wrwkv(a, jj_); const bf16_t* wf = wffn(a, jj_); bf16_t* Vb = last_ ? (bf16_t*)WSP(A_RV) : (bf16_t*)(a.ws + WS_VF); (void)wm; (void)wr_; (void)wf; (void)Vb;
            { MapMoe S{(const char*)WSP(A_HS), (const char*)WSP(A_WM13), P1K, E_M13 * 2, P1K, 28, 16, (const int*)(a.ws + WS_META)}; EpiSwiGLU E{(bf16_t*)WSP(A_MHID), DFE};
            pg8::gemm_phase(lds, 1024, 1024, S, E, G, c); } }
        SEAM(pb + 18);
        if (CT(19) && IN(pb + 19)) REPS(19) { PHB const bf16_t* wm = wmla(a, jj_); const bf16_t* wr_ = wrwkv(a, jj_); const bf16_t* wf = wffn(a, jj_); bf16_t* Vb = last_ ? (bf16_t*)WSP(A_RV) : (bf16_t*)(a.ws + WS_VF); (void)wm; (void)wr_; (void)wf; (void)Vb;
            { MapMoeDown S{(const char*)WSP(A_MHID), (const char*)WSP(A_WM2), (size_t)256 * DFE * 2, E_M2 * 2, (size_t)256 * DFE * 2, (const int*)(a.ws + WS_META)}; EpiBf<FPlainAux> E{{(bf16_t*)WSP(A_Y2), 1024}};
            pg8::gemm_phase(lds, DFE, DFE, S, E, G, c); } }
        SEAM(pb + 19);
    }
    { const int jj_ = 1; const bool last_ = true;
    if (CT(21) && IN(41)) REPS(21) { PHB const bf16_t* wm = wmla(a, jj_); const bf16_t* wr_ = wrwkv(a, jj_); const bf16_t* wf = wffn(a, jj_); bf16_t* Vb = last_ ? (bf16_t*)WSP(A_RV) : (bf16_t*)(a.ws + WS_VF); (void)wm; (void)wr_; (void)wf; (void)Vb;
            combine_rows<false>(a, 3, 0, nullptr, 0, nullptr, G, c); }
    }
#undef IN
#undef SEAM
}

typedef void (*KernFn)(Args);
#if MK_ONE_LAUNCH
#ifndef PMASK
#define PMASK 0x3fffffu
#endif
static KernFn kern_of(int) { return fwd<PMASK>; }
#else
static KernFn kern_of(int p) {
    static const KernFn tab[22] = { fwd<1u << 0>, fwd<1u << 1>, fwd<1u << 2>, fwd<1u << 3>, fwd<1u << 4>, fwd<1u << 5>, fwd<1u << 6>, fwd<1u << 7>, fwd<1u << 8>, fwd<1u << 9>, fwd<1u << 10>, fwd<1u << 11>, fwd<1u << 12>, fwd<1u << 13>, fwd<1u << 14>, fwd<1u << 15>, fwd<1u << 16>, fwd<1u << 17>, fwd<1u << 18>, fwd<1u << 19>, fwd<1u << 20>, fwd<1u << 21> };
    return tab[p == 0 ? 20 : (p == NPH - 1 ? 21 : (p - 1) % 20)];
}
#endif
extern "C" void kernel_launch(void* const* d_in, const int* in_sizes, int n_in, void* d_out, int out_size, void* d_ws, size_t ws_size, hipStream_t stream) {
    static int grid = 0;
    if (grid == 0) {
        if (n_in != N_IN || out_size != NB * SEQ * D || ws_size < WS_NEED) { fprintf(stderr, "kernel_launch: unexpected shapes: n_in %d out %d ws %zu (need %zu)\n", n_in, out_size, ws_size, (size_t)WS_NEED); grid = -1; return; }
        int dev = 0, cus = 0;
        if (hipGetDevice(&dev) != hipSuccess || hipDeviceGetAttribute(&cus, hipDeviceAttributeMultiprocessorCount, dev) != hipSuccess) { grid = -1; return; }
        for (int p = 0; p < NPH; ++p)
            if (hipFuncSetAttribute((const void*)kern_of(p), hipFuncAttributeMaxDynamicSharedMemorySize, LDS_BYTES) != hipSuccess) { fprintf(stderr, "kernel_launch: hipFuncSetAttribute failed\n"); grid = -1; return; }
        int per_cu = 0;
        if (hipOccupancyMaxActiveBlocksPerMultiprocessor(&per_cu, (const void*)kern_of(1), NTHR, LDS_BYTES) != hipSuccess || per_cu < 1) { fprintf(stderr, "kernel_launch: occupancy query says %d blocks per CU\n", per_cu); (void)hipGetLastError(); }
        grid = cus < 256 ? cus : 256;
    }
    if (grid < 0) return;
    (void)in_sizes;
    (void)hipMemsetAsync((char*)d_ws + WS_CTL, 0, CTL_BYTES, stream);
    Args a{};
    for (int i = 0; i < N_IN; ++i) a.in[i] = (const float*)d_in[i];
    a.out = (float*)d_out; a.ws = (unsigned char*)d_ws;
#if MK_ONE_LAUNCH
    a.ph_lo = 0; a.ph_hi = NPH;
    hipLaunchKernelGGL(kern_of(0), dim3(grid), dim3(NTHR), LDS_BYTES, stream, a);
#else
    for (int p = 0; p < NPH; ++p) { a.ph_lo = p; a.ph_hi = p + 1; hipLaunchKernelGGL(kern_of(p), dim3(grid), dim3(NTHR), LDS_BYTES, stream, a); }
#endif
    const hipError_t le = hipPeekAtLastError();
    if (le != hipSuccess) fprintf(stderr, "kernel_launch: launch failed: %s\n", hipGetErrorName(le));
}
```

```cpp
#include <hip/hip_runtime.h>
#include <cstdio>
#include <cstdint>
#ifndef SCAN_CHUNKED
#define SCAN_CHUNKED 1
#endif
#ifndef CS_SERIAL
#define CS_SERIAL 0
#endif
#ifndef CS_BOTH
#define CS_BOTH 0
#endif
#ifndef CS_NOTILE
#define CS_NOTILE 0
#endif
#ifndef CS_OOP
#define CS_OOP 0
#endif
#ifndef CS_TOL
#define CS_TOL 0.05f
#endif

#ifndef OVERLAP_TAIL
#define OVERLAP_TAIL 1
#endif
#ifndef MK_ONE_LAUNCH
#define MK_ONE_LAUNCH 1
#endif

#define LAS __attribute__((address_space(3)))
typedef unsigned short bf16_t;
typedef short bf16x8 __attribute__((ext_vector_type(8)));
typedef short s16x4 __attribute__((ext_vector_type(4)));
typedef float f32x2 __attribute__((ext_vector_type(2)));
typedef float f32x4 __attribute__((ext_vector_type(4)));
typedef float f32x16 __attribute__((ext_vector_type(16)));
typedef unsigned u32x2 __attribute__((ext_vector_type(2)));
typedef unsigned u32x4 __attribute__((ext_vector_type(4)));

constexpr int D = 1024, NB = 8, SEQ = 4096, CTX = 256, SEG = SEQ + CTX, R = NB * SEG;
constexpr int NPAN = R / 256;
constexpr int NTHR = 512, NWAVE = 8;
constexpr int QL = 384, KVL = 256, ROPE = 64, NOPE = 128, QKH = 192, VH = 128, NH = 8;
constexpr int DFF = 2816, NE = 8, DFE = 3584;
constexpr int MP_MAX = 71680;
constexpr float NORM_EPS = 1e-6f, LNX_EPS = 64e-5f;
constexpr float QSCALE = 0.07216878364870322f * 1.4426950408889634f;

enum { I_X = 0, I_C, I_CTX, I_CCTX, I_ADAW, I_ADAB, I_N1G, I_N2G, I_WQA, I_QAN, I_WQB, I_WKVA, I_KVAN, I_WKVB, I_QN, I_KN, I_MWO,
       I_MIX, I_WR, I_WK, I_WV, I_RWO, I_W0, I_W1, I_W2, I_A0, I_A1, I_A2, I_G1, I_G2, I_KK, I_KA, I_RK, I_LNW, I_LNB, I_V0, I_V1, I_V2,
       I_F1, I_F3, I_F2, I_ROUTER, I_M1, I_M3, I_M2, N_IN };

constexpr size_t U = (size_t)R * 1024 * 2;
constexpr size_t al256(size_t x) { return (x + 255) / 256 * 256; }
constexpr size_t WS_CTL = 0;
constexpr size_t CTL_BYTES = 65536;
constexpr size_t WS_MODS = WS_CTL + CTL_BYTES;
constexpr size_t WS_ROPE = WS_MODS + al256((size_t)4 * 9 * 6144 * 4);
constexpr size_t WS_CS = WS_ROPE + 8192;
constexpr size_t WS_RS = WS_CS + (size_t)NB * CTX * D * 4;
constexpr size_t WS_ROUTE = WS_RS + al256((size_t)R * 8);
constexpr size_t WS_RSLOT = WS_ROUTE + (size_t)R * 16;
constexpr size_t WS_HIST = WS_RSLOT + (size_t)R * 8;
constexpr size_t WS_META = WS_HIST + 2048 * 8 * 4;
constexpr size_t WS_WSM = WS_META + 256;
constexpr size_t E_QKVA = 768 * 1024, E_QB = 1536 * 384, E_KVB = 2048 * 384, E_MWO = 1024 * 1024, E_MLA = E_QKVA + E_QB + E_KVB + E_MWO;
constexpr int LDB1 = 2048 + 64;
constexpr size_t E_B1 = 1024 * LDB1, E_B2 = 1024 * LDB1, E_L1 = 512 * LDB1, E_L2A = 4096 * 256, E_L2B = 2048 * 256, E_RWO = 1024 * 1024, E_RWKV = E_B1 + E_B2 + E_L1 + E_L2A + E_L2B + E_RWO;
constexpr size_t E_F13 = 5632 * 1024, E_F2 = 1024 * 2816, E_FFN = E_F13 + E_F2;
constexpr size_t WS_WMLA = WS_WSM, WS_WRWKV = WS_WMLA + 2 * E_MLA * 2, WS_WFFN = WS_WRWKV + 2 * E_RWKV * 2;
constexpr size_t WS_VF = WS_WFFN + 2 * E_FFN * 2;
constexpr size_t WS_ARENA = WS_VF + U;
constexpr size_t A_H = 0;
constexpr int LDKV = 2048 + 64;
constexpr size_t A_QKVA = U, A_Q = 2 * U, A_KV = 2 * U + U * 3 / 2, A_K = A_KV + al256((size_t)R * LDKV * 2), A_O = A_K + U * 3 / 2;
constexpr size_t A_FHID = 5 * U;
constexpr size_t A_AX = 0, A_L1 = 5 * U, A_RR = A_L1 + U / 2, A_RK = A_RR + U, A_RV = A_RK + U, A_VL = A_RV + U, A_REND = A_VL + U;
constexpr size_t A_WL0 = 0, A_WL1 = U, A_AL0 = 2 * U, A_AL1 = 3 * U, A_G = 4 * U, A_RO = 0;
constexpr size_t A_YF = (SCAN_CHUNKED && CS_OOP && !CS_BOTH) ? A_REND : A_WL0, A_YR = (SCAN_CHUNKED && CS_OOP && !CS_BOTH) ? A_REND + U : A_WL1;
constexpr size_t A_YCF = CS_BOTH ? A_REND : A_YF, A_YCR = CS_BOTH ? A_REND + U : A_YR;
constexpr size_t A_HS = U, A_Y2 = U, A_MHID = A_HS + (size_t)MP_MAX * 1024 * 2, A_MEND = A_MHID + (size_t)MP_MAX * DFE * 2;
constexpr size_t E_M13 = (size_t)7168 * 1024, E_M2 = (size_t)1024 * 3584;
constexpr size_t A_WM13 = A_MEND, A_WM2 = A_WM13 + NE * E_M13 * 2, A_END = A_WM2 + NE * E_M2 * 2;
constexpr size_t WS_NEED = WS_ARENA + (A_END > A_REND ? A_END : A_REND);
static_assert(WS_NEED <= 1081188352ull, "workspace budget (sum of inputs)");
static_assert(CS_OOP || CS_BOTH || A_WM13 >= A_REND, "the MoE weight region must be free during the RWKV mixer (weights are converted inside the scan phase)");

struct Args { const float* in[N_IN]; float* out; unsigned char* ws; int ph_lo, ph_hi; };

__device__ __forceinline__ unsigned cvt_pk_bf16(float lo, float hi) { unsigned r; asm("v_cvt_pk_bf16_f32 %0, %1, %2" : "=v"(r) : "v"(lo), "v"(hi)); return r; }
__device__ __forceinline__ float bflo(unsigned w) { return __uint_as_float(w << 16); }
__device__ __forceinline__ float bfhi(unsigned w) { return __uint_as_float(w & 0xffff0000u); }
__device__ __forceinline__ void unpack8(const u32x4 w, float (&f)[8]) { f[0] = bflo(w.x); f[1] = bfhi(w.x); f[2] = bflo(w.y); f[3] = bfhi(w.y); f[4] = bflo(w.z); f[5] = bfhi(w.z); f[6] = bflo(w.w); f[7] = bfhi(w.w); }
__device__ __forceinline__ u32x4 pack8(const float (&f)[8]) { u32x4 w; w.x = cvt_pk_bf16(f[0], f[1]); w.y = cvt_pk_bf16(f[2], f[3]); w.z = cvt_pk_bf16(f[4], f[5]); w.w = cvt_pk_bf16(f[6], f[7]); return w; }
__device__ __forceinline__ float wave_sum(float v) {
#pragma unroll
    for (int o = 32; o >= 1; o >>= 1) v += __shfl_xor(v, o);
    return v;
}
template <int CTRL> __device__ __forceinline__ float dpp_f(float v) { return __int_as_float(__builtin_amdgcn_update_dpp(0, __float_as_int(v), CTRL, 0xF, 0xF, true)); }
__device__ __forceinline__ float red8(float v) { v += dpp_f<0xB1>(v); v += dpp_f<0x4E>(v); v += dpp_f<0x141>(v); return v; }
__device__ __forceinline__ int ltid() { int t = threadIdx.x; asm volatile("" : "+v"(t)); return t; }
template <class T> __device__ __forceinline__ T launder_s(T x) { asm volatile("" : "+s"(x)); return x; }
__device__ __forceinline__ Args launder_args(const Args& k) { Args a = k; a.ws = launder_s(k.ws); a.out = launder_s(k.out); return a; }
__device__ __forceinline__ float wave_sum_dpp(float v) {
    v += dpp_f<0xB1>(v); v += dpp_f<0x4E>(v); v += dpp_f<0x141>(v); v += dpp_f<0x140>(v);
    const int iv = __float_as_int(v);
    return (__int_as_float(__builtin_amdgcn_readlane(iv, 0)) + __int_as_float(__builtin_amdgcn_readlane(iv, 16))) + (__int_as_float(__builtin_amdgcn_readlane(iv, 32)) + __int_as_float(__builtin_amdgcn_readlane(iv, 48)));
}
__device__ __forceinline__ float sigmoidf_(float x) { return __builtin_amdgcn_rcpf(1.0f + __expf(-x)); }
__device__ __forceinline__ float* xrow(const Args& a, int row) {
    const int b = row / SEG, r = row - b * SEG;
    return r < CTX ? (float*)(a.ws + WS_CS) + (size_t)(b * CTX + r) * D : a.out + (size_t)(b * SEQ + r - CTX) * D;
}
__device__ __forceinline__ const float* xrow_in(const Args& a, int row) {
    const int b = row / SEG, r = row - b * SEG;
    return r < CTX ? a.in[I_CTX] + (size_t)(b * CTX + r) * D : a.in[I_X] + (size_t)(b * SEQ + r - CTX) * D;
}
__device__ __forceinline__ int mod_index(int row) { const int b = row / SEG, r = row - b * SEG; return r < CTX ? 8 : b; }
__device__ __forceinline__ const float* mods_ptr(const Args& a, int layer, int mi, int which) { return (const float*)(a.ws + WS_MODS) + ((size_t)(layer * 9 + mi) * 6 + which) * 1024; }

#define XB_TMO      128
#define XB_XCNT(j)  (256  + 64 * (j))
#define XB_XSUB(j)  (1280 + 64 * (j))
#define XB_XGEN(j)  (2304 + 64 * (j))
#define XB_TOP      3328
#define XB_TOPGEN   3392
#define XCD_BAR_WORDS 3456
#define XB_SPIN_CAP (1u << 22)
__device__ __forceinline__ unsigned xb_ld(unsigned* p)              { return __hip_atomic_load(p, __ATOMIC_RELAXED, __HIP_MEMORY_SCOPE_AGENT); }
__device__ __forceinline__ unsigned xb_add(unsigned* p, unsigned v) { return __hip_atomic_fetch_add(p, v, __ATOMIC_RELAXED, __HIP_MEMORY_SCOPE_AGENT); }
__device__ __forceinline__ unsigned xb_xcc_id() { return (unsigned)__builtin_amdgcn_s_getreg((3 << 11) | 20) & 0xFu; }
#define XB_SPIN(cond, bar) do { unsigned _sp = 0; while (cond) { __builtin_amdgcn_s_sleep(1); \
    if ((++_sp & 255u) == 0u) { if (xb_ld(&(bar)[XB_TMO])) break; if (_sp > XB_SPIN_CAP) { atomicAdd(&(bar)[XB_TMO], 1u); break; } } } } while (0)
struct XcdBarrier { unsigned* bar; unsigned x; volatile LAS unsigned* st; };
__device__ __forceinline__ XcdBarrier xcd_barrier_post(unsigned* bar, volatile LAS unsigned* st) {
    XcdBarrier b; b.bar = bar; b.x = xb_xcc_id(); b.st = st;
    if (threadIdx.x == 0) (void)xb_add(&bar[XB_XCNT(b.x)], 1u);
    return b;
}
__device__ __forceinline__ void xcd_barrier_complete(unsigned* bar, unsigned x, unsigned& nloc, unsigned& nx) {
    const unsigned G = gridDim.x * gridDim.y * gridDim.z;
    unsigned sum, cnt, mine, sp = 0u;
    for (;;) {
        sum = 0u; cnt = 0u; mine = 0u;
#pragma unroll
        for (unsigned j = 0; j < 16; ++j) { const unsigned c = xb_ld(&bar[XB_XCNT(j)]); sum += c; cnt += (c > 0u) ? 1u : 0u; mine = (j == x) ? c : mine; }
        if (sum == G) break;
        __builtin_amdgcn_s_sleep(1);
        if ((++sp & 255u) == 0u) { if (xb_ld(&bar[XB_TMO])) break; if (sp > XB_SPIN_CAP) { atomicAdd(&bar[XB_TMO], 1u); break; } }
    }
    nloc = mine > 0u ? mine : 1u; nx = cnt > 0u ? cnt : 1u;
}
__device__ __forceinline__ void xcd_barrier(const XcdBarrier& b) {
    asm volatile("s_waitcnt vmcnt(0)" ::: "memory");
    __syncthreads();
    if (threadIdx.x == 0) {
        unsigned* bar = b.bar;
        __builtin_amdgcn_s_waitcnt(0);
        unsigned nloc = b.st[0], nx = b.st[1];
        if (nloc == 0u) { xcd_barrier_complete(bar, b.x, nloc, nx); b.st[0] = nloc; b.st[1] = nx; }
        const unsigned old = xb_add(&bar[XB_XSUB(b.x)], 1u);
        const unsigned gen = old / nloc;
        if (old + 1u == (gen + 1u) * nloc) {
            __builtin_amdgcn_fence(__ATOMIC_RELEASE, "agent");
            asm volatile("s_waitcnt vmcnt(0)" ::: "memory");
            const unsigned og = xb_add(&bar[XB_TOP], 1u);
            const unsigned tg = og / nx;
            if (og + 1u == (tg + 1u) * nx) xb_add(&bar[XB_TOPGEN], 1u);
            else XB_SPIN(xb_ld(&bar[XB_TOPGEN]) == tg, bar);
            __builtin_amdgcn_fence(__ATOMIC_ACQUIRE, "agent");
            xb_add(&bar[XB_XGEN(b.x)], 1u);
            asm volatile("s_waitcnt vmcnt(0)" ::: "memory");
        } else {
            XB_SPIN(xb_ld(&bar[XB_XGEN(b.x)]) == gen, bar);
            __builtin_amdgcn_fence(__ATOMIC_ACQUIRE, "agent");
            asm volatile("s_waitcnt vmcnt(0)" ::: "memory");
        }
    }
    __syncthreads();
}

namespace pg8 {
constexpr int BM = 256, BK = 64, HALF = 128, HTB = HALF * BK * 2, STAGE_BYTES = 8 * HTB;
__device__ __forceinline__ int lds_byte(int r, int c) { const int st = (r >> 4) * 2 + (c >> 5), rr = r & 15, cc = c & 31, ob = rr * 64 + cc * 2; return st * 1024 + (ob ^ (((ob >> 9) & 1) << 5)); }
__device__ __forceinline__ void stage_rc(int b, int& Rr, int& C) { const int st = b / 1024, sb = b % 1024, swz = sb ^ (((sb >> 9) & 1) << 5); Rr = (st >> 1) * 16 + swz / 64; C = (st & 1) * 32 + (swz % 64) / 2; }
__device__ __forceinline__ int perm32(int rho) { const int n = rho >> 4, i = rho & 15; return 8 * (i >> 2) + 4 * n + (i & 3); }
struct GUnit { const char* A; const char* B; int nt, pm, pn, aux; };
__device__ __forceinline__ void tile_order(int L, int nM, int nN, int& pm, int& pn) {
    const int nwg = nM * nN; int wgid = L;
    { const int q = nwg / 8, r = nwg % 8, xcd = wgid % 8, off = wgid / 8; wgid = (xcd < r ? xcd * (q + 1) : r * (q + 1) + (xcd - r) * q) + off; }
    const int nig = 8 * nN, gid = wgid / nig, fm = gid * 8, gsz = (nM - fm) < 8 ? (nM - fm) : 8;
    pm = fm + ((wgid % nig) % gsz); pn = (wgid % nig) / gsz;
}
template <class Epi, class Map>
__device__ __forceinline__ void gemm_phase(LAS unsigned char* lds, const int lda, const int ldb, const Map& S, const Epi& E, const int G, const int c) {
    const int tid = ltid(), wid = __builtin_amdgcn_readfirstlane(tid >> 6), lane = tid & 63, wr = wid >> 2, wc = wid & 3, fr = lane & 15, fq = lane >> 4;
    unsigned voffA[2], voffB[2];
#pragma unroll
    for (int i = 0; i < 2; ++i) { int Rr, C; stage_rc(tid * 16 + i * 8192, Rr, C); const int Rb = Epi::PERM ? ((Rr & ~31) + perm32(Rr & 31)) : Rr;
        voffA[i] = (unsigned)(Rr * lda + C) * 2u; voffB[i] = (unsigned)(Rb * ldb + C) * 2u; }
    const size_t kstep = (size_t)(BK * 2);
    const size_t hA = (size_t)HALF * lda * 2, hB = (size_t)HALF * ldb * 2;
    const unsigned ldsw = (unsigned)wid * 1024u;
    const int aoff = lds_byte(wr * 64 + fr, fq * 8), boff = lds_byte(wc * 32 + fr, fq * 8);
#define PG8_SA(b, h) (((b) * 2 + (h)) * HTB)
#define PG8_SB(b, h) ((4 + (b) * 2 + (h)) * HTB)
#define PG8_STAGE(bufoff, gbase, voff) do { _Pragma("unroll") for (int _i = 0; _i < 2; ++_i) \
        __builtin_amdgcn_global_load_lds((const unsigned*)((const char*)(gbase) + (voff)[_i]), (LAS unsigned*)(lds + (bufoff) + ldsw + _i * 8192), 16, 0, 0); } while (0)
#define PG8_LDA(dst, b, h) do { _Pragma("unroll") for (int m = 0; m < 4; ++m) _Pragma("unroll") for (int k = 0; k < 2; ++k) dst[m][k] = *(const LAS bf16x8*)(lds + PG8_SA(b, h) + aoff + m * 2048 + k * 1024); } while (0)
#define PG8_LDB(dst, b, h) do { _Pragma("unroll") for (int n = 0; n < 2; ++n) _Pragma("unroll") for (int k = 0; k < 2; ++k) dst[n][k] = *(const LAS bf16x8*)(lds + PG8_SB(b, h) + boff + n * 2048 + k * 1024); } while (0)
#define PG8_MMA(ai, bj, At, Bt) do { __builtin_amdgcn_s_setprio(1); _Pragma("unroll") for (int m = 0; m < 4; ++m) _Pragma("unroll") for (int n = 0; n < 2; ++n) _Pragma("unroll") for (int k = 0; k < 2; ++k) \
        acc[ai][bj][m][n] = __builtin_amdgcn_mfma_f32_16x16x32_bf16(Bt[n][k], At[m][k], acc[ai][bj][m][n], 0, 0, 0); __builtin_amdgcn_s_setprio(0); } while (0)
#define PG8_WAIT_V(n) asm volatile("s_waitcnt vmcnt(" #n ")" ::: "memory")
#define PG8_WAIT_L(n) asm volatile("s_waitcnt lgkmcnt(" #n ")" ::: "memory")
#define PG8_BAR __builtin_amdgcn_s_barrier()
#define PG8_SCHED __builtin_amdgcn_sched_barrier(0)
    GUnit cur, nxt; int ui = 0;
    if (!S(c, cur)) return;
    f32x4 acc[2][2][4][2];
#pragma unroll
    for (int a = 0; a < 2; ++a)
#pragma unroll
        for (int b = 0; b < 2; ++b)
#pragma unroll
            for (int m = 0; m < 4; ++m)
#pragma unroll
                for (int n = 0; n < 2; ++n) acc[a][b][m][n] = (f32x4){0.f, 0.f, 0.f, 0.f};
    bf16x8 At[4][2], B0[2][2], B1[2][2];
    const char* cA = cur.A; const char* cB = cur.B;
    PG8_STAGE(PG8_SB(0, 0), cB, voffB); PG8_STAGE(PG8_SB(0, 1), cB + hB, voffB); PG8_STAGE(PG8_SA(0, 0), cA, voffA); PG8_STAGE(PG8_SA(0, 1), cA + hA, voffA);
    if (wr == 1) PG8_BAR;
    PG8_WAIT_V(2); PG8_BAR;
    PG8_STAGE(PG8_SB(1, 0), cB + kstep, voffB); PG8_STAGE(PG8_SA(1, 0), cA + kstep, voffA); PG8_STAGE(PG8_SB(1, 1), cB + hB + kstep, voffB);
    PG8_WAIT_V(6); PG8_BAR;
    for (;;) {
        const bool has_next = S((ui + 1) * G + c, nxt);
        const char* nA = has_next ? nxt.A : cA; const char* nB = has_next ? nxt.B : cB;
        const int nt = cur.nt;
        for (int t = 0; t < nt; t += 2) {
            const bool last = (t == nt - 2);
            const char* a1 = cA + (size_t)(t + 1) * kstep;
            const char* a2 = last ? nA : cA + (size_t)(t + 2) * kstep; const char* b2 = last ? nB : cB + (size_t)(t + 2) * kstep;
            const char* a3 = a2 + kstep; const char* b3 = b2 + kstep;
            PG8_LDB(B0, 0, 0); PG8_LDB(B1, 0, 1); PG8_SCHED; PG8_LDA(At, 0, 0); PG8_STAGE(PG8_SA(1, 1), a1 + hA, voffA);
            PG8_WAIT_V(8); PG8_WAIT_L(0); PG8_BAR; PG8_MMA(0, 0, At, B0); PG8_MMA(0, 1, At, B1); PG8_BAR; PG8_SCHED;
            PG8_LDA(At, 0, 1); PG8_STAGE(PG8_SB(0, 0), b2, voffB); PG8_STAGE(PG8_SB(0, 1), b2 + hB, voffB); PG8_STAGE(PG8_SA(0, 0), a2, voffA);
            PG8_WAIT_V(8); PG8_WAIT_L(0); PG8_BAR; PG8_MMA(1, 0, At, B0); PG8_MMA(1, 1, At, B1); PG8_BAR; PG8_SCHED;
            PG8_LDB(B0, 1, 0); PG8_LDB(B1, 1, 1); PG8_SCHED; PG8_LDA(At, 1, 0); PG8_STAGE(PG8_SA(0, 1), a2 + hA, voffA);
            PG8_WAIT_V(8); PG8_WAIT_L(0); PG8_BAR; PG8_MMA(0, 0, At, B0); PG8_MMA(0, 1, At, B1); PG8_BAR; PG8_SCHED;
            PG8_LDA(At, 1, 1); PG8_STAGE(PG8_SB(1, 0), b3, voffB); PG8_STAGE(PG8_SB(1, 1), b3 + hB, voffB); PG8_STAGE(PG8_SA(1, 0), a3, voffA);
            PG8_WAIT_V(8); PG8_WAIT_L(0); PG8_BAR; PG8_MMA(1, 0, At, B0); PG8_MMA(1, 1, At, B1); PG8_BAR; PG8_SCHED;
        }
        if (wr == 0) PG8_BAR;
        E(acc, cur, wr, wc, fr, fq);
        if (!has_next) break;
#pragma unroll
        for (int a = 0; a < 2; ++a)
#pragma unroll
            for (int b = 0; b < 2; ++b)
#pragma unroll
                for (int m = 0; m < 4; ++m)
#pragma unroll
                    for (int n = 0; n < 2; ++n) acc[a][b][m][n] = (f32x4){0.f, 0.f, 0.f, 0.f};
        cur = nxt; cA = nA; cB = nB; ++ui;
        if (wr == 1) PG8_BAR;
    }
    PG8_WAIT_V(0);
    PG8_BAR;
#undef PG8_SA
#undef PG8_SB
#undef PG8_STAGE
#undef PG8_LDA
#undef PG8_LDB
#undef PG8_MMA
#undef PG8_WAIT_V
#undef PG8_WAIT_L
#undef PG8_BAR
#undef PG8_SCHED
}
}

using pg8::GUnit;
typedef f32x4 Acc[2][2][4][2];
template <class F> struct EpiBf {
    static constexpr bool PERM = true;
    F f;
    __device__ __forceinline__ void operator()(const Acc& acc, const GUnit& u, int wr, int wc, int fr, int fq) const {
#pragma unroll
        for (int ai = 0; ai < 2; ++ai)
#pragma unroll
            for (int m = 0; m < 4; ++m) { const int trow = ai * 128 + wr * 64 + m * 16 + fr;
#pragma unroll
                for (int bj = 0; bj < 2; ++bj) f(acc[ai][bj][m][0], acc[ai][bj][m][1], u, trow, bj * 128 + wc * 32 + 8 * fq); }
    }
};
__device__ __forceinline__ void st8(bf16_t* p, f32x4 v0, f32x4 v1) { u32x4 w; w.x = cvt_pk_bf16(v0[0], v0[1]); w.y = cvt_pk_bf16(v0[2], v0[3]); w.z = cvt_pk_bf16(v1[0], v1[1]); w.w = cvt_pk_bf16(v1[2], v1[3]); *(u32x4*)p = w; }

struct FPlain { bf16_t* O; int ldc;
    __device__ __forceinline__ void operator()(f32x4 v0, f32x4 v1, const GUnit& u, int trow, int tcol) const { st8(O + (size_t)(u.pm * 256 + trow) * ldc + u.pn * 256 + tcol, v0, v1); } };
struct FQKV { bf16_t* Q; bf16_t* KV; const float* rsq; const float* rskv;
    __device__ __forceinline__ void operator()(f32x4 v0, f32x4 v1, const GUnit& u, int trow, int tcol) const {
        const int row = u.pm * 256 + trow;
        if (u.aux == 0) { const float s = rsq[row]; st8(Q + (size_t)row * 1536 + u.pn * 256 + tcol, v0 * s, v1 * s); }
        else { const float s = rskv[row]; st8(KV + (size_t)row * LDKV + u.pn * 256 + tcol, v0 * s, v1 * s); } } };
struct EpiQKV {
    static constexpr bool PERM = true;
    bf16_t* Q; bf16_t* KV; const float* rsq; const float* rskv;
    __device__ __forceinline__ void operator()(const Acc& acc, const GUnit& u, int wr, int wc, int fr, int fq) const {
        const float* rs = (u.aux == 0) ? rsq : rskv; bf16_t* O = (u.aux == 0) ? Q : KV; const int ldc = (u.aux == 0) ? 1536 : LDKV;
        float sc[2][4];
#pragma unroll
        for (int ai = 0; ai < 2; ++ai)
#pragma unroll
            for (int m = 0; m < 4; ++m) sc[ai][m] = rs[u.pm * 256 + ai * 128 + wr * 64 + m * 16 + fr];
#pragma unroll
        for (int ai = 0; ai < 2; ++ai)
#pragma unroll
            for (int m = 0; m < 4; ++m) { const int row = u.pm * 256 + ai * 128 + wr * 64 + m * 16 + fr; const float s = sc[ai][m];
#pragma unroll
                for (int bj = 0; bj < 2; ++bj) st8(O + (size_t)row * ldc + u.pn * 256 + bj * 128 + wc * 32 + 8 * fq, acc[ai][bj][m][0] * s, acc[ai][bj][m][1] * s); }
    }
};
struct EpiRw2 {
    static constexpr bool PERM = true;
    bf16_t* base; bf16_t* vl; const float* w0; const float* a0;
    __device__ __forceinline__ void operator()(const Acc& acc, const GUnit& u, int wr, int wc, int fr, int fq) const {
        bf16_t* o = (u.aux < 5) ? base + (size_t)u.aux * ((size_t)R * 1024) : vl;
        const bool act = u.aux < 4; const float scl = (u.aux < 2) ? 0.6065306597126334f : 1.0f;
        f32x4 bv[2][2];
#pragma unroll
        for (int bj = 0; bj < 2; ++bj) { const int col = u.pn * 256 + bj * 128 + wc * 32 + 8 * fq; const float* bp = (u.aux < 2 ? w0 : a0) + (u.aux & 1) * 1024 + col;
            bv[bj][0] = act ? *(const f32x4*)bp : (f32x4){0.f, 0.f, 0.f, 0.f}; bv[bj][1] = act ? *(const f32x4*)(bp + 4) : (f32x4){0.f, 0.f, 0.f, 0.f}; }
#pragma unroll
        for (int ai = 0; ai < 2; ++ai)
#pragma unroll
            for (int m = 0; m < 4; ++m) { const int row = u.pm * 256 + ai * 128 + wr * 64 + m * 16 + fr;
#pragma unroll
                for (int bj = 0; bj < 2; ++bj) { f32x4 v0 = acc[ai][bj][m][0], v1 = acc[ai][bj][m][1];
                    if (act) {
#pragma unroll
                        for (int j = 0; j < 4; ++j) { v0[j] = scl * sigmoidf_(bv[bj][0][j] + v0[j]); v1[j] = scl * sigmoidf_(bv[bj][1][j] + v1[j]); } }
                    st8(o + (size_t)row * 1024 + u.pn * 256 + bj * 128 + wc * 32 + 8 * fq, v0, v1); } }
    }
};
struct FRw1 { bf16_t* L1; bf16_t* RR; bf16_t* RK; bf16_t* RV;
    __device__ __forceinline__ void operator()(f32x4 v0, f32x4 v1, const GUnit& u, int trow, int tcol) const {
        const int row = u.pm * 256 + trow;
        if (u.aux == 0) { const int col = u.pn * 256 + tcol;
            if (col < 128) {
#pragma unroll
                for (int j = 0; j < 4; ++j) { v0[j] = 1.0f - 2.0f * __builtin_amdgcn_rcpf(1.0f + __expf(2.0f * v0[j])); v1[j] = 1.0f - 2.0f * __builtin_amdgcn_rcpf(1.0f + __expf(2.0f * v1[j])); } }
            else if (col >= 320) {
#pragma unroll
                for (int j = 0; j < 4; ++j) { v0[j] = sigmoidf_(v0[j]); v1[j] = sigmoidf_(v1[j]); } }
            st8(L1 + (size_t)row * 512 + col, v0, v1); }
        else { bf16_t* o = u.aux == 1 ? RR : (u.aux == 2 ? RK : RV); st8(o + (size_t)row * 1024 + u.pn * 256 + tcol, v0, v1); } } };
struct FRw2 { bf16_t* base; bf16_t* vl; const float* w0; const float* a0;
    __device__ __forceinline__ void operator()(f32x4 v0, f32x4 v1, const GUnit& u, int trow, int tcol) const {
        const int col = u.pn * 256 + tcol;
        const unsigned off = (unsigned)(u.pm * 256 + trow) * 1024u + (unsigned)col + (u.aux < 5 ? (unsigned)u.aux * (unsigned)(R * 1024) : 0u);
        bf16_t* o = (u.aux < 5) ? base : vl;
        if (u.aux < 4) {
            const float* bp = (u.aux < 2 ? w0 : a0) + (u.aux & 1) * 1024 + col; const f32x4 b0 = *(const f32x4*)bp, b1 = *(const f32x4*)(bp + 4);
            const float sc = (u.aux < 2) ? 0.6065306597126334f : 1.0f;
#pragma unroll
            for (int j = 0; j < 4; ++j) { v0[j] = sc * sigmoidf_(b0[j] + v0[j]); v1[j] = sc * sigmoidf_(b1[j] + v1[j]); } }
        st8(o + off, v0, v1); } };
struct EpiSwiGLU {
    static constexpr bool PERM = true;
    bf16_t* O; int ldc;
    __device__ __forceinline__ void operator()(const Acc& acc, const GUnit& u, int wr, int wc, int fr, int fq) const {
#pragma unroll
        for (int ai = 0; ai < 2; ++ai)
#pragma unroll
            for (int m = 0; m < 4; ++m) { const int trow = ai * 128 + wr * 64 + m * 16 + fr; f32x4 h0, h1;
#pragma unroll
                for (int j = 0; j < 4; ++j) { const float g0 = acc[ai][0][m][0][j], g1 = acc[ai][0][m][1][j];
                    h0[j] = g0 * sigmoidf_(g0) * acc[ai][1][m][0][j]; h1[j] = g1 * sigmoidf_(g1) * acc[ai][1][m][1][j]; }
                st8(O + (size_t)(u.pm * 256 + trow) * ldc + u.pn * 128 + wc * 32 + 8 * fq, h0, h1); }
    }
};
struct EpiResid {
    static constexpr bool PERM = false;
    float* cs; float* out; const float* mods; int layer, which;
    const float* scs; const float* sout;
    __device__ __forceinline__ void operator()(const Acc& acc, const GUnit& u, int wr, int wc, int fr, int fq) const {
        const int b = u.pm / 17, isctx = (u.pm % 17 == 0);
        float* xp = isctx ? cs + (size_t)b * CTX * D : out + (size_t)(b * SEQ + (u.pm % 17 - 1) * 256) * D;
        const float* sp = isctx ? scs + (size_t)b * CTX * D : sout + (size_t)(b * SEQ + (u.pm % 17 - 1) * 256) * D;
        const float* gp = mods + ((size_t)(layer * 9 + (isctx ? 8 : b)) * 6 + which) * 1024;
        const int col0 = u.pn * 256 + wc * 32 + 4 * fq;
        f32x4 gv[2][2];
#pragma unroll
        for (int bj = 0; bj < 2; ++bj)
#pragma unroll
            for (int n = 0; n < 2; ++n) gv[bj][n] = *(const f32x4*)(gp + col0 + bj * 128 + n * 16);
#pragma unroll
        for (int ai = 0; ai < 2; ++ai)
#pragma unroll
            for (int mh = 0; mh < 2; ++mh) {
                f32x4 xv[2][2][2];
#pragma unroll
                for (int mm = 0; mm < 2; ++mm) { const float* srow = sp + (size_t)(ai * 128 + wr * 64 + (mh * 2 + mm) * 16 + fr) * D + col0;
#pragma unroll
                    for (int bj = 0; bj < 2; ++bj)
#pragma unroll
                        for (int n = 0; n < 2; ++n) xv[mm][bj][n] = *(const f32x4*)(srow + bj * 128 + n * 16); }
#pragma unroll
                for (int mm = 0; mm < 2; ++mm) { float* rowp = xp + (size_t)(ai * 128 + wr * 64 + (mh * 2 + mm) * 16 + fr) * D + col0;
#pragma unroll
                    for (int bj = 0; bj < 2; ++bj)
#pragma unroll
                        for (int n = 0; n < 2; ++n) *(f32x4*)(rowp + bj * 128 + n * 16) = xv[mm][bj][n] + gv[bj][n] * acc[ai][bj][mh * 2 + mm][n]; }
                asm volatile("" ::: "memory"); }
    }
};

struct MapSimple {
    const char* A; const char* B; size_t sa, sb; int nN, nt, lat;
    __device__ __forceinline__ bool operator()(int L, GUnit& u) const { const int nM = lat ? 128 : NPAN; if (L >= nM * nN) return false; int q; pg8::tile_order(L, nM, nN, q, u.pn);
        u.pm = lat ? (q / 16) * 17 + 1 + (q % 16) : q;
        u.A = A + (size_t)u.pm * sa; u.B = B + (size_t)u.pn * sb; u.nt = nt; u.aux = 0; return true; }
};
struct MapTail {
    static constexpr bool KCAT = false;
    const char* A; const char* B; size_t sa, sb; int nt, lo, hi;
    __device__ __forceinline__ bool operator()(int L, GUnit& u) const { L += lo; if (L >= hi) return false;
        if (L < 512) { const int x = L & 7, off = L >> 3; u.pm = x * 16 + (off >> 2); u.pn = off & 3; } else { const int i = L - 512; u.pm = 128 + (i >> 2); u.pn = i & 3; }
        u.A = A + (size_t)u.pm * sa; u.B = B + (size_t)u.pn * sb; u.nt = nt; u.aux = 0; return true; }
};
struct MapQKV {
    const char* QKVA; const char* QB; const char* KVB;
    __device__ __forceinline__ bool operator()(int L, GUnit& u) const { if (L >= NPAN * 14) return false; int pn; pg8::tile_order(L, NPAN, 14, u.pm, pn);
        const char* ap = QKVA + (size_t)u.pm * 256 * 768 * 2;
        if (pn < 6) { u.A = ap; u.B = QB + (size_t)pn * 256 * 384 * 2; u.nt = 6; u.pn = pn; u.aux = 0; }
        else { u.A = ap + 384 * 2; u.B = KVB + (size_t)(pn - 6) * 256 * 384 * 2; u.nt = 4; u.pn = pn - 6; u.aux = 1; }
        return true; }
};
struct MapRw1 {
    static constexpr bool KCAT = false;
    const char* AX; const char* B1; const char* B2; const char* L1; int G;
    __device__ __forceinline__ void fill(GUnit& u, int pn) const {
        const char* ap = AX + (size_t)u.pm * 256 * 5120 * 2;
        if (pn < 2) { u.A = ap; u.B = L1 + (size_t)pn * 256 * LDB1 * 2; u.nt = 32; u.pn = pn; u.aux = 0; }
        else if (pn < 6) { u.A = ap + 2048 * 2; u.B = B1 + (size_t)(pn - 2) * 256 * LDB1 * 2; u.nt = 16; u.pn = pn - 2; u.aux = 1; }
        else if (pn < 10) { u.A = ap + 3072 * 2; u.B = B1 + (size_t)(pn - 6) * 256 * LDB1 * 2 + 1024 * 2; u.nt = 16; u.pn = pn - 6; u.aux = 2; }
        else { u.A = ap; u.B = B2 + (size_t)(pn - 10) * 256 * LDB1 * 2; u.nt = 16; u.pn = pn - 10; u.aux = 3; } }
    __device__ __forceinline__ bool operator()(int L, GUnit& u) const {
        int pn;
        if (G != 256) { if (L >= NPAN * 14) return false; pg8::tile_order(L, NPAN, 14, u.pm, pn); fill(u, pn); return true; }
        const int c = L & 255, i = L >> 8, nl = (c < 16) ? 2 : 1;
        if (i < nl) { pg8::tile_order(c + i * 256, NPAN, 2, u.pm, pn); fill(u, pn); return true; }
        const int k = i - nl; int Ln;
        if (c >= 16) { const int v = c - 16; if (k < 6) Ln = v + k * 240; else if (k == 6 && v < 112) Ln = 1440 + v; else return false; }
        else { if (k < 5) Ln = 1552 + c * 5 + k; else return false; }
        pg8::tile_order(Ln, NPAN, 12, u.pm, pn); fill(u, pn + 2); return true; }
};
struct MapRw2 {
    const char* L1; const char* L2A; const char* L2B; int pn0, nN, nt;
    __device__ __forceinline__ bool operator()(int L, GUnit& u) const { if (L >= NPAN * nN) return false; int pn; pg8::tile_order(L, NPAN, nN, u.pm, pn); pn += pn0;
        const char* ap = L1 + (size_t)u.pm * 256 * 512 * 2; u.nt = nt; u.pn = pn & 3; u.aux = pn >> 2;
        if (pn < 16) { const int koff = (pn < 8) ? 0 : 128 * 2;
            u.A = ap + koff; u.B = L2A + (size_t)pn * 256 * 256 * 2 + koff; u.nt = nt >> 1; }
        else { u.A = ap + 256 * 2; u.B = L2B + (size_t)(pn - 16) * 256 * 256 * 2; if (pn >= 20) u.nt = nt >> 1; }
        return true; }
};
struct MapMoe {
    const char* A; const char* B; size_t sa, sbe, sb; int nN, nt; const int* base;
    __device__ __forceinline__ bool operator()(int L, GUnit& u) const { const int nM = base[8] >> 8; if (L >= nM * nN) return false; pg8::tile_order(L, nM, nN, u.pm, u.pn);
        int e = 0;
#pragma unroll
        for (int j = 1; j < 8; ++j) e += (u.pm * 256 >= base[j]) ? 1 : 0;
        u.A = A + (size_t)u.pm * sa; u.B = B + (size_t)e * sbe + (size_t)u.pn * sb; u.nt = nt; u.aux = e; return true; }
};

struct MoeSplit { int nMf, nT, S; };
__device__ __forceinline__ MoeSplit moe_split(int total_slots) { const int nM = total_slots >> 8; MoeSplit s; s.nMf = (nM >> 6) << 6; s.nT = nM - s.nMf; int S = s.nT > 0 ? 64 / s.nT : 1; S = S > 8 ? 8 : S; s.S = S < 1 ? 1 : S; return s; }
constexpr int XP0 = (int)((A_WM13 - A_Y2) / ((size_t)256 * 1024 * 2));
static_assert((A_WM13 - A_Y2) % ((size_t)256 * 1024 * 2) == 0, "partial-tile panels are addressed relative to Y2");
struct MapMoeDown {
    const char* A; const char* B; size_t sa, sbe, sb; const int* base;
    __device__ __forceinline__ bool operator()(int L, GUnit& u) const { const MoeSplit sp = moe_split(base[8]); const int nfull = sp.nMf * 4;
        int k0 = 0, nt = 56, opan;
        if (L < nfull) { pg8::tile_order(L, sp.nMf, 4, u.pm, u.pn); opan = u.pm; }
        else { const int i = L - nfull, ntu = sp.nT * 4; if (i >= ntu * sp.S) return false;
            const int sl = i / ntu, t = i - sl * ntu; pg8::tile_order(t, sp.nT, 4, u.pm, u.pn); u.pm += sp.nMf;
            const int q = 28 / sp.S, r = 28 - q * sp.S, p0 = sl * q + (sl < r ? sl : r), np = q + (sl < r ? 1 : 0); k0 = p0 * 2; nt = np * 2;
            opan = sl == 0 ? u.pm : XP0 + (sl - 1) * sp.nT + (u.pm - sp.nMf); }
        int e = 0;
#pragma unroll
        for (int j = 1; j < 8; ++j) e += (u.pm * 256 >= base[j]) ? 1 : 0;
        u.A = A + (size_t)u.pm * sa + (size_t)k0 * 128; u.B = B + (size_t)e * sbe + (size_t)u.pn * sb + (size_t)k0 * 128; u.nt = nt; u.aux = opan; return true; }
};
struct FPlainAux { bf16_t* O; int ldc;
    __device__ __forceinline__ void operator()(f32x4 v0, f32x4 v1, const GUnit& u, int trow, int tcol) const { st8(O + (size_t)(u.aux * 256 + trow) * ldc + u.pn * 256 + tcol, v0, v1); } };

struct Job { const float* src; const float* kscale; const float* kscale2; bf16_t* dst; int sld, srcK, srcN, ldd, Nd, Kd, koff, grp, gstride, tn, tile0, pad; };
constexpr int MAXJOB = 96;
#define NOGRP (1 << 30)
struct JobList { LAS Job* jobs; int n, tiles, z; };
__device__ __forceinline__ void addjob(JobList& L, const float* src, int sld, int srcK, int srcN, const float* kscale, bf16_t* dst, int ldd, int Nd, int Kd, int koff, int grp, int gstride, const float* kscale2 = nullptr) {
    LAS Job* j = L.jobs + L.n; j->src = src; j->kscale = kscale; j->kscale2 = kscale2; j->dst = dst; j->sld = sld + L.z; j->srcK = srcK + L.z; j->srcN = srcN + L.z; j->ldd = ldd + L.z; j->Nd = Nd + L.z; j->Kd = Kd + L.z; j->koff = koff + L.z; j->grp = grp + L.z; j->gstride = gstride + L.z;
    const int tn = ((Nd + 63) >> 6) + L.z; j->tn = tn; j->tile0 = L.tiles; L.tiles += tn * (Kd >> 6); L.n += 1;
}
__device__ __forceinline__ bf16_t* wmla(const Args& a, int j) { return (bf16_t*)(a.ws + WS_WMLA) + (size_t)j * E_MLA; }
__device__ __forceinline__ bf16_t* wrwkv(const Args& a, int j) { return (bf16_t*)(a.ws + WS_WRWKV) + (size_t)j * E_RWKV; }
__device__ __forceinline__ bf16_t* wffn(const Args& a, int j) { return (bf16_t*)(a.ws + WS_WFFN) + (size_t)j * E_FFN; }
__device__ __forceinline__ void jobs_small(const Args& a, JobList& L) {
#pragma unroll 1
    for (int j = 0; j < 2; ++j) {
        {
            bf16_t* w = wmla(a, j); bf16_t* qkva = w; bf16_t* qb = w + E_QKVA; bf16_t* kvb = qb + E_QB; bf16_t* wo = kvb + E_KVB;
            addjob(L, a.in[I_WQA] + (size_t)j * D * QL, QL, D, QL, nullptr, qkva, 1024, 384, 1024, 0, NOGRP, 0);
            addjob(L, a.in[I_WKVA] + (size_t)j * D * 320, 320, D, 320, nullptr, qkva + (size_t)384 * 1024, 1024, 384, 1024, 0, NOGRP, 0);
            addjob(L, a.in[I_WQB] + (size_t)j * QL * 1536, 1536, QL, 1536, a.in[I_QAN] + j * QL, qb, 384, 1536, 384, 0, NOGRP, 0);
            addjob(L, a.in[I_WKVB] + (size_t)j * KVL * 2048, 2048, KVL, 2048, a.in[I_KVAN] + j * KVL, kvb, 384, 2048, 256, 0, NOGRP, 0);
            addjob(L, a.in[I_MWO] + (size_t)j * D * D, D, D, D, nullptr, wo, 1024, 1024, 1024, 0, NOGRP, 0);
        }
        {
            bf16_t* w = wrwkv(a, j); bf16_t* b1 = w; bf16_t* b2 = b1 + E_B1; bf16_t* l1 = b2 + E_B2; bf16_t* l2a = l1 + E_L1; bf16_t* l2b = l2a + E_L2A;
            const float* mix = a.in[I_MIX] + (size_t)j * 6 * D;
            addjob(L, a.in[I_WR] + (size_t)j * D * D, D, D, D, nullptr, b1, LDB1, 1024, 1024, 0, NOGRP, 0);
            addjob(L, a.in[I_WK] + (size_t)j * D * D, D, D, D, nullptr, b1 + 1024, LDB1, 1024, 1024, 0, NOGRP, 0);
            addjob(L, a.in[I_WV] + (size_t)j * D * D, D, D, D, nullptr, b2, LDB1, 1024, 1024, 0, NOGRP, 0);
            addjob(L, a.in[I_RWO] + (size_t)j * D * D, D, D, D, nullptr, b2 + E_B2 + E_L1 + E_L2A + E_L2B, 1024, 1024, 1024, 0, NOGRP, 0);
            for (int d = 0; d < 2; ++d) {
                const float* w1 = a.in[I_W1] + (size_t)(j * 2 + d) * D * 64; const float* a1 = a.in[I_A1] + (size_t)(j * 2 + d) * D * 64;
                addjob(L, w1, 64, D, 64, nullptr, l1 + (size_t)(d * 64) * LDB1, LDB1, 64, 1024, 0, NOGRP, 0);
                addjob(L, w1, 64, D, 64, mix + 1 * D, l1 + (size_t)(d * 64) * LDB1 + 1024, LDB1, 64, 1024, 0, NOGRP, 0, mix + 3 * D);
                addjob(L, a1, 64, D, 64, nullptr, l1 + (size_t)(128 + d * 64) * LDB1, LDB1, 64, 1024, 0, NOGRP, 0);
                addjob(L, a1, 64, D, 64, mix + 4 * D, l1 + (size_t)(128 + d * 64) * LDB1 + 1024, LDB1, 64, 1024, 0, NOGRP, 0, mix + 3 * D);
            }
            const float* v1 = (j == 1) ? a.in[I_V1] : nullptr;
            addjob(L, v1, 32, D, 32, nullptr, l1 + (size_t)256 * LDB1, LDB1, 64, 1024, 0, NOGRP, 0);
            addjob(L, nullptr, 32, D, 32, nullptr, l1 + (size_t)256 * LDB1 + 1024, LDB1, 64, 1024, 0, NOGRP, 0);
            addjob(L, a.in[I_G1] + (size_t)j * D * 160, 160, D, 160, nullptr, l1 + (size_t)320 * LDB1, LDB1, 192, 1024, 0, NOGRP, 0);
            addjob(L, a.in[I_G1] + (size_t)j * D * 160, 160, D, 160, mix + 5 * D, l1 + (size_t)320 * LDB1 + 1024, LDB1, 192, 1024, 0, NOGRP, 0, mix + 3 * D);
            for (int d = 0; d < 2; ++d) {
                addjob(L, a.in[I_W2] + (size_t)(j * 2 + d) * 64 * D, D, 64, D, nullptr, l2a + (size_t)(d * 1024) * 256, 256, 1024, 256, d * 64, NOGRP, 0);
                addjob(L, a.in[I_A2] + (size_t)(j * 2 + d) * 64 * D, D, 64, D, nullptr, l2a + (size_t)(2048 + d * 1024) * 256, 256, 1024, 256, 128 + d * 64, NOGRP, 0);
            }
            addjob(L, a.in[I_G2] + (size_t)j * 160 * D, D, 160, D, nullptr, l2b, 256, 1024, 256, 64, NOGRP, 0);
            addjob(L, (j == 1) ? a.in[I_V2] : nullptr, D, 32, D, nullptr, l2b + (size_t)1024 * 256, 256, 1024, 256, 0, NOGRP, 0);
        }
        {
            bf16_t* w = wffn(a, j);
            addjob(L, a.in[I_F1] + (size_t)j * D * DFF, DFF, D, DFF, nullptr, w, 1024, DFF, 1024, 0, 128, 256);
            addjob(L, a.in[I_F3] + (size_t)j * D * DFF, DFF, D, DFF, nullptr, w + (size_t)128 * 1024, 1024, DFF, 1024, 0, 128, 256);
            addjob(L, a.in[I_F2] + (size_t)j * DFF * D, D, DFF, D, nullptr, w + E_F13, DFF, 1024, DFF, 0, NOGRP, 0);
        }
    }
}
__device__ __forceinline__ void jobs_moe(const Args& a, JobList& L, int k) {
    bf16_t* w13 = (bf16_t*)(a.ws + WS_ARENA + A_WM13); bf16_t* w2 = (bf16_t*)(a.ws + WS_ARENA + A_WM2);
#pragma unroll 1
    for (int e = 0; e < NE; ++e) {
        const size_t so = (size_t)(k * NE + e) * D * DFE;
        addjob(L, a.in[I_M1] + so, DFE, D, DFE, nullptr, w13 + (size_t)e * E_M13, 1024, DFE, 1024, 0, 128, 256);
        addjob(L, a.in[I_M3] + so, DFE, D, DFE, nullptr, w13 + (size_t)e * E_M13 + (size_t)128 * 1024, 1024, DFE, 1024, 0, 128, 256);
        addjob(L, a.in[I_M2] + so, D, DFE, D, nullptr, w2 + (size_t)e * E_M2, DFE, 1024, DFE, 0, NOGRP, 0);
    }
}
__device__ __forceinline__ void run_prep(const Args& a, LAS unsigned char* jl, int which  , int j0  , int G, int c) {
    const int tid = ltid();
    LAS Job* jobs = (LAS Job*)jl; LAS int* hdr = (LAS int*)(jl + MAXJOB * sizeof(Job)); LAS float* tile = (LAS float*)(jl + MAXJOB * sizeof(Job) + 64);
    if (tid == 0) { JobList L{jobs, 0, 0, launder_s(0)}; if (which < 0) jobs_small(a, L); else jobs_moe(a, L, which); hdr[0] = L.n + L.z; hdr[1] = L.tiles + L.z; }
    __syncthreads();
    const int nj = hdr[0], ntile = hdr[1];
    const int kl = tid >> 4, nq = (tid & 15) * 4, sn = tid >> 3, sk = (tid & 7) * 8;
    int jcur = 0;
#define PREP_BAR() do { asm volatile("s_waitcnt lgkmcnt(0)" ::: "memory"); __builtin_amdgcn_s_barrier(); asm volatile("" ::: "memory"); } while (0)
    f32x4 vcur[2], vnxt[2];
#define PREP_FETCH(t_, dstv) do { while (jcur + 1 < nj && jobs[jcur + 1].tile0 <= (t_)) ++jcur; const LAS Job* J_ = jobs + jcur; \
        const float* src_ = J_->src; const float* ks_ = J_->kscale; const float* ks2_ = J_->kscale2; const int sld_ = J_->sld, srcK_ = J_->srcK, srcN_ = J_->srcN, koff_ = J_->koff, tn_ = J_->tn, tl_ = (t_) - J_->tile0; \
        const int n0_ = (tl_ % tn_) * 64, k0_ = (tl_ / tn_) * 64; \
        _Pragma("unroll") for (int p = 0; p < 2; ++p) { const int kk = k0_ + kl + 32 * p, ksi = kk - koff_, n = n0_ + nq; f32x4 v = (f32x4){0.f, 0.f, 0.f, 0.f}; \
            if (src_ != nullptr && ksi >= 0 && ksi < srcK_ && n < srcN_) { v = *(const __attribute__((address_space(1))) f32x4*)(src_ + (size_t)ksi * sld_ + n); if (ks_) { float sc_ = *(const __attribute__((address_space(1))) float*)(ks_ + ksi); if (ks2_) sc_ -= *(const __attribute__((address_space(1))) float*)(ks2_ + ksi); v = v * sc_; } } dstv[p] = v; } } while (0)
    int t = c + j0 * G;
    if (t < ntile) PREP_FETCH(t, vcur);
    for (; t < ntile; t += G) {
        const int jthis = jcur;
        if (t + G < ntile) PREP_FETCH(t + G, vnxt);
        const LAS Job* J = jobs + jthis;
        bf16_t* __restrict__ dst = J->dst;
        const int ldd = J->ldd, Nd = J->Nd, grp = J->grp, gstride = J->gstride, tn = J->tn, tl = t - J->tile0;
        const int n0 = (tl % tn) * 64, k0 = (tl / tn) * 64;
#pragma unroll
        for (int p = 0; p < 2; ++p) { LAS float* tp = tile + (kl + 32 * p) * 65 + nq; tp[0] = vcur[p][0]; tp[1] = vcur[p][1]; tp[2] = vcur[p][2]; tp[3] = vcur[p][3]; }
        PREP_BAR();
        { const int n = n0 + sn;
            if (n < Nd) { float f[8];
#pragma unroll
                for (int e = 0; e < 8; ++e) f[e] = tile[(sk + e) * 65 + sn];
                const int dr = (n / grp) * gstride + (n % grp);
                *(__attribute__((address_space(1))) u32x4*)(dst + (size_t)dr * ldd + k0 + sk) = pack8(f); } }
        PREP_BAR();
        vcur[0] = vnxt[0]; vcur[1] = vnxt[1];
    }
#undef PREP_FETCH
#undef PREP_BAR
    asm volatile("s_waitcnt vmcnt(0)" ::: "memory"); __syncthreads();
}

__device__ __forceinline__ void prologue_misc(const Args& a, LAS unsigned char* lds, int G, int c) {
    const int tid = ltid();
    if (c == 0) { float* rt = (float*)(a.ws + WS_ROPE);
      for (int i = tid; i < 1024; i += NTHR) { const int pos = i >> 4, j = i & 15; const double inv = 1.0 / pow(10000.0, (double)j / 16.0), ang = (double)pos * inv; rt[i] = (float)cos(ang); rt[1024 + i] = (float)sin(ang); } }
    LAS float* sc = (LAS float*)lds;
    LAS float* red = (LAS float*)(lds + 49152);
    for (int i = tid; i < 1024 * 12; i += NTHR) { const int k = i / 12, m = i % 12; float v = 0.f;
        if (m < 9) { const float x = (m < 8) ? a.in[I_C][m * D + k] : a.in[I_CCTX][k]; v = x / (1.0f + expf(-x)); } sc[i] = v; }
    __syncthreads();
    const int kq = tid >> 6, col = tid & 63;
    for (int u = c; u < 4 * 96; u += G) {
        const int layer = u / 96, n0 = (u % 96) * 64;
        const float* w = a.in[I_ADAW] + (size_t)layer * D * 6144 + n0 + col;
        float acc[9];
#pragma unroll
        for (int m = 0; m < 9; ++m) acc[m] = 0.f;
        for (int k8 = 0; k8 < 128; k8 += 8) {
            float wv[8];
#pragma unroll
            for (int e = 0; e < 8; ++e) wv[e] = w[(size_t)(kq * 128 + k8 + e) * 6144];
#pragma unroll
            for (int e = 0; e < 8; ++e) { const LAS f32x4* sp = (const LAS f32x4*)(sc + (kq * 128 + k8 + e) * 12); const f32x4 s0 = sp[0], s1 = sp[1], s2 = sp[2];
                acc[0] += s0[0] * wv[e]; acc[1] += s0[1] * wv[e]; acc[2] += s0[2] * wv[e]; acc[3] += s0[3] * wv[e];
                acc[4] += s1[0] * wv[e]; acc[5] += s1[1] * wv[e]; acc[6] += s1[2] * wv[e]; acc[7] += s1[3] * wv[e]; acc[8] += s2[0] * wv[e]; }
        }
#pragma unroll
        for (int m = 0; m < 9; ++m) red[(kq * 9 + m) * 64 + col] = acc[m];
        __syncthreads();
        for (int i = tid; i < 9 * 64; i += NTHR) { const int m = i >> 6, cc = i & 63; float s = 0.f;
#pragma unroll
            for (int q = 0; q < 8; ++q) s += red[(q * 9 + m) * 64 + cc];
            ((float*)(a.ws + WS_MODS))[(size_t)(layer * 9 + m) * 6144 + n0 + cc] = s + a.in[I_ADAB][layer * 6144 + n0 + cc]; }
        __syncthreads();
    }
}

struct RowParams { float A[16], Bv[16]; int mi; };
__device__ __forceinline__ void load_params(const Args& a, RowParams& P, int layer, int mi, const float* gain, int which, int lane) {
    const float* sh = mods_ptr(a, layer, mi, which); const float* scl = mods_ptr(a, layer, mi, which + 1);
#pragma unroll
    for (int j = 0; j < 2; ++j) { const int col = j * 512 + lane * 8;
#pragma unroll
        for (int q = 0; q < 2; ++q) { const f32x4 g = *(const f32x4*)(gain + col + 4 * q), s = *(const f32x4*)(scl + col + 4 * q), t = *(const f32x4*)(sh + col + 4 * q);
#pragma unroll
            for (int e = 0; e < 4; ++e) { P.A[j * 8 + q * 4 + e] = g[e] * (1.0f + s[e]); P.Bv[j * 8 + q * 4 + e] = t[e]; } } }
    P.mi = mi;
}
__device__ __forceinline__ void load_x16(const float* xp, int lane, float (&x)[16]) {
#pragma unroll
    for (int j = 0; j < 2; ++j)
#pragma unroll
        for (int q = 0; q < 2; ++q) { const f32x4 v = *(const f32x4*)(xp + j * 512 + lane * 8 + 4 * q); x[j * 8 + q * 4 + 0] = v[0]; x[j * 8 + q * 4 + 1] = v[1]; x[j * 8 + q * 4 + 2] = v[2]; x[j * 8 + q * 4 + 3] = v[3]; }
}
__device__ __forceinline__ void store_bf16_row(bf16_t* p, int lane, const float (&h)[16]) {
#pragma unroll
    for (int j = 0; j < 2; ++j) { u32x4 w; w.x = cvt_pk_bf16(h[j * 8 + 0], h[j * 8 + 1]); w.y = cvt_pk_bf16(h[j * 8 + 2], h[j * 8 + 3]); w.z = cvt_pk_bf16(h[j * 8 + 4], h[j * 8 + 5]); w.w = cvt_pk_bf16(h[j * 8 + 6], h[j * 8 + 7]);
        *(u32x4*)(p + j * 512 + lane * 8) = w; }
}
__device__ __forceinline__ void moe_combine16(const Args& a, int row, int layer_prev, int lane, float (&x)[16]) {
    const u32x4 rt = *(const u32x4*)(a.ws + WS_ROUTE + (size_t)row * 16);
    const int e0 = (int)rt[0];
    if (e0 < 0) return;
    const float p0 = __uint_as_float(rt[2]), p1 = __uint_as_float(rt[3]);
    const int* sl = (const int*)(a.ws + WS_RSLOT) + (size_t)row * 2; const int s0 = sl[0], s1 = sl[1];
    const bf16_t* y2 = (const bf16_t*)(a.ws + WS_ARENA + A_Y2);
    const float* g5 = mods_ptr(a, layer_prev, mod_index(row), 5);
    const MoeSplit sp = moe_split(((const int*)(a.ws + WS_META))[8]);
    const int x0 = (s0 >> 8) >= sp.nMf ? sp.S : 1, x1 = (s1 >> 8) >= sp.nMf ? sp.S : 1;
    const size_t o0 = ((size_t)(XP0 + (s0 >> 8) - sp.nMf) * 256 + (s0 & 255)) * 1024, o1 = ((size_t)(XP0 + (s1 >> 8) - sp.nMf) * 256 + (s1 & 255)) * 1024, ostep = (size_t)sp.nT * 256 * 1024;
#pragma unroll
    for (int j = 0; j < 2; ++j) { const int col = j * 512 + lane * 8; float ya[8], yb[8];
        unpack8(*(const u32x4*)(y2 + (size_t)s0 * 1024 + col), ya); unpack8(*(const u32x4*)(y2 + (size_t)s1 * 1024 + col), yb);
        for (int sl = 1; sl < x0; ++sl) { float t[8]; unpack8(*(const u32x4*)(y2 + o0 + (size_t)(sl - 1) * ostep + col), t);
#pragma unroll
            for (int e = 0; e < 8; ++e) ya[e] += t[e]; }
        for (int sl = 1; sl < x1; ++sl) { float t[8]; unpack8(*(const u32x4*)(y2 + o1 + (size_t)(sl - 1) * ostep + col), t);
#pragma unroll
            for (int e = 0; e < 8; ++e) yb[e] += t[e]; }
        const f32x4 g0 = *(const f32x4*)(g5 + col), g1 = *(const f32x4*)(g5 + col + 4);
#pragma unroll
        for (int e = 0; e < 8; ++e) x[j * 8 + e] += (e < 4 ? g0[e] : g1[e - 4]) * (p0 * ya[e] + p1 * yb[e]); }
}
__device__ __forceinline__ void store_x16(float* xp, int lane, const float (&x)[16]) {
#pragma unroll
    for (int j = 0; j < 2; ++j)
#pragma unroll
        for (int q = 0; q < 2; ++q) *(f32x4*)(xp + j * 512 + lane * 8 + 4 * q) = (f32x4){x[j * 8 + q * 4], x[j * 8 + q * 4 + 1], x[j * 8 + q * 4 + 2], x[j * 8 + q * 4 + 3]};
}
__device__ __forceinline__ void norm_row(const float (&x)[16], const RowParams& P, float (&h)[16]) {
    float ss = 0.f;
#pragma unroll
    for (int e = 0; e < 16; ++e) ss += x[e] * x[e];
    ss = wave_sum_dpp(ss);
    const float rstd = __builtin_amdgcn_rsqf(ss * (1.0f / 1024.0f) + NORM_EPS);
#pragma unroll
    for (int e = 0; e < 16; ++e) h[e] = x[e] * rstd * P.A[e] + P.Bv[e];
}
__device__ __forceinline__ void wave_rows(int G, int c, int& r0, int& r1) {
    const int nw = G * NWAVE, per = (R + nw - 1) / nw, gw = c * NWAVE + (ltid() >> 6);
    r0 = gw * per; r1 = r0 + per; if (r0 > R) r0 = R; if (r1 > R) r1 = R;
}
template <bool COMBINE, bool FIRST = false>
__device__ __forceinline__ void norm_plain(const Args& a, int layer, const float* gain, int which, bf16_t* Hout, int G, int c) {
    const int lane = ltid() & 63; int r0, r1; wave_rows(G, c, r0, r1);
    RowParams P; P.mi = -1;
    for (int row = r0; row < r1; ++row) {
        const int mi = mod_index(row); if (mi != P.mi) load_params(a, P, layer, mi, gain, which, lane);
        float* xp = xrow(a, row); float x[16], h[16]; load_x16(FIRST ? xrow_in(a, row) : xp, lane, x);
        if (COMBINE) { moe_combine16(a, row, layer - 1, lane, x); store_x16(xp, lane, x); }
        norm_row(x, P, h); store_bf16_row(Hout + (size_t)row * 1024, lane, h);
    }
}
struct CMeta { u32x4 rt; int s0, s1; };
struct CData { f32x4 x[4]; u32x4 y[4]; };
__device__ __forceinline__ void cm_load(const Args& a, int row, CMeta& m) {
    m.rt = *(const u32x4*)(a.ws + WS_ROUTE + (size_t)row * 16);
    const int* sl = (const int*)(a.ws + WS_RSLOT) + (size_t)row * 2; m.s0 = sl[0]; m.s1 = sl[1];
}
__device__ __forceinline__ void cd_load(const Args& a, int row, const CMeta& m, int lane, CData& d) {
    const float* xp = xrow(a, row);
#pragma unroll
    for (int j = 0; j < 2; ++j)
#pragma unroll
        for (int q = 0; q < 2; ++q) d.x[j * 2 + q] = *(const f32x4*)(xp + j * 512 + lane * 8 + 4 * q);
    if ((int)m.rt[0] >= 0) { const bf16_t* y2 = (const bf16_t*)(a.ws + WS_ARENA + A_Y2);
#pragma unroll
        for (int j = 0; j < 2; ++j) { d.y[j * 2] = *(const u32x4*)(y2 + (size_t)m.s0 * 1024 + j * 512 + lane * 8); d.y[j * 2 + 1] = *(const u32x4*)(y2 + (size_t)m.s1 * 1024 + j * 512 + lane * 8); } }
}
template <bool NORM>
__device__ __forceinline__ void combine_rows(const Args& a, int layer_prev, int layer, const float* gain, int which, bf16_t* Hout, int G, int c) {
    const int lane = ltid() & 63; int r0, r1; wave_rows(G, c, r0, r1); if (r0 >= r1) return;
    const bf16_t* y2 = (const bf16_t*)(a.ws + WS_ARENA + A_Y2);
    const MoeSplit sp = moe_split(((const int*)(a.ws + WS_META))[8]);
    const size_t ostep = (size_t)sp.nT * 256 * 1024;
    RowParams P; P.mi = -1; float g5[16]; int gmi = -1;
    CMeta m0, m1, m2; CData d0, dn;
    cm_load(a, r0, m0); m1 = m0; if (r0 + 1 < r1) cm_load(a, r0 + 1, m1);
    cd_load(a, r0, m0, lane, d0);
    for (int row = r0; row < r1; ++row) {
        m2 = m1; if (row + 2 < r1) cm_load(a, row + 2, m2);
        dn = d0; if (row + 1 < r1) cd_load(a, row + 1, m1, lane, dn);
        const int mi = mod_index(row);
        if (mi != gmi) { const float* gp = mods_ptr(a, layer_prev, mi, 5); gmi = mi;
#pragma unroll
            for (int j = 0; j < 2; ++j)
#pragma unroll
                for (int q = 0; q < 2; ++q) { const f32x4 v = *(const f32x4*)(gp + j * 512 + lane * 8 + 4 * q); g5[j * 8 + q * 4] = v[0]; g5[j * 8 + q * 4 + 1] = v[1]; g5[j * 8 + q * 4 + 2] = v[2]; g5[j * 8 + q * 4 + 3] = v[3]; } }
        float x[16];
#pragma unroll
        for (int i = 0; i < 4; ++i) { x[i * 4] = d0.x[i][0]; x[i * 4 + 1] = d0.x[i][1]; x[i * 4 + 2] = d0.x[i][2]; x[i * 4 + 3] = d0.x[i][3]; }
        const bool routed = (int)m0.rt[0] >= 0;
        if (routed) { const float p0 = __uint_as_float(m0.rt[2]), p1 = __uint_as_float(m0.rt[3]); const int s0 = m0.s0, s1 = m0.s1;
            const int x0 = (s0 >> 8) >= sp.nMf ? sp.S : 1, x1 = (s1 >> 8) >= sp.nMf ? sp.S : 1;
            const size_t o0 = ((size_t)(XP0 + (s0 >> 8) - sp.nMf) * 256 + (s0 & 255)) * 1024, o1 = ((size_t)(XP0 + (s1 >> 8) - sp.nMf) * 256 + (s1 & 255)) * 1024;
#pragma unroll
            for (int j = 0; j < 2; ++j) { const int col = j * 512 + lane * 8; float ya[8], yb[8]; unpack8(d0.y[j * 2], ya); unpack8(d0.y[j * 2 + 1], yb);
                for (int sl = 1; sl < x0; ++sl) { float t[8]; unpack8(*(const u32x4*)(y2 + o0 + (size_t)(sl - 1) * ostep + col), t);
#pragma unroll
                    for (int e = 0; e < 8; ++e) ya[e] += t[e]; }
                for (int sl = 1; sl < x1; ++sl) { float t[8]; unpack8(*(const u32x4*)(y2 + o1 + (size_t)(sl - 1) * ostep + col), t);
#pragma unroll
                    for (int e = 0; e < 8; ++e) yb[e] += t[e]; }
#pragma unroll
                for (int e = 0; e < 8; ++e) x[j * 8 + e] += g5[j * 8 + e] * (p0 * ya[e] + p1 * yb[e]); } }
        if (NORM || routed) store_x16(xrow(a, row), lane, x);
        if (NORM) { if (mi != P.mi) load_params(a, P, layer, mi, gain, which, lane); float h[16]; norm_row(x, P, h); store_bf16_row(Hout + (size_t)row * 1024, lane, h); }
        d0 = dn; m0 = m1; m1 = m2;
    }
}
__device__ __forceinline__ bool seg_first(int row) { const int r = row % SEG; return r == 0 || r == CTX; }
__device__ __forceinline__ bool seg_last(int row) { const int r = row % SEG; return r == CTX - 1 || r == SEG - 1; }
__device__ __forceinline__ void norm_mix(const Args& a, int layer, int j, int rlo, int rhi, int nw, int w) {
    const int lane = ltid() & 63; if (w < 0) return;
    const int per = (rhi - rlo + nw - 1) / nw; int r0 = rlo + w * per, r1 = r0 + per; if (r1 > rhi) r1 = rhi; if (r0 >= r1) return;
    const float* gain = a.in[I_N1G] + layer * D; const float* mix = a.in[I_MIX] + (size_t)j * 6 * D;
    bf16_t* AX = (bf16_t*)(a.ws + WS_ARENA + A_AX);
    float mr[16], mk[16], mv[16];
#pragma unroll
    for (int jj = 0; jj < 2; ++jj)
#pragma unroll
        for (int e = 0; e < 8; ++e) { const int col = jj * 512 + lane * 8 + e; mr[jj * 8 + e] = mix[col]; mk[jj * 8 + e] = mix[2 * D + col]; mv[jj * 8 + e] = mix[3 * D + col]; }
    RowParams P; P.mi = -1;
    float hp[16], hc[16], hn[16], x[16];
    if (!seg_first(r0)) { const int mi = mod_index(r0 - 1); if (mi != P.mi) load_params(a, P, layer, mi, gain, 0, lane); load_x16(xrow(a, r0 - 1), lane, x); norm_row(x, P, hp); }
    else {
#pragma unroll
        for (int e = 0; e < 16; ++e) hp[e] = 0.f; }
    { const int mi = mod_index(r0); if (mi != P.mi) load_params(a, P, layer, mi, gain, 0, lane); load_x16(xrow(a, r0), lane, x); norm_row(x, P, hc); }
    if (r0 + 1 < R) load_x16(xrow(a, r0 + 1), lane, x);
    for (int row = r0; row < r1; ++row) {
        float xq[16];
        if (row + 2 < R && row + 1 < r1) load_x16(xrow(a, row + 2), lane, xq);
        if (row + 1 < R) { const int mi = mod_index(row + 1); if (mi != P.mi) load_params(a, P, layer, mi, gain, 0, lane); norm_row(x, P, hn); }
        else {
#pragma unroll
            for (int e = 0; e < 16; ++e) hn[e] = 0.f; }
#pragma unroll
        for (int e = 0; e < 16; ++e) x[e] = xq[e];
        const float fp = seg_first(row) ? 0.f : 0.5f, fn = seg_last(row) ? 0.f : 0.5f;
        float xx[16], t[16];
#pragma unroll
        for (int e = 0; e < 16; ++e) xx[e] = fp * hp[e] + fn * hn[e] - hc[e];
        bf16_t* o = AX + (size_t)row * 5120;
        store_bf16_row(o + 1024, lane, xx);
#pragma unroll
        for (int e = 0; e < 16; ++e) t[e] = hc[e] + xx[e] * mv[e];
        store_bf16_row(o, lane, t);
#pragma unroll
        for (int e = 0; e < 16; ++e) t[e] = hc[e] + xx[e] * mr[e];
        store_bf16_row(o + 2048, lane, t);
#pragma unroll
        for (int e = 0; e < 16; ++e) t[e] = hc[e] + xx[e] * mk[e];
        store_bf16_row(o + 3072, lane, t);
#pragma unroll
        for (int e = 0; e < 16; ++e) { hp[e] = hc[e]; hc[e] = hn[e]; }
    }
}
__device__ __forceinline__ void norm_router(const Args& a, int layer, int k, bool last, LAS unsigned char* lds, int G, int c) {
    const int tid = ltid(), lane = tid & 63; int r0, r1; wave_rows(G, c, r0, r1);
    LAS float* rw = (LAS float*)lds;
    { const float* rsrc = a.in[I_ROUTER] + (size_t)k * D * NE; for (int i = tid; i < D * NE; i += NTHR) rw[(i >> 6) * 68 + (i & 63)] = rsrc[i]; }
    __syncthreads();
    const float* gain = a.in[I_N2G] + layer * D;
    bf16_t* Hout = (bf16_t*)(a.ws + WS_ARENA + A_H);
    RowParams P; P.mi = -1;
    int hist[8];
#pragma unroll
    for (int e = 0; e < 8; ++e) hist[e] = 0;
    float xn[16];
    if (r0 < r1) load_x16(xrow(a, r0), lane, xn);
    for (int row = r0; row < r1; ++row) {
        const int mi = mod_index(row); if (mi != P.mi) load_params(a, P, layer, mi, gain, 3, lane);
        float x[16], h[16];
#pragma unroll
        for (int e = 0; e < 16; ++e) x[e] = xn[e];
        if (row + 1 < r1) load_x16(xrow(a, row + 1), lane, xn);
        { float ss = 0.f;
#pragma unroll
          for (int e = 0; e < 16; ++e) ss += x[e] * x[e];
          ss = wave_sum_dpp(ss);
          const float rstd = __builtin_amdgcn_rsqf(ss * (1.0f / 1024.0f) + NORM_EPS);
#pragma unroll
          for (int e = 0; e < 16; ++e) h[e] = x[e] * rstd * P.A[e] + P.Bv[e]; }
        store_bf16_row(Hout + (size_t)row * 1024, lane, h);
        const bool routed = !(last && mi == 8);
        float lg[8];
#pragma unroll
        for (int e = 0; e < 8; ++e) lg[e] = 0.f;
#pragma unroll
        for (int jj = 0; jj < 2; ++jj)
#pragma unroll
            for (int q = 0; q < 8; ++q) { const LAS f32x4* rp = (const LAS f32x4*)(rw + (jj * 64 + lane) * 68 + q * 8); const f32x4 w0 = rp[0], w1 = rp[1]; const float hv = h[jj * 8 + q];
                lg[0] += hv * w0[0]; lg[1] += hv * w0[1]; lg[2] += hv * w0[2]; lg[3] += hv * w0[3]; lg[4] += hv * w1[0]; lg[5] += hv * w1[1]; lg[6] += hv * w1[2]; lg[7] += hv * w1[3]; }
#pragma unroll
        for (int e = 0; e < 8; ++e) lg[e] = wave_sum_dpp(lg[e]);
        int e0 = 0; float v0 = lg[0];
#pragma unroll
        for (int e = 1; e < 8; ++e) if (lg[e] > v0) { v0 = lg[e]; e0 = e; }
        int e1 = -1; float v1 = -3.0e38f;
#pragma unroll
        for (int e = 0; e < 8; ++e) if (e != e0 && lg[e] > v1) { v1 = lg[e]; e1 = e; }
        const float p0 = __builtin_amdgcn_rcpf(1.0f + __expf(v1 - v0)), p1 = 1.0f - p0;
        if (routed) {
#pragma unroll
            for (int e = 0; e < 8; ++e) hist[e] += (e == e0 || e == e1) ? 1 : 0; }
        if (lane == 0) *(u32x4*)(a.ws + WS_ROUTE + (size_t)row * 16) = (u32x4){(unsigned)(routed ? e0 : -1), (unsigned)(routed ? e1 : -1), __float_as_uint(p0), __float_as_uint(p1)};
    }
    const int gw = c * NWAVE + (tid >> 6);
    if (lane == 0) { int* hp = (int*)(a.ws + WS_HIST) + (size_t)gw * 8;
#pragma unroll
        for (int e = 0; e < 8; ++e) hp[e] = hist[e]; }
}

__device__ __forceinline__ void mla_stats(const Args& a, int G, int c) {
    const int lane = ltid() & 63; int r0, r1; wave_rows(G, c, r0, r1);
    const bf16_t* QKVA = (const bf16_t*)(a.ws + WS_ARENA + A_QKVA); float* rs = (float*)(a.ws + WS_RS);
    for (int row = r0; row < r1; ++row) {
        float sq = 0.f, skv = 0.f; float f[8];
        if (lane < 48) { unpack8(*(const u32x4*)(QKVA + (size_t)row * 768 + lane * 8), f);
#pragma unroll
            for (int e = 0; e < 8; ++e) sq += f[e] * f[e]; }
        if (lane < 32) { unpack8(*(const u32x4*)(QKVA + (size_t)row * 768 + 384 + lane * 8), f);
#pragma unroll
            for (int e = 0; e < 8; ++e) skv += f[e] * f[e]; }
        sq = wave_sum_dpp(sq); skv = wave_sum_dpp(skv);
        if (lane == 0) { rs[row] = 1.0f / sqrtf(sq * (1.0f / 384.0f) + NORM_EPS); rs[R + row] = 1.0f / sqrtf(skv * (1.0f / 256.0f) + NORM_EPS); }
    }
}
__device__ __forceinline__ void mla_qkpost(const Args& a, int j, int G, int c) {
    const int lane = ltid() & 63, hd = lane >> 3, sub = lane & 7; int r0, r1; wave_rows(G, c, r0, r1);
    bf16_t* Q = (bf16_t*)(a.ws + WS_ARENA + A_Q); const bf16_t* KV = (const bf16_t*)(a.ws + WS_ARENA + A_KV); const bf16_t* QKVA = (const bf16_t*)(a.ws + WS_ARENA + A_QKVA);
    bf16_t* K = (bf16_t*)(a.ws + WS_ARENA + A_K); const float* rt = (const float*)(a.ws + WS_ROPE);
    float gq[3][8], gk[3][8];
#pragma unroll
    for (int cc = 0; cc < 3; ++cc)
#pragma unroll
        for (int e = 0; e < 8; ++e) { gq[cc][e] = a.in[I_QN][j * QKH + cc * 64 + sub * 8 + e]; gk[cc][e] = a.in[I_KN][j * QKH + cc * 64 + sub * 8 + e]; }
    const float sgn = (sub & 2) ? 1.0f : -1.0f;
    for (int row = r0; row < r1; ++row) {
        const int r = row % SEG; const bool lat = r >= CTX; const int t = r - CTX, pos = (sub & 4) ? (t & 63) : (t >> 6);
        float cs[8], sn[8];
        if (lat) {
#pragma unroll
            for (int q = 0; q < 2; ++q) { const f32x4 cv = *(const f32x4*)(rt + pos * 16 + (sub & 1) * 8 + 4 * q), sv = *(const f32x4*)(rt + 1024 + pos * 16 + (sub & 1) * 8 + 4 * q);
#pragma unroll
                for (int e = 0; e < 4; ++e) { cs[q * 4 + e] = cv[e]; sn[q * 4 + e] = sv[e]; } } }
        float v[3][8];
        bf16_t* qp = Q + (size_t)row * 1536 + hd * QKH + sub * 8;
#pragma unroll
        for (int cc = 0; cc < 3; ++cc) unpack8(*(const u32x4*)(qp + cc * 64), v[cc]);
        { float ss = 0.f;
#pragma unroll
          for (int cc = 0; cc < 3; ++cc)
#pragma unroll
              for (int e = 0; e < 8; ++e) ss += v[cc][e] * v[cc][e];
          ss = red8(ss); const float rstd = 1.0f / sqrtf(ss * (1.0f / 192.0f) + NORM_EPS);
#pragma unroll
          for (int cc = 0; cc < 3; ++cc)
#pragma unroll
              for (int e = 0; e < 8; ++e) v[cc][e] = v[cc][e] * rstd * gq[cc][e];
          if (lat) {
#pragma unroll
              for (int e = 0; e < 8; ++e) { const float pr = __shfl_xor(v[2][e], 2); v[2][e] = v[2][e] * cs[e] + sgn * pr * sn[e]; } }
#pragma unroll
          for (int cc = 0; cc < 3; ++cc) {
#pragma unroll
              for (int e = 0; e < 8; ++e) v[cc][e] *= QSCALE;
              *(u32x4*)(qp + cc * 64) = pack8(v[cc]); } }
        const bf16_t* kp = KV + (size_t)row * LDKV + hd * 256 + sub * 8;
        unpack8(*(const u32x4*)(kp), v[0]); unpack8(*(const u32x4*)(kp + 64), v[1]); unpack8(*(const u32x4*)(QKVA + (size_t)row * 768 + 640 + sub * 8), v[2]);
        { float ss = 0.f;
#pragma unroll
          for (int cc = 0; cc < 3; ++cc)
#pragma unroll
              for (int e = 0; e < 8; ++e) ss += v[cc][e] * v[cc][e];
          ss = red8(ss); const float rstd = 1.0f / sqrtf(ss * (1.0f / 192.0f) + NORM_EPS);
#pragma unroll
          for (int cc = 0; cc < 3; ++cc)
#pragma unroll
              for (int e = 0; e < 8; ++e) v[cc][e] = v[cc][e] * rstd * gk[cc][e];
          if (lat) {
#pragma unroll
              for (int e = 0; e < 8; ++e) { const float pr = __shfl_xor(v[2][e], 2); v[2][e] = v[2][e] * cs[e] + sgn * pr * sn[e]; } }
          bf16_t* ko = K + (size_t)row * 1536 + hd * QKH + sub * 8;
#pragma unroll
          for (int cc = 0; cc < 3; ++cc) *(u32x4*)(ko + cc * 64) = pack8(v[cc]); }
    }
}

namespace att {
constexpr int KVBLK = 64, KROWB = 384;
constexpr int SHM_V = KVBLK * 128 * 2, SHM_K = KVBLK * KROWB;
constexpr int SHM_ATTN = 2 * SHM_V + 2 * SHM_K + NWAVE * 64 * 4;
constexpr float THR = 11.5f;
#define KSWZ(row, colB) ((row) * att::KROWB + ((colB) ^ (((row) & 7) << 4)))
#define SBAR() __builtin_amdgcn_sched_barrier(0)
__device__ __forceinline__ int crow(int r, int hi) { return (r & 3) + 8 * (r >> 2) + 4 * hi; }
__device__ __forceinline__ void partialSM(f32x16& p0, f32x16& p1, float& m_reg, float& mn, float& alpha) {
    float pmax = p0[0];
#pragma unroll
    for (int r = 1; r < 16; ++r) pmax = fmaxf(pmax, p0[r]);
#pragma unroll
    for (int r = 0; r < 16; ++r) pmax = fmaxf(pmax, p1[r]);
    { auto rr = __builtin_amdgcn_permlane32_swap(__float_as_uint(pmax), __float_as_uint(pmax), false, false); pmax = fmaxf(__uint_as_float(rr[0]), __uint_as_float(rr[1])); }
    if (__builtin_expect(__all(pmax - m_reg <= THR), 1)) { mn = m_reg; alpha = 1.f; }
    else { mn = fmaxf(m_reg, pmax); alpha = __builtin_amdgcn_exp2f(m_reg - mn); m_reg = mn; }
#pragma unroll
    for (int r = 0; r < 16; ++r) { p0[r] -= mn; p1[r] -= mn; }
#pragma unroll
    for (int r = 0; r < 16; ++r) p0[r] = __builtin_amdgcn_exp2f(p0[r]);
}
__device__ __forceinline__ void finishSM(f32x16& p0, f32x16& p1, float alpha, float& l_reg, bf16x8& pa0, bf16x8& pa1, bf16x8& pa2, bf16x8& pa3) {
#pragma unroll
    for (int r = 0; r < 16; ++r) p1[r] = __builtin_amdgcn_exp2f(p1[r]);
    float ps = 0;
#pragma unroll
    for (int r = 0; r < 16; ++r) ps += p0[r];
#pragma unroll
    for (int r = 0; r < 16; ++r) ps += p1[r];
    { auto rr = __builtin_amdgcn_permlane32_swap(__float_as_uint(ps), __float_as_uint(ps), false, false); ps = __uint_as_float(rr[0]) + __uint_as_float(rr[1]); }
    l_reg = l_reg * alpha + ps;
#define PK4(P, BASE, OUT) do { unsigned a0 = cvt_pk_bf16(P[BASE + 0], P[BASE + 1]), a1 = cvt_pk_bf16(P[BASE + 2], P[BASE + 3]);   \
    unsigned b0 = cvt_pk_bf16(P[BASE + 4], P[BASE + 5]), b1 = cvt_pk_bf16(P[BASE + 6], P[BASE + 7]);                              \
    auto r0 = __builtin_amdgcn_permlane32_swap(a0, b0, false, false); auto r1 = __builtin_amdgcn_permlane32_swap(a1, b1, false, false); \
    u32x4 w = {r0[0], r1[0], r0[1], r1[1]}; OUT = *reinterpret_cast<bf16x8*>(&w); } while (0)
    PK4(p0, 0, pa0); PK4(p0, 8, pa1); PK4(p1, 0, pa2); PK4(p1, 8, pa3);
#undef PK4
}
__device__ __forceinline__ void qkt(f32x16& p0, f32x16& p1, const char* Ks, const bf16x8* qr, int r32, int hi) {
    p0 = f32x16{}; p1 = f32x16{};
    bf16x8 ka[4], kb[4];
#define QK_LD(buf, g) do { _Pragma("unroll") for (int q_ = 0; q_ < 2; ++q_) { const int cb_ = ((2 * (g) + q_) * 16 + hi * 8) * 2; \
        buf[2 * q_] = *reinterpret_cast<const bf16x8*>(Ks + KSWZ(r32, cb_)); buf[2 * q_ + 1] = *reinterpret_cast<const bf16x8*>(Ks + KSWZ(32 + r32, cb_)); } } while (0)
#define QK_MM(buf, g) do { _Pragma("unroll") for (int q_ = 0; q_ < 2; ++q_) { p0 = __builtin_amdgcn_mfma_f32_32x32x16_bf16(buf[2 * q_], qr[2 * (g) + q_], p0, 0, 0, 0); \
        p1 = __builtin_amdgcn_mfma_f32_32x32x16_bf16(buf[2 * q_ + 1], qr[2 * (g) + q_], p1, 0, 0, 0); } } while (0)
    QK_LD(ka, 0); SBAR();
    QK_LD(kb, 1); SBAR(); QK_MM(ka, 0); SBAR();
    QK_LD(ka, 2); SBAR(); QK_MM(kb, 1); SBAR();
    QK_LD(kb, 3); SBAR(); QK_MM(ka, 2); SBAR();
    QK_LD(ka, 4); SBAR(); QK_MM(kb, 3); SBAR();
    QK_LD(kb, 5); SBAR(); QK_MM(ka, 4); SBAR();
    QK_MM(kb, 5); SBAR();
#undef QK_LD
#undef QK_MM
}
__device__ __forceinline__ int v_st(int k, int c) { const int kk = (k & ~0xC) | ((k & 4) << 1) | ((k & 8) >> 1); return ((kk >> 3) * 4 + (c >> 5)) * 512 + ((kk & 7) * 32 + (c & 31)) * 2; }
__device__ __forceinline__ int v_rd_base(int lane) { return ((lane & 3) << 3) | (((lane >> 2) & 3) << 6) | (((lane >> 4) & 1) << 5) | (((lane >> 5) & 1) << 8); }
constexpr int v_rd_off(int d0, int ks, int half) { return d0 * 512 + ks * 4096 + half * 2048; }
template <int OFF> __device__ __forceinline__ s16x4 tr_read(int vb) { s16x4 r; asm volatile("ds_read_b64_tr_b16 %0, %1 offset:%2" : "=&v"(r) : "v"(vb), "i"(OFF) : "memory"); return r; }
struct VFrag { s16x4 l0, h0, l1, h1, l2, h2, l3, h3; };
template <int D0> __device__ __forceinline__ void pv_issue(VFrag& f, int vb) {
    f.l0 = tr_read<v_rd_off(D0, 0, 0)>(vb); f.h0 = tr_read<v_rd_off(D0, 0, 1)>(vb); f.l1 = tr_read<v_rd_off(D0, 1, 0)>(vb); f.h1 = tr_read<v_rd_off(D0, 1, 1)>(vb);
    f.l2 = tr_read<v_rd_off(D0, 2, 0)>(vb); f.h2 = tr_read<v_rd_off(D0, 2, 1)>(vb); f.l3 = tr_read<v_rd_off(D0, 3, 0)>(vb); f.h3 = tr_read<v_rd_off(D0, 3, 1)>(vb);
}
__device__ __forceinline__ void pv_mma(f32x16& od, const VFrag& f, bf16x8 pa0, bf16x8 pa1, bf16x8 pa2, bf16x8 pa3) {
#define PK(L, H) (bf16x8){L[0], L[1], L[2], L[3], H[0], H[1], H[2], H[3]}
    od = __builtin_amdgcn_mfma_f32_32x32x16_bf16(pa0, PK(f.l0, f.h0), od, 0, 0, 0);
    od = __builtin_amdgcn_mfma_f32_32x32x16_bf16(pa1, PK(f.l1, f.h1), od, 0, 0, 0);
    od = __builtin_amdgcn_mfma_f32_32x32x16_bf16(pa2, PK(f.l2, f.h2), od, 0, 0, 0);
    od = __builtin_amdgcn_mfma_f32_32x32x16_bf16(pa3, PK(f.l3, f.h3), od, 0, 0, 0);
#undef PK
}
__device__ __forceinline__ void pv_d0(f32x16* o, int vb, bf16x8 pa0, bf16x8 pa1, bf16x8 pa2, bf16x8 pa3) {
    VFrag fa, fb;
    pv_issue<0>(fa, vb); pv_issue<1>(fb, vb);
    asm volatile("s_waitcnt lgkmcnt(8)" ::: "memory"); SBAR(); pv_mma(o[0], fa, pa0, pa1, pa2, pa3); SBAR();
    pv_issue<2>(fa, vb);
    asm volatile("s_waitcnt lgkmcnt(8)" ::: "memory"); SBAR(); pv_mma(o[1], fb, pa0, pa1, pa2, pa3); SBAR();
    pv_issue<3>(fb, vb);
    asm volatile("s_waitcnt lgkmcnt(8)" ::: "memory"); SBAR(); pv_mma(o[2], fa, pa0, pa1, pa2, pa3); SBAR();
    asm volatile("s_waitcnt lgkmcnt(0)" ::: "memory"); SBAR(); pv_mma(o[3], fb, pa0, pa1, pa2, pa3);
}
__device__ __forceinline__ void attn_unit(const bf16_t* __restrict__ Qb, const bf16_t* __restrict__ Kh, const bf16_t* __restrict__ Vh, bf16_t* __restrict__ Ob, int seq, char* lds) {
    constexpr int LDQ = 1536, LDK = 1536, LDV = LDKV, LDO = 1024;
    const int tid = ltid(), wid = tid >> 6, lane = tid & 63, r32 = lane & 31, hi = lane >> 5;
    char* V_lds = lds; char* K_lds = lds + 2 * SHM_V;
    float* wsp = (float*)(lds + 2 * SHM_V + 2 * SHM_K) + wid * 64; float* li_l = wsp; float* al_l = wsp + 32;
    float m_reg = -1e30f, l_reg = 0; f32x16 o[4] = {}; bf16x8 qr[12];
    const bf16_t* Qw = Qb + (long)(wid * 32 + r32) * LDQ + hi * 8;
#pragma unroll
    for (int d0 = 0; d0 < 12; ++d0) qr[d0] = *(const __attribute__((address_space(1))) bf16x8*)((const __attribute__((address_space(1))) bf16_t*)Qw + d0 * 16);
    const int sr = tid >> 4, sc = (tid & 15) * 8, vst0 = v_st(sr, sc), vst1 = v_st(32 + sr, sc);
    int kkey[3], kcb[3];
#pragma unroll
    for (int i = 0; i < 3; ++i) { const int ci = tid + i * 512; kkey[i] = ci / 24; kcb[i] = (ci % 24) * 16; }
    const int vb0 = (int)(uintptr_t)(LAS char*)V_lds + v_rd_base(lane);
    bf16x8 vs0, vs1, ks0, ks1, ks2;
#define GAS __attribute__((address_space(1)))
#define SLOAD(k0) do { vs0 = *(const GAS bf16x8*)((const GAS bf16_t*)Vh + (long)((k0) + sr) * LDV + sc); vs1 = *(const GAS bf16x8*)((const GAS bf16_t*)Vh + (long)((k0) + 32 + sr) * LDV + sc); \
    ks0 = *(const GAS bf16x8*)((const GAS char*)Kh + (long)((k0) + kkey[0]) * (LDK * 2) + kcb[0]); ks1 = *(const GAS bf16x8*)((const GAS char*)Kh + (long)((k0) + kkey[1]) * (LDK * 2) + kcb[1]); \
    ks2 = *(const GAS bf16x8*)((const GAS char*)Kh + (long)((k0) + kkey[2]) * (LDK * 2) + kcb[2]); } while (0)
#define SWRITE(b) do { *(bf16x8*)(V_lds + (b) * SHM_V + vst0) = vs0; *(bf16x8*)(V_lds + (b) * SHM_V + vst1) = vs1; \
    *(bf16x8*)(K_lds + (b) * SHM_K + KSWZ(kkey[0], kcb[0])) = ks0; *(bf16x8*)(K_lds + (b) * SHM_K + KSWZ(kkey[1], kcb[1])) = ks1; *(bf16x8*)(K_lds + (b) * SHM_K + KSWZ(kkey[2], kcb[2])) = ks2; } while (0)
#define SWAIT() asm volatile("s_waitcnt vmcnt(0)" ::: "memory")
#define RESC(al) do { if (__any((al) < 1.f)) { if (hi == 0) al_l[r32] = (al); asm volatile("s_waitcnt lgkmcnt(0)" ::: "memory"); \
    _Pragma("unroll") for (int d = 0; d < 4; ++d) _Pragma("unroll") for (int r = 0; r < 16; ++r) o[d][r] *= al_l[crow(r, hi)]; } } while (0)
    f32x16 p0, p1; float mn, al; bf16x8 pa0, pa1, pa2, pa3; const int NT = seq / KVBLK;
    SLOAD(0); SWAIT(); SWRITE(0); __syncthreads();
    for (int j = 0; j < NT; ++j) {
        const int bsel = j & 1;
        if (j + 1 < NT) SLOAD((j + 1) * KVBLK);
        SBAR(); qkt(p0, p1, K_lds + bsel * SHM_K, qr, r32, hi);
        partialSM(p0, p1, m_reg, mn, al);
        RESC(al);
        finishSM(p0, p1, al, l_reg, pa0, pa1, pa2, pa3); SBAR();
        pv_d0(o, vb0 + bsel * SHM_V, pa0, pa1, pa2, pa3);
        if (j + 1 < NT) { SWAIT(); SWRITE(bsel ^ 1); }
        __syncthreads();
    }
    if (hi == 0) li_l[r32] = l_reg; asm volatile("s_waitcnt lgkmcnt(0)" ::: "memory");
    float rli[16];
#pragma unroll
    for (int r = 0; r < 16; ++r) rli[r] = __builtin_amdgcn_rcpf(li_l[crow(r, hi)]);
    bf16_t* Ow = Ob + (long)(wid * 32) * LDO;
#pragma unroll
    for (int r = 0; r < 16; ++r) { const int orow = crow(r, hi);
#pragma unroll
        for (int d0 = 0; d0 < 4; ++d0) { const float val = o[d0][r] * rli[r]; ((__attribute__((address_space(1))) bf16_t*)Ow)[(long)orow * LDO + d0 * 32 + r32] = (bf16_t)(cvt_pk_bf16(val, val) & 0xffffu); } }
    __syncthreads();
#undef SLOAD
#undef SWRITE
#undef SWAIT
#undef RESC
}
}
__device__ __forceinline__ void attn_phase(const Args& a, LAS unsigned char* lds, int G, int c) {
    const bf16_t* Q = (const bf16_t*)(a.ws + WS_ARENA + A_Q); const bf16_t* K = (const bf16_t*)(a.ws + WS_ARENA + A_K); const bf16_t* KV = (const bf16_t*)(a.ws + WS_ARENA + A_KV);
    bf16_t* O = (bf16_t*)(a.ws + WS_ARENA + A_O);
    const int vcu = (G % 8 == 0) ? (c % 8) * (G / 8) + c / 8 : c;
    for (int L = vcu; L < 1024 + 64; L += G) {
        int b, h, q0, seq;
        if (L < 1024) { b = L >> 7; h = (L >> 4) & 7; q0 = CTX + (L & 15) * 256; seq = SEG; } else { const int l2 = L - 1024; b = l2 >> 3; h = l2 & 7; q0 = 0; seq = CTX; }
        const size_t rb = (size_t)b * SEG;
        att::attn_unit(Q + (rb + q0) * 1536 + h * QKH, K + rb * 1536 + h * QKH, KV + rb * LDKV + h * 256 + 128, O + (rb + q0) * 1024 + h * VH, seq, (char*)lds);
    }
}

namespace scan {
constexpr int CH = 32, STEP_B = 6 * 256, BUF_B = CH * STEP_B  , YB_B = CH * 64 * 4  , LDS_B = 2 * BUF_B + 2 * YB_B  , NCH = SEG / CH  ;
constexpr int TILE_B = 64 * 65 * 4, MT_TILES = 24 * 896;
struct MTile { const float* src; bf16_t* dst; int sld, ldd, n0, k0, grpd; };
__device__ __forceinline__ int step_row(int b, int dir, int gs) {
    const int base = b * SEG;
    if (dir == 0) return base + gs;
    return gs < CTX ? base + (CTX - 1 - gs) : base + CTX + (SEG - 1 - gs);
}
struct Raw { u32x4 k, r, v, wl, al, vf, vl; };
}
__device__ __forceinline__ bool moe_tile(const Args& a, int k, int t, scan::MTile& m) {
    if (CS_NOTILE || t >= scan::MT_TILES) return false;
    const int j = t / 896, tl = t - j * 896, e = j / 3, kind = j - e * 3; int tn;
    const size_t so = (size_t)(k * NE + e) * D * DFE;
    if (kind < 2) { m.src = a.in[kind == 0 ? I_M1 : I_M3] + so; m.sld = DFE; m.dst = (bf16_t*)(a.ws + WS_ARENA + A_WM13) + (size_t)e * E_M13 + (kind ? (size_t)128 * 1024 : 0); m.ldd = 1024; tn = 56; m.grpd = 1; }
    else { m.src = a.in[I_M2] + so; m.sld = D; m.dst = (bf16_t*)(a.ws + WS_ARENA + A_WM2) + (size_t)e * E_M2; m.ldd = DFE; tn = 16; m.grpd = 0; }
    m.n0 = (tl % tn) * 64; m.k0 = (tl / tn) * 64; return true;
}
__device__ __forceinline__ void scan_phase(const Args& a, int j, const bf16_t* Vsrc, const bool vres, LAS unsigned char* lds, int G, int c) {
    using namespace scan;
    int mt_round = 0;
    const int tid = ltid(), wave = tid >> 6, lane = tid & 63;
    const bf16_t* RR = (const bf16_t*)(a.ws + WS_ARENA + A_RR); const bf16_t* RK = (const bf16_t*)(a.ws + WS_ARENA + A_RK);
    for (int chain = c; chain < 256; chain += G) {
        const int b = chain >> 5, h = (chain >> 1) & 15, dir = chain & 1;
        const bf16_t* WL = (const bf16_t*)(a.ws + WS_ARENA + (dir ? A_WL1 : A_WL0)); const bf16_t* AL = (const bf16_t*)(a.ws + WS_ARENA + (dir ? A_AL1 : A_AL0));
        bf16_t* Y = (bf16_t*)(a.ws + WS_ARENA + (dir ? A_YR : A_YF));
        if (wave >= 4) {
            const int pt = tid - 256, s = pt >> 3, seg = pt & 7, ch0 = h * 64 + seg * 8;
            float kkp[8], kap[8], v0p[8];
            const bf16_t* VFp = (const bf16_t*)(a.ws + WS_VF); const bf16_t* VLp = (const bf16_t*)(a.ws + WS_ARENA + A_VL);
#pragma unroll
            for (int e = 0; e < 8; ++e) v0p[e] = vres ? a.in[I_V0][ch0 + e] : 0.f;
#pragma unroll
            for (int e = 0; e < 8; ++e) { kkp[e] = a.in[I_KK][(size_t)j * D + ch0 + e]; kap[e] = a.in[I_KA][(size_t)j * D + ch0 + e]; }
            Raw raw;
#define GLOAD(q) do { const size_t off_ = (size_t)step_row(b, dir, (q) * CH + s) * 1024 + ch0; \
                raw.k = *(const u32x4*)(RK + off_); raw.r = *(const u32x4*)(RR + off_); raw.v = *(const u32x4*)(Vsrc + off_); raw.wl = *(const u32x4*)(WL + off_); raw.al = *(const u32x4*)(AL + off_); \
                if (vres) { raw.vf = *(const u32x4*)(VFp + off_); raw.vl = *(const u32x4*)(VLp + off_); } } while (0)
#define PRODUCE(buf) do { \
                float k[8], r[8], v[8], wl[8], al[8]; unpack8(raw.k, k); unpack8(raw.r, r); unpack8(raw.v, v); unpack8(raw.wl, wl); unpack8(raw.al, al); \
                if (vres) { float vf[8], vl[8]; unpack8(raw.vf, vf); unpack8(raw.vl, vl); _Pragma("unroll") for (int e = 0; e < 8; ++e) v[e] = v[e] + (vf[e] - v[e]) * sigmoidf_(v0p[e] + vl[e]); } \
                float ad[8], kd[8], kk[8], ww[8], ss = 0.f; \
                _Pragma("unroll") for (int e = 0; e < 8; ++e) { ad[e] = al[e]; kd[e] = k[e] * (1.0f + (ad[e] - 1.0f) * kap[e]); kk[e] = k[e] * kkp[e]; ss += kk[e] * kk[e]; \
                    ww[e] = __expf(-wl[e]); } \
                ss = red8(ss); const float inv = 1.0f / fmaxf(sqrtf(ss), 1e-12f); \
                LAS f32x4* o = (LAS f32x4*)(lds + (buf) * BUF_B + s * STEP_B + seg * 32); \
                _Pragma("unroll") for (int e = 0; e < 8; ++e) kk[e] *= inv; \
                o[0] = (f32x4){ww[0], ww[1], ww[2], ww[3]}; o[1] = (f32x4){ww[4], ww[5], ww[6], ww[7]}; \
                o[16] = (f32x4){kd[0], kd[1], kd[2], kd[3]}; o[17] = (f32x4){kd[4], kd[5], kd[6], kd[7]}; \
                o[32] = (f32x4){-kk[0], -kk[1], -kk[2], -kk[3]}; o[33] = (f32x4){-kk[4], -kk[5], -kk[6], -kk[7]}; \
                o[48] = (f32x4){kk[0] * ad[0], kk[1] * ad[1], kk[2] * ad[2], kk[3] * ad[3]}; o[49] = (f32x4){kk[4] * ad[4], kk[5] * ad[5], kk[6] * ad[6], kk[7] * ad[7]}; \
                o[64] = (f32x4){r[0], r[1], r[2], r[3]}; o[65] = (f32x4){r[4], r[5], r[6], r[7]}; \
                o[80] = (f32x4){v[0], v[1], v[2], v[3]}; o[81] = (f32x4){v[4], v[5], v[6], v[7]}; } while (0)
#define YSTORE(q) do { const LAS f32x4* yp = (const LAS f32x4*)(lds + 2 * BUF_B + ((q) & 1) * YB_B + s * 256 + seg * 32); const f32x4 y0 = yp[0], y1 = yp[1]; \
                u32x4 w; w.x = cvt_pk_bf16(y0[0], y0[1]); w.y = cvt_pk_bf16(y0[2], y0[3]); w.z = cvt_pk_bf16(y1[0], y1[1]); w.w = cvt_pk_bf16(y1[2], y1[3]); \
                *(u32x4*)(Y + (size_t)step_row(b, dir, (q) * CH + s) * 1024 + ch0) = w; } while (0)
            GLOAD(0); PRODUCE(0); GLOAD(1);
            __syncthreads();
            f32x4 treg[4]; const int kl = pt >> 4, nq = (pt & 15) * 4, sn = pt >> 2, sk = (pt & 3) * 16;
            for (int q = 0; q < NCH; ++q) {
                if (q + 1 < NCH) { PRODUCE((q + 1) & 1); if (q + 2 < NCH) GLOAD(q + 2); }
                if (q >= 1) YSTORE(q - 1);
                MTile m;
                if (q >= 2 && moe_tile(a, j, c + (mt_round + q - 2) * G, m)) {
                    const LAS float* tl_ = (const LAS float*)(lds + LDS_B + (q & 1) * TILE_B); float f0[8], f1[8];
#pragma unroll
                    for (int e = 0; e < 8; ++e) { f0[e] = tl_[(sk + e) * 65 + sn]; f1[e] = tl_[(sk + 8 + e) * 65 + sn]; }
                    const int n = m.n0 + sn, dr = m.grpd ? ((n >> 7) * 256 + (n & 127)) : n; bf16_t* dp = m.dst + (size_t)dr * m.ldd + m.k0 + sk;
                    *(u32x4*)dp = pack8(f0); *(u32x4*)(dp + 8) = pack8(f1); }
                if (q >= 1 && q <= NCH - 2 && moe_tile(a, j, c + (mt_round + q - 1) * G, m)) {
                    LAS float* tl_ = (LAS float*)(lds + LDS_B + ((q - 1) & 1) * TILE_B);
#pragma unroll
                    for (int p = 0; p < 4; ++p) { LAS float* tp = tl_ + (kl + 16 * p) * 65 + nq; tp[0] = treg[p][0]; tp[1] = treg[p][1]; tp[2] = treg[p][2]; tp[3] = treg[p][3]; } }
                if (q <= NCH - 3 && moe_tile(a, j, c + (mt_round + q) * G, m)) {
#pragma unroll
                    for (int p = 0; p < 4; ++p) treg[p] = *(const f32x4*)(m.src + (size_t)(m.k0 + kl + 16 * p) * m.sld + m.n0 + nq); }
                __syncthreads();
            }
            YSTORE(NCH - 1);
#undef GLOAD
#undef PRODUCE
#undef YSTORE
        } else {
            const int rp = lane >> 3, ks = lane & 7, v0i = wave * 16 + rp * 2;
            f32x2 s0[4], s1[4];
#pragma unroll
            for (int i = 0; i < 4; ++i) { s0[i] = (f32x2){0.f, 0.f}; s1[i] = (f32x2){0.f, 0.f}; }
            __syncthreads();
            struct Vecs { f32x4 w0, w1, k0, k1, a0, a1, b0, b1, r0, r1; f32x2 vv; };
#define LOADV(V, t) do { const LAS f32x4* p_ = (const LAS f32x4*)(bp + (t) * STEP_B); V.w0 = p_[0]; V.w1 = p_[1]; V.k0 = p_[16]; V.k1 = p_[17]; V.a0 = p_[32]; V.a1 = p_[33]; \
                    V.b0 = p_[48]; V.b1 = p_[49]; V.r0 = p_[64]; V.r1 = p_[65]; V.vv = *(const LAS f32x2*)(vp + (t) * STEP_B); } while (0)
#define STEPV(V, t, HAVEPREV) do { \
                    const f32x2 wv[4] = {{V.w0[0], V.w0[1]}, {V.w0[2], V.w0[3]}, {V.w1[0], V.w1[1]}, {V.w1[2], V.w1[3]}}, kv[4] = {{V.k0[0], V.k0[1]}, {V.k0[2], V.k0[3]}, {V.k1[0], V.k1[1]}, {V.k1[2], V.k1[3]}}; \
                    const f32x2 av[4] = {{V.a0[0], V.a0[1]}, {V.a0[2], V.a0[3]}, {V.a1[0], V.a1[1]}, {V.a1[2], V.a1[3]}}, bv[4] = {{V.b0[0], V.b0[1]}, {V.b0[2], V.b0[3]}, {V.b1[0], V.b1[1]}, {V.b1[2], V.b1[3]}}; \
                    const f32x2 rv[4] = {{V.r0[0], V.r0[1]}, {V.r0[2], V.r0[3]}, {V.r1[0], V.r1[1]}, {V.r1[2], V.r1[3]}}; \
                    f32x2 d0 = s0[0] * av[0], d1 = s1[0] * av[0]; \
                    d0 += s0[1] * av[1]; d1 += s1[1] * av[1]; d0 += s0[2] * av[2]; d1 += s1[2] * av[2]; d0 += s0[3] * av[3]; d1 += s1[3] * av[3]; \
                    float h0 = d0.x + d0.y, h1 = d1.x + d1.y; \
                    h0 += dpp_f<0xB1>(h0); h1 += dpp_f<0xB1>(h1); yp0 += dpp_f<0xB1>(yp0); yp1 += dpp_f<0xB1>(yp1); \
                    h0 += dpp_f<0x4E>(h0); h1 += dpp_f<0x4E>(h1); yp0 += dpp_f<0x4E>(yp0); yp1 += dpp_f<0x4E>(yp1); \
                    h0 += dpp_f<0x141>(h0); h1 += dpp_f<0x141>(h1); yp0 += dpp_f<0x141>(yp0); yp1 += dpp_f<0x141>(yp1); \
                    if (HAVEPREV) yb[((t) - 1) * 64 + v0i + (ks & 1)] = (ks & 1) ? yp1 : yp0; \
                    const f32x2 sa0v = {h0, h0}, sa1v = {h1, h1}, v0v = {V.vv.x, V.vv.x}, v1v = {V.vv.y, V.vv.y}; \
                    _Pragma("unroll") for (int i = 0; i < 4; ++i) { s0[i] = s0[i] * wv[i] + sa0v * bv[i] + v0v * kv[i]; s1[i] = s1[i] * wv[i] + sa1v * bv[i] + v1v * kv[i]; } \
                    f32x2 y0 = s0[0] * rv[0], y1 = s1[0] * rv[0]; \
                    y0 += s0[1] * rv[1]; y1 += s1[1] * rv[1]; y0 += s0[2] * rv[2]; y1 += s1[2] * rv[2]; y0 += s0[3] * rv[3]; y1 += s1[3] * rv[3]; \
                    yp0 = y0.x + y0.y; yp1 = y1.x + y1.y; } while (0)
            for (int q = 0; q < NCH; ++q) {
                const LAS unsigned char* bp = lds + (q & 1) * BUF_B + ks * 32;
                const LAS unsigned char* vp = lds + (q & 1) * BUF_B + 5 * 256 + v0i * 4;
                LAS float* yb = (LAS float*)(lds + 2 * BUF_B + (q & 1) * YB_B);
                Vecs VA, VB; float yp0 = 0.f, yp1 = 0.f;
                LOADV(VA, 0); LOADV(VB, 1);
                STEPV(VA, 0, false);
                LOADV(VA, 2);
                STEPV(VB, 1, true);
#pragma unroll 1
                for (int t = 2; t < CH; t += 2) {
                    LOADV(VB, t + 1);
                    STEPV(VA, t, true);
                    LOADV(VA, t + 2);
                    STEPV(VB, t + 1, true);
                }
                yp0 = red8(yp0); yp1 = red8(yp1);
                yb[(CH - 1) * 64 + v0i + (ks & 1)] = (ks & 1) ? yp1 : yp0;
                __syncthreads();
            }
#undef LOADV
#undef STEPV
        }
        mt_round += NCH - 2;
        __syncthreads();
    }
}

namespace cs {
constexpr int C = 32, NCK = SEG / C;
constexpr int TM = 72, CM = 40, TMB = TM * 2, CMB = CM * 2;
constexpr int SZ_TM = 32 * TMB, SZ_CM = 64 * CMB, SZ_C32 = 32 * CMB;
constexpr int X_ATM = 0, X_RTM = SZ_TM, X_BHTM = 2 * SZ_TM, X_KHTM = 3 * SZ_TM, X_ACM = 4 * SZ_TM, X_RCM = X_ACM + SZ_CM, X_BBCM = X_RCM + SZ_CM, X_KBCM = X_BBCM + SZ_CM, X_B = X_KBCM + SZ_CM;
constexpr int Y_VCM = 0, Y_GC = SZ_CM, Y_B = SZ_CM + 256;
constexpr int OFF_X = 0, OFF_Y = 2 * X_B, OFF_MID = OFF_Y + 2 * Y_B;
constexpr int M_NL = 0, M_NR = SZ_C32, M_TT = 2 * SZ_C32, M_ARBT = 3 * SZ_C32, M_AAK = 4 * SZ_C32, M_UP = 5 * SZ_C32, M_W = 6 * SZ_C32, M_ARK = M_W + SZ_CM, MID_B = M_ARK + 4096;
constexpr int OFF_OUT = OFF_MID + MID_B;
constexpr int O_PST = 0, O_QST = 64 * TMB, O_PYT = O_QST + SZ_CM, O_QYT = O_PYT + SZ_TM, OUT_B = O_QYT + SZ_C32;
constexpr int OFF_YB = OFF_OUT + OUT_B, OFF_ES = OFF_YB + 8192, OFF_WT = OFF_ES + 2048, LDS_END = OFF_WT + 64 * 65 * 4;
__device__ __forceinline__ int rho(int r, int h) { return (r & 3) + 8 * (r >> 2) + 4 * h; }
__device__ __forceinline__ int perm16(int k) { return (k & ~0xC) | ((k & 4) << 1) | ((k & 8) >> 1); }
typedef __bf16 bf16v2 __attribute__((ext_vector_type(2)));
__device__ __forceinline__ unsigned cvt_pk_bf16_c(float lo, float hi) { const bf16v2 v = __builtin_convertvector((f32x2){lo, hi}, bf16v2); return __builtin_bit_cast(unsigned, v); }
__device__ __forceinline__ bf16_t f2bf(float x) { const __bf16 b = (__bf16)x; return __builtin_bit_cast(bf16_t, b); }
__device__ __forceinline__ float bf2f(bf16_t x) { return __uint_as_float((unsigned)x << 16); }
template <int KS> __device__ __forceinline__ void mma32t(f32x16& acc, const LAS unsigned char* A, int lda, const LAS unsigned char* B, int ldb, int r32, int h) {
    bf16x8 a[KS], b[KS];
#pragma unroll
    for (int s = 0; s < KS; ++s) { a[s] = *(const LAS bf16x8*)(A + r32 * lda + s * 32 + h * 16); b[s] = *(const LAS bf16x8*)(B + r32 * ldb + s * 32 + h * 16); }
#pragma unroll
    for (int s = 0; s < KS; ++s) acc = __builtin_amdgcn_mfma_f32_32x32x16_bf16(a[s], b[s], acc, 0, 0, 0);
}
__device__ __forceinline__ void mma32(f32x16& acc, const LAS unsigned char* A, int lda, const LAS unsigned char* B, int ldb, int ksteps, int r32, int h) {
    if (ksteps == 4) mma32t<4>(acc, A, lda, B, ldb, r32, h); else mma32t<2>(acc, A, lda, B, ldb, r32, h);
}
__device__ __forceinline__ void st_bf(const f32x16& acc, LAS unsigned char* dst, int sr, int sc, int r32, int h) {
#pragma unroll
    for (int r = 0; r < 16; ++r) *(LAS bf16_t*)(dst + rho(r, h) * sr + r32 * sc) = f2bf(acc[r]);
}
template <bool PERM> __device__ __forceinline__ void st_bf_T(const f32x16& acc, LAS unsigned char* dst, int sc, int r32, int h) {
#pragma unroll
    for (int m = 0; m < 4; ++m) { const int row0 = 8 * m + 4 * h, pos = PERM ? perm16(row0) : row0; u32x2 w; w.x = cvt_pk_bf16_c(acc[4 * m], acc[4 * m + 1]); w.y = cvt_pk_bf16_c(acc[4 * m + 2], acc[4 * m + 3]);
        *(LAS u32x2*)(dst + r32 * sc + pos * 2) = w; }
}
}
#define CS_BAR() do { asm volatile("s_waitcnt lgkmcnt(0)" ::: "memory"); __builtin_amdgcn_s_barrier(); asm volatile("" ::: "memory"); } while (0)
__device__ __forceinline__ void scan_chunked(const Args& a, int jl, const bf16_t* Vsrc, const bool vres, LAS unsigned char* lds, int G, int c) {
    using namespace cs;
    const int tid0 = ltid(), wave = __builtin_amdgcn_readfirstlane(tid0 >> 6);
    typedef const __attribute__((address_space(1))) bf16_t* gcp; typedef __attribute__((address_space(1))) bf16_t* gwp;
    gcp RR = (gcp)(a.ws + WS_ARENA + A_RR); gcp RK = (gcp)(a.ws + WS_ARENA + A_RK);
    gcp VFp = (gcp)(a.ws + WS_VF); gcp VLp = (gcp)(a.ws + WS_ARENA + A_VL); gcp Vg = (gcp)Vsrc;
    int mt0 = 0;
    for (int chain = c; chain < 256; chain += G) {
        const int b = chain >> 5, hd = (chain >> 1) & 15, dir = chain & 1;
        gcp WL = (gcp)(a.ws + WS_ARENA + (dir ? A_WL1 : A_WL0)); gcp AL = (gcp)(a.ws + WS_ARENA + (dir ? A_AL1 : A_AL0));
        gwp Y = (gwp)(a.ws + WS_ARENA + (dir ? A_YCR : A_YCF));
        const int gcol0 = hd * 64 + (tid0 & 63);
        const float kkp = a.in[I_KK][(size_t)jl * D + gcol0], kap = a.in[I_KA][(size_t)jl * D + gcol0], v0p = vres ? a.in[I_V0][gcol0] : 0.f;
        f32x16 S0 = {}, S1 = {};
        f32x4 wreg[8];
        constexpr int ntok = 4; const int tok0 = 4 * wave;
        bf16_t rk_[4], rr_[4], ra_[4], rv_[4], re_[4], rf_[4], rl_[4];
        bf16_t qk_[4], qr_[4], qa_[4], qv_[4], qe_[4], qf_[4], ql_[4];
#define CS_LOAD(q) do { _Pragma("unroll") for (int tk_ = 0; tk_ < 4; ++tk_) { const unsigned off_ = (unsigned)scan::step_row(b, dir, (q) * 32 + tok0 + tk_) * 1024u + (unsigned)gcol; \
                qk_[tk_] = RK[off_]; qr_[tk_] = RR[off_]; qa_[tk_] = AL[off_]; qe_[tk_] = WL[off_]; qv_[tk_] = Vg[off_]; if (vres) { qf_[tk_] = VFp[off_]; ql_[tk_] = VLp[off_]; } } } while (0)
#define CS_COPY() do { _Pragma("unroll") for (int tk_ = 0; tk_ < 4; ++tk_) { rk_[tk_] = qk_[tk_]; rr_[tk_] = qr_[tk_]; ra_[tk_] = qa_[tk_]; re_[tk_] = qe_[tk_]; rv_[tk_] = qv_[tk_]; rf_[tk_] = qf_[tk_]; rl_[tk_] = ql_[tk_]; } } while (0)
#define CS_ESUM() do { float es_ = 0.f; _Pragma("unroll") for (int tk_ = 0; tk_ < 4; ++tk_) es_ += bf2f(re_[tk_]); *(LAS float*)(lds + OFF_ES + wave * 256 + lane * 4) = es_; } while (0)
#define CS_MAIN(q) do { \
            LAS unsigned char* X_ = lds + OFF_X + ((q) & 1) * X_B; LAS unsigned char* Yb_ = lds + OFF_Y + ((q) & 1) * Y_B; \
            float before_ = 0.f, tot_ = 0.f; \
            _Pragma("unroll") for (int w_ = 0; w_ < 8; ++w_) { const float es_ = *(const LAS float*)(lds + OFF_ES + w_ * 256 + lane * 4); before_ += (w_ < wave) ? es_ : 0.f; tot_ += es_; } \
            float erun_ = __expf(-before_); const float gct_ = __expf(-tot_); \
            _Pragma("unroll") for (int p_ = 0; p_ < 2; ++p_) { const int t_ = tok0 + 2 * p_;            \
                const f32x2 kraw_ = {bf2f(rk_[2 * p_]), bf2f(rk_[2 * p_ + 1])}, rr2_ = {bf2f(rr_[2 * p_]), bf2f(rr_[2 * p_ + 1])}, ad_ = {bf2f(ra_[2 * p_]), bf2f(ra_[2 * p_ + 1])}; \
                f32x2 vv_ = {bf2f(rv_[2 * p_]), bf2f(rv_[2 * p_ + 1])}; \
                if (vres) { const f32x2 vf_ = {bf2f(rf_[2 * p_]), bf2f(rf_[2 * p_ + 1])}; const float s0_ = sigmoidf_(v0p + bf2f(rl_[2 * p_])), s1_ = sigmoidf_(v0p + bf2f(rl_[2 * p_ + 1])); \
                    vv_ = vv_ + (vf_ - vv_) * (f32x2){s0_, s1_}; } \
                const f32x2 kd_ = kraw_ * ((ad_ - 1.0f) * kap + 1.0f), kkr_ = kraw_ * kkp, sq_ = kkr_ * kkr_; \
                float s0 = sq_.x, s1 = sq_.y; \
                s0 += dpp_f<0xB1>(s0); s1 += dpp_f<0xB1>(s1); s0 += dpp_f<0x4E>(s0); s1 += dpp_f<0x4E>(s1); s0 += dpp_f<0x141>(s0); s1 += dpp_f<0x141>(s1); s0 += dpp_f<0x140>(s0); s1 += dpp_f<0x140>(s1); \
                const int i0_ = __float_as_int(s0), i1_ = __float_as_int(s1); \
                const float ss0_ = (__int_as_float(__builtin_amdgcn_readlane(i0_, 0)) + __int_as_float(__builtin_amdgcn_readlane(i0_, 16))) + (__int_as_float(__builtin_amdgcn_readlane(i0_, 32)) + __int_as_float(__builtin_amdgcn_readlane(i0_, 48))); \
                const float ss1_ = (__int_as_float(__builtin_amdgcn_readlane(i1_, 0)) + __int_as_float(__builtin_amdgcn_readlane(i1_, 16))) + (__int_as_float(__builtin_amdgcn_readlane(i1_, 32)) + __int_as_float(__builtin_amdgcn_readlane(i1_, 48))); \
                const f32x2 kk_ = kkr_ * (f32x2){__builtin_amdgcn_rsqf(fmaxf(ss0_, 1e-24f)), __builtin_amdgcn_rsqf(fmaxf(ss1_, 1e-24f))}; \
                const float w0_ = __expf(-bf2f(re_[2 * p_])), w1_ = __expf(-bf2f(re_[2 * p_ + 1])); \
                f32x2 E1_, E2_; E1_.x = erun_; E2_.x = erun_ * w0_; E1_.y = E2_.x; E2_.y = E2_.x * w1_; erun_ = E2_.y; \
                const f32x2 Ei_ = {__builtin_amdgcn_rcpf(E2_.x), __builtin_amdgcn_rcpf(E2_.y)}, E3_ = Ei_ * gct_, bv_ = kk_ * ad_; \
                const f32x2 at2_ = -(kk_ * E1_), rt2_ = rr2_ * E2_, bh2_ = bv_ * Ei_, kh2_ = kd_ * Ei_, kb2_ = kd_ * E3_, bb2_ = bv_ * E3_; \
                const unsigned pa_ = cvt_pk_bf16_c(at2_.x, at2_.y), pr_ = cvt_pk_bf16_c(rt2_.x, rt2_.y), pbh_ = cvt_pk_bf16_c(bh2_.x, bh2_.y), pkh_ = cvt_pk_bf16_c(kh2_.x, kh2_.y); \
                *(LAS unsigned*)(X_ + X_ACM + lane * CMB + t_ * 2) = pa_; *(LAS unsigned*)(X_ + X_RCM + lane * CMB + t_ * 2) = pr_; \
                *(LAS unsigned*)(X_ + X_KBCM + lane * CMB + t_ * 2) = cvt_pk_bf16_c(kb2_.x, kb2_.y); *(LAS unsigned*)(X_ + X_BBCM + lane * CMB + t_ * 2) = cvt_pk_bf16_c(bb2_.x, bb2_.y); \
                *(LAS unsigned*)(Yb_ + Y_VCM + lane * CMB + t_ * 2) = cvt_pk_bf16_c(vv_.x, vv_.y); \
                *(LAS bf16_t*)(X_ + X_ATM + t_ * TMB + lane * 2) = (bf16_t)pa_; *(LAS bf16_t*)(X_ + X_ATM + (t_ + 1) * TMB + lane * 2) = (bf16_t)(pa_ >> 16); \
                *(LAS bf16_t*)(X_ + X_RTM + t_ * TMB + lane * 2) = (bf16_t)pr_; *(LAS bf16_t*)(X_ + X_RTM + (t_ + 1) * TMB + lane * 2) = (bf16_t)(pr_ >> 16); \
                *(LAS bf16_t*)(X_ + X_BHTM + t_ * TMB + lane * 2) = (bf16_t)pbh_; *(LAS bf16_t*)(X_ + X_BHTM + (t_ + 1) * TMB + lane * 2) = (bf16_t)(pbh_ >> 16); \
                *(LAS bf16_t*)(X_ + X_KHTM + t_ * TMB + lane * 2) = (bf16_t)pkh_; *(LAS bf16_t*)(X_ + X_KHTM + (t_ + 1) * TMB + lane * 2) = (bf16_t)(pkh_ >> 16); } \
            if (wave == 7) *(LAS float*)(Yb_ + Y_GC + lane * 4) = gct_; } while (0)
        { const int tid = ltid(), lane = tid & 63, gcol = hd * 64 + lane;
          { CS_LOAD(0); CS_COPY(); CS_ESUM(); }
          CS_BAR();
          { CS_LOAD(1); CS_MAIN(0); } }
        CS_BAR();
        for (int it = -1; it < NCK; ++it) {
            const bool have_next = (it + 1 < NCK);
            const int tid = ltid(), lane = tid & 63, r32 = lane & 31, h = lane >> 5, gcol = hd * 64 + lane;
            LAS unsigned char* X = lds + OFF_X + ((it + 1) & 1) * X_B; LAS unsigned char* M = lds + OFF_MID; LAS unsigned char* O = lds + OFF_OUT;
            f32x16 acc = {}, accT = {};
            if (have_next && wave < 4) {
                if (wave == 0) {
                    bf16x8 fb[4], fa[4];
#pragma unroll
                    for (int s4 = 0; s4 < 4; ++s4) { fb[s4] = *(const LAS bf16x8*)(X + X_BHTM + r32 * TMB + s4 * 32 + h * 16); fa[s4] = *(const LAS bf16x8*)(X + X_ATM + r32 * TMB + s4 * 32 + h * 16); }
#pragma unroll
                    for (int s4 = 0; s4 < 4; ++s4) { acc = __builtin_amdgcn_mfma_f32_32x32x16_bf16(fb[s4], fa[s4], acc, 0, 0, 0); accT = __builtin_amdgcn_mfma_f32_32x32x16_bf16(fa[s4], fb[s4], accT, 0, 0, 0); }
#pragma unroll
                    for (int r = 0; r < 16; ++r) accT[r] = (r32 < rho(r, h)) ? accT[r] : 0.f; }
                else if (wave == 2) mma32(acc, X + X_ATM, TMB, X + X_KHTM, TMB, 4, r32, h);
                else mma32(acc, X + ((wave & 2) ? X_KHTM : X_BHTM), TMB, X + ((wave & 1) ? X_RTM : X_ATM), TMB, 4, r32, h);
#pragma unroll
                for (int r = 0; r < 16; ++r) { const int i = rho(r, h); const bool keep = (wave == 2) ? (r32 < i) : ((wave & 1) ? (i <= r32) : (i < r32)); acc[r] = keep ? acc[r] : 0.f; }
                if (wave == 0) { }
                else if (wave == 1) st_bf_T<false>(acc, M + M_ARBT, CMB, r32, h);
                else if (wave == 2) st_bf_T<false>(acc, M + M_AAK, CMB, r32, h);
                else {
#pragma unroll
                    for (int m = 0; m < 4; ++m) *(LAS f32x4*)(M + M_ARK + r32 * 128 + (8 * m + 4 * h) * 4) = (f32x4){acc[4 * m], acc[4 * m + 1], acc[4 * m + 2], acc[4 * m + 3]}; }
            }
            if (CS_SERIAL) CS_BAR();
            if (it >= 0 && wave >= 6) {
                const int vb = wave - 6; const LAS unsigned char* Yb = lds + OFF_Y + (it & 1) * Y_B;
                bf16x8 bs[4];
#pragma unroll
                for (int s = 0; s < 2; ++s) { u32x4 w0, w1;
                    w0.x = cvt_pk_bf16_c(S0[8 * s + 0], S0[8 * s + 1]); w0.y = cvt_pk_bf16_c(S0[8 * s + 2], S0[8 * s + 3]); w0.z = cvt_pk_bf16_c(S0[8 * s + 4], S0[8 * s + 5]); w0.w = cvt_pk_bf16_c(S0[8 * s + 6], S0[8 * s + 7]);
                    w1.x = cvt_pk_bf16_c(S1[8 * s + 0], S1[8 * s + 1]); w1.y = cvt_pk_bf16_c(S1[8 * s + 2], S1[8 * s + 3]); w1.z = cvt_pk_bf16_c(S1[8 * s + 4], S1[8 * s + 5]); w1.w = cvt_pk_bf16_c(S1[8 * s + 6], S1[8 * s + 7]);
                    bs[s] = *reinterpret_cast<bf16x8*>(&w0); bs[2 + s] = *reinterpret_cast<bf16x8*>(&w1); }
                const LAS unsigned char* Vr = Yb + Y_VCM + (vb * 32 + r32) * CMB + h * 16;
                const bf16x8 bv0 = *(const LAS bf16x8*)Vr, bv1 = *(const LAS bf16x8*)(Vr + 32);
                bf16x8 fy[6], fs[6];
#pragma unroll
                for (int s = 0; s < 4; ++s) { fy[s] = *(const LAS bf16x8*)(O + O_PYT + r32 * TMB + s * 32 + h * 16); fs[s] = *(const LAS bf16x8*)(O + O_PST + r32 * TMB + s * 32 + h * 16); }
#pragma unroll
                for (int s = 0; s < 2; ++s) { fy[4 + s] = *(const LAS bf16x8*)(O + O_QYT + r32 * CMB + s * 32 + h * 16); fs[4 + s] = *(const LAS bf16x8*)(O + O_QST + r32 * CMB + s * 32 + h * 16); }
                f32x16 n0, n1;
#pragma unroll
                for (int m = 0; m < 4; ++m) { const f32x4 g0 = *(const LAS f32x4*)(Yb + Y_GC + (8 * m + 4 * h) * 4), g1 = *(const LAS f32x4*)(Yb + Y_GC + (32 + 8 * m + 4 * h) * 4);
#pragma unroll
                    for (int i = 0; i < 4; ++i) { n0[4 * m + i] = S0[4 * m + i] * g0[i]; n1[4 * m + i] = S1[4 * m + i] * g1[i]; } }
                f32x16 ya = {};
#pragma unroll
                for (int s = 0; s < 4; ++s) { ya = __builtin_amdgcn_mfma_f32_32x32x16_bf16(fy[s], bs[s], ya, 0, 0, 0); n0 = __builtin_amdgcn_mfma_f32_32x32x16_bf16(fs[s], bs[s], n0, 0, 0, 0); }
                ya = __builtin_amdgcn_mfma_f32_32x32x16_bf16(fy[4], bv0, ya, 0, 0, 0); n0 = __builtin_amdgcn_mfma_f32_32x32x16_bf16(fs[4], bv0, n0, 0, 0, 0);
                ya = __builtin_amdgcn_mfma_f32_32x32x16_bf16(fy[5], bv1, ya, 0, 0, 0); n0 = __builtin_amdgcn_mfma_f32_32x32x16_bf16(fs[5], bv1, n0, 0, 0, 0);
#pragma unroll
                for (int s = 0; s < 4; ++s) fs[s] = *(const LAS bf16x8*)(O + O_PST + (32 + r32) * TMB + s * 32 + h * 16);
#pragma unroll
                for (int s = 0; s < 2; ++s) fs[4 + s] = *(const LAS bf16x8*)(O + O_QST + (32 + r32) * CMB + s * 32 + h * 16);
#pragma unroll
                for (int r = 0; r < 16; ++r) *(LAS float*)(lds + OFF_YB + rho(r, h) * 256 + (vb * 32 + r32) * 4) = ya[r];
#pragma unroll
                for (int s = 0; s < 4; ++s) n1 = __builtin_amdgcn_mfma_f32_32x32x16_bf16(fs[s], bs[s], n1, 0, 0, 0);
                n1 = __builtin_amdgcn_mfma_f32_32x32x16_bf16(fs[4], bv0, n1, 0, 0, 0); n1 = __builtin_amdgcn_mfma_f32_32x32x16_bf16(fs[5], bv1, n1, 0, 0, 0);
                S0 = n0; S1 = n1;
            }
            if (it + 2 < NCK) { CS_COPY(); CS_ESUM(); }
            if (wave == 4 || wave == 5) {
                const int pt = tid - 256; scan::MTile m;
                if (it >= 0 && it <= NCK - 2 && moe_tile(a, jl, c + (mt0 + it) * G, m)) {
                    const LAS float* tl_ = (const LAS float*)(lds + OFF_WT); const int sn = pt >> 1, sk = (pt & 1) * 32;
                    const int n = m.n0 + sn, dr = m.grpd ? ((n >> 7) * 256 + (n & 127)) : n; bf16_t* dp = m.dst + (size_t)dr * m.ldd + m.k0 + sk;
#pragma unroll
                    for (int q8 = 0; q8 < 4; ++q8) { float f[8];
#pragma unroll
                        for (int e = 0; e < 8; ++e) f[e] = tl_[(sk + q8 * 8 + e) * 65 + sn];
                        *(__attribute__((address_space(1))) u32x4*)(dp + q8 * 8) = pack8(f); } }
                if (it + 1 < NCK - 1 && moe_tile(a, jl, c + (mt0 + it + 1) * G, m)) { const int kl = pt >> 4, nq = (pt & 15) * 4;
#pragma unroll
                    for (int p8 = 0; p8 < 8; ++p8) wreg[p8] = *(const __attribute__((address_space(1))) f32x4*)(m.src + (size_t)(m.k0 + kl + 8 * p8) * m.sld + m.n0 + nq); }
            }
            CS_BAR();
            if (have_next && wave == 0) {
                f32x16 Tm = acc, Mm = acc, Mt = accT;
#pragma unroll
                for (int r = 0; r < 16; ++r) Tm[r] += (rho(r, h) == r32) ? 1.0f : 0.f;
#define CS_SLAB(tile, s) ({ u32x4 w_; w_.x = cvt_pk_bf16_c(tile[8 * (s) + 0], tile[8 * (s) + 1]); w_.y = cvt_pk_bf16_c(tile[8 * (s) + 2], tile[8 * (s) + 3]); \
                    w_.z = cvt_pk_bf16_c(tile[8 * (s) + 4], tile[8 * (s) + 5]); w_.w = cvt_pk_bf16_c(tile[8 * (s) + 6], tile[8 * (s) + 7]); *reinterpret_cast<bf16x8*>(&w_); })
                for (int lvl = 0; lvl < 4; ++lvl) {
                    const bf16x8 m0 = CS_SLAB(Mm, 0), m1 = CS_SLAB(Mm, 1), t0_ = CS_SLAB(Mt, 0), t1_ = CS_SLAB(Mt, 1);
                    f32x16 m2 = {}, m2t = {};
                    m2 = __builtin_amdgcn_mfma_f32_32x32x16_bf16(t0_, m0, m2, 0, 0, 0); m2t = __builtin_amdgcn_mfma_f32_32x32x16_bf16(m0, t0_, m2t, 0, 0, 0);
                    m2 = __builtin_amdgcn_mfma_f32_32x32x16_bf16(t1_, m1, m2, 0, 0, 0); m2t = __builtin_amdgcn_mfma_f32_32x32x16_bf16(m1, t1_, m2t, 0, 0, 0);
                    Mm = m2; Mt = m2t;
                    { const bf16x8 a0 = CS_SLAB(Mt, 0), a1 = CS_SLAB(Mt, 1), bt0 = CS_SLAB(Tm, 0), bt1 = CS_SLAB(Tm, 1);
                      Tm = __builtin_amdgcn_mfma_f32_32x32x16_bf16(a0, bt0, Tm, 0, 0, 0); Tm = __builtin_amdgcn_mfma_f32_32x32x16_bf16(a1, bt1, Tm, 0, 0, 0); }
                }
                st_bf_T<false>(Tm, M + M_TT, CMB, r32, h);
            }
            if (CS_SERIAL) CS_BAR();
            if (it + 3 < NCK) CS_LOAD(it + 3);
            if (it + 2 < NCK) CS_MAIN(it + 2);
            if (CS_SERIAL) CS_BAR();
            if (it >= 0 && wave >= 5) {
                for (int item = tid - 320; item < 256; item += 192) { const int t = item >> 3, seg = item & 7;
                    const LAS f32x4* yp = (const LAS f32x4*)(lds + OFF_YB + t * 256 + seg * 32); const f32x4 y0 = yp[0], y1 = yp[1];
                    u32x4 w; w.x = cvt_pk_bf16(y0[0], y0[1]); w.y = cvt_pk_bf16(y0[2], y0[3]); w.z = cvt_pk_bf16(y1[0], y1[1]); w.w = cvt_pk_bf16(y1[2], y1[3]);
                    *(__attribute__((address_space(1))) u32x4*)(Y + (size_t)scan::step_row(b, dir, it * 32 + t) * 1024 + hd * 64 + seg * 8) = w; }
            }
            CS_BAR();
            if (have_next && wave < 3) {
                f32x16 d = {};
                if (wave < 2) { mma32(d, M + M_TT, CMB, X + X_ACM + wave * 32 * CMB, CMB, 2, r32, h); st_bf_T<false>(d, M + M_W + wave * 32 * CMB, CMB, r32, h); }
                else { mma32(d, M + M_TT, CMB, M + M_AAK, CMB, 2, r32, h); st_bf_T<false>(d, M + M_UP, CMB, r32, h); }
            }
            if (wave == 4 || wave == 5) { const int pt = tid - 256, kl = pt >> 4, nq = (pt & 15) * 4; scan::MTile m;
                if (it + 1 < NCK - 1 && moe_tile(a, jl, c + (mt0 + it + 1) * G, m)) { LAS float* tl_ = (LAS float*)(lds + OFF_WT);
#pragma unroll
                    for (int p8 = 0; p8 < 8; ++p8) { LAS float* tp = tl_ + (kl + 8 * p8) * 65 + nq; tp[0] = wreg[p8][0]; tp[1] = wreg[p8][1]; tp[2] = wreg[p8][2]; tp[3] = wreg[p8][3]; } } }
            CS_BAR();
            if (have_next) {
                f32x16 d = {};
                if (wave < 4) { const int kt = wave & 1, kpt = wave >> 1;
                    mma32(d, M + M_W + kt * 32 * CMB, CMB, X + X_BBCM + kpt * 32 * CMB, CMB, 2, r32, h);
                    st_bf_T<true>(d, O + O_PST + kpt * 32 * TMB + kt * 64, TMB, r32, h); }
                else if (wave < 6) { const int kt = wave - 4;
                    u32x2 ra[4];
#pragma unroll
                    for (int m = 0; m < 4; ++m) ra[m] = *(const LAS u32x2*)(X + X_RTM + r32 * TMB + (kt * 32 + 8 * m + 4 * h) * 2);
                    mma32(d, M + M_W + kt * 32 * CMB, CMB, M + M_ARBT, CMB, 2, r32, h);
#pragma unroll
                    for (int m = 0; m < 4; ++m) { d[4 * m] += bflo(ra[m].x); d[4 * m + 1] += bfhi(ra[m].x); d[4 * m + 2] += bflo(ra[m].y); d[4 * m + 3] += bfhi(ra[m].y); }
                    st_bf_T<true>(d, O + O_PYT + kt * 64, TMB, r32, h); }
                else { const int kpt = wave - 6;
                    u32x2 ka[4];
#pragma unroll
                    for (int m = 0; m < 4; ++m) ka[m] = *(const LAS u32x2*)(X + X_KBCM + (kpt * 32 + r32) * CMB + (8 * m + 4 * h) * 2);
                    mma32(d, M + M_UP, CMB, X + X_BBCM + kpt * 32 * CMB, CMB, 2, r32, h);
#pragma unroll
                    for (int m = 0; m < 4; ++m) { d[4 * m] += bflo(ka[m].x); d[4 * m + 1] += bfhi(ka[m].x); d[4 * m + 2] += bflo(ka[m].y); d[4 * m + 3] += bfhi(ka[m].y); }
                    st_bf_T<false>(d, O + O_QST + kpt * 32 * CMB, CMB, r32, h);
                    if (wave == 7) { f32x16 e = {}; f32x4 aa[4];
#pragma unroll
                        for (int m = 0; m < 4; ++m) aa[m] = *(const LAS f32x4*)(M + M_ARK + r32 * 128 + (8 * m + 4 * h) * 4);
                        mma32(e, M + M_UP, CMB, M + M_ARBT, CMB, 2, r32, h);
#pragma unroll
                        for (int m = 0; m < 4; ++m) { e[4 * m] += aa[m][0]; e[4 * m + 1] += aa[m][1]; e[4 * m + 2] += aa[m][2]; e[4 * m + 3] += aa[m][3]; }
                        st_bf_T<false>(e, O + O_QYT, CMB, r32, h); } }
            }
            CS_BAR();
        }
#undef CS_LOAD
#undef CS_COPY
#undef CS_ESUM
#undef CS_MAIN
        mt0 += NCK - 1;
    }
}


__device__ __forceinline__ void scan_compare(const Args& a, LAS unsigned char* lds, int G, int c) {
    const int tid = ltid();
    asm volatile("s_waitcnt vmcnt(0)" ::: "memory"); __syncthreads();
    for (int chain = c; chain < 256; chain += G) {
        const int b = chain >> 5, hd = (chain >> 1) & 15, dir = chain & 1;
        const bf16_t* Yo = (const bf16_t*)(a.ws + WS_ARENA + (dir ? A_YR : A_YF)); const bf16_t* Yc = (const bf16_t*)(a.ws + WS_ARENA + (dir ? A_YCR : A_YCF));
        float md = 0.f, mo = 0.f;
        for (int i = tid; i < SEG * 8; i += NTHR) { const int r = i >> 3, seg = i & 7; const size_t off = (size_t)(b * SEG + r) * 1024 + hd * 64 + seg * 8;
            u32x4 wo, wc; const unsigned* po = (const unsigned*)(Yo + off); const unsigned* pc = (const unsigned*)(Yc + off);
#pragma unroll
            for (int q = 0; q < 4; ++q) { wo[q] = __hip_atomic_load(po + q, __ATOMIC_RELAXED, __HIP_MEMORY_SCOPE_AGENT); wc[q] = __hip_atomic_load(pc + q, __ATOMIC_RELAXED, __HIP_MEMORY_SCOPE_AGENT); }
            float yo[8], yc[8]; unpack8(wo, yo); unpack8(wc, yc);
#pragma unroll
            for (int e = 0; e < 8; ++e) { md = fmaxf(md, fabsf(yo[e] - yc[e])); mo = fmaxf(mo, fabsf(yo[e])); } }
#pragma unroll
        for (int o = 32; o >= 1; o >>= 1) { md = fmaxf(md, __shfl_xor(md, o)); mo = fmaxf(mo, __shfl_xor(mo, o)); }
        LAS float* red = (LAS float*)lds;
        if ((tid & 63) == 0) { red[(tid >> 6) * 2] = md; red[(tid >> 6) * 2 + 1] = mo; }
        __syncthreads();
        if (tid == 0) { float d = 0.f, o = 0.f; for (int w = 0; w < 8; ++w) { d = fmaxf(d, red[w * 2]); o = fmaxf(o, red[w * 2 + 1]); }
            if (!(d <= CS_TOL * o)) { bf16_t* Yw = (bf16_t*)(a.ws + WS_ARENA + (dir ? A_YR : A_YF)); Yw[(size_t)(b * SEG + CTX) * 1024 + hd * 64] = (bf16_t)0x7fc0u; } }
        __syncthreads();
    }
}

__device__ __forceinline__ void rwkv_outprep(const Args& a, int j, const bf16_t* Vsrc, const bool vres, int G, int c) {
    const int lane = ltid() & 63; int r0, r1; wave_rows(G, c, r0, r1);
    const bf16_t* YF = (const bf16_t*)(a.ws + WS_ARENA + A_YF); const bf16_t* YR = (const bf16_t*)(a.ws + WS_ARENA + A_YR);
    const bf16_t* RR = (const bf16_t*)(a.ws + WS_ARENA + A_RR); const bf16_t* RK = (const bf16_t*)(a.ws + WS_ARENA + A_RK);
    const bf16_t* AL0 = (const bf16_t*)(a.ws + WS_ARENA + A_AL0); const bf16_t* AL1 = (const bf16_t*)(a.ws + WS_ARENA + A_AL1); const bf16_t* GG = (const bf16_t*)(a.ws + WS_ARENA + A_G);
    bf16_t* O = (bf16_t*)(a.ws + WS_ARENA + A_RO);
    float lnw[16], lnb[16], rk[16], ka[16];
#pragma unroll
    for (int jj = 0; jj < 2; ++jj)
#pragma unroll
        for (int e = 0; e < 8; ++e) { const int col = jj * 512 + lane * 8 + e, i = jj * 8 + e; lnw[i] = a.in[I_LNW][j * D + col]; lnb[i] = a.in[I_LNB][j * D + col]; rk[i] = a.in[I_RK][j * D + col];
            ka[i] = a.in[I_KA][j * D + col]; }
    for (int row = r0; row < r1; ++row) {
        u32x4 out[2];
#pragma unroll
        for (int jj = 0; jj < 2; ++jj) { const size_t off = (size_t)row * 1024 + jj * 512 + lane * 8;
            float yf[8], yr[8], r[8], k[8], v[8], l0[8], l1[8], g[8], y[8];
            unpack8(*(const u32x4*)(YF + off), yf); unpack8(*(const u32x4*)(YR + off), yr); unpack8(*(const u32x4*)(RR + off), r); unpack8(*(const u32x4*)(RK + off), k);
            unpack8(*(const u32x4*)(Vsrc + off), v);
            if (vres) { float vf[8], vl[8]; unpack8(*(const u32x4*)((const bf16_t*)(a.ws + WS_VF) + off), vf); unpack8(*(const u32x4*)((const bf16_t*)(a.ws + WS_ARENA + A_VL) + off), vl);
#pragma unroll
                for (int e = 0; e < 8; ++e) v[e] = v[e] + (vf[e] - v[e]) * sigmoidf_(a.in[I_V0][jj * 512 + lane * 8 + e] + vl[e]); }
            unpack8(*(const u32x4*)(AL0 + off), l0); unpack8(*(const u32x4*)(AL1 + off), l1); unpack8(*(const u32x4*)(GG + off), g);
            float sm = 0.f, dot = 0.f;
#pragma unroll
            for (int e = 0; e < 8; ++e) { const int i = jj * 8 + e; y[e] = yf[e] + yr[e]; sm += y[e];
                const float adm = 0.5f * (l0[e] + l1[e]); const float kb = k[e] * (1.0f + (adm - 1.0f) * ka[i]); dot += r[e] * kb * rk[i]; }
            sm = red8(sm); dot = red8(dot); const float mu = sm * (1.0f / 64.0f); float var = 0.f;
#pragma unroll
            for (int e = 0; e < 8; ++e) { const float d = y[e] - mu; var += d * d; }
            var = red8(var) * (1.0f / 64.0f); const float rstd = 1.0f / sqrtf(var + LNX_EPS);
            float o[8];
#pragma unroll
            for (int e = 0; e < 8; ++e) { const int i = jj * 8 + e; o[e] = ((y[e] - mu) * rstd * lnw[i] + lnb[i] + dot * v[e]) * g[e]; }
            out[jj] = pack8(o); }
        *(u32x4*)(O + (size_t)row * 1024 + lane * 8) = out[0]; *(u32x4*)(O + (size_t)row * 1024 + 512 + lane * 8) = out[1];
    }
}

__device__ __forceinline__ void moe_gather(const Args& a, LAS unsigned char* lds, int G, int c) {
    const int tid = ltid(), wave = tid >> 6, lane = tid & 63; int r0, r1; wave_rows(G, c, r0, r1);
    LAS int* cnt = (LAS int*)lds;
    if (tid < 16) cnt[tid] = 0;
    __syncthreads();
    const int* hist = (const int*)(a.ws + WS_HIST); const int nchunk = G * NWAVE, first = c * NWAVE;
    int pre[8], tot[8];
#pragma unroll
    for (int e = 0; e < 8; ++e) { pre[e] = 0; tot[e] = 0; }
    for (int ch = tid; ch < nchunk; ch += NTHR) { const u32x4 h0 = *(const u32x4*)(hist + (size_t)ch * 8), h1 = *(const u32x4*)(hist + (size_t)ch * 8 + 4); const int m = ch < first ? 1 : 0;
        tot[0] += h0[0]; tot[1] += h0[1]; tot[2] += h0[2]; tot[3] += h0[3]; tot[4] += h1[0]; tot[5] += h1[1]; tot[6] += h1[2]; tot[7] += h1[3];
        pre[0] += m * h0[0]; pre[1] += m * h0[1]; pre[2] += m * h0[2]; pre[3] += m * h0[3]; pre[4] += m * h1[0]; pre[5] += m * h1[1]; pre[6] += m * h1[2]; pre[7] += m * h1[3]; }
#pragma unroll
    for (int e = 0; e < 8; ++e) { int p = pre[e], t = tot[e];
#pragma unroll
        for (int o = 32; o >= 1; o >>= 1) { p += __shfl_xor(p, o); t += __shfl_xor(t, o); }
        if (lane == 0) { __hip_atomic_fetch_add(&cnt[e], p, __ATOMIC_RELAXED, __HIP_MEMORY_SCOPE_WORKGROUP); __hip_atomic_fetch_add(&cnt[8 + e], t, __ATOMIC_RELAXED, __HIP_MEMORY_SCOPE_WORKGROUP); } }
    __syncthreads();
    int base[9], run[8]; base[0] = 0;
#pragma unroll
    for (int e = 0; e < 8; ++e) base[e + 1] = base[e] + ((cnt[8 + e] + 255) & ~255);
    if (c == 0 && tid < 9) { int v = 0;
#pragma unroll
        for (int e = 0; e < 9; ++e) v = (tid == e) ? base[e] : v;
        ((int*)(a.ws + WS_META))[tid] = v; }
#pragma unroll
    for (int e = 0; e < 8; ++e) { int p = cnt[e];
        for (int w = 0; w < wave; ++w) p += hist[(size_t)(first + w) * 8 + e];
        run[e] = base[e] + p; }
    const bf16_t* H = (const bf16_t*)(a.ws + WS_ARENA + A_H); bf16_t* HS = (bf16_t*)(a.ws + WS_ARENA + A_HS);
    for (int row = r0; row < r1; ++row) {
        const u32x4 rt = *(const u32x4*)(a.ws + WS_ROUTE + (size_t)row * 16); const int e0 = (int)rt[0], e1 = (int)rt[1];
        if (e0 < 0) continue;
        int s0 = 0, s1 = 0;
#pragma unroll
        for (int e = 0; e < 8; ++e) { if (e == e0) { s0 = run[e]; run[e] += 1; } if (e == e1) { s1 = run[e]; run[e] += 1; } }
        const u32x4 h0 = *(const u32x4*)(H + (size_t)row * 1024 + lane * 8), h1 = *(const u32x4*)(H + (size_t)row * 1024 + 512 + lane * 8);
        *(u32x4*)(HS + (size_t)s0 * 1024 + lane * 8) = h0; *(u32x4*)(HS + (size_t)s0 * 1024 + 512 + lane * 8) = h1;
        *(u32x4*)(HS + (size_t)s1 * 1024 + lane * 8) = h0; *(u32x4*)(HS + (size_t)s1 * 1024 + 512 + lane * 8) = h1;
        if (lane == 0) { int* sl = (int*)(a.ws + WS_RSLOT) + (size_t)row * 2; sl[0] = s0; sl[1] = s1; }
    }
}
__device__ __forceinline__ void final_combine(const Args& a, int layer, int G, int c) {
    const int lane = ltid() & 63; int r0, r1; wave_rows(G, c, r0, r1);
    for (int row = r0; row < r1; ++row) { if (row % SEG < CTX) continue;
        float* xp = xrow(a, row); float x[16]; load_x16(xp, lane, x); moe_combine16(a, row, layer, lane, x); store_x16(xp, lane, x); }
}

constexpr int NPH = 42;
#define CT(k) (((PSEL) >> (k)) & 1u)
#ifndef PROBE_MASK
#define PROBE_MASK 0u
#endif
#ifndef TPROBE_MASK
#define TPROBE_MASK 0u
#endif
struct TimeProbe { int n; bool on; unsigned long long t0;
    __device__ __forceinline__ TimeProbe(bool twice, bool on_) : n(twice ? 2 : 1), on(on_), t0(0) { if (on) t0 = wall_clock64(); }
    __device__ __forceinline__ void step() { --n; if (on && n == 0) { __syncthreads(); const unsigned long long t1 = wall_clock64(), dt = t1 - t0; while (wall_clock64() - t1 < dt) __builtin_amdgcn_s_sleep(8); } } };
#define REPS(k) for (TimeProbe tp_((((PROBE_MASK) >> (k)) & 1u) != 0u, (((TPROBE_MASK) >> (k)) & 1u) != 0u); tp_.n > 0; tp_.step())
constexpr int LDS_ST_OFF = 161792;
constexpr int LDS_BYTES = LDS_ST_OFF + 64;
constexpr int TILE_OFF = 73728;
#define WSP(off) (a.ws + WS_ARENA + (off))
template <unsigned PSEL>
__global__ void __launch_bounds__(NTHR, 2) fwd(Args ka) {
    extern __shared__ __attribute__((aligned(16))) unsigned char lds_raw[];
    LAS unsigned char* lds = (LAS unsigned char*)lds_raw;
    const int Gk = gridDim.x, ck = blockIdx.x, tid = ltid();
    volatile LAS unsigned* st = (volatile LAS unsigned*)(lds + LDS_ST_OFF);
    if (tid < 4) st[tid] = 0u;
    __syncthreads();
    XcdBarrier bar; bar.bar = (unsigned*)(ka.ws + WS_CTL); bar.x = 0; bar.st = st;
    if (ka.ph_hi - ka.ph_lo > 1) bar = xcd_barrier_post((unsigned*)(ka.ws + WS_CTL), st);
#define IN(p) (ka.ph_lo <= (p) && (p) < ka.ph_hi)
#define PHB const Args a = launder_args(ka); const int G = launder_s(Gk), c = launder_s(ck); (void)G; (void)c;
#define SEAM(p) do { if (IN(p) && IN((p) + 1)) xcd_barrier(bar); } while (0)
    const size_t P1K = (size_t)256 * 1024 * 2;

    { const int jj_ = 0; const bool last_ = false;
    if (CT(20) && IN(0)) REPS(20) { PHB const bf16_t* wm = wmla(a, jj_); const bf16_t* wr_ = wrwkv(a, jj_); const bf16_t* wf = wffn(a, jj_); bf16_t* Vb = last_ ? (bf16_t*)WSP(A_RV) : (bf16_t*)(a.ws + WS_VF); (void)wm; (void)wr_; (void)wf; (void)Vb;
            { prologue_misc(a, lds, G, c); run_prep(a, lds + TILE_OFF, -1, 0, G, c); } }
    }
    SEAM(0);

    for (int jj = 0; jj < 2; ++jj) {
        const int pb = 1 + jj * 20, lm = 2 * jj, lr = 2 * jj + 1, jj_ = jj; const bool last = (jj == 1), last_ = last;

        if (CT(0) && IN(pb + 0)) REPS(0) { PHB const bf16_t* wm = wmla(a, jj_); const bf16_t* wr_ = wrwkv(a, jj_); const bf16_t* wf = wffn(a, jj_); bf16_t* Vb = last_ ? (bf16_t*)WSP(A_RV) : (bf16_t*)(a.ws + WS_VF); (void)wm; (void)wr_; (void)wf; (void)Vb;
            { if (jj == 0) norm_plain<false, true>(a, lm, a.in[I_N1G] + lm * D, 0, (bf16_t*)WSP(A_H), G, c); else combine_rows<true>(a, lm - 1, lm, a.in[I_N1G] + lm * D, 0, (bf16_t*)WSP(A_H), G, c); } }
        SEAM(pb + 0);
        if (CT(1) && IN(pb + 1)) REPS(1) { PHB const bf16_t* wm = wmla(a, jj_); const bf16_t* wr_ = wrwkv(a, jj_); const bf16_t* wf = wffn(a, jj_); bf16_t* Vb = last_ ? (bf16_t*)WSP(A_RV) : (bf16_t*)(a.ws + WS_VF); (void)wm; (void)wr_; (void)wf; (void)Vb;
            { MapSimple S{(const char*)WSP(A_H), (const char*)wm, P1K, P1K, 3, 16, 0}; EpiBf<FPlain> E{{(bf16_t*)WSP(A_QKVA), 768}};
            pg8::gemm_phase(lds, 1024, 1024, S, E, G, c); } }
        SEAM(pb + 1);
        if (CT(2) && IN(pb + 2)) REPS(2) { PHB const bf16_t* wm = wmla(a, jj_); const bf16_t* wr_ = wrwkv(a, jj_); const bf16_t* wf = wffn(a, jj_); bf16_t* Vb = last_ ? (bf16_t*)WSP(A_RV) : (bf16_t*)(a.ws + WS_VF); (void)wm; (void)wr_; (void)wf; (void)Vb;
            mla_stats(a, G, c); }
        SEAM(pb + 2);
        if (CT(3) && IN(pb + 3)) REPS(3) { PHB const bf16_t* wm = wmla(a, jj_); const bf16_t* wr_ = wrwkv(a, jj_); const bf16_t* wf = wffn(a, jj_); bf16_t* Vb = last_ ? (bf16_t*)WSP(A_RV) : (bf16_t*)(a.ws + WS_VF); (void)wm; (void)wr_; (void)wf; (void)Vb;
            { MapQKV S{(const char*)WSP(A_QKVA), (const char*)(wm + E_QKVA), (const char*)(wm + E_QKVA + E_QB)};
            EpiQKV E{(bf16_t*)WSP(A_Q), (bf16_t*)WSP(A_KV), (const float*)(a.ws + WS_RS), (const float*)(a.ws + WS_RS) + R};
            pg8::gemm_phase(lds, 768, 384, S, E, G, c); } }
        SEAM(pb + 3);
        if (CT(4) && IN(pb + 4)) REPS(4) { PHB const bf16_t* wm = wmla(a, jj_); const bf16_t* wr_ = wrwkv(a, jj_); const bf16_t* wf = wffn(a, jj_); bf16_t* Vb = last_ ? (bf16_t*)WSP(A_RV) : (bf16_t*)(a.ws + WS_VF); (void)wm; (void)wr_; (void)wf; (void)Vb;
            mla_qkpost(a, jj, G, c); }
        SEAM(pb + 4);
        if (CT(5) && IN(pb + 5)) REPS(5) { PHB const bf16_t* wm = wmla(a, jj_); const bf16_t* wr_ = wrwkv(a, jj_); const bf16_t* wf = wffn(a, jj_); bf16_t* Vb = last_ ? (bf16_t*)WSP(A_RV) : (bf16_t*)(a.ws + WS_VF); (void)wm; (void)wr_; (void)wf; (void)Vb;
            attn_phase(a, lds, G, c); }
        SEAM(pb + 5);
        if (CT(6) && IN(pb + 6)) REPS(6) { PHB const bf16_t* wm = wmla(a, jj_); const bf16_t* wr_ = wrwkv(a, jj_); const bf16_t* wf = wffn(a, jj_); bf16_t* Vb = last_ ? (bf16_t*)WSP(A_RV) : (bf16_t*)(a.ws + WS_VF); (void)wm; (void)wr_; (void)wf; (void)Vb;
            { MapSimple S{(const char*)WSP(A_O), (const char*)(wm + E_QKVA + E_QB + E_KVB), P1K, P1K, 4, 16, 0}; EpiResid E{(float*)(a.ws + WS_CS), a.out, (const float*)(a.ws + WS_MODS), lm, 2, jj == 0 ? a.in[I_CTX] : (const float*)(a.ws + WS_CS), jj == 0 ? a.in[I_X] : (const float*)a.out};
            pg8::gemm_phase(lds, 1024, 1024, S, E, G, c); } }
        SEAM(pb + 6);
        if (CT(7) && IN(pb + 7)) REPS(7) { PHB const bf16_t* wm = wmla(a, jj_); const bf16_t* wr_ = wrwkv(a, jj_); const bf16_t* wf = wffn(a, jj_); bf16_t* Vb = last_ ? (bf16_t*)WSP(A_RV) : (bf16_t*)(a.ws + WS_VF); (void)wm; (void)wr_; (void)wf; (void)Vb;
            norm_plain<false>(a, lm, a.in[I_N2G] + lm * D, 3, (bf16_t*)WSP(A_H), G, c); }
        SEAM(pb + 7);
        if (CT(8) && IN(pb + 8)) REPS(8) { PHB const bf16_t* wm = wmla(a, jj_); const bf16_t* wr_ = wrwkv(a, jj_); const bf16_t* wf = wffn(a, jj_); bf16_t* Vb = last_ ? (bf16_t*)WSP(A_RV) : (bf16_t*)(a.ws + WS_VF); (void)wm; (void)wr_; (void)wf; (void)Vb;
            { MapSimple S{(const char*)WSP(A_H), (const char*)wf, P1K, P1K, 22, 16, 0}; EpiSwiGLU E{(bf16_t*)WSP(A_FHID), DFF};
            pg8::gemm_phase(lds, 1024, 1024, S, E, G, c); } }
        SEAM(pb + 8);
        if (CT(9) && IN(pb + 9)) REPS(9) { PHB const bf16_t* wm = wmla(a, jj_); const bf16_t* wr_ = wrwkv(a, jj_); const bf16_t* wf = wffn(a, jj_); bf16_t* Vb = last_ ? (bf16_t*)WSP(A_RV) : (bf16_t*)(a.ws + WS_VF); (void)wm; (void)wr_; (void)wf; (void)Vb;
            {
              const bool ovl = OVERLAP_TAIL && (ka.ph_hi - ka.ph_lo > 1) && G >= 64;
              EpiResid E{(float*)(a.ws + WS_CS), a.out, (const float*)(a.ws + WS_MODS), lm, 5, (const float*)(a.ws + WS_CS), (const float*)a.out};
              if (!ovl) { MapSimple S{(const char*)WSP(A_FHID), (const char*)(wf + E_F13), (size_t)256 * DFF * 2, (size_t)256 * DFF * 2, 4, 44, 0}; pg8::gemm_phase(lds, DFF, DFF, S, E, G, c); }
              else { { MapTail S{(const char*)WSP(A_FHID), (const char*)(wf + E_F13), (size_t)256 * DFF * 2, (size_t)256 * DFF * 2, 44, 0, 512}; pg8::gemm_phase(lds, DFF, DFF, S, E, G, c); }
                     xcd_barrier(bar);
                     if (c < 32) { MapTail S{(const char*)WSP(A_FHID), (const char*)(wf + E_F13), (size_t)256 * DFF * 2, (size_t)256 * DFF * 2, 44, 512, 544}; pg8::gemm_phase(lds, DFF, DFF, S, E, G, c); }
                     else norm_mix(a, lr, jj, 0, 32767, (G - 32) * NWAVE, (c - 32) * NWAVE + (ltid() >> 6)); } } }
        SEAM(pb + 9);
        if (CT(10) && IN(pb + 10)) REPS(10) { PHB const bf16_t* wm = wmla(a, jj_); const bf16_t* wr_ = wrwkv(a, jj_); const bf16_t* wf = wffn(a, jj_); bf16_t* Vb = last_ ? (bf16_t*)WSP(A_RV) : (bf16_t*)(a.ws + WS_VF); (void)wm; (void)wr_; (void)wf; (void)Vb;
            { const bool ovl = OVERLAP_TAIL && (ka.ph_hi - ka.ph_lo > 1) && G >= 64;
              norm_mix(a, lr, jj, ovl ? 32767 : 0, R, G * NWAVE, c * NWAVE + (ltid() >> 6)); } }
        SEAM(pb + 10);
        if (CT(11) && IN(pb + 11)) REPS(11) { PHB const bf16_t* wm = wmla(a, jj_); const bf16_t* wr_ = wrwkv(a, jj_); const bf16_t* wf = wffn(a, jj_); bf16_t* Vb = last_ ? (bf16_t*)WSP(A_RV) : (bf16_t*)(a.ws + WS_VF); (void)wm; (void)wr_; (void)wf; (void)Vb;
            { MapRw1 S{(const char*)WSP(A_AX), (const char*)wr_, (const char*)(wr_ + E_B1), (const char*)(wr_ + E_B1 + E_B2), G};
            EpiBf<FRw1> E{{(bf16_t*)WSP(A_L1), (bf16_t*)WSP(A_RR), (bf16_t*)WSP(A_RK), Vb}};
            pg8::gemm_phase(lds, 5120, LDB1, S, E, G, c); } }
        SEAM(pb + 11);
        if (CT(12) && IN(pb + 12)) REPS(12) { PHB const bf16_t* wm = wmla(a, jj_); const bf16_t* wr_ = wrwkv(a, jj_); const bf16_t* wf = wffn(a, jj_); bf16_t* Vb = last_ ? (bf16_t*)WSP(A_RV) : (bf16_t*)(a.ws + WS_VF); (void)wm; (void)wr_; (void)wf; (void)Vb;
            { int nt4 = 4; asm volatile("" : "+s"(nt4));
            MapRw2 S{(const char*)WSP(A_L1), (const char*)(wr_ + E_B1 + E_B2 + E_L1), (const char*)(wr_ + E_B1 + E_B2 + E_L1 + E_L2A), 0, last ? 24 : 20, nt4};
            EpiRw2 E{(bf16_t*)WSP(A_WL0), (bf16_t*)WSP(A_VL), a.in[I_W0] + (size_t)jj * 2 * D, a.in[I_A0] + (size_t)jj * 2 * D}; pg8::gemm_phase(lds, 512, 256, S, E, G, c); } }
        SEAM(pb + 12);
        if (CT(13) && IN(pb + 13)) REPS(13) { PHB const bf16_t* wm = wmla(a, jj_); const bf16_t* wr_ = wrwkv(a, jj_); const bf16_t* wf = wffn(a, jj_); bf16_t* Vb = last_ ? (bf16_t*)WSP(A_RV) : (bf16_t*)(a.ws + WS_VF); (void)wm; (void)wr_; (void)wf; (void)Vb;
            { if (SCAN_CHUNKED) scan_chunked(a, jj, Vb, last, lds, G, c); if (!SCAN_CHUNKED || CS_BOTH) { __syncthreads(); scan_phase(a, jj, Vb, last, lds, G, c); }
              if (SCAN_CHUNKED && CS_BOTH) scan_compare(a, lds, G, c); } }
        SEAM(pb + 13);
        if (CT(14) && IN(pb + 14)) REPS(14) { PHB const bf16_t* wm = wmla(a, jj_); const bf16_t* wr_ = wrwkv(a, jj_); const bf16_t* wf = wffn(a, jj_); bf16_t* Vb = last_ ? (bf16_t*)WSP(A_RV) : (bf16_t*)(a.ws + WS_VF); (void)wm; (void)wr_; (void)wf; (void)Vb;
            rwkv_outprep(a, jj, Vb, last, G, c); }
        SEAM(pb + 14);
        if (CT(15) && IN(pb + 15)) REPS(15) { PHB const bf16_t* wm = wmla(a, jj_); const bf16_t* wr_ = wrwkv(a, jj_); const bf16_t* wf = wffn(a, jj_); bf16_t* Vb = last_ ? (bf16_t*)WSP(A_RV) : (bf16_t*)(a.ws + WS_VF); (void)wm; (void)wr_; (void)wf; (void)Vb;
            { MapSimple S{(const char*)WSP(A_RO), (const char*)(wr_ + E_B1 + E_B2 + E_L1 + E_L2A + E_L2B), P1K, P1K, 4, 16, last ? 1 : 0}; EpiResid E{(float*)(a.ws + WS_CS), a.out, (const float*)(a.ws + WS_MODS), lr, 2, (const float*)(a.ws + WS_CS), (const float*)a.out};
            pg8::gemm_phase(lds, 1024, 1024, S, E, G, c); } }
        SEAM(pb + 15);
        if (CT(16) && IN(pb + 16)) REPS(16) { PHB const bf16_t* wm = wmla(a, jj_); const bf16_t* wr_ = wrwkv(a, jj_); const bf16_t* wf = wffn(a, jj_); bf16_t* Vb = last_ ? (bf16_t*)WSP(A_RV) : (bf16_t*)(a.ws + WS_VF); (void)wm; (void)wr_; (void)wf; (void)Vb;
            { norm_router(a, lr, jj, last, lds, G, c); run_prep(a, lds + TILE_OFF, jj, CS_NOTILE ? 0 : (SCAN_CHUNKED ? cs::NCK - 1 : scan::NCH - 2), G, c);   } }
        SEAM(pb + 16);
        if (CT(17) && IN(pb + 17)) REPS(17) { PHB const bf16_t* wm = wmla(a, jj_); const bf16_t* wr_ = wrwkv(a, jj_); const bf16_t* wf = wffn(a, jj_); bf16_t* Vb = last_ ? (bf16_t*)WSP(A_RV) : (bf16_t*)(a.ws + WS_VF); (void)wm; (void)wr_; (void)wf; (void)Vb;
            moe_gather(a, lds, G, c); }
        SEAM(pb + 17);
        if (CT(18) && IN(pb + 18)) REPS(18) { PHB const bf16_t* wm = wmla(a, jj_); const bf16_t* wr_ = wrwkv(a, jj_); const bf16_t* wf = wffn(a, jj_); bf16_t* Vb = last_ ? (bf16_t*)WSP(A_RV) : (bf16_t*)(a.ws + WS_VF); (void)wm; (void)wr_; (void)wf; (void)Vb;
            { MapMoe S{(const char*)WSP(A_HS), (const char*)WSP(A_WM13), P1K, E_M13 * 2, P1K, 28, 16, (const int*)(a.ws + WS_META)}; EpiSwiGLU E{(bf16_t*)WSP(A_MHID), DFE};
            pg8::gemm_phase(lds, 1024, 1024, S, E, G, c); } }
        SEAM(pb + 18);
        if (CT(19) && IN(pb + 19)) REPS(19) { PHB const bf16_t* wm = wmla(a, jj_); const bf16_t* wr_ = wrwkv(a, jj_); const bf16_t* wf = wffn(a, jj_); bf16_t* Vb = last_ ? (bf16_t*)WSP(A_RV) : (bf16_t*)(a.ws + WS_VF); (void)wm; (void)wr_; (void)wf; (void)Vb;
            { MapMoeDown S{(const char*)WSP(A_MHID), (const char*)WSP(A_WM2), (size_t)256 * DFE * 2, E_M2 * 2, (size_t)256 * DFE * 2, (const int*)(a.ws + WS_META)}; EpiBf<FPlainAux> E{{(bf16_t*)WSP(A_Y2), 1024}};
            pg8::gemm_phase(lds, DFE, DFE, S, E, G, c); } }
        SEAM(pb + 19);
    }
    { const int jj_ = 1; const bool last_ = true;
    if (CT(21) && IN(41)) REPS(21) { PHB const bf16_t* wm = wmla(a, jj_); const bf16_t* wr_ = wrwkv(a, jj_); const bf16_t* wf = wffn(a, jj_); bf16_t* Vb = last_ ? (bf16_t*)WSP(A_RV) : (bf16_t*)(a.ws + WS_VF); (void)wm; (void)wr_; (void)wf; (void)Vb;
            combine_rows<false>(a, 3, 0, nullptr, 0, nullptr, G, c); }
    }
#undef IN
#undef SEAM
}

typedef void (*KernFn)(Args);
#if MK_ONE_LAUNCH
#ifndef PMASK
#define PMASK 0x3fffffu
#endif
static KernFn kern_of(int) { return fwd<PMASK>; }
#else
static KernFn kern_of(int p) {
    static const KernFn tab[22] = { fwd<1u << 0>, fwd<1u << 1>, fwd<1u << 2>, fwd<1u << 3>, fwd<1u << 4>, fwd<1u << 5>, fwd<1u << 6>, fwd<1u << 7>, fwd<1u << 8>, fwd<1u << 9>, fwd<1u << 10>, fwd<1u << 11>, fwd<1u << 12>, fwd<1u << 13>, fwd<1u << 14>, fwd<1u << 15>, fwd<1u << 16>, fwd<1u << 17>, fwd<1u << 18>, fwd<1u << 19>, fwd<1u << 20>, fwd<1u << 21> };
    return tab[p == 0 ? 20 : (p == NPH - 1 ? 21 : (p - 1) % 20)];
}
#endif
extern "C" void kernel_launch(void* const* d_in, const int* in_sizes, int n_in, void* d_out, int out_size, void* d_ws, size_t ws_size, hipStream_t stream) {
    static int grid = 0;
    if (grid == 0) {
        if (n_in != N_IN || out_size != NB * SEQ * D || ws_size < WS_NEED) { fprintf(stderr, "kernel_launch: unexpected shapes: n_in %d out %d ws %zu (need %zu)\n", n_in, out_size, ws_size, (size_t)WS_NEED); grid = -1; return; }
        int dev = 0, cus = 0;
        if (hipGetDevice(&dev) != hipSuccess || hipDeviceGetAttribute(&cus, hipDeviceAttributeMultiprocessorCount, dev) != hipSuccess) { grid = -1; return; }
        for (int p = 0; p < NPH; ++p)
            if (hipFuncSetAttribute((const void*)kern_of(p), hipFuncAttributeMaxDynamicSharedMemorySize, LDS_BYTES) != hipSuccess) { fprintf(stderr, "kernel_launch: hipFuncSetAttribute failed\n"); grid = -1; return; }
        int per_cu = 0;
        if (hipOccupancyMaxActiveBlocksPerMultiprocessor(&per_cu, (const void*)kern_of(1), NTHR, LDS_BYTES) != hipSuccess || per_cu < 1) { fprintf(stderr, "kernel_launch: occupancy query says %d blocks per CU\n", per_cu); (void)hipGetLastError(); }
        grid = cus < 256 ? cus : 256;
    }
    if (grid < 0) return;
    (void)in_sizes;
    (void)hipMemsetAsync((char*)d_ws + WS_CTL, 0, CTL_BYTES, stream);
    Args a{};
    for (int i = 0; i < N_IN; ++i) a.in[i] = (const float*)d_in[i];
    a.out = (float*)d_out; a.ws = (unsigned char*)d_ws;
#if MK_ONE_LAUNCH
    a.ph_lo = 0; a.ph_hi = NPH;
    hipLaunchKernelGGL(kern_of(0), dim3(grid), dim3(NTHR), LDS_BYTES, stream, a);
#else
    for (int p = 0; p < NPH; ++p) { a.ph_lo = p; a.ph_hi = p + 1; hipLaunchKernelGGL(kern_of(p), dim3(grid), dim3(NTHR), LDS_BYTES, stream, a); }
#endif
    const hipError_t le = hipPeekAtLastError();
    if (le != hipSuccess) fprintf(stderr, "kernel_launch: launch failed: %s\n", hipGetErrorName(le));
}
```
